# Optimizing an MI355X kernel written in HIP

```python
import math
import jax, jax.numpy as jnp
from jax import lax
import numpy as np

D_MODEL = 1024
BATCH = 16
SEQ = 2048
DEPTH = 2

N_MEM = 256
CONV_CH = D_MODEL // 2
CONV_WIDTH = 31
DIFF_HEADS = 4
DIFF_HEAD_DIM = 64
DIFF_V_DIM = 2 * DIFF_HEAD_DIM
DIFF_QK = DIFF_HEADS * 2 * DIFF_HEAD_DIM
DIFF_WIDTH = DIFF_HEADS * DIFF_V_DIM
IN_COLS = 2 * CONV_CH + 2 * DIFF_QK + DIFF_WIDTH
Q_BLOCK = 128
REL_BUCKETS = 32
REL_MAX_DIST = 128
RWKV_HEAD_DIM = 64
RWKV_HEADS = D_MODEL // RWKV_HEAD_DIM
DECAY_LORA = 64
ICLR_LORA = 64
GATE_LORA = 160
GN_EPS = 64e-5
XATTN_HEADS = 4
XATTN_HEAD_DIM = D_MODEL // XATTN_HEADS
FFN_HIDDEN = 4 * D_MODEL
N_EVEN = (DEPTH + 1) // 2
N_ODD = DEPTH // 2
NORM_EPS = 1e-6

kernel_name = 'hybrid_conv_diffattn_rwkv7_encoder'


def rms_norm(x, g):
    xf = x.astype(jnp.float32)
    y = xf * lax.rsqrt(jnp.mean(jnp.square(xf), axis=-1, keepdims=True) + NORM_EPS)
    return (y * g.astype(jnp.float32)).astype(x.dtype)


def layer_norm(x, g, b, eps):
    xf = x.astype(jnp.float32)
    mu = jnp.mean(xf, axis=-1, keepdims=True)
    var = jnp.mean(jnp.square(xf - mu), axis=-1, keepdims=True)
    y = (xf - mu) * lax.rsqrt(var + eps) * g.astype(jnp.float32) + b.astype(jnp.float32)
    return y.astype(x.dtype)


def t5_bucket(rel):
    nb = REL_BUCKETS // 2
    max_exact = nb // 2
    ret = jnp.where(rel > 0, nb, 0)
    n = jnp.abs(rel)
    nf = jnp.maximum(n, 1).astype(jnp.float32)
    large = max_exact + (jnp.log(nf / max_exact) / math.log(REL_MAX_DIST / max_exact)
                         * (nb - max_exact)).astype(jnp.int32)
    large = jnp.minimum(large, nb - 1)
    return ret + jnp.where(n < max_exact, n, large)


def diff_attention(q, k, v, rel_table, lam):
    B, T = q.shape[0], q.shape[1]
    nblk = T // Q_BLOCK
    scale = DIFF_HEAD_DIM ** -0.5
    qb = q.reshape(B, nblk, Q_BLOCK, DIFF_HEADS, 2, DIFF_HEAD_DIM).transpose(1, 0, 3, 4, 2, 5)
    kt = k.transpose(0, 2, 3, 1, 4)
    vt = v.transpose(0, 2, 1, 3)
    key_pos = jnp.arange(T, dtype=jnp.int32)

    def block(args):
        q_blk, start = args
        q_pos = start + jnp.arange(Q_BLOCK, dtype=jnp.int32)
        bias = rel_table[t5_bucket(key_pos[None, :] - q_pos[:, None])]
        bias = jnp.transpose(bias, (2, 0, 1)).astype(jnp.float32)
        s = jnp.einsum('bhcqd,bhckd->bhcqk', q_blk, kt).astype(jnp.float32) * scale + bias[None, :, None]
        p = jax.nn.softmax(s, axis=-1)
        a = (p[:, :, 0] - lam * p[:, :, 1]).astype(vt.dtype)
        return jnp.einsum('bhqk,bhkv->bhqv', a, vt)

    starts = jnp.arange(nblk, dtype=jnp.int32) * Q_BLOCK
    o = lax.map(block, (qb, starts))
    return o.transpose(1, 0, 3, 2, 4).reshape(B, T, DIFF_HEADS, DIFF_V_DIM)


def conv_diff_mixer(h, w_in, w_out, conv_w, conv_b, ln_g, ln_b, lq1, lk1, lq2, lk2, subln_g, rel_table, layer_idx):
    B, T, _ = h.shape
    proj = h @ w_in
    u, q, k, v = jnp.split(proj, [2 * CONV_CH, 2 * CONV_CH + DIFF_QK, 2 * CONV_CH + 2 * DIFF_QK], axis=-1)
    u = u[..., :CONV_CH] * jax.nn.sigmoid(u[..., CONV_CH:])
    pad = CONV_WIDTH // 2
    u = lax.conv_general_dilated(u, conv_w[:, None, :].astype(u.dtype), (1,), [(pad, pad)],
                                 dimension_numbers=('NWC', 'WIO', 'NWC'),
                                 feature_group_count=CONV_CH) + conv_b
    u = jax.nn.silu(layer_norm(u, ln_g, ln_b, 1e-5))
    lam_init = 0.8 - 0.6 * math.exp(-0.3 * layer_idx)
    lam = (jnp.exp(jnp.sum(lq1.astype(jnp.float32) * lk1.astype(jnp.float32)))
           - jnp.exp(jnp.sum(lq2.astype(jnp.float32) * lk2.astype(jnp.float32))) + lam_init)
    o = diff_attention(q.reshape(B, T, DIFF_HEADS, 2, DIFF_HEAD_DIM),
                       k.reshape(B, T, DIFF_HEADS, 2, DIFF_HEAD_DIM),
                       v.reshape(B, T, DIFF_HEADS, DIFF_V_DIM), rel_table, lam)
    o = rms_norm(o, subln_g) * (1.0 - lam_init)
    mixed = jnp.concatenate([u, o.reshape(B, T, DIFF_WIDTH).astype(u.dtype)], axis=-1)
    return mixed @ w_out


def wkv7_scan(r, w, k, v, a, b, reverse):
    B, T, H, N = r.shape
    xs = tuple(jnp.moveaxis(t.astype(jnp.float32), 1, 0) for t in (r, w, k, v, a, b))

    def step(S, inp):
        r_t, w_t, k_t, v_t, a_t, b_t = inp
        sa = jnp.einsum('bhij,bhj->bhi', S, a_t)
        S = S * w_t[:, :, None, :] + sa[..., None] * b_t[:, :, None, :] + v_t[..., None] * k_t[:, :, None, :]
        return S, jnp.einsum('bhij,bhj->bhi', S, r_t)

    S0 = jnp.zeros((B, H, N, N), jnp.float32)
    _, ys = lax.scan(step, S0, xs, reverse=reverse)
    return jnp.moveaxis(ys, 0, 1)


def rwkv7_mixer(h, mu, w_r, w_k, w_v, w_o, w0, w1, w2, a0, a1, a2, g1, g2, k_k, k_a, r_k, ln_g, ln_b):
    B, T, D = h.shape
    H, N = RWKV_HEADS, RWKV_HEAD_DIM
    f32 = jnp.float32
    zero = jnp.zeros_like(h[:, :1])
    h_prev = jnp.concatenate([zero, h[:, :-1]], axis=1)
    h_next = jnp.concatenate([h[:, 1:], zero], axis=1)
    hh = 0.5 * (h_prev + h_next) - h
    xr, xw, xk, xv, xa, xg = [h + hh * mu[i] for i in range(6)]
    r = (xr @ w_r).reshape(B, T, H, N)
    k = (xk @ w_k).reshape(B, T, H, N)
    v = (xv @ w_v).reshape(B, T, H, N)
    g = jax.nn.sigmoid(xg @ g1) @ g2
    w_pre = w0[:, None, None, :] + jnp.einsum('zbtr,zrd->zbtd', jnp.tanh(jnp.einsum('btd,zdr->zbtr', xw, w1)), w2)
    w_pre = w_pre.astype(f32)
    decay = jnp.exp(-jnp.exp(-jax.nn.softplus(-w_pre) - 0.5)).reshape(2, B, T, H, N)
    a_pre = a0[:, None, None, :] + jnp.einsum('zbtr,zrd->zbtd', jnp.einsum('btd,zdr->zbtr', xa, a1), a2)
    a_rate = jax.nn.sigmoid(a_pre.astype(f32)).reshape(2, B, T, H, N)
    kf = k.astype(f32)
    kk = kf * k_k.reshape(H, N).astype(f32)
    kk = kk / jnp.maximum(jnp.sqrt(jnp.sum(jnp.square(kk), axis=-1, keepdims=True)), 1e-12)
    k_dir = kf[None] * (1.0 + (a_rate - 1.0) * k_a.reshape(H, N).astype(f32))
    y_f = wkv7_scan(r, decay[0], k_dir[0], v, -kk, kk * a_rate[0], reverse=False)
    y_b = wkv7_scan(r, decay[1], k_dir[1], v, -kk, kk * a_rate[1], reverse=True)
    y = layer_norm(y_f + y_b, ln_g.reshape(H, N), ln_b.reshape(H, N), GN_EPS)
    bonus = jnp.sum(r.astype(f32)[None] * k_dir * r_k.astype(f32), axis=(0, 4))[..., None] * v.astype(f32)
    out = (y + bonus).reshape(B, T, D).astype(h.dtype) * g
    return out @ w_o


def cross_attention(h, m, w_q, w_kv, w_o):
    B, T, D = h.shape
    M = m.shape[1]
    q = (h @ w_q).reshape(B, T, XATTN_HEADS, XATTN_HEAD_DIM)
    kv = (m @ w_kv).reshape(B, M, 2, XATTN_HEADS, XATTN_HEAD_DIM)
    k, v = kv[:, :, 0], kv[:, :, 1]
    s = jnp.einsum('bqhd,bkhd->bhqk', q, k).astype(jnp.float32) * (XATTN_HEAD_DIM ** -0.5)
    p = jax.nn.softmax(s, axis=-1).astype(v.dtype)
    o = jnp.einsum('bhqk,bkhd->bqhd', p, v).reshape(B, T, D)
    return o @ w_o


def squared_relu_mlp(h, w_up, w_down):
    return jnp.square(jax.nn.relu(h @ w_up)) @ w_down


def setup_inputs(seed: int = 0) -> dict:
    key = jax.random.key(seed)
    ks = iter(jax.random.split(key, 64))
    D = D_MODEL

    def nrm(shape, scale):
        return scale * jax.random.normal(next(ks), shape, jnp.float32)

    def gain(shape):
        return 1.0 + nrm(shape, 0.02)

    def unif(shape, lo, hi):
        return jax.random.uniform(next(ks), shape, jnp.float32, lo, hi)

    return {
        'x': nrm((BATCH, SEQ, D), 1.0),
        'mem': nrm((BATCH, N_MEM, D), 1.0),
        'rel_bias_table': nrm((REL_BUCKETS, DIFF_HEADS), 0.5),
        'norm_mix': gain((DEPTH, D)),
        'norm_xattn': gain((DEPTH, D)),
        'norm_mem': gain((DEPTH, D)),
        'norm_ffn': gain((DEPTH, D)),
        'norm_final': gain((D,)),
        'ab_w_in': nrm((N_EVEN, D, IN_COLS), D ** -0.5),
        'ab_w_out': nrm((N_EVEN, CONV_CH + DIFF_WIDTH, D), (CONV_CH + DIFF_WIDTH) ** -0.5),
        'conv_w': nrm((N_EVEN, CONV_WIDTH, CONV_CH), CONV_WIDTH ** -0.5),
        'conv_b': nrm((N_EVEN, CONV_CH), 0.02),
        'conv_ln_g': gain((N_EVEN, CONV_CH)),
        'conv_ln_b': nrm((N_EVEN, CONV_CH), 0.02),
        'diff_lq1': nrm((N_EVEN, DIFF_HEAD_DIM), 0.1),
        'diff_lk1': nrm((N_EVEN, DIFF_HEAD_DIM), 0.1),
        'diff_lq2': nrm((N_EVEN, DIFF_HEAD_DIM), 0.1),
        'diff_lk2': nrm((N_EVEN, DIFF_HEAD_DIM), 0.1),
        'diff_subln_g': gain((N_EVEN, DIFF_V_DIM)),
        'rwkv_mu': unif((N_ODD, 6, D), 0.0, 1.0),
        'rwkv_w_r': nrm((N_ODD, D, D), D ** -0.5),
        'rwkv_w_k': nrm((N_ODD, D, D), D ** -0.5),
        'rwkv_w_v': nrm((N_ODD, D, D), D ** -0.5),
        'rwkv_w_o': nrm((N_ODD, D, D), D ** -0.5),
        'rwkv_w0': unif((N_ODD, 2, D), -4.0, 1.0),
        'rwkv_w1': nrm((N_ODD, 2, D, DECAY_LORA), D ** -0.5),
        'rwkv_w2': nrm((N_ODD, 2, DECAY_LORA, D), 0.1 * DECAY_LORA ** -0.5),
        'rwkv_a0': nrm((N_ODD, 2, D), 0.1),
        'rwkv_a1': nrm((N_ODD, 2, D, ICLR_LORA), D ** -0.5),
        'rwkv_a2': nrm((N_ODD, 2, ICLR_LORA, D), 0.5 * ICLR_LORA ** -0.5),
        'rwkv_g1': nrm((N_ODD, D, GATE_LORA), D ** -0.5),
        'rwkv_g2': nrm((N_ODD, GATE_LORA, D), GATE_LORA ** -0.5),
        'rwkv_k_k': 0.85 + nrm((N_ODD, D), 0.02),
        'rwkv_k_a': gain((N_ODD, D)),
        'rwkv_r_k': nrm((N_ODD, RWKV_HEADS, RWKV_HEAD_DIM), 0.1),
        'rwkv_ln_g': gain((N_ODD, D)),
        'rwkv_ln_b': nrm((N_ODD, D), 0.02),
        'xattn_w_q': nrm((DEPTH, D, D), D ** -0.5),
        'xattn_w_kv': nrm((DEPTH, D, 2 * D), D ** -0.5),
        'xattn_w_o': nrm((DEPTH, D, D), D ** -0.5),
        'ffn_w_up': nrm((DEPTH, D, FFN_HIDDEN), D ** -0.5),
        'ffn_w_down': nrm((DEPTH, FFN_HIDDEN, D), FFN_HIDDEN ** -0.5),
    }


def reference(x, mem, rel_bias_table, norm_mix, norm_xattn, norm_mem, norm_ffn, norm_final,
              ab_w_in, ab_w_out, conv_w, conv_b, conv_ln_g, conv_ln_b,
              diff_lq1, diff_lk1, diff_lq2, diff_lk2, diff_subln_g,
              rwkv_mu, rwkv_w_r, rwkv_w_k, rwkv_w_v, rwkv_w_o, rwkv_w0, rwkv_w1, rwkv_w2,
              rwkv_a0, rwkv_a1, rwkv_a2, rwkv_g1, rwkv_g2, rwkv_k_k, rwkv_k_a, rwkv_r_k,
              rwkv_ln_g, rwkv_ln_b, xattn_w_q, xattn_w_kv, xattn_w_o, ffn_w_up, ffn_w_down):
    h = x
    for i in range(DEPTH):
        hn = rms_norm(h, norm_mix[i])
        j = i // 2
        if i % 2 == 0:
            h = h + conv_diff_mixer(hn, ab_w_in[j], ab_w_out[j], conv_w[j], conv_b[j], conv_ln_g[j], conv_ln_b[j],
                                    diff_lq1[j], diff_lk1[j], diff_lq2[j], diff_lk2[j], diff_subln_g[j],
                                    rel_bias_table, i)
        else:
            h = h + rwkv7_mixer(hn, rwkv_mu[j], rwkv_w_r[j], rwkv_w_k[j], rwkv_w_v[j], rwkv_w_o[j],
                                rwkv_w0[j], rwkv_w1[j], rwkv_w2[j], rwkv_a0[j], rwkv_a1[j], rwkv_a2[j],
                                rwkv_g1[j], rwkv_g2[j], rwkv_k_k[j], rwkv_k_a[j], rwkv_r_k[j],
                                rwkv_ln_g[j], rwkv_ln_b[j])
        h = h + cross_attention(rms_norm(h, norm_xattn[i]), rms_norm(mem, norm_mem[i]),
                                xattn_w_q[i], xattn_w_kv[i], xattn_w_o[i])
        h = h + squared_relu_mlp(rms_norm(h, norm_ffn[i]), ffn_w_up[i], ffn_w_down[i])
    return rms_norm(h, norm_final)
```

```cpp
#include <hip/hip_runtime.h>
#include <hip/hip_cooperative_groups.h>
#include <cstdio>
#include <cstdint>
namespace cg = cooperative_groups;

#ifndef MK_SINGLE
#define MK_SINGLE 1
#endif

#define LAS __attribute__((address_space(3)))
#define DI __device__ __forceinline__
typedef unsigned short bf16;
typedef short bf16x8 __attribute__((ext_vector_type(8)));
typedef short s16x4 __attribute__((ext_vector_type(4)));
typedef float f32x2 __attribute__((ext_vector_type(2)));
typedef float f32x4 __attribute__((ext_vector_type(4)));
typedef float f32x16 __attribute__((ext_vector_type(16)));
typedef unsigned u32x2 __attribute__((ext_vector_type(2)));
typedef unsigned u32x4 __attribute__((ext_vector_type(4)));

constexpr int D = 1024, NB = 16, T = 2048, M = NB * T, NMEM = 256, MMEM = NB * NMEM;
constexpr int FF = 4096;
constexpr float EPS = 1e-6f;
constexpr float LOG2E = 1.4426950408889634f;

constexpr size_t MiB = 1u << 20;
constexpr size_t WS_BAR = 0;
constexpr size_t WS_RS = 64 * 1024;
constexpr size_t WS_RSMEM = WS_RS + M * 4;
constexpr size_t WS_BIAS = WS_RSMEM + MMEM * 4;
constexpr size_t WS_LAM = WS_BIAS + 4 * 4096 * 4;
constexpr size_t WS_WIN = 1 * MiB;
constexpr size_t WS_WOUT = WS_WIN + 5 * MiB;
constexpr size_t WS_WQN = WS_WOUT + 2 * MiB;
constexpr size_t WS_WKV = WS_WQN + 4 * MiB;
constexpr size_t WS_WXO = WS_WKV + 8 * MiB;
constexpr size_t WS_WUP = WS_WXO + 4 * MiB;
constexpr size_t WS_WDN = WS_WUP + 16 * MiB;
constexpr size_t WS_WBIG = WS_WDN + 16 * MiB;
constexpr size_t WS_W2T = WS_WBIG + 14 * MiB;
constexpr size_t WS_G2T = WS_W2T + 512 * 1024;
constexpr size_t WS_WRO = WS_G2T + 512 * 1024;
constexpr size_t WS_WEND = WS_WRO + 2 * MiB;
static_assert(WS_WEND == 73 * MiB, "weight map");
constexpr size_t WS_SA = 73 * MiB;
constexpr size_t WS_SB = 137 * MiB;
constexpr size_t WS_GLU = 201 * MiB;
constexpr size_t WS_VT = 233 * MiB;
constexpr size_t WS_MIX = 265 * MiB;
constexpr size_t WS_G0 = 329 * MiB;
constexpr size_t WS_VW0 = 361 * MiB;
constexpr size_t WS_MEMB = 393 * MiB;
constexpr size_t WS_KV = 401 * MiB;
constexpr size_t WS_G1 = 433 * MiB;
constexpr size_t WS_VW1 = 465 * MiB;
static_assert(WS_G1 - WS_G0 == 104 * MiB && WS_VW0 - WS_G0 == 32 * MiB && WS_VW1 - WS_G1 == 32 * MiB, "G / VW spacing used by EpiPre");
constexpr size_t WS_BONUS = 497 * MiB;
constexpr size_t WS_HID = 137 * MiB;
constexpr size_t WS_A1 = 73 * MiB;
constexpr size_t WS_R = 201 * MiB, WS_K = 265 * MiB, WS_V = 329 * MiB;
static_assert(WS_K - WS_R == 64 * MiB && WS_V - WS_K == 64 * MiB, "r, k, v spacing used by EpiRwkv");
constexpr size_t WS_HD1 = 393 * MiB;
constexpr size_t WS_HD2 = 409 * MiB;
constexpr size_t WS_YF = 73 * MiB, WS_YB = 137 * MiB;
constexpr size_t WS_GATE = 265 * MiB;
constexpr size_t WS_COMB = 201 * MiB;
constexpr size_t WS_NEED = 512 * MiB;

constexpr int LDS_X = 131072;
constexpr int LDS_MISC = 131072 + 8192;
constexpr int LDS_BYTES = 147456;

DI unsigned f2bf(float f) { unsigned u = __builtin_bit_cast(unsigned, f); return (u + 0x7fffu + ((u >> 16) & 1u)) >> 16; }
typedef __bf16 bf16x2v __attribute__((ext_vector_type(2)));
DI unsigned pk2(float lo, float hi) { const f32x2 v = {lo, hi}; return __builtin_bit_cast(unsigned, __builtin_convertvector(v, bf16x2v)); }
DI float bf2f(unsigned short b) { return __builtin_bit_cast(float, ((unsigned)b) << 16); }
DI float bflo(unsigned w) { return __builtin_bit_cast(float, w << 16); }
DI float bfhi(unsigned w) { return __builtin_bit_cast(float, w & 0xffff0000u); }
template <int MASK> DI float swz_xor(float v) { return __builtin_bit_cast(float, __builtin_amdgcn_ds_swizzle(__builtin_bit_cast(int, v), (MASK << 10) | 0x1f)); }
DI float half_sum(float v) { const int x = __builtin_bit_cast(int, v); const auto r = __builtin_amdgcn_permlane32_swap(x, x, false, false); return __builtin_bit_cast(float, (int)r[0]) + __builtin_bit_cast(float, (int)r[1]); }
DI float half_max(float v) { const int x = __builtin_bit_cast(int, v); const auto r = __builtin_amdgcn_permlane32_swap(x, x, false, false); return fmaxf(__builtin_bit_cast(float, (int)r[0]), __builtin_bit_cast(float, (int)r[1])); }
DI float wave_sum(float v) {
    v += swz_xor<1>(v); v += swz_xor<2>(v); v += swz_xor<4>(v); v += swz_xor<8>(v); v += swz_xor<16>(v); v = half_sum(v);
    return v;
}
DI int opaque(int x) { asm volatile("" : "+v"(x)); return x; }
template <class Tp> DI Tp* opq_ptr(Tp* p) { asm volatile("" : "+s"(p)); return p; }
DI int opq(int x) { asm volatile("" : "+s"(x)); return x; }
DI float fexp2(float x) { return __builtin_amdgcn_exp2f(x); }
DI float frcp(float x) { return __builtin_amdgcn_rcpf(x); }
DI float sigmoidf_(float x) { return frcp(1.0f + fexp2(-x * LOG2E)); }
DI float tanhf_(float x) { float e = fexp2(-2.0f * LOG2E * fabsf(x)); float t = (1.0f - e) * frcp(1.0f + e); return x < 0.f ? -t : t; }

namespace pg8 {
constexpr int BM = 256, BK = 64, HALF = 128, HTB = HALF * BK * 2, STAGE_BYTES = 8 * HTB, NXCD = 8, WGM = 8;
DI int lds_byte(int r, int c) { const int st = (r >> 4) * 2 + (c >> 5), rr = r & 15, cc = c & 31, ob = rr * 64 + cc * 2; return st * 1024 + (ob ^ (((ob >> 9) & 1) << 5)); }
DI void stage_rc(int b, int& R, int& C) { const int st = b / 1024, sb = b % 1024, swz = sb ^ (((sb >> 9) & 1) << 5); R = (st >> 1) * 16 + swz / 64; C = (st & 1) * 32 + (swz % 64) / 2; }
DI int perm32(int rho) { const int n = rho >> 4, i = rho & 15; return 8 * (i >> 2) + 4 * n + (i & 3); }

struct Unit { int pm, pn, z; const char* pa; const char* pb; };

DI bool tile_order(long L, int nM, int nN, int& pm, int& pn) {
    const int nwg = nM * nN; if (L >= nwg) return false;
    int wgid = (int)L; { const int q = nwg / NXCD, r = nwg % NXCD, xcd = wgid % NXCD, off = wgid / NXCD; wgid = (xcd < r ? xcd * (q + 1) : r * (q + 1) + (xcd - r) * q) + off; }
    const int nig = WGM * nN, gid = wgid / nig, fm = gid * WGM, gsz = (nM - fm) < WGM ? (nM - fm) : WGM;
    pm = fm + ((wgid % nig) % gsz); pn = (wgid % nig) / gsz; return true;
}
struct PlainSched {
    const bf16* A; const bf16* Bt; int lda, ldb, nM, nN, G, c, bshift; size_t bstride;
    DI bool next(int i, Unit& u) const {
        if (!tile_order((long)i * G + c, nM, nN, u.pm, u.pn)) return false;
        u.z = u.pm >> bshift;
        u.pa = (const char*)(A + (size_t)u.pm * 256 * lda);
        u.pb = (const char*)(Bt + (size_t)u.z * bstride + (size_t)u.pn * 256 * ldb);
        return true;
    }
};

DI unsigned cvt_pk_bf16(float lo, float hi) { return pk2(lo, hi); }

template <class Epi, class Sched>
DI void gemm_phase(LAS unsigned char* lds, const int K, const int lda, const int ldb, const Sched& S, const Epi& E) {
    const int tid = opaque(threadIdx.x), wid = __builtin_amdgcn_readfirstlane(tid >> 6), lane = tid & 63, wr = wid >> 2, wc = wid & 3, fr = lane & 15, fq = lane >> 4;
    const int nt = K / BK;
    unsigned voffA[2], voffB[2];
#pragma unroll
    for (int i = 0; i < 2; ++i) { int R, C; stage_rc(tid * 16 + i * 8192, R, C); const int Rb = Epi::PERM ? ((R & ~31) + perm32(R & 31)) : R;
        voffA[i] = (unsigned)(R * lda + C) * 2u; voffB[i] = (unsigned)(Rb * ldb + C) * 2u; }
    const size_t kstep = (size_t)(BK * 2);
    const size_t hstepA = (size_t)HALF * lda * 2, hstepB = (size_t)HALF * ldb * 2;
    const unsigned ldsw = (unsigned)wid * 1024u;
    const int aoff = lds_byte(wr * 64 + fr, fq * 8), boff = lds_byte(wc * 32 + fr, fq * 8);
#define PG8_SA(b, h) (((b) * 2 + (h)) * HTB)
#define PG8_SB(b, h) ((4 + (b) * 2 + (h)) * HTB)
#define PG8_STAGE(bufoff, gbase, voff) do { _Pragma("unroll") for (int _i = 0; _i < 2; ++_i) \
        __builtin_amdgcn_global_load_lds((const unsigned*)((const char*)(gbase) + (voff)[_i]), (LAS unsigned*)(lds + (bufoff) + ldsw + _i * 8192), 16, 0, 0); } while (0)
#define PG8_LDA(dst, b, h) do { _Pragma("unroll") for (int m = 0; m < 4; ++m) _Pragma("unroll") for (int k = 0; k < 2; ++k) dst[m][k] = *(const LAS bf16x8*)(lds + PG8_SA(b, h) + aoff + m * 2048 + k * 1024); } while (0)
#define PG8_LDB(dst, b, h) do { _Pragma("unroll") for (int n = 0; n < 2; ++n) _Pragma("unroll") for (int k = 0; k < 2; ++k) dst[n][k] = *(const LAS bf16x8*)(lds + PG8_SB(b, h) + boff + n * 2048 + k * 1024); } while (0)
#define PG8_MMA(ai, bj, At, Bt) do { __builtin_amdgcn_s_setprio(1); _Pragma("unroll") for (int m = 0; m < 4; ++m) _Pragma("unroll") for (int n = 0; n < 2; ++n) _Pragma("unroll") for (int k = 0; k < 2; ++k) \
        acc[ai][bj][m][n] = __builtin_amdgcn_mfma_f32_16x16x32_bf16(Bt[n][k], At[m][k], acc[ai][bj][m][n], 0, 0, 0); __builtin_amdgcn_s_setprio(0); } while (0)
#define PG8_WAIT_V(n) asm volatile("s_waitcnt vmcnt(" #n ")" ::: "memory")
#define PG8_WAIT_L(n) asm volatile("s_waitcnt lgkmcnt(" #n ")" ::: "memory")
#define PG8_BAR __builtin_amdgcn_s_barrier()
#define PG8_SCHED __builtin_amdgcn_sched_barrier(0)
    Unit cur, nxt; int ui = 0;
    if (!S.next(0, cur)) return;
    f32x4 acc[2][2][4][2];
#pragma unroll
    for (int a = 0; a < 2; ++a)
#pragma unroll
        for (int b = 0; b < 2; ++b)
#pragma unroll
            for (int m = 0; m < 4; ++m)
#pragma unroll
                for (int n = 0; n < 2; ++n) acc[a][b][m][n] = (f32x4){0.f, 0.f, 0.f, 0.f};
    bf16x8 At[4][2], B0[2][2], B1[2][2];
    const char* cA = cur.pa; const char* cB = cur.pb;
    PG8_STAGE(PG8_SB(0, 0), cB, voffB); PG8_STAGE(PG8_SB(0, 1), cB + hstepB, voffB); PG8_STAGE(PG8_SA(0, 0), cA, voffA); PG8_STAGE(PG8_SA(0, 1), cA + hstepA, voffA);
    if (wr == 1) PG8_BAR;
    PG8_WAIT_V(2); PG8_BAR;
    PG8_STAGE(PG8_SB(1, 0), cB + kstep, voffB); PG8_STAGE(PG8_SA(1, 0), cA + kstep, voffA); PG8_STAGE(PG8_SB(1, 1), cB + hstepB + kstep, voffB);
    PG8_WAIT_V(6); PG8_BAR;
    for (;;) {
        const bool has_next = S.next(ui + 1, nxt);
        const char* nA = has_next ? nxt.pa : cA; const char* nB = has_next ? nxt.pb : cB;
#pragma unroll 1
        for (int t = 0; t < nt; t += 2) {
            const bool last = (t == nt - 2);
            const char* a1 = cA + (size_t)(t + 1) * kstep;
            const char* a2 = last ? nA : cA + (size_t)(t + 2) * kstep; const char* b2 = last ? nB : cB + (size_t)(t + 2) * kstep;
            const char* a3 = a2 + kstep; const char* b3 = b2 + kstep;
            PG8_LDB(B0, 0, 0); PG8_LDB(B1, 0, 1); PG8_SCHED; PG8_LDA(At, 0, 0); PG8_STAGE(PG8_SA(1, 1), a1 + hstepA, voffA);
            PG8_WAIT_V(8); PG8_WAIT_L(0); PG8_BAR; PG8_MMA(0, 0, At, B0); PG8_MMA(0, 1, At, B1); PG8_BAR; PG8_SCHED;
            PG8_LDA(At, 0, 1); PG8_STAGE(PG8_SB(0, 0), b2, voffB); PG8_STAGE(PG8_SB(0, 1), b2 + hstepB, voffB); PG8_STAGE(PG8_SA(0, 0), a2, voffA);
            PG8_WAIT_V(8); PG8_WAIT_L(0); PG8_BAR; PG8_MMA(1, 0, At, B0); PG8_MMA(1, 1, At, B1); PG8_BAR; PG8_SCHED;
            PG8_LDB(B0, 1, 0); PG8_LDB(B1, 1, 1); PG8_SCHED; PG8_LDA(At, 1, 0); PG8_STAGE(PG8_SA(0, 1), a2 + hstepA, voffA);
            PG8_WAIT_V(8); PG8_WAIT_L(0); PG8_BAR; PG8_MMA(0, 0, At, B0); PG8_MMA(0, 1, At, B1); PG8_BAR; PG8_SCHED;
            PG8_LDA(At, 1, 1); PG8_STAGE(PG8_SB(1, 0), b3, voffB); PG8_STAGE(PG8_SB(1, 1), b3 + hstepB, voffB); PG8_STAGE(PG8_SA(1, 0), a3, voffA);
            PG8_WAIT_V(8); PG8_WAIT_L(0); PG8_BAR; PG8_MMA(1, 0, At, B0); PG8_MMA(1, 1, At, B1); PG8_BAR; PG8_SCHED;
        }
        if (wr == 0) PG8_BAR;
        E(acc, cur, wr, wc, fr, fq, lds);
        if (!has_next) break;
#pragma unroll
        for (int a = 0; a < 2; ++a)
#pragma unroll
            for (int b = 0; b < 2; ++b)
#pragma unroll
                for (int m = 0; m < 4; ++m)
#pragma unroll
                    for (int n = 0; n < 2; ++n) acc[a][b][m][n] = (f32x4){0.f, 0.f, 0.f, 0.f};
        cur = nxt; cA = nA; cB = nB; ++ui;
        if (wr == 1) PG8_BAR;
    }
    PG8_WAIT_V(0);
    PG8_BAR;
#undef PG8_SA
#undef PG8_SB
#undef PG8_STAGE
#undef PG8_LDA
#undef PG8_LDB
#undef PG8_MMA
#undef PG8_WAIT_V
#undef PG8_WAIT_L
#undef PG8_BAR
#undef PG8_SCHED
}
}
using pg8::Unit;

DI void store8(bf16* p, const f32x4 v0, const f32x4 v1) {
    u32x4 w; w.x = pk2(v0[0], v0[1]); w.y = pk2(v0[2], v0[3]); w.z = pk2(v1[0], v1[1]); w.w = pk2(v1[2], v1[3]);
    *(u32x4*)p = w;
}
#define EPI_ARGS f32x4 (&acc)[2][2][4][2], const Unit& u, int wr, int wc, int fr, int fq, LAS unsigned char* lds

template <int ACT> struct EpiRowScale {
    static constexpr bool PERM = true;
    bf16* O; int ldc; const float* rs;
    DI void operator()(EPI_ARGS) const {
        const int row0 = u.pm * 256 + wr * 64 + fr, col0 = u.pn * 256 + wc * 32 + 8 * fq;
#pragma unroll
        for (int ai = 0; ai < 2; ++ai)
#pragma unroll
            for (int m = 0; m < 4; ++m) {
                const int row = row0 + ai * 128 + m * 16; const float s = rs ? rs[row] : 1.0f;
                bf16* rowp = O + (size_t)row * ldc + col0;
#pragma unroll
                for (int bj = 0; bj < 2; ++bj) { f32x4 v0 = acc[ai][bj][m][0] * s, v1 = acc[ai][bj][m][1] * s;
                    if (ACT == 2) {
#pragma unroll
                        for (int j = 0; j < 4; ++j) { float a = fmaxf(v0[j], 0.f), b = fmaxf(v1[j], 0.f); v0[j] = a * a; v1[j] = b * b; } }
                    store8(rowp + bj * 128, v0, v1); }
            }
    }
};
struct EpiInProj {
    static constexpr bool PERM = true;
    bf16* GLU; bf16* QK; const float* rs;
    DI void operator()(EPI_ARGS) const {
        const int row0 = u.pm * 256 + wr * 64 + fr;
        if (u.pn < 4) {
            const int col0 = u.pn * 128 + wc * 32 + 8 * fq;
#pragma unroll
            for (int ai = 0; ai < 2; ++ai)
#pragma unroll
                for (int m = 0; m < 4; ++m) {
                    const int row = row0 + ai * 128 + m * 16; const float s = rs[row];
                    f32x4 o0, o1;
#pragma unroll
                    for (int j = 0; j < 4; ++j) { o0[j] = acc[ai][0][m][0][j] * s * sigmoidf_(acc[ai][1][m][0][j] * s); o1[j] = acc[ai][0][m][1][j] * s * sigmoidf_(acc[ai][1][m][1][j] * s); }
                    store8(GLU + (size_t)row * 512 + col0, o0, o1);
                }
        } else {
            const int col0 = (u.pn - 4) * 256 + wc * 32 + 8 * fq;
#pragma unroll
            for (int ai = 0; ai < 2; ++ai)
#pragma unroll
                for (int m = 0; m < 4; ++m) {
                    const int row = row0 + ai * 128 + m * 16; const float s = rs[row];
#pragma unroll
                    for (int bj = 0; bj < 2; ++bj) store8(QK + (size_t)row * 1024 + col0 + bj * 128, acc[ai][bj][m][0] * s, acc[ai][bj][m][1] * s);
                }
        }
    }
};
struct EpiVT {
    static constexpr bool PERM = true;
    bf16* O; const float* cs;
    DI void operator()(EPI_ARGS) const {
        const int row0 = u.pm * 256 + wr * 64 + fr, col0 = u.pn * 256 + wc * 32 + 8 * fq;
        f32x4 c[2][2];
#pragma unroll
        for (int bj = 0; bj < 2; ++bj) { c[bj][0] = *(const f32x4*)(cs + col0 + bj * 128); c[bj][1] = *(const f32x4*)(cs + col0 + bj * 128 + 4); }
#pragma unroll
        for (int ai = 0; ai < 2; ++ai)
#pragma unroll
            for (int m = 0; m < 4; ++m) {
                const int row = row0 + ai * 128 + m * 16;
#pragma unroll
                for (int bj = 0; bj < 2; ++bj) store8(O + (size_t)row * M + col0 + bj * 128, acc[ai][bj][m][0] * c[bj][0], acc[ai][bj][m][1] * c[bj][1]);
            }
    }
};
struct EpiPre {
    static constexpr bool PERM = true;
    bf16* base0;
    DI void operator()(EPI_ARGS) const {
        bf16* O = base0 + (size_t)((u.z >> 30) & 1) * (52u << 20) + (size_t)(u.z & 0x3fffffff);
        const int row0 = wr * 64 + fr, col0 = wc * 32 + 8 * fq;
#pragma unroll
        for (int ai = 0; ai < 2; ++ai)
#pragma unroll
            for (int m = 0; m < 4; ++m) {
                const int row = row0 + ai * 128 + m * 16;
#pragma unroll
                for (int bj = 0; bj < 2; ++bj) store8(O + (size_t)row * 1024 + col0 + bj * 128, acc[ai][bj][m][0], acc[ai][bj][m][1]);
            }
    }
};
struct EpiResid {
    static constexpr bool PERM = false;
    const float* resid; float* out;
    DI void operator()(EPI_ARGS) const {
        const int row0 = u.pm * 256 + wr * 64 + fr, col0 = u.pn * 256 + wc * 32 + 4 * fq;
#pragma unroll
        for (int ai = 0; ai < 2; ++ai)
#pragma unroll
            for (int m = 0; m < 4; ++m) {
                const size_t off = (size_t)(row0 + ai * 128 + m * 16) * D + col0;
#pragma unroll
                for (int bj = 0; bj < 2; ++bj)
#pragma unroll
                    for (int n = 0; n < 2; ++n) { const f32x4 r = *(const f32x4*)(resid + off + bj * 128 + n * 16); *(f32x4*)(out + off + bj * 128 + n * 16) = r + acc[ai][bj][m][n]; }
            }
    }
};
struct EpiSoftmax {
    static constexpr bool PERM = true;
    bf16* P; const float* rs;
    DI void operator()(EPI_ARGS) const {
        LAS f32x2* X = (LAS f32x2*)(lds + LDS_X);
        const int row0 = u.pm * 256, col0 = u.pn * 256 + wc * 32 + 8 * fq;
        float mw[2][4];
#pragma unroll
        for (int ai = 0; ai < 2; ++ai)
#pragma unroll
            for (int m = 0; m < 4; ++m) {
                const int rl = ai * 128 + wr * 64 + m * 16 + fr; const float s = rs[row0 + rl] * LOG2E;
                float mx = -3.0e38f;
#pragma unroll
                for (int bj = 0; bj < 2; ++bj)
#pragma unroll
                    for (int n = 0; n < 2; ++n) { acc[ai][bj][m][n] = acc[ai][bj][m][n] * s;
#pragma unroll
                        for (int j = 0; j < 4; ++j) mx = fmaxf(mx, acc[ai][bj][m][n][j]); }
                mx = fmaxf(mx, swz_xor<16>(mx)); mx = half_max(mx);
                float sum = 0.f;
#pragma unroll
                for (int bj = 0; bj < 2; ++bj)
#pragma unroll
                    for (int n = 0; n < 2; ++n)
#pragma unroll
                        for (int j = 0; j < 4; ++j) { const float p = fexp2(acc[ai][bj][m][n][j] - mx); acc[ai][bj][m][n][j] = p; sum += p; }
                sum += swz_xor<16>(sum); sum = half_sum(sum);
                mw[ai][m] = mx;
                if (fq == 0) X[rl * 4 + wc] = (f32x2){mx, sum};
            }
        asm volatile("s_waitcnt lgkmcnt(0)" ::: "memory"); __builtin_amdgcn_s_barrier(); asm volatile("" ::: "memory");
#pragma unroll
        for (int ai = 0; ai < 2; ++ai)
#pragma unroll
            for (int m = 0; m < 4; ++m) {
                const int rl = ai * 128 + wr * 64 + m * 16 + fr;
                const f32x2 a = X[rl * 4 + 0], b = X[rl * 4 + 1], c = X[rl * 4 + 2], d = X[rl * 4 + 3];
                const float mt = fmaxf(fmaxf(a.x, b.x), fmaxf(c.x, d.x));
                const float lt = a.y * fexp2(a.x - mt) + b.y * fexp2(b.x - mt) + c.y * fexp2(c.x - mt) + d.y * fexp2(d.x - mt);
                const float f = fexp2(mw[ai][m] - mt) / lt;
                bf16* rowp = P + (size_t)(row0 + rl) * 1024 + col0;
#pragma unroll
                for (int bj = 0; bj < 2; ++bj) store8(rowp + bj * 128, acc[ai][bj][m][0] * f, acc[ai][bj][m][1] * f);
            }
        asm volatile("s_waitcnt lgkmcnt(0)" ::: "memory"); __builtin_amdgcn_s_barrier(); asm volatile("" ::: "memory");
    }
};
struct EpiRwkv {
    static constexpr bool PERM = true;
    bf16* R; bf16* Kk; bf16* V; bf16* HD1; bf16* HD2;
    DI void operator()(EPI_ARGS) const {
        const int row0 = u.pm * 256 + wr * 64 + fr; const int g = u.pn >> 2;
        bf16* O; int ldc, colt, mode0 = 0, mode1 = 0;
        if (u.pn < 12) { O = R + (size_t)g * (32u << 20); ldc = 1024; colt = (u.pn & 3) * 256; }
        else if (u.pn == 12) { O = HD1; ldc = 256; colt = 0; mode0 = 1; }
        else { O = HD2; ldc = 256; colt = 0; mode0 = 2; mode1 = 2; }
        const int col0 = colt + wc * 32 + 8 * fq;
#pragma unroll
        for (int ai = 0; ai < 2; ++ai)
#pragma unroll
            for (int m = 0; m < 4; ++m) {
                bf16* rowp = O + (size_t)(row0 + ai * 128 + m * 16) * ldc + col0;
#pragma unroll
                for (int bj = 0; bj < 2; ++bj) { f32x4 v0 = acc[ai][bj][m][0], v1 = acc[ai][bj][m][1]; const int md = bj ? mode1 : mode0;
                    if (md == 1) {
#pragma unroll
                        for (int j = 0; j < 4; ++j) { v0[j] = tanhf_(v0[j]); v1[j] = tanhf_(v1[j]); } }
                    else if (md == 2) {
#pragma unroll
                        for (int j = 0; j < 4; ++j) { v0[j] = sigmoidf_(v0[j]); v1[j] = sigmoidf_(v1[j]); } }
                    store8(rowp + bj * 128, v0, v1); }
            }
    }
};

enum InIdx { I_X = 0, I_MEM, I_REL, I_NMIX, I_NXATTN, I_NMEM, I_NFFN, I_NFINAL, I_WIN, I_WOUT, I_CONVW, I_CONVB, I_CLNG, I_CLNB, I_LQ1, I_LK1, I_LQ2, I_LK2, I_SUBLN,
             I_MU, I_WR, I_WK, I_WV, I_WO, I_W0, I_W1, I_W2, I_A0, I_A1, I_A2, I_G1, I_G2, I_KK, I_KA, I_RK, I_LNG, I_LNB, I_XQ, I_XKV, I_XO, I_UP, I_DN, N_IN };
struct Args { const float* in[N_IN]; float* out; unsigned char* ws; int ph_lo, ph_hi; };
static_assert(sizeof(Args) == (N_IN + 2) * 8 + 8, "Args has no padding");

struct Frame {
    LAS unsigned char* lds;
    int tid, lane, wave, gw, ngw;
    unsigned char* ws;
};

DI Frame fresh(const Frame& F0) {
    Frame F = F0; F.tid = opaque(threadIdx.x); F.lane = F.tid & 63; F.wave = __builtin_amdgcn_readfirstlane(F.tid >> 6); F.gw = opq(blockIdx.x) * 8 + F.wave; F.ngw = opq(gridDim.x) * 8; return F;
}
struct TJob { const float* W; int K, N; bf16* WT; int ldt, row_off, col_off, perm; const float* gain; };
DI void tr_item(const TJob& J, LAS float* scr, int item, int lane) {
    const int nblk = J.N / 32, kb = item / nblk, nb = item % nblk, k0 = 64 * kb, n0 = 32 * nb;
    float scale = 1.0f; int drow = J.row_off + n0;
    if (J.perm) {
        if (n0 < 512) drow = 256 * (n0 >> 7) + (n0 & 127);
        else if (n0 < 1024) drow = 256 * ((n0 - 512) >> 7) + 128 + ((n0 - 512) & 127);
        else drow = n0;
        if (n0 >= 1024 && n0 < 1536) scale = 0.125f;
    }
#pragma unroll 8
    for (int i = 0; i < 32; ++i) { const int kk = 2 * i + (lane >> 5); float v = J.W[(size_t)(k0 + kk) * J.N + n0 + (lane & 31)]; if (J.gain) v *= J.gain[k0 + kk]; scr[kk * 33 + (lane & 31)] = v * scale; }
    asm volatile("s_waitcnt lgkmcnt(0)" ::: "memory");
    const int c = lane & 7;
#pragma unroll
    for (int j = 0; j < 4; ++j) { const int n = (lane >> 3) + 8 * j; const LAS float* s = scr + (8 * c) * 33 + n;
        u32x4 o; o.x = pk2(s[0 * 33], s[1 * 33]); o.y = pk2(s[2 * 33], s[3 * 33]); o.z = pk2(s[4 * 33], s[5 * 33]); o.w = pk2(s[6 * 33], s[7 * 33]);
        *(u32x4*)(J.WT + (size_t)(drow + n) * J.ldt + J.col_off + k0 + 8 * c) = o; }
    asm volatile("s_waitcnt lgkmcnt(0)" ::: "memory");
}
constexpr int N_TJOBS = 31;
DI TJob get_tjob(int j, const Args& a, unsigned char* ws) {
    TJob J; J.perm = 0; J.gain = nullptr; J.row_off = 0; J.col_off = 0;
    if (j == 0) { J.W = a.in[opq(I_WIN)]; J.K = 1024; J.N = 2560; J.WT = (bf16*)(ws + WS_WIN); J.ldt = 1024; J.perm = 1; J.gain = a.in[opq(I_NMIX)]; }
    else if (j == 1) { J.W = a.in[opq(I_WOUT)]; J.K = 1024; J.N = 1024; J.WT = (bf16*)(ws + WS_WOUT); J.ldt = 1024; }
    else if (j < 4) { const int i = j - 2; J.W = a.in[opq(I_XKV)] + (size_t)i * 1024 * 2048; J.K = 1024; J.N = 2048; J.WT = (bf16*)(ws + WS_WKV) + (size_t)i * 2048 * 1024; J.ldt = 1024; J.gain = a.in[opq(I_NMEM)] + i * 1024; }
    else if (j < 6) { const int i = j - 4; J.W = a.in[opq(I_XO)] + (size_t)i * 1024 * 1024; J.K = 1024; J.N = 1024; J.WT = (bf16*)(ws + WS_WXO) + (size_t)i * 1024 * 1024; J.ldt = 1024; }
    else if (j < 8) { const int i = j - 6; J.W = a.in[opq(I_UP)] + (size_t)i * 1024 * 4096; J.K = 1024; J.N = 4096; J.WT = (bf16*)(ws + WS_WUP) + (size_t)i * 4096 * 1024; J.ldt = 1024; J.gain = a.in[opq(I_NFFN)] + i * 1024; }
    else if (j < 10) { const int i = j - 8; J.W = a.in[opq(I_DN)] + (size_t)i * 4096 * 1024; J.K = 4096; J.N = 1024; J.WT = (bf16*)(ws + WS_WDN) + (size_t)i * 1024 * 4096; J.ldt = 4096; }
    else if (j < 26) {
        const int q = j - 10, src = q >> 1, copy = q & 1; int mu = 0;
        J.K = 1024; J.WT = (bf16*)(ws + WS_WBIG); J.ldt = 2048; J.col_off = copy * 1024;
        if (src == 0) { J.W = a.in[opq(I_WR)]; J.N = 1024; J.row_off = 0; mu = 0; }
        else if (src == 1) { J.W = a.in[opq(I_WK)]; J.N = 1024; J.row_off = 1024; mu = 2; }
        else if (src == 2) { J.W = a.in[opq(I_WV)]; J.N = 1024; J.row_off = 2048; mu = 3; }
        else if (src == 3) { J.W = a.in[opq(I_W1)]; J.N = 64; J.row_off = 3072; mu = 1; }
        else if (src == 4) { J.W = a.in[opq(I_W1)] + 1024 * 64; J.N = 64; J.row_off = 3136; mu = 1; }
        else if (src == 5) { J.W = a.in[opq(I_A1)]; J.N = 64; J.row_off = 3200; mu = 4; }
        else if (src == 6) { J.W = a.in[opq(I_A1)] + 1024 * 64; J.N = 64; J.row_off = 3264; mu = 4; }
        else { J.W = a.in[opq(I_G1)]; J.N = 160; J.row_off = 3328; mu = 5; }
        if (copy) J.gain = a.in[opq(I_MU)] + mu * 1024;
    }
    else if (j < 30) { const int q = j - 26; J.W = (q < 2 ? a.in[opq(I_W2)] : a.in[opq(I_A2)]) + (size_t)(q & 1) * 64 * 1024; J.K = 64; J.N = 1024; J.WT = (bf16*)(ws + WS_W2T) + (size_t)q * 1024 * 64; J.ldt = 64; }
    else { J.W = a.in[opq(I_WO)]; J.K = 1024; J.N = 1024; J.WT = (bf16*)(ws + WS_WRO); J.ldt = 1024; }
    return J;
}
DI void row_to_bf16_rs(const float* xrow, bf16* orow, float* rs, int lane) {
    const f32x4* xr = (const f32x4*)xrow + lane;
    f32x4 v[4]; float s = 0.f;
#pragma unroll
    for (int j = 0; j < 4; ++j) { v[j] = xr[64 * j]; s += (v[j].x * v[j].x + v[j].y * v[j].y) + (v[j].z * v[j].z + v[j].w * v[j].w); }
    s = wave_sum(s);
    u32x2* o8 = (u32x2*)orow + lane;
#pragma unroll
    for (int j = 0; j < 4; ++j) { u32x2 w; w.x = pk2(v[j].x, v[j].y); w.y = pk2(v[j].z, v[j].w); o8[64 * j] = w; }
    if (lane == 0) *rs = 1.0f / sqrtf(s * (1.0f / D) + EPS);
}
DI int t5_bucket(int rel) {
    const int n = rel < 0 ? -rel : rel; int r = rel > 0 ? 16 : 0;
    if (n < 8) return r + n;
    int lg = 8; lg += (n >= 12); lg += (n >= 16); lg += (n >= 23); lg += (n >= 32); lg += (n >= 46); lg += (n >= 64); lg += (n >= 91);
    return r + lg;
}
DI void phase_prologue(const Frame& F0, const Args& a, unsigned char* ws) {
    const Frame F = fresh(F0);
    LAS float* scr = (LAS float*)(F.lds + F.wave * 16384);
    for (int j = 0; j < N_TJOBS; ++j) {
        const TJob J = get_tjob(j, a, ws); const int items = (J.K / 64) * (J.N / 32);
        for (int it = F.gw; it < items; it += F.ngw) tr_item(J, scr, it, F.lane);
    }
    const int gt = F.gw * 64 + F.lane, ngt = F.ngw * 64;
    for (int i = 0; i < 2; ++i) {
        const float* W = a.in[opq(I_XQ)] + (size_t)i * 1024 * 1024; const float* g = a.in[opq(I_NXATTN)] + i * 1024; bf16* O = (bf16*)(ws + WS_WQN) + (size_t)i * 1024 * 1024;
        for (int e = gt; e < 1024 * 1024 / 4; e += ngt) { const f32x4 v = ((const f32x4*)W)[e]; const float s = g[(e * 4) >> 10] * 0.0625f; u32x2 w; w.x = pk2(v.x * s, v.y * s); w.y = pk2(v.z * s, v.w * s); ((u32x2*)O)[e] = w; }
    }
    { const float* W = a.in[opq(I_G2)]; bf16* O = (bf16*)(ws + WS_G2T);
      for (int e = gt; e < 1024 * 256; e += ngt) { const int n = e >> 8, k = e & 255; O[e] = (bf16)(k < 160 ? f2bf(W[(size_t)k * 1024 + n]) : 0u); } }
    { u32x4* O = (u32x4*)((bf16*)(ws + WS_WBIG) + (size_t)3488 * 2048);
      for (int e = gt; e < 96 * 2048 * 2 / 16; e += ngt) O[e] = (u32x4){0u, 0u, 0u, 0u}; }
    for (int m = F.gw; m < M; m += F.ngw) row_to_bf16_rs(a.in[opq(I_X)] + (size_t)m * D, (bf16*)(ws + WS_SA) + (size_t)m * D, (float*)(ws + WS_RS) + m, F.lane);
    for (int m = F.gw; m < MMEM; m += F.ngw) row_to_bf16_rs(a.in[opq(I_MEM)] + (size_t)m * D, (bf16*)(ws + WS_MEMB) + (size_t)m * D, (float*)(ws + WS_RSMEM) + m, F.lane);
    { float* B = (float*)(ws + WS_BIAS); const float* tab = a.in[opq(I_REL)];
      for (int e = gt; e < 4 * 4096; e += ngt) { const int h = e >> 12, idx = e & 4095; const int rel = idx - 2047; B[e] = idx < 4095 ? tab[t5_bucket(rel) * 4 + h] * LOG2E : 0.f; } }
    if (F.gw == 0) {
        const float q1 = a.in[opq(I_LQ1)][F.lane] * a.in[opq(I_LK1)][F.lane], q2 = a.in[opq(I_LQ2)][F.lane] * a.in[opq(I_LK2)][F.lane];
        const float s1 = wave_sum(q1), s2 = wave_sum(q2);
        if (F.lane == 0) ((float*)(ws + WS_LAM))[0] = expf(s1) - expf(s2) + 0.2f;
    }
}

DI void phase_norm(const Frame& F0, const float* h, bf16* hb, float* rs) {
    const Frame F = fresh(F0);
    for (int m = F.gw; m < M; m += F.ngw) row_to_bf16_rs(h + (size_t)m * D, hb + (size_t)m * D, rs + m, F.lane);
}
DI void phase_final_norm(const Frame& F0, float* h, const float* g) {
    const Frame F = fresh(F0);
    f32x4 gv[4];
#pragma unroll
    for (int j = 0; j < 4; ++j) gv[j] = ((const f32x4*)g)[F.lane + 64 * j];
    for (int m = F.gw; m < M; m += F.ngw) {
        f32x4* xr = (f32x4*)(h + (size_t)m * D) + F.lane;
        f32x4 v[4]; float s = 0.f;
#pragma unroll
        for (int j = 0; j < 4; ++j) { v[j] = xr[64 * j]; s += (v[j].x * v[j].x + v[j].y * v[j].y) + (v[j].z * v[j].z + v[j].w * v[j].w); }
        const float r = 1.0f / sqrtf(wave_sum(s) * (1.0f / D) + EPS);
#pragma unroll
        for (int j = 0; j < 4; ++j) xr[64 * j] = v[j] * r * gv[j];
    }
}
DI void phase_rwkv_shift(const Frame& F0, const float* h, const float* g, bf16* A1) {
    const Frame F = fresh(F0);
    f32x4 gv[4];
#pragma unroll
    for (int j = 0; j < 4; ++j) gv[j] = ((const f32x4*)g)[F.lane + 64 * j];
    for (int ch = F.gw; ch < M / 16; ch += F.ngw) {
        const int m0 = ch * 16, t0 = m0 & (T - 1);
        f32x4 p2[4], p1[4], cu[4];
#pragma unroll
        for (int j = 0; j < 4; ++j) { p2[j] = (f32x4){0.f, 0.f, 0.f, 0.f}; p1[j] = p2[j]; cu[j] = p2[j]; }
        for (int i = -1; i <= 16; ++i) {
            const int t = t0 + i;
#pragma unroll
            for (int j = 0; j < 4; ++j) { p2[j] = p1[j]; p1[j] = cu[j]; }
            if (t >= 0 && t < T) {
                const f32x4* xr = (const f32x4*)(h + (size_t)(m0 + i) * D) + F.lane; float s = 0.f;
#pragma unroll
                for (int j = 0; j < 4; ++j) { cu[j] = xr[64 * j]; s += (cu[j].x * cu[j].x + cu[j].y * cu[j].y) + (cu[j].z * cu[j].z + cu[j].w * cu[j].w); }
                const float r = 1.0f / sqrtf(wave_sum(s) * (1.0f / D) + EPS);
#pragma unroll
                for (int j = 0; j < 4; ++j) cu[j] = cu[j] * r * gv[j];
            } else {
#pragma unroll
                for (int j = 0; j < 4; ++j) cu[j] = (f32x4){0.f, 0.f, 0.f, 0.f};
            }
            if (i >= 1) {
                u32x2* o = (u32x2*)(A1 + (size_t)(m0 + i - 1) * 2048) + F.lane;
#pragma unroll
                for (int j = 0; j < 4; ++j) { const f32x4 hh = (p2[j] + cu[j]) * 0.5f - p1[j];
                    u32x2 w; w.x = pk2(p1[j].x, p1[j].y); w.y = pk2(p1[j].z, p1[j].w); o[64 * j] = w;
                    u32x2 w2; w2.x = pk2(hh.x, hh.y); w2.y = pk2(hh.z, hh.w); o[256 + 64 * j] = w2; }
            }
        }
    }
}
DI void phase_rwkv_comb(const Frame& F0, const bf16* YF, const bf16* YB, const bf16* V, const bf16* GT, const float* BON, const float* lng, const float* lnb, bf16* O) {
    const Frame F = fresh(F0);
    const int hd = F.lane >> 2, c0 = F.lane * 16;
    float lg[16], lb[16];
#pragma unroll
    for (int j = 0; j < 16; ++j) { lg[j] = lng[c0 + j]; lb[j] = lnb[c0 + j]; }
    for (int m = F.gw; m < M; m += F.ngw) {
        const size_t off = (size_t)m * D + c0;
        u32x4 a[2], b[2], vv[2], gg[2];
#pragma unroll
        for (int q = 0; q < 2; ++q) { a[q] = ((const u32x4*)(YF + off))[q]; b[q] = ((const u32x4*)(YB + off))[q]; vv[q] = ((const u32x4*)(V + off))[q]; gg[q] = ((const u32x4*)(GT + off))[q]; }
        const float bon = BON[(size_t)m * 16 + hd] + BON[(size_t)(M + m) * 16 + hd];
        float y[16]; float s = 0.f;
#pragma unroll
        for (int q = 0; q < 2; ++q)
#pragma unroll
            for (int w = 0; w < 4; ++w) { y[q * 8 + 2 * w] = bflo(a[q][w]) + bflo(b[q][w]); y[q * 8 + 2 * w + 1] = bfhi(a[q][w]) + bfhi(b[q][w]); }
#pragma unroll
        for (int j = 0; j < 16; ++j) s += y[j];
        s += swz_xor<1>(s); s += swz_xor<2>(s);
        const float mean = s * (1.0f / 64.0f); float q2 = 0.f;
#pragma unroll
        for (int j = 0; j < 16; ++j) { y[j] -= mean; q2 += y[j] * y[j]; }
        q2 += swz_xor<1>(q2); q2 += swz_xor<2>(q2);
        const float rstd = 1.0f / sqrtf(q2 * (1.0f / 64.0f) + 64e-5f);
        u32x4 o[2];
#pragma unroll
        for (int q = 0; q < 2; ++q)
#pragma unroll
            for (int w = 0; w < 4; ++w) {
                const int j = q * 8 + 2 * w;
                const float r0 = (y[j] * rstd * lg[j] + lb[j] + bon * bflo(vv[q][w])) * bflo(gg[q][w]);
                const float r1 = (y[j + 1] * rstd * lg[j + 1] + lb[j + 1] + bon * bfhi(vv[q][w])) * bfhi(gg[q][w]);
                o[q][w] = pk2(r0, r1);
            }
        ((u32x4*)(O + off))[0] = o[0]; ((u32x4*)(O + off))[1] = o[1];
    }
}

constexpr int CV_ROWB = 1040, CV_IN_BYTES = 94 * CV_ROWB, CV_W_OFF = CV_IN_BYTES;
DI void conv_load_weights(const Frame& F, const float* cw) {
    LAS bf16* W = (LAS bf16*)(F.lds + CV_W_OFF);
    for (int e = F.tid; e < 31 * 512; e += 512) W[e] = (bf16)f2bf(cw[e]);
}
DI void conv_unit(const Frame& F0, int unit, const bf16* GLU, const float* cb, const float* lg, const float* lb, bf16* MIX) {
    const Frame F = fresh(F0);
    const int b = unit >> 5, t0 = (unit & 31) * 64;
    __syncthreads();
    for (int p = F.tid; p < 94 * 64; p += 512) {
        const int r = p >> 6, c = p & 63, t = t0 - 15 + r;
        u32x4 v = (u32x4){0u, 0u, 0u, 0u};
        if (t >= 0 && t < T) v = *(const u32x4*)(GLU + (size_t)(b * T + t) * 512 + c * 8);
        *(LAS u32x4*)(F.lds + r * CV_ROWB + c * 16) = v;
    }
    __syncthreads();
    const int tl = F.tid >> 3, chunk = F.tid & 7;
    float y[64];
#pragma unroll
    for (int i = 0; i < 8; ++i) {
        const int cg = chunk + 8 * i;
        float acc[8];
#pragma unroll
        for (int e = 0; e < 8; ++e) acc[e] = cb[cg * 8 + e];
#pragma unroll 1
        for (int j = 0; j < 31; ++j) {
            const u32x4 x = *(const LAS u32x4*)(F.lds + (tl + j) * CV_ROWB + cg * 16);
            const u32x4 w = *(const LAS u32x4*)(F.lds + CV_W_OFF + j * 1024 + cg * 16);
#pragma unroll
            for (int q = 0; q < 4; ++q) { acc[2 * q] += bflo(x[q]) * bflo(w[q]); acc[2 * q + 1] += bfhi(x[q]) * bfhi(w[q]); }
        }
#pragma unroll
        for (int e = 0; e < 8; ++e) y[i * 8 + e] = acc[e];
    }
    float s = 0.f;
#pragma unroll
    for (int j = 0; j < 64; ++j) s += y[j];
    s += swz_xor<1>(s); s += swz_xor<2>(s); s += swz_xor<4>(s);
    const float mean = s * (1.0f / 512.0f); float q2 = 0.f;
#pragma unroll
    for (int j = 0; j < 64; ++j) { y[j] -= mean; q2 += y[j] * y[j]; }
    q2 += swz_xor<1>(q2); q2 += swz_xor<2>(q2); q2 += swz_xor<4>(q2);
    const float rstd = 1.0f / sqrtf(q2 * (1.0f / 512.0f) + 1e-5f);
    bf16* orow = MIX + (size_t)(b * T + t0 + tl) * 1024;
#pragma unroll
    for (int i = 0; i < 8; ++i) {
        const int c0 = (chunk + 8 * i) * 8;
        const f32x4 g0 = *(const f32x4*)(lg + c0), g1 = *(const f32x4*)(lg + c0 + 4), b0 = *(const f32x4*)(lb + c0), b1 = *(const f32x4*)(lb + c0 + 4);
        f32x4 o0, o1;
#pragma unroll
        for (int e = 0; e < 4; ++e) { const float v0 = y[i * 8 + e] * rstd * g0[e] + b0[e], v1 = y[i * 8 + 4 + e] * rstd * g1[e] + b1[e]; o0[e] = v0 * sigmoidf_(v0); o1[e] = v1 * sigmoidf_(v1); }
        store8(orow + c0, o0, o1);
    }
}

constexpr int DA_KROW = 272, DA_VROW = 136, DA_KB = 64 * DA_KROW, DA_VB = 128 * DA_VROW, DA_BUF = DA_KB + DA_VB;
DI int crow(int reg, int hf) { return (reg & 3) + 8 * (reg >> 2) + 4 * hf; }
DI void diffattn_unit(const Frame& F0, int unit, const bf16* QK, const bf16* VT, const float* BIAS, const float lam, const float* subg, bf16* MIX) {
    const Frame F = fresh(F0);
    const int b = unit >> 6, h = (unit >> 4) & 3, qb = unit & 15;
    const int c = F.wave >> 2, qs = F.wave & 3, r32 = F.lane & 31, hf = F.lane >> 5;
    const int q0w = qb * 128 + qs * 32;
    const float* bias_h = BIAS + h * 4096 + 2047;
    bf16x8 Qf[4];
    { const bf16* qp = QK + (size_t)(b * T + q0w + r32) * 1024 + h * 128 + c * 64 + 8 * hf;
#pragma unroll
      for (int ks = 0; ks < 4; ++ks) Qf[ks] = *(const bf16x8*)(qp + 16 * ks); }
    const bf16* kg[2]; const bf16* vg[2]; int kl[2], vl[2];
#pragma unroll
    for (int i = 0; i < 2; ++i) { const int p = F.tid + 512 * i;
        kg[i] = QK + (size_t)(b * T + (p >> 4)) * 1024 + 512 + h * 128 + (p & 15) * 8; kl[i] = (p >> 4) * DA_KROW + (p & 15) * 16;
        vg[i] = VT + (size_t)(h * 128 + (p >> 3)) * M + b * T + (p & 7) * 8; vl[i] = DA_KB + (p >> 3) * DA_VROW + (p & 7) * 16; }
    u32x4 kr[2], vr[2];
#pragma unroll
    for (int i = 0; i < 2; ++i) { kr[i] = *(const u32x4*)(kg[i]); vr[i] = *(const u32x4*)(vg[i]); }
    __syncthreads();
#pragma unroll
    for (int i = 0; i < 2; ++i) { *(LAS u32x4*)(F.lds + kl[i]) = kr[i]; *(LAS u32x2*)(F.lds + vl[i]) = (u32x2){vr[i].x, vr[i].y}; *(LAS u32x2*)(F.lds + vl[i] + 8) = (u32x2){vr[i].z, vr[i].w}; }
    __syncthreads();
    f32x16 O[4];
#pragma unroll
    for (int vt = 0; vt < 4; ++vt)
#pragma unroll
        for (int i = 0; i < 16; ++i) O[vt][i] = 0.f;
    float lsum = 0.f;
    const int ka = r32 * DA_KROW + c * 128 + 16 * hf;
    const int va = DA_KB + r32 * DA_VROW + 8 * hf;
    for (int kt = 0; kt < 32; ++kt) {
        const int k0 = kt * 64;
        LAS unsigned char* buf = F.lds + (kt & 1) * DA_BUF;
        if (kt + 1 < 32) {
#pragma unroll
            for (int i = 0; i < 2; ++i) { kr[i] = *(const u32x4*)(kg[i] + (size_t)(k0 + 64) * 1024); vr[i] = *(const u32x4*)(vg[i] + k0 + 64); }
        }
        const int dmin = k0 - (q0w + 31), dmax = k0 + 63 - q0w;
        const bool far = (dmin >= 91) || (dmax <= -91);
        const float cb = dmin >= 91 ? bias_h[91] : bias_h[-91];
#pragma unroll
        for (int sub = 0; sub < 2; ++sub) {
            f32x16 S;
#pragma unroll
            for (int i = 0; i < 16; ++i) S[i] = 0.f;
#pragma unroll
            for (int ks = 0; ks < 4; ++ks) { const bf16x8 a = *(const LAS bf16x8*)(buf + ka + sub * 32 * DA_KROW + ks * 32); S = __builtin_amdgcn_mfma_f32_32x32x16_bf16(a, Qf[ks], S, 0, 0, 0); }
            float p[16];
            if (far) {
#pragma unroll
                for (int i = 0; i < 16; ++i) p[i] = fexp2(S[i] * LOG2E + cb);
            } else {
                const int rel0 = k0 + 32 * sub - (q0w + r32);
#pragma unroll
                for (int i = 0; i < 16; ++i) p[i] = fexp2(S[i] * LOG2E + bias_h[rel0 + crow(i, hf)]);
            }
#pragma unroll
            for (int i = 0; i < 16; ++i) lsum += p[i];
#pragma unroll
            for (int s = 0; s < 2; ++s) {
                u32x4 pw; pw.x = pk2(p[8 * s], p[8 * s + 1]); pw.y = pk2(p[8 * s + 2], p[8 * s + 3]); pw.z = pk2(p[8 * s + 4], p[8 * s + 5]); pw.w = pk2(p[8 * s + 6], p[8 * s + 7]);
                const bf16x8 pa = __builtin_bit_cast(bf16x8, pw);
#pragma unroll
                for (int vt = 0; vt < 4; ++vt) {
                    const LAS unsigned char* vp = buf + va + vt * 32 * DA_VROW + (32 * sub + 16 * s) * 2;
                    const u32x2 lo = *(const LAS u32x2*)(vp), hi = *(const LAS u32x2*)(vp + 16);
                    const u32x4 vw = (u32x4){lo.x, lo.y, hi.x, hi.y};
                    O[vt] = __builtin_amdgcn_mfma_f32_32x32x16_bf16(pa, __builtin_bit_cast(bf16x8, vw), O[vt], 0, 0, 0);
                }
            }
        }
        if (kt + 1 < 32) {
            LAS unsigned char* nb = F.lds + ((kt + 1) & 1) * DA_BUF;
#pragma unroll
            for (int i = 0; i < 2; ++i) { *(LAS u32x4*)(nb + kl[i]) = kr[i]; *(LAS u32x2*)(nb + vl[i]) = (u32x2){vr[i].x, vr[i].y}; *(LAS u32x2*)(nb + vl[i] + 8) = (u32x2){vr[i].z, vr[i].w}; }
        }
        __syncthreads();
    }
    lsum = half_sum(lsum);
    LAS float* XO = (LAS float*)F.lds;
    LAS float* LW = (LAS float*)(F.lds + 65536) + F.wave * 32;
    if (hf == 0) LW[r32] = 1.0f / lsum;
    asm volatile("s_waitcnt lgkmcnt(0)" ::: "memory");
    float il[16];
#pragma unroll
    for (int i = 0; i < 16; ++i) il[i] = LW[crow(i, hf)];
    if (c == 1) {
#pragma unroll
        for (int vt = 0; vt < 4; ++vt)
#pragma unroll
            for (int i = 0; i < 16; ++i) XO[(qs * 32 + crow(i, hf)) * 128 + vt * 32 + r32] = O[vt][i] * il[i];
    }
    __syncthreads();
    if (c == 0) {
        float ss[16];
#pragma unroll
        for (int i = 0; i < 16; ++i) ss[i] = 0.f;
#pragma unroll
        for (int vt = 0; vt < 4; ++vt)
#pragma unroll
            for (int i = 0; i < 16; ++i) { const float o = O[vt][i] * il[i] - lam * XO[(qs * 32 + crow(i, hf)) * 128 + vt * 32 + r32]; O[vt][i] = o; ss[i] += o * o; }
#pragma unroll
        for (int i = 0; i < 16; ++i) { float v = ss[i]; v += swz_xor<1>(v); v += swz_xor<2>(v); v += swz_xor<4>(v); v += swz_xor<8>(v); v += swz_xor<16>(v); ss[i] = 0.8f / sqrtf(v * (1.0f / 128.0f) + EPS); }
#pragma unroll
        for (int vt = 0; vt < 4; ++vt) {
            const float g = subg[vt * 32 + r32];
#pragma unroll
            for (int i = 0; i < 16; ++i) MIX[(size_t)(b * T + q0w + crow(i, hf)) * 1024 + 512 + h * 128 + vt * 32 + r32] = (bf16)f2bf(O[vt][i] * ss[i] * g);
        }
    }
}

constexpr int SC_VECB = 256, SC_STEPB = 6 * SC_VECB, SC_BUFB = 16 * SC_STEPB;
constexpr int SC_SCR_OFF = 4 * SC_BUFB, SC_SCR_W = 16 * 68 * 4;
DI float dpp_x1(float v) { return __builtin_bit_cast(float, __builtin_amdgcn_update_dpp(0, __builtin_bit_cast(int, v), 0xB1, 0xF, 0xF, true)); }
DI float dpp_x2(float v) { return __builtin_bit_cast(float, __builtin_amdgcn_update_dpp(0, __builtin_bit_cast(int, v), 0x4E, 0xF, 0xF, true)); }
DI float quad_sum(float v) { v += dpp_x1(v); v += dpp_x2(v); return v; }

struct ScanPtrs { const bf16 *R, *K, *V, *HD1, *W2T; const float *w0, *a0, *kk, *ka, *rk; bf16 *YF, *YB; float* BON; };

DI void scan_pair(const Frame& F0, int bh, const ScanPtrs& P) {
    const Frame F = fresh(F0);
    const int b = bh >> 4, h = bh & 15;
    __syncthreads();
    if (F.wave < 4) {
        const int z = F.wave >> 1, rh = F.wave & 1, rp = F.lane >> 2, jq = F.lane & 3, i0 = rh * 32 + 2 * rp;
        f32x2 S[16];
#pragma unroll
        for (int j = 0; j < 16; ++j) S[j] = (f32x2){0.f, 0.f};
        bf16* Y = z ? P.YB : P.YF;
        __builtin_amdgcn_s_barrier();
        for (int e = 0; e < T / 16; ++e) {
            const LAS unsigned char* base = F.lds + (z * 2 + (e & 1)) * SC_BUFB + jq * 64;
            const int t0c = z ? T - 16 * (e + 1) : 16 * e;
#pragma unroll 2
            for (int s = 0; s < 16; ++s) {
                const int li = z ? 15 - s : s;
                const LAS unsigned char* sb = base + li * SC_STEPB;
                f32x4 wv[4], kv[4], bv[4], av[4], rv[4];
#pragma unroll
                for (int q = 0; q < 4; ++q) { av[q] = *(const LAS f32x4*)(sb + 3 * SC_VECB + q * 16); wv[q] = *(const LAS f32x4*)(sb + q * 16); kv[q] = *(const LAS f32x4*)(sb + SC_VECB + q * 16);
                    bv[q] = *(const LAS f32x4*)(sb + 2 * SC_VECB + q * 16); rv[q] = *(const LAS f32x4*)(sb + 4 * SC_VECB + q * 16); }
                const f32x2 v2 = *(const LAS f32x2*)(sb - jq * 64 + 5 * SC_VECB + i0 * 4);
                f32x2 sa = (f32x2){0.f, 0.f}, sa1 = (f32x2){0.f, 0.f};
#pragma unroll
                for (int j = 0; j < 16; j += 2) { sa += S[j] * av[j >> 2][j & 3]; sa1 += S[j + 1] * av[(j + 1) >> 2][(j + 1) & 3]; }
                sa += sa1;
                sa.x = quad_sum(sa.x); sa.y = quad_sum(sa.y);
                f32x2 y = (f32x2){0.f, 0.f}, y1 = (f32x2){0.f, 0.f};
#pragma unroll
                for (int j = 0; j < 16; j += 2) {
                    S[j] = S[j] * wv[j >> 2][j & 3] + sa * bv[j >> 2][j & 3] + v2 * kv[j >> 2][j & 3];
                    S[j + 1] = S[j + 1] * wv[(j + 1) >> 2][(j + 1) & 3] + sa * bv[(j + 1) >> 2][(j + 1) & 3] + v2 * kv[(j + 1) >> 2][(j + 1) & 3];
                    y += S[j] * rv[j >> 2][j & 3]; y1 += S[j + 1] * rv[(j + 1) >> 2][(j + 1) & 3];
                }
                y += y1;
                y.x = quad_sum(y.x); y.y = quad_sum(y.y);
                if (jq == 0) *(unsigned*)(Y + (size_t)(b * T + t0c + li) * 1024 + h * 64 + i0) = pk2(y.x, y.y);
            }
            asm volatile("s_waitcnt lgkmcnt(0)" ::: "memory");
            __builtin_amdgcn_s_barrier();
        }
    } else {
        const int pw = F.wave - 4, z = pw >> 1, par = pw & 1;
        const int l15 = F.lane & 15, l4 = F.lane >> 4, row = F.lane >> 2, cq = F.lane & 3;
        const bf16* w2p = P.W2T + (size_t)z * 65536 + (size_t)(h * 64 + l15) * 64 + 8 * l4;
        const int ch0 = h * 64 + cq * 16;
        LAS float* scrW = (LAS float*)(F.lds + SC_SCR_OFF + pw * 2 * SC_SCR_W);
        LAS float* scrA = scrW + 16 * 68;
        bf16x8 Ahw[2], Aha[2]; u32x4 r16[2], k16[2], v16[2];
        auto do_load = [&](int c) {
            const int t0c = z ? T - 16 * (c + 1) : 16 * c; const size_t m0 = (size_t)b * T + t0c;
#pragma unroll
            for (int ks = 0; ks < 2; ++ks) { const bf16* p = P.HD1 + (m0 + l15) * 256 + z * 64 + 32 * ks + 8 * l4; Ahw[ks] = *(const bf16x8*)p; Aha[ks] = *(const bf16x8*)(p + 128); }
            const size_t off = (m0 + row) * 1024 + ch0;
#pragma unroll
            for (int q = 0; q < 2; ++q) { r16[q] = ((const u32x4*)(P.R + off))[q]; k16[q] = ((const u32x4*)(P.K + off))[q]; v16[q] = ((const u32x4*)(P.V + off))[q]; }
        };
        auto do_compute = [&](int c) {
            const int t0c = z ? T - 16 * (c + 1) : 16 * c; const size_t m0 = (size_t)b * T + t0c;
#pragma unroll
            for (int nt = 0; nt < 4; ++nt) {
                f32x4 dw = (f32x4){0.f, 0.f, 0.f, 0.f}, da = dw;
#pragma unroll
                for (int ks = 0; ks < 2; ++ks) { const bf16x8 wf = *(const bf16x8*)(w2p + nt * 1024 + ks * 32), af = *(const bf16x8*)(w2p + 2 * 65536 + nt * 1024 + ks * 32);
                    dw = __builtin_amdgcn_mfma_f32_16x16x32_bf16(Ahw[ks], wf, dw, 0, 0, 0); da = __builtin_amdgcn_mfma_f32_16x16x32_bf16(Aha[ks], af, da, 0, 0, 0); }
#pragma unroll
                for (int rg = 0; rg < 4; ++rg) { scrW[(4 * l4 + rg) * 68 + 16 * nt + l15] = dw[rg]; scrA[(4 * l4 + rg) * 68 + 16 * nt + l15] = da[rg]; }
            }
            asm volatile("s_waitcnt lgkmcnt(0)" ::: "memory");
            float ssq = 0.f;
#pragma unroll
            for (int q = 0; q < 2; ++q)
#pragma unroll
                for (int w = 0; w < 4; ++w) { const f32x2 kc = *(const f32x2*)(P.kk + ch0 + q * 8 + 2 * w); const float k0 = bflo(k16[q][w]) * kc.x, k1 = bfhi(k16[q][w]) * kc.y; ssq += k0 * k0 + k1 * k1; }
            ssq = quad_sum(ssq);
            const float inv = 1.0f / fmaxf(sqrtf(ssq), 1e-12f);
            float bon = 0.f;
            LAS unsigned char* sb = F.lds + (z * 2 + (c & 1)) * SC_BUFB + row * SC_STEPB + cq * 64;
#pragma unroll
            for (int q = 0; q < 4; ++q) {
                const f32x4 wp = *(const LAS f32x4*)(scrW + row * 68 + cq * 16 + q * 4), ap = *(const LAS f32x4*)(scrA + row * 68 + cq * 16 + q * 4);
                const f32x4 w0v = *(const f32x4*)(P.w0 + z * 1024 + ch0 + q * 4), a0v = *(const f32x4*)(P.a0 + z * 1024 + ch0 + q * 4);
                const f32x4 kkv = *(const f32x4*)(P.kk + ch0 + q * 4), kav = *(const f32x4*)(P.ka + ch0 + q * 4), rkv = *(const f32x4*)(P.rk + ch0 + q * 4);
                const unsigned kw0 = k16[q >> 1][(q & 1) * 2], kw1 = k16[q >> 1][(q & 1) * 2 + 1], rw0 = r16[q >> 1][(q & 1) * 2], rw1 = r16[q >> 1][(q & 1) * 2 + 1], vw0 = v16[q >> 1][(q & 1) * 2], vw1 = v16[q >> 1][(q & 1) * 2 + 1];
                const f32x4 kf = (f32x4){bflo(kw0), bfhi(kw0), bflo(kw1), bfhi(kw1)}, rf = (f32x4){bflo(rw0), bfhi(rw0), bflo(rw1), bfhi(rw1)}, vf = (f32x4){bflo(vw0), bfhi(vw0), bflo(vw1), bfhi(vw1)};
                f32x4 ow, ok, ob, oa;
#pragma unroll
                for (int j = 0; j < 4; ++j) {
                    const float dec = fexp2(-0.60653066f * LOG2E * sigmoidf_(wp[j] + w0v[j]));
                    const float ar = sigmoidf_(ap[j] + a0v[j]);
                    const float kkn = kf[j] * kkv[j] * inv;
                    const float kd = kf[j] * (1.0f + (ar - 1.0f) * kav[j]);
                    ow[j] = dec; ok[j] = kd; ob[j] = kkn * ar; oa[j] = -kkn;
                    bon += rf[j] * kd * rkv[j];
                }
                *(LAS f32x4*)(sb + q * 16) = ow; *(LAS f32x4*)(sb + SC_VECB + q * 16) = ok; *(LAS f32x4*)(sb + 2 * SC_VECB + q * 16) = ob;
                *(LAS f32x4*)(sb + 3 * SC_VECB + q * 16) = oa; *(LAS f32x4*)(sb + 4 * SC_VECB + q * 16) = rf; *(LAS f32x4*)(sb + 5 * SC_VECB + q * 16) = vf;
            }
            bon = quad_sum(bon);
            if (cq == 0) P.BON[((size_t)z * M + m0 + row) * 16 + h] = bon;
            asm volatile("s_waitcnt lgkmcnt(0)" ::: "memory");
        };
        if (par == 0) { do_load(0); do_compute(0); } else do_load(1);
        __builtin_amdgcn_s_barrier();
        for (int e = 0; e < T / 16; ++e) {
            if (((e + 1) & 1) == par) { if (e + 1 < T / 16) do_compute(e + 1); }
            else { if (e + 2 < T / 16) do_load(e + 2); }
            __builtin_amdgcn_s_barrier();
        }
    }
}

constexpr int NPH = 25;
template <int TYPE> struct PreSched {
    const bf16* KV; const bf16* W; int G, c;
    DI bool next(int i, Unit& u) const {
        const long L = (long)i * G + c; if (L >= 512) return false;
        const int rem = (int)L, i2 = rem >> 8, b = (rem >> 4) & 15, hh = (rem >> 2) & 3, t4 = rem & 3;
        u.pm = 0; u.pn = 0;
        const bf16* kvp = KV + (size_t)(b * 256) * 4096 + i2 * 2048 + hh * 256;
        const bf16* wp = W + (size_t)i2 * 1024 * 1024 + (size_t)(t4 * 256) * 1024 + hh * 256;
        if (TYPE == 0) { u.pa = (const char*)kvp; u.pb = (const char*)wp; u.z = (i2 << 30) | (b * 1048576 + hh * 256 * 1024 + t4 * 256); }
        else { u.pa = (const char*)wp; u.pb = (const char*)(kvp + 1024); u.z = (i2 << 30) | (16 * 1048576 + b * 1048576 + t4 * 256 * 1024 + hh * 256); }
        return true;
    }
};

__global__ void __launch_bounds__(512, 2) mk_fwd(Args a) {
    extern __shared__ __attribute__((aligned(16))) unsigned char lds_raw[];
    Frame F;
    F.lds = (LAS unsigned char*)lds_raw;
    F.tid = threadIdx.x; F.lane = F.tid & 63; F.wave = __builtin_amdgcn_readfirstlane(F.tid >> 6);
    F.gw = blockIdx.x * 8 + F.wave; F.ngw = gridDim.x * 8; F.ws = a.ws;
    cg::grid_group grid = cg::this_grid();

    for (int ph = a.ph_lo; ph < a.ph_hi; ++ph) {
        const int G = opq(gridDim.x), cblk = opq(blockIdx.x);
        unsigned char* ws = opq_ptr(a.ws);
        float* RS = (float*)(ws + WS_RS);
        bf16* SA = (bf16*)(ws + WS_SA); bf16* SB = (bf16*)(ws + WS_SB);
        const int li = ph >= 18 ? 1 : 0;
        int cp = ph; if (ph >= 18 && ph <= 23) cp = ph - 12;
#ifndef PH_MASK
#define PH_MASK 0xffffffffu
#endif
        if (!((PH_MASK >> cp) & 1u)) cp = 99;
        switch (cp) {
        case 0: phase_prologue(F, a, ws); break;
        case 1: {
            pg8::PlainSched S{(const bf16*)(ws + WS_MEMB), (const bf16*)(ws + WS_WKV), 1024, 1024, MMEM / 256, 16, G, cblk, 30, 0};
            EpiRowScale<0> E{(bf16*)(ws + WS_KV), 4096, (const float*)(ws + WS_RSMEM)};
            pg8::gemm_phase(F.lds, 1024, 1024, 1024, S, E);
        } break;
        case 2: {
            EpiPre E{(bf16*)(ws + WS_G0)};
            { PreSched<0> S{(const bf16*)(ws + WS_KV), (const bf16*)(ws + WS_WQN), G, cblk}; pg8::gemm_phase(F.lds, 256, 4096, 1024, S, E); }
            { PreSched<1> S{(const bf16*)(ws + WS_KV), (const bf16*)(ws + WS_WXO), G, cblk}; pg8::gemm_phase(F.lds, 256, 1024, 4096, S, E); }
        } break;
        case 3: {
            { pg8::PlainSched S{SA, (const bf16*)(ws + WS_WIN), 1024, 1024, M / 256, 8, G, cblk, 30, 0};
              EpiInProj E{(bf16*)(ws + WS_GLU), SB, RS};
              pg8::gemm_phase(F.lds, 1024, 1024, 1024, S, E); }
            { pg8::PlainSched S{(const bf16*)(ws + WS_WIN) + (size_t)2048 * 1024, SA, 1024, 1024, 2, M / 256, G, cblk, 30, 0};
              EpiVT E{(bf16*)(ws + WS_VT), RS};
              pg8::gemm_phase(F.lds, 1024, 1024, 1024, S, E); }
        } break;
        case 4: {
            const float lam = ((const float*)(ws + WS_LAM))[0];
#ifndef NO_ATTN
            for (int u = cblk; u < 1024; u += G) diffattn_unit(F, u, SB, (const bf16*)(ws + WS_VT), (const float*)(ws + WS_BIAS), lam, a.in[opq(I_SUBLN)], (bf16*)(ws + WS_MIX));
#endif
            __syncthreads();
#ifndef NO_CONV
            conv_load_weights(F, a.in[opq(I_CONVW)]);
            for (int u = cblk; u < 512; u += G) conv_unit(F, u, (const bf16*)(ws + WS_GLU), a.in[opq(I_CONVB)], a.in[opq(I_CLNG)], a.in[opq(I_CLNB)], (bf16*)(ws + WS_MIX));
#endif
            __syncthreads();
        } break;
        case 5: {
            pg8::PlainSched S{(const bf16*)(ws + WS_MIX), (const bf16*)(ws + WS_WOUT), 1024, 1024, M / 256, 4, G, cblk, 30, 0};
            EpiResid E{a.in[opq(I_X)], a.out};
            pg8::gemm_phase(F.lds, 1024, 1024, 1024, S, E);
        } break;
        case 6: case 9: phase_norm(F, a.out, SA, RS); break;
        case 7: {
            pg8::PlainSched S{SA, (const bf16*)(ws + (li ? WS_G1 : WS_G0)), 1024, 1024, M / 256, 4, G, cblk, 3, (size_t)1048576};
            EpiSoftmax E{SB, RS};
            pg8::gemm_phase(F.lds, 1024, 1024, 1024, S, E);
        } break;
        case 8: {
            pg8::PlainSched S{SB, (const bf16*)(ws + (li ? WS_VW1 : WS_VW0)), 1024, 1024, M / 256, 4, G, cblk, 3, (size_t)1048576};
            EpiResid E{a.out, a.out};
            pg8::gemm_phase(F.lds, 1024, 1024, 1024, S, E);
        } break;
        case 10: {
            pg8::PlainSched S{SA, (const bf16*)(ws + WS_WUP) + (size_t)li * 4096 * 1024, 1024, 1024, M / 256, 16, G, cblk, 30, 0};
            EpiRowScale<2> E{(bf16*)(ws + WS_HID), 4096, RS};
            pg8::gemm_phase(F.lds, 1024, 1024, 1024, S, E);
        } break;
        case 11: {
            pg8::PlainSched S{(const bf16*)(ws + WS_HID), (const bf16*)(ws + WS_WDN) + (size_t)li * 1024 * 4096, 4096, 4096, M / 256, 4, G, cblk, 30, 0};
            EpiResid E{a.out, a.out};
            pg8::gemm_phase(F.lds, 4096, 4096, 4096, S, E);
        } break;
        case 12: phase_rwkv_shift(F, a.out, a.in[opq(I_NMIX)] + 1024, (bf16*)(ws + WS_A1)); break;
        case 13: {
            pg8::PlainSched S{(const bf16*)(ws + WS_A1), (const bf16*)(ws + WS_WBIG), 2048, 2048, M / 256, 14, G, cblk, 30, 0};
            EpiRwkv E{(bf16*)(ws + WS_R), (bf16*)(ws + WS_K), (bf16*)(ws + WS_V), (bf16*)(ws + WS_HD1), (bf16*)(ws + WS_HD2)};
            pg8::gemm_phase(F.lds, 2048, 2048, 2048, S, E);
        } break;
        case 14: {
            ScanPtrs P{(const bf16*)(ws + WS_R), (const bf16*)(ws + WS_K), (const bf16*)(ws + WS_V), (const bf16*)(ws + WS_HD1), (const bf16*)(ws + WS_W2T),
                       a.in[opq(I_W0)], a.in[opq(I_A0)], a.in[opq(I_KK)], a.in[opq(I_KA)], a.in[opq(I_RK)], (bf16*)(ws + WS_YF), (bf16*)(ws + WS_YB), (float*)(ws + WS_BONUS)};
            for (int bh = cblk; bh < 256; bh += G) scan_pair(F, bh, P);
            __syncthreads();
        } break;
        case 15: {
            pg8::PlainSched S{(const bf16*)(ws + WS_HD2), (const bf16*)(ws + WS_G2T), 256, 256, M / 256, 4, G, cblk, 30, 0};
            EpiRowScale<0> E{(bf16*)(ws + WS_GATE), 1024, nullptr};
            pg8::gemm_phase(F.lds, 256, 256, 256, S, E);
        } break;
        case 16: phase_rwkv_comb(F, (const bf16*)(ws + WS_YF), (const bf16*)(ws + WS_YB), (const bf16*)(ws + WS_V), (const bf16*)(ws + WS_GATE), (const float*)(ws + WS_BONUS),
                                 a.in[opq(I_LNG)], a.in[opq(I_LNB)], (bf16*)(ws + WS_COMB)); break;
        case 17: {
            pg8::PlainSched S{(const bf16*)(ws + WS_COMB), (const bf16*)(ws + WS_WRO), 1024, 1024, M / 256, 4, G, cblk, 30, 0};
            EpiResid E{a.out, a.out};
            pg8::gemm_phase(F.lds, 1024, 1024, 1024, S, E);
        } break;
        case 24: phase_final_norm(F, a.out, a.in[opq(I_NFINAL)]); break;
        default: break;
        }
        if (ph + 1 < a.ph_hi) grid.sync();
    }
}

extern "C" void kernel_launch(void* const* d_in, const int* in_sizes, int n_in, void* d_out, int out_size, void* d_ws, size_t ws_size, hipStream_t stream) {
    static int grid = 0;
    if (grid == 0) {
        if (n_in != N_IN || in_sizes[0] != M * D || out_size != M * D || ws_size < WS_NEED) {
            fprintf(stderr, "kernel_launch: unexpected problem (n_in %d, in0 %d, out %d, ws %zu); nothing launched\n", n_in, n_in > 0 ? in_sizes[0] : -1, out_size, ws_size); grid = -1; return; }
        int dev = 0, cus = 0, per_cu = 0;
        if (hipGetDevice(&dev) != hipSuccess || hipDeviceGetAttribute(&cus, hipDeviceAttributeMultiprocessorCount, dev) != hipSuccess) { grid = -1; return; }
        if (hipFuncSetAttribute((const void*)mk_fwd, hipFuncAttributeMaxDynamicSharedMemorySize, LDS_BYTES) != hipSuccess) { fprintf(stderr, "kernel_launch: hipFuncSetAttribute failed\n"); grid = -1; return; }
        if (hipOccupancyMaxActiveBlocksPerMultiprocessor(&per_cu, (const void*)mk_fwd, 512, LDS_BYTES) != hipSuccess || per_cu < 1) { fprintf(stderr, "kernel_launch: occupancy query says %d\n", per_cu); (void)hipGetLastError(); grid = -1; return; }
        grid = cus;
    }
    if (grid < 0) return;
    Args a{};
    for (int i = 0; i < N_IN; ++i) a.in[i] = (const float*)d_in[i];
    a.out = (float*)d_out; a.ws = (unsigned char*)d_ws;
#if MK_SINGLE
    a.ph_lo = 0; a.ph_hi = NPH;
    void* params[] = {&a};
    hipError_t e = hipLaunchCooperativeKernel((const void*)mk_fwd, dim3(grid), dim3(512), params, LDS_BYTES, stream);
    if (e != hipSuccess) fprintf(stderr, "kernel_launch: cooperative launch failed: %s\n", hipGetErrorString(e));
#else
    for (int ph = 0; ph < NPH; ++ph) { a.ph_lo = ph; a.ph_hi = ph + 1; hipLaunchKernelGGL(mk_fwd, dim3(grid), dim3(512), LDS_BYTES, stream, a); }
#endif
}
```

```cpp
#include <hip/hip_runtime.h>
#include <hip/hip_cooperative_groups.h>
#include <cstdio>
#include <cstdint>
namespace cg = cooperative_groups;

#ifndef MK_SINGLE
#define MK_SINGLE 1
#endif

#define LAS __attribute__((address_space(3)))
#define DI __device__ __forceinline__
typedef unsigned short bf16;
typedef short bf16x8 __attribute__((ext_vector_type(8)));
typedef short s16x4 __attribute__((ext_vector_type(4)));
typedef float f32x2 __attribute__((ext_vector_type(2)));
typedef float f32x4 __attribute__((ext_vector_type(4)));
typedef float f32x16 __attribute__((ext_vector_type(16)));
typedef unsigned u32x2 __attribute__((ext_vector_type(2)));
typedef unsigned u32x4 __attribute__((ext_vector_type(4)));

constexpr int D = 1024, NB = 16, T = 2048, M = NB * T, NMEM = 256, MMEM = NB * NMEM;
constexpr int FF = 4096;
constexpr float EPS = 1e-6f;
constexpr float LOG2E = 1.4426950408889634f;

constexpr size_t MiB = 1u << 20;
constexpr size_t WS_BAR = 0;
constexpr size_t WS_RS = 64 * 1024;
constexpr size_t WS_RSMEM = WS_RS + M * 4;
constexpr size_t WS_BIAS = WS_RSMEM + MMEM * 4;
constexpr size_t WS_LAM = WS_BIAS + 4 * 4096 * 4;
constexpr size_t WS_WIN = 1 * MiB;
constexpr size_t WS_WOUT = WS_WIN + 5 * MiB;
constexpr size_t WS_WQN = WS_WOUT + 2 * MiB;
constexpr size_t WS_WKV = WS_WQN + 4 * MiB;
constexpr size_t WS_WXO = WS_WKV + 8 * MiB;
constexpr size_t WS_WUP = WS_WXO + 4 * MiB;
constexpr size_t WS_WDN = WS_WUP + 16 * MiB;
constexpr size_t WS_WBIG = WS_WDN + 16 * MiB;
constexpr size_t WS_W2T = WS_WBIG + 14 * MiB;
constexpr size_t WS_G2T = WS_W2T + 512 * 1024;
constexpr size_t WS_WRO = WS_G2T + 512 * 1024;
constexpr size_t WS_WEND = WS_WRO + 2 * MiB;
static_assert(WS_WEND == 73 * MiB, "weight map");
constexpr size_t WS_SA = 73 * MiB;
constexpr size_t WS_SB = 137 * MiB;
constexpr size_t WS_GLU = 201 * MiB;
constexpr size_t WS_VT = 233 * MiB;
constexpr size_t WS_MIX = 265 * MiB;
constexpr size_t WS_G0 = 329 * MiB;
constexpr size_t WS_VW0 = 361 * MiB;
constexpr size_t WS_MEMB = 393 * MiB;
constexpr size_t WS_KV = 401 * MiB;
constexpr size_t WS_G1 = 433 * MiB;
constexpr size_t WS_VW1 = 465 * MiB;
static_assert(WS_G1 - WS_G0 == 104 * MiB && WS_VW0 - WS_G0 == 32 * MiB && WS_VW1 - WS_G1 == 32 * MiB, "G / VW spacing used by EpiPre");
constexpr size_t WS_BONUS = 497 * MiB;
constexpr size_t WS_HID = 137 * MiB;
constexpr size_t WS_A1 = 73 * MiB;
constexpr size_t WS_R = 201 * MiB, WS_K = 265 * MiB, WS_V = 329 * MiB;
static_assert(WS_K - WS_R == 64 * MiB && WS_V - WS_K == 64 * MiB, "r, k, v spacing used by EpiRwkv");
constexpr size_t WS_HD1 = 393 * MiB;
constexpr size_t WS_HD2 = 409 * MiB;
constexpr size_t WS_YF = 73 * MiB, WS_YB = 137 * MiB;
constexpr size_t WS_GATE = 265 * MiB;
constexpr size_t WS_COMB = 201 * MiB;
constexpr size_t WS_NEED = 512 * MiB;

constexpr int LDS_X = 131072;
constexpr int LDS_MISC = 131072 + 8192;
constexpr int LDS_BYTES = 147456;

DI unsigned f2bf(float f) { unsigned u = __builtin_bit_cast(unsigned, f); return (u + 0x7fffu + ((u >> 16) & 1u)) >> 16; }
typedef __bf16 bf16x2v __attribute__((ext_vector_type(2)));
DI unsigned pk2(float lo, float hi) { const f32x2 v = {lo, hi}; return __builtin_bit_cast(unsigned, __builtin_convertvector(v, bf16x2v)); }
DI float bf2f(unsigned short b) { return __builtin_bit_cast(float, ((unsigned)b) << 16); }
DI float bflo(unsigned w) { return __builtin_bit_cast(float, w << 16); }
DI float bfhi(unsigned w) { return __builtin_bit_cast(float, w & 0xffff0000u); }
template <int MASK> DI float swz_xor(float v) { return __builtin_bit_cast(float, __builtin_amdgcn_ds_swizzle(__builtin_bit_cast(int, v), (MASK << 10) | 0x1f)); }
DI float half_sum(float v) { const int x = __builtin_bit_cast(int, v); const auto r = __builtin_amdgcn_permlane32_swap(x, x, false, false); return __builtin_bit_cast(float, (int)r[0]) + __builtin_bit_cast(float, (int)r[1]); }
DI float half_max(float v) { const int x = __builtin_bit_cast(int, v); const auto r = __builtin_amdgcn_permlane32_swap(x, x, false, false); return fmaxf(__builtin_bit_cast(float, (int)r[0]), __builtin_bit_cast(float, (int)r[1])); }
DI float wave_sum(float v) {
    v += swz_xor<1>(v); v += swz_xor<2>(v); v += swz_xor<4>(v); v += swz_xor<8>(v); v += swz_xor<16>(v); v = half_sum(v);
    return v;
}
DI int opaque(int x) { asm volatile("" : "+v"(x)); return x; }
template <class Tp> DI Tp* opq_ptr(Tp* p) { asm volatile("" : "+s"(p)); return p; }
DI int opq(int x) { asm volatile("" : "+s"(x)); return x; }
DI float fexp2(float x) { return __builtin_amdgcn_exp2f(x); }
DI float frcp(float x) { return __builtin_amdgcn_rcpf(x); }
DI float sigmoidf_(float x) { return frcp(1.0f + fexp2(-x * LOG2E)); }
DI float tanhf_(float x) { float e = fexp2(-2.0f * LOG2E * fabsf(x)); float t = (1.0f - e) * frcp(1.0f + e); return x < 0.f ? -t : t; }

namespace pg8 {
constexpr int BM = 256, BK = 64, HALF = 128, HTB = HALF * BK * 2, STAGE_BYTES = 8 * HTB, NXCD = 8, WGM = 8;
DI int lds_byte(int r, int c) { const int st = (r >> 4) * 2 + (c >> 5), rr = r & 15, cc = c & 31, ob = rr * 64 + cc * 2; return st * 1024 + (ob ^ (((ob >> 9) & 1) << 5)); }
DI void stage_rc(int b, int& R, int& C) { const int st = b / 1024, sb = b % 1024, swz = sb ^ (((sb >> 9) & 1) << 5); R = (st >> 1) * 16 + swz / 64; C = (st & 1) * 32 + (swz % 64) / 2; }
DI int perm32(int rho) { const int n = rho >> 4, i = rho & 15; return 8 * (i >> 2) + 4 * n + (i & 3); }

struct Unit { int pm, pn, z; const char* pa; const char* pb; };

DI bool tile_order(long L, int nM, int nN, int& pm, int& pn) {
    const int nwg = nM * nN; if (L >= nwg) return false;
    int wgid = (int)L; { const int q = nwg / NXCD, r = nwg % NXCD, xcd = wgid % NXCD, off = wgid / NXCD; wgid = (xcd < r ? xcd * (q + 1) : r * (q + 1) + (xcd - r) * q) + off; }
    const int nig = WGM * nN, gid = wgid / nig, fm = gid * WGM, gsz = (nM - fm) < WGM ? (nM - fm) : WGM;
    pm = fm + ((wgid % nig) % gsz); pn = (wgid % nig) / gsz; return true;
}
struct PlainSched {
    const bf16* A; const bf16* Bt; int lda, ldb, nM, nN, G, c, bshift; size_t bstride;
    DI bool next(int i, Unit& u) const {
        if (!tile_order((long)i * G + c, nM, nN, u.pm, u.pn)) return false;
        u.z = u.pm >> bshift;
        u.pa = (const char*)(A + (size_t)u.pm * 256 * lda);
        u.pb = (const char*)(Bt + (size_t)u.z * bstride + (size_t)u.pn * 256 * ldb);
        return true;
    }
};

DI unsigned cvt_pk_bf16(float lo, float hi) { return pk2(lo, hi); }

template <class Epi, class Sched>
DI void gemm_phase(LAS unsigned char* lds, const int K, const int lda, const int ldb, const Sched& S, const Epi& E) {
    const int tid = opaque(threadIdx.x), wid = __builtin_amdgcn_readfirstlane(tid >> 6), lane = tid & 63, wr = wid >> 2, wc = wid & 3, fr = lane & 15, fq = lane >> 4;
    const int nt = K / BK;
    unsigned voffA[2], voffB[2];
#pragma unroll
    for (int i = 0; i < 2; ++i) { int R, C; stage_rc(tid * 16 + i * 8192, R, C); const int Rb = Epi::PERM ? ((R & ~31) + perm32(R & 31)) : R;
        voffA[i] = (unsigned)(R * lda + C) * 2u; voffB[i] = (unsigned)(Rb * ldb + C) * 2u; }
    const size_t kstep = (size_t)(BK * 2);
    const size_t hstepA = (size_t)HALF * lda * 2, hstepB = (size_t)HALF * ldb * 2;
    const unsigned ldsw = (unsigned)wid * 1024u;
    const int aoff = lds_byte(wr * 64 + fr, fq * 8), boff = lds_byte(wc * 32 + fr, fq * 8);
#define PG8_SA(b, h) (((b) * 2 + (h)) * HTB)
#define PG8_SB(b, h) ((4 + (b) * 2 + (h)) * HTB)
#define PG8_STAGE(bufoff, gbase, voff) do { _Pragma("unroll") for (int _i = 0; _i < 2; ++_i) \
        __builtin_amdgcn_global_load_lds((const unsigned*)((const char*)(gbase) + (voff)[_i]), (LAS unsigned*)(lds + (bufoff) + ldsw + _i * 8192), 16, 0, 0); } while (0)
#define PG8_LDA(dst, b, h) do { _Pragma("unroll") for (int m = 0; m < 4; ++m) _Pragma("unroll") for (int k = 0; k < 2; ++k) dst[m][k] = *(const LAS bf16x8*)(lds + PG8_SA(b, h) + aoff + m * 2048 + k * 1024); } while (0)
#define PG8_LDB(dst, b, h) do { _Pragma("unroll") for (int n = 0; n < 2; ++n) _Pragma("unroll") for (int k = 0; k < 2; ++k) dst[n][k] = *(const LAS bf16x8*)(lds + PG8_SB(b, h) + boff + n * 2048 + k * 1024); } while (0)
#define PG8_MMA(ai, bj, At, Bt) do { __builtin_amdgcn_s_setprio(1); _Pragma("unroll") for (int m = 0; m < 4; ++m) _Pragma("unroll") for (int n = 0; n < 2; ++n) _Pragma("unroll") for (int k = 0; k < 2; ++k) \
        acc[ai][bj][m][n] = __builtin_amdgcn_mfma_f32_16x16x32_bf16(Bt[n][k], At[m][k], acc[ai][bj][m][n], 0, 0, 0); __builtin_amdgcn_s_setprio(0); } while (0)
#define PG8_WAIT_V(n) asm volatile("s_waitcnt vmcnt(" #n ")" ::: "memory")
#define PG8_WAIT_L(n) asm volatile("s_waitcnt lgkmcnt(" #n ")" ::: "memory")
#define PG8_BAR __builtin_amdgcn_s_barrier()
#define PG8_SCHED __builtin_amdgcn_sched_barrier(0)
    Unit cur, nxt; int ui = 0;
    if (!S.next(0, cur)) return;
    f32x4 acc[2][2][4][2];
#pragma unroll
    for (int a = 0; a < 2; ++a)
#pragma unroll
        for (int b = 0; b < 2; ++b)
#pragma unroll
            for (int m = 0; m < 4; ++m)
#pragma unroll
                for (int n = 0; n < 2; ++n) acc[a][b][m][n] = (f32x4){0.f, 0.f, 0.f, 0.f};
    bf16x8 At[4][2], B0[2][2], B1[2][2];
    const char* cA = cur.pa; const char* cB = cur.pb;
    PG8_STAGE(PG8_SB(0, 0), cB, voffB); PG8_STAGE(PG8_SB(0, 1), cB + hstepB, voffB); PG8_STAGE(PG8_SA(0, 0), cA, voffA); PG8_STAGE(PG8_SA(0, 1), cA + hstepA, voffA);
    if (wr == 1) PG8_BAR;
    PG8_WAIT_V(2); PG8_BAR;
    PG8_STAGE(PG8_SB(1, 0), cB + kstep, voffB); PG8_STAGE(PG8_SA(1, 0), cA + kstep, voffA); PG8_STAGE(PG8_SB(1, 1), cB + hstepB + kstep, voffB);
    PG8_WAIT_V(6); PG8_BAR;
    for (;;) {
        const bool has_next = S.next(ui + 1, nxt);
        const char* nA = has_next ? nxt.pa : cA; const char* nB = has_next ? nxt.pb : cB;
#pragma unroll 1
        for (int t = 0; t < nt; t += 2) {
            const bool last = (t == nt - 2);
            const char* a1 = cA + (size_t)(t + 1) * kstep;
            const char* a2 = last ? nA : cA + (size_t)(t + 2) * kstep; const char* b2 = last ? nB : cB + (size_t)(t + 2) * kstep;
            const char* a3 = a2 + kstep; const char* b3 = b2 + kstep;
            PG8_LDB(B0, 0, 0); PG8_LDB(B1, 0, 1); PG8_SCHED; PG8_LDA(At, 0, 0); PG8_STAGE(PG8_SA(1, 1), a1 + hstepA, voffA);
            PG8_WAIT_V(8); PG8_WAIT_L(0); PG8_BAR; PG8_MMA(0, 0, At, B0); PG8_MMA(0, 1, At, B1); PG8_BAR; PG8_SCHED;
            PG8_LDA(At, 0, 1); PG8_STAGE(PG8_SB(0, 0), b2, voffB); PG8_STAGE(PG8_SB(0, 1), b2 + hstepB, voffB); PG8_STAGE(PG8_SA(0, 0), a2, voffA);
            PG8_WAIT_V(8); PG8_WAIT_L(0); PG8_BAR; PG8_MMA(1, 0, At, B0); PG8_MMA(1, 1, At, B1); PG8_BAR; PG8_SCHED;
            PG8_LDB(B0, 1, 0); PG8_LDB(B1, 1, 1); PG8_SCHED; PG8_LDA(At, 1, 0); PG8_STAGE(PG8_SA(0, 1), a2 + hstepA, voffA);
            PG8_WAIT_V(8); PG8_WAIT_L(0); PG8_BAR; PG8_MMA(0, 0, At, B0); PG8_MMA(0, 1, At, B1); PG8_BAR; PG8_SCHED;
            PG8_LDA(At, 1, 1); PG8_STAGE(PG8_SB(1, 0), b3, voffB); PG8_STAGE(PG8_SB(1, 1), b3 + hstepB, voffB); PG8_STAGE(PG8_SA(1, 0), a3, voffA);
            PG8_WAIT_V(8); PG8_WAIT_L(0); PG8_BAR; PG8_MMA(1, 0, At, B0); PG8_MMA(1, 1, At, B1); PG8_BAR; PG8_SCHED;
        }
        if (wr == 0) PG8_BAR;
        E(acc, cur, wr, wc, fr, fq, lds);
        if (!has_next) break;
#pragma unroll
        for (int a = 0; a < 2; ++a)
#pragma unroll
            for (int b = 0; b < 2; ++b)
#pragma unroll
                for (int m = 0; m < 4; ++m)
#pragma unroll
                    for (int n = 0; n < 2; ++n) acc[a][b][m][n] = (f32x4){0.f, 0.f, 0.f, 0.f};
        cur = nxt; cA = nA; cB = nB; ++ui;
        if (wr == 1) PG8_BAR;
    }
    PG8_WAIT_V(0);
    PG8_BAR;
#undef PG8_SA
#undef PG8_SB
#undef PG8_STAGE
#undef PG8_LDA
#undef PG8_LDB
#undef PG8_MMA
#undef PG8_WAIT_V
#undef PG8_WAIT_L
#undef PG8_BAR
#undef PG8_SCHED
}
}
using pg8::Unit;

DI void store8(bf16* p, const f32x4 v0, const f32x4 v1) {
    u32x4 w; w.x = pk2(v0[0], v0[1]); w.y = pk2(v0[2], v0[3]); w.z = pk2(v1[0], v1[1]); w.w = pk2(v1[2], v1[3]);
    *(u32x4*)p = w;
}
#define EPI_ARGS f32x4 (&acc)[2][2][4][2], const Unit& u, int wr, int wc, int fr, int fq, LAS unsigned char* lds

template <int ACT> struct EpiRowScale {
    static constexpr bool PERM = true;
    bf16* O; int ldc; const float* rs;
    DI void operator()(EPI_ARGS) const {
        const int row0 = u.pm * 256 + wr * 64 + fr, col0 = u.pn * 256 + wc * 32 + 8 * fq;
#pragma unroll
        for (int ai = 0; ai < 2; ++ai)
#pragma unroll
            for (int m = 0; m < 4; ++m) {
                const int row = row0 + ai * 128 + m * 16; const float s = rs ? rs[row] : 1.0f;
                bf16* rowp = O + (size_t)row * ldc + col0;
#pragma unroll
                for (int bj = 0; bj < 2; ++bj) { f32x4 v0 = acc[ai][bj][m][0] * s, v1 = acc[ai][bj][m][1] * s;
                    if (ACT == 2) {
#pragma unroll
                        for (int j = 0; j < 4; ++j) { float a = fmaxf(v0[j], 0.f), b = fmaxf(v1[j], 0.f); v0[j] = a * a; v1[j] = b * b; } }
                    store8(rowp + bj * 128, v0, v1); }
            }
    }
};
struct EpiInProj {
    static constexpr bool PERM = true;
    bf16* GLU; bf16* QK; const float* rs;
    DI void operator()(EPI_ARGS) const {
        const int row0 = u.pm * 256 + wr * 64 + fr;
        if (u.pn < 4) {
            const int col0 = u.pn * 128 + wc * 32 + 8 * fq;
#pragma unroll
            for (int ai = 0; ai < 2; ++ai)
#pragma unroll
                for (int m = 0; m < 4; ++m) {
                    const int row = row0 + ai * 128 + m * 16; const float s = rs[row];
                    f32x4 o0, o1;
#pragma unroll
                    for (int j = 0; j < 4; ++j) { o0[j] = acc[ai][0][m][0][j] * s * sigmoidf_(acc[ai][1][m][0][j] * s); o1[j] = acc[ai][0][m][1][j] * s * sigmoidf_(acc[ai][1][m][1][j] * s); }
                    store8(GLU + (size_t)row * 512 + col0, o0, o1);
                }
        } else {
            const int col0 = (u.pn - 4) * 256 + wc * 32 + 8 * fq;
#pragma unroll
            for (int ai = 0; ai < 2; ++ai)
#pragma unroll
                for (int m = 0; m < 4; ++m) {
                    const int row = row0 + ai * 128 + m * 16; const float s = rs[row];
#pragma unroll
                    for (int bj = 0; bj < 2; ++bj) store8(QK + (size_t)row * 1024 + col0 + bj * 128, acc[ai][bj][m][0] * s, acc[ai][bj][m][1] * s);
                }
        }
    }
};
struct EpiVT {
    static constexpr bool PERM = true;
    bf16* O; const float* cs;
    DI void operator()(EPI_ARGS) const {
        const int row0 = u.pm * 256 + wr * 64 + fr, col0 = u.pn * 256 + wc * 32 + 8 * fq;
        f32x4 c[2][2];
#pragma unroll
        for (int bj = 0; bj < 2; ++bj) { c[bj][0] = *(const f32x4*)(cs + col0 + bj * 128); c[bj][1] = *(const f32x4*)(cs + col0 + bj * 128 + 4); }
#pragma unroll
        for (int ai = 0; ai < 2; ++ai)
#pragma unroll
            for (int m = 0; m < 4; ++m) {
                const int row = row0 + ai * 128 + m * 16;
#pragma unroll
                for (int bj = 0; bj < 2; ++bj) store8(O + (size_t)row * M + col0 + bj * 128, acc[ai][bj][m][0] * c[bj][0], acc[ai][bj][m][1] * c[bj][1]);
            }
    }
};
struct EpiPre {
    static constexpr bool PERM = true;
    bf16* base0;
    DI void operator()(EPI_ARGS) const {
        bf16* O = base0 + (size_t)((u.z >> 30) & 1) * (52u << 20) + (size_t)(u.z & 0x3fffffff);
        const int row0 = wr * 64 + fr, col0 = wc * 32 + 8 * fq;
#pragma unroll
        for (int ai = 0; ai < 2; ++ai)
#pragma unroll
            for (int m = 0; m < 4; ++m) {
                const int row = row0 + ai * 128 + m * 16;
#pragma unroll
                for (int bj = 0; bj < 2; ++bj) store8(O + (size_t)row * 1024 + col0 + bj * 128, acc[ai][bj][m][0], acc[ai][bj][m][1]);
            }
    }
};
struct EpiResid {
    static constexpr bool PERM = false;
    const float* resid; float* out;
    DI void operator()(EPI_ARGS) const {
        const int row0 = u.pm * 256 + wr * 64 + fr, col0 = u.pn * 256 + wc * 32 + 4 * fq;
#pragma unroll
        for (int ai = 0; ai < 2; ++ai)
#pragma unroll
            for (int m = 0; m < 4; ++m) {
                const size_t off = (size_t)(row0 + ai * 128 + m * 16) * D + col0;
#pragma unroll
                for (int bj = 0; bj < 2; ++bj)
#pragma unroll
                    for (int n = 0; n < 2; ++n) { const f32x4 r = *(const f32x4*)(resid + off + bj * 128 + n * 16); *(f32x4*)(out + off + bj * 128 + n * 16) = r + acc[ai][bj][m][n]; }
            }
    }
};
struct EpiSoftmax {
    static constexpr bool PERM = true;
    bf16* P; const float* rs;
    DI void operator()(EPI_ARGS) const {
        LAS f32x2* X = (LAS f32x2*)(lds + LDS_X);
        const int row0 = u.pm * 256, col0 = u.pn * 256 + wc * 32 + 8 * fq;
        float mw[2][4];
#pragma unroll
        for (int ai = 0; ai < 2; ++ai)
#pragma unroll
            for (int m = 0; m < 4; ++m) {
                const int rl = ai * 128 + wr * 64 + m * 16 + fr; const float s = rs[row0 + rl] * LOG2E;
                float mx = -3.0e38f;
#pragma unroll
                for (int bj = 0; bj < 2; ++bj)
#pragma unroll
                    for (int n = 0; n < 2; ++n) { acc[ai][bj][m][n] = acc[ai][bj][m][n] * s;
#pragma unroll
                        for (int j = 0; j < 4; ++j) mx = fmaxf(mx, acc[ai][bj][m][n][j]); }
                mx = fmaxf(mx, swz_xor<16>(mx)); mx = half_max(mx);
                float sum = 0.f;
#pragma unroll
                for (int bj = 0; bj < 2; ++bj)
#pragma unroll
                    for (int n = 0; n < 2; ++n)
#pragma unroll
                        for (int j = 0; j < 4; ++j) { const float p = fexp2(acc[ai][bj][m][n][j] - mx); acc[ai][bj][m][n][j] = p; sum += p; }
                sum += swz_xor<16>(sum); sum = half_sum(sum);
                mw[ai][m] = mx;
                if (fq == 0) X[rl * 4 + wc] = (f32x2){mx, sum};
            }
        asm volatile("s_waitcnt lgkmcnt(0)" ::: "memory"); __builtin_amdgcn_s_barrier(); asm volatile("" ::: "memory");
#pragma unroll
        for (int ai = 0; ai < 2; ++ai)
#pragma unroll
            for (int m = 0; m < 4; ++m) {
                const int rl = ai * 128 + wr * 64 + m * 16 + fr;
                const f32x2 a = X[rl * 4 + 0], b = X[rl * 4 + 1], c = X[rl * 4 + 2], d = X[rl * 4 + 3];
                const float mt = fmaxf(fmaxf(a.x, b.x), fmaxf(c.x, d.x));
                const float lt = a.y * fexp2(a.x - mt) + b.y * fexp2(b.x - mt) + c.y * fexp2(c.x - mt) + d.y * fexp2(d.x - mt);
                const float f = fexp2(mw[ai][m] - mt) / lt;
                bf16* rowp = P + (size_t)(row0 + rl) * 1024 + col0;
#pragma unroll
                for (int bj = 0; bj < 2; ++bj) store8(rowp + bj * 128, acc[ai][bj][m][0] * f, acc[ai][bj][m][1] * f);
            }
        asm volatile("s_waitcnt lgkmcnt(0)" ::: "memory"); __builtin_amdgcn_s_barrier(); asm volatile("" ::: "memory");
    }
};
struct EpiRwkv {
    static constexpr bool PERM = true;
    bf16* R; bf16* Kk; bf16* V; bf16* HD1; bf16* HD2;
    DI void operator()(EPI_ARGS) const {
        const int row0 = u.pm * 256 + wr * 64 + fr; const int g = u.pn >> 2;
        bf16* O; int ldc, colt, mode0 = 0, mode1 = 0;
        if (u.pn < 12) { O = R + (size_t)g * (32u << 20); ldc = 1024; colt = (u.pn & 3) * 256; }
        else if (u.pn == 12) { O = HD1; ldc = 256; colt = 0; mode0 = 1; }
        else { O = HD2; ldc = 256; colt = 0; mode0 = 2; mode1 = 2; }
        const int col0 = colt + wc * 32 + 8 * fq;
#pragma unroll
        for (int ai = 0; ai < 2; ++ai)
#pragma unroll
            for (int m = 0; m < 4; ++m) {
                bf16* rowp = O + (size_t)(row0 + ai * 128 + m * 16) * ldc + col0;
#pragma unroll
                for (int bj = 0; bj < 2; ++bj) { f32x4 v0 = acc[ai][bj][m][0], v1 = acc[ai][bj][m][1]; const int md = bj ? mode1 : mode0;
                    if (md == 1) {
#pragma unroll
                        for (int j = 0; j < 4; ++j) { v0[j] = tanhf_(v0[j]); v1[j] = tanhf_(v1[j]); } }
                    else if (md == 2) {
#pragma unroll
                        for (int j = 0; j < 4; ++j) { v0[j] = sigmoidf_(v0[j]); v1[j] = sigmoidf_(v1[j]); } }
                    store8(rowp + bj * 128, v0, v1); }
            }
    }
};

enum InIdx { I_X = 0, I_MEM, I_REL, I_NMIX, I_NXATTN, I_NMEM, I_NFFN, I_NFINAL, I_WIN, I_WOUT, I_CONVW, I_CONVB, I_CLNG, I_CLNB, I_LQ1, I_LK1, I_LQ2, I_LK2, I_SUBLN,
             I_MU, I_WR, I_WK, I_WV, I_WO, I_W0, I_W1, I_W2, I_A0, I_A1, I_A2, I_G1, I_G2, I_KK, I_KA, I_RK, I_LNG, I_LNB, I_XQ, I_XKV, I_XO, I_UP, I_DN, N_IN };
struct Args { const float* in[N_IN]; float* out; unsigned char* ws; int ph_lo, ph_hi; };
static_assert(sizeof(Args) == (N_IN + 2) * 8 + 8, "Args has no padding");

struct Frame {
    LAS unsigned char* lds;
    int tid, lane, wave, gw, ngw;
    unsigned char* ws;
};

DI Frame fresh(const Frame& F0) {
    Frame F = F0; F.tid = opaque(threadIdx.x); F.lane = F.tid & 63; F.wave = __builtin_amdgcn_readfirstlane(F.tid >> 6); F.gw = opq(blockIdx.x) * 8 + F.wave; F.ngw = opq(gridDim.x) * 8; return F;
}
struct TJob { const float* W; int K, N; bf16* WT; int ldt, row_off, col_off, perm; const float* gain; };
DI void tr_item(const TJob& J, LAS float* scr, int item, int lane) {
    const int nblk = J.N / 32, kb = item / nblk, nb = item % nblk, k0 = 64 * kb, n0 = 32 * nb;
    float scale = 1.0f; int drow = J.row_off + n0;
    if (J.perm) {
        if (n0 < 512) drow = 256 * (n0 >> 7) + (n0 & 127);
        else if (n0 < 1024) drow = 256 * ((n0 - 512) >> 7) + 128 + ((n0 - 512) & 127);
        else drow = n0;
        if (n0 >= 1024 && n0 < 1536) scale = 0.125f;
    }
#pragma unroll 8
    for (int i = 0; i < 32; ++i) { const int kk = 2 * i + (lane >> 5); float v = J.W[(size_t)(k0 + kk) * J.N + n0 + (lane & 31)]; if (J.gain) v *= J.gain[k0 + kk]; scr[kk * 33 + (lane & 31)] = v * scale; }
    asm volatile("s_waitcnt lgkmcnt(0)" ::: "memory");
    const int c = lane & 7;
#pragma unroll
    for (int j = 0; j < 4; ++j) { const int n = (lane >> 3) + 8 * j; const LAS float* s = scr + (8 * c) * 33 + n;
        u32x4 o; o.x = pk2(s[0 * 33], s[1 * 33]); o.y = pk2(s[2 * 33], s[3 * 33]); o.z = pk2(s[4 * 33], s[5 * 33]); o.w = pk2(s[6 * 33], s[7 * 33]);
        *(u32x4*)(J.WT + (size_t)(drow + n) * J.ldt + J.col_off + k0 + 8 * c) = o; }
    asm volatile("s_waitcnt lgkmcnt(0)" ::: "memory");
}
constexpr int N_TJOBS = 31;
DI TJob get_tjob(int j, const Args& a, unsigned char* ws) {
    TJob J; J.perm = 0; J.gain = nullptr; J.row_off = 0; J.col_off = 0;
    if (j == 0) { J.W = a.in[opq(I_WIN)]; J.K = 1024; J.N = 2560; J.WT = (bf16*)(ws + WS_WIN); J.ldt = 1024; J.perm = 1; J.gain = a.in[opq(I_NMIX)]; }
    else if (j == 1) { J.W = a.in[opq(I_WOUT)]; J.K = 1024; J.N = 1024; J.WT = (bf16*)(ws + WS_WOUT); J.ldt = 1024; }
    else if (j < 4) { const int i = j - 2; J.W = a.in[opq(I_XKV)] + (size_t)i * 1024 * 2048; J.K = 1024; J.N = 2048; J.WT = (bf16*)(ws + WS_WKV) + (size_t)i * 2048 * 1024; J.ldt = 1024; J.gain = a.in[opq(I_NMEM)] + i * 1024; }
    else if (j < 6) { const int i = j - 4; J.W = a.in[opq(I_XO)] + (size_t)i * 1024 * 1024; J.K = 1024; J.N = 1024; J.WT = (bf16*)(ws + WS_WXO) + (size_t)i * 1024 * 1024; J.ldt = 1024; }
    else if (j < 8) { const int i = j - 6; J.W = a.in[opq(I_UP)] + (size_t)i * 1024 * 4096; J.K = 1024; J.N = 4096; J.WT = (bf16*)(ws + WS_WUP) + (size_t)i * 4096 * 1024; J.ldt = 1024; J.gain = a.in[opq(I_NFFN)] + i * 1024; }
    else if (j < 10) { const int i = j - 8; J.W = a.in[opq(I_DN)] + (size_t)i * 4096 * 1024; J.K = 4096; J.N = 1024; J.WT = (bf16*)(ws + WS_WDN) + (size_t)i * 1024 * 4096; J.ldt = 4096; }
    else if (j < 26) {
        const int q = j - 10, src = q >> 1, copy = q & 1; int mu = 0;
        J.K = 1024; J.WT = (bf16*)(ws + WS_WBIG); J.ldt = 2048; J.col_off = copy * 1024;
        if (src == 0) { J.W = a.in[opq(I_WR)]; J.N = 1024; J.row_off = 0; mu = 0; }
        else if (src == 1) { J.W = a.in[opq(I_WK)]; J.N = 1024; J.row_off = 1024; mu = 2; }
        else if (src == 2) { J.W = a.in[opq(I_WV)]; J.N = 1024; J.row_off = 2048; mu = 3; }
        else if (src == 3) { J.W = a.in[opq(I_W1)]; J.N = 64; J.row_off = 3072; mu = 1; }
        else if (src == 4) { J.W = a.in[opq(I_W1)] + 1024 * 64; J.N = 64; J.row_off = 3136; mu = 1; }
        else if (src == 5) { J.W = a.in[opq(I_A1)]; J.N = 64; J.row_off = 3200; mu = 4; }
        else if (src == 6) { J.W = a.in[opq(I_A1)] + 1024 * 64; J.N = 64; J.row_off = 3264; mu = 4; }
        else { J.W = a.in[opq(I_G1)]; J.N = 160; J.row_off = 3328; mu = 5; }
        if (copy) J.gain = a.in[opq(I_MU)] + mu * 1024;
    }
    else if (j < 30) { const int q = j - 26; J.W = (q < 2 ? a.in[opq(I_W2)] : a.in[opq(I_A2)]) + (size_t)(q & 1) * 64 * 1024; J.K = 64; J.N = 1024; J.WT = (bf16*)(ws + WS_W2T) + (size_t)q * 1024 * 64; J.ldt = 64; }
    else { J.W = a.in[opq(I_WO)]; J.K = 1024; J.N = 1024; J.WT = (bf16*)(ws + WS_WRO); J.ldt = 1024; }
    return J;
}
DI void row_to_bf16_rs(const float* xrow, bf16* orow, float* rs, int lane) {
    const f32x4* xr = (const f32x4*)xrow + lane;
    f32x4 v[4]; float s = 0.f;
#pragma unroll
    for (int j = 0; j < 4; ++j) { v[j] = xr[64 * j]; s += (v[j].x * v[j].x + v[j].y * v[j].y) + (v[j].z * v[j].z + v[j].w * v[j].w); }
    s = wave_sum(s);
    u32x2* o8 = (u32x2*)orow + lane;
#pragma unroll
    for (int j = 0; j < 4; ++j) { u32x2 w; w.x = pk2(v[j].x, v[j].y); w.y = pk2(v[j].z, v[j].w); o8[64 * j] = w; }
    if (lane == 0) *rs = 1.0f / sqrtf(s * (1.0f / D) + EPS);
}
DI int t5_bucket(int rel) {
    const int n = rel < 0 ? -rel : rel; int r = rel > 0 ? 16 : 0;
    if (n < 8) return r + n;
    int lg = 8; lg += (n >= 12); lg += (n >= 16); lg += (n >= 23); lg += (n >= 32); lg += (n >= 46); lg += (n >= 64); lg += (n >= 91);
    return r + lg;
}
DI void phase_prologue(const Frame& F0, const Args& a, unsigned char* ws) {
    const Frame F = fresh(F0);
    LAS float* scr = (LAS float*)(F.lds + F.wave * 16384);
    for (int j = 0; j < N_TJOBS; ++j) {
        const TJob J = get_tjob(j, a, ws); const int items = (J.K / 64) * (J.N / 32);
        for (int it = F.gw; it < items; it += F.ngw) tr_item(J, scr, it, F.lane);
    }
    const int gt = F.gw * 64 + F.lane, ngt = F.ngw * 64;
    for (int i = 0; i < 2; ++i) {
        const float* W = a.in[opq(I_XQ)] + (size_t)i * 1024 * 1024; const float* g = a.in[opq(I_NXATTN)] + i * 1024; bf16* O = (bf16*)(ws + WS_WQN) + (size_t)i * 1024 * 1024;
        for (int e = gt; e < 1024 * 1024 / 4; e += ngt) { const f32x4 v = ((const f32x4*)W)[e]; const float s = g[(e * 4) >> 10] * 0.0625f; u32x2 w; w.x = pk2(v.x * s, v.y * s); w.y = pk2(v.z * s, v.w * s); ((u32x2*)O)[e] = w; }
    }
    { const float* W = a.in[opq(I_G2)]; bf16* O = (bf16*)(ws + WS_G2T);
      for (int e = gt; e < 1024 * 256; e += ngt) { const int n = e >> 8, k = e & 255; O[e] = (bf16)(k < 160 ? f2bf(W[(size_t)k * 1024 + n]) : 0u); } }
    { u32x4* O = (u32x4*)((bf16*)(ws + WS_WBIG) + (size_t)3488 * 2048);
      for (int e = gt; e < 96 * 2048 * 2 / 16; e += ngt) O[e] = (u32x4){0u, 0u, 0u, 0u}; }
    for (int m = F.gw; m < M; m += F.ngw) row_to_bf16_rs(a.in[opq(I_X)] + (size_t)m * D, (bf16*)(ws + WS_SA) + (size_t)m * D, (float*)(ws + WS_RS) + m, F.lane);
    for (int m = F.gw; m < MMEM; m += F.ngw) row_to_bf16_rs(a.in[opq(I_MEM)] + (size_t)m * D, (bf16*)(ws + WS_MEMB) + (size_t)m * D, (float*)(ws + WS_RSMEM) + m, F.lane);
    { float* B = (float*)(ws + WS_BIAS); const float* tab = a.in[opq(I_REL)];
      for (int e = gt; e < 4 * 4096; e += ngt) { const int h = e >> 12, idx = e & 4095; const int rel = idx - 2047; B[e] = idx < 4095 ? tab[t5_bucket(rel) * 4 + h] * LOG2E : 0.f; } }
    if (F.gw == 0) {
        const float q1 = a.in[opq(I_LQ1)][F.lane] * a.in[opq(I_LK1)][F.lane], q2 = a.in[opq(I_LQ2)][F.lane] * a.in[opq(I_LK2)][F.lane];
        const float s1 = wave_sum(q1), s2 = wave_sum(q2);
        if (F.lane == 0) ((float*)(ws + WS_LAM))[0] = expf(s1) - expf(s2) + 0.2f;
    }
}

DI void phase_norm(const Frame& F0, const float* h, bf16* hb, float* rs) {
    const Frame F = fresh(F0);
    for (int m = F.gw; m < M; m += F.ngw) row_to_bf16_rs(h + (size_t)m * D, hb + (size_t)m * D, rs + m, F.lane);
}
DI void phase_final_norm(const Frame& F0, float* h, const float* g) {
    const Frame F = fresh(F0);
    f32x4 gv[4];
#pragma unroll
    for (int j = 0; j < 4; ++j) gv[j] = ((const f32x4*)g)[F.lane + 64 * j];
    for (int m = F.gw; m < M; m += F.ngw) {
        f32x4* xr = (f32x4*)(h + (size_t)m * D) + F.lane;
        f32x4 v[4]; float s = 0.f;
#pragma unroll
        for (int j = 0; j < 4; ++j) { v[j] = xr[64 * j]; s += (v[j].x * v[j].x + v[j].y * v[j].y) + (v[j].z * v[j].z + v[j].w * v[j].w); }
        const float r = 1.0f / sqrtf(wave_sum(s) * (1.0f / D) + EPS);
#pragma unroll
        for (int j = 0; j < 4; ++j) xr[64 * j] = v[j] * r * gv[j];
    }
}
DI void phase_rwkv_shift(const Frame& F0, const float* h, const float* g, bf16* A1) {
    const Frame F = fresh(F0);
    f32x4 gv[4];
#pragma unroll
    for (int j = 0; j < 4; ++j) gv[j] = ((const f32x4*)g)[F.lane + 64 * j];
    for (int ch = F.gw; ch < M / 16; ch += F.ngw) {
        const int m0 = ch * 16, t0 = m0 & (T - 1);
        f32x4 p2[4], p1[4], cu[4];
#pragma unroll
        for (int j = 0; j < 4; ++j) { p2[j] = (f32x4){0.f, 0.f, 0.f, 0.f}; p1[j] = p2[j]; cu[j] = p2[j]; }
        for (int i = -1; i <= 16; ++i) {
            const int t = t0 + i;
#pragma unroll
            for (int j = 0; j < 4; ++j) { p2[j] = p1[j]; p1[j] = cu[j]; }
            if (t >= 0 && t < T) {
                const f32x4* xr = (const f32x4*)(h + (size_t)(m0 + i) * D) + F.lane; float s = 0.f;
#pragma unroll
                for (int j = 0; j < 4; ++j) { cu[j] = xr[64 * j]; s += (cu[j].x * cu[j].x + cu[j].y * cu[j].y) + (cu[j].z * cu[j].z + cu[j].w * cu[j].w); }
                const float r = 1.0f / sqrtf(wave_sum(s) * (1.0f / D) + EPS);
#pragma unroll
                for (int j = 0; j < 4; ++j) cu[j] = cu[j] * r * gv[j];
            } else {
#pragma unroll
                for (int j = 0; j < 4; ++j) cu[j] = (f32x4){0.f, 0.f, 0.f, 0.f};
            }
            if (i >= 1) {
                u32x2* o = (u32x2*)(A1 + (size_t)(m0 + i - 1) * 2048) + F.lane;
#pragma unroll
                for (int j = 0; j < 4; ++j) { const f32x4 hh = (p2[j] + cu[j]) * 0.5f - p1[j];
                    u32x2 w; w.x = pk2(p1[j].x, p1[j].y); w.y = pk2(p1[j].z, p1[j].w); o[64 * j] = w;
                    u32x2 w2; w2.x = pk2(hh.x, hh.y); w2.y = pk2(hh.z, hh.w); o[256 + 64 * j] = w2; }
            }
        }
    }
}
DI void phase_rwkv_comb(const Frame& F0, const bf16* YF, const bf16* YB, const bf16* V, const bf16* GT, const float* BON, const float* lng, const float* lnb, bf16* O) {
    const Frame F = fresh(F0);
    const int hd = F.lane >> 2, c0 = F.lane * 16;
    float lg[16], lb[16];
#pragma unroll
    for (int j = 0; j < 16; ++j) { lg[j] = lng[c0 + j]; lb[j] = lnb[c0 + j]; }
    for (int m = F.gw; m < M; m += F.ngw) {
        const size_t off = (size_t)m * D + c0;
        u32x4 a[2], b[2], vv[2], gg[2];
#pragma unroll
        for (int q = 0; q < 2; ++q) { a[q] = ((const u32x4*)(YF + off))[q]; b[q] = ((const u32x4*)(YB + off))[q]; vv[q] = ((const u32x4*)(V + off))[q]; gg[q] = ((const u32x4*)(GT + off))[q]; }
        const float bon = BON[(size_t)m * 16 + hd] + BON[(size_t)(M + m) * 16 + hd];
        float y[16]; float s = 0.f;
#pragma unroll
        for (int q = 0; q < 2; ++q)
#pragma unroll
            for (int w = 0; w < 4; ++w) { y[q * 8 + 2 * w] = bflo(a[q][w]) + bflo(b[q][w]); y[q * 8 + 2 * w + 1] = bfhi(a[q][w]) + bfhi(b[q][w]); }
#pragma unroll
        for (int j = 0; j < 16; ++j) s += y[j];
        s += swz_xor<1>(s); s += swz_xor<2>(s);
        const float mean = s * (1.0f / 64.0f); float q2 = 0.f;
#pragma unroll
        for (int j = 0; j < 16; ++j) { y[j] -= mean; q2 += y[j] * y[j]; }
        q2 += swz_xor<1>(q2); q2 += swz_xor<2>(q2);
        const float rstd = 1.0f / sqrtf(q2 * (1.0f / 64.0f) + 64e-5f);
        u32x4 o[2];
#pragma unroll
        for (int q = 0; q < 2; ++q)
#pragma unroll
            for (int w = 0; w < 4; ++w) {
                const int j = q * 8 + 2 * w;
                const float r0 = (y[j] * rstd * lg[j] + lb[j] + bon * bflo(vv[q][w])) * bflo(gg[q][w]);
                const float r1 = (y[j + 1] * rstd * lg[j + 1] + lb[j + 1] + bon * bfhi(vv[q][w])) * bfhi(gg[q][w]);
                o[q][w] = pk2(r0, r1);
            }
        ((u32x4*)(O + off))[0] = o[0]; ((u32x4*)(O + off))[1] = o[1];
    }
}

constexpr int CV_ROWB = 1040, CV_IN_BYTES = 94 * CV_ROWB, CV_W_OFF = CV_IN_BYTES;
DI void conv_load_weights(const Frame& F, const float* cw) {
    LAS bf16* W = (LAS bf16*)(F.lds + CV_W_OFF);
    for (int e = F.tid; e < 31 * 512; e += 512) W[e] = (bf16)f2bf(cw[e]);
}
DI void conv_unit(const Frame& F0, int unit, const bf16* GLU, const float* cb, const float* lg, const float* lb, bf16* MIX) {
    const Frame F = fresh(F0);
    const int b = unit >> 5, t0 = (unit & 31) * 64;
    __syncthreads();
    for (int p = F.tid; p < 94 * 64; p += 512) {
        const int r = p >> 6, c = p & 63, t = t0 - 15 + r;
        u32x4 v = (u32x4){0u, 0u, 0u, 0u};
        if (t >= 0 && t < T) v = *(const u32x4*)(GLU + (size_t)(b * T + t) * 512 + c * 8);
        *(LAS u32x4*)(F.lds + r * CV_ROWB + c * 16) = v;
    }
    __syncthreads();
    const int tl = F.tid >> 3, chunk = F.tid & 7;
    float y[64];
#pragma unroll
    for (int i = 0; i < 8; ++i) {
        const int cg = chunk + 8 * i;
        float acc[8];
#pragma unroll
        for (int e = 0; e < 8; ++e) acc[e] = cb[cg * 8 + e];
#pragma unroll 1
        for (int j = 0; j < 31; ++j) {
            const u32x4 x = *(const LAS u32x4*)(F.lds + (tl + j) * CV_ROWB + cg * 16);
            const u32x4 w = *(const LAS u32x4*)(F.lds + CV_W_OFF + j * 1024 + cg * 16);
#pragma unroll
            for (int q = 0; q < 4; ++q) { acc[2 * q] += bflo(x[q]) * bflo(w[q]); acc[2 * q + 1] += bfhi(x[q]) * bfhi(w[q]); }
        }
#pragma unroll
        for (int e = 0; e < 8; ++e) y[i * 8 + e] = acc[e];
    }
    float s = 0.f;
#pragma unroll
    for (int j = 0; j < 64; ++j) s += y[j];
    s += swz_xor<1>(s); s += swz_xor<2>(s); s += swz_xor<4>(s);
    const float mean = s * (1.0f / 512.0f); float q2 = 0.f;
#pragma unroll
    for (int j = 0; j < 64; ++j) { y[j] -= mean; q2 += y[j] * y[j]; }
    q2 += swz_xor<1>(q2); q2 += swz_xor<2>(q2); q2 += swz_xor<4>(q2);
    const float rstd = 1.0f / sqrtf(q2 * (1.0f / 512.0f) + 1e-5f);
    bf16* orow = MIX + (size_t)(b * T + t0 + tl) * 1024;
#pragma unroll
    for (int i = 0; i < 8; ++i) {
        const int c0 = (chunk + 8 * i) * 8;
        const f32x4 g0 = *(const f32x4*)(lg + c0), g1 = *(const f32x4*)(lg + c0 + 4), b0 = *(const f32x4*)(lb + c0), b1 = *(const f32x4*)(lb + c0 + 4);
        f32x4 o0, o1;
#pragma unroll
        for (int e = 0; e < 4; ++e) { const float v0 = y[i * 8 + e] * rstd * g0[e] + b0[e], v1 = y[i * 8 + 4 + e] * rstd * g1[e] + b1[e]; o0[e] = v0 * sigmoidf_(v0); o1[e] = v1 * sigmoidf_(v1); }
        store8(orow + c0, o0, o1);
    }
}

constexpr int DA_KROW = 272, DA_VROW = 136, DA_KB = 64 * DA_KROW, DA_VB = 128 * DA_VROW, DA_BUF = DA_KB + DA_VB;
DI int crow(int reg, int hf) { return (reg & 3) + 8 * (reg >> 2) + 4 * hf; }
DI void diffattn_unit(const Frame& F0, int unit, const bf16* QK, const bf16* VT, const float* BIAS, const float lam, const float* subg, bf16* MIX) {
    const Frame F = fresh(F0);
    const int b = unit >> 6, h = (unit >> 4) & 3, qb = unit & 15;
    const int c = F.wave >> 2, qs = F.wave & 3, r32 = F.lane & 31, hf = F.lane >> 5;
    const int q0w = qb * 128 + qs * 32;
    const float* bias_h = BIAS + h * 4096 + 2047;
    bf16x8 Qf[4];
    { const bf16* qp = QK + (size_t)(b * T + q0w + r32) * 1024 + h * 128 + c * 64 + 8 * hf;
#pragma unroll
      for (int ks = 0; ks < 4; ++ks) Qf[ks] = *(const bf16x8*)(qp + 16 * ks); }
    const bf16* kg[2]; const bf16* vg[2]; int kl[2], vl[2];
#pragma unroll
    for (int i = 0; i < 2; ++i) { const int p = F.tid + 512 * i;
        kg[i] = QK + (size_t)(b * T + (p >> 4)) * 1024 + 512 + h * 128 + (p & 15) * 8; kl[i] = (p >> 4) * DA_KROW + (p & 15) * 16;
        vg[i] = VT + (size_t)(h * 128 + (p >> 3)) * M + b * T + (p & 7) * 8; vl[i] = DA_KB + (p >> 3) * DA_VROW + (p & 7) * 16; }
    u32x4 kr[2], vr[2];
#pragma unroll
    for (int i = 0; i < 2; ++i) { kr[i] = *(const u32x4*)(kg[i]); vr[i] = *(const u32x4*)(vg[i]); }
    __syncthreads();
#pragma unroll
    for (int i = 0; i < 2; ++i) { *(LAS u32x4*)(F.lds + kl[i]) = kr[i]; *(LAS u32x2*)(F.lds + vl[i]) = (u32x2){vr[i].x, vr[i].y}; *(LAS u32x2*)(F.lds + vl[i] + 8) = (u32x2){vr[i].z, vr[i].w}; }
    __syncthreads();
    f32x16 O[4];
#pragma unroll
    for (int vt = 0; vt < 4; ++vt)
#pragma unroll
        for (int i = 0; i < 16; ++i) O[vt][i] = 0.f;
    float lsum = 0.f;
    const int ka = r32 * DA_KROW + c * 128 + 16 * hf;
    const int va = DA_KB + r32 * DA_VROW + 8 * hf;
    for (int kt = 0; kt < 32; ++kt) {
        const int k0 = kt * 64;
        LAS unsigned char* buf = F.lds + (kt & 1) * DA_BUF;
        if (kt + 1 < 32) {
#pragma unroll
            for (int i = 0; i < 2; ++i) { kr[i] = *(const u32x4*)(kg[i] + (size_t)(k0 + 64) * 1024); vr[i] = *(const u32x4*)(vg[i] + k0 + 64); }
        }
        const int dmin = k0 - (q0w + 31), dmax = k0 + 63 - q0w;
        const bool far = (dmin >= 91) || (dmax <= -91);
        const float cb = dmin >= 91 ? bias_h[91] : bias_h[-91];
#pragma unroll
        for (int sub = 0; sub < 2; ++sub) {
            f32x16 S;
#pragma unroll
            for (int i = 0; i < 16; ++i) S[i] = 0.f;
#pragma unroll
            for (int ks = 0; ks < 4; ++ks) { const bf16x8 a = *(const LAS bf16x8*)(buf + ka + sub * 32 * DA_KROW + ks * 32); S = __builtin_amdgcn_mfma_f32_32x32x16_bf16(a, Qf[ks], S, 0, 0, 0); }
            float p[16];
            if (far) {
#pragma unroll
                for (int i = 0; i < 16; ++i) p[i] = fexp2(S[i] * LOG2E + cb);
            } else {
                const int rel0 = k0 + 32 * sub - (q0w + r32);
#pragma unroll
                for (int i = 0; i < 16; ++i) p[i] = fexp2(S[i] * LOG2E + bias_h[rel0 + crow(i, hf)]);
            }
#pragma unroll
            for (int i = 0; i < 16; ++i) lsum += p[i];
#pragma unroll
            for (int s = 0; s < 2; ++s) {
                u32x4 pw; pw.x = pk2(p[8 * s], p[8 * s + 1]); pw.y = pk2(p[8 * s + 2], p[8 * s + 3]); pw.z = pk2(p[8 * s + 4], p[8 * s + 5]); pw.w = pk2(p[8 * s + 6], p[8 * s + 7]);
                const bf16x8 pa = __builtin_bit_cast(bf16x8, pw);
#pragma unroll
                for (int vt = 0; vt < 4; ++vt) {
                    const LAS unsigned char* vp = buf + va + vt * 32 * DA_VROW + (32 * sub + 16 * s) * 2;
                    const u32x2 lo = *(const LAS u32x2*)(vp), hi = *(const LAS u32x2*)(vp + 16);
                    const u32x4 vw = (u32x4){lo.x, lo.y, hi.x, hi.y};
                    O[vt] = __builtin_amdgcn_mfma_f32_32x32x16_bf16(pa, __builtin_bit_cast(bf16x8, vw), O[vt], 0, 0, 0);
                }
            }
        }
        if (kt + 1 < 32) {
            LAS unsigned char* nb = F.lds + ((kt + 1) & 1) * DA_BUF;
#pragma unroll
            for (int i = 0; i < 2; ++i) { *(LAS u32x4*)(nb + kl[i]) = kr[i]; *(LAS u32x2*)(nb + vl[i]) = (u32x2){vr[i].x, vr[i].y}; *(LAS u32x2*)(nb + vl[i] + 8) = (u32x2){vr[i].z, vr[i].w}; }
        }
        __syncthreads();
    }
    lsum = half_sum(lsum);
    LAS float* XO = (LAS float*)F.lds;
    LAS float* LW = (LAS float*)(F.lds + 65536) + F.wave * 32;
    if (hf == 0) LW[r32] = 1.0f / lsum;
    asm volatile("s_waitcnt lgkmcnt(0)" ::: "memory");
    float il[16];
#pragma unroll
    for (int i = 0; i < 16; ++i) il[i] = LW[crow(i, hf)];
    if (c == 1) {
#pragma unroll
        for (int vt = 0; vt < 4; ++vt)
#pragma unroll
            for (int i = 0; i < 16; ++i) XO[(qs * 32 + crow(i, hf)) * 128 + vt * 32 + r32] = O[vt][i] * il[i];
    }
    __syncthreads();
    if (c == 0) {
        float ss[16];
#pragma unroll
        for (int i = 0; i < 16; ++i) ss[i] = 0.f;
#pragma unroll
        for (int vt = 0; vt < 4; ++vt)
#pragma unroll
            for (int i = 0; i < 16; ++i) { const float o = O[vt][i] * il[i] - lam * XO[(qs * 32 + crow(i, hf)) * 128 + vt * 32 + r32]; O[vt][i] = o; ss[i] += o * o; }
#pragma unroll
        for (int i = 0; i < 16; ++i) { float v = ss[i]; v += swz_xor<1>(v); v += swz_xor<2>(v); v += swz_xor<4>(v); v += swz_xor<8>(v); v += swz_xor<16>(v); ss[i] = 0.8f / sqrtf(v * (1.0f / 128.0f) + EPS); }
#pragma unroll
        for (int vt = 0; vt < 4; ++vt) {
            const float g = subg[vt * 32 + r32];
#pragma unroll
            for (int i = 0; i < 16; ++i) MIX[(size_t)(b * T + q0w + crow(i, hf)) * 1024 + 512 + h * 128 + vt * 32 + r32] = (bf16)f2bf(O[vt][i] * ss[i] * g);
        }
    }
}

constexpr int SC_VECB = 256, SC_STEPB = 6 * SC_VECB, SC_BUFB = 16 * SC_STEPB;
constexpr int SC_SCR_OFF = 4 * SC_BUFB, SC_SCR_W = 16 * 68 * 4;
DI float dpp_x1(float v) { return __builtin_bit_cast(float, __builtin_amdgcn_update_dpp(0, __builtin_bit_cast(int, v), 0xB1, 0xF, 0xF, true)); }
DI float dpp_x2(float v) { return __builtin_bit_cast(float, __builtin_amdgcn_update_dpp(0, __builtin_bit_cast(int, v), 0x4E, 0xF, 0xF, true)); }
DI float quad_sum(float v) { v += dpp_x1(v); v += dpp_x2(v); return v; }

struct ScanPtrs { const bf16 *R, *K, *V, *HD1, *W2T; const float *w0, *a0, *kk, *ka, *rk; bf16 *YF, *YB; float* BON; };

DI void scan_pair(const Frame& F0, int bh, const ScanPtrs& P) {
    const Frame F = fresh(F0);
    const int b = bh >> 4, h = bh & 15;
    __syncthreads();
    if (F.wave < 4) {
        const int z = F.wave >> 1, rh = F.wave & 1, rp = F.lane >> 2, jq = F.lane & 3, i0 = rh * 32 + 2 * rp;
        f32x2 S[16];
#pragma unroll
        for (int j = 0; j < 16; ++j) S[j] = (f32x2){0.f, 0.f};
        bf16* Y = z ? P.YB : P.YF;
        __builtin_amdgcn_s_barrier();
        for (int e = 0; e < T / 16; ++e) {
            const LAS unsigned char* base = F.lds + (z * 2 + (e & 1)) * SC_BUFB + jq * 64;
            const int t0c = z ? T - 16 * (e + 1) : 16 * e;
#pragma unroll 2
            for (int s = 0; s < 16; ++s) {
                const int li = z ? 15 - s : s;
                const LAS unsigned char* sb = base + li * SC_STEPB;
                f32x4 wv[4], kv[4], bv[4], av[4], rv[4];
#pragma unroll
                for (int q = 0; q < 4; ++q) { av[q] = *(const LAS f32x4*)(sb + 3 * SC_VECB + q * 16); wv[q] = *(const LAS f32x4*)(sb + q * 16); kv[q] = *(const LAS f32x4*)(sb + SC_VECB + q * 16);
                    bv[q] = *(const LAS f32x4*)(sb + 2 * SC_VECB + q * 16); rv[q] = *(const LAS f32x4*)(sb + 4 * SC_VECB + q * 16); }
                const f32x2 v2 = *(const LAS f32x2*)(sb - jq * 64 + 5 * SC_VECB + i0 * 4);
                f32x2 sa = (f32x2){0.f, 0.f}, sa1 = (f32x2){0.f, 0.f};
#pragma unroll
                for (int j = 0; j < 16; j += 2) { sa += S[j] * av[j >> 2][j & 3]; sa1 += S[j + 1] * av[(j + 1) >> 2][(j + 1) & 3]; }
                sa += sa1;
                sa.x = quad_sum(sa.x); sa.y = quad_sum(sa.y);
                f32x2 y = (f32x2){0.f, 0.f}, y1 = (f32x2){0.f, 0.f};
#pragma unroll
                for (int j = 0; j < 16; j += 2) {
                    S[j] = S[j] * wv[j >> 2][j & 3] + sa * bv[j >> 2][j & 3] + v2 * kv[j >> 2][j & 3];
                    S[j + 1] = S[j + 1] * wv[(j + 1) >> 2][(j + 1) & 3] + sa * bv[(j + 1) >> 2][(j + 1) & 3] + v2 * kv[(j + 1) >> 2][(j + 1) & 3];
                    y += S[j] * rv[j >> 2][j & 3]; y1 += S[j + 1] * rv[(j + 1) >> 2][(j + 1) & 3];
                }
                y += y1;
                y.x = quad_sum(y.x); y.y = quad_sum(y.y);
                if (jq == 0) *(unsigned*)(Y + (size_t)(b * T + t0c + li) * 1024 + h * 64 + i0) = pk2(y.x, y.y);
            }
            asm volatile("s_waitcnt lgkmcnt(0)" ::: "memory");
            __builtin_amdgcn_s_barrier();
        }
    } else {
        const int pw = F.wave - 4, z = pw >> 1, par = pw & 1;
        const int l15 = F.lane & 15, l4 = F.lane >> 4, row = F.lane >> 2, cq = F.lane & 3;
        const bf16* w2p = P.W2T + (size_t)z * 65536 + (size_t)(h * 64 + l15) * 64 + 8 * l4;
        const int ch0 = h * 64 + cq * 16;
        LAS float* scrW = (LAS float*)(F.lds + SC_SCR_OFF + pw * 2 * SC_SCR_W);
        LAS float* scrA = scrW + 16 * 68;
        bf16x8 Ahw[2], Aha[2]; u32x4 r16[2], k16[2], v16[2];
        auto do_load = [&](int c) {
            const int t0c = z ? T - 16 * (c + 1) : 16 * c; const size_t m0 = (size_t)b * T + t0c;
#pragma unroll
            for (int ks = 0; ks < 2; ++ks) { const bf16* p = P.HD1 + (m0 + l15) * 256 + z * 64 + 32 * ks + 8 * l4; Ahw[ks] = *(const bf16x8*)p; Aha[ks] = *(const bf16x8*)(p + 128); }
            const size_t off = (m0 + row) * 1024 + ch0;
#pragma unroll
            for (int q = 0; q < 2; ++q) { r16[q] = ((const u32x4*)(P.R + off))[q]; k16[q] = ((const u32x4*)(P.K + off))[q]; v16[q] = ((const u32x4*)(P.V + off))[q]; }
        };
        auto do_compute = [&](int c) {
            const int t0c = z ? T - 16 * (c + 1) : 16 * c; const size_t m0 = (size_t)b * T + t0c;
#pragma unroll
            for (int nt = 0; nt < 4; ++nt) {
                f32x4 dw = (f32x4){0.f, 0.f, 0.f, 0.f}, da = dw;
#pragma unroll
                for (int ks = 0; ks < 2; ++ks) { const bf16x8 wf = *(const bf16x8*)(w2p + nt * 1024 + ks * 32), af = *(const bf16x8*)(w2p + 2 * 65536 + nt * 1024 + ks * 32);
                    dw = __builtin_amdgcn_mfma_f32_16x16x32_bf16(Ahw[ks], wf, dw, 0, 0, 0); da = __builtin_amdgcn_mfma_f32_16x16x32_bf16(Aha[ks], af, da, 0, 0, 0); }
#pragma unroll
                for (int rg = 0; rg < 4; ++rg) { scrW[(4 * l4 + rg) * 68 + 16 * nt + l15] = dw[rg]; scrA[(4 * l4 + rg) * 68 + 16 * nt + l15] = da[rg]; }
            }
            asm volatile("s_waitcnt lgkmcnt(0)" ::: "memory");
            float ssq = 0.f;
#pragma unroll
            for (int q = 0; q < 2; ++q)
#pragma unroll
                for (int w = 0; w < 4; ++w) { const f32x2 kc = *(const f32x2*)(P.kk + ch0 + q * 8 + 2 * w); const float k0 = bflo(k16[q][w]) * kc.x, k1 = bfhi(k16[q][w]) * kc.y; ssq += k0 * k0 + k1 * k1; }
            ssq = quad_sum(ssq);
            const float inv = 1.0f / fmaxf(sqrtf(ssq), 1e-12f);
            float bon = 0.f;
            LAS unsigned char* sb = F.lds + (z * 2 + (c & 1)) * SC_BUFB + row * SC_STEPB + cq * 64;
#pragma unroll
            for (int q = 0; q < 4; ++q) {
                const f32x4 wp = *(const LAS f32x4*)(scrW + row * 68 + cq * 16 + q * 4), ap = *(const LAS f32x4*)(scrA + row * 68 + cq * 16 + q * 4);
                const f32x4 w0v = *(const f32x4*)(P.w0 + z * 1024 + ch0 + q * 4), a0v = *(const f32x4*)(P.a0 + z * 1024 + ch0 + q * 4);
                const f32x4 kkv = *(const f32x4*)(P.kk + ch0 + q * 4), kav = *(const f32x4*)(P.ka + ch0 + q * 4), rkv = *(const f32x4*)(P.rk + ch0 + q * 4);
                const unsigned kw0 = k16[q >> 1][(q & 1) * 2], kw1 = k16[q >> 1][(q & 1) * 2 + 1], rw0 = r16[q >> 1][(q & 1) * 2], rw1 = r16[q >> 1][(q & 1) * 2 + 1], vw0 = v16[q >> 1][(q & 1) * 2], vw1 = v16[q >> 1][(q & 1) * 2 + 1];
                const f32x4 kf = (f32x4){bflo(kw0), bfhi(kw0), bflo(kw1), bfhi(kw1)}, rf = (f32x4){bflo(rw0), bfhi(rw0), bflo(rw1), bfhi(rw1)}, vf = (f32x4){bflo(vw0), bfhi(vw0), bflo(vw1), bfhi(vw1)};
                f32x4 ow, ok, ob, oa;
#pragma unroll
                for (int j = 0; j < 4; ++j) {
                    const float dec = fexp2(-0.60653066f * LOG2E * sigmoidf_(wp[j] + w0v[j]));
                    const float ar = sigmoidf_(ap[j] + a0v[j]);
                    const float kkn = kf[j] * kkv[j] * inv;
                    const float kd = kf[j] * (1.0f + (ar - 1.0f) * kav[j]);
                    ow[j] = dec; ok[j] = kd; ob[j] = kkn * ar; oa[j] = -kkn;
                    bon += rf[j] * kd * rkv[j];
                }
                *(LAS f32x4*)(sb + q * 16) = ow; *(LAS f32x4*)(sb + SC_VECB + q * 16) = ok; *(LAS f32x4*)(sb + 2 * SC_VECB + q * 16) = ob;
                *(LAS f32x4*)(sb + 3 * SC_VECB + q * 16) = oa; *(LAS f32x4*)(sb + 4 * SC_VECB + q * 16) = rf; *(LAS f32x4*)(sb + 5 * SC_VECB + q * 16) = vf;
            }
            bon = quad_sum(bon);
            if (cq == 0) P.BON[((size_t)z * M + m0 + row) * 16 + h] = bon;
            asm volatile("s_waitcnt lgkmcnt(0)" ::: "memory");
        };
        if (par == 0) { do_load(0); do_compute(0); } else do_load(1);
        __builtin_amdgcn_s_barrier();
        for (int e = 0; e < T / 16; ++e) {
            if (((e + 1) & 1) == par) { if (e + 1 < T / 16) do_compute(e + 1); }
            else { if (e + 2 < T / 16) do_load(e + 2); }
            __builtin_amdgcn_s_barrier();
        }
    }
}


#define XB_TMO      128
#define XB_XCNT(j)  (256  + 64 * (j))
#define XB_XSUB(j)  (1280 + 64 * (j))
#define XB_XGEN(j)  (2304 + 64 * (j))
#define XB_TOP      3328
#define XB_TOPGEN   3392
#define XCD_BAR_WORDS 3456
#define XB_SPIN_CAP (1u << 22)
DI unsigned xb_ld(unsigned* p)              { return __hip_atomic_load(p, __ATOMIC_RELAXED, __HIP_MEMORY_SCOPE_AGENT); }
DI unsigned xb_add(unsigned* p, unsigned v) { return __hip_atomic_fetch_add(p, v, __ATOMIC_RELAXED, __HIP_MEMORY_SCOPE_AGENT); }
DI unsigned xb_xcc_id() { return (unsigned)__builtin_amdgcn_s_getreg((3 << 11) | 20) & 0xFu; }
#define XB_SPIN(cond, bar) do { unsigned _sp = 0; while (cond) { __builtin_amdgcn_s_sleep(1); \
    if ((++_sp & 255u) == 0u) { if (xb_ld(&(bar)[XB_TMO])) break; if (_sp > XB_SPIN_CAP) { atomicAdd(&(bar)[XB_TMO], 1u); break; } } } } while (0)
struct XcdBarrier { unsigned* bar; unsigned x; volatile LAS unsigned* st; };
DI XcdBarrier xcd_barrier_post(unsigned* bar, volatile LAS unsigned* st) {
    XcdBarrier b; b.bar = bar; b.x = xb_xcc_id(); b.st = st;
    if (threadIdx.x == 0) (void)xb_add(&bar[XB_XCNT(b.x)], 1u);
    return b;
}
DI void xcd_barrier_complete(unsigned* bar, unsigned x, unsigned& nloc, unsigned& nx) {
    const unsigned G = gridDim.x * gridDim.y * gridDim.z;
    unsigned sum, cnt, mine, sp = 0u;
    for (;;) {
        sum = 0u; cnt = 0u; mine = 0u;
#pragma unroll
        for (unsigned j = 0; j < 16; ++j) { const unsigned c = xb_ld(&bar[XB_XCNT(j)]); sum += c; cnt += (c > 0u) ? 1u : 0u; mine = (j == x) ? c : mine; }
        if (sum == G) break;
        __builtin_amdgcn_s_sleep(1);
        if ((++sp & 255u) == 0u) { if (xb_ld(&bar[XB_TMO])) break; if (sp > XB_SPIN_CAP) { atomicAdd(&bar[XB_TMO], 1u); break; } }
    }
    nloc = mine > 0u ? mine : 1u; nx = cnt > 0u ? cnt : 1u;
}
DI void xcd_barrier(const XcdBarrier& b) {
    asm volatile("s_waitcnt vmcnt(0)" ::: "memory");
    __syncthreads();
    if (threadIdx.x == 0) {
        unsigned* bar = b.bar;
        __builtin_amdgcn_s_waitcnt(0);
        unsigned nloc = b.st[0], nx = b.st[1];
        if (nloc == 0u) { xcd_barrier_complete(bar, b.x, nloc, nx); b.st[0] = nloc; b.st[1] = nx; }
        const unsigned old = xb_add(&bar[XB_XSUB(b.x)], 1u);
        const unsigned gen = old / nloc;
        if (old + 1u == (gen + 1u) * nloc) {
            __builtin_amdgcn_fence(__ATOMIC_RELEASE, "agent");
            asm volatile("s_waitcnt vmcnt(0)" ::: "memory");
            const unsigned og = xb_add(&bar[XB_TOP], 1u);
            const unsigned tg = og / nx;
            if (og + 1u == (tg + 1u) * nx) xb_add(&bar[XB_TOPGEN], 1u);
            else XB_SPIN(xb_ld(&bar[XB_TOPGEN]) == tg, bar);
            __builtin_amdgcn_fence(__ATOMIC_ACQUIRE, "agent");
            xb_add(&bar[XB_XGEN(b.x)], 1u);
            asm volatile("s_waitcnt vmcnt(0)" ::: "memory");
        } else {
            XB_SPIN(xb_ld(&bar[XB_XGEN(b.x)]) == gen, bar);
            __builtin_amdgcn_fence(__ATOMIC_ACQUIRE, "agent");
            asm volatile("s_waitcnt vmcnt(0)" ::: "memory");
        }
    }
    __syncthreads();
}

#ifndef MK_PROG
#define MK_PROG 0,1,2,3,4,5,6,7,8,9,10,11,12,13,14,15,16,17,18,19,20,21,22,23,24
#endif
__constant__ int PROG[] = {MK_PROG};
constexpr int NPH = sizeof(PROG) / sizeof(int);
template <int TYPE> struct PreSched {
    const bf16* KV; const bf16* W; int G, c;
    DI bool next(int i, Unit& u) const {
        const long L = (long)i * G + c; if (L >= 512) return false;
        const int rem = (int)L, i2 = rem >> 8, b = (rem >> 4) & 15, hh = (rem >> 2) & 3, t4 = rem & 3;
        u.pm = 0; u.pn = 0;
        const bf16* kvp = KV + (size_t)(b * 256) * 4096 + i2 * 2048 + hh * 256;
        const bf16* wp = W + (size_t)i2 * 1024 * 1024 + (size_t)(t4 * 256) * 1024 + hh * 256;
        if (TYPE == 0) { u.pa = (const char*)kvp; u.pb = (const char*)wp; u.z = (i2 << 30) | (b * 1048576 + hh * 256 * 1024 + t4 * 256); }
        else { u.pa = (const char*)wp; u.pb = (const char*)(kvp + 1024); u.z = (i2 << 30) | (16 * 1048576 + b * 1048576 + t4 * 256 * 1024 + hh * 256); }
        return true;
    }
};

__global__ void __launch_bounds__(512, 2) mk_fwd(Args a) {
    extern __shared__ __attribute__((aligned(16))) unsigned char lds_raw[];
    Frame F;
    F.lds = (LAS unsigned char*)lds_raw;
    F.tid = threadIdx.x; F.lane = F.tid & 63; F.wave = __builtin_amdgcn_readfirstlane(F.tid >> 6);
    F.gw = blockIdx.x * 8 + F.wave; F.ngw = gridDim.x * 8; F.ws = a.ws;
    cg::grid_group grid = cg::this_grid();
    volatile LAS unsigned* MISC = (volatile LAS unsigned*)(F.lds + LDS_MISC);
    if (F.tid < 2) MISC[F.tid] = 0u;
    __syncthreads();
    (void)xcd_barrier_post((unsigned*)(a.ws + WS_BAR), MISC);

    for (int pi = a.ph_lo; pi < a.ph_hi; ++pi) {
        const int ph = PROG[pi];
        const int G = opq(gridDim.x), cblk = opq(blockIdx.x);
        unsigned char* ws = opq_ptr(a.ws);
        float* RS = (float*)(ws + WS_RS);
        bf16* SA = (bf16*)(ws + WS_SA); bf16* SB = (bf16*)(ws + WS_SB);
        const int li = ph >= 18 ? 1 : 0;
        int cp = ph; if (ph >= 18 && ph <= 23) cp = ph - 12;
#ifndef PH_MASK
#define PH_MASK 0xffffffffu
#endif
        if (!((PH_MASK >> cp) & 1u)) cp = 99;
        switch (cp) {
        case 0: phase_prologue(F, a, ws); break;
        case 1: {
            pg8::PlainSched S{(const bf16*)(ws + WS_MEMB), (const bf16*)(ws + WS_WKV), 1024, 1024, MMEM / 256, 16, G, cblk, 30, 0};
            EpiRowScale<0> E{(bf16*)(ws + WS_KV), 4096, (const float*)(ws + WS_RSMEM)};
            pg8::gemm_phase(F.lds, 1024, 1024, 1024, S, E);
        } break;
        case 2: {
            EpiPre E{(bf16*)(ws + WS_G0)};
            { PreSched<0> S{(const bf16*)(ws + WS_KV), (const bf16*)(ws + WS_WQN), G, cblk}; pg8::gemm_phase(F.lds, 256, 4096, 1024, S, E); }
            { PreSched<1> S{(const bf16*)(ws + WS_KV), (const bf16*)(ws + WS_WXO), G, cblk}; pg8::gemm_phase(F.lds, 256, 1024, 4096, S, E); }
        } break;
        case 3: {
            { pg8::PlainSched S{SA, (const bf16*)(ws + WS_WIN), 1024, 1024, M / 256, 8, G, cblk, 30, 0};
              EpiInProj E{(bf16*)(ws + WS_GLU), SB, RS};
              pg8::gemm_phase(F.lds, 1024, 1024, 1024, S, E); }
            { pg8::PlainSched S{(const bf16*)(ws + WS_WIN) + (size_t)2048 * 1024, SA, 1024, 1024, 2, M / 256, G, cblk, 30, 0};
              EpiVT E{(bf16*)(ws + WS_VT), RS};
              pg8::gemm_phase(F.lds, 1024, 1024, 1024, S, E); }
        } break;
        case 4: {
            const float lam = ((const float*)(ws + WS_LAM))[0];
#ifndef NO_ATTN
            for (int u = cblk; u < 1024; u += G) diffattn_unit(F, u, SB, (const bf16*)(ws + WS_VT), (const float*)(ws + WS_BIAS), lam, a.in[opq(I_SUBLN)], (bf16*)(ws + WS_MIX));
#endif
            __syncthreads();
#ifndef NO_CONV
            conv_load_weights(F, a.in[opq(I_CONVW)]);
            for (int u = cblk; u < 512; u += G) conv_unit(F, u, (const bf16*)(ws + WS_GLU), a.in[opq(I_CONVB)], a.in[opq(I_CLNG)], a.in[opq(I_CLNB)], (bf16*)(ws + WS_MIX));
#endif
            __syncthreads();
        } break;
        case 5: {
            pg8::PlainSched S{(const bf16*)(ws + WS_MIX), (const bf16*)(ws + WS_WOUT), 1024, 1024, M / 256, 4, G, cblk, 30, 0};
            EpiResid E{a.in[opq(I_X)], a.out};
            pg8::gemm_phase(F.lds, 1024, 1024, 1024, S, E);
        } break;
        case 6: case 9: phase_norm(F, a.out, SA, RS); break;
        case 7: {
            pg8::PlainSched S{SA, (const bf16*)(ws + (li ? WS_G1 : WS_G0)), 1024, 1024, M / 256, 4, G, cblk, 3, (size_t)1048576};
            EpiSoftmax E{SB, RS};
            pg8::gemm_phase(F.lds, 1024, 1024, 1024, S, E);
        } break;
        case 8: {
            pg8::PlainSched S{SB, (const bf16*)(ws + (li ? WS_VW1 : WS_VW0)), 1024, 1024, M / 256, 4, G, cblk, 3, (size_t)1048576};
            EpiResid E{a.out, a.out};
            pg8::gemm_phase(F.lds, 1024, 1024, 1024, S, E);
        } break;
        case 10: {
            pg8::PlainSched S{SA, (const bf16*)(ws + WS_WUP) + (size_t)li * 4096 * 1024, 1024, 1024, M / 256, 16, G, cblk, 30, 0};
            EpiRowScale<2> E{(bf16*)(ws + WS_HID), 4096, RS};
            pg8::gemm_phase(F.lds, 1024, 1024, 1024, S, E);
        } break;
        case 11: {
            pg8::PlainSched S{(const bf16*)(ws + WS_HID), (const bf16*)(ws + WS_WDN) + (size_t)li * 1024 * 4096, 4096, 4096, M / 256, 4, G, cblk, 30, 0};
            EpiResid E{a.out, a.out};
            pg8::gemm_phase(F.lds, 4096, 4096, 4096, S, E);
        } break;
        case 12: phase_rwkv_shift(F, a.out, a.in[opq(I_NMIX)] + 1024, (bf16*)(ws + WS_A1)); break;
        case 13: {
            pg8::PlainSched S{(const bf16*)(ws + WS_A1), (const bf16*)(ws + WS_WBIG), 2048, 2048, M / 256, 14, G, cblk, 30, 0};
            EpiRwkv E{(bf16*)(ws + WS_R), (bf16*)(ws + WS_K), (bf16*)(ws + WS_V), (bf16*)(ws + WS_HD1), (bf16*)(ws + WS_HD2)};
            pg8::gemm_phase(F.lds, 2048, 2048, 2048, S, E);
        } break;
        case 14: {
            ScanPtrs P{(const bf16*)(ws + WS_R), (const bf16*)(ws + WS_K), (const bf16*)(ws + WS_V), (const bf16*)(ws + WS_HD1), (const bf16*)(ws + WS_W2T),
                       a.in[opq(I_W0)], a.in[opq(I_A0)], a.in[opq(I_KK)], a.in[opq(I_KA)], a.in[opq(I_RK)], (bf16*)(ws + WS_YF), (bf16*)(ws + WS_YB), (float*)(ws + WS_BONUS)};
            for (int bh = cblk; bh < 256; bh += G) scan_pair(F, bh, P);
            __syncthreads();
        } break;
        case 15: {
            pg8::PlainSched S{(const bf16*)(ws + WS_HD2), (const bf16*)(ws + WS_G2T), 256, 256, M / 256, 4, G, cblk, 30, 0};
            EpiRowScale<0> E{(bf16*)(ws + WS_GATE), 1024, nullptr};
            pg8::gemm_phase(F.lds, 256, 256, 256, S, E);
        } break;
        case 16: phase_rwkv_comb(F, (const bf16*)(ws + WS_YF), (const bf16*)(ws + WS_YB), (const bf16*)(ws + WS_V), (const bf16*)(ws + WS_GATE), (const float*)(ws + WS_BONUS),
                                 a.in[opq(I_LNG)], a.in[opq(I_LNB)], (bf16*)(ws + WS_COMB)); break;
        case 17: {
            pg8::PlainSched S{(const bf16*)(ws + WS_COMB), (const bf16*)(ws + WS_WRO), 1024, 1024, M / 256, 4, G, cblk, 30, 0};
            EpiResid E{a.out, a.out};
            pg8::gemm_phase(F.lds, 1024, 1024, 1024, S, E);
        } break;
        case 24: phase_final_norm(F, a.out, a.in[opq(I_NFINAL)]); break;
        default: break;
        }
        if (pi + 1 < a.ph_hi) {
#ifdef MK_ALL_CG
            grid.sync();
#else
            if (pi == a.ph_lo) grid.sync(); else { XcdBarrier xb; xb.bar = (unsigned*)(ws + WS_BAR); xb.x = xb_xcc_id(); xb.st = (volatile LAS unsigned*)(F.lds + LDS_MISC); xcd_barrier(xb); }
#endif
        }
    }
}

extern "C" void kernel_launch(void* const* d_in, const int* in_sizes, int n_in, void* d_out, int out_size, void* d_ws, size_t ws_size, hipStream_t stream) {
    static int grid = 0;
    if (grid == 0) {
        if (n_in != N_IN || in_sizes[0] != M * D || out_size != M * D || ws_size < WS_NEED) {
            fprintf(stderr, "kernel_launch: unexpected problem (n_in %d, in0 %d, out %d, ws %zu); nothing launched\n", n_in, n_in > 0 ? in_sizes[0] : -1, out_size, ws_size); grid = -1; return; }
        int dev = 0, cus = 0, per_cu = 0;
        if (hipGetDevice(&dev) != hipSuccess || hipDeviceGetAttribute(&cus, hipDeviceAttributeMultiprocessorCount, dev) != hipSuccess) { grid = -1; return; }
        if (hipFuncSetAttribute((const void*)mk_fwd, hipFuncAttributeMaxDynamicSharedMemorySize, LDS_BYTES) != hipSuccess) { fprintf(stderr, "kernel_launch: hipFuncSetAttribute failed\n"); grid = -1; return; }
        if (hipOccupancyMaxActiveBlocksPerMultiprocessor(&per_cu, (const void*)mk_fwd, 512, LDS_BYTES) != hipSuccess || per_cu < 1) { fprintf(stderr, "kernel_launch: occupancy query says %d\n", per_cu); (void)hipGetLastError(); grid = -1; return; }
        grid = cus;
    }
    if (grid < 0) return;
    if (hipMemsetAsync((char*)d_ws + WS_BAR, 0, 65536, stream) != hipSuccess) { fprintf(stderr, "kernel_launch: memset failed\n"); return; }
    Args a{};
    for (int i = 0; i < N_IN; ++i) a.in[i] = (const float*)d_in[i];
    a.out = (float*)d_out; a.ws = (unsigned char*)d_ws;
#if MK_SINGLE
    a.ph_lo = 0; a.ph_hi = NPH;
    void* params[] = {&a};
    hipError_t e = hipLaunchCooperativeKernel((const void*)mk_fwd, dim3(grid), dim3(512), params, LDS_BYTES, stream);
    if (e != hipSuccess) fprintf(stderr, "kernel_launch: cooperative launch failed: %s\n", hipGetErrorString(e));
#else
    for (int ph = 0; ph < NPH; ++ph) { a.ph_lo = ph; a.ph_hi = ph + 1; hipLaunchKernelGGL(mk_fwd, dim3(grid), dim3(512), LDS_BYTES, stream, a); }
#endif
}
```

```cpp
#include <hip/hip_runtime.h>
#include <hip/hip_cooperative_groups.h>
#include <cstdio>
#include <cstdint>
namespace cg = cooperative_groups;

#ifndef MK_SINGLE
#define MK_SINGLE 1
#endif

#define LAS __attribute__((address_space(3)))
#define DI __device__ __forceinline__
typedef unsigned short bf16;
typedef short bf16x8 __attribute__((ext_vector_type(8)));
typedef short s16x4 __attribute__((ext_vector_type(4)));
typedef float f32x2 __attribute__((ext_vector_type(2)));
typedef float f32x4 __attribute__((ext_vector_type(4)));
typedef float f32x16 __attribute__((ext_vector_type(16)));
typedef unsigned u32x2 __attribute__((ext_vector_type(2)));
typedef unsigned u32x4 __attribute__((ext_vector_type(4)));

constexpr int D = 1024, NB = 16, T = 2048, M = NB * T, NMEM = 256, MMEM = NB * NMEM;
constexpr int FF = 4096;
constexpr float EPS = 1e-6f;
constexpr float LOG2E = 1.4426950408889634f;

constexpr size_t MiB = 1u << 20;
constexpr size_t WS_BAR = 0;
constexpr size_t WS_RS = 64 * 1024;
constexpr size_t WS_RSMEM = WS_RS + M * 4;
constexpr size_t WS_BIAS = WS_RSMEM + MMEM * 4;
constexpr size_t WS_LAM = WS_BIAS + 4 * 4096 * 4;
constexpr size_t WS_WIN = 1 * MiB;
constexpr size_t WS_WOUT = WS_WIN + 5 * MiB;
constexpr size_t WS_WQN = WS_WOUT + 2 * MiB;
constexpr size_t WS_WKV = WS_WQN + 4 * MiB;
constexpr size_t WS_WXO = WS_WKV + 8 * MiB;
constexpr size_t WS_WUP = WS_WXO + 4 * MiB;
constexpr size_t WS_WDN = WS_WUP + 16 * MiB;
constexpr size_t WS_WBIG = WS_WDN + 16 * MiB;
constexpr size_t WS_W2T = WS_WBIG + 14 * MiB;
constexpr size_t WS_G2T = WS_W2T + 512 * 1024;
constexpr size_t WS_WRO = WS_G2T + 512 * 1024;
constexpr size_t WS_WEND = WS_WRO + 2 * MiB;
static_assert(WS_WEND == 73 * MiB, "weight map");
constexpr size_t WS_SA = 73 * MiB;
constexpr size_t WS_SB = 137 * MiB;
constexpr size_t WS_GLU = 201 * MiB;
constexpr size_t WS_VT = 233 * MiB;
constexpr size_t WS_MIX = 265 * MiB;
constexpr size_t WS_G0 = 329 * MiB;
constexpr size_t WS_VW0 = 361 * MiB;
constexpr size_t WS_MEMB = 393 * MiB;
constexpr size_t WS_KV = 401 * MiB;
constexpr size_t WS_G1 = 433 * MiB;
constexpr size_t WS_VW1 = 465 * MiB;
static_assert(WS_G1 - WS_G0 == 104 * MiB && WS_VW0 - WS_G0 == 32 * MiB && WS_VW1 - WS_G1 == 32 * MiB, "G / VW spacing used by EpiPre");
constexpr size_t WS_BONUS = 497 * MiB;
constexpr size_t WS_PS = 502 * MiB;
constexpr size_t WS_HID = 137 * MiB;
constexpr size_t WS_A1 = 73 * MiB;
constexpr size_t WS_R = 201 * MiB, WS_K = 265 * MiB, WS_V = 329 * MiB;
static_assert(WS_K - WS_R == 64 * MiB && WS_V - WS_K == 64 * MiB, "r, k, v spacing used by EpiRwkv");
constexpr size_t WS_HD1 = 393 * MiB;
constexpr size_t WS_HD2 = 409 * MiB;
constexpr size_t WS_YF = 73 * MiB, WS_YB = 137 * MiB;
constexpr size_t WS_GATE = 265 * MiB;
constexpr size_t WS_COMB = 201 * MiB;
constexpr size_t WS_NEED = 512 * MiB;

constexpr int LDS_X = 131072;
constexpr int LDS_MISC = 131072 + 8192;
constexpr int LDS_BYTES = 147456;

DI unsigned f2bf(float f) { unsigned u = __builtin_bit_cast(unsigned, f); return (u + 0x7fffu + ((u >> 16) & 1u)) >> 16; }
typedef __bf16 bf16x2v __attribute__((ext_vector_type(2)));
DI unsigned pk2(float lo, float hi) { const f32x2 v = {lo, hi}; return __builtin_bit_cast(unsigned, __builtin_convertvector(v, bf16x2v)); }
DI float bf2f(unsigned short b) { return __builtin_bit_cast(float, ((unsigned)b) << 16); }
DI float bflo(unsigned w) { return __builtin_bit_cast(float, w << 16); }
DI float bfhi(unsigned w) { return __builtin_bit_cast(float, w & 0xffff0000u); }
template <int MASK> DI float swz_xor(float v) { return __builtin_bit_cast(float, __builtin_amdgcn_ds_swizzle(__builtin_bit_cast(int, v), (MASK << 10) | 0x1f)); }
DI float half_sum(float v) { const int x = __builtin_bit_cast(int, v); const auto r = __builtin_amdgcn_permlane32_swap(x, x, false, false); return __builtin_bit_cast(float, (int)r[0]) + __builtin_bit_cast(float, (int)r[1]); }
DI float half_max(float v) { const int x = __builtin_bit_cast(int, v); const auto r = __builtin_amdgcn_permlane32_swap(x, x, false, false); return fmaxf(__builtin_bit_cast(float, (int)r[0]), __builtin_bit_cast(float, (int)r[1])); }
DI float wave_sum(float v) {
    v += swz_xor<1>(v); v += swz_xor<2>(v); v += swz_xor<4>(v); v += swz_xor<8>(v); v += swz_xor<16>(v); v = half_sum(v);
    return v;
}
DI int opaque(int x) { asm volatile("" : "+v"(x)); return x; }
template <class Tp> DI Tp* opq_ptr(Tp* p) { asm volatile("" : "+s"(p)); return p; }
DI int opq(int x) { asm volatile("" : "+s"(x)); return x; }
DI float fexp2(float x) { return __builtin_amdgcn_exp2f(x); }
DI float frcp(float x) { return __builtin_amdgcn_rcpf(x); }
DI float sigmoidf_(float x) { return frcp(1.0f + fexp2(-x * LOG2E)); }
DI float tanhf_(float x) { float e = fexp2(-2.0f * LOG2E * fabsf(x)); float t = (1.0f - e) * frcp(1.0f + e); return x < 0.f ? -t : t; }

namespace pg8 {
constexpr int BM = 256, BK = 64, HALF = 128, HTB = HALF * BK * 2, STAGE_BYTES = 8 * HTB, NXCD = 8, WGM = 8;
DI int lds_byte(int r, int c) { const int st = (r >> 4) * 2 + (c >> 5), rr = r & 15, cc = c & 31, ob = rr * 64 + cc * 2; return st * 1024 + (ob ^ (((ob >> 9) & 1) << 5)); }
DI void stage_rc(int b, int& R, int& C) { const int st = b / 1024, sb = b % 1024, swz = sb ^ (((sb >> 9) & 1) << 5); R = (st >> 1) * 16 + swz / 64; C = (st & 1) * 32 + (swz % 64) / 2; }
DI int perm32(int rho) { const int n = rho >> 4, i = rho & 15; return 8 * (i >> 2) + 4 * n + (i & 3); }

struct Unit { int pm, pn, z; const char* pa; const char* pb; };

DI bool tile_order(long L, int nM, int nN, int& pm, int& pn) {
    const int nwg = nM * nN; if (L >= nwg) return false;
    int wgid = (int)L; { const int q = nwg / NXCD, r = nwg % NXCD, xcd = wgid % NXCD, off = wgid / NXCD; wgid = (xcd < r ? xcd * (q + 1) : r * (q + 1) + (xcd - r) * q) + off; }
    const int nig = WGM * nN, gid = wgid / nig, fm = gid * WGM, gsz = (nM - fm) < WGM ? (nM - fm) : WGM;
    pm = fm + ((wgid % nig) % gsz); pn = (wgid % nig) / gsz; return true;
}
struct PlainSched {
    const bf16* A; const bf16* Bt; int lda, ldb, nM, nN, G, c, bshift; size_t bstride;
    DI bool next(int i, Unit& u) const {
        if (!tile_order((long)i * G + c, nM, nN, u.pm, u.pn)) return false;
        u.z = u.pm >> bshift;
        u.pa = (const char*)(A + (size_t)u.pm * 256 * lda);
        u.pb = (const char*)(Bt + (size_t)u.z * bstride + (size_t)u.pn * 256 * ldb);
        return true;
    }
};

DI unsigned cvt_pk_bf16(float lo, float hi) { return pk2(lo, hi); }

template <class Epi, class Sched>
DI void gemm_phase(LAS unsigned char* lds, const int K, const int lda, const int ldb, const Sched& S, const Epi& E) {
    const int tid = opaque(threadIdx.x), wid = __builtin_amdgcn_readfirstlane(tid >> 6), lane = tid & 63, wr = wid >> 2, wc = wid & 3, fr = lane & 15, fq = lane >> 4;
    const int nt = K / BK;
    unsigned voffA[2], voffB[2];
#pragma unroll
    for (int i = 0; i < 2; ++i) { int R, C; stage_rc(tid * 16 + i * 8192, R, C); const int Rb = Epi::PERM ? ((R & ~31) + perm32(R & 31)) : R;
        voffA[i] = (unsigned)(R * lda + C) * 2u; voffB[i] = (unsigned)(Rb * ldb + C) * 2u; }
    const size_t kstep = (size_t)(BK * 2);
    const size_t hstepA = (size_t)HALF * lda * 2, hstepB = (size_t)HALF * ldb * 2;
    const unsigned ldsw = (unsigned)wid * 1024u;
    const int aoff = lds_byte(wr * 64 + fr, fq * 8), boff = lds_byte(wc * 32 + fr, fq * 8);
#define PG8_SA(b, h) (((b) * 2 + (h)) * HTB)
#define PG8_SB(b, h) ((4 + (b) * 2 + (h)) * HTB)
#define PG8_STAGE(bufoff, gbase, voff) do { _Pragma("unroll") for (int _i = 0; _i < 2; ++_i) \
        __builtin_amdgcn_global_load_lds((const unsigned*)((const char*)(gbase) + (voff)[_i]), (LAS unsigned*)(lds + (bufoff) + ldsw + _i * 8192), 16, 0, 0); } while (0)
#define PG8_LDA(dst, b, h) do { _Pragma("unroll") for (int m = 0; m < 4; ++m) _Pragma("unroll") for (int k = 0; k < 2; ++k) dst[m][k] = *(const LAS bf16x8*)(lds + PG8_SA(b, h) + aoff + m * 2048 + k * 1024); } while (0)
#define PG8_LDB(dst, b, h) do { _Pragma("unroll") for (int n = 0; n < 2; ++n) _Pragma("unroll") for (int k = 0; k < 2; ++k) dst[n][k] = *(const LAS bf16x8*)(lds + PG8_SB(b, h) + boff + n * 2048 + k * 1024); } while (0)
#define PG8_MMA(ai, bj, At, Bt) do { __builtin_amdgcn_s_setprio(1); _Pragma("unroll") for (int m = 0; m < 4; ++m) _Pragma("unroll") for (int n = 0; n < 2; ++n) _Pragma("unroll") for (int k = 0; k < 2; ++k) \
        acc[ai][bj][m][n] = __builtin_amdgcn_mfma_f32_16x16x32_bf16(Bt[n][k], At[m][k], acc[ai][bj][m][n], 0, 0, 0); __builtin_amdgcn_s_setprio(0); } while (0)
#define PG8_WAIT_V(n) asm volatile("s_waitcnt vmcnt(" #n ")" ::: "memory")
#define PG8_WAIT_L(n) asm volatile("s_waitcnt lgkmcnt(" #n ")" ::: "memory")
#define PG8_BAR __builtin_amdgcn_s_barrier()
#define PG8_SCHED __builtin_amdgcn_sched_barrier(0)
    Unit cur, nxt; int ui = 0;
    if (!S.next(0, cur)) return;
    f32x4 acc[2][2][4][2];
#pragma unroll
    for (int a = 0; a < 2; ++a)
#pragma unroll
        for (int b = 0; b < 2; ++b)
#pragma unroll
            for (int m = 0; m < 4; ++m)
#pragma unroll
                for (int n = 0; n < 2; ++n) acc[a][b][m][n] = (f32x4){0.f, 0.f, 0.f, 0.f};
    bf16x8 At[4][2], B0[2][2], B1[2][2];
    const char* cA = cur.pa; const char* cB = cur.pb;
    PG8_STAGE(PG8_SB(0, 0), cB, voffB); PG8_STAGE(PG8_SB(0, 1), cB + hstepB, voffB); PG8_STAGE(PG8_SA(0, 0), cA, voffA); PG8_STAGE(PG8_SA(0, 1), cA + hstepA, voffA);
    if (wr == 1) PG8_BAR;
    PG8_WAIT_V(2); PG8_BAR;
    PG8_STAGE(PG8_SB(1, 0), cB + kstep, voffB); PG8_STAGE(PG8_SA(1, 0), cA + kstep, voffA); PG8_STAGE(PG8_SB(1, 1), cB + hstepB + kstep, voffB);
    PG8_WAIT_V(6); PG8_BAR;
    for (;;) {
        const bool has_next = S.next(ui + 1, nxt);
        const char* nA = has_next ? nxt.pa : cA; const char* nB = has_next ? nxt.pb : cB;
#pragma unroll 1
        for (int t = 0; t < nt; t += 2) {
            const bool last = (t == nt - 2);
            const char* a1 = cA + (size_t)(t + 1) * kstep;
            const char* a2 = last ? nA : cA + (size_t)(t + 2) * kstep; const char* b2 = last ? nB : cB + (size_t)(t + 2) * kstep;
            const char* a3 = a2 + kstep; const char* b3 = b2 + kstep;
            PG8_LDB(B0, 0, 0); PG8_LDB(B1, 0, 1); PG8_SCHED; PG8_LDA(At, 0, 0); PG8_STAGE(PG8_SA(1, 1), a1 + hstepA, voffA);
            PG8_WAIT_V(8); PG8_WAIT_L(0); PG8_BAR; PG8_MMA(0, 0, At, B0); PG8_MMA(0, 1, At, B1); PG8_BAR; PG8_SCHED;
            PG8_LDA(At, 0, 1); PG8_STAGE(PG8_SB(0, 0), b2, voffB); PG8_STAGE(PG8_SB(0, 1), b2 + hstepB, voffB); PG8_STAGE(PG8_SA(0, 0), a2, voffA);
            PG8_WAIT_V(8); PG8_WAIT_L(0); PG8_BAR; PG8_MMA(1, 0, At, B0); PG8_MMA(1, 1, At, B1); PG8_BAR; PG8_SCHED;
            PG8_LDB(B0, 1, 0); PG8_LDB(B1, 1, 1); PG8_SCHED; PG8_LDA(At, 1, 0); PG8_STAGE(PG8_SA(0, 1), a2 + hstepA, voffA);
            PG8_WAIT_V(8); PG8_WAIT_L(0); PG8_BAR; PG8_MMA(0, 0, At, B0); PG8_MMA(0, 1, At, B1); PG8_BAR; PG8_SCHED;
            PG8_LDA(At, 1, 1); PG8_STAGE(PG8_SB(1, 0), b3, voffB); PG8_STAGE(PG8_SB(1, 1), b3 + hstepB, voffB); PG8_STAGE(PG8_SA(1, 0), a3, voffA);
            PG8_WAIT_V(8); PG8_WAIT_L(0); PG8_BAR; PG8_MMA(1, 0, At, B0); PG8_MMA(1, 1, At, B1); PG8_BAR; PG8_SCHED;
        }
        if (wr == 0) PG8_BAR;
        E(acc, cur, wr, wc, fr, fq, lds);
        if (!has_next) break;
#pragma unroll
        for (int a = 0; a < 2; ++a)
#pragma unroll
            for (int b = 0; b < 2; ++b)
#pragma unroll
                for (int m = 0; m < 4; ++m)
#pragma unroll
                    for (int n = 0; n < 2; ++n) acc[a][b][m][n] = (f32x4){0.f, 0.f, 0.f, 0.f};
        cur = nxt; cA = nA; cB = nB; ++ui;
        if (wr == 1) PG8_BAR;
    }
    PG8_WAIT_V(0);
    PG8_BAR;
#undef PG8_SA
#undef PG8_SB
#undef PG8_STAGE
#undef PG8_LDA
#undef PG8_LDB
#undef PG8_MMA
#undef PG8_WAIT_V
#undef PG8_WAIT_L
#undef PG8_BAR
#undef PG8_SCHED
}
}
using pg8::Unit;

DI void store8(bf16* p, const f32x4 v0, const f32x4 v1) {
    u32x4 w; w.x = pk2(v0[0], v0[1]); w.y = pk2(v0[2], v0[3]); w.z = pk2(v1[0], v1[1]); w.w = pk2(v1[2], v1[3]);
    *(u32x4*)p = w;
}
#define EPI_ARGS f32x4 (&acc)[2][2][4][2], const Unit& u, int wr, int wc, int fr, int fq, LAS unsigned char* lds

DI float rs_ps(const float* ps, int row) {
    const f32x4* p = (const f32x4*)(ps + (size_t)row * 16); const f32x4 a = p[0], b = p[1], c = p[2], d = p[3];
    const float s = ((a.x + a.y) + (a.z + a.w)) + ((b.x + b.y) + (b.z + b.w)) + (((c.x + c.y) + (c.z + c.w)) + ((d.x + d.y) + (d.z + d.w)));
    return 1.0f / sqrtf(s * (1.0f / D) + EPS);
}
template <int ACT> struct EpiRowScale {
    static constexpr bool PERM = true;
    bf16* O; int ldc; const float* rs; const float* ps;
    DI void operator()(EPI_ARGS) const {
        const int row0 = u.pm * 256 + wr * 64 + fr, col0 = u.pn * 256 + wc * 32 + 8 * fq;
#pragma unroll
        for (int ai = 0; ai < 2; ++ai)
#pragma unroll
            for (int m = 0; m < 4; ++m) {
                const int row = row0 + ai * 128 + m * 16; const float s = ps ? rs_ps(ps, row) : (rs ? rs[row] : 1.0f);
                bf16* rowp = O + (size_t)row * ldc + col0;
#pragma unroll
                for (int bj = 0; bj < 2; ++bj) { f32x4 v0 = acc[ai][bj][m][0] * s, v1 = acc[ai][bj][m][1] * s;
                    if (ACT == 2) {
#pragma unroll
                        for (int j = 0; j < 4; ++j) { float a = fmaxf(v0[j], 0.f), b = fmaxf(v1[j], 0.f); v0[j] = a * a; v1[j] = b * b; } }
                    store8(rowp + bj * 128, v0, v1); }
            }
    }
};
struct EpiInProj {
    static constexpr bool PERM = true;
    bf16* GLU; bf16* QK; const float* rs;
    DI void operator()(EPI_ARGS) const {
        const int row0 = u.pm * 256 + wr * 64 + fr;
        if (u.pn < 4) {
            const int col0 = u.pn * 128 + wc * 32 + 8 * fq;
#pragma unroll
            for (int ai = 0; ai < 2; ++ai)
#pragma unroll
                for (int m = 0; m < 4; ++m) {
                    const int row = row0 + ai * 128 + m * 16; const float s = rs[row];
                    f32x4 o0, o1;
#pragma unroll
                    for (int j = 0; j < 4; ++j) { o0[j] = acc[ai][0][m][0][j] * s * sigmoidf_(acc[ai][1][m][0][j] * s); o1[j] = acc[ai][0][m][1][j] * s * sigmoidf_(acc[ai][1][m][1][j] * s); }
                    store8(GLU + (size_t)row * 512 + col0, o0, o1);
                }
        } else {
            const int col0 = (u.pn - 4) * 256 + wc * 32 + 8 * fq;
#pragma unroll
            for (int ai = 0; ai < 2; ++ai)
#pragma unroll
                for (int m = 0; m < 4; ++m) {
                    const int row = row0 + ai * 128 + m * 16; const float s = rs[row];
#pragma unroll
                    for (int bj = 0; bj < 2; ++bj) store8(QK + (size_t)row * 1024 + col0 + bj * 128, acc[ai][bj][m][0] * s, acc[ai][bj][m][1] * s);
                }
        }
    }
};
struct EpiVT {
    static constexpr bool PERM = true;
    bf16* O; const float* cs;
    DI void operator()(EPI_ARGS) const {
        const int row0 = u.pm * 256 + wr * 64 + fr, col0 = u.pn * 256 + wc * 32 + 8 * fq;
        f32x4 c[2][2];
#pragma unroll
        for (int bj = 0; bj < 2; ++bj) { c[bj][0] = *(const f32x4*)(cs + col0 + bj * 128); c[bj][1] = *(const f32x4*)(cs + col0 + bj * 128 + 4); }
#pragma unroll
        for (int ai = 0; ai < 2; ++ai)
#pragma unroll
            for (int m = 0; m < 4; ++m) {
                const int row = row0 + ai * 128 + m * 16;
#pragma unroll
                for (int bj = 0; bj < 2; ++bj) store8(O + (size_t)row * M + col0 + bj * 128, acc[ai][bj][m][0] * c[bj][0], acc[ai][bj][m][1] * c[bj][1]);
            }
    }
};
struct EpiPre {
    static constexpr bool PERM = true;
    bf16* base0;
    DI void operator()(EPI_ARGS) const {
        bf16* O = base0 + (size_t)((u.z >> 30) & 1) * (52u << 20) + (size_t)(u.z & 0x3fffffff);
        const int row0 = wr * 64 + fr, col0 = wc * 32 + 8 * fq;
#pragma unroll
        for (int ai = 0; ai < 2; ++ai)
#pragma unroll
            for (int m = 0; m < 4; ++m) {
                const int row = row0 + ai * 128 + m * 16;
#pragma unroll
                for (int bj = 0; bj < 2; ++bj) store8(O + (size_t)row * 1024 + col0 + bj * 128, acc[ai][bj][m][0], acc[ai][bj][m][1]);
            }
    }
};
struct EpiResid {
    static constexpr bool PERM = false;
    const float* resid; float* out; bf16* hb; float* ps;
    DI void operator()(EPI_ARGS) const {
        const int row0 = u.pm * 256 + wr * 64 + fr, col0 = u.pn * 256 + wc * 32 + 4 * fq;
#pragma unroll
        for (int ai = 0; ai < 2; ++ai)
#pragma unroll
            for (int m = 0; m < 4; ++m) {
                const int row = row0 + ai * 128 + m * 16; const size_t off = (size_t)row * D + col0; float ss = 0.f;
#pragma unroll
                for (int bj = 0; bj < 2; ++bj)
#pragma unroll
                    for (int n = 0; n < 2; ++n) { const f32x4 r = *(const f32x4*)(resid + off + bj * 128 + n * 16) + acc[ai][bj][m][n]; *(f32x4*)(out + off + bj * 128 + n * 16) = r;
                        if (hb) { u32x2 w; w.x = pk2(r.x, r.y); w.y = pk2(r.z, r.w); *(u32x2*)(hb + off + bj * 128 + n * 16) = w; }
                        ss += (r.x * r.x + r.y * r.y) + (r.z * r.z + r.w * r.w); }
                if (ps) { ss += swz_xor<16>(ss); ss = half_sum(ss); if (fq == 0) ps[(size_t)row * 16 + u.pn * 4 + wc] = ss; }
            }
    }
};
struct EpiSoftmax {
    static constexpr bool PERM = true;
    bf16* P; const float* ps;
    DI void operator()(EPI_ARGS) const {
        LAS f32x2* X = (LAS f32x2*)(lds + LDS_X);
        const int row0 = u.pm * 256, col0 = u.pn * 256 + wc * 32 + 8 * fq;
        float mw[2][4];
#pragma unroll
        for (int ai = 0; ai < 2; ++ai)
#pragma unroll
            for (int m = 0; m < 4; ++m) {
                const int rl = ai * 128 + wr * 64 + m * 16 + fr; const float s = rs_ps(ps, row0 + rl) * LOG2E;
                float mx = -3.0e38f;
#pragma unroll
                for (int bj = 0; bj < 2; ++bj)
#pragma unroll
                    for (int n = 0; n < 2; ++n) { acc[ai][bj][m][n] = acc[ai][bj][m][n] * s;
#pragma unroll
                        for (int j = 0; j < 4; ++j) mx = fmaxf(mx, acc[ai][bj][m][n][j]); }
                mx = fmaxf(mx, swz_xor<16>(mx)); mx = half_max(mx);
                float sum = 0.f;
#pragma unroll
                for (int bj = 0; bj < 2; ++bj)
#pragma unroll
                    for (int n = 0; n < 2; ++n)
#pragma unroll
                        for (int j = 0; j < 4; ++j) { const float p = fexp2(acc[ai][bj][m][n][j] - mx); acc[ai][bj][m][n][j] = p; sum += p; }
                sum += swz_xor<16>(sum); sum = half_sum(sum);
                mw[ai][m] = mx;
                if (fq == 0) X[rl * 4 + wc] = (f32x2){mx, sum};
            }
        asm volatile("s_waitcnt lgkmcnt(0)" ::: "memory"); __builtin_amdgcn_s_barrier(); asm volatile("" ::: "memory");
#pragma unroll
        for (int ai = 0; ai < 2; ++ai)
#pragma unroll
            for (int m = 0; m < 4; ++m) {
                const int rl = ai * 128 + wr * 64 + m * 16 + fr;
                const f32x2 a = X[rl * 4 + 0], b = X[rl * 4 + 1], c = X[rl * 4 + 2], d = X[rl * 4 + 3];
                const float mt = fmaxf(fmaxf(a.x, b.x), fmaxf(c.x, d.x));
                const float lt = a.y * fexp2(a.x - mt) + b.y * fexp2(b.x - mt) + c.y * fexp2(c.x - mt) + d.y * fexp2(d.x - mt);
                const float f = fexp2(mw[ai][m] - mt) / lt;
                bf16* rowp = P + (size_t)(row0 + rl) * 1024 + col0;
#pragma unroll
                for (int bj = 0; bj < 2; ++bj) store8(rowp + bj * 128, acc[ai][bj][m][0] * f, acc[ai][bj][m][1] * f);
            }
        asm volatile("s_waitcnt lgkmcnt(0)" ::: "memory"); __builtin_amdgcn_s_barrier(); asm volatile("" ::: "memory");
    }
};
struct EpiRwkv {
    static constexpr bool PERM = true;
    bf16* R; bf16* Kk; bf16* V; bf16* HD1; bf16* HD2;
    DI void operator()(EPI_ARGS) const {
        const int row0 = u.pm * 256 + wr * 64 + fr; const int g = u.pn >> 2;
        bf16* O; int ldc, colt, mode0 = 0, mode1 = 0;
        if (u.pn < 12) { O = R + (size_t)g * (32u << 20); ldc = 1024; colt = (u.pn & 3) * 256; }
        else if (u.pn == 12) { O = HD1; ldc = 256; colt = 0; mode0 = 1; }
        else { O = HD2; ldc = 256; colt = 0; mode0 = 2; mode1 = 2; }
        const int col0 = colt + wc * 32 + 8 * fq;
#pragma unroll
        for (int ai = 0; ai < 2; ++ai)
#pragma unroll
            for (int m = 0; m < 4; ++m) {
                bf16* rowp = O + (size_t)(row0 + ai * 128 + m * 16) * ldc + col0;
#pragma unroll
                for (int bj = 0; bj < 2; ++bj) { f32x4 v0 = acc[ai][bj][m][0], v1 = acc[ai][bj][m][1]; const int md = bj ? mode1 : mode0;
                    if (md == 1) {
#pragma unroll
                        for (int j = 0; j < 4; ++j) { v0[j] = tanhf_(v0[j]); v1[j] = tanhf_(v1[j]); } }
                    else if (md == 2) {
#pragma unroll
                        for (int j = 0; j < 4; ++j) { v0[j] = sigmoidf_(v0[j]); v1[j] = sigmoidf_(v1[j]); } }
                    store8(rowp + bj * 128, v0, v1); }
            }
    }
};

enum InIdx { I_X = 0, I_MEM, I_REL, I_NMIX, I_NXATTN, I_NMEM, I_NFFN, I_NFINAL, I_WIN, I_WOUT, I_CONVW, I_CONVB, I_CLNG, I_CLNB, I_LQ1, I_LK1, I_LQ2, I_LK2, I_SUBLN,
             I_MU, I_WR, I_WK, I_WV, I_WO, I_W0, I_W1, I_W2, I_A0, I_A1, I_A2, I_G1, I_G2, I_KK, I_KA, I_RK, I_LNG, I_LNB, I_XQ, I_XKV, I_XO, I_UP, I_DN, N_IN };
struct Args { const float* in[N_IN]; float* out; unsigned char* ws; int ph_lo, ph_hi; };
static_assert(sizeof(Args) == (N_IN + 2) * 8 + 8, "Args has no padding");

struct Frame {
    LAS unsigned char* lds;
    int tid, lane, wave, gw, ngw;
    unsigned char* ws;
};

DI Frame fresh(const Frame& F0) {
    Frame F = F0; F.tid = opaque(threadIdx.x); F.lane = F.tid & 63; F.wave = __builtin_amdgcn_readfirstlane(F.tid >> 6); F.gw = opq(blockIdx.x) * 8 + F.wave; F.ngw = opq(gridDim.x) * 8; return F;
}
struct TJob { const float* W; int K, N; bf16* WT; int ldt, row_off, col_off, perm; const float* gain; };
DI void tr_item(const TJob& J, LAS float* scr, int item, int lane) {
    const int nblk = J.N / 32, kb = item / nblk, nb = item % nblk, k0 = 64 * kb, n0 = 32 * nb;
    float scale = 1.0f; int drow = J.row_off + n0;
    if (J.perm) {
        if (n0 < 512) drow = 256 * (n0 >> 7) + (n0 & 127);
        else if (n0 < 1024) drow = 256 * ((n0 - 512) >> 7) + 128 + ((n0 - 512) & 127);
        else drow = n0;
        if (n0 >= 1024 && n0 < 1536) scale = 0.125f;
    }
    float tv[32];
    const float* wp = J.W + (size_t)(k0 + (lane >> 5)) * J.N + n0 + (lane & 31);
#pragma unroll
    for (int i = 0; i < 32; ++i) tv[i] = wp[(size_t)(2 * i) * J.N];
    if (J.gain) {
#pragma unroll
        for (int i = 0; i < 32; ++i) tv[i] *= J.gain[k0 + 2 * i + (lane >> 5)];
    }
#pragma unroll
    for (int i = 0; i < 32; ++i) scr[(2 * i + (lane >> 5)) * 33 + (lane & 31)] = tv[i] * scale;
    asm volatile("s_waitcnt lgkmcnt(0)" ::: "memory");
    const int c = lane & 7;
#pragma unroll
    for (int j = 0; j < 4; ++j) { const int n = (lane >> 3) + 8 * j; const LAS float* s = scr + (8 * c) * 33 + n;
        u32x4 o; o.x = pk2(s[0 * 33], s[1 * 33]); o.y = pk2(s[2 * 33], s[3 * 33]); o.z = pk2(s[4 * 33], s[5 * 33]); o.w = pk2(s[6 * 33], s[7 * 33]);
        *(u32x4*)(J.WT + (size_t)(drow + n) * J.ldt + J.col_off + k0 + 8 * c) = o; }
    asm volatile("s_waitcnt lgkmcnt(0)" ::: "memory");
}
constexpr int N_TJOBS = 31;
DI TJob get_tjob(int j, const Args& a, unsigned char* ws) {
    TJob J; J.perm = 0; J.gain = nullptr; J.row_off = 0; J.col_off = 0;
    if (j == 0) { J.W = a.in[opq(I_WIN)]; J.K = 1024; J.N = 2560; J.WT = (bf16*)(ws + WS_WIN); J.ldt = 1024; J.perm = 1; J.gain = a.in[opq(I_NMIX)]; }
    else if (j == 1) { J.W = a.in[opq(I_WOUT)]; J.K = 1024; J.N = 1024; J.WT = (bf16*)(ws + WS_WOUT); J.ldt = 1024; }
    else if (j < 4) { const int i = j - 2; J.W = a.in[opq(I_XKV)] + (size_t)i * 1024 * 2048; J.K = 1024; J.N = 2048; J.WT = (bf16*)(ws + WS_WKV) + (size_t)i * 2048 * 1024; J.ldt = 1024; J.gain = a.in[opq(I_NMEM)] + i * 1024; }
    else if (j < 6) { const int i = j - 4; J.W = a.in[opq(I_XO)] + (size_t)i * 1024 * 1024; J.K = 1024; J.N = 1024; J.WT = (bf16*)(ws + WS_WXO) + (size_t)i * 1024 * 1024; J.ldt = 1024; }
    else if (j < 8) { const int i = j - 6; J.W = a.in[opq(I_UP)] + (size_t)i * 1024 * 4096; J.K = 1024; J.N = 4096; J.WT = (bf16*)(ws + WS_WUP) + (size_t)i * 4096 * 1024; J.ldt = 1024; J.gain = a.in[opq(I_NFFN)] + i * 1024; }
    else if (j < 10) { const int i = j - 8; J.W = a.in[opq(I_DN)] + (size_t)i * 4096 * 1024; J.K = 4096; J.N = 1024; J.WT = (bf16*)(ws + WS_WDN) + (size_t)i * 1024 * 4096; J.ldt = 4096; }
    else if (j < 26) {
        const int q = j - 10, src = q >> 1, copy = q & 1; int mu = 0;
        J.K = 1024; J.WT = (bf16*)(ws + WS_WBIG); J.ldt = 2048; J.col_off = copy * 1024;
        if (src == 0) { J.W = a.in[opq(I_WR)]; J.N = 1024; J.row_off = 0; mu = 0; }
        else if (src == 1) { J.W = a.in[opq(I_WK)]; J.N = 1024; J.row_off = 1024; mu = 2; }
        else if (src == 2) { J.W = a.in[opq(I_WV)]; J.N = 1024; J.row_off = 2048; mu = 3; }
        else if (src == 3) { J.W = a.in[opq(I_W1)]; J.N = 64; J.row_off = 3072; mu = 1; }
        else if (src == 4) { J.W = a.in[opq(I_W1)] + 1024 * 64; J.N = 64; J.row_off = 3136; mu = 1; }
        else if (src == 5) { J.W = a.in[opq(I_A1)]; J.N = 64; J.row_off = 3200; mu = 4; }
        else if (src == 6) { J.W = a.in[opq(I_A1)] + 1024 * 64; J.N = 64; J.row_off = 3264; mu = 4; }
        else { J.W = a.in[opq(I_G1)]; J.N = 160; J.row_off = 3328; mu = 5; }
        if (copy) J.gain = a.in[opq(I_MU)] + mu * 1024;
    }
    else if (j < 30) { const int q = j - 26; J.W = (q < 2 ? a.in[opq(I_W2)] : a.in[opq(I_A2)]) + (size_t)(q & 1) * 64 * 1024; J.K = 64; J.N = 1024; J.WT = (bf16*)(ws + WS_W2T) + (size_t)q * 1024 * 64; J.ldt = 64; }
    else { J.W = a.in[opq(I_WO)]; J.K = 1024; J.N = 1024; J.WT = (bf16*)(ws + WS_WRO); J.ldt = 1024; }
    return J;
}
DI void row_to_bf16_rs(const float* xrow, bf16* orow, float* rs, int lane) {
    const f32x4* xr = (const f32x4*)xrow + lane;
    f32x4 v[4]; float s = 0.f;
#pragma unroll
    for (int j = 0; j < 4; ++j) { v[j] = xr[64 * j]; s += (v[j].x * v[j].x + v[j].y * v[j].y) + (v[j].z * v[j].z + v[j].w * v[j].w); }
    s = wave_sum(s);
    u32x2* o8 = (u32x2*)orow + lane;
#pragma unroll
    for (int j = 0; j < 4; ++j) { u32x2 w; w.x = pk2(v[j].x, v[j].y); w.y = pk2(v[j].z, v[j].w); o8[64 * j] = w; }
    if (lane == 0) *rs = 1.0f / sqrtf(s * (1.0f / D) + EPS);
}
DI void rows4_to_bf16_rs(const Frame& F, const float* X, bf16* O, float* rs, int nrows) {
    for (int m0 = F.gw * 4; m0 < nrows; m0 += F.ngw * 4) {
        f32x4 v[4][4];
#pragma unroll
        for (int r = 0; r < 4; ++r)
#pragma unroll
            for (int j = 0; j < 4; ++j) v[r][j] = ((const f32x4*)(X + (size_t)(m0 + r) * D))[F.lane + 64 * j];
#pragma unroll
        for (int r = 0; r < 4; ++r) {
            float s = 0.f;
#pragma unroll
            for (int j = 0; j < 4; ++j) s += (v[r][j].x * v[r][j].x + v[r][j].y * v[r][j].y) + (v[r][j].z * v[r][j].z + v[r][j].w * v[r][j].w);
            s = wave_sum(s);
            u32x2* o8 = (u32x2*)(O + (size_t)(m0 + r) * D) + F.lane;
#pragma unroll
            for (int j = 0; j < 4; ++j) { u32x2 w; w.x = pk2(v[r][j].x, v[r][j].y); w.y = pk2(v[r][j].z, v[r][j].w); o8[64 * j] = w; }
            if (F.lane == 0) rs[m0 + r] = 1.0f / sqrtf(s * (1.0f / D) + EPS);
        }
    }
}
DI int t5_bucket(int rel) {
    const int n = rel < 0 ? -rel : rel; int r = rel > 0 ? 16 : 0;
    if (n < 8) return r + n;
    int lg = 8; lg += (n >= 12); lg += (n >= 16); lg += (n >= 23); lg += (n >= 32); lg += (n >= 46); lg += (n >= 64); lg += (n >= 91);
    return r + lg;
}
DI void phase_prologue(const Frame& F0, const Args& a, unsigned char* ws) {
    const Frame F = fresh(F0);
    LAS float* scr = (LAS float*)(F.lds + F.wave * 16384);
    for (int j = 0; j < N_TJOBS; ++j) {
        const TJob J = get_tjob(j, a, ws); const int items = (J.K / 64) * (J.N / 32);
        for (int it = F.gw; it < items; it += F.ngw) tr_item(J, scr, it, F.lane);
    }
    const int gt = F.gw * 64 + F.lane, ngt = F.ngw * 64;
    for (int i = 0; i < 2; ++i) {
        const float* W = a.in[opq(I_XQ)] + (size_t)i * 1024 * 1024; const float* g = a.in[opq(I_NXATTN)] + i * 1024; bf16* O = (bf16*)(ws + WS_WQN) + (size_t)i * 1024 * 1024;
        for (int e = gt; e < 1024 * 1024 / 4; e += ngt) { const f32x4 v = ((const f32x4*)W)[e]; const float s = g[(e * 4) >> 10] * 0.0625f; u32x2 w; w.x = pk2(v.x * s, v.y * s); w.y = pk2(v.z * s, v.w * s); ((u32x2*)O)[e] = w; }
    }
    { const float* W = a.in[opq(I_G2)]; bf16* O = (bf16*)(ws + WS_G2T);
      for (int e = gt; e < 1024 * 256; e += ngt) { const int n = e >> 8, k = e & 255; O[e] = (bf16)(k < 160 ? f2bf(W[(size_t)k * 1024 + n]) : 0u); } }
    { u32x4* O = (u32x4*)((bf16*)(ws + WS_WBIG) + (size_t)3488 * 2048);
      for (int e = gt; e < 96 * 2048 * 2 / 16; e += ngt) O[e] = (u32x4){0u, 0u, 0u, 0u}; }
    rows4_to_bf16_rs(F, a.in[opq(I_X)], (bf16*)(ws + WS_SA), (float*)(ws + WS_RS), M);
    rows4_to_bf16_rs(F, a.in[opq(I_MEM)], (bf16*)(ws + WS_MEMB), (float*)(ws + WS_RSMEM), MMEM);
    { float* B = (float*)(ws + WS_BIAS); const float* tab = a.in[opq(I_REL)];
      for (int e = gt; e < 4 * 4096; e += ngt) { const int h = e >> 12, idx = e & 4095; const int rel = idx - 2047; B[e] = idx < 4095 ? tab[t5_bucket(rel) * 4 + h] * LOG2E : 0.f; } }
    if (F.gw == 0) {
        const float q1 = a.in[opq(I_LQ1)][F.lane] * a.in[opq(I_LK1)][F.lane], q2 = a.in[opq(I_LQ2)][F.lane] * a.in[opq(I_LK2)][F.lane];
        const float s1 = wave_sum(q1), s2 = wave_sum(q2);
        if (F.lane == 0) ((float*)(ws + WS_LAM))[0] = expf(s1) - expf(s2) + 0.2f;
    }
}

DI void phase_norm(const Frame& F0, const float* h, bf16* hb, float* rs) {
    const Frame F = fresh(F0);
    for (int m = F.gw; m < M; m += F.ngw) row_to_bf16_rs(h + (size_t)m * D, hb + (size_t)m * D, rs + m, F.lane);
}
DI void phase_final_norm(const Frame& F0, float* h, const float* g) {
    const Frame F = fresh(F0);
    f32x4 gv[4];
#pragma unroll
    for (int j = 0; j < 4; ++j) gv[j] = ((const f32x4*)g)[F.lane + 64 * j];
    for (int m = F.gw; m < M; m += F.ngw) {
        f32x4* xr = (f32x4*)(h + (size_t)m * D) + F.lane;
        f32x4 v[4]; float s = 0.f;
#pragma unroll
        for (int j = 0; j < 4; ++j) { v[j] = xr[64 * j]; s += (v[j].x * v[j].x + v[j].y * v[j].y) + (v[j].z * v[j].z + v[j].w * v[j].w); }
        const float r = 1.0f / sqrtf(wave_sum(s) * (1.0f / D) + EPS);
#pragma unroll
        for (int j = 0; j < 4; ++j) xr[64 * j] = v[j] * r * gv[j];
    }
}
DI void phase_rwkv_shift(const Frame& F0, const float* h, const float* g, bf16* A1) {
    const Frame F = fresh(F0);
    f32x4 gv[4];
#pragma unroll
    for (int j = 0; j < 4; ++j) gv[j] = ((const f32x4*)g)[F.lane + 64 * j];
    for (int ch = F.gw; ch < M / 16; ch += F.ngw) {
        const int m0 = ch * 16, t0 = m0 & (T - 1);
        f32x4 p2[4], p1[4], cu[4];
#pragma unroll
        for (int j = 0; j < 4; ++j) { p2[j] = (f32x4){0.f, 0.f, 0.f, 0.f}; p1[j] = p2[j]; cu[j] = p2[j]; }
        for (int i = -1; i <= 16; ++i) {
            const int t = t0 + i;
#pragma unroll
            for (int j = 0; j < 4; ++j) { p2[j] = p1[j]; p1[j] = cu[j]; }
            if (t >= 0 && t < T) {
                const f32x4* xr = (const f32x4*)(h + (size_t)(m0 + i) * D) + F.lane; float s = 0.f;
#pragma unroll
                for (int j = 0; j < 4; ++j) { cu[j] = xr[64 * j]; s += (cu[j].x * cu[j].x + cu[j].y * cu[j].y) + (cu[j].z * cu[j].z + cu[j].w * cu[j].w); }
                const float r = 1.0f / sqrtf(wave_sum(s) * (1.0f / D) + EPS);
#pragma unroll
                for (int j = 0; j < 4; ++j) cu[j] = cu[j] * r * gv[j];
            } else {
#pragma unroll
                for (int j = 0; j < 4; ++j) cu[j] = (f32x4){0.f, 0.f, 0.f, 0.f};
            }
            if (i >= 1) {
                u32x2* o = (u32x2*)(A1 + (size_t)(m0 + i - 1) * 2048) + F.lane;
#pragma unroll
                for (int j = 0; j < 4; ++j) { const f32x4 hh = (p2[j] + cu[j]) * 0.5f - p1[j];
                    u32x2 w; w.x = pk2(p1[j].x, p1[j].y); w.y = pk2(p1[j].z, p1[j].w); o[64 * j] = w;
                    u32x2 w2; w2.x = pk2(hh.x, hh.y); w2.y = pk2(hh.z, hh.w); o[256 + 64 * j] = w2; }
            }
        }
    }
}
DI void phase_rwkv_comb(const Frame& F0, const bf16* YF, const bf16* YB, const bf16* V, const bf16* GT, const float* BON, const float* lng, const float* lnb, bf16* O) {
    const Frame F = fresh(F0);
    const int hd = F.lane >> 2, c0 = F.lane * 16;
    float lg[16], lb[16];
#pragma unroll
    for (int j = 0; j < 16; ++j) { lg[j] = lng[c0 + j]; lb[j] = lnb[c0 + j]; }
    for (int m = F.gw; m < M; m += F.ngw) {
        const size_t off = (size_t)m * D + c0;
        u32x4 a[2], b[2], vv[2], gg[2];
#pragma unroll
        for (int q = 0; q < 2; ++q) { a[q] = ((const u32x4*)(YF + off))[q]; b[q] = ((const u32x4*)(YB + off))[q]; vv[q] = ((const u32x4*)(V + off))[q]; gg[q] = ((const u32x4*)(GT + off))[q]; }
        const float bon = BON[(size_t)m * 16 + hd] + BON[(size_t)(M + m) * 16 + hd];
        float y[16]; float s = 0.f;
#pragma unroll
        for (int q = 0; q < 2; ++q)
#pragma unroll
            for (int w = 0; w < 4; ++w) { y[q * 8 + 2 * w] = bflo(a[q][w]) + bflo(b[q][w]); y[q * 8 + 2 * w + 1] = bfhi(a[q][w]) + bfhi(b[q][w]); }
#pragma unroll
        for (int j = 0; j < 16; ++j) s += y[j];
        s += swz_xor<1>(s); s += swz_xor<2>(s);
        const float mean = s * (1.0f / 64.0f); float q2 = 0.f;
#pragma unroll
        for (int j = 0; j < 16; ++j) { y[j] -= mean; q2 += y[j] * y[j]; }
        q2 += swz_xor<1>(q2); q2 += swz_xor<2>(q2);
        const float rstd = 1.0f / sqrtf(q2 * (1.0f / 64.0f) + 64e-5f);
        u32x4 o[2];
#pragma unroll
        for (int q = 0; q < 2; ++q)
#pragma unroll
            for (int w = 0; w < 4; ++w) {
                const int j = q * 8 + 2 * w;
                const float r0 = (y[j] * rstd * lg[j] + lb[j] + bon * bflo(vv[q][w])) * bflo(gg[q][w]);
                const float r1 = (y[j + 1] * rstd * lg[j + 1] + lb[j + 1] + bon * bfhi(vv[q][w])) * bfhi(gg[q][w]);
                o[q][w] = pk2(r0, r1);
            }
        ((u32x4*)(O + off))[0] = o[0]; ((u32x4*)(O + off))[1] = o[1];
    }
}

constexpr int CV_ROWB = 1040, CV_IN_BYTES = 94 * CV_ROWB, CV_W_OFF = CV_IN_BYTES;
DI void conv_load_weights(const Frame& F0, const float* cw) {
    const Frame F = fresh(F0);
    LAS bf16* W = (LAS bf16*)(F.lds + CV_W_OFF);
    for (int e = F.tid; e < 31 * 512; e += 512) W[e] = (bf16)f2bf(cw[e]);
}
DI void conv_unit(const Frame& F0, int unit, const bf16* GLU, const float* cb, const float* lg, const float* lb, bf16* MIX) {
    const Frame F = fresh(F0);
    const int b = unit >> 5, t0 = (unit & 31) * 64;
    __syncthreads();
    for (int p = F.tid; p < 94 * 64; p += 512) {
        const int r = p >> 6, c = p & 63, t = t0 - 15 + r;
        u32x4 v = (u32x4){0u, 0u, 0u, 0u};
        if (t >= 0 && t < T) v = *(const u32x4*)(GLU + (size_t)(b * T + t) * 512 + c * 8);
        *(LAS u32x4*)(F.lds + r * CV_ROWB + c * 16) = v;
    }
    __syncthreads();
    const int tl = F.tid >> 3, chunk = F.tid & 7;
    float y[64];
#pragma unroll
    for (int i = 0; i < 8; ++i) {
        const int cg = chunk + 8 * i;
        float acc[8];
#pragma unroll
        for (int e = 0; e < 8; ++e) acc[e] = cb[cg * 8 + e];
#pragma unroll 1
        for (int j = 0; j < 31; ++j) {
            const u32x4 x = *(const LAS u32x4*)(F.lds + (tl + j) * CV_ROWB + cg * 16);
            const u32x4 w = *(const LAS u32x4*)(F.lds + CV_W_OFF + j * 1024 + cg * 16);
#pragma unroll
            for (int q = 0; q < 4; ++q) { acc[2 * q] += bflo(x[q]) * bflo(w[q]); acc[2 * q + 1] += bfhi(x[q]) * bfhi(w[q]); }
        }
#pragma unroll
        for (int e = 0; e < 8; ++e) y[i * 8 + e] = acc[e];
    }
    float s = 0.f;
#pragma unroll
    for (int j = 0; j < 64; ++j) s += y[j];
    s += swz_xor<1>(s); s += swz_xor<2>(s); s += swz_xor<4>(s);
    const float mean = s * (1.0f / 512.0f); float q2 = 0.f;
#pragma unroll
    for (int j = 0; j < 64; ++j) { y[j] -= mean; q2 += y[j] * y[j]; }
    q2 += swz_xor<1>(q2); q2 += swz_xor<2>(q2); q2 += swz_xor<4>(q2);
    const float rstd = 1.0f / sqrtf(q2 * (1.0f / 512.0f) + 1e-5f);
    bf16* orow = MIX + (size_t)(b * T + t0 + tl) * 1024;
#pragma unroll
    for (int i = 0; i < 8; ++i) {
        const int c0 = (chunk + 8 * i) * 8;
        const f32x4 g0 = *(const f32x4*)(lg + c0), g1 = *(const f32x4*)(lg + c0 + 4), b0 = *(const f32x4*)(lb + c0), b1 = *(const f32x4*)(lb + c0 + 4);
        f32x4 o0, o1;
#pragma unroll
        for (int e = 0; e < 4; ++e) { const float v0 = y[i * 8 + e] * rstd * g0[e] + b0[e], v1 = y[i * 8 + 4 + e] * rstd * g1[e] + b1[e]; o0[e] = v0 * sigmoidf_(v0); o1[e] = v1 * sigmoidf_(v1); }
        store8(orow + c0, o0, o1);
    }
}

constexpr int DA_KROW = 272, DA_VROW = 136, DA_KB = 64 * DA_KROW, DA_VB = 128 * DA_VROW, DA_BUF = DA_KB + DA_VB;
DI int crow(int reg, int hf) { return (reg & 3) + 8 * (reg >> 2) + 4 * hf; }
DI void diffattn_unit(const Frame& F0, int unit, const bf16* QK, const bf16* VT, const float* BIAS, const float lam, const float* subg, bf16* MIX) {
    const Frame F = fresh(F0);
    const int b = unit >> 6, h = (unit >> 4) & 3, qb = unit & 15;
    const int c = F.wave >> 2, qs = F.wave & 3, r32 = F.lane & 31, hf = F.lane >> 5;
    const int q0w = qb * 128 + qs * 32;
    const float* bias_h = BIAS + h * 4096 + 2047;
    bf16x8 Qf[4];
    { const bf16* qp = QK + (size_t)(b * T + q0w + r32) * 1024 + h * 128 + c * 64 + 8 * hf;
#pragma unroll
      for (int ks = 0; ks < 4; ++ks) Qf[ks] = *(const bf16x8*)(qp + 16 * ks); }
    const bf16* kg[2]; const bf16* vg[2]; int kl[2], vl[2];
#pragma unroll
    for (int i = 0; i < 2; ++i) { const int p = F.tid + 512 * i;
        kg[i] = QK + (size_t)(b * T + (p >> 4)) * 1024 + 512 + h * 128 + (p & 15) * 8; kl[i] = (p >> 4) * DA_KROW + (p & 15) * 16;
        vg[i] = VT + (size_t)(h * 128 + (p >> 3)) * M + b * T + (p & 7) * 8; vl[i] = DA_KB + (p >> 3) * DA_VROW + (p & 7) * 16; }
    u32x4 kr[2], vr[2];
#pragma unroll
    for (int i = 0; i < 2; ++i) { kr[i] = *(const u32x4*)(kg[i]); vr[i] = *(const u32x4*)(vg[i]); }
    __syncthreads();
#pragma unroll
    for (int i = 0; i < 2; ++i) { *(LAS u32x4*)(F.lds + kl[i]) = kr[i]; *(LAS u32x2*)(F.lds + vl[i]) = (u32x2){vr[i].x, vr[i].y}; *(LAS u32x2*)(F.lds + vl[i] + 8) = (u32x2){vr[i].z, vr[i].w}; }
    __syncthreads();
    f32x16 O[4];
#pragma unroll
    for (int vt = 0; vt < 4; ++vt)
#pragma unroll
        for (int i = 0; i < 16; ++i) O[vt][i] = 0.f;
    float lsum = 0.f;
    const int ka = r32 * DA_KROW + c * 128 + 16 * hf;
    const int va = DA_KB + r32 * DA_VROW + 8 * hf;
    for (int kt = 0; kt < 32; ++kt) {
        const int k0 = kt * 64;
        LAS unsigned char* buf = F.lds + (kt & 1) * DA_BUF;
        if (kt + 1 < 32) {
#pragma unroll
            for (int i = 0; i < 2; ++i) { kr[i] = *(const u32x4*)(kg[i] + (size_t)(k0 + 64) * 1024); vr[i] = *(const u32x4*)(vg[i] + k0 + 64); }
        }
        const int dmin = k0 - (q0w + 31), dmax = k0 + 63 - q0w;
        const bool far = (dmin >= 91) || (dmax <= -91);
        const float cb = dmin >= 91 ? bias_h[91] : bias_h[-91];
#pragma unroll
        for (int sub = 0; sub < 2; ++sub) {
            f32x16 S;
#pragma unroll
            for (int i = 0; i < 16; ++i) S[i] = 0.f;
#pragma unroll
            for (int ks = 0; ks < 4; ++ks) { const bf16x8 a = *(const LAS bf16x8*)(buf + ka + sub * 32 * DA_KROW + ks * 32); S = __builtin_amdgcn_mfma_f32_32x32x16_bf16(a, Qf[ks], S, 0, 0, 0); }
            float p[16];
            if (far) {
#pragma unroll
                for (int i = 0; i < 16; ++i) p[i] = fexp2(S[i] * LOG2E + cb);
            } else {
                const int rel0 = k0 + 32 * sub - (q0w + r32);
#pragma unroll
                for (int i = 0; i < 16; ++i) p[i] = fexp2(S[i] * LOG2E + bias_h[rel0 + crow(i, hf)]);
            }
#pragma unroll
            for (int i = 0; i < 16; ++i) lsum += p[i];
#pragma unroll
            for (int s = 0; s < 2; ++s) {
                u32x4 pw; pw.x = pk2(p[8 * s], p[8 * s + 1]); pw.y = pk2(p[8 * s + 2], p[8 * s + 3]); pw.z = pk2(p[8 * s + 4], p[8 * s + 5]); pw.w = pk2(p[8 * s + 6], p[8 * s + 7]);
                const bf16x8 pa = __builtin_bit_cast(bf16x8, pw);
#pragma unroll
                for (int vt = 0; vt < 4; ++vt) {
                    const LAS unsigned char* vp = buf + va + vt * 32 * DA_VROW + (32 * sub + 16 * s) * 2;
                    const u32x2 lo = *(const LAS u32x2*)(vp), hi = *(const LAS u32x2*)(vp + 16);
                    const u32x4 vw = (u32x4){lo.x, lo.y, hi.x, hi.y};
                    O[vt] = __builtin_amdgcn_mfma_f32_32x32x16_bf16(pa, __builtin_bit_cast(bf16x8, vw), O[vt], 0, 0, 0);
                }
            }
        }
        if (kt + 1 < 32) {
            LAS unsigned char* nb = F.lds + ((kt + 1) & 1) * DA_BUF;
#pragma unroll
            for (int i = 0; i < 2; ++i) { *(LAS u32x4*)(nb + kl[i]) = kr[i]; *(LAS u32x2*)(nb + vl[i]) = (u32x2){vr[i].x, vr[i].y}; *(LAS u32x2*)(nb + vl[i] + 8) = (u32x2){vr[i].z, vr[i].w}; }
        }
        __syncthreads();
    }
    lsum = half_sum(lsum);
    LAS float* XO = (LAS float*)F.lds;
    LAS float* LW = (LAS float*)(F.lds + 65536) + F.wave * 32;
    if (hf == 0) LW[r32] = 1.0f / lsum;
    asm volatile("s_waitcnt lgkmcnt(0)" ::: "memory");
    float il[16];
#pragma unroll
    for (int i = 0; i < 16; ++i) il[i] = LW[crow(i, hf)];
    if (c == 1) {
#pragma unroll
        for (int vt = 0; vt < 4; ++vt)
#pragma unroll
            for (int i = 0; i < 16; ++i) XO[(qs * 32 + crow(i, hf)) * 128 + vt * 32 + r32] = O[vt][i] * il[i];
    }
    __syncthreads();
    if (c == 0) {
        float ss[16];
#pragma unroll
        for (int i = 0; i < 16; ++i) ss[i] = 0.f;
#pragma unroll
        for (int vt = 0; vt < 4; ++vt)
#pragma unroll
            for (int i = 0; i < 16; ++i) { const float o = O[vt][i] * il[i] - lam * XO[(qs * 32 + crow(i, hf)) * 128 + vt * 32 + r32]; O[vt][i] = o; ss[i] += o * o; }
#pragma unroll
        for (int i = 0; i < 16; ++i) { float v = ss[i]; v += swz_xor<1>(v); v += swz_xor<2>(v); v += swz_xor<4>(v); v += swz_xor<8>(v); v += swz_xor<16>(v); ss[i] = 0.8f / sqrtf(v * (1.0f / 128.0f) + EPS); }
#pragma unroll
        for (int vt = 0; vt < 4; ++vt) {
            const float g = subg[vt * 32 + r32];
#pragma unroll
            for (int i = 0; i < 16; ++i) MIX[(size_t)(b * T + q0w + crow(i, hf)) * 1024 + 512 + h * 128 + vt * 32 + r32] = (bf16)f2bf(O[vt][i] * ss[i] * g);
        }
    }
}

constexpr int SC_VECB = 256, SC_STEPB = 6 * SC_VECB, SC_BUFB = 16 * SC_STEPB;
constexpr int SC_SCR_OFF = 4 * SC_BUFB, SC_SCR_W = 16 * 68 * 4;
DI float dpp_x1(float v) { return __builtin_bit_cast(float, __builtin_amdgcn_update_dpp(0, __builtin_bit_cast(int, v), 0xB1, 0xF, 0xF, true)); }
DI float dpp_x2(float v) { return __builtin_bit_cast(float, __builtin_amdgcn_update_dpp(0, __builtin_bit_cast(int, v), 0x4E, 0xF, 0xF, true)); }
DI float quad_sum(float v) { v += dpp_x1(v); v += dpp_x2(v); return v; }

DI float a_fmac(float acc, float a, float b) { return __builtin_fmaf(a, b, acc); }
DI float a_fma(float a, float b, float c) { return __builtin_fmaf(a, b, c); }
DI float a_mul(float a, float b) { return a * b; }
struct ScanPtrs { const bf16 *R, *K, *V, *HD1, *W2T; const float *w0, *a0, *kk, *ka, *rk; bf16 *YF, *YB; float* BON; };

DI void scan_pair(const Frame& F0, int bh, const ScanPtrs& P) {
    const Frame F = fresh(F0);
    const int b = bh >> 4, h = bh & 15;
    __syncthreads();
    if (F.wave < 4) {
        const int z = F.wave >> 1, rh = F.wave & 1, rp = F.lane >> 2, jq = F.lane & 3, i0 = rh * 32 + 2 * rp;
        float S0[16], S1[16];
#pragma unroll
        for (int j = 0; j < 16; ++j) { S0[j] = 0.f; S1[j] = 0.f; }
        bf16* Y = z ? P.YB : P.YF;
        __builtin_amdgcn_s_barrier();
#ifdef MK_TPROBE
        unsigned long long tp_acc = 0ull, tp_phase0 = __builtin_amdgcn_s_memtime();
#endif
        for (int e = 0; e < T / 16; ++e) {
#ifdef MK_TPROBE
            const unsigned long long tp0 = __builtin_amdgcn_s_memtime();
#endif
            const LAS unsigned char* base = F.lds + (z * 2 + (e & 1)) * SC_BUFB + jq * 64;
            const int t0c = z ? T - 16 * (e + 1) : 16 * e;
            bf16* yrow = Y + (size_t)(b * T + t0c) * 1024 + h * 64 + i0;
            f32x4 wv[2][4], kv[2][4], bv[2][4], av[2][4], rv[2][4]; f32x2 v2[2];
#define SC_FETCH(slot, li_) do { const LAS unsigned char* sb_ = base + (li_) * SC_STEPB; _Pragma("unroll") for (int q = 0; q < 4; ++q) { \
                av[slot][q] = *(const LAS f32x4*)(sb_ + 3 * SC_VECB + q * 16); wv[slot][q] = *(const LAS f32x4*)(sb_ + q * 16); kv[slot][q] = *(const LAS f32x4*)(sb_ + SC_VECB + q * 16); \
                bv[slot][q] = *(const LAS f32x4*)(sb_ + 2 * SC_VECB + q * 16); rv[slot][q] = *(const LAS f32x4*)(sb_ + 4 * SC_VECB + q * 16); } \
                v2[slot] = *(const LAS f32x2*)(sb_ - jq * 64 + 5 * SC_VECB + i0 * 4); } while (0)
            SC_FETCH(0, z ? 15 : 0);
#pragma unroll
            for (int s = 0; s < 16; ++s) {
                const int li = z ? 15 - s : s, cs = s & 1, ns = cs ^ 1;
                if (s < 15) SC_FETCH(ns, z ? 14 - s : s + 1);
                __builtin_amdgcn_sched_barrier(0);
                float sa0 = 0.f, sa1 = 0.f, sb0 = 0.f, sb1 = 0.f;
#pragma unroll
                for (int j = 0; j < 16; j += 2) { const float a0 = av[cs][j >> 2][j & 3], a1 = av[cs][(j + 1) >> 2][(j + 1) & 3];
                    sa0 = a_fmac(sa0, S0[j], a0); sb0 = a_fmac(sb0, S1[j], a0); sa1 = a_fmac(sa1, S0[j + 1], a1); sb1 = a_fmac(sb1, S1[j + 1], a1); }
                const float sa = quad_sum(sa0 + sa1), sb = quad_sum(sb0 + sb1);
                const float v0 = v2[cs].x, v1 = v2[cs].y;
                float y0 = 0.f, y1 = 0.f, z0 = 0.f, z1 = 0.f;
#pragma unroll
                for (int j = 0; j < 16; ++j) {
                    const float wj = wv[cs][j >> 2][j & 3], bj = bv[cs][j >> 2][j & 3], kj = kv[cs][j >> 2][j & 3], rj = rv[cs][j >> 2][j & 3];
                    S0[j] = a_fma(S0[j], wj, a_fma(sa, bj, a_mul(v0, kj)));
                    S1[j] = a_fma(S1[j], wj, a_fma(sb, bj, a_mul(v1, kj)));
                    if (j & 1) { y1 = a_fmac(y1, S0[j], rj); z1 = a_fmac(z1, S1[j], rj); } else { y0 = a_fmac(y0, S0[j], rj); z0 = a_fmac(z0, S1[j], rj); }
                }
                f32x2 y; y.x = quad_sum(y0 + y1); y.y = quad_sum(z0 + z1);
                if (jq == 0) *(unsigned*)(yrow + (size_t)li * 1024) = pk2(y.x, y.y);
                __builtin_amdgcn_sched_barrier(0);
            }
#undef SC_FETCH
            asm volatile("s_waitcnt lgkmcnt(0)" ::: "memory");
#ifdef MK_TPROBE
            tp_acc += __builtin_amdgcn_s_memtime() - tp0;
#endif
            __builtin_amdgcn_s_barrier();
        }
#ifdef MK_TPROBE
        if (blockIdx.x == 0 && F.wave == 0) {
            const unsigned long long tot = __builtin_amdgcn_s_memtime() - tp_phase0;
            const unsigned long long amt = (MK_TPROBE > 0 ? (unsigned long long)MK_TPROBE * tp_acc : (unsigned long long)(-(MK_TPROBE)) * (tot - tp_acc));
            const unsigned long long w0 = __builtin_amdgcn_s_memtime();
            while (__builtin_amdgcn_s_memtime() - w0 < amt) __builtin_amdgcn_s_sleep(8);
        }
#endif
    } else {
        const int pw = F.wave - 4, z = pw >> 1, par = pw & 1;
        const int l15 = F.lane & 15, l4 = F.lane >> 4, row = F.lane >> 2, cq = F.lane & 3;
        const bf16* w2p = P.W2T + (size_t)z * 65536 + (size_t)(h * 64 + l15) * 64 + 8 * l4;
        const int ch0 = h * 64 + cq * 16;
        LAS float* scrW = (LAS float*)(F.lds + SC_SCR_OFF + pw * 2 * SC_SCR_W);
        LAS float* scrA = scrW + 16 * 68;
        bf16x8 Ahw[2], Aha[2]; u32x4 r16[2], k16[2], v16[2];
        auto do_load = [&](int c) {
            const int t0c = z ? T - 16 * (c + 1) : 16 * c; const size_t m0 = (size_t)b * T + t0c;
#pragma unroll
            for (int ks = 0; ks < 2; ++ks) { const bf16* p = P.HD1 + (m0 + l15) * 256 + z * 64 + 32 * ks + 8 * l4; Ahw[ks] = *(const bf16x8*)p; Aha[ks] = *(const bf16x8*)(p + 128); }
            const size_t off = (m0 + row) * 1024 + ch0;
#pragma unroll
            for (int q = 0; q < 2; ++q) { r16[q] = ((const u32x4*)(P.R + off))[q]; k16[q] = ((const u32x4*)(P.K + off))[q]; v16[q] = ((const u32x4*)(P.V + off))[q]; }
        };
        auto do_compute = [&](int c) {
            const int t0c = z ? T - 16 * (c + 1) : 16 * c; const size_t m0 = (size_t)b * T + t0c;
#pragma unroll
            for (int nt = 0; nt < 4; ++nt) {
                f32x4 dw = (f32x4){0.f, 0.f, 0.f, 0.f}, da = dw;
#pragma unroll
                for (int ks = 0; ks < 2; ++ks) { const bf16x8 wf = *(const bf16x8*)(w2p + nt * 1024 + ks * 32), af = *(const bf16x8*)(w2p + 2 * 65536 + nt * 1024 + ks * 32);
                    dw = __builtin_amdgcn_mfma_f32_16x16x32_bf16(Ahw[ks], wf, dw, 0, 0, 0); da = __builtin_amdgcn_mfma_f32_16x16x32_bf16(Aha[ks], af, da, 0, 0, 0); }
#pragma unroll
                for (int rg = 0; rg < 4; ++rg) { scrW[(4 * l4 + rg) * 68 + 16 * nt + l15] = dw[rg]; scrA[(4 * l4 + rg) * 68 + 16 * nt + l15] = da[rg]; }
            }
            asm volatile("s_waitcnt lgkmcnt(0)" ::: "memory");
            float ssq = 0.f;
#pragma unroll
            for (int q = 0; q < 2; ++q)
#pragma unroll
                for (int w = 0; w < 4; ++w) { const f32x2 kc = *(const f32x2*)(P.kk + ch0 + q * 8 + 2 * w); const float k0 = bflo(k16[q][w]) * kc.x, k1 = bfhi(k16[q][w]) * kc.y; ssq += k0 * k0 + k1 * k1; }
            ssq = quad_sum(ssq);
            const float inv = 1.0f / fmaxf(sqrtf(ssq), 1e-12f);
            float bon = 0.f;
            LAS unsigned char* sb = F.lds + (z * 2 + (c & 1)) * SC_BUFB + row * SC_STEPB + cq * 64;
#pragma unroll
            for (int q = 0; q < 4; ++q) {
                const f32x4 wp = *(const LAS f32x4*)(scrW + row * 68 + cq * 16 + q * 4), ap = *(const LAS f32x4*)(scrA + row * 68 + cq * 16 + q * 4);
                const f32x4 w0v = *(const f32x4*)(P.w0 + z * 1024 + ch0 + q * 4), a0v = *(const f32x4*)(P.a0 + z * 1024 + ch0 + q * 4);
                const f32x4 kkv = *(const f32x4*)(P.kk + ch0 + q * 4), kav = *(const f32x4*)(P.ka + ch0 + q * 4), rkv = *(const f32x4*)(P.rk + ch0 + q * 4);
                const unsigned kw0 = k16[q >> 1][(q & 1) * 2], kw1 = k16[q >> 1][(q & 1) * 2 + 1], rw0 = r16[q >> 1][(q & 1) * 2], rw1 = r16[q >> 1][(q & 1) * 2 + 1], vw0 = v16[q >> 1][(q & 1) * 2], vw1 = v16[q >> 1][(q & 1) * 2 + 1];
                const f32x4 kf = (f32x4){bflo(kw0), bfhi(kw0), bflo(kw1), bfhi(kw1)}, rf = (f32x4){bflo(rw0), bfhi(rw0), bflo(rw1), bfhi(rw1)}, vf = (f32x4){bflo(vw0), bfhi(vw0), bflo(vw1), bfhi(vw1)};
                f32x4 ow, ok, ob, oa;
#pragma unroll
                for (int j = 0; j < 4; ++j) {
                    const float dec = fexp2(-0.60653066f * LOG2E * sigmoidf_(wp[j] + w0v[j]));
                    const float ar = sigmoidf_(ap[j] + a0v[j]);
                    const float kkn = kf[j] * kkv[j] * inv;
                    const float kd = kf[j] * (1.0f + (ar - 1.0f) * kav[j]);
                    ow[j] = dec; ok[j] = kd; ob[j] = kkn * ar; oa[j] = -kkn;
                    bon += rf[j] * kd * rkv[j];
                }
                *(LAS f32x4*)(sb + q * 16) = ow; *(LAS f32x4*)(sb + SC_VECB + q * 16) = ok; *(LAS f32x4*)(sb + 2 * SC_VECB + q * 16) = ob;
                *(LAS f32x4*)(sb + 3 * SC_VECB + q * 16) = oa; *(LAS f32x4*)(sb + 4 * SC_VECB + q * 16) = rf; *(LAS f32x4*)(sb + 5 * SC_VECB + q * 16) = vf;
            }
            bon = quad_sum(bon);
            if (cq == 0) P.BON[((size_t)z * M + m0 + row) * 16 + h] = bon;
            asm volatile("s_waitcnt lgkmcnt(0)" ::: "memory");
        };
        if (par == 0) { do_load(0); do_compute(0); } else do_load(1);
        __builtin_amdgcn_s_barrier();
        for (int e = 0; e < T / 16; ++e) {
            if (((e + 1) & 1) == par) { if (e + 1 < T / 16) do_compute(e + 1); }
            else { if (e + 2 < T / 16) do_load(e + 2); }
            __builtin_amdgcn_s_barrier();
        }
    }
}


#define XB_TMO      128
#define XB_XCNT(j)  (256  + 64 * (j))
#define XB_XSUB(j)  (1280 + 64 * (j))
#define XB_XGEN(j)  (2304 + 64 * (j))
#define XB_TOP      3328
#define XB_TOPGEN   3392
#define XCD_BAR_WORDS 3456
#define XB_SPIN_CAP (1u << 22)
DI unsigned xb_ld(unsigned* p)              { return __hip_atomic_load(p, __ATOMIC_RELAXED, __HIP_MEMORY_SCOPE_AGENT); }
DI unsigned xb_add(unsigned* p, unsigned v) { return __hip_atomic_fetch_add(p, v, __ATOMIC_RELAXED, __HIP_MEMORY_SCOPE_AGENT); }
DI unsigned xb_xcc_id() { return (unsigned)__builtin_amdgcn_s_getreg((3 << 11) | 20) & 0xFu; }
#define XB_SPIN(cond, bar) do { unsigned _sp = 0; while (cond) { __builtin_amdgcn_s_sleep(1); \
    if ((++_sp & 255u) == 0u) { if (xb_ld(&(bar)[XB_TMO])) break; if (_sp > XB_SPIN_CAP) { atomicAdd(&(bar)[XB_TMO], 1u); break; } } } } while (0)
struct XcdBarrier { unsigned* bar; unsigned x; volatile LAS unsigned* st; };
DI XcdBarrier xcd_barrier_post(unsigned* bar, volatile LAS unsigned* st) {
    XcdBarrier b; b.bar = bar; b.x = xb_xcc_id(); b.st = st;
    if (threadIdx.x == 0) (void)xb_add(&bar[XB_XCNT(b.x)], 1u);
    return b;
}
DI void xcd_barrier_complete(unsigned* bar, unsigned x, unsigned& nloc, unsigned& nx) {
    const unsigned G = gridDim.x * gridDim.y * gridDim.z;
    unsigned sum, cnt, mine, sp = 0u;
    for (;;) {
        sum = 0u; cnt = 0u; mine = 0u;
#pragma unroll
        for (unsigned j = 0; j < 16; ++j) { const unsigned c = xb_ld(&bar[XB_XCNT(j)]); sum += c; cnt += (c > 0u) ? 1u : 0u; mine = (j == x) ? c : mine; }
        if (sum == G) break;
        __builtin_amdgcn_s_sleep(1);
        if ((++sp & 255u) == 0u) { if (xb_ld(&bar[XB_TMO])) break; if (sp > XB_SPIN_CAP) { atomicAdd(&bar[XB_TMO], 1u); break; } }
    }
    nloc = mine > 0u ? mine : 1u; nx = cnt > 0u ? cnt : 1u;
}
DI void xcd_barrier(const XcdBarrier& b) {
    asm volatile("s_waitcnt vmcnt(0)" ::: "memory");
    __syncthreads();
    if (threadIdx.x == 0) {
        unsigned* bar = b.bar;
        __builtin_amdgcn_s_waitcnt(0);
        unsigned nloc = b.st[0], nx = b.st[1];
        if (nloc == 0u) { xcd_barrier_complete(bar, b.x, nloc, nx); b.st[0] = nloc; b.st[1] = nx; }
        const unsigned old = xb_add(&bar[XB_XSUB(b.x)], 1u);
        const unsigned gen = old / nloc;
        if (old + 1u == (gen + 1u) * nloc) {
            __builtin_amdgcn_fence(__ATOMIC_RELEASE, "agent");
            asm volatile("s_waitcnt vmcnt(0)" ::: "memory");
            const unsigned og = xb_add(&bar[XB_TOP], 1u);
            const unsigned tg = og / nx;
            if (og + 1u == (tg + 1u) * nx) xb_add(&bar[XB_TOPGEN], 1u);
            else XB_SPIN(xb_ld(&bar[XB_TOPGEN]) == tg, bar);
            __builtin_amdgcn_fence(__ATOMIC_ACQUIRE, "agent");
            xb_add(&bar[XB_XGEN(b.x)], 1u);
            asm volatile("s_waitcnt vmcnt(0)" ::: "memory");
        } else {
            XB_SPIN(xb_ld(&bar[XB_XGEN(b.x)]) == gen, bar);
            __builtin_amdgcn_fence(__ATOMIC_ACQUIRE, "agent");
            asm volatile("s_waitcnt vmcnt(0)" ::: "memory");
        }
    }
    __syncthreads();
}

#ifndef MK_PROG
#define MK_PROG 0,1,2,3,4,5,7,8,10,11,12,13,14,15,16,17,19,20,22,23,24
#endif
__constant__ int PROG[] = {MK_PROG};
constexpr int NPH = sizeof(PROG) / sizeof(int);
template <int TYPE> struct PreSched {
    const bf16* KV; const bf16* W; int G, c;
    DI bool next(int i, Unit& u) const {
        const long L = (long)i * G + c; if (L >= 512) return false;
        const int rem = (int)L, i2 = rem >> 8, b = (rem >> 4) & 15, hh = (rem >> 2) & 3, t4 = rem & 3;
        u.pm = 0; u.pn = 0;
        const bf16* kvp = KV + (size_t)(b * 256) * 4096 + i2 * 2048 + hh * 256;
        const bf16* wp = W + (size_t)i2 * 1024 * 1024 + (size_t)(t4 * 256) * 1024 + hh * 256;
        if (TYPE == 0) { u.pa = (const char*)kvp; u.pb = (const char*)wp; u.z = (i2 << 30) | (b * 1048576 + hh * 256 * 1024 + t4 * 256); }
        else { u.pa = (const char*)wp; u.pb = (const char*)(kvp + 1024); u.z = (i2 << 30) | (16 * 1048576 + b * 1048576 + t4 * 256 * 1024 + hh * 256); }
        return true;
    }
};

__global__ void __launch_bounds__(512, 2) mk_fwd(Args a) {
    extern __shared__ __attribute__((aligned(16))) unsigned char lds_raw[];
    Frame F;
    F.lds = (LAS unsigned char*)lds_raw;
    F.tid = threadIdx.x; F.lane = F.tid & 63; F.wave = __builtin_amdgcn_readfirstlane(F.tid >> 6);
    F.gw = blockIdx.x * 8 + F.wave; F.ngw = gridDim.x * 8; F.ws = a.ws;
    cg::grid_group grid = cg::this_grid();
    volatile LAS unsigned* MISC = (volatile LAS unsigned*)(F.lds + LDS_MISC);
    if (F.tid < 2) MISC[F.tid] = 0u;
    __syncthreads();
    (void)xcd_barrier_post((unsigned*)(a.ws + WS_BAR), MISC);

    for (int pi = a.ph_lo; pi < a.ph_hi; ++pi) {
        const int ph = PROG[pi];
        const int G = opq(gridDim.x), cblk = opq(blockIdx.x);
        unsigned char* ws = a.ws + (size_t)opq(0);
        float* RS = (float*)(ws + WS_RS);
        bf16* SA = (bf16*)(ws + WS_SA); bf16* SB = (bf16*)(ws + WS_SB);
        const int li = ph >= 18 ? 1 : 0;
        int cp = ph; if (ph >= 18 && ph <= 23) cp = ph - 12;
#ifndef PH_MASK
#define PH_MASK 0xffffffffu
#endif
        if (!((PH_MASK >> cp) & 1u)) cp = 99;
        switch (cp) {
        case 0: phase_prologue(F, a, ws); break;
        case 1: {
            pg8::PlainSched S{(const bf16*)(ws + WS_MEMB), (const bf16*)(ws + WS_WKV), 1024, 1024, MMEM / 256, 16, G, cblk, 30, 0};
            EpiRowScale<0> E{(bf16*)(ws + WS_KV), 4096, (const float*)(ws + WS_RSMEM), nullptr};
            pg8::gemm_phase(F.lds, 1024, 1024, 1024, S, E);
        } break;
        case 2: {
            EpiPre E{(bf16*)(ws + WS_G0)};
            { PreSched<0> S{(const bf16*)(ws + WS_KV), (const bf16*)(ws + WS_WQN), G, cblk}; pg8::gemm_phase(F.lds, 256, 4096, 1024, S, E); }
            { PreSched<1> S{(const bf16*)(ws + WS_KV), (const bf16*)(ws + WS_WXO), G, cblk}; pg8::gemm_phase(F.lds, 256, 1024, 4096, S, E); }
        } break;
        case 3: {
            { pg8::PlainSched S{SA, (const bf16*)(ws + WS_WIN), 1024, 1024, M / 256, 8, G, cblk, 30, 0};
              EpiInProj E{(bf16*)(ws + WS_GLU), SB, RS};
              pg8::gemm_phase(F.lds, 1024, 1024, 1024, S, E); }
            { pg8::PlainSched S{(const bf16*)(ws + WS_WIN) + (size_t)2048 * 1024, SA, 1024, 1024, 2, M / 256, G, cblk, 30, 0};
              EpiVT E{(bf16*)(ws + WS_VT), RS};
              pg8::gemm_phase(F.lds, 1024, 1024, 1024, S, E); }
        } break;
        case 4: {
            const float lam = ((const float*)(ws + WS_LAM))[0];
#ifndef NO_ATTN
            for (int u = cblk; u < 1024; u += G) diffattn_unit(F, u, SB, (const bf16*)(ws + WS_VT), (const float*)(ws + WS_BIAS), lam, a.in[opq(I_SUBLN)], (bf16*)(ws + WS_MIX));
#endif
            __syncthreads();
#ifndef NO_CONV
            conv_load_weights(F, a.in[opq(I_CONVW)]);
            for (int u = cblk; u < 512; u += G) conv_unit(F, u, (const bf16*)(ws + WS_GLU), a.in[opq(I_CONVB)], a.in[opq(I_CLNG)], a.in[opq(I_CLNB)], (bf16*)(ws + WS_MIX));
#endif
            __syncthreads();
        } break;
        case 5: {
            pg8::PlainSched S{(const bf16*)(ws + WS_MIX), (const bf16*)(ws + WS_WOUT), 1024, 1024, M / 256, 4, G, cblk, 30, 0};
            EpiResid E{a.in[opq(I_X)], a.out, SA, (float*)(ws + WS_PS)};
            pg8::gemm_phase(F.lds, 1024, 1024, 1024, S, E);
        } break;
        case 7: {
            pg8::PlainSched S{SA, (const bf16*)(ws + (li ? WS_G1 : WS_G0)), 1024, 1024, M / 256, 4, G, cblk, 3, (size_t)1048576};
            EpiSoftmax E{SB, (const float*)(ws + WS_PS)};
            pg8::gemm_phase(F.lds, 1024, 1024, 1024, S, E);
        } break;
        case 8: {
            pg8::PlainSched S{SB, (const bf16*)(ws + (li ? WS_VW1 : WS_VW0)), 1024, 1024, M / 256, 4, G, cblk, 3, (size_t)1048576};
            EpiResid E{a.out, a.out, SA, (float*)(ws + WS_PS)};
            pg8::gemm_phase(F.lds, 1024, 1024, 1024, S, E);
        } break;
        case 10: {
            pg8::PlainSched S{SA, (const bf16*)(ws + WS_WUP) + (size_t)li * 4096 * 1024, 1024, 1024, M / 256, 16, G, cblk, 30, 0};
            EpiRowScale<2> E{(bf16*)(ws + WS_HID), 4096, nullptr, (const float*)(ws + WS_PS)};
            pg8::gemm_phase(F.lds, 1024, 1024, 1024, S, E);
        } break;
        case 11: {
            pg8::PlainSched S{(const bf16*)(ws + WS_HID), (const bf16*)(ws + WS_WDN) + (size_t)li * 1024 * 4096, 4096, 4096, M / 256, 4, G, cblk, 30, 0};
            EpiResid E{a.out, a.out, nullptr, nullptr};
            pg8::gemm_phase(F.lds, 4096, 4096, 4096, S, E);
        } break;
        case 12: phase_rwkv_shift(F, a.out, a.in[opq(I_NMIX)] + 1024, (bf16*)(ws + WS_A1)); break;
        case 13: {
            pg8::PlainSched S{(const bf16*)(ws + WS_A1), (const bf16*)(ws + WS_WBIG), 2048, 2048, M / 256, 14, G, cblk, 30, 0};
            EpiRwkv E{(bf16*)(ws + WS_R), (bf16*)(ws + WS_K), (bf16*)(ws + WS_V), (bf16*)(ws + WS_HD1), (bf16*)(ws + WS_HD2)};
            pg8::gemm_phase(F.lds, 2048, 2048, 2048, S, E);
        } break;
        case 14: {
            ScanPtrs P{(const bf16*)(ws + WS_R), (const bf16*)(ws + WS_K), (const bf16*)(ws + WS_V), (const bf16*)(ws + WS_HD1), (const bf16*)(ws + WS_W2T),
                       a.in[opq(I_W0)], a.in[opq(I_A0)], a.in[opq(I_KK)], a.in[opq(I_KA)], a.in[opq(I_RK)], (bf16*)(ws + WS_YF), (bf16*)(ws + WS_YB), (float*)(ws + WS_BONUS)};
            for (int bh = cblk; bh < 256; bh += G) scan_pair(F, bh, P);
            __syncthreads();
        } break;
        case 15: {
            pg8::PlainSched S{(const bf16*)(ws + WS_HD2), (const bf16*)(ws + WS_G2T), 256, 256, M / 256, 4, G, cblk, 30, 0};
            EpiRowScale<0> E{(bf16*)(ws + WS_GATE), 1024, nullptr, nullptr};
            pg8::gemm_phase(F.lds, 256, 256, 256, S, E);
        } break;
        case 16: phase_rwkv_comb(F, (const bf16*)(ws + WS_YF), (const bf16*)(ws + WS_YB), (const bf16*)(ws + WS_V), (const bf16*)(ws + WS_GATE), (const float*)(ws + WS_BONUS),
                                 a.in[opq(I_LNG)], a.in[opq(I_LNB)], (bf16*)(ws + WS_COMB)); break;
        case 17: {
            pg8::PlainSched S{(const bf16*)(ws + WS_COMB), (const bf16*)(ws + WS_WRO), 1024, 1024, M / 256, 4, G, cblk, 30, 0};
            EpiResid E{a.out, a.out, SA, (float*)(ws + WS_PS)};
            pg8::gemm_phase(F.lds, 1024, 1024, 1024, S, E);
        } break;
        case 24: phase_final_norm(F, a.out, a.in[opq(I_NFINAL)]); break;
        default: break;
        }
        if (pi + 1 < a.ph_hi) {
#ifdef MK_ALL_CG
            grid.sync();
#else
            if (pi == a.ph_lo) grid.sync(); else { XcdBarrier xb; xb.bar = (unsigned*)(ws + WS_BAR); xb.x = xb_xcc_id(); xb.st = (volatile LAS unsigned*)(F.lds + LDS_MISC); xcd_barrier(xb); }
#endif
        }
    }
}

extern "C" void kernel_launch(void* const* d_in, const int* in_sizes, int n_in, void* d_out, int out_size, void* d_ws, size_t ws_size, hipStream_t stream) {
    static int grid = 0;
    if (grid == 0) {
        if (n_in != N_IN || in_sizes[0] != M * D || out_size != M * D || ws_size < WS_NEED) {
            fprintf(stderr, "kernel_launch: unexpected problem (n_in %d, in0 %d, out %d, ws %zu); nothing launched\n", n_in, n_in > 0 ? in_sizes[0] : -1, out_size, ws_size); grid = -1; return; }
        int dev = 0, cus = 0, per_cu = 0;
        if (hipGetDevice(&dev) != hipSuccess || hipDeviceGetAttribute(&cus, hipDeviceAttributeMultiprocessorCount, dev) != hipSuccess) { grid = -1; return; }
        if (hipFuncSetAttribute((const void*)mk_fwd, hipFuncAttributeMaxDynamicSharedMemorySize, LDS_BYTES) != hipSuccess) { fprintf(stderr, "kernel_launch: hipFuncSetAttribute failed\n"); grid = -1; return; }
        if (hipOccupancyMaxActiveBlocksPerMultiprocessor(&per_cu, (const void*)mk_fwd, 512, LDS_BYTES) != hipSuccess || per_cu < 1) { fprintf(stderr, "kernel_launch: occupancy query says %d\n", per_cu); (void)hipGetLastError(); grid = -1; return; }
        grid = cus;
    }
    if (grid < 0) return;
    if (hipMemsetAsync((char*)d_ws + WS_BAR, 0, 65536, stream) != hipSuccess) { fprintf(stderr, "kernel_launch: memset failed\n"); return; }
    Args a{};
    for (int i = 0; i < N_IN; ++i) a.in[i] = (const float*)d_in[i];
    a.out = (float*)d_out; a.ws = (unsigned char*)d_ws;
#if MK_SINGLE
    a.ph_lo = 0; a.ph_hi = NPH;
    void* params[] = {&a};
    hipError_t e = hipLaunchCooperativeKernel((const void*)mk_fwd, dim3(grid), dim3(512), params, LDS_BYTES, stream);
    if (e != hipSuccess) fprintf(stderr, "kernel_launch: cooperative launch failed: %s\n", hipGetErrorString(e));
#else
    for (int ph = 0; ph < NPH; ++ph) { a.ph_lo = ph; a.ph_hi = ph + 1; hipLaunchKernelGGL(mk_fwd, dim3(grid), dim3(512), LDS_BYTES, stream, a); }
#endif
}
```

```cpp
#include <hip/hip_runtime.h>
#include <hip/hip_cooperative_groups.h>
#include <cstdio>
#include <cstdint>
namespace cg = cooperative_groups;

#ifndef MK_SINGLE
#define MK_SINGLE 1
#endif

#define LAS __attribute__((address_space(3)))
#define DI __device__ __forceinline__
typedef unsigned short bf16;
typedef short bf16x8 __attribute__((ext_vector_type(8)));
typedef short s16x4 __attribute__((ext_vector_type(4)));
typedef float f32x2 __attribute__((ext_vector_type(2)));
typedef float f32x4 __attribute__((ext_vector_type(4)));
typedef float f32x16 __attribute__((ext_vector_type(16)));
typedef unsigned u32x2 __attribute__((ext_vector_type(2)));
typedef unsigned u32x4 __attribute__((ext_vector_type(4)));

constexpr int D = 1024, NB = 16, T = 2048, M = NB * T, NMEM = 256, MMEM = NB * NMEM;
constexpr int FF = 4096;
constexpr float EPS = 1e-6f;
constexpr float LOG2E = 1.4426950408889634f;

constexpr size_t MiB = 1u << 20;
constexpr size_t WS_BAR = 0;
constexpr size_t WS_RS = 64 * 1024;
constexpr size_t WS_RSMEM = WS_RS + M * 4;
constexpr size_t WS_BIAS = WS_RSMEM + MMEM * 4;
constexpr size_t WS_LAM = WS_BIAS + 4 * 4096 * 4;
constexpr size_t WS_WIN = 1 * MiB;
constexpr size_t WS_WOUT = WS_WIN + 5 * MiB;
constexpr size_t WS_WQN = WS_WOUT + 2 * MiB;
constexpr size_t WS_WKV = WS_WQN + 4 * MiB;
constexpr size_t WS_WXO = WS_WKV + 8 * MiB;
constexpr size_t WS_WUP = WS_WXO + 4 * MiB;
constexpr size_t WS_WDN = WS_WUP + 16 * MiB;
constexpr size_t WS_WBIG = WS_WDN + 16 * MiB;
constexpr size_t WS_W2T = WS_WBIG + 14 * MiB;
constexpr size_t WS_G2T = WS_W2T + 512 * 1024;
constexpr size_t WS_WRO = WS_G2T + 512 * 1024;
constexpr size_t WS_WEND = WS_WRO + 2 * MiB;
static_assert(WS_WEND == 73 * MiB, "weight map");
constexpr size_t WS_SA = 73 * MiB;
constexpr size_t WS_SB = 137 * MiB;
constexpr size_t WS_GLU = 201 * MiB;
constexpr size_t WS_VT = 233 * MiB;
constexpr size_t WS_MIX = 265 * MiB;
constexpr size_t WS_G0 = 329 * MiB;
constexpr size_t WS_VW0 = 361 * MiB;
constexpr size_t WS_MEMB = 393 * MiB;
constexpr size_t WS_KV = 401 * MiB;
constexpr size_t WS_G1 = 433 * MiB;
constexpr size_t WS_VW1 = 465 * MiB;
static_assert(WS_G1 - WS_G0 == 104 * MiB && WS_VW0 - WS_G0 == 32 * MiB && WS_VW1 - WS_G1 == 32 * MiB, "G / VW spacing used by EpiPre");
constexpr size_t WS_BONUS = 497 * MiB;
constexpr size_t WS_PS = 502 * MiB;
constexpr size_t WS_HID = 137 * MiB;
constexpr size_t WS_A1 = 73 * MiB;
constexpr size_t WS_R = 201 * MiB, WS_K = 265 * MiB, WS_V = 329 * MiB;
static_assert(WS_K - WS_R == 64 * MiB && WS_V - WS_K == 64 * MiB, "r, k, v spacing used by EpiRwkv");
constexpr size_t WS_HD1 = 393 * MiB;
constexpr size_t WS_HD2 = 409 * MiB;
constexpr size_t WS_YF = 73 * MiB, WS_YB = 137 * MiB;
constexpr size_t WS_GATE = 265 * MiB;
constexpr size_t WS_COMB = 201 * MiB;
constexpr size_t WS_NEED = 512 * MiB;

constexpr int LDS_X = 131072;
constexpr int LDS_MISC = 131072 + 8192;
constexpr int LDS_BYTES = 147456;

DI unsigned f2bf(float f) { unsigned u = __builtin_bit_cast(unsigned, f); return (u + 0x7fffu + ((u >> 16) & 1u)) >> 16; }
typedef __bf16 bf16x2v __attribute__((ext_vector_type(2)));
DI unsigned pk2(float lo, float hi) { const f32x2 v = {lo, hi}; return __builtin_bit_cast(unsigned, __builtin_convertvector(v, bf16x2v)); }
DI float bf2f(unsigned short b) { return __builtin_bit_cast(float, ((unsigned)b) << 16); }
DI float bflo(unsigned w) { return __builtin_bit_cast(float, w << 16); }
DI float bfhi(unsigned w) { return __builtin_bit_cast(float, w & 0xffff0000u); }
template <int MASK> DI float swz_xor(float v) { return __builtin_bit_cast(float, __builtin_amdgcn_ds_swizzle(__builtin_bit_cast(int, v), (MASK << 10) | 0x1f)); }
DI float half_sum(float v) { const int x = __builtin_bit_cast(int, v); const auto r = __builtin_amdgcn_permlane32_swap(x, x, false, false); return __builtin_bit_cast(float, (int)r[0]) + __builtin_bit_cast(float, (int)r[1]); }
DI float half_max(float v) { const int x = __builtin_bit_cast(int, v); const auto r = __builtin_amdgcn_permlane32_swap(x, x, false, false); return fmaxf(__builtin_bit_cast(float, (int)r[0]), __builtin_bit_cast(float, (int)r[1])); }
DI float wave_sum(float v) {
    v += swz_xor<1>(v); v += swz_xor<2>(v); v += swz_xor<4>(v); v += swz_xor<8>(v); v += swz_xor<16>(v); v = half_sum(v);
    return v;
}
DI int opaque(int x) { asm volatile("" : "+v"(x)); return x; }
template <class Tp> DI Tp* opq_ptr(Tp* p) { asm volatile("" : "+s"(p)); return p; }
DI int opq(int x) { asm volatile("" : "+s"(x)); return x; }
DI float fexp2(float x) { return __builtin_amdgcn_exp2f(x); }
DI float frcp(float x) { return __builtin_amdgcn_rcpf(x); }
DI float sigmoidf_(float x) { return frcp(1.0f + fexp2(-x * LOG2E)); }
DI float tanhf_(float x) { float e = fexp2(-2.0f * LOG2E * fabsf(x)); float t = (1.0f - e) * frcp(1.0f + e); return x < 0.f ? -t : t; }

namespace pg8 {
constexpr int BM = 256, BK = 64, HALF = 128, HTB = HALF * BK * 2, STAGE_BYTES = 8 * HTB, NXCD = 8, WGM = 8;
DI int lds_byte(int r, int c) { const int st = (r >> 4) * 2 + (c >> 5), rr = r & 15, cc = c & 31, ob = rr * 64 + cc * 2; return st * 1024 + (ob ^ (((ob >> 9) & 1) << 5)); }
DI void stage_rc(int b, int& R, int& C) { const int st = b / 1024, sb = b % 1024, swz = sb ^ (((sb >> 9) & 1) << 5); R = (st >> 1) * 16 + swz / 64; C = (st & 1) * 32 + (swz % 64) / 2; }
DI int perm32(int rho) { const int n = rho >> 4, i = rho & 15; return 8 * (i >> 2) + 4 * n + (i & 3); }

struct Unit { int pm, pn, z; const char* pa; const char* pb; };

DI bool tile_order(long L, int nM, int nN, int& pm, int& pn) {
    const int nwg = nM * nN; if (L >= nwg) return false;
    int wgid = (int)L; { const int q = nwg / NXCD, r = nwg % NXCD, xcd = wgid % NXCD, off = wgid / NXCD; wgid = (xcd < r ? xcd * (q + 1) : r * (q + 1) + (xcd - r) * q) + off; }
    const int nig = WGM * nN, gid = wgid / nig, fm = gid * WGM, gsz = (nM - fm) < WGM ? (nM - fm) : WGM;
    pm = fm + ((wgid % nig) % gsz); pn = (wgid % nig) / gsz; return true;
}
struct PlainSched {
    const bf16* A; const bf16* Bt; int lda, ldb, nM, nN, G, c, bshift; size_t bstride;
    DI bool next(int i, Unit& u) const {
        if (!tile_order((long)i * G + c, nM, nN, u.pm, u.pn)) return false;
        u.z = u.pm >> bshift;
        u.pa = (const char*)(A + (size_t)u.pm * 256 * lda);
        u.pb = (const char*)(Bt + (size_t)u.z * bstride + (size_t)u.pn * 256 * ldb);
        return true;
    }
};

DI unsigned cvt_pk_bf16(float lo, float hi) { return pk2(lo, hi); }

template <class Epi, class Sched>
DI void gemm_phase(LAS unsigned char* lds, const int K, const int lda, const int ldb, const Sched& S, const Epi& E) {
    const int tid = opaque(threadIdx.x), wid = __builtin_amdgcn_readfirstlane(tid >> 6), lane = tid & 63, wr = wid >> 2, wc = wid & 3, fr = lane & 15, fq = lane >> 4;
    const int nt = K / BK;
    unsigned voffA[2], voffB[2];
#pragma unroll
    for (int i = 0; i < 2; ++i) { int R, C; stage_rc(tid * 16 + i * 8192, R, C); const int Rb = Epi::PERM ? ((R & ~31) + perm32(R & 31)) : R;
        voffA[i] = (unsigned)(R * lda + C) * 2u; voffB[i] = (unsigned)(Rb * ldb + C) * 2u; }
    const size_t kstep = (size_t)(BK * 2);
    const size_t hstepA = (size_t)HALF * lda * 2, hstepB = (size_t)HALF * ldb * 2;
    const unsigned ldsw = (unsigned)wid * 1024u;
    const int aoff = lds_byte(wr * 64 + fr, fq * 8), boff = lds_byte(wc * 32 + fr, fq * 8);
#define PG8_SA(b, h) (((b) * 2 + (h)) * HTB)
#define PG8_SB(b, h) ((4 + (b) * 2 + (h)) * HTB)
#define PG8_STAGE(bufoff, gbase, voff) do { _Pragma("unroll") for (int _i = 0; _i < 2; ++_i) \
        __builtin_amdgcn_global_load_lds((const unsigned*)((const char*)(gbase) + (voff)[_i]), (LAS unsigned*)(lds + (bufoff) + ldsw + _i * 8192), 16, 0, 0); } while (0)
#define PG8_LDA(dst, b, h) do { _Pragma("unroll") for (int m = 0; m < 4; ++m) _Pragma("unroll") for (int k = 0; k < 2; ++k) dst[m][k] = *(const LAS bf16x8*)(lds + PG8_SA(b, h) + aoff + m * 2048 + k * 1024); } while (0)
#define PG8_LDB(dst, b, h) do { _Pragma("unroll") for (int n = 0; n < 2; ++n) _Pragma("unroll") for (int k = 0; k < 2; ++k) dst[n][k] = *(const LAS bf16x8*)(lds + PG8_SB(b, h) + boff + n * 2048 + k * 1024); } while (0)
#define PG8_MMA(ai, bj, At, Bt) do { __builtin_amdgcn_s_setprio(1); _Pragma("unroll") for (int m = 0; m < 4; ++m) _Pragma("unroll") for (int n = 0; n < 2; ++n) _Pragma("unroll") for (int k = 0; k < 2; ++k) \
        acc[ai][bj][m][n] = __builtin_amdgcn_mfma_f32_16x16x32_bf16(Bt[n][k], At[m][k], acc[ai][bj][m][n], 0, 0, 0); __builtin_amdgcn_s_setprio(0); } while (0)
#define PG8_WAIT_V(n) asm volatile("s_waitcnt vmcnt(" #n ")" ::: "memory")
#define PG8_WAIT_L(n) asm volatile("s_waitcnt lgkmcnt(" #n ")" ::: "memory")
#define PG8_BAR __builtin_amdgcn_s_barrier()
#define PG8_SCHED __builtin_amdgcn_sched_barrier(0)
    Unit cur, nxt; int ui = 0;
    if (!S.next(0, cur)) return;
    f32x4 acc[2][2][4][2];
#pragma unroll
    for (int a = 0; a < 2; ++a)
#pragma unroll
        for (int b = 0; b < 2; ++b)
#pragma unroll
            for (int m = 0; m < 4; ++m)
#pragma unroll
                for (int n = 0; n < 2; ++n) acc[a][b][m][n] = (f32x4){0.f, 0.f, 0.f, 0.f};
    bf16x8 At[4][2], B0[2][2], B1[2][2];
    const char* cA = cur.pa; const char* cB = cur.pb;
    PG8_STAGE(PG8_SB(0, 0), cB, voffB); PG8_STAGE(PG8_SB(0, 1), cB + hstepB, voffB); PG8_STAGE(PG8_SA(0, 0), cA, voffA); PG8_STAGE(PG8_SA(0, 1), cA + hstepA, voffA);
    if (wr == 1) PG8_BAR;
    PG8_WAIT_V(2); PG8_BAR;
    PG8_STAGE(PG8_SB(1, 0), cB + kstep, voffB); PG8_STAGE(PG8_SA(1, 0), cA + kstep, voffA); PG8_STAGE(PG8_SB(1, 1), cB + hstepB + kstep, voffB);
    PG8_WAIT_V(6); PG8_BAR;
    for (;;) {
        const bool has_next = S.next(ui + 1, nxt);
        const char* nA = has_next ? nxt.pa : cA; const char* nB = has_next ? nxt.pb : cB;
#pragma unroll 1
        for (int t = 0; t < nt; t += 2) {
            const bool last = (t == nt - 2);
            const char* a1 = cA + (size_t)(t + 1) * kstep;
            const char* a2 = last ? nA : cA + (size_t)(t + 2) * kstep; const char* b2 = last ? nB : cB + (size_t)(t + 2) * kstep;
            const char* a3 = a2 + kstep; const char* b3 = b2 + kstep;
            PG8_LDB(B0, 0, 0); PG8_LDB(B1, 0, 1); PG8_SCHED; PG8_LDA(At, 0, 0); PG8_STAGE(PG8_SA(1, 1), a1 + hstepA, voffA);
            PG8_WAIT_V(8); PG8_WAIT_L(0); PG8_BAR; PG8_MMA(0, 0, At, B0); PG8_MMA(0, 1, At, B1); PG8_BAR; PG8_SCHED;
            PG8_LDA(At, 0, 1); PG8_STAGE(PG8_SB(0, 0), b2, voffB); PG8_STAGE(PG8_SB(0, 1), b2 + hstepB, voffB); PG8_STAGE(PG8_SA(0, 0), a2, voffA);
            PG8_WAIT_V(8); PG8_WAIT_L(0); PG8_BAR; PG8_MMA(1, 0, At, B0); PG8_MMA(1, 1, At, B1); PG8_BAR; PG8_SCHED;
            PG8_LDB(B0, 1, 0); PG8_LDB(B1, 1, 1); PG8_SCHED; PG8_LDA(At, 1, 0); PG8_STAGE(PG8_SA(0, 1), a2 + hstepA, voffA);
            PG8_WAIT_V(8); PG8_WAIT_L(0); PG8_BAR; PG8_MMA(0, 0, At, B0); PG8_MMA(0, 1, At, B1); PG8_BAR; PG8_SCHED;
            PG8_LDA(At, 1, 1); PG8_STAGE(PG8_SB(1, 0), b3, voffB); PG8_STAGE(PG8_SB(1, 1), b3 + hstepB, voffB); PG8_STAGE(PG8_SA(1, 0), a3, voffA);
            PG8_WAIT_V(8); PG8_WAIT_L(0); PG8_BAR; PG8_MMA(1, 0, At, B0); PG8_MMA(1, 1, At, B1); PG8_BAR; PG8_SCHED;
        }
        if (wr == 0) PG8_BAR;
        E(acc, cur, wr, wc, fr, fq, lds);
        if (!has_next) break;
#pragma unroll
        for (int a = 0; a < 2; ++a)
#pragma unroll
            for (int b = 0; b < 2; ++b)
#pragma unroll
                for (int m = 0; m < 4; ++m)
#pragma unroll
                    for (int n = 0; n < 2; ++n) acc[a][b][m][n] = (f32x4){0.f, 0.f, 0.f, 0.f};
        cur = nxt; cA = nA; cB = nB; ++ui;
        if (wr == 1) PG8_BAR;
    }
    PG8_WAIT_V(0);
    PG8_BAR;
#undef PG8_SA
#undef PG8_SB
#undef PG8_STAGE
#undef PG8_LDA
#undef PG8_LDB
#undef PG8_MMA
#undef PG8_WAIT_V
#undef PG8_WAIT_L
#undef PG8_BAR
#undef PG8_SCHED
}
}
using pg8::Unit;

DI void store8(bf16* p, const f32x4 v0, const f32x4 v1) {
    u32x4 w; w.x = pk2(v0[0], v0[1]); w.y = pk2(v0[2], v0[3]); w.z = pk2(v1[0], v1[1]); w.w = pk2(v1[2], v1[3]);
    *(u32x4*)p = w;
}
#define EPI_ARGS f32x4 (&acc)[2][2][4][2], const Unit& u, int wr, int wc, int fr, int fq, LAS unsigned char* lds

DI float rs_ps(const float* ps, int row) {
    const f32x4* p = (const f32x4*)(ps + (size_t)row * 16); const f32x4 a = p[0], b = p[1], c = p[2], d = p[3];
    const float s = ((a.x + a.y) + (a.z + a.w)) + ((b.x + b.y) + (b.z + b.w)) + (((c.x + c.y) + (c.z + c.w)) + ((d.x + d.y) + (d.z + d.w)));
    return 1.0f / sqrtf(s * (1.0f / D) + EPS);
}
template <int ACT> struct EpiRowScale {
    static constexpr bool PERM = true;
    bf16* O; int ldc; const float* rs; const float* ps;
    DI void operator()(EPI_ARGS) const {
        const int row0 = u.pm * 256 + wr * 64 + fr, col0 = u.pn * 256 + wc * 32 + 8 * fq;
#pragma unroll
        for (int ai = 0; ai < 2; ++ai)
#pragma unroll
            for (int m = 0; m < 4; ++m) {
                const int row = row0 + ai * 128 + m * 16; const float s = ps ? rs_ps(ps, row) : (rs ? rs[row] : 1.0f);
                bf16* rowp = O + (size_t)row * ldc + col0;
#pragma unroll
                for (int bj = 0; bj < 2; ++bj) { f32x4 v0 = acc[ai][bj][m][0] * s, v1 = acc[ai][bj][m][1] * s;
                    if (ACT == 2) {
#pragma unroll
                        for (int j = 0; j < 4; ++j) { float a = fmaxf(v0[j], 0.f), b = fmaxf(v1[j], 0.f); v0[j] = a * a; v1[j] = b * b; } }
                    store8(rowp + bj * 128, v0, v1); }
            }
    }
};
struct EpiInProj {
    static constexpr bool PERM = true;
    bf16* GLU; bf16* QK; const float* rs;
    DI void operator()(EPI_ARGS) const {
        const int row0 = u.pm * 256 + wr * 64 + fr;
        if (u.pn < 4) {
            const int col0 = u.pn * 128 + wc * 32 + 8 * fq;
#pragma unroll
            for (int ai = 0; ai < 2; ++ai)
#pragma unroll
                for (int m = 0; m < 4; ++m) {
                    const int row = row0 + ai * 128 + m * 16; const float s = rs[row];
                    f32x4 o0, o1;
#pragma unroll
                    for (int j = 0; j < 4; ++j) { o0[j] = acc[ai][0][m][0][j] * s * sigmoidf_(acc[ai][1][m][0][j] * s); o1[j] = acc[ai][0][m][1][j] * s * sigmoidf_(acc[ai][1][m][1][j] * s); }
                    store8(GLU + (size_t)row * 512 + col0, o0, o1);
                }
        } else {
            const int col0 = (u.pn - 4) * 256 + wc * 32 + 8 * fq;
#pragma unroll
            for (int ai = 0; ai < 2; ++ai)
#pragma unroll
                for (int m = 0; m < 4; ++m) {
                    const int row = row0 + ai * 128 + m * 16; const float s = rs[row];
#pragma unroll
                    for (int bj = 0; bj < 2; ++bj) store8(QK + (size_t)row * 1024 + col0 + bj * 128, acc[ai][bj][m][0] * s, acc[ai][bj][m][1] * s);
                }
        }
    }
};
struct EpiVT {
    static constexpr bool PERM = true;
    bf16* O; const float* cs;
    DI void operator()(EPI_ARGS) const {
        const int row0 = u.pm * 256 + wr * 64 + fr, col0 = u.pn * 256 + wc * 32 + 8 * fq;
        f32x4 c[2][2];
#pragma unroll
        for (int bj = 0; bj < 2; ++bj) { c[bj][0] = *(const f32x4*)(cs + col0 + bj * 128); c[bj][1] = *(const f32x4*)(cs + col0 + bj * 128 + 4); }
#pragma unroll
        for (int ai = 0; ai < 2; ++ai)
#pragma unroll
            for (int m = 0; m < 4; ++m) {
                const int row = row0 + ai * 128 + m * 16;
#pragma unroll
                for (int bj = 0; bj < 2; ++bj) store8(O + (size_t)row * M + col0 + bj * 128, acc[ai][bj][m][0] * c[bj][0], acc[ai][bj][m][1] * c[bj][1]);
            }
    }
};
struct EpiPre {
    static constexpr bool PERM = true;
    bf16* base0;
    DI void operator()(EPI_ARGS) const {
        bf16* O = base0 + (size_t)((u.z >> 30) & 1) * (52u << 20) + (size_t)(u.z & 0x3fffffff);
        const int row0 = wr * 64 + fr, col0 = wc * 32 + 8 * fq;
#pragma unroll
        for (int ai = 0; ai < 2; ++ai)
#pragma unroll
            for (int m = 0; m < 4; ++m) {
                const int row = row0 + ai * 128 + m * 16;
#pragma unroll
                for (int bj = 0; bj < 2; ++bj) store8(O + (size_t)row * 1024 + col0 + bj * 128, acc[ai][bj][m][0], acc[ai][bj][m][1]);
            }
    }
};
struct EpiResid {
    static constexpr bool PERM = false;
    const float* resid; float* out; bf16* hb; float* ps;
    DI void operator()(EPI_ARGS) const {
        const int row0 = u.pm * 256 + wr * 64 + fr, col0 = u.pn * 256 + wc * 32 + 4 * fq;
#pragma unroll
        for (int ai = 0; ai < 2; ++ai)
#pragma unroll
            for (int m = 0; m < 4; ++m) {
                const int row = row0 + ai * 128 + m * 16; const size_t off = (size_t)row * D + col0; float ss = 0.f;
#pragma unroll
                for (int bj = 0; bj < 2; ++bj)
#pragma unroll
                    for (int n = 0; n < 2; ++n) { const f32x4 r = *(const f32x4*)(resid + off + bj * 128 + n * 16) + acc[ai][bj][m][n]; *(f32x4*)(out + off + bj * 128 + n * 16) = r;
                        if (hb) { u32x2 w; w.x = pk2(r.x, r.y); w.y = pk2(r.z, r.w); *(u32x2*)(hb + off + bj * 128 + n * 16) = w; }
                        ss += (r.x * r.x + r.y * r.y) + (r.z * r.z + r.w * r.w); }
                if (ps) { ss += swz_xor<16>(ss); ss = half_sum(ss); if (fq == 0) ps[(size_t)row * 16 + u.pn * 4 + wc] = ss; }
            }
    }
};
struct EpiSoftmax {
    static constexpr bool PERM = true;
    bf16* P; const float* ps;
    DI void operator()(EPI_ARGS) const {
        LAS f32x2* X = (LAS f32x2*)(lds + LDS_X);
        const int row0 = u.pm * 256, col0 = u.pn * 256 + wc * 32 + 8 * fq;
        float mw[2][4];
#pragma unroll
        for (int ai = 0; ai < 2; ++ai)
#pragma unroll
            for (int m = 0; m < 4; ++m) {
                const int rl = ai * 128 + wr * 64 + m * 16 + fr; const float s = rs_ps(ps, row0 + rl) * LOG2E;
                float mx = -3.0e38f;
#pragma unroll
                for (int bj = 0; bj < 2; ++bj)
#pragma unroll
                    for (int n = 0; n < 2; ++n) { acc[ai][bj][m][n] = acc[ai][bj][m][n] * s;
#pragma unroll
                        for (int j = 0; j < 4; ++j) mx = fmaxf(mx, acc[ai][bj][m][n][j]); }
                mx = fmaxf(mx, swz_xor<16>(mx)); mx = half_max(mx);
                float sum = 0.f;
#pragma unroll
                for (int bj = 0; bj < 2; ++bj)
#pragma unroll
                    for (int n = 0; n < 2; ++n)
#pragma unroll
                        for (int j = 0; j < 4; ++j) { const float p = fexp2(acc[ai][bj][m][n][j] - mx); acc[ai][bj][m][n][j] = p; sum += p; }
                sum += swz_xor<16>(sum); sum = half_sum(sum);
                mw[ai][m] = mx;
                if (fq == 0) X[rl * 4 + wc] = (f32x2){mx, sum};
            }
        asm volatile("s_waitcnt lgkmcnt(0)" ::: "memory"); __builtin_amdgcn_s_barrier(); asm volatile("" ::: "memory");
#pragma unroll
        for (int ai = 0; ai < 2; ++ai)
#pragma unroll
            for (int m = 0; m < 4; ++m) {
                const int rl = ai * 128 + wr * 64 + m * 16 + fr;
                const f32x2 a = X[rl * 4 + 0], b = X[rl * 4 + 1], c = X[rl * 4 + 2], d = X[rl * 4 + 3];
                const float mt = fmaxf(fmaxf(a.x, b.x), fmaxf(c.x, d.x));
                const float lt = a.y * fexp2(a.x - mt) + b.y * fexp2(b.x - mt) + c.y * fexp2(c.x - mt) + d.y * fexp2(d.x - mt);
                const float f = fexp2(mw[ai][m] - mt) / lt;
                bf16* rowp = P + (size_t)(row0 + rl) * 1024 + col0;
#pragma unroll
                for (int bj = 0; bj < 2; ++bj) store8(rowp + bj * 128, acc[ai][bj][m][0] * f, acc[ai][bj][m][1] * f);
            }
        asm volatile("s_waitcnt lgkmcnt(0)" ::: "memory"); __builtin_amdgcn_s_barrier(); asm volatile("" ::: "memory");
    }
};
struct EpiRwkv {
    static constexpr bool PERM = true;
    bf16* R; bf16* Kk; bf16* V; bf16* HD1; bf16* HD2;
    DI void operator()(EPI_ARGS) const {
        const int row0 = u.pm * 256 + wr * 64 + fr; const int g = u.pn >> 2;
        bf16* O; int ldc, colt, mode0 = 0, mode1 = 0;
        if (u.pn < 12) { O = R + (size_t)g * (32u << 20); ldc = 1024; colt = (u.pn & 3) * 256; }
        else if (u.pn == 12) { O = HD1; ldc = 256; colt = 0; mode0 = 1; }
        else { O = HD2; ldc = 256; colt = 0; mode0 = 2; mode1 = 2; }
        const int col0 = colt + wc * 32 + 8 * fq;
#pragma unroll
        for (int ai = 0; ai < 2; ++ai)
#pragma unroll
            for (int m = 0; m < 4; ++m) {
                bf16* rowp = O + (size_t)(row0 + ai * 128 + m * 16) * ldc + col0;
#pragma unroll
                for (int bj = 0; bj < 2; ++bj) { f32x4 v0 = acc[ai][bj][m][0], v1 = acc[ai][bj][m][1]; const int md = bj ? mode1 : mode0;
                    if (md == 1) {
#pragma unroll
                        for (int j = 0; j < 4; ++j) { v0[j] = tanhf_(v0[j]); v1[j] = tanhf_(v1[j]); } }
                    else if (md == 2) {
#pragma unroll
                        for (int j = 0; j < 4; ++j) { v0[j] = sigmoidf_(v0[j]); v1[j] = sigmoidf_(v1[j]); } }
                    store8(rowp + bj * 128, v0, v1); }
            }
    }
};

enum InIdx { I_X = 0, I_MEM, I_REL, I_NMIX, I_NXATTN, I_NMEM, I_NFFN, I_NFINAL, I_WIN, I_WOUT, I_CONVW, I_CONVB, I_CLNG, I_CLNB, I_LQ1, I_LK1, I_LQ2, I_LK2, I_SUBLN,
             I_MU, I_WR, I_WK, I_WV, I_WO, I_W0, I_W1, I_W2, I_A0, I_A1, I_A2, I_G1, I_G2, I_KK, I_KA, I_RK, I_LNG, I_LNB, I_XQ, I_XKV, I_XO, I_UP, I_DN, N_IN };
struct Args { const float* in[N_IN]; float* out; unsigned char* ws; int ph_lo, ph_hi; };
static_assert(sizeof(Args) == (N_IN + 2) * 8 + 8, "Args has no padding");

struct Frame {
    LAS unsigned char* lds;
    int tid, lane, wave, gw, ngw;
    unsigned char* ws;
};

DI Frame fresh(const Frame& F0) {
    Frame F = F0; F.tid = opaque(threadIdx.x); F.lane = F.tid & 63; F.wave = __builtin_amdgcn_readfirstlane(F.tid >> 6); F.gw = opq(blockIdx.x) * 8 + F.wave; F.ngw = opq(gridDim.x) * 8; return F;
}
struct TJob { const float* W; int K, N; bf16* WT; int ldt, row_off, col_off, perm; const float* gain; };
DI void tr_item(const TJob& J, LAS float* scr, int item, int lane) {
    const int nblk = J.N / 32, kb = item / nblk, nb = item % nblk, k0 = 64 * kb, n0 = 32 * nb;
    float scale = 1.0f; int drow = J.row_off + n0;
    if (J.perm) {
        if (n0 < 512) drow = 256 * (n0 >> 7) + (n0 & 127);
        else if (n0 < 1024) drow = 256 * ((n0 - 512) >> 7) + 128 + ((n0 - 512) & 127);
        else drow = n0;
        if (n0 >= 1024 && n0 < 1536) scale = 0.125f;
    }
    float tv[32];
    const float* wp = J.W + (size_t)(k0 + (lane >> 5)) * J.N + n0 + (lane & 31);
#pragma unroll
    for (int i = 0; i < 32; ++i) tv[i] = wp[(size_t)(2 * i) * J.N];
    if (J.gain) {
#pragma unroll
        for (int i = 0; i < 32; ++i) tv[i] *= J.gain[k0 + 2 * i + (lane >> 5)];
    }
#pragma unroll
    for (int i = 0; i < 32; ++i) scr[(2 * i + (lane >> 5)) * 33 + (lane & 31)] = tv[i] * scale;
    asm volatile("s_waitcnt lgkmcnt(0)" ::: "memory");
    const int c = lane & 7;
#pragma unroll
    for (int j = 0; j < 4; ++j) { const int n = (lane >> 3) + 8 * j; const LAS float* s = scr + (8 * c) * 33 + n;
        u32x4 o; o.x = pk2(s[0 * 33], s[1 * 33]); o.y = pk2(s[2 * 33], s[3 * 33]); o.z = pk2(s[4 * 33], s[5 * 33]); o.w = pk2(s[6 * 33], s[7 * 33]);
        *(u32x4*)(J.WT + (size_t)(drow + n) * J.ldt + J.col_off + k0 + 8 * c) = o; }
    asm volatile("s_waitcnt lgkmcnt(0)" ::: "memory");
}
constexpr int N_TJOBS = 31;
DI TJob get_tjob(int j, const Args& a, unsigned char* ws) {
    TJob J; J.perm = 0; J.gain = nullptr; J.row_off = 0; J.col_off = 0;
    if (j == 0) { J.W = a.in[opq(I_WIN)]; J.K = 1024; J.N = 2560; J.WT = (bf16*)(ws + WS_WIN); J.ldt = 1024; J.perm = 1; J.gain = a.in[opq(I_NMIX)]; }
    else if (j == 1) { J.W = a.in[opq(I_WOUT)]; J.K = 1024; J.N = 1024; J.WT = (bf16*)(ws + WS_WOUT); J.ldt = 1024; }
    else if (j < 4) { const int i = j - 2; J.W = a.in[opq(I_XKV)] + (size_t)i * 1024 * 2048; J.K = 1024; J.N = 2048; J.WT = (bf16*)(ws + WS_WKV) + (size_t)i * 2048 * 1024; J.ldt = 1024; J.gain = a.in[opq(I_NMEM)] + i * 1024; }
    else if (j < 6) { const int i = j - 4; J.W = a.in[opq(I_XO)] + (size_t)i * 1024 * 1024; J.K = 1024; J.N = 1024; J.WT = (bf16*)(ws + WS_WXO) + (size_t)i * 1024 * 1024; J.ldt = 1024; }
    else if (j < 8) { const int i = j - 6; J.W = a.in[opq(I_UP)] + (size_t)i * 1024 * 4096; J.K = 1024; J.N = 4096; J.WT = (bf16*)(ws + WS_WUP) + (size_t)i * 4096 * 1024; J.ldt = 1024; J.gain = a.in[opq(I_NFFN)] + i * 1024; }
    else if (j < 10) { const int i = j - 8; J.W = a.in[opq(I_DN)] + (size_t)i * 4096 * 1024; J.K = 4096; J.N = 1024; J.WT = (bf16*)(ws + WS_WDN) + (size_t)i * 1024 * 4096; J.ldt = 4096; }
    else if (j < 26) {
        const int q = j - 10, src = q >> 1, copy = q & 1; int mu = 0;
        J.K = 1024; J.WT = (bf16*)(ws + WS_WBIG); J.ldt = 2048; J.col_off = copy * 1024;
        if (src == 0) { J.W = a.in[opq(I_WR)]; J.N = 1024; J.row_off = 0; mu = 0; }
        else if (src == 1) { J.W = a.in[opq(I_WK)]; J.N = 1024; J.row_off = 1024; mu = 2; }
        else if (src == 2) { J.W = a.in[opq(I_WV)]; J.N = 1024; J.row_off = 2048; mu = 3; }
        else if (src == 3) { J.W = a.in[opq(I_W1)]; J.N = 64; J.row_off = 3072; mu = 1; }
        else if (src == 4) { J.W = a.in[opq(I_W1)] + 1024 * 64; J.N = 64; J.row_off = 3136; mu = 1; }
        else if (src == 5) { J.W = a.in[opq(I_A1)]; J.N = 64; J.row_off = 3200; mu = 4; }
        else if (src == 6) { J.W = a.in[opq(I_A1)] + 1024 * 64; J.N = 64; J.row_off = 3264; mu = 4; }
        else { J.W = a.in[opq(I_G1)]; J.N = 160; J.row_off = 3328; mu = 5; }
        if (copy) J.gain = a.in[opq(I_MU)] + mu * 1024;
    }
    else if (j < 30) { const int q = j - 26; J.W = (q < 2 ? a.in[opq(I_W2)] : a.in[opq(I_A2)]) + (size_t)(q & 1) * 64 * 1024; J.K = 64; J.N = 1024; J.WT = (bf16*)(ws + WS_W2T) + (size_t)q * 1024 * 64; J.ldt = 64; }
    else { J.W = a.in[opq(I_WO)]; J.K = 1024; J.N = 1024; J.WT = (bf16*)(ws + WS_WRO); J.ldt = 1024; }
    return J;
}
DI void row_to_bf16_rs(const float* xrow, bf16* orow, float* rs, int lane) {
    const f32x4* xr = (const f32x4*)xrow + lane;
    f32x4 v[4]; float s = 0.f;
#pragma unroll
    for (int j = 0; j < 4; ++j) { v[j] = xr[64 * j]; s += (v[j].x * v[j].x + v[j].y * v[j].y) + (v[j].z * v[j].z + v[j].w * v[j].w); }
    s = wave_sum(s);
    u32x2* o8 = (u32x2*)orow + lane;
#pragma unroll
    for (int j = 0; j < 4; ++j) { u32x2 w; w.x = pk2(v[j].x, v[j].y); w.y = pk2(v[j].z, v[j].w); o8[64 * j] = w; }
    if (lane == 0) *rs = 1.0f / sqrtf(s * (1.0f / D) + EPS);
}
DI void rows4_to_bf16_rs(const Frame& F, const float* X, bf16* O, float* rs, int nrows) {
    for (int m0 = F.gw * 4; m0 < nrows; m0 += F.ngw * 4) {
        f32x4 v[4][4];
#pragma unroll
        for (int r = 0; r < 4; ++r)
#pragma unroll
            for (int j = 0; j < 4; ++j) v[r][j] = ((const f32x4*)(X + (size_t)(m0 + r) * D))[F.lane + 64 * j];
#pragma unroll
        for (int r = 0; r < 4; ++r) {
            float s = 0.f;
#pragma unroll
            for (int j = 0; j < 4; ++j) s += (v[r][j].x * v[r][j].x + v[r][j].y * v[r][j].y) + (v[r][j].z * v[r][j].z + v[r][j].w * v[r][j].w);
            s = wave_sum(s);
            u32x2* o8 = (u32x2*)(O + (size_t)(m0 + r) * D) + F.lane;
#pragma unroll
            for (int j = 0; j < 4; ++j) { u32x2 w; w.x = pk2(v[r][j].x, v[r][j].y); w.y = pk2(v[r][j].z, v[r][j].w); o8[64 * j] = w; }
            if (F.lane == 0) rs[m0 + r] = 1.0f / sqrtf(s * (1.0f / D) + EPS);
        }
    }
}
DI int t5_bucket(int rel) {
    const int n = rel < 0 ? -rel : rel; int r = rel > 0 ? 16 : 0;
    if (n < 8) return r + n;
    int lg = 8; lg += (n >= 12); lg += (n >= 16); lg += (n >= 23); lg += (n >= 32); lg += (n >= 46); lg += (n >= 64); lg += (n >= 91);
    return r + lg;
}
DI void phase_prologue(const Frame& F0, const Args& a, unsigned char* ws) {
    const Frame F = fresh(F0);
    LAS float* scr = (LAS float*)(F.lds + F.wave * 16384);
    for (int j = 0; j < N_TJOBS; ++j) {
        const TJob J = get_tjob(j, a, ws); const int items = (J.K / 64) * (J.N / 32);
        for (int it = F.gw; it < items; it += F.ngw) tr_item(J, scr, it, F.lane);
    }
    const int gt = F.gw * 64 + F.lane, ngt = F.ngw * 64;
    for (int i = 0; i < 2; ++i) {
        const float* W = a.in[opq(I_XQ)] + (size_t)i * 1024 * 1024; const float* g = a.in[opq(I_NXATTN)] + i * 1024; bf16* O = (bf16*)(ws + WS_WQN) + (size_t)i * 1024 * 1024;
        for (int e = gt; e < 1024 * 1024 / 4; e += ngt) { const f32x4 v = ((const f32x4*)W)[e]; const float s = g[(e * 4) >> 10] * 0.0625f; u32x2 w; w.x = pk2(v.x * s, v.y * s); w.y = pk2(v.z * s, v.w * s); ((u32x2*)O)[e] = w; }
    }
    { const float* W = a.in[opq(I_G2)]; bf16* O = (bf16*)(ws + WS_G2T);
      for (int e = gt; e < 1024 * 256; e += ngt) { const int n = e >> 8, k = e & 255; O[e] = (bf16)(k < 160 ? f2bf(W[(size_t)k * 1024 + n]) : 0u); } }
    { u32x4* O = (u32x4*)((bf16*)(ws + WS_WBIG) + (size_t)3488 * 2048);
      for (int e = gt; e < 96 * 2048 * 2 / 16; e += ngt) O[e] = (u32x4){0u, 0u, 0u, 0u}; }
    rows4_to_bf16_rs(F, a.in[opq(I_X)], (bf16*)(ws + WS_SA), (float*)(ws + WS_RS), M);
    rows4_to_bf16_rs(F, a.in[opq(I_MEM)], (bf16*)(ws + WS_MEMB), (float*)(ws + WS_RSMEM), MMEM);
    { float* B = (float*)(ws + WS_BIAS); const float* tab = a.in[opq(I_REL)];
      for (int e = gt; e < 4 * 4096; e += ngt) { const int h = e >> 12, idx = e & 4095; const int rel = idx - 2047; B[e] = idx < 4095 ? tab[t5_bucket(rel) * 4 + h] * LOG2E : 0.f; } }
    if (F.gw == 0) {
        const float q1 = a.in[opq(I_LQ1)][F.lane] * a.in[opq(I_LK1)][F.lane], q2 = a.in[opq(I_LQ2)][F.lane] * a.in[opq(I_LK2)][F.lane];
        const float s1 = wave_sum(q1), s2 = wave_sum(q2);
        if (F.lane == 0) ((float*)(ws + WS_LAM))[0] = expf(s1) - expf(s2) + 0.2f;
    }
}

DI void phase_norm(const Frame& F0, const float* h, bf16* hb, float* rs) {
    const Frame F = fresh(F0);
    for (int m = F.gw; m < M; m += F.ngw) row_to_bf16_rs(h + (size_t)m * D, hb + (size_t)m * D, rs + m, F.lane);
}
DI void phase_final_norm(const Frame& F0, float* h, const float* g, const float osc) {
    const Frame F = fresh(F0);
    f32x4 gv[4];
#pragma unroll
    for (int j = 0; j < 4; ++j) gv[j] = ((const f32x4*)g)[F.lane + 64 * j];
    for (int m0 = F.gw * 4; m0 < M; m0 += F.ngw * 4) {
        f32x4 v[4][4];
#pragma unroll
        for (int r = 0; r < 4; ++r)
#pragma unroll
            for (int j = 0; j < 4; ++j) v[r][j] = ((const f32x4*)(h + (size_t)(m0 + r) * D))[F.lane + 64 * j];
#pragma unroll
        for (int r = 0; r < 4; ++r) {
            float s = 0.f;
#pragma unroll
            for (int j = 0; j < 4; ++j) s += (v[r][j].x * v[r][j].x + v[r][j].y * v[r][j].y) + (v[r][j].z * v[r][j].z + v[r][j].w * v[r][j].w);
            const float rr = osc / sqrtf(wave_sum(s) * (1.0f / D) + EPS);
            f32x4* xr = (f32x4*)(h + (size_t)(m0 + r) * D) + F.lane;
#pragma unroll
            for (int j = 0; j < 4; ++j) xr[64 * j] = v[r][j] * rr * gv[j];
        }
    }
}
DI void phase_rwkv_shift(const Frame& F0, const float* h, const float* g, bf16* A1) {
    const Frame F = fresh(F0);
    f32x4 gv[4];
#pragma unroll
    for (int j = 0; j < 4; ++j) gv[j] = ((const f32x4*)g)[F.lane + 64 * j];
    for (int ch = F.gw; ch < M / 16; ch += F.ngw) {
        const int m0 = ch * 16, t0 = m0 & (T - 1);
        f32x4 p2[4], p1[4], cu[4];
#pragma unroll
        for (int j = 0; j < 4; ++j) { p2[j] = (f32x4){0.f, 0.f, 0.f, 0.f}; p1[j] = p2[j]; cu[j] = p2[j]; }
#pragma unroll 1
        for (int g6 = 0; g6 < 3; ++g6) {
            f32x4 ld[6][4];
#pragma unroll
            for (int r = 0; r < 6; ++r) { const int i = g6 * 6 + r - 1, t = t0 + i; const bool ok = (t >= 0 && t < T);
#pragma unroll
                for (int j = 0; j < 4; ++j) ld[r][j] = ok ? ((const f32x4*)(h + (size_t)(m0 + i) * D))[F.lane + 64 * j] : (f32x4){0.f, 0.f, 0.f, 0.f}; }
#pragma unroll
            for (int r = 0; r < 6; ++r) {
                const int i = g6 * 6 + r - 1;
                float s = 0.f;
#pragma unroll
                for (int j = 0; j < 4; ++j) { p2[j] = p1[j]; p1[j] = cu[j]; cu[j] = ld[r][j]; s += (cu[j].x * cu[j].x + cu[j].y * cu[j].y) + (cu[j].z * cu[j].z + cu[j].w * cu[j].w); }
                const float rr = 1.0f / sqrtf(wave_sum(s) * (1.0f / D) + EPS);
#pragma unroll
                for (int j = 0; j < 4; ++j) cu[j] = cu[j] * rr * gv[j];
                if (i >= 1) {
                    u32x2* o = (u32x2*)(A1 + (size_t)(m0 + i - 1) * 2048) + F.lane;
#pragma unroll
                    for (int j = 0; j < 4; ++j) { const f32x4 hh = (p2[j] + cu[j]) * 0.5f - p1[j];
                        u32x2 w; w.x = pk2(p1[j].x, p1[j].y); w.y = pk2(p1[j].z, p1[j].w); o[64 * j] = w;
                        u32x2 w2; w2.x = pk2(hh.x, hh.y); w2.y = pk2(hh.z, hh.w); o[256 + 64 * j] = w2; }
                }
            }
        }
    }
}
DI void phase_rwkv_comb(const Frame& F0, const bf16* YF, const bf16* YB, const bf16* V, const bf16* GT, const float* BON, const float* lng, const float* lnb, bf16* O) {
    const Frame F = fresh(F0);
    const int hd = F.lane >> 2, c0 = F.lane * 16;
    float lg[16], lb[16];
#pragma unroll
    for (int j = 0; j < 16; ++j) { lg[j] = lng[c0 + j]; lb[j] = lnb[c0 + j]; }
    for (int m0 = F.gw * 2; m0 < M; m0 += F.ngw * 2) {
        u32x4 a[2][2], b[2][2], vv[2][2], gg[2][2]; float bonr[2];
#pragma unroll
        for (int r = 0; r < 2; ++r) { const size_t off = (size_t)(m0 + r) * D + c0;
#pragma unroll
            for (int q = 0; q < 2; ++q) { a[r][q] = ((const u32x4*)(YF + off))[q]; b[r][q] = ((const u32x4*)(YB + off))[q]; vv[r][q] = ((const u32x4*)(V + off))[q]; gg[r][q] = ((const u32x4*)(GT + off))[q]; }
            bonr[r] = BON[(size_t)(m0 + r) * 16 + hd] + BON[(size_t)(M + m0 + r) * 16 + hd]; }
#pragma unroll
        for (int r = 0; r < 2; ++r) {
            const size_t off = (size_t)(m0 + r) * D + c0; const float bon = bonr[r];
            float y[16]; float s = 0.f;
#pragma unroll
            for (int q = 0; q < 2; ++q)
#pragma unroll
                for (int w = 0; w < 4; ++w) { y[q * 8 + 2 * w] = bflo(a[r][q][w]) + bflo(b[r][q][w]); y[q * 8 + 2 * w + 1] = bfhi(a[r][q][w]) + bfhi(b[r][q][w]); }
#pragma unroll
            for (int j = 0; j < 16; ++j) s += y[j];
            s += swz_xor<1>(s); s += swz_xor<2>(s);
            const float mean = s * (1.0f / 64.0f); float q2 = 0.f;
#pragma unroll
            for (int j = 0; j < 16; ++j) { y[j] -= mean; q2 += y[j] * y[j]; }
            q2 += swz_xor<1>(q2); q2 += swz_xor<2>(q2);
            const float rstd = 1.0f / sqrtf(q2 * (1.0f / 64.0f) + 64e-5f);
            u32x4 o[2];
#pragma unroll
            for (int q = 0; q < 2; ++q)
#pragma unroll
                for (int w = 0; w < 4; ++w) {
                    const int j = q * 8 + 2 * w;
                    const float r0 = (y[j] * rstd * lg[j] + lb[j] + bon * bflo(vv[r][q][w])) * bflo(gg[r][q][w]);
                    const float r1 = (y[j + 1] * rstd * lg[j + 1] + lb[j + 1] + bon * bfhi(vv[r][q][w])) * bfhi(gg[r][q][w]);
                    o[q][w] = pk2(r0, r1);
                }
            ((u32x4*)(O + off))[0] = o[0]; ((u32x4*)(O + off))[1] = o[1];
        }
    }
}
constexpr int CV_ROWB = 1040, CV_IN_BYTES = 94 * CV_ROWB, CV_W_OFF = CV_IN_BYTES;
DI void conv_load_weights(const Frame& F0, const float* cw) {
    const Frame F = fresh(F0);
    LAS bf16* W = (LAS bf16*)(F.lds + CV_W_OFF);
    for (int e = F.tid; e < 31 * 512; e += 512) W[e] = (bf16)f2bf(cw[e]);
}
DI void conv_unit(const Frame& F0, int unit, const bf16* GLU, const float* cb, const float* lg, const float* lb, bf16* MIX) {
    const Frame F = fresh(F0);
    const int b = unit >> 5, t0 = (unit & 31) * 64;
    __syncthreads();
    for (int p = F.tid; p < 94 * 64; p += 512) {
        const int r = p >> 6, c = p & 63, t = t0 - 15 + r;
        u32x4 v = (u32x4){0u, 0u, 0u, 0u};
        if (t >= 0 && t < T) v = *(const u32x4*)(GLU + (size_t)(b * T + t) * 512 + c * 8);
        *(LAS u32x4*)(F.lds + r * CV_ROWB + c * 16) = v;
    }
    __syncthreads();
    const int tl = F.tid >> 3, chunk = F.tid & 7;
    float y[64];
#pragma unroll
    for (int i = 0; i < 8; ++i) {
        const int cg = chunk + 8 * i;
        float acc[8];
#pragma unroll
        for (int e = 0; e < 8; ++e) acc[e] = cb[cg * 8 + e];
#pragma unroll 1
        for (int j = 0; j < 31; ++j) {
            const u32x4 x = *(const LAS u32x4*)(F.lds + (tl + j) * CV_ROWB + cg * 16);
            const u32x4 w = *(const LAS u32x4*)(F.lds + CV_W_OFF + j * 1024 + cg * 16);
#pragma unroll
            for (int q = 0; q < 4; ++q) { acc[2 * q] += bflo(x[q]) * bflo(w[q]); acc[2 * q + 1] += bfhi(x[q]) * bfhi(w[q]); }
        }
#pragma unroll
        for (int e = 0; e < 8; ++e) y[i * 8 + e] = acc[e];
    }
    float s = 0.f;
#pragma unroll
    for (int j = 0; j < 64; ++j) s += y[j];
    s += swz_xor<1>(s); s += swz_xor<2>(s); s += swz_xor<4>(s);
    const float mean = s * (1.0f / 512.0f); float q2 = 0.f;
#pragma unroll
    for (int j = 0; j < 64; ++j) { y[j] -= mean; q2 += y[j] * y[j]; }
    q2 += swz_xor<1>(q2); q2 += swz_xor<2>(q2); q2 += swz_xor<4>(q2);
    const float rstd = 1.0f / sqrtf(q2 * (1.0f / 512.0f) + 1e-5f);
    bf16* orow = MIX + (size_t)(b * T + t0 + tl) * 1024;
#pragma unroll
    for (int i = 0; i < 8; ++i) {
        const int c0 = (chunk + 8 * i) * 8;
        const f32x4 g0 = *(const f32x4*)(lg + c0), g1 = *(const f32x4*)(lg + c0 + 4), b0 = *(const f32x4*)(lb + c0), b1 = *(const f32x4*)(lb + c0 + 4);
        f32x4 o0, o1;
#pragma unroll
        for (int e = 0; e < 4; ++e) { const float v0 = y[i * 8 + e] * rstd * g0[e] + b0[e], v1 = y[i * 8 + 4 + e] * rstd * g1[e] + b1[e]; o0[e] = v0 * sigmoidf_(v0); o1[e] = v1 * sigmoidf_(v1); }
        store8(orow + c0, o0, o1);
    }
}

constexpr int DA_KROW = 272, DA_VROW = 136, DA_KB = 64 * DA_KROW, DA_VB = 128 * DA_VROW, DA_BUF = DA_KB + DA_VB;
DI int crow(int reg, int hf) { return (reg & 3) + 8 * (reg >> 2) + 4 * hf; }
DI void diffattn_unit(const Frame& F0, int unit, const bf16* QK, const bf16* VT, const float* BIAS, const float lam, const float* subg, bf16* MIX) {
    const Frame F = fresh(F0);
    const int b = unit >> 6, h = (unit >> 4) & 3, qb = unit & 15;
    const int c = F.wave >> 2, qs = F.wave & 3, r32 = F.lane & 31, hf = F.lane >> 5;
    const int q0w = qb * 128 + qs * 32;
    const float* bias_h = BIAS + h * 4096 + 2047;
    bf16x8 Qf[4];
    { const bf16* qp = QK + (size_t)(b * T + q0w + r32) * 1024 + h * 128 + c * 64 + 8 * hf;
#pragma unroll
      for (int ks = 0; ks < 4; ++ks) Qf[ks] = *(const bf16x8*)(qp + 16 * ks); }
    const bf16* kg[2]; const bf16* vg[2]; int kl[2], vl[2];
#pragma unroll
    for (int i = 0; i < 2; ++i) { const int p = F.tid + 512 * i;
        kg[i] = QK + (size_t)(b * T + (p >> 4)) * 1024 + 512 + h * 128 + (p & 15) * 8; kl[i] = (p >> 4) * DA_KROW + (p & 15) * 16;
        vg[i] = VT + (size_t)(h * 128 + (p >> 3)) * M + b * T + (p & 7) * 8; vl[i] = DA_KB + (p >> 3) * DA_VROW + (p & 7) * 16; }
    u32x4 kr[2], vr[2];
#pragma unroll
    for (int i = 0; i < 2; ++i) { kr[i] = *(const u32x4*)(kg[i]); vr[i] = *(const u32x4*)(vg[i]); }
    __syncthreads();
#pragma unroll
    for (int i = 0; i < 2; ++i) { *(LAS u32x4*)(F.lds + kl[i]) = kr[i]; *(LAS u32x2*)(F.lds + vl[i]) = (u32x2){vr[i].x, vr[i].y}; *(LAS u32x2*)(F.lds + vl[i] + 8) = (u32x2){vr[i].z, vr[i].w}; }
    __syncthreads();
    f32x16 O[4];
#pragma unroll
    for (int vt = 0; vt < 4; ++vt)
#pragma unroll
        for (int i = 0; i < 16; ++i) O[vt][i] = 0.f;
    float lsum = 0.f;
    const int ka = r32 * DA_KROW + c * 128 + 16 * hf;
    const int va = DA_KB + r32 * DA_VROW + 8 * hf;
    for (int kt = 0; kt < 32; ++kt) {
        const int k0 = kt * 64;
        LAS unsigned char* buf = F.lds + (kt & 1) * DA_BUF;
        if (kt + 1 < 32) {
#pragma unroll
            for (int i = 0; i < 2; ++i) { kr[i] = *(const u32x4*)(kg[i] + (size_t)(k0 + 64) * 1024); vr[i] = *(const u32x4*)(vg[i] + k0 + 64); }
        }
        const int dmin = k0 - (q0w + 31), dmax = k0 + 63 - q0w;
        const bool far = (dmin >= 91) || (dmax <= -91);
        const float cb = dmin >= 91 ? bias_h[91] : bias_h[-91];
#pragma unroll
        for (int sub = 0; sub < 2; ++sub) {
            f32x16 S;
#pragma unroll
            for (int i = 0; i < 16; ++i) S[i] = 0.f;
#pragma unroll
            for (int ks = 0; ks < 4; ++ks) { const bf16x8 a = *(const LAS bf16x8*)(buf + ka + sub * 32 * DA_KROW + ks * 32); S = __builtin_amdgcn_mfma_f32_32x32x16_bf16(a, Qf[ks], S, 0, 0, 0); }
            float p[16];
            if (far) {
#pragma unroll
                for (int i = 0; i < 16; ++i) p[i] = fexp2(S[i] * LOG2E + cb);
            } else {
                const int rel0 = k0 + 32 * sub - (q0w + r32);
#pragma unroll
                for (int i = 0; i < 16; ++i) p[i] = fexp2(S[i] * LOG2E + bias_h[rel0 + crow(i, hf)]);
            }
#pragma unroll
            for (int i = 0; i < 16; ++i) lsum += p[i];
#pragma unroll
            for (int s = 0; s < 2; ++s) {
                u32x4 pw; pw.x = pk2(p[8 * s], p[8 * s + 1]); pw.y = pk2(p[8 * s + 2], p[8 * s + 3]); pw.z = pk2(p[8 * s + 4], p[8 * s + 5]); pw.w = pk2(p[8 * s + 6], p[8 * s + 7]);
                const bf16x8 pa = __builtin_bit_cast(bf16x8, pw);
#pragma unroll
                for (int vt = 0; vt < 4; ++vt) {
                    const LAS unsigned char* vp = buf + va + vt * 32 * DA_VROW + (32 * sub + 16 * s) * 2;
                    const u32x2 lo = *(const LAS u32x2*)(vp), hi = *(const LAS u32x2*)(vp + 16);
                    const u32x4 vw = (u32x4){lo.x, lo.y, hi.x, hi.y};
                    O[vt] = __builtin_amdgcn_mfma_f32_32x32x16_bf16(pa, __builtin_bit_cast(bf16x8, vw), O[vt], 0, 0, 0);
                }
            }
        }
        if (kt + 1 < 32) {
            LAS unsigned char* nb = F.lds + ((kt + 1) & 1) * DA_BUF;
#pragma unroll
            for (int i = 0; i < 2; ++i) { *(LAS u32x4*)(nb + kl[i]) = kr[i]; *(LAS u32x2*)(nb + vl[i]) = (u32x2){vr[i].x, vr[i].y}; *(LAS u32x2*)(nb + vl[i] + 8) = (u32x2){vr[i].z, vr[i].w}; }
        }
        __syncthreads();
    }
    lsum = half_sum(lsum);
    LAS float* XO = (LAS float*)F.lds;
    LAS float* LW = (LAS float*)(F.lds + 65536) + F.wave * 32;
    if (hf == 0) LW[r32] = 1.0f / lsum;
    asm volatile("s_waitcnt lgkmcnt(0)" ::: "memory");
    float il[16];
#pragma unroll
    for (int i = 0; i < 16; ++i) il[i] = LW[crow(i, hf)];
    if (c == 1) {
#pragma unroll
        for (int vt = 0; vt < 4; ++vt)
#pragma unroll
            for (int i = 0; i < 16; ++i) XO[(qs * 32 + crow(i, hf)) * 128 + vt * 32 + r32] = O[vt][i] * il[i];
    }
    __syncthreads();
    if (c == 0) {
        float ss[16];
#pragma unroll
        for (int i = 0; i < 16; ++i) ss[i] = 0.f;
#pragma unroll
        for (int vt = 0; vt < 4; ++vt)
#pragma unroll
            for (int i = 0; i < 16; ++i) { const float o = O[vt][i] * il[i] - lam * XO[(qs * 32 + crow(i, hf)) * 128 + vt * 32 + r32]; O[vt][i] = o; ss[i] += o * o; }
#pragma unroll
        for (int i = 0; i < 16; ++i) { float v = ss[i]; v += swz_xor<1>(v); v += swz_xor<2>(v); v += swz_xor<4>(v); v += swz_xor<8>(v); v += swz_xor<16>(v); ss[i] = 0.8f / sqrtf(v * (1.0f / 128.0f) + EPS); }
#pragma unroll
        for (int vt = 0; vt < 4; ++vt) {
            const float g = subg[vt * 32 + r32];
#pragma unroll
            for (int i = 0; i < 16; ++i) MIX[(size_t)(b * T + q0w + crow(i, hf)) * 1024 + 512 + h * 128 + vt * 32 + r32] = (bf16)f2bf(O[vt][i] * ss[i] * g);
        }
    }
}

constexpr int SC_VECB = 256, SC_STEPB = 6 * SC_VECB, SC_BUFB = 16 * SC_STEPB;
constexpr int SC_SCR_OFF = 4 * SC_BUFB, SC_SCR_W = 16 * 68 * 4;
DI float dpp_x1(float v) { return __builtin_bit_cast(float, __builtin_amdgcn_update_dpp(0, __builtin_bit_cast(int, v), 0xB1, 0xF, 0xF, true)); }
DI float dpp_x2(float v) { return __builtin_bit_cast(float, __builtin_amdgcn_update_dpp(0, __builtin_bit_cast(int, v), 0x4E, 0xF, 0xF, true)); }
DI float quad_sum(float v) { v += dpp_x1(v); v += dpp_x2(v); return v; }

DI float a_fmac(float acc, float a, float b) { return __builtin_fmaf(a, b, acc); }
DI float a_fma(float a, float b, float c) { return __builtin_fmaf(a, b, c); }
DI float a_mul(float a, float b) { return a * b; }
struct ScanPtrs { const bf16 *R, *K, *V, *HD1, *W2T; const float *w0, *a0, *kk, *ka, *rk; bf16 *YF, *YB; float* BON; unsigned* ERR; };

DI void scan_pair(const Frame& F0, int bh, const ScanPtrs& P) {
    const Frame F = fresh(F0);
    const int b = bh >> 4, h = bh & 15;
    __syncthreads();
    if (F.wave < 4) {
        const int z = F.wave >> 1, rh = F.wave & 1, rp = F.lane >> 2, jq = F.lane & 3, i0 = rh * 32 + 2 * rp;
        float S0[16], S1[16];
#pragma unroll
        for (int j = 0; j < 16; ++j) { S0[j] = 0.f; S1[j] = 0.f; }
        bf16* Y = z ? P.YB : P.YF;
        __builtin_amdgcn_s_barrier();
#ifdef MK_TPROBE
        unsigned long long tp_acc = 0ull, tp_phase0 = __builtin_amdgcn_s_memtime();
#endif
        for (int e = 0; e < T / 16; ++e) {
#ifdef MK_TPROBE
            const unsigned long long tp0 = __builtin_amdgcn_s_memtime();
#endif
            const LAS unsigned char* base = F.lds + (z * 2 + (e & 1)) * SC_BUFB + jq * 64;
            const int t0c = z ? T - 16 * (e + 1) : 16 * e;
            bf16* yrow = Y + (size_t)(b * T + t0c) * 1024 + h * 64 + i0;
            f32x4 wv[2][4], kv[2][4], bv[2][4], av[2][4], rv[2][4]; f32x2 v2[2];
#define SC_FETCH(slot, li_) do { const LAS unsigned char* sb_ = base + (li_) * SC_STEPB; _Pragma("unroll") for (int q = 0; q < 4; ++q) { \
                av[slot][q] = *(const LAS f32x4*)(sb_ + 3 * SC_VECB + q * 16); wv[slot][q] = *(const LAS f32x4*)(sb_ + q * 16); kv[slot][q] = *(const LAS f32x4*)(sb_ + SC_VECB + q * 16); \
                bv[slot][q] = *(const LAS f32x4*)(sb_ + 2 * SC_VECB + q * 16); rv[slot][q] = *(const LAS f32x4*)(sb_ + 4 * SC_VECB + q * 16); } \
                v2[slot] = *(const LAS f32x2*)(sb_ - jq * 64 + 5 * SC_VECB + i0 * 4); } while (0)
            SC_FETCH(0, z ? 15 : 0);
#pragma unroll
            for (int s = 0; s < 16; ++s) {
                const int li = z ? 15 - s : s, cs = s & 1, ns = cs ^ 1;
                if (s < 15) SC_FETCH(ns, z ? 14 - s : s + 1);
                __builtin_amdgcn_sched_barrier(0);
                float sa0 = 0.f, sa1 = 0.f, sb0 = 0.f, sb1 = 0.f;
#pragma unroll
                for (int j = 0; j < 16; j += 2) { const float a0 = av[cs][j >> 2][j & 3], a1 = av[cs][(j + 1) >> 2][(j + 1) & 3];
                    sa0 = a_fmac(sa0, S0[j], a0); sb0 = a_fmac(sb0, S1[j], a0); sa1 = a_fmac(sa1, S0[j + 1], a1); sb1 = a_fmac(sb1, S1[j + 1], a1); }
                const float sa = quad_sum(sa0 + sa1), sb = quad_sum(sb0 + sb1);
                const float v0 = v2[cs].x, v1 = v2[cs].y;
                float y0 = 0.f, y1 = 0.f, z0 = 0.f, z1 = 0.f;
#pragma unroll
                for (int j = 0; j < 16; ++j) {
                    const float wj = wv[cs][j >> 2][j & 3], bj = bv[cs][j >> 2][j & 3], kj = kv[cs][j >> 2][j & 3], rj = rv[cs][j >> 2][j & 3];
                    S0[j] = a_fma(S0[j], wj, a_fma(sa, bj, a_mul(v0, kj)));
                    S1[j] = a_fma(S1[j], wj, a_fma(sb, bj, a_mul(v1, kj)));
                    if (j & 1) { y1 = a_fmac(y1, S0[j], rj); z1 = a_fmac(z1, S1[j], rj); } else { y0 = a_fmac(y0, S0[j], rj); z0 = a_fmac(z0, S1[j], rj); }
                }
                f32x2 y; y.x = quad_sum(y0 + y1); y.y = quad_sum(z0 + z1);
                if (jq == 0) *(unsigned*)(yrow + (size_t)li * 1024) = pk2(y.x, y.y);
                __builtin_amdgcn_sched_barrier(0);
            }
#undef SC_FETCH
            asm volatile("s_waitcnt lgkmcnt(0)" ::: "memory");
#ifdef MK_TPROBE
            tp_acc += __builtin_amdgcn_s_memtime() - tp0;
#endif
            __builtin_amdgcn_s_barrier();
        }
#ifdef MK_TPROBE
        if (blockIdx.x == 0 && F.wave == 0) {
            const unsigned long long tot = __builtin_amdgcn_s_memtime() - tp_phase0;
            const unsigned long long amt = (MK_TPROBE > 0 ? (unsigned long long)MK_TPROBE * tp_acc : (unsigned long long)(-(MK_TPROBE)) * (tot - tp_acc));
            const unsigned long long w0 = __builtin_amdgcn_s_memtime();
            while (__builtin_amdgcn_s_memtime() - w0 < amt) __builtin_amdgcn_s_sleep(8);
        }
#endif
    } else {
        const int pw = F.wave - 4, z = pw >> 1, par = pw & 1;
        const int l15 = F.lane & 15, l4 = F.lane >> 4, row = F.lane >> 2, cq = F.lane & 3;
        const bf16* w2p = P.W2T + (size_t)z * 65536 + (size_t)(h * 64 + l15) * 64 + 8 * l4;
        const int ch0 = h * 64 + cq * 16;
        LAS float* scrW = (LAS float*)(F.lds + SC_SCR_OFF + pw * 2 * SC_SCR_W);
        LAS float* scrA = scrW + 16 * 68;
        bf16x8 Ahw[2], Aha[2]; u32x4 r16[2], k16[2], v16[2];
        auto do_load = [&](int c) {
            const int t0c = z ? T - 16 * (c + 1) : 16 * c; const size_t m0 = (size_t)b * T + t0c;
#pragma unroll
            for (int ks = 0; ks < 2; ++ks) { const bf16* p = P.HD1 + (m0 + l15) * 256 + z * 64 + 32 * ks + 8 * l4; Ahw[ks] = *(const bf16x8*)p; Aha[ks] = *(const bf16x8*)(p + 128); }
            const size_t off = (m0 + row) * 1024 + ch0;
#pragma unroll
            for (int q = 0; q < 2; ++q) { r16[q] = ((const u32x4*)(P.R + off))[q]; k16[q] = ((const u32x4*)(P.K + off))[q]; v16[q] = ((const u32x4*)(P.V + off))[q]; }
        };
        auto do_compute = [&](int c) {
            const int t0c = z ? T - 16 * (c + 1) : 16 * c; const size_t m0 = (size_t)b * T + t0c;
#pragma unroll
            for (int nt = 0; nt < 4; ++nt) {
                f32x4 dw = (f32x4){0.f, 0.f, 0.f, 0.f}, da = dw;
#pragma unroll
                for (int ks = 0; ks < 2; ++ks) { const bf16x8 wf = *(const bf16x8*)(w2p + nt * 1024 + ks * 32), af = *(const bf16x8*)(w2p + 2 * 65536 + nt * 1024 + ks * 32);
                    dw = __builtin_amdgcn_mfma_f32_16x16x32_bf16(Ahw[ks], wf, dw, 0, 0, 0); da = __builtin_amdgcn_mfma_f32_16x16x32_bf16(Aha[ks], af, da, 0, 0, 0); }
#pragma unroll
                for (int rg = 0; rg < 4; ++rg) { scrW[(4 * l4 + rg) * 68 + 16 * nt + l15] = dw[rg]; scrA[(4 * l4 + rg) * 68 + 16 * nt + l15] = da[rg]; }
            }
            asm volatile("s_waitcnt lgkmcnt(0)" ::: "memory");
            float ssq = 0.f;
#pragma unroll
            for (int q = 0; q < 2; ++q)
#pragma unroll
                for (int w = 0; w < 4; ++w) { const f32x2 kc = *(const f32x2*)(P.kk + ch0 + q * 8 + 2 * w); const float k0 = bflo(k16[q][w]) * kc.x, k1 = bfhi(k16[q][w]) * kc.y; ssq += k0 * k0 + k1 * k1; }
            ssq = quad_sum(ssq);
            const float inv = 1.0f / fmaxf(sqrtf(ssq), 1e-12f);
            float bon = 0.f;
            LAS unsigned char* sb = F.lds + (z * 2 + (c & 1)) * SC_BUFB + row * SC_STEPB + cq * 64;
#pragma unroll
            for (int q = 0; q < 4; ++q) {
                const f32x4 wp = *(const LAS f32x4*)(scrW + row * 68 + cq * 16 + q * 4), ap = *(const LAS f32x4*)(scrA + row * 68 + cq * 16 + q * 4);
                const f32x4 w0v = *(const f32x4*)(P.w0 + z * 1024 + ch0 + q * 4), a0v = *(const f32x4*)(P.a0 + z * 1024 + ch0 + q * 4);
                const f32x4 kkv = *(const f32x4*)(P.kk + ch0 + q * 4), kav = *(const f32x4*)(P.ka + ch0 + q * 4), rkv = *(const f32x4*)(P.rk + ch0 + q * 4);
                const unsigned kw0 = k16[q >> 1][(q & 1) * 2], kw1 = k16[q >> 1][(q & 1) * 2 + 1], rw0 = r16[q >> 1][(q & 1) * 2], rw1 = r16[q >> 1][(q & 1) * 2 + 1], vw0 = v16[q >> 1][(q & 1) * 2], vw1 = v16[q >> 1][(q & 1) * 2 + 1];
                const f32x4 kf = (f32x4){bflo(kw0), bfhi(kw0), bflo(kw1), bfhi(kw1)}, rf = (f32x4){bflo(rw0), bfhi(rw0), bflo(rw1), bfhi(rw1)}, vf = (f32x4){bflo(vw0), bfhi(vw0), bflo(vw1), bfhi(vw1)};
                f32x4 ow, ok, ob, oa;
#pragma unroll
                for (int j = 0; j < 4; ++j) {
                    const float dec = fexp2(-0.60653066f * LOG2E * sigmoidf_(wp[j] + w0v[j]));
                    const float ar = sigmoidf_(ap[j] + a0v[j]);
                    const float kkn = kf[j] * kkv[j] * inv;
                    const float kd = kf[j] * (1.0f + (ar - 1.0f) * kav[j]);
                    ow[j] = dec; ok[j] = kd; ob[j] = kkn * ar; oa[j] = -kkn;
                    bon += rf[j] * kd * rkv[j];
                }
                *(LAS f32x4*)(sb + q * 16) = ow; *(LAS f32x4*)(sb + SC_VECB + q * 16) = ok; *(LAS f32x4*)(sb + 2 * SC_VECB + q * 16) = ob;
                *(LAS f32x4*)(sb + 3 * SC_VECB + q * 16) = oa; *(LAS f32x4*)(sb + 4 * SC_VECB + q * 16) = rf; *(LAS f32x4*)(sb + 5 * SC_VECB + q * 16) = vf;
            }
            bon = quad_sum(bon);
            if (cq == 0) P.BON[((size_t)z * M + m0 + row) * 16 + h] = bon;
            asm volatile("s_waitcnt lgkmcnt(0)" ::: "memory");
        };
        if (par == 0) { do_load(0); do_compute(0); } else do_load(1);
        __builtin_amdgcn_s_barrier();
        for (int e = 0; e < T / 16; ++e) {
            if (((e + 1) & 1) == par) { if (e + 1 < T / 16) do_compute(e + 1); }
            else { if (e + 2 < T / 16) do_load(e + 2); }
            __builtin_amdgcn_s_barrier();
        }
    }
}


constexpr int CS_AT = 0, CS_RT = 2304, CS_BK = 4608, CS_SMQ = 9728, CS_SMT = 11008, CS_NQ = 12288, CS_VT = 13568, CS_GL = 16640, CS_BUF = 16896;
constexpr int CS_PZ = 4 * CS_BUF;
constexpr int CS_W = CS_PZ + 2 * 4608;
constexpr int CS_WSZ = 7424;
constexpr int CS_BON = CS_W + 8 * CS_WSZ;
static_assert(CS_BON + 1024 <= 131072 + 8192, "chunked-scan LDS map");
template <int CTRL> DI float dpp_mov0(float v) { return __builtin_bit_cast(float, __builtin_amdgcn_update_dpp(0, __builtin_bit_cast(int, v), CTRL, 0xF, 0xF, false)); }
DI float row_prefix(float v) { v += dpp_mov0<0x111>(v); v += dpp_mov0<0x112>(v); v += dpp_mov0<0x114>(v); v += dpp_mov0<0x118>(v); return v; }
DI float row_suffix(float v) { v += dpp_mov0<0x101>(v); v += dpp_mov0<0x102>(v); v += dpp_mov0<0x104>(v); v += dpp_mov0<0x108>(v); return v; }
DI bf16x8 lds16(const LAS unsigned char* p) { return *(const LAS bf16x8*)p; }
DI f32x4 mfma16(bf16x8 a, bf16x8 b, f32x4 c) { return __builtin_amdgcn_mfma_f32_16x16x32_bf16(a, b, c, 0, 0, 0); }

DI void scan_pair_mfma(const Frame& F0, int bh, const ScanPtrs& P) {
    const Frame F = fresh(F0);
    const int b = bh >> 4, h = bh & 15;
    const int z = F.wave >> 2, q4 = F.wave & 3;
    const int l15 = F.lane & 15, l4 = F.lane >> 4;
    const int te = l15, cg = l4, c4 = cg * 4;
    const int rr = z ? 15 - te : te;
    const int jl = 16 * q4 + c4;
    const int chq = h * 64 + 16 * q4;
    LAS unsigned char* const L = F.lds;
    LAS unsigned char* const pz = L + CS_PZ + z * 4608;
    LAS unsigned char* const wsc = L + CS_W + F.wave * CS_WSZ;
    LAS float* const scrW = (LAS float*)wsc; LAS float* const scrA = scrW + 16 * 20;
    LAS unsigned char* const ZB = wsc + 2560; LAS unsigned char* const XB = wsc + 4864; LAS unsigned char* const UB = wsc + 5632;
    LAS float* const yst = (LAS float*)(wsc + 6400);
    LAS float* const bonp = (LAS float*)(L + CS_BON);
    bf16* Y = z ? P.YB : P.YF;
    const bf16* w2p = P.W2T + (size_t)z * 65536 + (size_t)(chq + l15) * 64 + 8 * l4;
    bf16x8 Wf[2], Af[2];
#pragma unroll
    for (int ks = 0; ks < 2; ++ks) { Wf[ks] = *(const bf16x8*)(w2p + ks * 32); Af[ks] = *(const bf16x8*)(w2p + 2 * 65536 + ks * 32); }
    const f32x4 w0v = *(const f32x4*)(P.w0 + z * 1024 + chq + c4), a0v = *(const f32x4*)(P.a0 + z * 1024 + chq + c4);
    const f32x4 kkv = *(const f32x4*)(P.kk + chq + c4), kav = *(const f32x4*)(P.ka + chq + c4), rkv = *(const f32x4*)(P.rk + chq + c4);
    f32x4 kcn[4];
#pragma unroll
    for (int q = 0; q < 4; ++q) kcn[q] = *(const f32x4*)(P.kk + h * 64 + 16 * cg + q * 4);
    f32x4 Z[4];
#pragma unroll
    for (int jt = 0; jt < 4; ++jt) Z[jt] = (f32x4){0.f, 0.f, 0.f, 0.f};
    bf16x8 Ahw[2], Aha[2]; u32x2 r4, k4, v4; u32x4 kfull[2];
    auto do_load = [&](int c) {
        const int t0c = z ? T - 16 * (c + 1) : 16 * c; const size_t m0 = (size_t)b * T + t0c;
#pragma unroll
        for (int ks = 0; ks < 2; ++ks) { const bf16* p = P.HD1 + (m0 + l15) * 256 + z * 64 + 32 * ks + 8 * l4; Ahw[ks] = *(const bf16x8*)p; Aha[ks] = *(const bf16x8*)(p + 128); }
        const size_t off = (m0 + rr) * 1024;
        r4 = *(const u32x2*)(P.R + off + chq + c4); k4 = *(const u32x2*)(P.K + off + chq + c4); v4 = *(const u32x2*)(P.V + off + chq + c4);
        kfull[0] = ((const u32x4*)(P.K + off + h * 64 + 16 * cg))[0]; kfull[1] = ((const u32x4*)(P.K + off + h * 64 + 16 * cg))[1];
    };
    auto prep_a = [&](int c) {
        LAS unsigned char* const bp = L + (z * 2 + (c & 1)) * CS_BUF;
        f32x4 dw = (f32x4){0.f, 0.f, 0.f, 0.f}, da = dw;
#pragma unroll
        for (int ks = 0; ks < 2; ++ks) { dw = mfma16(Ahw[ks], Wf[ks], dw); da = mfma16(Aha[ks], Af[ks], da); }
#pragma unroll
        for (int rg = 0; rg < 4; ++rg) { scrW[(4 * l4 + rg) * 20 + l15] = dw[rg]; scrA[(4 * l4 + rg) * 20 + l15] = da[rg]; }
        float ssq = 0.f;
#pragma unroll
        for (int q = 0; q < 2; ++q)
#pragma unroll
            for (int w = 0; w < 4; ++w) { const float k0 = bflo(kfull[q][w]) * kcn[q * 2 + (w >> 1)][(w & 1) * 2], k1 = bfhi(kfull[q][w]) * kcn[q * 2 + (w >> 1)][(w & 1) * 2 + 1]; ssq += k0 * k0 + k1 * k1; }
        ssq += swz_xor<16>(ssq); ssq = half_sum(ssq);
        const float inv = 1.0f / fmaxf(sqrtf(ssq), 1e-12f);
        asm volatile("s_waitcnt lgkmcnt(0)" ::: "memory");
        const f32x4 wp = *(const LAS f32x4*)(scrW + rr * 20 + c4), ap = *(const LAS f32x4*)(scrA + rr * 20 + c4);
        const f32x4 kf = (f32x4){bflo(k4.x), bfhi(k4.x), bflo(k4.y), bfhi(k4.y)}, rf = (f32x4){bflo(r4.x), bfhi(r4.x), bflo(r4.y), bfhi(r4.y)}, vf = (f32x4){bflo(v4.x), bfhi(v4.x), bflo(v4.y), bfhi(v4.y)};
        f32x4 at, rt, bt, kt, bhh, khh, gl; float bon = 0.f;
#pragma unroll
        for (int j = 0; j < 4; ++j) {
            const float lw = -0.60653066f * LOG2E * sigmoidf_(wp[j] + w0v[j]);
            const float ar = sigmoidf_(ap[j] + a0v[j]);
            const float kkn = kf[j] * kkv[j] * inv;
            const float kd = kf[j] * (1.0f + (ar - 1.0f) * kav[j]);
            const float bvec = kkn * ar, avec = -kkn;
#ifdef MK_LDSPREFIX
            scrW[te * 20 + c4 + j] = lw;
            asm volatile("s_waitcnt lgkmcnt(0)" ::: "memory");
            float pi = 0.f, su = 0.f;
            for (int s2 = 0; s2 < 16; ++s2) { const float x = scrW[s2 * 20 + c4 + j]; if (s2 <= te) pi += x; else su += x; }
            asm volatile("s_waitcnt lgkmcnt(0)" ::: "memory");
#else
            const float pi = row_prefix(lw), su = row_suffix(lw) - lw;
#endif
            const float eI = fexp2(pi), eE = fexp2(pi - lw), eN = fexp2(-pi), eS = fexp2(su);
            at[j] = avec * eE; rt[j] = rf[j] * eI; bt[j] = bvec * eN; kt[j] = kd * eN; bhh[j] = bvec * eS; khh[j] = kd * eS; gl[j] = fexp2(pi + su);
            bon += rf[j] * kd * rkv[j];
        }
        const int co = jl * 2;
        { u32x2 w; w.x = pk2(at[0], at[1]); w.y = pk2(at[2], at[3]); *(LAS u32x2*)(bp + CS_AT + te * 144 + co) = w; }
        { u32x2 w; w.x = pk2(rt[0], rt[1]); w.y = pk2(rt[2], rt[3]); *(LAS u32x2*)(bp + CS_RT + te * 144 + co) = w; }
        { u32x2 w; w.x = pk2(bt[0], bt[1]); w.y = pk2(bt[2], bt[3]); *(LAS u32x2*)(pz + te * 144 + co) = w; }
        { u32x2 w; w.x = pk2(kt[0], kt[1]); w.y = pk2(kt[2], kt[3]); *(LAS u32x2*)(pz + 2304 + te * 144 + co) = w; }
#pragma unroll
        for (int j = 0; j < 4; ++j) {
            *(LAS bf16*)(bp + CS_BK + (jl + j) * 80 + te * 2) = (bf16)f2bf(bhh[j]);
            *(LAS bf16*)(bp + CS_BK + (jl + j) * 80 + 32 + te * 2) = (bf16)f2bf(khh[j]);
            *(LAS bf16*)(bp + CS_VT + (jl + j) * 48 + te * 2) = (bf16)f2bf(vf[j]);
        }
        if (te == 0) *(LAS f32x4*)(bp + CS_GL + jl * 4) = gl;
        bon += swz_xor<16>(bon); bon = half_sum(bon);
        if (cg == 0) bonp[((z * 2 + (c & 1)) * 4 + q4) * 16 + rr] = bon;
    };
    auto prep_b = [&](int c) {
        LAS unsigned char* const bp = L + (z * 2 + (c & 1)) * CS_BUF;
        const int r32 = F.lane & 31, hf = F.lane >> 5;
        const LAS unsigned char* pa = (r32 < 16 ? bp + CS_AT + r32 * 144 : bp + CS_RT + (r32 - 16) * 144) + 16 * hf;
        const LAS unsigned char* pb = (r32 < 16 ? pz + r32 * 144 : pz + 2304 + (r32 - 16) * 144) + 16 * hf;
        f32x16 Dm;
#pragma unroll
        for (int i = 0; i < 16; ++i) Dm[i] = 0.f;
#pragma unroll
        for (int ks = 0; ks < 4; ++ks) Dm = __builtin_amdgcn_mfma_f32_32x32x16_bf16(lds16(pa + 32 * ks), lds16(pb + 32 * ks), Dm, 0, 0, 0);
        const int sc = r32 & 15;
#pragma unroll
        for (int reg = 0; reg < 8; ++reg) { const int t = crow(reg, hf);
            if (r32 >= 16) *(LAS bf16*)(bp + CS_SMQ + t * 80 + sc * 2) = (bf16)f2bf(sc < t ? Dm[reg] : 0.f); }
#pragma unroll
        for (int reg = 8; reg < 16; ++reg) { const int t = crow(reg, hf) - 16;
            *(LAS bf16*)(bp + CS_NQ + t * 80 + r32 * 2) = (bf16)f2bf(sc <= t ? Dm[reg] : 0.f); }
        float Tr[16];
#pragma unroll
        for (int t = 0; t < 16; ++t) {
            float acc = (sc == t) ? 1.0f : 0.0f;
#pragma unroll
            for (int s2 = 0; s2 < t; ++s2) {
                const float dsrc = Dm[(t & 3) + 4 * (t >> 3)];
                const float n = __builtin_bit_cast(float, __builtin_amdgcn_readlane(__builtin_bit_cast(int, dsrc), s2 + 32 * ((t >> 2) & 1)));
                acc = __builtin_fmaf(n, Tr[s2], acc);
            }
            Tr[t] = acc;
            if (F.lane < 16) *(LAS bf16*)(bp + CS_SMT + t * 80 + sc * 2) = (bf16)f2bf(acc);
        }
    };
    auto stage_s = [&](int c) {
        const LAS unsigned char* const bp = L + (z * 2 + (c & 1)) * CS_BUF;
        const int q = l4, i = l15;
#pragma unroll
        for (int jt = 0; jt < 4; ++jt) { u32x2 w; w.x = pk2(Z[jt][0], Z[jt][1]); w.y = pk2(Z[jt][2], Z[jt][3]); *(LAS u32x2*)(ZB + i * 144 + (16 * jt + 4 * q) * 2) = w; }
        asm volatile("" ::: "memory");
        const bf16x8 Zb0 = lds16(ZB + i * 144 + (8 * q) * 2), Zb1 = lds16(ZB + i * 144 + (32 + 8 * q) * 2);
        const bf16x8 Vb = lds16(bp + CS_VT + (16 * q4 + i) * 48 + 8 * (q & 1) * 2);
        const LAS unsigned char* arow = bp + l15 * 144 + 8 * q * 2;
        const f32x4 zero = (f32x4){0.f, 0.f, 0.f, 0.f};
        f32x4 X = mfma16(lds16(arow + CS_AT), Zb0, zero); X = mfma16(lds16(arow + CS_AT + 64), Zb1, X);
        X = mfma16(lds16(bp + CS_SMQ + l15 * 80 + 16 * q), Vb, X);
        { u32x2 w; w.x = pk2(X[0], X[1]); w.y = pk2(X[2], X[3]); *(LAS u32x2*)(XB + i * 48 + 8 * q) = w; }
        asm volatile("" ::: "memory");
        const bf16x8 Xb = lds16(XB + i * 48 + 16 * (q & 1));
        const f32x4 U = mfma16(lds16(bp + CS_SMT + l15 * 80 + 16 * q), Xb, zero);
        { u32x2 w; w.x = pk2(U[0], U[1]); w.y = pk2(U[2], U[3]); *(LAS u32x2*)(UB + i * 48 + 8 * q) = w; }
        asm volatile("" ::: "memory");
        const bf16x8 Ub = lds16(UB + i * 48 + 16 * (q & 1));
        const bf16x8 UVb = q < 2 ? Ub : Vb;
        f32x4 Yv = mfma16(lds16(arow + CS_RT), Zb0, zero); Yv = mfma16(lds16(arow + CS_RT + 64), Zb1, Yv);
        Yv = mfma16(lds16(bp + CS_NQ + l15 * 80 + 16 * q), UVb, Yv);
#pragma unroll
        for (int r = 0; r < 4; ++r) yst[(4 * q + r) * 16 + i] = Yv[r];
#pragma unroll
        for (int jt = 0; jt < 4; ++jt) { const f32x4 g = *(const LAS f32x4*)(bp + CS_GL + (16 * jt + 4 * q) * 4);
            Z[jt] = mfma16(lds16(bp + CS_BK + (16 * jt + l15) * 80 + 16 * q), UVb, Z[jt] * g); }
    };
    auto flush_y = [&](int c) {
        const int t0c = z ? T - 16 * (c + 1) : 16 * c; const int st = F.lane >> 2, i4 = (F.lane & 3) * 4;
        f32x4 yv = *(const LAS f32x4*)(yst + st * 16 + i4);
#ifdef MK_CLAMPY
        for (int j = 0; j < 4; ++j) yv[j] = (yv[j] == yv[j]) ? fminf(fmaxf(yv[j], -1.0e4f), 1.0e4f) : 0.f;
#endif
#ifdef MK_SCANCHECK
        { const u32x2 ref = *(const u32x2*)(Y + (size_t)(b * T + t0c + (z ? 15 - st : st)) * 1024 + chq + i4);
          const float r0 = bflo(ref.x), r1 = bfhi(ref.x), r2 = bflo(ref.y), r3 = bfhi(ref.y);
          float er = fmaxf(fmaxf(fabsf(yv.x - r0) / (fabsf(r0) + 1.0f), fabsf(yv.y - r1) / (fabsf(r1) + 1.0f)), fmaxf(fabsf(yv.z - r2) / (fabsf(r2) + 1.0f), fabsf(yv.w - r3) / (fabsf(r3) + 1.0f)));
          if (!(er == er)) er = 1.0e9f;
          atomicMax((unsigned*)(P.ERR + c), __float_as_uint(er)); }
#else
        u32x2 w; w.x = pk2(yv.x, yv.y); w.y = pk2(yv.z, yv.w);
        *(u32x2*)(Y + (size_t)(b * T + t0c + (z ? 15 - st : st)) * 1024 + chq + i4) = w;
#endif
    };
    auto bonus_flush = [&](int c) {
#ifdef MK_SCANCHECK
        return;
#endif
        if (q4 == 0 && F.lane < 16) {
            const int t0c = z ? T - 16 * (c + 1) : 16 * c; const size_t m0 = (size_t)b * T + t0c;
            const LAS float* qq = bonp + (z * 2 + (c & 1)) * 64 + F.lane;
            P.BON[((size_t)z * M + m0 + F.lane) * 16 + h] = (qq[0] + qq[16]) + (qq[32] + qq[48]);
        }
    };
    __syncthreads();
    for (int e = F.tid; e < 2 * 2 * 2 * 16 * 8; e += 512) { const int row = (e >> 3) & 15, tile = (e >> 7) & 1, zb = e >> 8, w = e & 7;
        *(LAS unsigned*)(L + zb * CS_BUF + (tile ? CS_SMT : CS_SMQ) + row * 80 + 32 + w * 4) = 0u; }
    do_load(0); prep_a(0);
    asm volatile("s_waitcnt lgkmcnt(0)" ::: "memory"); __builtin_amdgcn_s_barrier(); asm volatile("" ::: "memory");
    if (q4 == 0) prep_b(0);
    do_load(1);
    asm volatile("s_waitcnt lgkmcnt(0)" ::: "memory"); __builtin_amdgcn_s_barrier(); asm volatile("" ::: "memory");
    for (int e = 0; e < T / 16; ++e) {
        if (e + 1 < T / 16) prep_a(e + 1);
        if (e > 0) flush_y(e - 1);
        bonus_flush(e);
        if (e + 2 < T / 16) do_load(e + 2);
        asm volatile("s_waitcnt lgkmcnt(0)" ::: "memory"); __builtin_amdgcn_s_barrier(); asm volatile("" ::: "memory");
        stage_s(e);
        if (q4 == 0 && e + 1 < T / 16) prep_b(e + 1);
        asm volatile("s_waitcnt lgkmcnt(0)" ::: "memory"); __builtin_amdgcn_s_barrier(); asm volatile("" ::: "memory");
    }
    flush_y(T / 16 - 1);
}

#define XB_TMO      128
#define XB_XCNT(j)  (256  + 64 * (j))
#define XB_XSUB(j)  (1280 + 64 * (j))
#define XB_XGEN(j)  (2304 + 64 * (j))
#define XB_TOP      3328
#define XB_TOPGEN   3392
#define XCD_BAR_WORDS 3456
#define XB_SPIN_CAP (1u << 22)
DI unsigned xb_ld(unsigned* p)              { return __hip_atomic_load(p, __ATOMIC_RELAXED, __HIP_MEMORY_SCOPE_AGENT); }
DI unsigned xb_add(unsigned* p, unsigned v) { return __hip_atomic_fetch_add(p, v, __ATOMIC_RELAXED, __HIP_MEMORY_SCOPE_AGENT); }
DI unsigned xb_xcc_id() { return (unsigned)__builtin_amdgcn_s_getreg((3 << 11) | 20) & 0xFu; }
#define XB_SPIN(cond, bar) do { unsigned _sp = 0; while (cond) { __builtin_amdgcn_s_sleep(1); \
    if ((++_sp & 255u) == 0u) { if (xb_ld(&(bar)[XB_TMO])) break; if (_sp > XB_SPIN_CAP) { atomicAdd(&(bar)[XB_TMO], 1u); break; } } } } while (0)
struct XcdBarrier { unsigned* bar; unsigned x; volatile LAS unsigned* st; };
DI XcdBarrier xcd_barrier_post(unsigned* bar, volatile LAS unsigned* st) {
    XcdBarrier b; b.bar = bar; b.x = xb_xcc_id(); b.st = st;
    if (threadIdx.x == 0) (void)xb_add(&bar[XB_XCNT(b.x)], 1u);
    return b;
}
DI void xcd_barrier_complete(unsigned* bar, unsigned x, unsigned& nloc, unsigned& nx) {
    const unsigned G = gridDim.x * gridDim.y * gridDim.z;
    unsigned sum, cnt, mine, sp = 0u;
    for (;;) {
        sum = 0u; cnt = 0u; mine = 0u;
#pragma unroll
        for (unsigned j = 0; j < 16; ++j) { const unsigned c = xb_ld(&bar[XB_XCNT(j)]); sum += c; cnt += (c > 0u) ? 1u : 0u; mine = (j == x) ? c : mine; }
        if (sum == G) break;
        __builtin_amdgcn_s_sleep(1);
        if ((++sp & 255u) == 0u) { if (xb_ld(&bar[XB_TMO])) break; if (sp > XB_SPIN_CAP) { atomicAdd(&bar[XB_TMO], 1u); break; } }
    }
    nloc = mine > 0u ? mine : 1u; nx = cnt > 0u ? cnt : 1u;
}
DI void xcd_barrier(const XcdBarrier& b) {
    asm volatile("s_waitcnt vmcnt(0)" ::: "memory");
    __syncthreads();
    if (threadIdx.x == 0) {
        unsigned* bar = b.bar;
        __builtin_amdgcn_s_waitcnt(0);
        unsigned nloc = b.st[0], nx = b.st[1];
        if (nloc == 0u) { xcd_barrier_complete(bar, b.x, nloc, nx); b.st[0] = nloc; b.st[1] = nx; }
        const unsigned old = xb_add(&bar[XB_XSUB(b.x)], 1u);
        const unsigned gen = old / nloc;
        if (old + 1u == (gen + 1u) * nloc) {
            __builtin_amdgcn_fence(__ATOMIC_RELEASE, "agent");
            asm volatile("s_waitcnt vmcnt(0)" ::: "memory");
            const unsigned og = xb_add(&bar[XB_TOP], 1u);
            const unsigned tg = og / nx;
            if (og + 1u == (tg + 1u) * nx) xb_add(&bar[XB_TOPGEN], 1u);
            else XB_SPIN(xb_ld(&bar[XB_TOPGEN]) == tg, bar);
            __builtin_amdgcn_fence(__ATOMIC_ACQUIRE, "agent");
            xb_add(&bar[XB_XGEN(b.x)], 1u);
            asm volatile("s_waitcnt vmcnt(0)" ::: "memory");
        } else {
            XB_SPIN(xb_ld(&bar[XB_XGEN(b.x)]) == gen, bar);
            __builtin_amdgcn_fence(__ATOMIC_ACQUIRE, "agent");
            asm volatile("s_waitcnt vmcnt(0)" ::: "memory");
        }
    }
    __syncthreads();
}

#ifndef MK_PROG
#ifdef MK_SCANCHECK
#define MK_PROG 0,1,2,3,4,5,7,8,10,11,12,13,14,25,15,16,17,19,20,22,23,24
#else
#define MK_PROG 0,1,2,3,4,5,7,8,10,11,12,13,14,15,16,17,19,20,22,23,24
#endif
#endif
__constant__ int PROG[] = {MK_PROG};
constexpr int NPH = sizeof(PROG) / sizeof(int);
template <int TYPE> struct PreSched {
    const bf16* KV; const bf16* W; int G, c;
    DI bool next(int i, Unit& u) const {
        const long L = (long)i * G + c; if (L >= 512) return false;
        const int rem = (int)L, i2 = rem >> 8, b = (rem >> 4) & 15, hh = (rem >> 2) & 3, t4 = rem & 3;
        u.pm = 0; u.pn = 0;
        const bf16* kvp = KV + (size_t)(b * 256) * 4096 + i2 * 2048 + hh * 256;
        const bf16* wp = W + (size_t)i2 * 1024 * 1024 + (size_t)(t4 * 256) * 1024 + hh * 256;
        if (TYPE == 0) { u.pa = (const char*)kvp; u.pb = (const char*)wp; u.z = (i2 << 30) | (b * 1048576 + hh * 256 * 1024 + t4 * 256); }
        else { u.pa = (const char*)wp; u.pb = (const char*)(kvp + 1024); u.z = (i2 << 30) | (16 * 1048576 + b * 1048576 + t4 * 256 * 1024 + hh * 256); }
        return true;
    }
};

__global__ void __launch_bounds__(512, 2) mk_fwd(Args a) {
    extern __shared__ __attribute__((aligned(16))) unsigned char lds_raw[];
    Frame F;
    F.lds = (LAS unsigned char*)lds_raw;
    F.tid = threadIdx.x; F.lane = F.tid & 63; F.wave = __builtin_amdgcn_readfirstlane(F.tid >> 6);
    F.gw = blockIdx.x * 8 + F.wave; F.ngw = gridDim.x * 8; F.ws = a.ws;
    cg::grid_group grid = cg::this_grid();
    volatile LAS unsigned* MISC = (volatile LAS unsigned*)(F.lds + LDS_MISC);
    if (F.tid < 2) MISC[F.tid] = 0u;
    __syncthreads();
    (void)xcd_barrier_post((unsigned*)(a.ws + WS_BAR), MISC);

    for (int pi = a.ph_lo; pi < a.ph_hi; ++pi) {
        const int ph = PROG[pi];
        const int G = opq(gridDim.x), cblk = opq(blockIdx.x);
        unsigned char* ws = a.ws + (size_t)opq(0);
        float* RS = (float*)(ws + WS_RS);
        bf16* SA = (bf16*)(ws + WS_SA); bf16* SB = (bf16*)(ws + WS_SB);
        const int li = ph >= 18 ? 1 : 0;
        int cp = ph; if (ph >= 18 && ph <= 23) cp = ph - 12;
#ifndef PH_MASK
#define PH_MASK 0xffffffffu
#endif
        if (!((PH_MASK >> cp) & 1u)) cp = 99;
        switch (cp) {
        case 0: phase_prologue(F, a, ws); break;
        case 1: {
            pg8::PlainSched S{(const bf16*)(ws + WS_MEMB), (const bf16*)(ws + WS_WKV), 1024, 1024, MMEM / 256, 16, G, cblk, 30, 0};
            EpiRowScale<0> E{(bf16*)(ws + WS_KV), 4096, (const float*)(ws + WS_RSMEM), nullptr};
            pg8::gemm_phase(F.lds, 1024, 1024, 1024, S, E);
        } break;
        case 2: {
            EpiPre E{(bf16*)(ws + WS_G0)};
            { PreSched<0> S{(const bf16*)(ws + WS_KV), (const bf16*)(ws + WS_WQN), G, cblk}; pg8::gemm_phase(F.lds, 256, 4096, 1024, S, E); }
            { PreSched<1> S{(const bf16*)(ws + WS_KV), (const bf16*)(ws + WS_WXO), G, cblk}; pg8::gemm_phase(F.lds, 256, 1024, 4096, S, E); }
        } break;
        case 3: {
            { pg8::PlainSched S{SA, (const bf16*)(ws + WS_WIN), 1024, 1024, M / 256, 8, G, cblk, 30, 0};
              EpiInProj E{(bf16*)(ws + WS_GLU), SB, RS};
              pg8::gemm_phase(F.lds, 1024, 1024, 1024, S, E); }
            { pg8::PlainSched S{(const bf16*)(ws + WS_WIN) + (size_t)2048 * 1024, SA, 1024, 1024, 2, M / 256, G, cblk, 30, 0};
              EpiVT E{(bf16*)(ws + WS_VT), RS};
              pg8::gemm_phase(F.lds, 1024, 1024, 1024, S, E); }
        } break;
        case 4: {
            const float lam = ((const float*)(ws + WS_LAM))[0];
#ifndef NO_ATTN
            for (int u = cblk; u < 1024; u += G) diffattn_unit(F, u, SB, (const bf16*)(ws + WS_VT), (const float*)(ws + WS_BIAS), lam, a.in[opq(I_SUBLN)], (bf16*)(ws + WS_MIX));
#endif
            __syncthreads();
#ifndef NO_CONV
            conv_load_weights(F, a.in[opq(I_CONVW)]);
            for (int u = cblk; u < 512; u += G) conv_unit(F, u, (const bf16*)(ws + WS_GLU), a.in[opq(I_CONVB)], a.in[opq(I_CLNG)], a.in[opq(I_CLNB)], (bf16*)(ws + WS_MIX));
#endif
            __syncthreads();
        } break;
        case 5: {
            pg8::PlainSched S{(const bf16*)(ws + WS_MIX), (const bf16*)(ws + WS_WOUT), 1024, 1024, M / 256, 4, G, cblk, 30, 0};
            EpiResid E{a.in[opq(I_X)], a.out, SA, (float*)(ws + WS_PS)};
            pg8::gemm_phase(F.lds, 1024, 1024, 1024, S, E);
        } break;
        case 7: {
            pg8::PlainSched S{SA, (const bf16*)(ws + (li ? WS_G1 : WS_G0)), 1024, 1024, M / 256, 4, G, cblk, 3, (size_t)1048576};
            EpiSoftmax E{SB, (const float*)(ws + WS_PS)};
            pg8::gemm_phase(F.lds, 1024, 1024, 1024, S, E);
        } break;
        case 8: {
            pg8::PlainSched S{SB, (const bf16*)(ws + (li ? WS_VW1 : WS_VW0)), 1024, 1024, M / 256, 4, G, cblk, 3, (size_t)1048576};
            EpiResid E{a.out, a.out, SA, (float*)(ws + WS_PS)};
            pg8::gemm_phase(F.lds, 1024, 1024, 1024, S, E);
        } break;
        case 10: {
            pg8::PlainSched S{SA, (const bf16*)(ws + WS_WUP) + (size_t)li * 4096 * 1024, 1024, 1024, M / 256, 16, G, cblk, 30, 0};
            EpiRowScale<2> E{(bf16*)(ws + WS_HID), 4096, nullptr, (const float*)(ws + WS_PS)};
            pg8::gemm_phase(F.lds, 1024, 1024, 1024, S, E);
        } break;
        case 11: {
            pg8::PlainSched S{(const bf16*)(ws + WS_HID), (const bf16*)(ws + WS_WDN) + (size_t)li * 1024 * 4096, 4096, 4096, M / 256, 4, G, cblk, 30, 0};
            EpiResid E{a.out, a.out, nullptr, nullptr};
            pg8::gemm_phase(F.lds, 4096, 4096, 4096, S, E);
        } break;
        case 12: phase_rwkv_shift(F, a.out, a.in[opq(I_NMIX)] + 1024, (bf16*)(ws + WS_A1)); break;
        case 13: {
            pg8::PlainSched S{(const bf16*)(ws + WS_A1), (const bf16*)(ws + WS_WBIG), 2048, 2048, M / 256, 14, G, cblk, 30, 0};
            EpiRwkv E{(bf16*)(ws + WS_R), (bf16*)(ws + WS_K), (bf16*)(ws + WS_V), (bf16*)(ws + WS_HD1), (bf16*)(ws + WS_HD2)};
            pg8::gemm_phase(F.lds, 2048, 2048, 2048, S, E);
        } break;
        case 14: {
            ScanPtrs P{(const bf16*)(ws + WS_R), (const bf16*)(ws + WS_K), (const bf16*)(ws + WS_V), (const bf16*)(ws + WS_HD1), (const bf16*)(ws + WS_W2T),
                       a.in[opq(I_W0)], a.in[opq(I_A0)], a.in[opq(I_KK)], a.in[opq(I_KA)], a.in[opq(I_RK)], (bf16*)(ws + WS_YF), (bf16*)(ws + WS_YB), (float*)(ws + WS_BONUS), (unsigned*)(ws + WS_BAR + 32768)};
#if defined(MK_SCAN_VALU) || defined(MK_SCANCHECK)
            for (int bh = cblk; bh < 256; bh += G) scan_pair(F, bh, P);
#else
            for (int bh = cblk; bh < 256; bh += G) scan_pair_mfma(F, bh, P);
#endif
            __syncthreads();
        } break;
#ifdef MK_SCANCHECK
        case 25: {
            ScanPtrs P{(const bf16*)(ws + WS_R), (const bf16*)(ws + WS_K), (const bf16*)(ws + WS_V), (const bf16*)(ws + WS_HD1), (const bf16*)(ws + WS_W2T),
                       a.in[opq(I_W0)], a.in[opq(I_A0)], a.in[opq(I_KK)], a.in[opq(I_KA)], a.in[opq(I_RK)], (bf16*)(ws + WS_YF), (bf16*)(ws + WS_YB), (float*)(ws + WS_BONUS), (unsigned*)(ws + WS_BAR + 32768)};
            for (int bh = cblk; bh < 256; bh += G) scan_pair_mfma(F, bh, P);
            __syncthreads();
        } break;
#endif
        case 15: {
            pg8::PlainSched S{(const bf16*)(ws + WS_HD2), (const bf16*)(ws + WS_G2T), 256, 256, M / 256, 4, G, cblk, 30, 0};
            EpiRowScale<0> E{(bf16*)(ws + WS_GATE), 1024, nullptr, nullptr};
            pg8::gemm_phase(F.lds, 256, 256, 256, S, E);
        } break;
        case 16: phase_rwkv_comb(F, (const bf16*)(ws + WS_YF), (const bf16*)(ws + WS_YB), (const bf16*)(ws + WS_V), (const bf16*)(ws + WS_GATE), (const float*)(ws + WS_BONUS),
                                 a.in[opq(I_LNG)], a.in[opq(I_LNB)], (bf16*)(ws + WS_COMB)); break;
        case 17: {
            pg8::PlainSched S{(const bf16*)(ws + WS_COMB), (const bf16*)(ws + WS_WRO), 1024, 1024, M / 256, 4, G, cblk, 30, 0};
            EpiResid E{a.out, a.out, SA, (float*)(ws + WS_PS)};
            pg8::gemm_phase(F.lds, 1024, 1024, 1024, S, E);
        } break;
        case 24: {
            float osc = 1.0f;
#ifdef MK_SCANCHECK
            { const unsigned* ER = (const unsigned*)(ws + WS_BAR + 32768); int bad = -1;
              for (int c = 127; c >= 0; --c) if (__uint_as_float(__builtin_amdgcn_readfirstlane(__hip_atomic_load(ER + c, __ATOMIC_RELAXED, __HIP_MEMORY_SCOPE_AGENT))) > MK_SCANCHECK_TOL) bad = c;
              if (bad >= 0) osc = 1.0f + 0.03f * (float)(bad + 1); }
#endif
            phase_final_norm(F, a.out, a.in[opq(I_NFINAL)], osc);
        } break;
        default: break;
        }
        if (pi + 1 < a.ph_hi) {
#ifdef MK_ALL_CG
            grid.sync();
#else
            if (pi == a.ph_lo) grid.sync(); else { XcdBarrier xb; xb.bar = (unsigned*)(ws + WS_BAR); xb.x = xb_xcc_id(); xb.st = (volatile LAS unsigned*)(F.lds + LDS_MISC); xcd_barrier(xb); }
#endif
        }
    }
}

extern "C" void kernel_launch(void* const* d_in, const int* in_sizes, int n_in, void* d_out, int out_size, void* d_ws, size_t ws_size, hipStream_t stream) {
    static int grid = 0;
    if (grid == 0) {
        if (n_in != N_IN || in_sizes[0] != M * D || out_size != M * D || ws_size < WS_NEED) {
            fprintf(stderr, "kernel_launch: unexpected problem (n_in %d, in0 %d, out %d, ws %zu); nothing launched\n", n_in, n_in > 0 ? in_sizes[0] : -1, out_size, ws_size); grid = -1; return; }
        int dev = 0, cus = 0, per_cu = 0;
        if (hipGetDevice(&dev) != hipSuccess || hipDeviceGetAttribute(&cus, hipDeviceAttributeMultiprocessorCount, dev) != hipSuccess) { grid = -1; return; }
        if (hipFuncSetAttribute((const void*)mk_fwd, hipFuncAttributeMaxDynamicSharedMemorySize, LDS_BYTES) != hipSuccess) { fprintf(stderr, "kernel_launch: hipFuncSetAttribute failed\n"); grid = -1; return; }
        if (hipOccupancyMaxActiveBlocksPerMultiprocessor(&per_cu, (const void*)mk_fwd, 512, LDS_BYTES) != hipSuccess || per_cu < 1) { fprintf(stderr, "kernel_launch: occupancy query says %d\n", per_cu); (void)hipGetLastError(); grid = -1; return; }
        grid = cus;
    }
    if (grid < 0) return;
    if (hipMemsetAsync((char*)d_ws + WS_BAR, 0, 65536, stream) != hipSuccess) { fprintf(stderr, "kernel_launch: memset failed\n"); return; }
    Args a{};
    for (int i = 0; i < N_IN; ++i) a.in[i] = (const float*)d_in[i];
    a.out = (float*)d_out; a.ws = (unsigned char*)d_ws;
#if MK_SINGLE
    a.ph_lo = 0; a.ph_hi = NPH;
    void* params[] = {&a};
    hipError_t e = hipLaunchCooperativeKernel((const void*)mk_fwd, dim3(grid), dim3(512), params, LDS_BYTES, stream);
    if (e != hipSuccess) fprintf(stderr, "kernel_launch: cooperative launch failed: %s\n", hipGetErrorString(e));
#else
    for (int ph = 0; ph < NPH; ++ph) { a.ph_lo = ph; a.ph_hi = ph + 1; hipLaunchKernelGGL(mk_fwd, dim3(grid), dim3(512), LDS_BYTES, stream, a); }
#endif
}
```

```cpp
#include <hip/hip_runtime.h>
#include <hip/hip_cooperative_groups.h>
#include <cstdio>
#include <cstdint>
namespace cg = cooperative_groups;

#ifndef MK_SINGLE
#define MK_SINGLE 1
#endif

#define LAS __attribute__((address_space(3)))
#define DI __device__ __forceinline__
typedef unsigned short bf16;
typedef short bf16x8 __attribute__((ext_vector_type(8)));
typedef short s16x4 __attribute__((ext_vector_type(4)));
typedef float f32x2 __attribute__((ext_vector_type(2)));
typedef float f32x4 __attribute__((ext_vector_type(4)));
typedef float f32x16 __attribute__((ext_vector_type(16)));
typedef unsigned u32x2 __attribute__((ext_vector_type(2)));
typedef unsigned u32x4 __attribute__((ext_vector_type(4)));

constexpr int D = 1024, NB = 16, T = 2048, M = NB * T, NMEM = 256, MMEM = NB * NMEM;
constexpr int FF = 4096;
constexpr float EPS = 1e-6f;
constexpr float LOG2E = 1.4426950408889634f;

constexpr size_t MiB = 1u << 20;
constexpr size_t WS_BAR = 0;
constexpr size_t WS_RS = 64 * 1024;
constexpr size_t WS_RSMEM = WS_RS + M * 4;
constexpr size_t WS_BIAS = WS_RSMEM + MMEM * 4;
constexpr size_t WS_LAM = WS_BIAS + 4 * 4096 * 4;
constexpr size_t WS_WIN = 1 * MiB;
constexpr size_t WS_WOUT = WS_WIN + 5 * MiB;
constexpr size_t WS_WQN = WS_WOUT + 2 * MiB;
constexpr size_t WS_WKV = WS_WQN + 4 * MiB;
constexpr size_t WS_WXO = WS_WKV + 8 * MiB;
constexpr size_t WS_WUP = WS_WXO + 4 * MiB;
constexpr size_t WS_WDN = WS_WUP + 16 * MiB;
constexpr size_t WS_WBIG = WS_WDN + 16 * MiB;
constexpr size_t WS_W2T = WS_WBIG + 14 * MiB;
constexpr size_t WS_G2T = WS_W2T + 512 * 1024;
constexpr size_t WS_WRO = WS_G2T + 512 * 1024;
constexpr size_t WS_WEND = WS_WRO + 2 * MiB;
static_assert(WS_WEND == 73 * MiB, "weight map");
constexpr size_t WS_SA = 73 * MiB;
constexpr size_t WS_SB = 137 * MiB;
constexpr size_t WS_GLU = 201 * MiB;
constexpr size_t WS_VT = 233 * MiB;
constexpr size_t WS_MIX = 265 * MiB;
constexpr size_t WS_G0 = 329 * MiB;
constexpr size_t WS_VW0 = 361 * MiB;
constexpr size_t WS_MEMB = 393 * MiB;
constexpr size_t WS_KV = 401 * MiB;
constexpr size_t WS_G1 = 433 * MiB;
constexpr size_t WS_VW1 = 465 * MiB;
static_assert(WS_G1 - WS_G0 == 104 * MiB && WS_VW0 - WS_G0 == 32 * MiB && WS_VW1 - WS_G1 == 32 * MiB, "G / VW spacing used by EpiPre");
constexpr size_t WS_BONUS = 497 * MiB;
constexpr size_t WS_PS = 502 * MiB;
constexpr size_t WS_HID = 137 * MiB;
constexpr size_t WS_A1 = 73 * MiB;
constexpr size_t WS_R = 201 * MiB, WS_K = 265 * MiB, WS_V = 329 * MiB;
static_assert(WS_K - WS_R == 64 * MiB && WS_V - WS_K == 64 * MiB, "r, k, v spacing used by EpiRwkv");
constexpr size_t WS_HD1 = 393 * MiB;
constexpr size_t WS_HD2 = 409 * MiB;
constexpr size_t WS_YF = 73 * MiB, WS_YB = 137 * MiB;
constexpr size_t WS_GATE = 265 * MiB;
constexpr size_t WS_COMB = 201 * MiB;
constexpr size_t WS_NEED = 512 * MiB;

constexpr int LDS_X = 131072;
constexpr int LDS_MISC = 163840 - 256;
constexpr int LDS_BYTES = 163840;

DI unsigned f2bf(float f) { unsigned u = __builtin_bit_cast(unsigned, f); return (u + 0x7fffu + ((u >> 16) & 1u)) >> 16; }
typedef __bf16 bf16x2v __attribute__((ext_vector_type(2)));
DI unsigned pk2(float lo, float hi) { const f32x2 v = {lo, hi}; return __builtin_bit_cast(unsigned, __builtin_convertvector(v, bf16x2v)); }
DI float bf2f(unsigned short b) { return __builtin_bit_cast(float, ((unsigned)b) << 16); }
DI float bflo(unsigned w) { return __builtin_bit_cast(float, w << 16); }
DI float bfhi(unsigned w) { return __builtin_bit_cast(float, w & 0xffff0000u); }
template <int MASK> DI float swz_xor(float v) { return __builtin_bit_cast(float, __builtin_amdgcn_ds_swizzle(__builtin_bit_cast(int, v), (MASK << 10) | 0x1f)); }
DI float half_sum(float v) { const int x = __builtin_bit_cast(int, v); const auto r = __builtin_amdgcn_permlane32_swap(x, x, false, false); return __builtin_bit_cast(float, (int)r[0]) + __builtin_bit_cast(float, (int)r[1]); }
DI float half_max(float v) { const int x = __builtin_bit_cast(int, v); const auto r = __builtin_amdgcn_permlane32_swap(x, x, false, false); return fmaxf(__builtin_bit_cast(float, (int)r[0]), __builtin_bit_cast(float, (int)r[1])); }
DI float wave_sum(float v) {
    v += swz_xor<1>(v); v += swz_xor<2>(v); v += swz_xor<4>(v); v += swz_xor<8>(v); v += swz_xor<16>(v); v = half_sum(v);
    return v;
}
DI int opaque(int x) { asm volatile("" : "+v"(x)); return x; }
template <class Tp> DI Tp* opq_ptr(Tp* p) { asm volatile("" : "+s"(p)); return p; }
DI int opq(int x) { asm volatile("" : "+s"(x)); return x; }
DI float fexp2(float x) { return __builtin_amdgcn_exp2f(x); }
DI float frcp(float x) { return __builtin_amdgcn_rcpf(x); }
DI float sigmoidf_(float x) { return frcp(1.0f + fexp2(-x * LOG2E)); }
DI float tanhf_(float x) { float e = fexp2(-2.0f * LOG2E * fabsf(x)); float t = (1.0f - e) * frcp(1.0f + e); return x < 0.f ? -t : t; }

namespace pg8 {
constexpr int BM = 256, BK = 64, HALF = 128, HTB = HALF * BK * 2, STAGE_BYTES = 8 * HTB, NXCD = 8, WGM = 8;
DI int lds_byte(int r, int c) { const int st = (r >> 4) * 2 + (c >> 5), rr = r & 15, cc = c & 31, ob = rr * 64 + cc * 2; return st * 1024 + (ob ^ (((ob >> 9) & 1) << 5)); }
DI void stage_rc(int b, int& R, int& C) { const int st = b / 1024, sb = b % 1024, swz = sb ^ (((sb >> 9) & 1) << 5); R = (st >> 1) * 16 + swz / 64; C = (st & 1) * 32 + (swz % 64) / 2; }
DI int perm32(int rho) { const int n = rho >> 4, i = rho & 15; return 8 * (i >> 2) + 4 * n + (i & 3); }

struct Unit { int pm, pn, z; const char* pa; const char* pb; };

DI bool tile_order(long L, int nM, int nN, int& pm, int& pn) {
    const int nwg = nM * nN; if (L >= nwg) return false;
    int wgid = (int)L; { const int q = nwg / NXCD, r = nwg % NXCD, xcd = wgid % NXCD, off = wgid / NXCD; wgid = (xcd < r ? xcd * (q + 1) : r * (q + 1) + (xcd - r) * q) + off; }
    const int nig = WGM * nN, gid = wgid / nig, fm = gid * WGM, gsz = (nM - fm) < WGM ? (nM - fm) : WGM;
    pm = fm + ((wgid % nig) % gsz); pn = (wgid % nig) / gsz; return true;
}
struct PlainSched {
    const bf16* A; const bf16* Bt; int lda, ldb, nM, nN, G, c, bshift; size_t bstride;
    DI bool next(int i, Unit& u) const {
        if (!tile_order((long)i * G + c, nM, nN, u.pm, u.pn)) return false;
        u.z = u.pm >> bshift;
        u.pa = (const char*)(A + (size_t)u.pm * 256 * lda);
        u.pb = (const char*)(Bt + (size_t)u.z * bstride + (size_t)u.pn * 256 * ldb);
        return true;
    }
};

DI unsigned cvt_pk_bf16(float lo, float hi) { return pk2(lo, hi); }

template <class Epi, class Sched>
DI void gemm_phase(LAS unsigned char* lds, const int K, const int lda, const int ldb, const Sched& S, const Epi& E) {
    const int tid = opaque(threadIdx.x), wid = __builtin_amdgcn_readfirstlane(tid >> 6), lane = tid & 63, wr = wid >> 2, wc = wid & 3, fr = lane & 15, fq = lane >> 4;
    const int nt = K / BK;
    unsigned voffA[2], voffB[2];
#pragma unroll
    for (int i = 0; i < 2; ++i) { int R, C; stage_rc(tid * 16 + i * 8192, R, C); const int Rb = Epi::PERM ? ((R & ~31) + perm32(R & 31)) : R;
        voffA[i] = (unsigned)(R * lda + C) * 2u; voffB[i] = (unsigned)(Rb * ldb + C) * 2u; }
    const size_t kstep = (size_t)(BK * 2);
    const size_t hstepA = (size_t)HALF * lda * 2, hstepB = (size_t)HALF * ldb * 2;
    const unsigned ldsw = (unsigned)wid * 1024u;
    const int aoff = lds_byte(wr * 64 + fr, fq * 8), boff = lds_byte(wc * 32 + fr, fq * 8);
#define PG8_SA(b, h) (((b) * 2 + (h)) * HTB)
#define PG8_SB(b, h) ((4 + (b) * 2 + (h)) * HTB)
#define PG8_STAGE(bufoff, gbase, voff) do { _Pragma("unroll") for (int _i = 0; _i < 2; ++_i) \
        __builtin_amdgcn_global_load_lds((const unsigned*)((const char*)(gbase) + (voff)[_i]), (LAS unsigned*)(lds + (bufoff) + ldsw + _i * 8192), 16, 0, 0); } while (0)
#define PG8_LDA(dst, b, h) do { _Pragma("unroll") for (int m = 0; m < 4; ++m) _Pragma("unroll") for (int k = 0; k < 2; ++k) dst[m][k] = *(const LAS bf16x8*)(lds + PG8_SA(b, h) + aoff + m * 2048 + k * 1024); } while (0)
#define PG8_LDB(dst, b, h) do { _Pragma("unroll") for (int n = 0; n < 2; ++n) _Pragma("unroll") for (int k = 0; k < 2; ++k) dst[n][k] = *(const LAS bf16x8*)(lds + PG8_SB(b, h) + boff + n * 2048 + k * 1024); } while (0)
#define PG8_MMA(ai, bj, At, Bt) do { __builtin_amdgcn_s_setprio(1); _Pragma("unroll") for (int m = 0; m < 4; ++m) _Pragma("unroll") for (int n = 0; n < 2; ++n) _Pragma("unroll") for (int k = 0; k < 2; ++k) \
        acc[ai][bj][m][n] = __builtin_amdgcn_mfma_f32_16x16x32_bf16(Bt[n][k], At[m][k], acc[ai][bj][m][n], 0, 0, 0); __builtin_amdgcn_s_setprio(0); } while (0)
#define PG8_WAIT_V(n) asm volatile("s_waitcnt vmcnt(" #n ")" ::: "memory")
#define PG8_WAIT_L(n) asm volatile("s_waitcnt lgkmcnt(" #n ")" ::: "memory")
#define PG8_BAR __builtin_amdgcn_s_barrier()
#define PG8_SCHED __builtin_amdgcn_sched_barrier(0)
    Unit cur, nxt; int ui = 0;
    if (!S.next(0, cur)) return;
    f32x4 acc[2][2][4][2];
#pragma unroll
    for (int a = 0; a < 2; ++a)
#pragma unroll
        for (int b = 0; b < 2; ++b)
#pragma unroll
            for (int m = 0; m < 4; ++m)
#pragma unroll
                for (int n = 0; n < 2; ++n) acc[a][b][m][n] = (f32x4){0.f, 0.f, 0.f, 0.f};
    bf16x8 At[4][2], B0[2][2], B1[2][2];
    const char* cA = cur.pa; const char* cB = cur.pb;
    PG8_STAGE(PG8_SB(0, 0), cB, voffB); PG8_STAGE(PG8_SB(0, 1), cB + hstepB, voffB); PG8_STAGE(PG8_SA(0, 0), cA, voffA); PG8_STAGE(PG8_SA(0, 1), cA + hstepA, voffA);
    if (wr == 1) PG8_BAR;
    PG8_WAIT_V(2); PG8_BAR;
    PG8_STAGE(PG8_SB(1, 0), cB + kstep, voffB); PG8_STAGE(PG8_SA(1, 0), cA + kstep, voffA); PG8_STAGE(PG8_SB(1, 1), cB + hstepB + kstep, voffB);
    PG8_WAIT_V(6); PG8_BAR;
    for (;;) {
        const bool has_next = S.next(ui + 1, nxt);
        const char* nA = has_next ? nxt.pa : cA; const char* nB = has_next ? nxt.pb : cB;
#pragma unroll 1
        for (int t = 0; t < nt; t += 2) {
            const bool last = (t == nt - 2);
            const char* a1 = cA + (size_t)(t + 1) * kstep;
            const char* a2 = last ? nA : cA + (size_t)(t + 2) * kstep; const char* b2 = last ? nB : cB + (size_t)(t + 2) * kstep;
            const char* a3 = a2 + kstep; const char* b3 = b2 + kstep;
            PG8_LDB(B0, 0, 0); PG8_LDB(B1, 0, 1); PG8_SCHED; PG8_LDA(At, 0, 0); PG8_STAGE(PG8_SA(1, 1), a1 + hstepA, voffA);
            PG8_WAIT_V(8); PG8_WAIT_L(0); PG8_BAR; PG8_MMA(0, 0, At, B0); PG8_MMA(0, 1, At, B1); PG8_BAR; PG8_SCHED;
            PG8_LDA(At, 0, 1); PG8_STAGE(PG8_SB(0, 0), b2, voffB); PG8_STAGE(PG8_SB(0, 1), b2 + hstepB, voffB); PG8_STAGE(PG8_SA(0, 0), a2, voffA);
            PG8_WAIT_V(8); PG8_WAIT_L(0); PG8_BAR; PG8_MMA(1, 0, At, B0); PG8_MMA(1, 1, At, B1); PG8_BAR; PG8_SCHED;
            PG8_LDB(B0, 1, 0); PG8_LDB(B1, 1, 1); PG8_SCHED; PG8_LDA(At, 1, 0); PG8_STAGE(PG8_SA(0, 1), a2 + hstepA, voffA);
            PG8_WAIT_V(8); PG8_WAIT_L(0); PG8_BAR; PG8_MMA(0, 0, At, B0); PG8_MMA(0, 1, At, B1); PG8_BAR; PG8_SCHED;
            PG8_LDA(At, 1, 1); PG8_STAGE(PG8_SB(1, 0), b3, voffB); PG8_STAGE(PG8_SB(1, 1), b3 + hstepB, voffB); PG8_STAGE(PG8_SA(1, 0), a3, voffA);
            PG8_WAIT_V(8); PG8_WAIT_L(0); PG8_BAR; PG8_MMA(1, 0, At, B0); PG8_MMA(1, 1, At, B1); PG8_BAR; PG8_SCHED;
        }
        if (wr == 0) PG8_BAR;
        E(acc, cur, wr, wc, fr, fq, lds);
        if (!has_next) break;
#pragma unroll
        for (int a = 0; a < 2; ++a)
#pragma unroll
            for (int b = 0; b < 2; ++b)
#pragma unroll
                for (int m = 0; m < 4; ++m)
#pragma unroll
                    for (int n = 0; n < 2; ++n) acc[a][b][m][n] = (f32x4){0.f, 0.f, 0.f, 0.f};
        cur = nxt; cA = nA; cB = nB; ++ui;
        if (wr == 1) PG8_BAR;
    }
    PG8_WAIT_V(0);
    PG8_BAR;
#undef PG8_SA
#undef PG8_SB
#undef PG8_STAGE
#undef PG8_LDA
#undef PG8_LDB
#undef PG8_MMA
#undef PG8_WAIT_V
#undef PG8_WAIT_L
#undef PG8_BAR
#undef PG8_SCHED
}
}
using pg8::Unit;

DI void store8(bf16* p, const f32x4 v0, const f32x4 v1) {
    u32x4 w; w.x = pk2(v0[0], v0[1]); w.y = pk2(v0[2], v0[3]); w.z = pk2(v1[0], v1[1]); w.w = pk2(v1[2], v1[3]);
    *(u32x4*)p = w;
}
#define EPI_ARGS f32x4 (&acc)[2][2][4][2], const Unit& u, int wr, int wc, int fr, int fq, LAS unsigned char* lds

DI float rs_ps(const float* ps, int row) {
    const f32x4* p = (const f32x4*)(ps + (size_t)row * 16); const f32x4 a = p[0], b = p[1], c = p[2], d = p[3];
    const float s = ((a.x + a.y) + (a.z + a.w)) + ((b.x + b.y) + (b.z + b.w)) + (((c.x + c.y) + (c.z + c.w)) + ((d.x + d.y) + (d.z + d.w)));
    return 1.0f / sqrtf(s * (1.0f / D) + EPS);
}
template <int ACT> struct EpiRowScale {
    static constexpr bool PERM = true;
    bf16* O; int ldc; const float* rs; const float* ps;
    DI void operator()(EPI_ARGS) const {
        const int row0 = u.pm * 256 + wr * 64 + fr, col0 = u.pn * 256 + wc * 32 + 8 * fq;
#pragma unroll
        for (int ai = 0; ai < 2; ++ai)
#pragma unroll
            for (int m = 0; m < 4; ++m) {
                const int row = row0 + ai * 128 + m * 16; const float s = ps ? rs_ps(ps, row) : (rs ? rs[row] : 1.0f);
                bf16* rowp = O + (size_t)row * ldc + col0;
#pragma unroll
                for (int bj = 0; bj < 2; ++bj) { f32x4 v0 = acc[ai][bj][m][0] * s, v1 = acc[ai][bj][m][1] * s;
                    if (ACT == 2) {
#pragma unroll
                        for (int j = 0; j < 4; ++j) { float a = fmaxf(v0[j], 0.f), b = fmaxf(v1[j], 0.f); v0[j] = a * a; v1[j] = b * b; } }
                    store8(rowp + bj * 128, v0, v1); }
            }
    }
};
struct EpiInProj {
    static constexpr bool PERM = true;
    bf16* GLU; bf16* QK; const float* rs;
    DI void operator()(EPI_ARGS) const {
        const int row0 = u.pm * 256 + wr * 64 + fr;
        if (u.pn < 4) {
            const int col0 = u.pn * 128 + wc * 32 + 8 * fq;
#pragma unroll
            for (int ai = 0; ai < 2; ++ai)
#pragma unroll
                for (int m = 0; m < 4; ++m) {
                    const int row = row0 + ai * 128 + m * 16; const float s = rs[row];
                    f32x4 o0, o1;
#pragma unroll
                    for (int j = 0; j < 4; ++j) { o0[j] = acc[ai][0][m][0][j] * s * sigmoidf_(acc[ai][1][m][0][j] * s); o1[j] = acc[ai][0][m][1][j] * s * sigmoidf_(acc[ai][1][m][1][j] * s); }
                    store8(GLU + (size_t)row * 512 + col0, o0, o1);
                }
        } else {
            const int col0 = (u.pn - 4) * 256 + wc * 32 + 8 * fq;
#pragma unroll
            for (int ai = 0; ai < 2; ++ai)
#pragma unroll
                for (int m = 0; m < 4; ++m) {
                    const int row = row0 + ai * 128 + m * 16; const float s = rs[row];
#pragma unroll
                    for (int bj = 0; bj < 2; ++bj) store8(QK + (size_t)row * 1024 + col0 + bj * 128, acc[ai][bj][m][0] * s, acc[ai][bj][m][1] * s);
                }
        }
    }
};
struct EpiVT {
    static constexpr bool PERM = true;
    bf16* O; const float* cs;
    DI void operator()(EPI_ARGS) const {
        const int row0 = u.pm * 256 + wr * 64 + fr, col0 = u.pn * 256 + wc * 32 + 8 * fq;
        f32x4 c[2][2];
#pragma unroll
        for (int bj = 0; bj < 2; ++bj) { c[bj][0] = *(const f32x4*)(cs + col0 + bj * 128); c[bj][1] = *(const f32x4*)(cs + col0 + bj * 128 + 4); }
#pragma unroll
        for (int ai = 0; ai < 2; ++ai)
#pragma unroll
            for (int m = 0; m < 4; ++m) {
                const int row = row0 + ai * 128 + m * 16;
#pragma unroll
                for (int bj = 0; bj < 2; ++bj) store8(O + (size_t)row * M + col0 + bj * 128, acc[ai][bj][m][0] * c[bj][0], acc[ai][bj][m][1] * c[bj][1]);
            }
    }
};
struct EpiPre {
    static constexpr bool PERM = true;
    bf16* base0;
    DI void operator()(EPI_ARGS) const {
        bf16* O = base0 + (size_t)((u.z >> 30) & 1) * (52u << 20) + (size_t)(u.z & 0x3fffffff);
        const int row0 = wr * 64 + fr, col0 = wc * 32 + 8 * fq;
#pragma unroll
        for (int ai = 0; ai < 2; ++ai)
#pragma unroll
            for (int m = 0; m < 4; ++m) {
                const int row = row0 + ai * 128 + m * 16;
#pragma unroll
                for (int bj = 0; bj < 2; ++bj) store8(O + (size_t)row * 1024 + col0 + bj * 128, acc[ai][bj][m][0], acc[ai][bj][m][1]);
            }
    }
};
struct EpiResid {
    static constexpr bool PERM = true;
    const float* xres; const bf16* hres; bf16* out; float* ps;
    DI void operator()(EPI_ARGS) const {
        const int row0 = u.pm * 256 + wr * 64 + fr, col0 = u.pn * 256 + wc * 32 + 8 * fq;
#pragma unroll
        for (int ai = 0; ai < 2; ++ai)
#pragma unroll
            for (int m = 0; m < 4; ++m) {
                const int row = row0 + ai * 128 + m * 16; const size_t off = (size_t)row * D + col0; float ss = 0.f;
#pragma unroll
                for (int bj = 0; bj < 2; ++bj) {
                    f32x4 r0, r1;
                    if (xres) { r0 = *(const f32x4*)(xres + off + bj * 128); r1 = *(const f32x4*)(xres + off + bj * 128 + 4); }
                    else { const u32x4 hw = *(const u32x4*)(hres + off + bj * 128); r0 = (f32x4){bflo(hw.x), bfhi(hw.x), bflo(hw.y), bfhi(hw.y)}; r1 = (f32x4){bflo(hw.z), bfhi(hw.z), bflo(hw.w), bfhi(hw.w)}; }
                    r0 = r0 + acc[ai][bj][m][0]; r1 = r1 + acc[ai][bj][m][1];
                    u32x4 w; w.x = pk2(r0[0], r0[1]); w.y = pk2(r0[2], r0[3]); w.z = pk2(r1[0], r1[1]); w.w = pk2(r1[2], r1[3]);
                    *(u32x4*)(out + off + bj * 128) = w;
                    if (ps) {
#pragma unroll
                        for (int q = 0; q < 4; ++q) { const float a = bflo(w[q]), b = bfhi(w[q]); ss += a * a + b * b; }
                    }
                }
                if (ps) { ss += swz_xor<16>(ss); ss = half_sum(ss); if (fq == 0) ps[(size_t)row * 16 + u.pn * 4 + wc] = ss; }
            }
    }
};
struct EpiSoftmax {
    static constexpr bool PERM = true;
    bf16* P; const float* ps;
    DI void operator()(EPI_ARGS) const {
        LAS f32x2* X = (LAS f32x2*)(lds + LDS_X);
        const int row0 = u.pm * 256, col0 = u.pn * 256 + wc * 32 + 8 * fq;
        float mw[2][4];
#pragma unroll
        for (int ai = 0; ai < 2; ++ai)
#pragma unroll
            for (int m = 0; m < 4; ++m) {
                const int rl = ai * 128 + wr * 64 + m * 16 + fr; const float s = rs_ps(ps, row0 + rl) * LOG2E;
                float mx = -3.0e38f;
#pragma unroll
                for (int bj = 0; bj < 2; ++bj)
#pragma unroll
                    for (int n = 0; n < 2; ++n) { acc[ai][bj][m][n] = acc[ai][bj][m][n] * s;
#pragma unroll
                        for (int j = 0; j < 4; ++j) mx = fmaxf(mx, acc[ai][bj][m][n][j]); }
                mx = fmaxf(mx, swz_xor<16>(mx)); mx = half_max(mx);
                float sum = 0.f;
#pragma unroll
                for (int bj = 0; bj < 2; ++bj)
#pragma unroll
                    for (int n = 0; n < 2; ++n)
#pragma unroll
                        for (int j = 0; j < 4; ++j) { const float p = fexp2(acc[ai][bj][m][n][j] - mx); acc[ai][bj][m][n][j] = p; sum += p; }
                sum += swz_xor<16>(sum); sum = half_sum(sum);
                mw[ai][m] = mx;
                if (fq == 0) X[rl * 4 + wc] = (f32x2){mx, sum};
            }
        asm volatile("s_waitcnt lgkmcnt(0)" ::: "memory"); __builtin_amdgcn_s_barrier(); asm volatile("" ::: "memory");
#pragma unroll
        for (int ai = 0; ai < 2; ++ai)
#pragma unroll
            for (int m = 0; m < 4; ++m) {
                const int rl = ai * 128 + wr * 64 + m * 16 + fr;
                const f32x2 a = X[rl * 4 + 0], b = X[rl * 4 + 1], c = X[rl * 4 + 2], d = X[rl * 4 + 3];
                const float mt = fmaxf(fmaxf(a.x, b.x), fmaxf(c.x, d.x));
                const float lt = a.y * fexp2(a.x - mt) + b.y * fexp2(b.x - mt) + c.y * fexp2(c.x - mt) + d.y * fexp2(d.x - mt);
                const float f = fexp2(mw[ai][m] - mt) / lt;
                bf16* rowp = P + (size_t)(row0 + rl) * 1024 + col0;
#pragma unroll
                for (int bj = 0; bj < 2; ++bj) store8(rowp + bj * 128, acc[ai][bj][m][0] * f, acc[ai][bj][m][1] * f);
            }
        asm volatile("s_waitcnt lgkmcnt(0)" ::: "memory"); __builtin_amdgcn_s_barrier(); asm volatile("" ::: "memory");
    }
};
struct EpiRwkv {
    static constexpr bool PERM = true;
    bf16* R; bf16* Kk; bf16* V; bf16* HD1; bf16* HD2;
    DI void operator()(EPI_ARGS) const {
        const int row0 = u.pm * 256 + wr * 64 + fr; const int g = u.pn >> 2;
        bf16* O; int ldc, colt, mode0 = 0, mode1 = 0;
        if (u.pn < 12) { O = R + (size_t)g * (32u << 20); ldc = 1024; colt = (u.pn & 3) * 256; }
        else if (u.pn == 12) { O = HD1; ldc = 256; colt = 0; mode0 = 1; }
        else { O = HD2; ldc = 256; colt = 0; mode0 = 2; mode1 = 2; }
        const int col0 = colt + wc * 32 + 8 * fq;
#pragma unroll
        for (int ai = 0; ai < 2; ++ai)
#pragma unroll
            for (int m = 0; m < 4; ++m) {
                bf16* rowp = O + (size_t)(row0 + ai * 128 + m * 16) * ldc + col0;
#pragma unroll
                for (int bj = 0; bj < 2; ++bj) { f32x4 v0 = acc[ai][bj][m][0], v1 = acc[ai][bj][m][1]; const int md = bj ? mode1 : mode0;
                    if (md == 1) {
#pragma unroll
                        for (int j = 0; j < 4; ++j) { v0[j] = tanhf_(v0[j]); v1[j] = tanhf_(v1[j]); } }
                    else if (md == 2) {
#pragma unroll
                        for (int j = 0; j < 4; ++j) { v0[j] = sigmoidf_(v0[j]); v1[j] = sigmoidf_(v1[j]); } }
                    store8(rowp + bj * 128, v0, v1); }
            }
    }
};

enum InIdx { I_X = 0, I_MEM, I_REL, I_NMIX, I_NXATTN, I_NMEM, I_NFFN, I_NFINAL, I_WIN, I_WOUT, I_CONVW, I_CONVB, I_CLNG, I_CLNB, I_LQ1, I_LK1, I_LQ2, I_LK2, I_SUBLN,
             I_MU, I_WR, I_WK, I_WV, I_WO, I_W0, I_W1, I_W2, I_A0, I_A1, I_A2, I_G1, I_G2, I_KK, I_KA, I_RK, I_LNG, I_LNB, I_XQ, I_XKV, I_XO, I_UP, I_DN, N_IN };
struct Args { const float* in[N_IN]; float* out; unsigned char* ws; int ph_lo, ph_hi; };
static_assert(sizeof(Args) == (N_IN + 2) * 8 + 8, "Args has no padding");

struct Frame {
    LAS unsigned char* lds;
    int tid, lane, wave, gw, ngw;
    unsigned char* ws;
};

DI Frame fresh(const Frame& F0) {
    Frame F = F0; F.tid = opaque(threadIdx.x); F.lane = F.tid & 63; F.wave = __builtin_amdgcn_readfirstlane(F.tid >> 6); F.gw = opq(blockIdx.x) * 8 + F.wave; F.ngw = opq(gridDim.x) * 8; return F;
}
struct TJob { const float* W; int K, N; bf16* WT; int ldt, row_off, col_off, perm; const float* gain; };
DI void tr_item(const TJob& J, LAS float* scr, int item, int lane) {
    const int nblk = J.N / 32, kb = item / nblk, nb = item % nblk, k0 = 64 * kb, n0 = 32 * nb;
    float scale = 1.0f; int drow = J.row_off + n0;
    if (J.perm) {
        if (n0 < 512) drow = 256 * (n0 >> 7) + (n0 & 127);
        else if (n0 < 1024) drow = 256 * ((n0 - 512) >> 7) + 128 + ((n0 - 512) & 127);
        else drow = n0;
        if (n0 >= 1024 && n0 < 1536) scale = 0.125f;
    }
    float tv[32];
    const float* wp = J.W + (size_t)(k0 + (lane >> 5)) * J.N + n0 + (lane & 31);
#pragma unroll
    for (int i = 0; i < 32; ++i) tv[i] = wp[(size_t)(2 * i) * J.N];
    if (J.gain) {
#pragma unroll
        for (int i = 0; i < 32; ++i) tv[i] *= J.gain[k0 + 2 * i + (lane >> 5)];
    }
#pragma unroll
    for (int i = 0; i < 32; ++i) scr[(2 * i + (lane >> 5)) * 33 + (lane & 31)] = tv[i] * scale;
    asm volatile("s_waitcnt lgkmcnt(0)" ::: "memory");
    const int c = lane & 7;
#pragma unroll
    for (int j = 0; j < 4; ++j) { const int n = (lane >> 3) + 8 * j; const LAS float* s = scr + (8 * c) * 33 + n;
        u32x4 o; o.x = pk2(s[0 * 33], s[1 * 33]); o.y = pk2(s[2 * 33], s[3 * 33]); o.z = pk2(s[4 * 33], s[5 * 33]); o.w = pk2(s[6 * 33], s[7 * 33]);
        *(u32x4*)(J.WT + (size_t)(drow + n) * J.ldt + J.col_off + k0 + 8 * c) = o; }
    asm volatile("s_waitcnt lgkmcnt(0)" ::: "memory");
}
constexpr int N_TJOBS = 31;
DI TJob get_tjob(int j, const Args& a, unsigned char* ws) {
    TJob J; J.perm = 0; J.gain = nullptr; J.row_off = 0; J.col_off = 0;
    if (j == 0) { J.W = a.in[opq(I_WIN)]; J.K = 1024; J.N = 2560; J.WT = (bf16*)(ws + WS_WIN); J.ldt = 1024; J.perm = 1; J.gain = a.in[opq(I_NMIX)]; }
    else if (j == 1) { J.W = a.in[opq(I_WOUT)]; J.K = 1024; J.N = 1024; J.WT = (bf16*)(ws + WS_WOUT); J.ldt = 1024; }
    else if (j < 4) { const int i = j - 2; J.W = a.in[opq(I_XKV)] + (size_t)i * 1024 * 2048; J.K = 1024; J.N = 2048; J.WT = (bf16*)(ws + WS_WKV) + (size_t)i * 2048 * 1024; J.ldt = 1024; J.gain = a.in[opq(I_NMEM)] + i * 1024; }
    else if (j < 6) { const int i = j - 4; J.W = a.in[opq(I_XO)] + (size_t)i * 1024 * 1024; J.K = 1024; J.N = 1024; J.WT = (bf16*)(ws + WS_WXO) + (size_t)i * 1024 * 1024; J.ldt = 1024; }
    else if (j < 8) { const int i = j - 6; J.W = a.in[opq(I_UP)] + (size_t)i * 1024 * 4096; J.K = 1024; J.N = 4096; J.WT = (bf16*)(ws + WS_WUP) + (size_t)i * 4096 * 1024; J.ldt = 1024; J.gain = a.in[opq(I_NFFN)] + i * 1024; }
    else if (j < 10) { const int i = j - 8; J.W = a.in[opq(I_DN)] + (size_t)i * 4096 * 1024; J.K = 4096; J.N = 1024; J.WT = (bf16*)(ws + WS_WDN) + (size_t)i * 1024 * 4096; J.ldt = 4096; }
    else if (j < 26) {
        const int q = j - 10, src = q >> 1, copy = q & 1; int mu = 0;
        J.K = 1024; J.WT = (bf16*)(ws + WS_WBIG); J.ldt = 2048; J.col_off = copy * 1024;
        if (src == 0) { J.W = a.in[opq(I_WR)]; J.N = 1024; J.row_off = 0; mu = 0; }
        else if (src == 1) { J.W = a.in[opq(I_WK)]; J.N = 1024; J.row_off = 1024; mu = 2; }
        else if (src == 2) { J.W = a.in[opq(I_WV)]; J.N = 1024; J.row_off = 2048; mu = 3; }
        else if (src == 3) { J.W = a.in[opq(I_W1)]; J.N = 64; J.row_off = 3072; mu = 1; }
        else if (src == 4) { J.W = a.in[opq(I_W1)] + 1024 * 64; J.N = 64; J.row_off = 3136; mu = 1; }
        else if (src == 5) { J.W = a.in[opq(I_A1)]; J.N = 64; J.row_off = 3200; mu = 4; }
        else if (src == 6) { J.W = a.in[opq(I_A1)] + 1024 * 64; J.N = 64; J.row_off = 3264; mu = 4; }
        else { J.W = a.in[opq(I_G1)]; J.N = 160; J.row_off = 3328; mu = 5; }
        if (copy) J.gain = a.in[opq(I_MU)] + mu * 1024;
    }
    else if (j < 30) { const int q = j - 26; J.W = (q < 2 ? a.in[opq(I_W2)] : a.in[opq(I_A2)]) + (size_t)(q & 1) * 64 * 1024; J.K = 64; J.N = 1024; J.WT = (bf16*)(ws + WS_W2T) + (size_t)q * 1024 * 64; J.ldt = 64; }
    else { J.W = a.in[opq(I_WO)]; J.K = 1024; J.N = 1024; J.WT = (bf16*)(ws + WS_WRO); J.ldt = 1024; }
    return J;
}
DI void row_to_bf16_rs(const float* xrow, bf16* orow, float* rs, int lane) {
    const f32x4* xr = (const f32x4*)xrow + lane;
    f32x4 v[4]; float s = 0.f;
#pragma unroll
    for (int j = 0; j < 4; ++j) { v[j] = xr[64 * j]; s += (v[j].x * v[j].x + v[j].y * v[j].y) + (v[j].z * v[j].z + v[j].w * v[j].w); }
    s = wave_sum(s);
    u32x2* o8 = (u32x2*)orow + lane;
#pragma unroll
    for (int j = 0; j < 4; ++j) { u32x2 w; w.x = pk2(v[j].x, v[j].y); w.y = pk2(v[j].z, v[j].w); o8[64 * j] = w; }
    if (lane == 0) *rs = 1.0f / sqrtf(s * (1.0f / D) + EPS);
}
DI void rows4_to_bf16_rs(const Frame& F, const float* X, bf16* O, float* rs, int nrows) {
    for (int m0 = F.gw * 4; m0 < nrows; m0 += F.ngw * 4) {
        f32x4 v[4][4];
#pragma unroll
        for (int r = 0; r < 4; ++r)
#pragma unroll
            for (int j = 0; j < 4; ++j) v[r][j] = ((const f32x4*)(X + (size_t)(m0 + r) * D))[F.lane + 64 * j];
#pragma unroll
        for (int r = 0; r < 4; ++r) {
            float s = 0.f;
#pragma unroll
            for (int j = 0; j < 4; ++j) s += (v[r][j].x * v[r][j].x + v[r][j].y * v[r][j].y) + (v[r][j].z * v[r][j].z + v[r][j].w * v[r][j].w);
            s = wave_sum(s);
            u32x2* o8 = (u32x2*)(O + (size_t)(m0 + r) * D) + F.lane;
#pragma unroll
            for (int j = 0; j < 4; ++j) { u32x2 w; w.x = pk2(v[r][j].x, v[r][j].y); w.y = pk2(v[r][j].z, v[r][j].w); o8[64 * j] = w; }
            if (F.lane == 0) rs[m0 + r] = 1.0f / sqrtf(s * (1.0f / D) + EPS);
        }
    }
}
DI int t5_bucket(int rel) {
    const int n = rel < 0 ? -rel : rel; int r = rel > 0 ? 16 : 0;
    if (n < 8) return r + n;
    int lg = 8; lg += (n >= 12); lg += (n >= 16); lg += (n >= 23); lg += (n >= 32); lg += (n >= 46); lg += (n >= 64); lg += (n >= 91);
    return r + lg;
}
DI void phase_prologue(const Frame& F0, const Args& a, unsigned char* ws) {
    const Frame F = fresh(F0);
    LAS float* scr = (LAS float*)(F.lds + F.wave * 16384);
    for (int j = 0; j < N_TJOBS; ++j) {
        const TJob J = get_tjob(j, a, ws); const int items = (J.K / 64) * (J.N / 32);
        for (int it = F.gw; it < items; it += F.ngw) tr_item(J, scr, it, F.lane);
    }
    const int gt = F.gw * 64 + F.lane, ngt = F.ngw * 64;
    for (int i = 0; i < 2; ++i) {
        const float* W = a.in[opq(I_XQ)] + (size_t)i * 1024 * 1024; const float* g = a.in[opq(I_NXATTN)] + i * 1024; bf16* O = (bf16*)(ws + WS_WQN) + (size_t)i * 1024 * 1024;
        for (int e = gt; e < 1024 * 1024 / 4; e += ngt) { const f32x4 v = ((const f32x4*)W)[e]; const float s = g[(e * 4) >> 10] * 0.0625f; u32x2 w; w.x = pk2(v.x * s, v.y * s); w.y = pk2(v.z * s, v.w * s); ((u32x2*)O)[e] = w; }
    }
    { const float* W = a.in[opq(I_G2)]; bf16* O = (bf16*)(ws + WS_G2T);
      for (int e = gt; e < 1024 * 256; e += ngt) { const int n = e >> 8, k = e & 255; O[e] = (bf16)(k < 160 ? f2bf(W[(size_t)k * 1024 + n]) : 0u); } }
    { u32x4* O = (u32x4*)((bf16*)(ws + WS_WBIG) + (size_t)3488 * 2048);
      for (int e = gt; e < 96 * 2048 * 2 / 16; e += ngt) O[e] = (u32x4){0u, 0u, 0u, 0u}; }
    rows4_to_bf16_rs(F, a.in[opq(I_X)], (bf16*)(ws + WS_SA), (float*)(ws + WS_RS), M);
    rows4_to_bf16_rs(F, a.in[opq(I_MEM)], (bf16*)(ws + WS_MEMB), (float*)(ws + WS_RSMEM), MMEM);
    { float* B = (float*)(ws + WS_BIAS); const float* tab = a.in[opq(I_REL)];
      for (int e = gt; e < 4 * 4096; e += ngt) { const int h = e >> 12, idx = e & 4095; const int rel = idx - 2047; B[e] = idx < 4095 ? tab[t5_bucket(rel) * 4 + h] * LOG2E : 0.f; } }
    if (F.gw == 0) {
        const float q1 = a.in[opq(I_LQ1)][F.lane] * a.in[opq(I_LK1)][F.lane], q2 = a.in[opq(I_LQ2)][F.lane] * a.in[opq(I_LK2)][F.lane];
        const float s1 = wave_sum(q1), s2 = wave_sum(q2);
        if (F.lane == 0) ((float*)(ws + WS_LAM))[0] = expf(s1) - expf(s2) + 0.2f;
    }
}

DI void phase_norm(const Frame& F0, const float* h, bf16* hb, float* rs) {
    const Frame F = fresh(F0);
    for (int m = F.gw; m < M; m += F.ngw) row_to_bf16_rs(h + (size_t)m * D, hb + (size_t)m * D, rs + m, F.lane);
}
DI void phase_final_norm(const Frame& F0, const bf16* h, float* out, const float* g, const float osc) {
    const Frame F = fresh(F0);
    f32x4 gv[4];
#pragma unroll
    for (int j = 0; j < 4; ++j) gv[j] = ((const f32x4*)g)[F.lane + 64 * j];
    for (int m0 = F.gw * 4; m0 < M; m0 += F.ngw * 4) {
        u32x2 hw[4][4];
#pragma unroll
        for (int r = 0; r < 4; ++r)
#pragma unroll
            for (int j = 0; j < 4; ++j) hw[r][j] = ((const u32x2*)(h + (size_t)(m0 + r) * D))[F.lane + 64 * j];
#pragma unroll
        for (int r = 0; r < 4; ++r) {
            f32x4 v[4]; float s = 0.f;
#pragma unroll
            for (int j = 0; j < 4; ++j) { v[j] = (f32x4){bflo(hw[r][j].x), bfhi(hw[r][j].x), bflo(hw[r][j].y), bfhi(hw[r][j].y)}; s += (v[j].x * v[j].x + v[j].y * v[j].y) + (v[j].z * v[j].z + v[j].w * v[j].w); }
            const float rr = osc / sqrtf(wave_sum(s) * (1.0f / D) + EPS);
            f32x4* xr = (f32x4*)(out + (size_t)(m0 + r) * D) + F.lane;
#pragma unroll
            for (int j = 0; j < 4; ++j) xr[64 * j] = v[j] * rr * gv[j];
        }
    }
}
DI void phase_rwkv_shift(const Frame& F0, const bf16* h, const float* g, bf16* A1) {
    const Frame F = fresh(F0);
    f32x4 gv[4];
#pragma unroll
    for (int j = 0; j < 4; ++j) gv[j] = ((const f32x4*)g)[F.lane + 64 * j];
    for (int ch = F.gw; ch < M / 16; ch += F.ngw) {
        const int m0 = ch * 16, t0 = m0 & (T - 1);
        f32x4 p2[4], p1[4], cu[4];
#pragma unroll
        for (int j = 0; j < 4; ++j) { p2[j] = (f32x4){0.f, 0.f, 0.f, 0.f}; p1[j] = p2[j]; cu[j] = p2[j]; }
#pragma unroll 1
        for (int g6 = 0; g6 < 3; ++g6) {
            f32x4 ld[6][4];
#pragma unroll
            for (int r = 0; r < 6; ++r) { const int i = g6 * 6 + r - 1, t = t0 + i; const bool ok = (t >= 0 && t < T);
#pragma unroll
                for (int j = 0; j < 4; ++j) { const u32x2 w = ok ? ((const u32x2*)(h + (size_t)(m0 + i) * D))[F.lane + 64 * j] : (u32x2){0u, 0u}; ld[r][j] = (f32x4){bflo(w.x), bfhi(w.x), bflo(w.y), bfhi(w.y)}; } }
#pragma unroll
            for (int r = 0; r < 6; ++r) {
                const int i = g6 * 6 + r - 1;
                float s = 0.f;
#pragma unroll
                for (int j = 0; j < 4; ++j) { p2[j] = p1[j]; p1[j] = cu[j]; cu[j] = ld[r][j]; s += (cu[j].x * cu[j].x + cu[j].y * cu[j].y) + (cu[j].z * cu[j].z + cu[j].w * cu[j].w); }
                const float rr = 1.0f / sqrtf(wave_sum(s) * (1.0f / D) + EPS);
#pragma unroll
                for (int j = 0; j < 4; ++j) cu[j] = cu[j] * rr * gv[j];
                if (i >= 1) {
                    u32x2* o = (u32x2*)(A1 + (size_t)(m0 + i - 1) * 2048) + F.lane;
#pragma unroll
                    for (int j = 0; j < 4; ++j) { const f32x4 hh = (p2[j] + cu[j]) * 0.5f - p1[j];
                        u32x2 w; w.x = pk2(p1[j].x, p1[j].y); w.y = pk2(p1[j].z, p1[j].w); o[64 * j] = w;
                        u32x2 w2; w2.x = pk2(hh.x, hh.y); w2.y = pk2(hh.z, hh.w); o[256 + 64 * j] = w2; }
                }
            }
        }
    }
}
DI void phase_rwkv_comb(const Frame& F0, const bf16* YF, const bf16* YB, const bf16* V, const bf16* GT, const float* BON, const float* lng, const float* lnb, bf16* O) {
    const Frame F = fresh(F0);
    const int hd = F.lane >> 2, c0 = F.lane * 16;
    float lg[16], lb[16];
#pragma unroll
    for (int j = 0; j < 16; ++j) { lg[j] = lng[c0 + j]; lb[j] = lnb[c0 + j]; }
    for (int m0 = F.gw * 2; m0 < M; m0 += F.ngw * 2) {
        u32x4 a[2][2], b[2][2], vv[2][2], gg[2][2]; float bonr[2];
#pragma unroll
        for (int r = 0; r < 2; ++r) { const size_t off = (size_t)(m0 + r) * D + c0;
#pragma unroll
            for (int q = 0; q < 2; ++q) { a[r][q] = ((const u32x4*)(YF + off))[q]; b[r][q] = ((const u32x4*)(YB + off))[q]; vv[r][q] = ((const u32x4*)(V + off))[q]; gg[r][q] = ((const u32x4*)(GT + off))[q]; }
            bonr[r] = BON[(size_t)(m0 + r) * 16 + hd] + BON[(size_t)(M + m0 + r) * 16 + hd]; }
#pragma unroll
        for (int r = 0; r < 2; ++r) {
            const size_t off = (size_t)(m0 + r) * D + c0; const float bon = bonr[r];
            float y[16]; float s = 0.f;
#pragma unroll
            for (int q = 0; q < 2; ++q)
#pragma unroll
                for (int w = 0; w < 4; ++w) { y[q * 8 + 2 * w] = bflo(a[r][q][w]) + bflo(b[r][q][w]); y[q * 8 + 2 * w + 1] = bfhi(a[r][q][w]) + bfhi(b[r][q][w]); }
#pragma unroll
            for (int j = 0; j < 16; ++j) s += y[j];
            s += swz_xor<1>(s); s += swz_xor<2>(s);
            const float mean = s * (1.0f / 64.0f); float q2 = 0.f;
#pragma unroll
            for (int j = 0; j < 16; ++j) { y[j] -= mean; q2 += y[j] * y[j]; }
            q2 += swz_xor<1>(q2); q2 += swz_xor<2>(q2);
            const float rstd = 1.0f / sqrtf(q2 * (1.0f / 64.0f) + 64e-5f);
            u32x4 o[2];
#pragma unroll
            for (int q = 0; q < 2; ++q)
#pragma unroll
                for (int w = 0; w < 4; ++w) {
                    const int j = q * 8 + 2 * w;
                    const float r0 = (y[j] * rstd * lg[j] + lb[j] + bon * bflo(vv[r][q][w])) * bflo(gg[r][q][w]);
                    const float r1 = (y[j + 1] * rstd * lg[j + 1] + lb[j + 1] + bon * bfhi(vv[r][q][w])) * bfhi(gg[r][q][w]);
                    o[q][w] = pk2(r0, r1);
                }
            ((u32x4*)(O + off))[0] = o[0]; ((u32x4*)(O + off))[1] = o[1];
        }
    }
}
constexpr int CV_ROWB = 1040, CV_IN_BYTES = 94 * CV_ROWB, CV_W_OFF = CV_IN_BYTES;
DI void conv_load_weights(const Frame& F0, const float* cw) {
    const Frame F = fresh(F0);
    LAS bf16* W = (LAS bf16*)(F.lds + CV_W_OFF);
    for (int e = F.tid; e < 31 * 512; e += 512) W[e] = (bf16)f2bf(cw[e]);
}
DI void conv_unit(const Frame& F0, int unit, const bf16* GLU, const float* cb, const float* lg, const float* lb, bf16* MIX) {
    const Frame F = fresh(F0);
    const int b = unit >> 5, t0 = (unit & 31) * 64;
    __syncthreads();
    for (int p = F.tid; p < 94 * 64; p += 512) {
        const int r = p >> 6, c = p & 63, t = t0 - 15 + r;
        u32x4 v = (u32x4){0u, 0u, 0u, 0u};
        if (t >= 0 && t < T) v = *(const u32x4*)(GLU + (size_t)(b * T + t) * 512 + c * 8);
        *(LAS u32x4*)(F.lds + r * CV_ROWB + c * 16) = v;
    }
    __syncthreads();
    const int tl = F.tid >> 3, chunk = F.tid & 7;
    float y[64];
#pragma unroll
    for (int i = 0; i < 8; ++i) {
        const int cg = chunk + 8 * i;
        float acc[8];
#pragma unroll
        for (int e = 0; e < 8; ++e) acc[e] = cb[cg * 8 + e];
#pragma unroll 1
        for (int j = 0; j < 31; ++j) {
            const u32x4 x = *(const LAS u32x4*)(F.lds + (tl + j) * CV_ROWB + cg * 16);
            const u32x4 w = *(const LAS u32x4*)(F.lds + CV_W_OFF + j * 1024 + cg * 16);
#pragma unroll
            for (int q = 0; q < 4; ++q) { acc[2 * q] += bflo(x[q]) * bflo(w[q]); acc[2 * q + 1] += bfhi(x[q]) * bfhi(w[q]); }
        }
#pragma unroll
        for (int e = 0; e < 8; ++e) y[i * 8 + e] = acc[e];
    }
    float s = 0.f;
#pragma unroll
    for (int j = 0; j < 64; ++j) s += y[j];
    s += swz_xor<1>(s); s += swz_xor<2>(s); s += swz_xor<4>(s);
    const float mean = s * (1.0f / 512.0f); float q2 = 0.f;
#pragma unroll
    for (int j = 0; j < 64; ++j) { y[j] -= mean; q2 += y[j] * y[j]; }
    q2 += swz_xor<1>(q2); q2 += swz_xor<2>(q2); q2 += swz_xor<4>(q2);
    const float rstd = 1.0f / sqrtf(q2 * (1.0f / 512.0f) + 1e-5f);
    bf16* orow = MIX + (size_t)(b * T + t0 + tl) * 1024;
#pragma unroll
    for (int i = 0; i < 8; ++i) {
        const int c0 = (chunk + 8 * i) * 8;
        const f32x4 g0 = *(const f32x4*)(lg + c0), g1 = *(const f32x4*)(lg + c0 + 4), b0 = *(const f32x4*)(lb + c0), b1 = *(const f32x4*)(lb + c0 + 4);
        f32x4 o0, o1;
#pragma unroll
        for (int e = 0; e < 4; ++e) { const float v0 = y[i * 8 + e] * rstd * g0[e] + b0[e], v1 = y[i * 8 + 4 + e] * rstd * g1[e] + b1[e]; o0[e] = v0 * sigmoidf_(v0); o1[e] = v1 * sigmoidf_(v1); }
        store8(orow + c0, o0, o1);
    }
}

constexpr int DA_KROW = 272, DA_VROW = 136, DA_KB = 64 * DA_KROW, DA_VB = 128 * DA_VROW, DA_BUF = DA_KB + DA_VB;
DI int crow(int reg, int hf) { return (reg & 3) + 8 * (reg >> 2) + 4 * hf; }
DI void diffattn_unit(const Frame& F0, int unit, const bf16* QK, const bf16* VT, const float* BIAS, const float lam, const float* subg, bf16* MIX) {
    const Frame F = fresh(F0);
    const int b = unit >> 6, h = (unit >> 4) & 3, qb = unit & 15;
    const int c = F.wave >> 2, qs = F.wave & 3, r32 = F.lane & 31, hf = F.lane >> 5;
    const int q0w = qb * 128 + qs * 32;
    const float* bias_h = BIAS + h * 4096 + 2047;
    bf16x8 Qf[4];
    { const bf16* qp = QK + (size_t)(b * T + q0w + r32) * 1024 + h * 128 + c * 64 + 8 * hf;
#pragma unroll
      for (int ks = 0; ks < 4; ++ks) Qf[ks] = *(const bf16x8*)(qp + 16 * ks); }
    const bf16* kg[2]; const bf16* vg[2]; int kl[2], vl[2];
#pragma unroll
    for (int i = 0; i < 2; ++i) { const int p = F.tid + 512 * i;
        kg[i] = QK + (size_t)(b * T + (p >> 4)) * 1024 + 512 + h * 128 + (p & 15) * 8; kl[i] = (p >> 4) * DA_KROW + (p & 15) * 16;
        vg[i] = VT + (size_t)(h * 128 + (p >> 3)) * M + b * T + (p & 7) * 8; vl[i] = DA_KB + (p >> 3) * DA_VROW + (p & 7) * 16; }
    u32x4 kr[2], vr[2];
#pragma unroll
    for (int i = 0; i < 2; ++i) { kr[i] = *(const u32x4*)(kg[i]); vr[i] = *(const u32x4*)(vg[i]); }
    __syncthreads();
#pragma unroll
    for (int i = 0; i < 2; ++i) { *(LAS u32x4*)(F.lds + kl[i]) = kr[i]; *(LAS u32x2*)(F.lds + vl[i]) = (u32x2){vr[i].x, vr[i].y}; *(LAS u32x2*)(F.lds + vl[i] + 8) = (u32x2){vr[i].z, vr[i].w}; }
    __syncthreads();
    f32x16 O[4];
#pragma unroll
    for (int vt = 0; vt < 4; ++vt)
#pragma unroll
        for (int i = 0; i < 16; ++i) O[vt][i] = 0.f;
    float lsum = 0.f;
    const int ka = r32 * DA_KROW + c * 128 + 16 * hf;
    const int va = DA_KB + r32 * DA_VROW + 8 * hf;
    for (int kt = 0; kt < 32; ++kt) {
        const int k0 = kt * 64;
        LAS unsigned char* buf = F.lds + (kt & 1) * DA_BUF;
        if (kt + 1 < 32) {
#pragma unroll
            for (int i = 0; i < 2; ++i) { kr[i] = *(const u32x4*)(kg[i] + (size_t)(k0 + 64) * 1024); vr[i] = *(const u32x4*)(vg[i] + k0 + 64); }
        }
        const int dmin = k0 - (q0w + 31), dmax = k0 + 63 - q0w;
        const bool far = (dmin >= 91) || (dmax <= -91);
        const float cb = dmin >= 91 ? bias_h[91] : bias_h[-91];
#pragma unroll
        for (int sub = 0; sub < 2; ++sub) {
            f32x16 S;
#pragma unroll
            for (int i = 0; i < 16; ++i) S[i] = 0.f;
#pragma unroll
            for (int ks = 0; ks < 4; ++ks) { const bf16x8 a = *(const LAS bf16x8*)(buf + ka + sub * 32 * DA_KROW + ks * 32); S = __builtin_amdgcn_mfma_f32_32x32x16_bf16(a, Qf[ks], S, 0, 0, 0); }
            float p[16];
            if (far) {
#pragma unroll
                for (int i = 0; i < 16; ++i) p[i] = fexp2(S[i] * LOG2E + cb);
            } else {
                const int rel0 = k0 + 32 * sub - (q0w + r32);
#pragma unroll
                for (int i = 0; i < 16; ++i) p[i] = fexp2(S[i] * LOG2E + bias_h[rel0 + crow(i, hf)]);
            }
#pragma unroll
            for (int i = 0; i < 16; ++i) lsum += p[i];
#pragma unroll
            for (int s = 0; s < 2; ++s) {
                u32x4 pw; pw.x = pk2(p[8 * s], p[8 * s + 1]); pw.y = pk2(p[8 * s + 2], p[8 * s + 3]); pw.z = pk2(p[8 * s + 4], p[8 * s + 5]); pw.w = pk2(p[8 * s + 6], p[8 * s + 7]);
                const bf16x8 pa = __builtin_bit_cast(bf16x8, pw);
#pragma unroll
                for (int vt = 0; vt < 4; ++vt) {
                    const LAS unsigned char* vp = buf + va + vt * 32 * DA_VROW + (32 * sub + 16 * s) * 2;
                    const u32x2 lo = *(const LAS u32x2*)(vp), hi = *(const LAS u32x2*)(vp + 16);
                    const u32x4 vw = (u32x4){lo.x, lo.y, hi.x, hi.y};
                    O[vt] = __builtin_amdgcn_mfma_f32_32x32x16_bf16(pa, __builtin_bit_cast(bf16x8, vw), O[vt], 0, 0, 0);
                }
            }
        }
        if (kt + 1 < 32) {
            LAS unsigned char* nb = F.lds + ((kt + 1) & 1) * DA_BUF;
#pragma unroll
            for (int i = 0; i < 2; ++i) { *(LAS u32x4*)(nb + kl[i]) = kr[i]; *(LAS u32x2*)(nb + vl[i]) = (u32x2){vr[i].x, vr[i].y}; *(LAS u32x2*)(nb + vl[i] + 8) = (u32x2){vr[i].z, vr[i].w}; }
        }
        __syncthreads();
    }
    lsum = half_sum(lsum);
    LAS float* XO = (LAS float*)F.lds;
    LAS float* LW = (LAS float*)(F.lds + 65536) + F.wave * 32;
    if (hf == 0) LW[r32] = 1.0f / lsum;
    asm volatile("s_waitcnt lgkmcnt(0)" ::: "memory");
    float il[16];
#pragma unroll
    for (int i = 0; i < 16; ++i) il[i] = LW[crow(i, hf)];
    if (c == 1) {
#pragma unroll
        for (int vt = 0; vt < 4; ++vt)
#pragma unroll
            for (int i = 0; i < 16; ++i) XO[(qs * 32 + crow(i, hf)) * 128 + vt * 32 + r32] = O[vt][i] * il[i];
    }
    __syncthreads();
    if (c == 0) {
        float ss[16];
#pragma unroll
        for (int i = 0; i < 16; ++i) ss[i] = 0.f;
#pragma unroll
        for (int vt = 0; vt < 4; ++vt)
#pragma unroll
            for (int i = 0; i < 16; ++i) { const float o = O[vt][i] * il[i] - lam * XO[(qs * 32 + crow(i, hf)) * 128 + vt * 32 + r32]; O[vt][i] = o; ss[i] += o * o; }
#pragma unroll
        for (int i = 0; i < 16; ++i) { float v = ss[i]; v += swz_xor<1>(v); v += swz_xor<2>(v); v += swz_xor<4>(v); v += swz_xor<8>(v); v += swz_xor<16>(v); ss[i] = 0.8f / sqrtf(v * (1.0f / 128.0f) + EPS); }
#pragma unroll
        for (int vt = 0; vt < 4; ++vt) {
            const float g = subg[vt * 32 + r32];
#pragma unroll
            for (int i = 0; i < 16; ++i) MIX[(size_t)(b * T + q0w + crow(i, hf)) * 1024 + 512 + h * 128 + vt * 32 + r32] = (bf16)f2bf(O[vt][i] * ss[i] * g);
        }
    }
}

constexpr int SC_VECB = 256, SC_STEPB = 6 * SC_VECB, SC_BUFB = 16 * SC_STEPB;
constexpr int SC_SCR_OFF = 4 * SC_BUFB, SC_SCR_W = 16 * 68 * 4;
DI float dpp_x1(float v) { return __builtin_bit_cast(float, __builtin_amdgcn_update_dpp(0, __builtin_bit_cast(int, v), 0xB1, 0xF, 0xF, true)); }
DI float dpp_x2(float v) { return __builtin_bit_cast(float, __builtin_amdgcn_update_dpp(0, __builtin_bit_cast(int, v), 0x4E, 0xF, 0xF, true)); }
DI float quad_sum(float v) { v += dpp_x1(v); v += dpp_x2(v); return v; }

DI float a_fmac(float acc, float a, float b) { return __builtin_fmaf(a, b, acc); }
DI float a_fma(float a, float b, float c) { return __builtin_fmaf(a, b, c); }
DI float a_mul(float a, float b) { return a * b; }
struct ScanPtrs { const bf16 *R, *K, *V, *HD1, *W2T; const float *w0, *a0, *kk, *ka, *rk; bf16 *YF, *YB; float* BON; unsigned* ERR; };

DI void scan_pair(const Frame& F0, int bh, const ScanPtrs& P) {
    const Frame F = fresh(F0);
    const int b = bh >> 4, h = bh & 15;
    __syncthreads();
    if (F.wave < 4) {
        const int z = F.wave >> 1, rh = F.wave & 1, rp = F.lane >> 2, jq = F.lane & 3, i0 = rh * 32 + 2 * rp;
        float S0[16], S1[16];
#pragma unroll
        for (int j = 0; j < 16; ++j) { S0[j] = 0.f; S1[j] = 0.f; }
        bf16* Y = z ? P.YB : P.YF;
        __builtin_amdgcn_s_barrier();
#ifdef MK_TPROBE
        unsigned long long tp_acc = 0ull, tp_phase0 = __builtin_amdgcn_s_memtime();
#endif
        for (int e = 0; e < T / 16; ++e) {
#ifdef MK_TPROBE
            const unsigned long long tp0 = __builtin_amdgcn_s_memtime();
#endif
            const LAS unsigned char* base = F.lds + (z * 2 + (e & 1)) * SC_BUFB + jq * 64;
            const int t0c = z ? T - 16 * (e + 1) : 16 * e;
            bf16* yrow = Y + (size_t)(b * T + t0c) * 1024 + h * 64 + i0;
            f32x4 wv[2][4], kv[2][4], bv[2][4], av[2][4], rv[2][4]; f32x2 v2[2];
#define SC_FETCH(slot, li_) do { const LAS unsigned char* sb_ = base + (li_) * SC_STEPB; _Pragma("unroll") for (int q = 0; q < 4; ++q) { \
                av[slot][q] = *(const LAS f32x4*)(sb_ + 3 * SC_VECB + q * 16); wv[slot][q] = *(const LAS f32x4*)(sb_ + q * 16); kv[slot][q] = *(const LAS f32x4*)(sb_ + SC_VECB + q * 16); \
                bv[slot][q] = *(const LAS f32x4*)(sb_ + 2 * SC_VECB + q * 16); rv[slot][q] = *(const LAS f32x4*)(sb_ + 4 * SC_VECB + q * 16); } \
                v2[slot] = *(const LAS f32x2*)(sb_ - jq * 64 + 5 * SC_VECB + i0 * 4); } while (0)
            SC_FETCH(0, z ? 15 : 0);
#pragma unroll
            for (int s = 0; s < 16; ++s) {
                const int li = z ? 15 - s : s, cs = s & 1, ns = cs ^ 1;
                if (s < 15) SC_FETCH(ns, z ? 14 - s : s + 1);
                __builtin_amdgcn_sched_barrier(0);
                float sa0 = 0.f, sa1 = 0.f, sb0 = 0.f, sb1 = 0.f;
#pragma unroll
                for (int j = 0; j < 16; j += 2) { const float a0 = av[cs][j >> 2][j & 3], a1 = av[cs][(j + 1) >> 2][(j + 1) & 3];
                    sa0 = a_fmac(sa0, S0[j], a0); sb0 = a_fmac(sb0, S1[j], a0); sa1 = a_fmac(sa1, S0[j + 1], a1); sb1 = a_fmac(sb1, S1[j + 1], a1); }
                const float sa = quad_sum(sa0 + sa1), sb = quad_sum(sb0 + sb1);
                const float v0 = v2[cs].x, v1 = v2[cs].y;
                float y0 = 0.f, y1 = 0.f, z0 = 0.f, z1 = 0.f;
#pragma unroll
                for (int j = 0; j < 16; ++j) {
                    const float wj = wv[cs][j >> 2][j & 3], bj = bv[cs][j >> 2][j & 3], kj = kv[cs][j >> 2][j & 3], rj = rv[cs][j >> 2][j & 3];
                    S0[j] = a_fma(S0[j], wj, a_fma(sa, bj, a_mul(v0, kj)));
                    S1[j] = a_fma(S1[j], wj, a_fma(sb, bj, a_mul(v1, kj)));
                    if (j & 1) { y1 = a_fmac(y1, S0[j], rj); z1 = a_fmac(z1, S1[j], rj); } else { y0 = a_fmac(y0, S0[j], rj); z0 = a_fmac(z0, S1[j], rj); }
                }
                f32x2 y; y.x = quad_sum(y0 + y1); y.y = quad_sum(z0 + z1);
                if (jq == 0) *(unsigned*)(yrow + (size_t)li * 1024) = pk2(y.x, y.y);
                __builtin_amdgcn_sched_barrier(0);
            }
#undef SC_FETCH
            asm volatile("s_waitcnt lgkmcnt(0)" ::: "memory");
#ifdef MK_TPROBE
            tp_acc += __builtin_amdgcn_s_memtime() - tp0;
#endif
            __builtin_amdgcn_s_barrier();
        }
#ifdef MK_TPROBE
        if (blockIdx.x == 0 && F.wave == 0) {
            const unsigned long long tot = __builtin_amdgcn_s_memtime() - tp_phase0;
            const unsigned long long amt = (MK_TPROBE > 0 ? (unsigned long long)MK_TPROBE * tp_acc : (unsigned long long)(-(MK_TPROBE)) * (tot - tp_acc));
            const unsigned long long w0 = __builtin_amdgcn_s_memtime();
            while (__builtin_amdgcn_s_memtime() - w0 < amt) __builtin_amdgcn_s_sleep(8);
        }
#endif
    } else {
        const int pw = F.wave - 4, z = pw >> 1, par = pw & 1;
        const int l15 = F.lane & 15, l4 = F.lane >> 4, row = F.lane >> 2, cq = F.lane & 3;
        const bf16* w2p = P.W2T + (size_t)z * 65536 + (size_t)(h * 64 + l15) * 64 + 8 * l4;
        const int ch0 = h * 64 + cq * 16;
        LAS float* scrW = (LAS float*)(F.lds + SC_SCR_OFF + pw * 2 * SC_SCR_W);
        LAS float* scrA = scrW + 16 * 68;
        bf16x8 Ahw[2], Aha[2]; u32x4 r16[2], k16[2], v16[2];
        auto do_load = [&](int c) {
            const int t0c = z ? T - 16 * (c + 1) : 16 * c; const size_t m0 = (size_t)b * T + t0c;
#pragma unroll
            for (int ks = 0; ks < 2; ++ks) { const bf16* p = P.HD1 + (m0 + l15) * 256 + z * 64 + 32 * ks + 8 * l4; Ahw[ks] = *(const bf16x8*)p; Aha[ks] = *(const bf16x8*)(p + 128); }
            const size_t off = (m0 + row) * 1024 + ch0;
#pragma unroll
            for (int q = 0; q < 2; ++q) { r16[q] = ((const u32x4*)(P.R + off))[q]; k16[q] = ((const u32x4*)(P.K + off))[q]; v16[q] = ((const u32x4*)(P.V + off))[q]; }
        };
        auto do_compute = [&](int c) {
            const int t0c = z ? T - 16 * (c + 1) : 16 * c; const size_t m0 = (size_t)b * T + t0c;
#pragma unroll
            for (int nt = 0; nt < 4; ++nt) {
                f32x4 dw = (f32x4){0.f, 0.f, 0.f, 0.f}, da = dw;
#pragma unroll
                for (int ks = 0; ks < 2; ++ks) { const bf16x8 wf = *(const bf16x8*)(w2p + nt * 1024 + ks * 32), af = *(const bf16x8*)(w2p + 2 * 65536 + nt * 1024 + ks * 32);
                    dw = __builtin_amdgcn_mfma_f32_16x16x32_bf16(Ahw[ks], wf, dw, 0, 0, 0); da = __builtin_amdgcn_mfma_f32_16x16x32_bf16(Aha[ks], af, da, 0, 0, 0); }
#pragma unroll
                for (int rg = 0; rg < 4; ++rg) { scrW[(4 * l4 + rg) * 68 + 16 * nt + l15] = dw[rg]; scrA[(4 * l4 + rg) * 68 + 16 * nt + l15] = da[rg]; }
            }
            asm volatile("s_waitcnt lgkmcnt(0)" ::: "memory");
            float ssq = 0.f;
#pragma unroll
            for (int q = 0; q < 2; ++q)
#pragma unroll
                for (int w = 0; w < 4; ++w) { const f32x2 kc = *(const f32x2*)(P.kk + ch0 + q * 8 + 2 * w); const float k0 = bflo(k16[q][w]) * kc.x, k1 = bfhi(k16[q][w]) * kc.y; ssq += k0 * k0 + k1 * k1; }
            ssq = quad_sum(ssq);
            const float inv = 1.0f / fmaxf(sqrtf(ssq), 1e-12f);
            float bon = 0.f;
            LAS unsigned char* sb = F.lds + (z * 2 + (c & 1)) * SC_BUFB + row * SC_STEPB + cq * 64;
#pragma unroll
            for (int q = 0; q < 4; ++q) {
                const f32x4 wp = *(const LAS f32x4*)(scrW + row * 68 + cq * 16 + q * 4), ap = *(const LAS f32x4*)(scrA + row * 68 + cq * 16 + q * 4);
                const f32x4 w0v = *(const f32x4*)(P.w0 + z * 1024 + ch0 + q * 4), a0v = *(const f32x4*)(P.a0 + z * 1024 + ch0 + q * 4);
                const f32x4 kkv = *(const f32x4*)(P.kk + ch0 + q * 4), kav = *(const f32x4*)(P.ka + ch0 + q * 4), rkv = *(const f32x4*)(P.rk + ch0 + q * 4);
                const unsigned kw0 = k16[q >> 1][(q & 1) * 2], kw1 = k16[q >> 1][(q & 1) * 2 + 1], rw0 = r16[q >> 1][(q & 1) * 2], rw1 = r16[q >> 1][(q & 1) * 2 + 1], vw0 = v16[q >> 1][(q & 1) * 2], vw1 = v16[q >> 1][(q & 1) * 2 + 1];
                const f32x4 kf = (f32x4){bflo(kw0), bfhi(kw0), bflo(kw1), bfhi(kw1)}, rf = (f32x4){bflo(rw0), bfhi(rw0), bflo(rw1), bfhi(rw1)}, vf = (f32x4){bflo(vw0), bfhi(vw0), bflo(vw1), bfhi(vw1)};
                f32x4 ow, ok, ob, oa;
#pragma unroll
                for (int j = 0; j < 4; ++j) {
                    const float dec = fexp2(-0.60653066f * LOG2E * sigmoidf_(wp[j] + w0v[j]));
                    const float ar = sigmoidf_(ap[j] + a0v[j]);
                    const float kkn = kf[j] * kkv[j] * inv;
                    const float kd = kf[j] * (1.0f + (ar - 1.0f) * kav[j]);
                    ow[j] = dec; ok[j] = kd; ob[j] = kkn * ar; oa[j] = -kkn;
                    bon += rf[j] * kd * rkv[j];
                }
                *(LAS f32x4*)(sb + q * 16) = ow; *(LAS f32x4*)(sb + SC_VECB + q * 16) = ok; *(LAS f32x4*)(sb + 2 * SC_VECB + q * 16) = ob;
                *(LAS f32x4*)(sb + 3 * SC_VECB + q * 16) = oa; *(LAS f32x4*)(sb + 4 * SC_VECB + q * 16) = rf; *(LAS f32x4*)(sb + 5 * SC_VECB + q * 16) = vf;
            }
            bon = quad_sum(bon);
            if (cq == 0) P.BON[((size_t)z * M + m0 + row) * 16 + h] = bon;
            asm volatile("s_waitcnt lgkmcnt(0)" ::: "memory");
        };
        if (par == 0) { do_load(0); do_compute(0); } else do_load(1);
        __builtin_amdgcn_s_barrier();
        for (int e = 0; e < T / 16; ++e) {
            if (((e + 1) & 1) == par) { if (e + 1 < T / 16) do_compute(e + 1); }
            else { if (e + 2 < T / 16) do_load(e + 2); }
            __builtin_amdgcn_s_barrier();
        }
    }
}


constexpr int CS_AT = 0, CS_RT = 2304, CS_BK = 4608, CS_SMQ = 9728, CS_SMT = 11008, CS_NQ = 12288, CS_VT = 13568, CS_GL = 16640, CS_BUF = 16896;
constexpr int CS_PZ = 6 * CS_BUF;
constexpr int CS_W = CS_PZ + 4 * 4608;
constexpr int CS_WSZ = 4864;
constexpr int CS_BON = CS_W + 8 * CS_WSZ;
static_assert(CS_BON + 1536 <= LDS_MISC, "chunked-scan LDS map");
template <int CTRL> DI float dpp_mov0(float v) { return __builtin_bit_cast(float, __builtin_amdgcn_update_dpp(0, __builtin_bit_cast(int, v), CTRL, 0xF, 0xF, false)); }
DI float row_prefix(float v) { v += dpp_mov0<0x111>(v); v += dpp_mov0<0x112>(v); v += dpp_mov0<0x114>(v); v += dpp_mov0<0x118>(v); return v; }
DI float row_suffix(float v) { v += dpp_mov0<0x101>(v); v += dpp_mov0<0x102>(v); v += dpp_mov0<0x104>(v); v += dpp_mov0<0x108>(v); return v; }
DI bf16x8 lds16(const LAS unsigned char* p) { return *(const LAS bf16x8*)p; }
DI f32x4 mfma16(bf16x8 a, bf16x8 b, f32x4 c) { return __builtin_amdgcn_mfma_f32_16x16x32_bf16(a, b, c, 0, 0, 0); }

DI void scan_pair_mfma(const Frame& F0, int bh, const ScanPtrs& P) {
    const Frame F = fresh(F0);
    const int b = bh >> 4, h = bh & 15;
    const int z = F.wave >> 2, q4 = F.wave & 3;
    const int l15 = F.lane & 15, l4 = F.lane >> 4;
    const int te = l15, cg = l4, c4 = cg * 4;
    const int rr = z ? 15 - te : te;
    const int jl = 16 * q4 + c4;
    const int chq = h * 64 + 16 * q4;
    LAS unsigned char* const L = F.lds;
    LAS unsigned char* const wsc = L + CS_W + F.wave * CS_WSZ;
    LAS float* const scrW = (LAS float*)wsc; LAS float* const scrA = scrW + 16 * 20;
    LAS unsigned char* const ZB = wsc; LAS unsigned char* const XB = wsc + 2304; LAS unsigned char* const UB = wsc + 3072;
    LAS float* const yst = (LAS float*)(wsc + 3840);
    LAS float* const bonp = (LAS float*)(L + CS_BON);
    bf16* Y = z ? P.YB : P.YF;
    const bf16* w2p = P.W2T + (size_t)z * 65536 + (size_t)(chq + l15) * 64 + 8 * l4;
    bf16x8 Wf[2], Af[2];
#pragma unroll
    for (int ks = 0; ks < 2; ++ks) { Wf[ks] = *(const bf16x8*)(w2p + ks * 32); Af[ks] = *(const bf16x8*)(w2p + 2 * 65536 + ks * 32); }
    const f32x4 w0v = *(const f32x4*)(P.w0 + z * 1024 + chq + c4), a0v = *(const f32x4*)(P.a0 + z * 1024 + chq + c4);
    const f32x4 kkv = *(const f32x4*)(P.kk + chq + c4), kav = *(const f32x4*)(P.ka + chq + c4), rkv = *(const f32x4*)(P.rk + chq + c4);
    f32x4 kcn[4];
#pragma unroll
    for (int q = 0; q < 4; ++q) kcn[q] = *(const f32x4*)(P.kk + h * 64 + 16 * cg + q * 4);
    f32x4 Z[4];
#pragma unroll
    for (int jt = 0; jt < 4; ++jt) Z[jt] = (f32x4){0.f, 0.f, 0.f, 0.f};
    bf16x8 Ahw[2], Aha[2]; u32x2 r4, k4, v4; u32x4 kfull[2];
    auto do_load = [&](int c) {
        const int t0c = z ? T - 16 * (c + 1) : 16 * c; const size_t m0 = (size_t)b * T + t0c;
#pragma unroll
        for (int ks = 0; ks < 2; ++ks) { const bf16* p = P.HD1 + (m0 + l15) * 256 + z * 64 + 32 * ks + 8 * l4; Ahw[ks] = *(const bf16x8*)p; Aha[ks] = *(const bf16x8*)(p + 128); }
        const size_t off = (m0 + rr) * 1024;
        r4 = *(const u32x2*)(P.R + off + chq + c4); k4 = *(const u32x2*)(P.K + off + chq + c4); v4 = *(const u32x2*)(P.V + off + chq + c4);
        kfull[0] = ((const u32x4*)(P.K + off + h * 64 + 16 * cg))[0]; kfull[1] = ((const u32x4*)(P.K + off + h * 64 + 16 * cg))[1];
    };
    auto prep_a = [&](int c) {
        LAS unsigned char* const bp = L + (z * 3 + c % 3) * CS_BUF;
        LAS unsigned char* const pz = L + CS_PZ + (z * 2 + (c & 1)) * 4608;
        f32x4 dw = (f32x4){0.f, 0.f, 0.f, 0.f}, da = dw;
#pragma unroll
        for (int ks = 0; ks < 2; ++ks) { dw = mfma16(Ahw[ks], Wf[ks], dw); da = mfma16(Aha[ks], Af[ks], da); }
#pragma unroll
        for (int rg = 0; rg < 4; ++rg) { scrW[(4 * l4 + rg) * 20 + l15] = dw[rg]; scrA[(4 * l4 + rg) * 20 + l15] = da[rg]; }
        float ssq = 0.f;
#pragma unroll
        for (int q = 0; q < 2; ++q)
#pragma unroll
            for (int w = 0; w < 4; ++w) { const float k0 = bflo(kfull[q][w]) * kcn[q * 2 + (w >> 1)][(w & 1) * 2], k1 = bfhi(kfull[q][w]) * kcn[q * 2 + (w >> 1)][(w & 1) * 2 + 1]; ssq += k0 * k0 + k1 * k1; }
        ssq += swz_xor<16>(ssq); ssq = half_sum(ssq);
        const float inv = __builtin_amdgcn_rsqf(fmaxf(ssq, 1e-24f));
        asm volatile("s_waitcnt lgkmcnt(0)" ::: "memory");
        const f32x4 wp = *(const LAS f32x4*)(scrW + rr * 20 + c4), ap = *(const LAS f32x4*)(scrA + rr * 20 + c4);
        const f32x4 kf = (f32x4){bflo(k4.x), bfhi(k4.x), bflo(k4.y), bfhi(k4.y)}, rf = (f32x4){bflo(r4.x), bfhi(r4.x), bflo(r4.y), bfhi(r4.y)}, vf = (f32x4){bflo(v4.x), bfhi(v4.x), bflo(v4.y), bfhi(v4.y)};
        f32x4 at, rt, bt, kt, bhh, khh, gl; float bon = 0.f;
#pragma unroll
        for (int j = 0; j < 4; ++j) {
            const float lw = -0.60653066f * LOG2E * sigmoidf_(wp[j] + w0v[j]);
            const float ar = sigmoidf_(ap[j] + a0v[j]);
            const float kkn = kf[j] * kkv[j] * inv;
            const float kd = kf[j] * (1.0f + (ar - 1.0f) * kav[j]);
            const float bvec = kkn * ar, avec = -kkn;
#ifdef MK_LDSPREFIX
            scrW[te * 20 + c4 + j] = lw;
            asm volatile("s_waitcnt lgkmcnt(0)" ::: "memory");
            float pi = 0.f, su = 0.f;
            for (int s2 = 0; s2 < 16; ++s2) { const float x = scrW[s2 * 20 + c4 + j]; if (s2 <= te) pi += x; else su += x; }
            asm volatile("s_waitcnt lgkmcnt(0)" ::: "memory");
#else
            const float pi = row_prefix(lw), su = row_suffix(lw) - lw;
#endif
            const float eI = fexp2(pi), eE = fexp2(pi - lw), eN = frcp(eI), eS = fexp2(su);
            at[j] = avec * eE; rt[j] = rf[j] * eI; bt[j] = bvec * eN; kt[j] = kd * eN; bhh[j] = bvec * eS; khh[j] = kd * eS; gl[j] = eI * eS;
            bon += rf[j] * kd * rkv[j];
        }
        const int co = jl * 2;
        { u32x2 w; w.x = pk2(at[0], at[1]); w.y = pk2(at[2], at[3]); *(LAS u32x2*)(bp + CS_AT + te * 144 + co) = w; }
        { u32x2 w; w.x = pk2(rt[0], rt[1]); w.y = pk2(rt[2], rt[3]); *(LAS u32x2*)(bp + CS_RT + te * 144 + co) = w; }
        { u32x2 w; w.x = pk2(bt[0], bt[1]); w.y = pk2(bt[2], bt[3]); *(LAS u32x2*)(pz + te * 144 + co) = w; }
        { u32x2 w; w.x = pk2(kt[0], kt[1]); w.y = pk2(kt[2], kt[3]); *(LAS u32x2*)(pz + 2304 + te * 144 + co) = w; }
#pragma unroll
        for (int j = 0; j < 4; ++j) {
            const unsigned bk = pk2(bhh[j], khh[j]);
            *(LAS bf16*)(bp + CS_BK + (jl + j) * 80 + te * 2) = (bf16)(bk & 0xffffu);
            *(LAS bf16*)(bp + CS_BK + (jl + j) * 80 + 32 + te * 2) = (bf16)(bk >> 16);
        }
        *(LAS bf16*)(bp + CS_VT + (jl + 0) * 48 + te * 2) = (bf16)(v4.x & 0xffffu); *(LAS bf16*)(bp + CS_VT + (jl + 1) * 48 + te * 2) = (bf16)(v4.x >> 16);
        *(LAS bf16*)(bp + CS_VT + (jl + 2) * 48 + te * 2) = (bf16)(v4.y & 0xffffu); *(LAS bf16*)(bp + CS_VT + (jl + 3) * 48 + te * 2) = (bf16)(v4.y >> 16);
        if (te == 0) *(LAS f32x4*)(bp + CS_GL + jl * 4) = gl;
        bon += swz_xor<16>(bon); bon = half_sum(bon);
        if (cg == 0) bonp[((z * 3 + c % 3) * 4 + q4) * 16 + rr] = bon;
    };
    auto prep_b = [&](int c) {
        LAS unsigned char* const bp = L + (z * 3 + c % 3) * CS_BUF;
        const LAS unsigned char* const pz = L + CS_PZ + (z * 2 + (c & 1)) * 4608;
        const int r32 = F.lane & 31, hf = F.lane >> 5;
        const LAS unsigned char* pa = (r32 < 16 ? bp + CS_AT + r32 * 144 : bp + CS_RT + (r32 - 16) * 144) + 16 * hf;
        const LAS unsigned char* pb = (r32 < 16 ? pz + r32 * 144 : pz + 2304 + (r32 - 16) * 144) + 16 * hf;
        f32x16 Dm;
#pragma unroll
        for (int i = 0; i < 16; ++i) Dm[i] = 0.f;
#pragma unroll
        for (int ks = 0; ks < 4; ++ks) Dm = __builtin_amdgcn_mfma_f32_32x32x16_bf16(lds16(pa + 32 * ks), lds16(pb + 32 * ks), Dm, 0, 0, 0);
        const int sc = r32 & 15;
#pragma unroll
        for (int reg = 0; reg < 8; ++reg) { const int t = crow(reg, hf);
            if (r32 >= 16) *(LAS bf16*)(bp + CS_SMQ + t * 80 + sc * 2) = (bf16)f2bf(sc < t ? Dm[reg] : 0.f); }
#pragma unroll
        for (int reg = 8; reg < 16; ++reg) { const int t = crow(reg, hf) - 16;
            *(LAS bf16*)(bp + CS_NQ + t * 80 + r32 * 2) = (bf16)f2bf(sc <= t ? Dm[reg] : 0.f); }
#pragma unroll
        for (int reg = 0; reg < 8; ++reg) { if (r32 < 16) scrW[crow(reg, hf) * 16 + r32] = Dm[reg]; }
        asm volatile("s_waitcnt lgkmcnt(0)" ::: "memory");
        float Tr[16];
        f32x4 nr[4][4];
#pragma unroll
        for (int r = 0; r < 4; ++r)
#pragma unroll
            for (int q = 0; q < 4; ++q) nr[r][q] = (4 * q < r) ? *(const LAS f32x4*)(scrW + r * 16 + q * 4) : (f32x4){0.f, 0.f, 0.f, 0.f};
#pragma unroll
        for (int t = 0; t < 16; ++t) {
            float acc = (sc == t) ? 1.0f : 0.0f, acc1 = 0.f, acc2 = 0.f, acc3 = 0.f;
#pragma unroll
            for (int s2 = 0; s2 < t; ++s2) { const float n = nr[t & 3][s2 >> 2][s2 & 3];
                if ((s2 & 3) == 0) acc = __builtin_fmaf(n, Tr[s2], acc); else if ((s2 & 3) == 1) acc1 = __builtin_fmaf(n, Tr[s2], acc1);
                else if ((s2 & 3) == 2) acc2 = __builtin_fmaf(n, Tr[s2], acc2); else acc3 = __builtin_fmaf(n, Tr[s2], acc3); }
            acc = (acc + acc1) + (acc2 + acc3);
            Tr[t] = acc;
            if (t + 4 < 16) {
#pragma unroll
                for (int q = 0; q < 4; ++q) if (4 * q < t + 4) nr[t & 3][q] = *(const LAS f32x4*)(scrW + (t + 4) * 16 + q * 4);
            }
        }
        if (F.lane < 16) {
#pragma unroll
            for (int t = 0; t < 16; ++t) *(LAS bf16*)(bp + CS_SMT + t * 80 + sc * 2) = (bf16)f2bf(Tr[t]);
        }
    };
    auto stage_s = [&](int c) {
        const LAS unsigned char* const bp = L + (z * 3 + c % 3) * CS_BUF;
        const int q = l4, i = l15;
#pragma unroll
        for (int jt = 0; jt < 4; ++jt) { u32x2 w; w.x = pk2(Z[jt][0], Z[jt][1]); w.y = pk2(Z[jt][2], Z[jt][3]); *(LAS u32x2*)(ZB + i * 144 + (16 * jt + 4 * q) * 2) = w; }
        asm volatile("" ::: "memory");
        const bf16x8 Zb0 = lds16(ZB + i * 144 + (8 * q) * 2), Zb1 = lds16(ZB + i * 144 + (32 + 8 * q) * 2);
        const bf16x8 Vb = lds16(bp + CS_VT + (16 * q4 + i) * 48 + 8 * (q & 1) * 2);
        const LAS unsigned char* arow = bp + l15 * 144 + 8 * q * 2;
        const f32x4 zero = (f32x4){0.f, 0.f, 0.f, 0.f};
        f32x4 X = mfma16(lds16(arow + CS_AT), Zb0, zero); X = mfma16(lds16(arow + CS_AT + 64), Zb1, X);
        X = mfma16(lds16(bp + CS_SMQ + l15 * 80 + 16 * q), Vb, X);
        { u32x2 w; w.x = pk2(X[0], X[1]); w.y = pk2(X[2], X[3]); *(LAS u32x2*)(XB + i * 48 + 8 * q) = w; }
        asm volatile("" ::: "memory");
        const bf16x8 Xb = lds16(XB + i * 48 + 16 * (q & 1));
        const f32x4 U = mfma16(lds16(bp + CS_SMT + l15 * 80 + 16 * q), Xb, zero);
        { u32x2 w; w.x = pk2(U[0], U[1]); w.y = pk2(U[2], U[3]); *(LAS u32x2*)(UB + i * 48 + 8 * q) = w; }
        asm volatile("" ::: "memory");
        const bf16x8 Ub = lds16(UB + i * 48 + 16 * (q & 1));
        const bf16x8 UVb = q < 2 ? Ub : Vb;
        f32x4 Yv = mfma16(lds16(arow + CS_RT), Zb0, zero); Yv = mfma16(lds16(arow + CS_RT + 64), Zb1, Yv);
        Yv = mfma16(lds16(bp + CS_NQ + l15 * 80 + 16 * q), UVb, Yv);
#pragma unroll
        for (int r = 0; r < 4; ++r) yst[(4 * q + r) * 16 + i] = Yv[r];
#pragma unroll
        for (int jt = 0; jt < 4; ++jt) { const f32x4 g = *(const LAS f32x4*)(bp + CS_GL + (16 * jt + 4 * q) * 4);
            Z[jt] = mfma16(lds16(bp + CS_BK + (16 * jt + l15) * 80 + 16 * q), UVb, Z[jt] * g); }
    };
    auto flush_y = [&](int c) {
        const int t0c = z ? T - 16 * (c + 1) : 16 * c; const int st = F.lane >> 2, i4 = (F.lane & 3) * 4;
        f32x4 yv = *(const LAS f32x4*)(yst + st * 16 + i4);
#ifdef MK_CLAMPY
        for (int j = 0; j < 4; ++j) yv[j] = (yv[j] == yv[j]) ? fminf(fmaxf(yv[j], -1.0e4f), 1.0e4f) : 0.f;
#endif
#ifdef MK_SCANCHECK
        { const u32x2 ref = *(const u32x2*)(Y + (size_t)(b * T + t0c + (z ? 15 - st : st)) * 1024 + chq + i4);
          const float r0 = bflo(ref.x), r1 = bfhi(ref.x), r2 = bflo(ref.y), r3 = bfhi(ref.y);
          float er = fmaxf(fmaxf(fabsf(yv.x - r0) / (fabsf(r0) + 1.0f), fabsf(yv.y - r1) / (fabsf(r1) + 1.0f)), fmaxf(fabsf(yv.z - r2) / (fabsf(r2) + 1.0f), fabsf(yv.w - r3) / (fabsf(r3) + 1.0f)));
          if (!(er == er)) er = 1.0e9f;
          atomicMax((unsigned*)(P.ERR + c), __float_as_uint(er)); }
#else
        u32x2 w; w.x = pk2(yv.x, yv.y); w.y = pk2(yv.z, yv.w);
        *(u32x2*)(Y + (size_t)(b * T + t0c + (z ? 15 - st : st)) * 1024 + chq + i4) = w;
#endif
    };
    auto bonus_flush = [&](int c) {
#ifdef MK_SCANCHECK
        return;
#endif
        if (q4 == 0 && F.lane < 16) {
            const int t0c = z ? T - 16 * (c + 1) : 16 * c; const size_t m0 = (size_t)b * T + t0c;
            const LAS float* qq = bonp + (z * 3 + c % 3) * 64 + F.lane;
            P.BON[((size_t)z * M + m0 + F.lane) * 16 + h] = (qq[0] + qq[16]) + (qq[32] + qq[48]);
        }
    };
    __syncthreads();
    for (int e = F.tid; e < 6 * 2 * 16 * 8; e += 512) { const int row = (e >> 3) & 15, tile = (e >> 7) & 1, zb = e >> 8, w = e & 7;
        *(LAS unsigned*)(L + zb * CS_BUF + (tile ? CS_SMT : CS_SMQ) + row * 80 + 32 + w * 4) = 0u; }
    const bool pb_wave = (q4 == z);
    constexpr int NC = T / 16;
    do_load(0); prep_a(0); do_load(1); prep_a(1);
    asm volatile("s_waitcnt lgkmcnt(0)" ::: "memory"); __builtin_amdgcn_s_barrier(); asm volatile("" ::: "memory");
    if (pb_wave) prep_b(0);
    do_load(2);
    asm volatile("s_waitcnt lgkmcnt(0)" ::: "memory"); __builtin_amdgcn_s_barrier(); asm volatile("" ::: "memory");
#ifdef MK_TPROBE
    unsigned long long tpa[4] = {0ull, 0ull, 0ull, 0ull};
#define TP_T() __builtin_amdgcn_s_memtime()
#define TP_ACC(i, t0) tpa[i] += TP_T() - (t0)
#else
#define TP_T() 0ull
#define TP_ACC(i, t0) ((void)(t0))
#endif
    for (int e = 0; e < NC; ++e) {
        const unsigned long long t0 = TP_T();
        if (e + 2 < NC) prep_a(e + 2);
        asm volatile("s_waitcnt lgkmcnt(0)" ::: "memory");
        TP_ACC(0, t0); const unsigned long long t1 = TP_T();
        if (e > 0) flush_y(e - 1);
        if (e + 1 < NC) bonus_flush(e + 1);
        if (e == 0) bonus_flush(0);
        if (e + 3 < NC) do_load(e + 3);
        stage_s(e);
        asm volatile("s_waitcnt lgkmcnt(0)" ::: "memory");
        TP_ACC(1, t1); const unsigned long long t2 = TP_T();
        if (pb_wave && e + 1 < NC) prep_b(e + 1);
        asm volatile("s_waitcnt lgkmcnt(0)" ::: "memory");
        TP_ACC(2, t2); const unsigned long long t3 = TP_T();
        __builtin_amdgcn_s_barrier(); asm volatile("" ::: "memory");
        TP_ACC(3, t3);
    }
#ifdef MK_TPROBE
    if (blockIdx.x == 0 && F.wave == MK_TPROBE_WAVE) {
        const unsigned long long amt = 4ull * tpa[MK_TPROBE];
        const unsigned long long w0 = __builtin_amdgcn_s_memtime();
        while (__builtin_amdgcn_s_memtime() - w0 < amt) __builtin_amdgcn_s_sleep(8);
    }
#endif
    flush_y(T / 16 - 1);
}

#define XB_TMO      128
#define XB_XCNT(j)  (256  + 64 * (j))
#define XB_XSUB(j)  (1280 + 64 * (j))
#define XB_XGEN(j)  (2304 + 64 * (j))
#define XB_TOP      3328
#define XB_TOPGEN   3392
#define XCD_BAR_WORDS 3456
#define XB_SPIN_CAP (1u << 22)
DI unsigned xb_ld(unsigned* p)              { return __hip_atomic_load(p, __ATOMIC_RELAXED, __HIP_MEMORY_SCOPE_AGENT); }
DI unsigned xb_add(unsigned* p, unsigned v) { return __hip_atomic_fetch_add(p, v, __ATOMIC_RELAXED, __HIP_MEMORY_SCOPE_AGENT); }
DI unsigned xb_xcc_id() { return (unsigned)__builtin_amdgcn_s_getreg((3 << 11) | 20) & 0xFu; }
#define XB_SPIN(cond, bar) do { unsigned _sp = 0; while (cond) { __builtin_amdgcn_s_sleep(1); \
    if ((++_sp & 255u) == 0u) { if (xb_ld(&(bar)[XB_TMO])) break; if (_sp > XB_SPIN_CAP) { atomicAdd(&(bar)[XB_TMO], 1u); break; } } } } while (0)
struct XcdBarrier { unsigned* bar; unsigned x; volatile LAS unsigned* st; };
DI XcdBarrier xcd_barrier_post(unsigned* bar, volatile LAS unsigned* st) {
    XcdBarrier b; b.bar = bar; b.x = xb_xcc_id(); b.st = st;
    if (threadIdx.x == 0) (void)xb_add(&bar[XB_XCNT(b.x)], 1u);
    return b;
}
DI void xcd_barrier_complete(unsigned* bar, unsigned x, unsigned& nloc, unsigned& nx) {
    const unsigned G = gridDim.x * gridDim.y * gridDim.z;
    unsigned sum, cnt, mine, sp = 0u;
    for (;;) {
        sum = 0u; cnt = 0u; mine = 0u;
#pragma unroll
        for (unsigned j = 0; j < 16; ++j) { const unsigned c = xb_ld(&bar[XB_XCNT(j)]); sum += c; cnt += (c > 0u) ? 1u : 0u; mine = (j == x) ? c : mine; }
        if (sum == G) break;
        __builtin_amdgcn_s_sleep(1);
        if ((++sp & 255u) == 0u) { if (xb_ld(&bar[XB_TMO])) break; if (sp > XB_SPIN_CAP) { atomicAdd(&bar[XB_TMO], 1u); break; } }
    }
    nloc = mine > 0u ? mine : 1u; nx = cnt > 0u ? cnt : 1u;
}
DI void xcd_barrier(const XcdBarrier& b) {
    asm volatile("s_waitcnt vmcnt(0)" ::: "memory");
    __syncthreads();
    if (threadIdx.x == 0) {
        unsigned* bar = b.bar;
        __builtin_amdgcn_s_waitcnt(0);
        unsigned nloc = b.st[0], nx = b.st[1];
        if (nloc == 0u) { xcd_barrier_complete(bar, b.x, nloc, nx); b.st[0] = nloc; b.st[1] = nx; }
        const unsigned old = xb_add(&bar[XB_XSUB(b.x)], 1u);
        const unsigned gen = old / nloc;
        if (old + 1u == (gen + 1u) * nloc) {
            __builtin_amdgcn_fence(__ATOMIC_RELEASE, "agent");
            asm volatile("s_waitcnt vmcnt(0)" ::: "memory");
            const unsigned og = xb_add(&bar[XB_TOP], 1u);
            const unsigned tg = og / nx;
            if (og + 1u == (tg + 1u) * nx) xb_add(&bar[XB_TOPGEN], 1u);
            else XB_SPIN(xb_ld(&bar[XB_TOPGEN]) == tg, bar);
            __builtin_amdgcn_fence(__ATOMIC_ACQUIRE, "agent");
            xb_add(&bar[XB_XGEN(b.x)], 1u);
            asm volatile("s_waitcnt vmcnt(0)" ::: "memory");
        } else {
            XB_SPIN(xb_ld(&bar[XB_XGEN(b.x)]) == gen, bar);
            __builtin_amdgcn_fence(__ATOMIC_ACQUIRE, "agent");
            asm volatile("s_waitcnt vmcnt(0)" ::: "memory");
        }
    }
    __syncthreads();
}

#ifndef MK_PROG
#ifdef MK_SCANCHECK
#define MK_PROG 0,1,2,3,4,5,7,8,10,11,12,13,14,25,15,16,17,19,20,22,23,24
#else
#define MK_PROG 0,1,2,3,4,5,7,8,10,11,12,13,14,15,16,17,19,20,22,23,24
#endif
#endif
__constant__ int PROG[] = {MK_PROG};
constexpr int NPH = sizeof(PROG) / sizeof(int);
template <int TYPE> struct PreSched {
    const bf16* KV; const bf16* W; int G, c;
    DI bool next(int i, Unit& u) const {
        const long L = (long)i * G + c; if (L >= 512) return false;
        const int rem = (int)L, i2 = rem >> 8, b = (rem >> 4) & 15, hh = (rem >> 2) & 3, t4 = rem & 3;
        u.pm = 0; u.pn = 0;
        const bf16* kvp = KV + (size_t)(b * 256) * 4096 + i2 * 2048 + hh * 256;
        const bf16* wp = W + (size_t)i2 * 1024 * 1024 + (size_t)(t4 * 256) * 1024 + hh * 256;
        if (TYPE == 0) { u.pa = (const char*)kvp; u.pb = (const char*)wp; u.z = (i2 << 30) | (b * 1048576 + hh * 256 * 1024 + t4 * 256); }
        else { u.pa = (const char*)wp; u.pb = (const char*)(kvp + 1024); u.z = (i2 << 30) | (16 * 1048576 + b * 1048576 + t4 * 256 * 1024 + hh * 256); }
        return true;
    }
};

__global__ void __launch_bounds__(512, 2) mk_fwd(Args a) {
    extern __shared__ __attribute__((aligned(16))) unsigned char lds_raw[];
    Frame F;
    F.lds = (LAS unsigned char*)lds_raw;
    F.tid = threadIdx.x; F.lane = F.tid & 63; F.wave = __builtin_amdgcn_readfirstlane(F.tid >> 6);
    F.gw = blockIdx.x * 8 + F.wave; F.ngw = gridDim.x * 8; F.ws = a.ws;
    cg::grid_group grid = cg::this_grid();
    volatile LAS unsigned* MISC = (volatile LAS unsigned*)(F.lds + LDS_MISC);
    if (F.tid < 2) MISC[F.tid] = 0u;
    __syncthreads();
    (void)xcd_barrier_post((unsigned*)(a.ws + WS_BAR), MISC);

    for (int pi = a.ph_lo; pi < a.ph_hi; ++pi) {
        const int ph = PROG[pi];
        const int G = opq(gridDim.x), cblk = opq(blockIdx.x);
        unsigned char* ws = a.ws + (size_t)opq(0);
        float* RS = (float*)(ws + WS_RS);
        bf16* SA = (bf16*)(ws + WS_SA); bf16* SB = (bf16*)(ws + WS_SB);
        bf16* H = (bf16*)a.out;
        const int li = ph >= 18 ? 1 : 0;
        int cp = ph; if (ph >= 18 && ph <= 23) cp = ph - 12;
#ifndef PH_MASK
#define PH_MASK 0xffffffffu
#endif
        if (!((PH_MASK >> cp) & 1u)) cp = 99;
        switch (cp) {
        case 0: phase_prologue(F, a, ws); break;
        case 1: {
            pg8::PlainSched S{(const bf16*)(ws + WS_MEMB), (const bf16*)(ws + WS_WKV), 1024, 1024, MMEM / 256, 16, G, cblk, 30, 0};
            EpiRowScale<0> E{(bf16*)(ws + WS_KV), 4096, (const float*)(ws + WS_RSMEM), nullptr};
            pg8::gemm_phase(F.lds, 1024, 1024, 1024, S, E);
        } break;
        case 2: {
            EpiPre E{(bf16*)(ws + WS_G0)};
            { PreSched<0> S{(const bf16*)(ws + WS_KV), (const bf16*)(ws + WS_WQN), G, cblk}; pg8::gemm_phase(F.lds, 256, 4096, 1024, S, E); }
            { PreSched<1> S{(const bf16*)(ws + WS_KV), (const bf16*)(ws + WS_WXO), G, cblk}; pg8::gemm_phase(F.lds, 256, 1024, 4096, S, E); }
        } break;
        case 3: {
            { pg8::PlainSched S{SA, (const bf16*)(ws + WS_WIN), 1024, 1024, M / 256, 8, G, cblk, 30, 0};
              EpiInProj E{(bf16*)(ws + WS_GLU), SB, RS};
              pg8::gemm_phase(F.lds, 1024, 1024, 1024, S, E); }
            { pg8::PlainSched S{(const bf16*)(ws + WS_WIN) + (size_t)2048 * 1024, SA, 1024, 1024, 2, M / 256, G, cblk, 30, 0};
              EpiVT E{(bf16*)(ws + WS_VT), RS};
              pg8::gemm_phase(F.lds, 1024, 1024, 1024, S, E); }
        } break;
        case 4: {
            const float lam = ((const float*)(ws + WS_LAM))[0];
#ifndef NO_ATTN
            for (int u = cblk; u < 1024; u += G) diffattn_unit(F, u, SB, (const bf16*)(ws + WS_VT), (const float*)(ws + WS_BIAS), lam, a.in[opq(I_SUBLN)], (bf16*)(ws + WS_MIX));
#endif
            __syncthreads();
#ifndef NO_CONV
            conv_load_weights(F, a.in[opq(I_CONVW)]);
            for (int u = cblk; u < 512; u += G) conv_unit(F, u, (const bf16*)(ws + WS_GLU), a.in[opq(I_CONVB)], a.in[opq(I_CLNG)], a.in[opq(I_CLNB)], (bf16*)(ws + WS_MIX));
#endif
            __syncthreads();
        } break;
        case 5: {
            pg8::PlainSched S{(const bf16*)(ws + WS_MIX), (const bf16*)(ws + WS_WOUT), 1024, 1024, M / 256, 4, G, cblk, 30, 0};
            EpiResid E{a.in[opq(I_X)], nullptr, H, (float*)(ws + WS_PS)};
            pg8::gemm_phase(F.lds, 1024, 1024, 1024, S, E);
        } break;
        case 7: {
            pg8::PlainSched S{H, (const bf16*)(ws + (li ? WS_G1 : WS_G0)), 1024, 1024, M / 256, 4, G, cblk, 3, (size_t)1048576};
            EpiSoftmax E{SB, (const float*)(ws + WS_PS)};
            pg8::gemm_phase(F.lds, 1024, 1024, 1024, S, E);
        } break;
        case 8: {
            pg8::PlainSched S{SB, (const bf16*)(ws + (li ? WS_VW1 : WS_VW0)), 1024, 1024, M / 256, 4, G, cblk, 3, (size_t)1048576};
            EpiResid E{nullptr, H, H, (float*)(ws + WS_PS)};
            pg8::gemm_phase(F.lds, 1024, 1024, 1024, S, E);
        } break;
        case 10: {
            pg8::PlainSched S{H, (const bf16*)(ws + WS_WUP) + (size_t)li * 4096 * 1024, 1024, 1024, M / 256, 16, G, cblk, 30, 0};
            EpiRowScale<2> E{(bf16*)(ws + WS_HID), 4096, nullptr, (const float*)(ws + WS_PS)};
            pg8::gemm_phase(F.lds, 1024, 1024, 1024, S, E);
        } break;
        case 11: {
            pg8::PlainSched S{(const bf16*)(ws + WS_HID), (const bf16*)(ws + WS_WDN) + (size_t)li * 1024 * 4096, 4096, 4096, M / 256, 4, G, cblk, 30, 0};
            EpiResid E{nullptr, H, li ? SA : H, nullptr};
            pg8::gemm_phase(F.lds, 4096, 4096, 4096, S, E);
        } break;
        case 12: phase_rwkv_shift(F, H, a.in[opq(I_NMIX)] + 1024, (bf16*)(ws + WS_A1)); break;
        case 13: {
            pg8::PlainSched S{(const bf16*)(ws + WS_A1), (const bf16*)(ws + WS_WBIG), 2048, 2048, M / 256, 14, G, cblk, 30, 0};
            EpiRwkv E{(bf16*)(ws + WS_R), (bf16*)(ws + WS_K), (bf16*)(ws + WS_V), (bf16*)(ws + WS_HD1), (bf16*)(ws + WS_HD2)};
            pg8::gemm_phase(F.lds, 2048, 2048, 2048, S, E);
        } break;
        case 14: {
            ScanPtrs P{(const bf16*)(ws + WS_R), (const bf16*)(ws + WS_K), (const bf16*)(ws + WS_V), (const bf16*)(ws + WS_HD1), (const bf16*)(ws + WS_W2T),
                       a.in[opq(I_W0)], a.in[opq(I_A0)], a.in[opq(I_KK)], a.in[opq(I_KA)], a.in[opq(I_RK)], (bf16*)(ws + WS_YF), (bf16*)(ws + WS_YB), (float*)(ws + WS_BONUS), (unsigned*)(ws + WS_BAR + 32768)};
#if defined(MK_SCAN_VALU) || defined(MK_SCANCHECK)
            for (int bh = cblk; bh < 256; bh += G) scan_pair(F, bh, P);
#else
            for (int bh = cblk; bh < 256; bh += G) scan_pair_mfma(F, bh, P);
#endif
            __syncthreads();
        } break;
#ifdef MK_SCANCHECK
        case 25: {
            ScanPtrs P{(const bf16*)(ws + WS_R), (const bf16*)(ws + WS_K), (const bf16*)(ws + WS_V), (const bf16*)(ws + WS_HD1), (const bf16*)(ws + WS_W2T),
                       a.in[opq(I_W0)], a.in[opq(I_A0)], a.in[opq(I_KK)], a.in[opq(I_KA)], a.in[opq(I_RK)], (bf16*)(ws + WS_YF), (bf16*)(ws + WS_YB), (float*)(ws + WS_BONUS), (unsigned*)(ws + WS_BAR + 32768)};
            for (int bh = cblk; bh < 256; bh += G) scan_pair_mfma(F, bh, P);
            __syncthreads();
        } break;
#endif
        case 15: {
            pg8::PlainSched S{(const bf16*)(ws + WS_HD2), (const bf16*)(ws + WS_G2T), 256, 256, M / 256, 4, G, cblk, 30, 0};
            EpiRowScale<0> E{(bf16*)(ws + WS_GATE), 1024, nullptr, nullptr};
            pg8::gemm_phase(F.lds, 256, 256, 256, S, E);
        } break;
        case 16: phase_rwkv_comb(F, (const bf16*)(ws + WS_YF), (const bf16*)(ws + WS_YB), (const bf16*)(ws + WS_V), (const bf16*)(ws + WS_GATE), (const float*)(ws + WS_BONUS),
                                 a.in[opq(I_LNG)], a.in[opq(I_LNB)], (bf16*)(ws + WS_COMB)); break;
        case 17: {
            pg8::PlainSched S{(const bf16*)(ws + WS_COMB), (const bf16*)(ws + WS_WRO), 1024, 1024, M / 256, 4, G, cblk, 30, 0};
            EpiResid E{nullptr, H, H, (float*)(ws + WS_PS)};
            pg8::gemm_phase(F.lds, 1024, 1024, 1024, S, E);
        } break;
        case 24: {
            float osc = 1.0f;
#ifdef MK_SCANCHECK
            { const unsigned* ER = (const unsigned*)(ws + WS_BAR + 32768); int bad = -1;
              for (int c = 127; c >= 0; --c) if (__uint_as_float(__builtin_amdgcn_readfirstlane(__hip_atomic_load(ER + c, __ATOMIC_RELAXED, __HIP_MEMORY_SCOPE_AGENT))) > MK_SCANCHECK_TOL) bad = c;
              if (bad >= 0) osc = 1.0f + 0.03f * (float)(bad + 1); }
#endif
            phase_final_norm(F, SA, a.out, a.in[opq(I_NFINAL)], osc);
        } break;
        default: break;
        }
        if (pi + 1 < a.ph_hi) {
#ifdef MK_ALL_CG
            grid.sync();
#else
            if (pi == a.ph_lo) grid.sync(); else { XcdBarrier xb; xb.bar = (unsigned*)(ws + WS_BAR); xb.x = xb_xcc_id(); xb.st = (volatile LAS unsigned*)(F.lds + LDS_MISC); xcd_barrier(xb); }
#endif
        }
    }
}

extern "C" void kernel_launch(void* const* d_in, const int* in_sizes, int n_in, void* d_out, int out_size, void* d_ws, size_t ws_size, hipStream_t stream) {
    static int grid = 0;
    if (grid == 0) {
        if (n_in != N_IN || in_sizes[0] != M * D || out_size != M * D || ws_size < WS_NEED) {
            fprintf(stderr, "kernel_launch: unexpected problem (n_in %d, in0 %d, out %d, ws %zu); nothing launched\n", n_in, n_in > 0 ? in_sizes[0] : -1, out_size, ws_size); grid = -1; return; }
        int dev = 0, cus = 0, per_cu = 0;
        if (hipGetDevice(&dev) != hipSuccess || hipDeviceGetAttribute(&cus, hipDeviceAttributeMultiprocessorCount, dev) != hipSuccess) { grid = -1; return; }
        if (hipFuncSetAttribute((const void*)mk_fwd, hipFuncAttributeMaxDynamicSharedMemorySize, LDS_BYTES) != hipSuccess) { fprintf(stderr, "kernel_launch: hipFuncSetAttribute failed\n"); grid = -1; return; }
        if (hipOccupancyMaxActiveBlocksPerMultiprocessor(&per_cu, (const void*)mk_fwd, 512, LDS_BYTES) != hipSuccess || per_cu < 1) { fprintf(stderr, "kernel_launch: occupancy query says %d\n", per_cu); (void)hipGetLastError(); grid = -1; return; }
        grid = cus;
    }
    if (grid < 0) return;
    if (hipMemsetAsync((char*)d_ws + WS_BAR, 0, 65536, stream) != hipSuccess) { fprintf(stderr, "kernel_launch: memset failed\n"); return; }
    Args a{};
    for (int i = 0; i < N_IN; ++i) a.in[i] = (const float*)d_in[i];
    a.out = (float*)d_out; a.ws = (unsigned char*)d_ws;
#if MK_SINGLE
    a.ph_lo = 0; a.ph_hi = NPH;
    void* params[] = {&a};
    hipError_t e = hipLaunchCooperativeKernel((const void*)mk_fwd, dim3(grid), dim3(512), params, LDS_BYTES, stream);
    if (e != hipSuccess) fprintf(stderr, "kernel_launch: cooperative launch failed: %s\n", hipGetErrorString(e));
#else
    for (int ph = 0; ph < NPH; ++ph) { a.ph_lo = ph; a.ph_hi = ph + 1; hipLaunchKernelGGL(mk_fwd, dim3(grid), dim3(512), LDS_BYTES, stream, a); }
#endif
}
```

```cpp
#include <hip/hip_runtime.h>
#include <hip/hip_cooperative_groups.h>
#include <cstdio>
#include <cstdint>
namespace cg = cooperative_groups;

#ifndef MK_SINGLE
#define MK_SINGLE 1
#endif

#define LAS __attribute__((address_space(3)))
#define DI __device__ __forceinline__
typedef unsigned short bf16;
typedef short bf16x8 __attribute__((ext_vector_type(8)));
typedef short s16x4 __attribute__((ext_vector_type(4)));
typedef float f32x2 __attribute__((ext_vector_type(2)));
typedef float f32x4 __attribute__((ext_vector_type(4)));
typedef float f32x16 __attribute__((ext_vector_type(16)));
typedef unsigned u32x2 __attribute__((ext_vector_type(2)));
typedef unsigned u32x4 __attribute__((ext_vector_type(4)));

constexpr int D = 1024, NB = 16, T = 2048, M = NB * T, NMEM = 256, MMEM = NB * NMEM;
constexpr int FF = 4096;
constexpr float EPS = 1e-6f;
constexpr float LOG2E = 1.4426950408889634f;

constexpr size_t MiB = 1u << 20;
constexpr size_t WS_BAR = 0;
constexpr size_t WS_RS = 64 * 1024;
constexpr size_t WS_RSMEM = WS_RS + M * 4;
constexpr size_t WS_BIAS = WS_RSMEM + MMEM * 4;
constexpr size_t WS_LAM = WS_BIAS + 4 * 4096 * 4;
constexpr size_t WS_WIN = 1 * MiB;
constexpr size_t WS_WOUT = WS_WIN + 5 * MiB;
constexpr size_t WS_WQN = WS_WOUT + 2 * MiB;
constexpr size_t WS_WKV = WS_WQN + 4 * MiB;
constexpr size_t WS_WXO = WS_WKV + 8 * MiB;
constexpr size_t WS_WUP = WS_WXO + 4 * MiB;
constexpr size_t WS_WDN = WS_WUP + 16 * MiB;
constexpr size_t WS_WBIG = WS_WDN + 16 * MiB;
constexpr size_t WS_W2T = WS_WBIG + 14 * MiB;
constexpr size_t WS_G2T = WS_W2T + 512 * 1024;
constexpr size_t WS_WRO = WS_G2T + 512 * 1024;
constexpr size_t WS_WEND = WS_WRO + 2 * MiB;
static_assert(WS_WEND == 73 * MiB, "weight map");
constexpr size_t WS_SA = 73 * MiB;
constexpr size_t WS_SB = 137 * MiB;
constexpr size_t WS_GLU = 201 * MiB;
constexpr size_t WS_VT = 233 * MiB;
constexpr size_t WS_MIX = 265 * MiB;
constexpr size_t WS_G0 = 329 * MiB;
constexpr size_t WS_VW0 = 361 * MiB;
constexpr size_t WS_MEMB = 393 * MiB;
constexpr size_t WS_KV = 401 * MiB;
constexpr size_t WS_G1 = 433 * MiB;
constexpr size_t WS_VW1 = 465 * MiB;
static_assert(WS_G1 - WS_G0 == 104 * MiB && WS_VW0 - WS_G0 == 32 * MiB && WS_VW1 - WS_G1 == 32 * MiB, "G / VW spacing used by EpiPre");
constexpr size_t WS_BONUS = 497 * MiB;
constexpr size_t WS_PS = 502 * MiB;
constexpr size_t WS_HID = 137 * MiB;
constexpr size_t WS_A1 = 73 * MiB;
constexpr size_t WS_R = 201 * MiB, WS_K = 265 * MiB, WS_V = 329 * MiB;
static_assert(WS_K - WS_R == 64 * MiB && WS_V - WS_K == 64 * MiB, "r, k, v spacing used by EpiRwkv");
constexpr size_t WS_HD1 = 393 * MiB;
constexpr size_t WS_HD2 = 409 * MiB;
constexpr size_t WS_YF = 73 * MiB, WS_YB = 137 * MiB;
constexpr size_t WS_GATE = 265 * MiB;
constexpr size_t WS_COMB = 201 * MiB;
constexpr size_t WS_NEED = 512 * MiB;

constexpr int LDS_X = 131072;
constexpr int LDS_MISC = 163840 - 256;
constexpr int LDS_BYTES = 163840;

DI unsigned f2bf(float f) { unsigned u = __builtin_bit_cast(unsigned, f); return (u + 0x7fffu + ((u >> 16) & 1u)) >> 16; }
typedef __bf16 bf16x2v __attribute__((ext_vector_type(2)));
DI unsigned pk2(float lo, float hi) { const f32x2 v = {lo, hi}; return __builtin_bit_cast(unsigned, __builtin_convertvector(v, bf16x2v)); }
DI float bf2f(unsigned short b) { return __builtin_bit_cast(float, ((unsigned)b) << 16); }
DI float bflo(unsigned w) { return __builtin_bit_cast(float, w << 16); }
DI float bfhi(unsigned w) { return __builtin_bit_cast(float, w & 0xffff0000u); }
template <int MASK> DI float swz_xor(float v) { return __builtin_bit_cast(float, __builtin_amdgcn_ds_swizzle(__builtin_bit_cast(int, v), (MASK << 10) | 0x1f)); }
DI float half_sum(float v) { const int x = __builtin_bit_cast(int, v); const auto r = __builtin_amdgcn_permlane32_swap(x, x, false, false); return __builtin_bit_cast(float, (int)r[0]) + __builtin_bit_cast(float, (int)r[1]); }
DI float half_max(float v) { const int x = __builtin_bit_cast(int, v); const auto r = __builtin_amdgcn_permlane32_swap(x, x, false, false); return fmaxf(__builtin_bit_cast(float, (int)r[0]), __builtin_bit_cast(float, (int)r[1])); }
DI float wave_sum(float v) {
    v += swz_xor<1>(v); v += swz_xor<2>(v); v += swz_xor<4>(v); v += swz_xor<8>(v); v += swz_xor<16>(v); v = half_sum(v);
    return v;
}
DI int opaque(int x) { asm volatile("" : "+v"(x)); return x; }
template <class Tp> DI Tp* opq_ptr(Tp* p) { asm volatile("" : "+s"(p)); return p; }
DI int opq(int x) { asm volatile("" : "+s"(x)); return x; }
DI float fexp2(float x) { return __builtin_amdgcn_exp2f(x); }
DI float frcp(float x) { return __builtin_amdgcn_rcpf(x); }
DI float sigmoidf_(float x) { return frcp(1.0f + fexp2(-x * LOG2E)); }
DI float tanhf_(float x) { float e = fexp2(-2.0f * LOG2E * fabsf(x)); float t = (1.0f - e) * frcp(1.0f + e); return x < 0.f ? -t : t; }

namespace pg8 {
constexpr int BM = 256, BK = 64, HALF = 128, HTB = HALF * BK * 2, STAGE_BYTES = 8 * HTB, NXCD = 8, WGM = 8;
DI int lds_byte(int r, int c) { const int st = (r >> 4) * 2 + (c >> 5), rr = r & 15, cc = c & 31, ob = rr * 64 + cc * 2; return st * 1024 + (ob ^ (((ob >> 9) & 1) << 5)); }
DI void stage_rc(int b, int& R, int& C) { const int st = b / 1024, sb = b % 1024, swz = sb ^ (((sb >> 9) & 1) << 5); R = (st >> 1) * 16 + swz / 64; C = (st & 1) * 32 + (swz % 64) / 2; }
DI int perm32(int rho) { const int n = rho >> 4, i = rho & 15; return 8 * (i >> 2) + 4 * n + (i & 3); }

struct Unit { int pm, pn, z; const char* pa; const char* pb; };

DI bool tile_order(long L, int nM, int nN, int& pm, int& pn) {
    const int nwg = nM * nN; if (L >= nwg) return false;
    int wgid = (int)L; { const int q = nwg / NXCD, r = nwg % NXCD, xcd = wgid % NXCD, off = wgid / NXCD; wgid = (xcd < r ? xcd * (q + 1) : r * (q + 1) + (xcd - r) * q) + off; }
    const int nig = WGM * nN, gid = wgid / nig, fm = gid * WGM, gsz = (nM - fm) < WGM ? (nM - fm) : WGM;
    pm = fm + ((wgid % nig) % gsz); pn = (wgid % nig) / gsz; return true;
}
struct PlainSched {
    const bf16* A; const bf16* Bt; int lda, ldb, nM, nN, G, c, bshift; size_t bstride;
    DI bool next(int i, Unit& u) const {
        if (!tile_order((long)i * G + c, nM, nN, u.pm, u.pn)) return false;
        u.z = u.pm >> bshift;
        u.pa = (const char*)(A + (size_t)u.pm * 256 * lda);
        u.pb = (const char*)(Bt + (size_t)u.z * bstride + (size_t)u.pn * 256 * ldb);
        return true;
    }
};

DI unsigned cvt_pk_bf16(float lo, float hi) { return pk2(lo, hi); }

template <class Epi, class Sched>
DI void gemm_phase(LAS unsigned char* lds, const int K, const int lda, const int ldb, const Sched& S, const Epi& E) {
    const int tid = opaque(threadIdx.x), wid = __builtin_amdgcn_readfirstlane(tid >> 6), lane = tid & 63, wr = wid >> 2, wc = wid & 3, fr = lane & 15, fq = lane >> 4;
    const int nt = K / BK;
    unsigned voffA[2], voffB[2];
#pragma unroll
    for (int i = 0; i < 2; ++i) { int R, C; stage_rc(tid * 16 + i * 8192, R, C); const int Rb = Epi::PERM ? ((R & ~31) + perm32(R & 31)) : R;
        voffA[i] = (unsigned)(R * lda + C) * 2u; voffB[i] = (unsigned)(Rb * ldb + C) * 2u; }
    const size_t kstep = (size_t)(BK * 2);
    const size_t hstepA = (size_t)HALF * lda * 2, hstepB = (size_t)HALF * ldb * 2;
    const unsigned ldsw = (unsigned)wid * 1024u;
    const int aoff = lds_byte(wr * 64 + fr, fq * 8), boff = lds_byte(wc * 32 + fr, fq * 8);
#define PG8_SA(b, h) (((b) * 2 + (h)) * HTB)
#define PG8_SB(b, h) ((4 + (b) * 2 + (h)) * HTB)
#define PG8_STAGE(bufoff, gbase, voff) do { _Pragma("unroll") for (int _i = 0; _i < 2; ++_i) \
        __builtin_amdgcn_global_load_lds((const unsigned*)((const char*)(gbase) + (voff)[_i]), (LAS unsigned*)(lds + (bufoff) + ldsw + _i * 8192), 16, 0, 0); } while (0)
#define PG8_LDA(dst, b, h) do { _Pragma("unroll") for (int m = 0; m < 4; ++m) _Pragma("unroll") for (int k = 0; k < 2; ++k) dst[m][k] = *(const LAS bf16x8*)(lds + PG8_SA(b, h) + aoff + m * 2048 + k * 1024); } while (0)
#define PG8_LDB(dst, b, h) do { _Pragma("unroll") for (int n = 0; n < 2; ++n) _Pragma("unroll") for (int k = 0; k < 2; ++k) dst[n][k] = *(const LAS bf16x8*)(lds + PG8_SB(b, h) + boff + n * 2048 + k * 1024); } while (0)
#define PG8_MMA(ai, bj, At, Bt) do { __builtin_amdgcn_s_setprio(1); _Pragma("unroll") for (int m = 0; m < 4; ++m) _Pragma("unroll") for (int n = 0; n < 2; ++n) _Pragma("unroll") for (int k = 0; k < 2; ++k) \
        acc[ai][bj][m][n] = __builtin_amdgcn_mfma_f32_16x16x32_bf16(Bt[n][k], At[m][k], acc[ai][bj][m][n], 0, 0, 0); __builtin_amdgcn_s_setprio(0); } while (0)
#define PG8_WAIT_V(n) asm volatile("s_waitcnt vmcnt(" #n ")" ::: "memory")
#define PG8_WAIT_L(n) asm volatile("s_waitcnt lgkmcnt(" #n ")" ::: "memory")
#define PG8_BAR __builtin_amdgcn_s_barrier()
#define PG8_SCHED __builtin_amdgcn_sched_barrier(0)
    Unit cur, nxt; int ui = 0;
    if (!S.next(0, cur)) return;
    f32x4 acc[2][2][4][2];
#pragma unroll
    for (int a = 0; a < 2; ++a)
#pragma unroll
        for (int b = 0; b < 2; ++b)
#pragma unroll
            for (int m = 0; m < 4; ++m)
#pragma unroll
                for (int n = 0; n < 2; ++n) acc[a][b][m][n] = (f32x4){0.f, 0.f, 0.f, 0.f};
    bf16x8 At[4][2], B0[2][2], B1[2][2];
    const char* cA = cur.pa; const char* cB = cur.pb;
    PG8_STAGE(PG8_SB(0, 0), cB, voffB); PG8_STAGE(PG8_SB(0, 1), cB + hstepB, voffB); PG8_STAGE(PG8_SA(0, 0), cA, voffA); PG8_STAGE(PG8_SA(0, 1), cA + hstepA, voffA);
    if (wr == 1) PG8_BAR;
    PG8_WAIT_V(2); PG8_BAR;
    PG8_STAGE(PG8_SB(1, 0), cB + kstep, voffB); PG8_STAGE(PG8_SA(1, 0), cA + kstep, voffA); PG8_STAGE(PG8_SB(1, 1), cB + hstepB + kstep, voffB);
    PG8_WAIT_V(6); PG8_BAR;
    for (;;) {
        const bool has_next = S.next(ui + 1, nxt);
        const char* nA = has_next ? nxt.pa : cA; const char* nB = has_next ? nxt.pb : cB;
#pragma unroll 1
        for (int t = 0; t < nt; t += 2) {
            const bool last = (t == nt - 2);
            const char* a1 = cA + (size_t)(t + 1) * kstep;
            const char* a2 = last ? nA : cA + (size_t)(t + 2) * kstep; const char* b2 = last ? nB : cB + (size_t)(t + 2) * kstep;
            const char* a3 = a2 + kstep; const char* b3 = b2 + kstep;
            PG8_LDB(B0, 0, 0); PG8_LDB(B1, 0, 1); PG8_SCHED; PG8_LDA(At, 0, 0); PG8_STAGE(PG8_SA(1, 1), a1 + hstepA, voffA);
            PG8_WAIT_V(8); PG8_WAIT_L(0); PG8_BAR; PG8_MMA(0, 0, At, B0); PG8_MMA(0, 1, At, B1); PG8_BAR; PG8_SCHED;
            PG8_LDA(At, 0, 1); PG8_STAGE(PG8_SB(0, 0), b2, voffB); PG8_STAGE(PG8_SB(0, 1), b2 + hstepB, voffB); PG8_STAGE(PG8_SA(0, 0), a2, voffA);
            PG8_WAIT_V(8); PG8_WAIT_L(0); PG8_BAR; PG8_MMA(1, 0, At, B0); PG8_MMA(1, 1, At, B1); PG8_BAR; PG8_SCHED;
            PG8_LDB(B0, 1, 0); PG8_LDB(B1, 1, 1); PG8_SCHED; PG8_LDA(At, 1, 0); PG8_STAGE(PG8_SA(0, 1), a2 + hstepA, voffA);
            PG8_WAIT_V(8); PG8_WAIT_L(0); PG8_BAR; PG8_MMA(0, 0, At, B0); PG8_MMA(0, 1, At, B1); PG8_BAR; PG8_SCHED;
            PG8_LDA(At, 1, 1); PG8_STAGE(PG8_SB(1, 0), b3, voffB); PG8_STAGE(PG8_SB(1, 1), b3 + hstepB, voffB); PG8_STAGE(PG8_SA(1, 0), a3, voffA);
            PG8_WAIT_V(8); PG8_WAIT_L(0); PG8_BAR; PG8_MMA(1, 0, At, B0); PG8_MMA(1, 1, At, B1); PG8_BAR; PG8_SCHED;
        }
        if (wr == 0) PG8_BAR;
        E(acc, cur, wr, wc, fr, fq, lds);
        if (!has_next) break;
#pragma unroll
        for (int a = 0; a < 2; ++a)
#pragma unroll
            for (int b = 0; b < 2; ++b)
#pragma unroll
                for (int m = 0; m < 4; ++m)
#pragma unroll
                    for (int n = 0; n < 2; ++n) acc[a][b][m][n] = (f32x4){0.f, 0.f, 0.f, 0.f};
        cur = nxt; cA = nA; cB = nB; ++ui;
        if (wr == 1) PG8_BAR;
    }
    PG8_WAIT_V(0);
    PG8_BAR;
#undef PG8_SA
#undef PG8_SB
#undef PG8_STAGE
#undef PG8_LDA
#undef PG8_LDB
#undef PG8_MMA
#undef PG8_WAIT_V
#undef PG8_WAIT_L
#undef PG8_BAR
#undef PG8_SCHED
}
}
using pg8::Unit;

DI void store8(bf16* p, const f32x4 v0, const f32x4 v1) {
    u32x4 w; w.x = pk2(v0[0], v0[1]); w.y = pk2(v0[2], v0[3]); w.z = pk2(v1[0], v1[1]); w.w = pk2(v1[2], v1[3]);
    *(u32x4*)p = w;
}
#define EPI_ARGS f32x4 (&acc)[2][2][4][2], const Unit& u, int wr, int wc, int fr, int fq, LAS unsigned char* lds

DI float rs_ps(const float* ps, int row) {
    const f32x4* p = (const f32x4*)(ps + (size_t)row * 16); const f32x4 a = p[0], b = p[1], c = p[2], d = p[3];
    const float s = ((a.x + a.y) + (a.z + a.w)) + ((b.x + b.y) + (b.z + b.w)) + (((c.x + c.y) + (c.z + c.w)) + ((d.x + d.y) + (d.z + d.w)));
    return 1.0f / sqrtf(s * (1.0f / D) + EPS);
}
template <int ACT> struct EpiRowScale {
    static constexpr bool PERM = true;
    bf16* O; int ldc; const float* rs; const float* ps;
    DI void operator()(EPI_ARGS) const {
        const int row0 = u.pm * 256 + wr * 64 + fr, col0 = u.pn * 256 + wc * 32 + 8 * fq;
#pragma unroll
        for (int ai = 0; ai < 2; ++ai)
#pragma unroll
            for (int m = 0; m < 4; ++m) {
                const int row = row0 + ai * 128 + m * 16; const float s = ps ? rs_ps(ps, row) : (rs ? rs[row] : 1.0f);
                bf16* rowp = O + (size_t)row * ldc + col0;
#pragma unroll
                for (int bj = 0; bj < 2; ++bj) { f32x4 v0 = acc[ai][bj][m][0] * s, v1 = acc[ai][bj][m][1] * s;
                    if (ACT == 2) {
#pragma unroll
                        for (int j = 0; j < 4; ++j) { float a = fmaxf(v0[j], 0.f), b = fmaxf(v1[j], 0.f); v0[j] = a * a; v1[j] = b * b; } }
                    store8(rowp + bj * 128, v0, v1); }
            }
    }
};
struct EpiInProj {
    static constexpr bool PERM = true;
    bf16* GLU; bf16* QK; const float* rs;
    DI void operator()(EPI_ARGS) const {
        const int row0 = u.pm * 256 + wr * 64 + fr;
        if (u.pn < 4) {
            const int col0 = u.pn * 128 + wc * 32 + 8 * fq;
#pragma unroll
            for (int ai = 0; ai < 2; ++ai)
#pragma unroll
                for (int m = 0; m < 4; ++m) {
                    const int row = row0 + ai * 128 + m * 16; const float s = rs[row];
                    f32x4 o0, o1;
#pragma unroll
                    for (int j = 0; j < 4; ++j) { o0[j] = acc[ai][0][m][0][j] * s * sigmoidf_(acc[ai][1][m][0][j] * s); o1[j] = acc[ai][0][m][1][j] * s * sigmoidf_(acc[ai][1][m][1][j] * s); }
                    store8(GLU + (size_t)row * 512 + col0, o0, o1);
                }
        } else {
            const int col0 = (u.pn - 4) * 256 + wc * 32 + 8 * fq;
#pragma unroll
            for (int ai = 0; ai < 2; ++ai)
#pragma unroll
                for (int m = 0; m < 4; ++m) {
                    const int row = row0 + ai * 128 + m * 16; const float s = rs[row];
#pragma unroll
                    for (int bj = 0; bj < 2; ++bj) store8(QK + (size_t)row * 1024 + col0 + bj * 128, acc[ai][bj][m][0] * s, acc[ai][bj][m][1] * s);
                }
        }
    }
};
struct EpiVT {
    static constexpr bool PERM = true;
    bf16* O; const float* cs;
    DI void operator()(EPI_ARGS) const {
        const int row0 = u.pm * 256 + wr * 64 + fr, col0 = u.pn * 256 + wc * 32 + 8 * fq;
        f32x4 c[2][2];
#pragma unroll
        for (int bj = 0; bj < 2; ++bj) { c[bj][0] = *(const f32x4*)(cs + col0 + bj * 128); c[bj][1] = *(const f32x4*)(cs + col0 + bj * 128 + 4); }
#pragma unroll
        for (int ai = 0; ai < 2; ++ai)
#pragma unroll
            for (int m = 0; m < 4; ++m) {
                const int row = row0 + ai * 128 + m * 16;
#pragma unroll
                for (int bj = 0; bj < 2; ++bj) store8(O + (size_t)row * M + col0 + bj * 128, acc[ai][bj][m][0] * c[bj][0], acc[ai][bj][m][1] * c[bj][1]);
            }
    }
};
struct EpiPre {
    static constexpr bool PERM = true;
    bf16* base0;
    DI void operator()(EPI_ARGS) const {
        bf16* O = base0 + (size_t)((u.z >> 30) & 1) * (52u << 20) + (size_t)(u.z & 0x3fffffff);
        const int row0 = wr * 64 + fr, col0 = wc * 32 + 8 * fq;
#pragma unroll
        for (int ai = 0; ai < 2; ++ai)
#pragma unroll
            for (int m = 0; m < 4; ++m) {
                const int row = row0 + ai * 128 + m * 16;
#pragma unroll
                for (int bj = 0; bj < 2; ++bj) store8(O + (size_t)row * 1024 + col0 + bj * 128, acc[ai][bj][m][0], acc[ai][bj][m][1]);
            }
    }
};
struct EpiResid {
    static constexpr bool PERM = true;
    const float* xres; const bf16* hres; bf16* out; float* ps;
    DI void operator()(EPI_ARGS) const {
        const int row0 = u.pm * 256 + wr * 64 + fr, col0 = u.pn * 256 + wc * 32 + 8 * fq;
#pragma unroll
        for (int ai = 0; ai < 2; ++ai)
#pragma unroll
            for (int m = 0; m < 4; ++m) {
                const int row = row0 + ai * 128 + m * 16; const size_t off = (size_t)row * D + col0; float ss = 0.f;
#pragma unroll
                for (int bj = 0; bj < 2; ++bj) {
                    f32x4 r0, r1;
                    if (xres) { r0 = *(const f32x4*)(xres + off + bj * 128); r1 = *(const f32x4*)(xres + off + bj * 128 + 4); }
                    else { const u32x4 hw = *(const u32x4*)(hres + off + bj * 128); r0 = (f32x4){bflo(hw.x), bfhi(hw.x), bflo(hw.y), bfhi(hw.y)}; r1 = (f32x4){bflo(hw.z), bfhi(hw.z), bflo(hw.w), bfhi(hw.w)}; }
                    r0 = r0 + acc[ai][bj][m][0]; r1 = r1 + acc[ai][bj][m][1];
                    u32x4 w; w.x = pk2(r0[0], r0[1]); w.y = pk2(r0[2], r0[3]); w.z = pk2(r1[0], r1[1]); w.w = pk2(r1[2], r1[3]);
                    *(u32x4*)(out + off + bj * 128) = w;
                    if (ps) {
#pragma unroll
                        for (int q = 0; q < 4; ++q) { const float a = bflo(w[q]), b = bfhi(w[q]); ss += a * a + b * b; }
                    }
                }
                if (ps) { ss += swz_xor<16>(ss); ss = half_sum(ss); if (fq == 0) ps[(size_t)row * 16 + u.pn * 4 + wc] = ss; }
            }
    }
};
struct EpiSoftmax {
    static constexpr bool PERM = true;
    bf16* P; const float* ps;
    DI void operator()(EPI_ARGS) const {
        LAS f32x2* X = (LAS f32x2*)(lds + LDS_X);
        const int row0 = u.pm * 256, col0 = u.pn * 256 + wc * 32 + 8 * fq;
        float mw[2][4];
#pragma unroll
        for (int ai = 0; ai < 2; ++ai)
#pragma unroll
            for (int m = 0; m < 4; ++m) {
                const int rl = ai * 128 + wr * 64 + m * 16 + fr; const float s = rs_ps(ps, row0 + rl) * LOG2E;
                float mx = -3.0e38f;
#pragma unroll
                for (int bj = 0; bj < 2; ++bj)
#pragma unroll
                    for (int n = 0; n < 2; ++n) { acc[ai][bj][m][n] = acc[ai][bj][m][n] * s;
#pragma unroll
                        for (int j = 0; j < 4; ++j) mx = fmaxf(mx, acc[ai][bj][m][n][j]); }
                mx = fmaxf(mx, swz_xor<16>(mx)); mx = half_max(mx);
                float sum = 0.f;
#pragma unroll
                for (int bj = 0; bj < 2; ++bj)
#pragma unroll
                    for (int n = 0; n < 2; ++n)
#pragma unroll
                        for (int j = 0; j < 4; ++j) { const float p = fexp2(acc[ai][bj][m][n][j] - mx); acc[ai][bj][m][n][j] = p; sum += p; }
                sum += swz_xor<16>(sum); sum = half_sum(sum);
                mw[ai][m] = mx;
                if (fq == 0) X[rl * 4 + wc] = (f32x2){mx, sum};
            }
        asm volatile("s_waitcnt lgkmcnt(0)" ::: "memory"); __builtin_amdgcn_s_barrier(); asm volatile("" ::: "memory");
#pragma unroll
        for (int ai = 0; ai < 2; ++ai)
#pragma unroll
            for (int m = 0; m < 4; ++m) {
                const int rl = ai * 128 + wr * 64 + m * 16 + fr;
                const f32x2 a = X[rl * 4 + 0], b = X[rl * 4 + 1], c = X[rl * 4 + 2], d = X[rl * 4 + 3];
                const float mt = fmaxf(fmaxf(a.x, b.x), fmaxf(c.x, d.x));
                const float lt = a.y * fexp2(a.x - mt) + b.y * fexp2(b.x - mt) + c.y * fexp2(c.x - mt) + d.y * fexp2(d.x - mt);
                const float f = fexp2(mw[ai][m] - mt) / lt;
                bf16* rowp = P + (size_t)(row0 + rl) * 1024 + col0;
#pragma unroll
                for (int bj = 0; bj < 2; ++bj) store8(rowp + bj * 128, acc[ai][bj][m][0] * f, acc[ai][bj][m][1] * f);
            }
        asm volatile("s_waitcnt lgkmcnt(0)" ::: "memory"); __builtin_amdgcn_s_barrier(); asm volatile("" ::: "memory");
    }
};
struct EpiRwkv {
    static constexpr bool PERM = true;
    bf16* R; bf16* Kk; bf16* V; bf16* HD1; bf16* HD2;
    DI void operator()(EPI_ARGS) const {
        const int row0 = u.pm * 256 + wr * 64 + fr; const int g = u.pn >> 2;
        bf16* O; int ldc, colt, mode0 = 0, mode1 = 0;
        if (u.pn < 12) { O = R + (size_t)g * (32u << 20); ldc = 1024; colt = (u.pn & 3) * 256; }
        else if (u.pn == 12) { O = HD1; ldc = 256; colt = 0; mode0 = 1; }
        else { O = HD2; ldc = 256; colt = 0; mode0 = 2; mode1 = 2; }
        const int col0 = colt + wc * 32 + 8 * fq;
#pragma unroll
        for (int ai = 0; ai < 2; ++ai)
#pragma unroll
            for (int m = 0; m < 4; ++m) {
                bf16* rowp = O + (size_t)(row0 + ai * 128 + m * 16) * ldc + col0;
#pragma unroll
                for (int bj = 0; bj < 2; ++bj) { f32x4 v0 = acc[ai][bj][m][0], v1 = acc[ai][bj][m][1]; const int md = bj ? mode1 : mode0;
                    if (md == 1) {
#pragma unroll
                        for (int j = 0; j < 4; ++j) { v0[j] = tanhf_(v0[j]); v1[j] = tanhf_(v1[j]); } }
                    else if (md == 2) {
#pragma unroll
                        for (int j = 0; j < 4; ++j) { v0[j] = sigmoidf_(v0[j]); v1[j] = sigmoidf_(v1[j]); } }
                    store8(rowp + bj * 128, v0, v1); }
            }
    }
};

enum InIdx { I_X = 0, I_MEM, I_REL, I_NMIX, I_NXATTN, I_NMEM, I_NFFN, I_NFINAL, I_WIN, I_WOUT, I_CONVW, I_CONVB, I_CLNG, I_CLNB, I_LQ1, I_LK1, I_LQ2, I_LK2, I_SUBLN,
             I_MU, I_WR, I_WK, I_WV, I_WO, I_W0, I_W1, I_W2, I_A0, I_A1, I_A2, I_G1, I_G2, I_KK, I_KA, I_RK, I_LNG, I_LNB, I_XQ, I_XKV, I_XO, I_UP, I_DN, N_IN };
struct Args { const float* in[N_IN]; float* out; unsigned char* ws; int ph_lo, ph_hi; };
static_assert(sizeof(Args) == (N_IN + 2) * 8 + 8, "Args has no padding");

struct Frame {
    LAS unsigned char* lds;
    int tid, lane, wave, gw, ngw;
    unsigned char* ws;
};

DI Frame fresh(const Frame& F0) {
    Frame F = F0; F.tid = opaque(threadIdx.x); F.lane = F.tid & 63; F.wave = __builtin_amdgcn_readfirstlane(F.tid >> 6); F.gw = opq(blockIdx.x) * 8 + F.wave; F.ngw = opq(gridDim.x) * 8; return F;
}
struct TJob { const float* W; int K, N; bf16* WT; int ldt, row_off, col_off, perm; const float* gain; };
DI void tr_item(const TJob& J, LAS float* scr, int item, int lane) {
    const int nblk = J.N / 32, kb = item / nblk, nb = item % nblk, k0 = 64 * kb, n0 = 32 * nb;
    float scale = 1.0f; int drow = J.row_off + n0;
    if (J.perm) {
        if (n0 < 512) drow = 256 * (n0 >> 7) + (n0 & 127);
        else if (n0 < 1024) drow = 256 * ((n0 - 512) >> 7) + 128 + ((n0 - 512) & 127);
        else drow = n0;
        if (n0 >= 1024 && n0 < 1536) scale = 0.125f;
    }
    float tv[32];
    const float* wp = J.W + (size_t)(k0 + (lane >> 5)) * J.N + n0 + (lane & 31);
#pragma unroll
    for (int i = 0; i < 32; ++i) tv[i] = wp[(size_t)(2 * i) * J.N];
    if (J.gain) {
#pragma unroll
        for (int i = 0; i < 32; ++i) tv[i] *= J.gain[k0 + 2 * i + (lane >> 5)];
    }
#pragma unroll
    for (int i = 0; i < 32; ++i) scr[(2 * i + (lane >> 5)) * 33 + (lane & 31)] = tv[i] * scale;
    asm volatile("s_waitcnt lgkmcnt(0)" ::: "memory");
    const int c = lane & 7;
#pragma unroll
    for (int j = 0; j < 4; ++j) { const int n = (lane >> 3) + 8 * j; const LAS float* s = scr + (8 * c) * 33 + n;
        u32x4 o; o.x = pk2(s[0 * 33], s[1 * 33]); o.y = pk2(s[2 * 33], s[3 * 33]); o.z = pk2(s[4 * 33], s[5 * 33]); o.w = pk2(s[6 * 33], s[7 * 33]);
        *(u32x4*)(J.WT + (size_t)(drow + n) * J.ldt + J.col_off + k0 + 8 * c) = o; }
    asm volatile("s_waitcnt lgkmcnt(0)" ::: "memory");
}
constexpr int N_TJOBS = 31;
DI TJob get_tjob(int j, const Args& a, unsigned char* ws) {
    TJob J; J.perm = 0; J.gain = nullptr; J.row_off = 0; J.col_off = 0;
    if (j == 0) { J.W = a.in[opq(I_WIN)]; J.K = 1024; J.N = 2560; J.WT = (bf16*)(ws + WS_WIN); J.ldt = 1024; J.perm = 1; J.gain = a.in[opq(I_NMIX)]; }
    else if (j == 1) { J.W = a.in[opq(I_WOUT)]; J.K = 1024; J.N = 1024; J.WT = (bf16*)(ws + WS_WOUT); J.ldt = 1024; }
    else if (j < 4) { const int i = j - 2; J.W = a.in[opq(I_XKV)] + (size_t)i * 1024 * 2048; J.K = 1024; J.N = 2048; J.WT = (bf16*)(ws + WS_WKV) + (size_t)i * 2048 * 1024; J.ldt = 1024; J.gain = a.in[opq(I_NMEM)] + i * 1024; }
    else if (j < 6) { const int i = j - 4; J.W = a.in[opq(I_XO)] + (size_t)i * 1024 * 1024; J.K = 1024; J.N = 1024; J.WT = (bf16*)(ws + WS_WXO) + (size_t)i * 1024 * 1024; J.ldt = 1024; }
    else if (j < 8) { const int i = j - 6; J.W = a.in[opq(I_UP)] + (size_t)i * 1024 * 4096; J.K = 1024; J.N = 4096; J.WT = (bf16*)(ws + WS_WUP) + (size_t)i * 4096 * 1024; J.ldt = 1024; J.gain = a.in[opq(I_NFFN)] + i * 1024; }
    else if (j < 10) { const int i = j - 8; J.W = a.in[opq(I_DN)] + (size_t)i * 4096 * 1024; J.K = 4096; J.N = 1024; J.WT = (bf16*)(ws + WS_WDN) + (size_t)i * 1024 * 4096; J.ldt = 4096; }
    else if (j < 26) {
        const int q = j - 10, src = q >> 1, copy = q & 1; int mu = 0;
        J.K = 1024; J.WT = (bf16*)(ws + WS_WBIG); J.ldt = 2048; J.col_off = copy * 1024;
        if (src == 0) { J.W = a.in[opq(I_WR)]; J.N = 1024; J.row_off = 0; mu = 0; }
        else if (src == 1) { J.W = a.in[opq(I_WK)]; J.N = 1024; J.row_off = 1024; mu = 2; }
        else if (src == 2) { J.W = a.in[opq(I_WV)]; J.N = 1024; J.row_off = 2048; mu = 3; }
        else if (src == 3) { J.W = a.in[opq(I_W1)]; J.N = 64; J.row_off = 3072; mu = 1; }
        else if (src == 4) { J.W = a.in[opq(I_W1)] + 1024 * 64; J.N = 64; J.row_off = 3136; mu = 1; }
        else if (src == 5) { J.W = a.in[opq(I_A1)]; J.N = 64; J.row_off = 3200; mu = 4; }
        else if (src == 6) { J.W = a.in[opq(I_A1)] + 1024 * 64; J.N = 64; J.row_off = 3264; mu = 4; }
        else { J.W = a.in[opq(I_G1)]; J.N = 160; J.row_off = 3328; mu = 5; }
        if (copy) J.gain = a.in[opq(I_MU)] + mu * 1024;
    }
    else if (j < 30) { const int q = j - 26; J.W = (q < 2 ? a.in[opq(I_W2)] : a.in[opq(I_A2)]) + (size_t)(q & 1) * 64 * 1024; J.K = 64; J.N = 1024; J.WT = (bf16*)(ws + WS_W2T) + (size_t)q * 1024 * 64; J.ldt = 64; }
    else { J.W = a.in[opq(I_WO)]; J.K = 1024; J.N = 1024; J.WT = (bf16*)(ws + WS_WRO); J.ldt = 1024; }
    return J;
}
DI void row_to_bf16_rs(const float* xrow, bf16* orow, float* rs, int lane) {
    const f32x4* xr = (const f32x4*)xrow + lane;
    f32x4 v[4]; float s = 0.f;
#pragma unroll
    for (int j = 0; j < 4; ++j) { v[j] = xr[64 * j]; s += (v[j].x * v[j].x + v[j].y * v[j].y) + (v[j].z * v[j].z + v[j].w * v[j].w); }
    s = wave_sum(s);
    u32x2* o8 = (u32x2*)orow + lane;
#pragma unroll
    for (int j = 0; j < 4; ++j) { u32x2 w; w.x = pk2(v[j].x, v[j].y); w.y = pk2(v[j].z, v[j].w); o8[64 * j] = w; }
    if (lane == 0) *rs = 1.0f / sqrtf(s * (1.0f / D) + EPS);
}
DI void rows4_to_bf16_rs(const Frame& F, const float* X, bf16* O, float* rs, int nrows) {
    for (int m0 = F.gw * 4; m0 < nrows; m0 += F.ngw * 4) {
        f32x4 v[4][4];
#pragma unroll
        for (int r = 0; r < 4; ++r)
#pragma unroll
            for (int j = 0; j < 4; ++j) v[r][j] = ((const f32x4*)(X + (size_t)(m0 + r) * D))[F.lane + 64 * j];
#pragma unroll
        for (int r = 0; r < 4; ++r) {
            float s = 0.f;
#pragma unroll
            for (int j = 0; j < 4; ++j) s += (v[r][j].x * v[r][j].x + v[r][j].y * v[r][j].y) + (v[r][j].z * v[r][j].z + v[r][j].w * v[r][j].w);
            s = wave_sum(s);
            u32x2* o8 = (u32x2*)(O + (size_t)(m0 + r) * D) + F.lane;
#pragma unroll
            for (int j = 0; j < 4; ++j) { u32x2 w; w.x = pk2(v[r][j].x, v[r][j].y); w.y = pk2(v[r][j].z, v[r][j].w); o8[64 * j] = w; }
            if (F.lane == 0) rs[m0 + r] = 1.0f / sqrtf(s * (1.0f / D) + EPS);
        }
    }
}
DI int t5_bucket(int rel) {
    const int n = rel < 0 ? -rel : rel; int r = rel > 0 ? 16 : 0;
    if (n < 8) return r + n;
    int lg = 8; lg += (n >= 12); lg += (n >= 16); lg += (n >= 23); lg += (n >= 32); lg += (n >= 46); lg += (n >= 64); lg += (n >= 91);
    return r + lg;
}
DI void phase_prologue(const Frame& F0, const Args& a, unsigned char* ws) {
    const Frame F = fresh(F0);
    LAS float* scr = (LAS float*)(F.lds + F.wave * 16384);
    for (int j = 0; j < N_TJOBS; ++j) {
        const TJob J = get_tjob(j, a, ws); const int items = (J.K / 64) * (J.N / 32);
        for (int it = F.gw; it < items; it += F.ngw) tr_item(J, scr, it, F.lane);
    }
    const int gt = F.gw * 64 + F.lane, ngt = F.ngw * 64;
    for (int i = 0; i < 2; ++i) {
        const float* W = a.in[opq(I_XQ)] + (size_t)i * 1024 * 1024; const float* g = a.in[opq(I_NXATTN)] + i * 1024; bf16* O = (bf16*)(ws + WS_WQN) + (size_t)i * 1024 * 1024;
        for (int e = gt; e < 1024 * 1024 / 4; e += ngt) { const f32x4 v = ((const f32x4*)W)[e]; const float s = g[(e * 4) >> 10] * 0.0625f; u32x2 w; w.x = pk2(v.x * s, v.y * s); w.y = pk2(v.z * s, v.w * s); ((u32x2*)O)[e] = w; }
    }
    { const float* W = a.in[opq(I_G2)]; bf16* O = (bf16*)(ws + WS_G2T);
      for (int e = gt; e < 1024 * 256; e += ngt) { const int n = e >> 8, k = e & 255; O[e] = (bf16)(k < 160 ? f2bf(W[(size_t)k * 1024 + n]) : 0u); } }
    { u32x4* O = (u32x4*)((bf16*)(ws + WS_WBIG) + (size_t)3488 * 2048);
      for (int e = gt; e < 96 * 2048 * 2 / 16; e += ngt) O[e] = (u32x4){0u, 0u, 0u, 0u}; }
    rows4_to_bf16_rs(F, a.in[opq(I_X)], (bf16*)(ws + WS_SA), (float*)(ws + WS_RS), M);
    rows4_to_bf16_rs(F, a.in[opq(I_MEM)], (bf16*)(ws + WS_MEMB), (float*)(ws + WS_RSMEM), MMEM);
    { float* B = (float*)(ws + WS_BIAS); const float* tab = a.in[opq(I_REL)];
      for (int e = gt; e < 4 * 4096; e += ngt) { const int h = e >> 12, idx = e & 4095; const int rel = idx - 2047; B[e] = idx < 4095 ? tab[t5_bucket(rel) * 4 + h] * LOG2E : 0.f; } }
    if (F.gw == 0) {
        const float q1 = a.in[opq(I_LQ1)][F.lane] * a.in[opq(I_LK1)][F.lane], q2 = a.in[opq(I_LQ2)][F.lane] * a.in[opq(I_LK2)][F.lane];
        const float s1 = wave_sum(q1), s2 = wave_sum(q2);
        if (F.lane == 0) ((float*)(ws + WS_LAM))[0] = expf(s1) - expf(s2) + 0.2f;
    }
}

DI void phase_norm(const Frame& F0, const float* h, bf16* hb, float* rs) {
    const Frame F = fresh(F0);
    for (int m = F.gw; m < M; m += F.ngw) row_to_bf16_rs(h + (size_t)m * D, hb + (size_t)m * D, rs + m, F.lane);
}
DI void phase_final_norm(const Frame& F0, const bf16* h, float* out, const float* g, const float osc) {
    const Frame F = fresh(F0);
    f32x4 gv[4];
#pragma unroll
    for (int j = 0; j < 4; ++j) gv[j] = ((const f32x4*)g)[F.lane + 64 * j];
    for (int m0 = F.gw * 4; m0 < M; m0 += F.ngw * 4) {
        u32x2 hw[4][4];
#pragma unroll
        for (int r = 0; r < 4; ++r)
#pragma unroll
            for (int j = 0; j < 4; ++j) hw[r][j] = ((const u32x2*)(h + (size_t)(m0 + r) * D))[F.lane + 64 * j];
#pragma unroll
        for (int r = 0; r < 4; ++r) {
            f32x4 v[4]; float s = 0.f;
#pragma unroll
            for (int j = 0; j < 4; ++j) { v[j] = (f32x4){bflo(hw[r][j].x), bfhi(hw[r][j].x), bflo(hw[r][j].y), bfhi(hw[r][j].y)}; s += (v[j].x * v[j].x + v[j].y * v[j].y) + (v[j].z * v[j].z + v[j].w * v[j].w); }
            const float rr = osc / sqrtf(wave_sum(s) * (1.0f / D) + EPS);
            f32x4* xr = (f32x4*)(out + (size_t)(m0 + r) * D) + F.lane;
#pragma unroll
            for (int j = 0; j < 4; ++j) xr[64 * j] = v[j] * rr * gv[j];
        }
    }
}
DI void phase_rwkv_shift(const Frame& F0, const bf16* h, const float* g, bf16* A1) {
    const Frame F = fresh(F0);
    f32x4 gv[4];
#pragma unroll
    for (int j = 0; j < 4; ++j) gv[j] = ((const f32x4*)g)[F.lane + 64 * j];
    for (int ch = F.gw; ch < M / 16; ch += F.ngw) {
        const int m0 = ch * 16, t0 = m0 & (T - 1);
        f32x4 p2[4], p1[4], cu[4];
#pragma unroll
        for (int j = 0; j < 4; ++j) { p2[j] = (f32x4){0.f, 0.f, 0.f, 0.f}; p1[j] = p2[j]; cu[j] = p2[j]; }
#pragma unroll 1
        for (int g6 = 0; g6 < 3; ++g6) {
            f32x4 ld[6][4];
#pragma unroll
            for (int r = 0; r < 6; ++r) { const int i = g6 * 6 + r - 1, t = t0 + i; const bool ok = (t >= 0 && t < T);
#pragma unroll
                for (int j = 0; j < 4; ++j) { const u32x2 w = ok ? ((const u32x2*)(h + (size_t)(m0 + i) * D))[F.lane + 64 * j] : (u32x2){0u, 0u}; ld[r][j] = (f32x4){bflo(w.x), bfhi(w.x), bflo(w.y), bfhi(w.y)}; } }
#pragma unroll
            for (int r = 0; r < 6; ++r) {
                const int i = g6 * 6 + r - 1;
                float s = 0.f;
#pragma unroll
                for (int j = 0; j < 4; ++j) { p2[j] = p1[j]; p1[j] = cu[j]; cu[j] = ld[r][j]; s += (cu[j].x * cu[j].x + cu[j].y * cu[j].y) + (cu[j].z * cu[j].z + cu[j].w * cu[j].w); }
                const float rr = 1.0f / sqrtf(wave_sum(s) * (1.0f / D) + EPS);
#pragma unroll
                for (int j = 0; j < 4; ++j) cu[j] = cu[j] * rr * gv[j];
                if (i >= 1) {
                    u32x2* o = (u32x2*)(A1 + (size_t)(m0 + i - 1) * 2048) + F.lane;
#pragma unroll
                    for (int j = 0; j < 4; ++j) { const f32x4 hh = (p2[j] + cu[j]) * 0.5f - p1[j];
                        u32x2 w; w.x = pk2(p1[j].x, p1[j].y); w.y = pk2(p1[j].z, p1[j].w); o[64 * j] = w;
                        u32x2 w2; w2.x = pk2(hh.x, hh.y); w2.y = pk2(hh.z, hh.w); o[256 + 64 * j] = w2; }
                }
            }
        }
    }
}
DI void phase_rwkv_comb(const Frame& F0, const bf16* YF, const bf16* YB, const bf16* V, const bf16* GT, const float* BON, const float* lng, const float* lnb, bf16* O) {
    const Frame F = fresh(F0);
    const int hd = F.lane >> 2, c0 = F.lane * 16;
    float lg[16], lb[16];
#pragma unroll
    for (int j = 0; j < 16; ++j) { lg[j] = lng[c0 + j]; lb[j] = lnb[c0 + j]; }
    for (int m0 = F.gw * 2; m0 < M; m0 += F.ngw * 2) {
        u32x4 a[2][2], b[2][2], vv[2][2], gg[2][2]; float bonr[2];
#pragma unroll
        for (int r = 0; r < 2; ++r) { const size_t off = (size_t)(m0 + r) * D + c0;
#pragma unroll
            for (int q = 0; q < 2; ++q) { a[r][q] = ((const u32x4*)(YF + off))[q]; b[r][q] = ((const u32x4*)(YB + off))[q]; vv[r][q] = ((const u32x4*)(V + off))[q]; gg[r][q] = ((const u32x4*)(GT + off))[q]; }
            bonr[r] = BON[(size_t)(m0 + r) * 16 + hd] + BON[(size_t)(M + m0 + r) * 16 + hd]; }
#pragma unroll
        for (int r = 0; r < 2; ++r) {
            const size_t off = (size_t)(m0 + r) * D + c0; const float bon = bonr[r];
            float y[16]; float s = 0.f;
#pragma unroll
            for (int q = 0; q < 2; ++q)
#pragma unroll
                for (int w = 0; w < 4; ++w) { y[q * 8 + 2 * w] = bflo(a[r][q][w]) + bflo(b[r][q][w]); y[q * 8 + 2 * w + 1] = bfhi(a[r][q][w]) + bfhi(b[r][q][w]); }
#pragma unroll
            for (int j = 0; j < 16; ++j) s += y[j];
            s += swz_xor<1>(s); s += swz_xor<2>(s);
            const float mean = s * (1.0f / 64.0f); float q2 = 0.f;
#pragma unroll
            for (int j = 0; j < 16; ++j) { y[j] -= mean; q2 += y[j] * y[j]; }
            q2 += swz_xor<1>(q2); q2 += swz_xor<2>(q2);
            const float rstd = 1.0f / sqrtf(q2 * (1.0f / 64.0f) + 64e-5f);
            u32x4 o[2];
#pragma unroll
            for (int q = 0; q < 2; ++q)
#pragma unroll
                for (int w = 0; w < 4; ++w) {
                    const int j = q * 8 + 2 * w;
                    const float r0 = (y[j] * rstd * lg[j] + lb[j] + bon * bflo(vv[r][q][w])) * bflo(gg[r][q][w]);
                    const float r1 = (y[j + 1] * rstd * lg[j + 1] + lb[j + 1] + bon * bfhi(vv[r][q][w])) * bfhi(gg[r][q][w]);
                    o[q][w] = pk2(r0, r1);
                }
            ((u32x4*)(O + off))[0] = o[0]; ((u32x4*)(O + off))[1] = o[1];
        }
    }
}
constexpr int CV_ROWB = 1040, CV_IN_BYTES = 94 * CV_ROWB, CV_W_OFF = CV_IN_BYTES;
DI void conv_load_weights(const Frame& F0, const float* cw) {
    const Frame F = fresh(F0);
    LAS bf16* W = (LAS bf16*)(F.lds + CV_W_OFF);
    for (int e = F.tid; e < 31 * 512; e += 512) W[e] = (bf16)f2bf(cw[e]);
}
DI void conv_unit(const Frame& F0, int unit, const bf16* GLU, const float* cb, const float* lg, const float* lb, bf16* MIX) {
    const Frame F = fresh(F0);
    const int b = unit >> 5, t0 = (unit & 31) * 64;
    __syncthreads();
    for (int p = F.tid; p < 94 * 64; p += 512) {
        const int r = p >> 6, c = p & 63, t = t0 - 15 + r;
        u32x4 v = (u32x4){0u, 0u, 0u, 0u};
        if (t >= 0 && t < T) v = *(const u32x4*)(GLU + (size_t)(b * T + t) * 512 + c * 8);
        *(LAS u32x4*)(F.lds + r * CV_ROWB + c * 16) = v;
    }
    __syncthreads();
    const int tl = F.tid >> 3, chunk = F.tid & 7;
    float y[64];
#pragma unroll
    for (int i = 0; i < 8; ++i) {
        const int cg = chunk + 8 * i;
        float acc[8];
#pragma unroll
        for (int e = 0; e < 8; ++e) acc[e] = cb[cg * 8 + e];
#pragma unroll 1
        for (int j = 0; j < 31; ++j) {
            const u32x4 x = *(const LAS u32x4*)(F.lds + (tl + j) * CV_ROWB + cg * 16);
            const u32x4 w = *(const LAS u32x4*)(F.lds + CV_W_OFF + j * 1024 + cg * 16);
#pragma unroll
            for (int q = 0; q < 4; ++q) { acc[2 * q] += bflo(x[q]) * bflo(w[q]); acc[2 * q + 1] += bfhi(x[q]) * bfhi(w[q]); }
        }
#pragma unroll
        for (int e = 0; e < 8; ++e) y[i * 8 + e] = acc[e];
    }
    float s = 0.f;
#pragma unroll
    for (int j = 0; j < 64; ++j) s += y[j];
    s += swz_xor<1>(s); s += swz_xor<2>(s); s += swz_xor<4>(s);
    const float mean = s * (1.0f / 512.0f); float q2 = 0.f;
#pragma unroll
    for (int j = 0; j < 64; ++j) { y[j] -= mean; q2 += y[j] * y[j]; }
    q2 += swz_xor<1>(q2); q2 += swz_xor<2>(q2); q2 += swz_xor<4>(q2);
    const float rstd = 1.0f / sqrtf(q2 * (1.0f / 512.0f) + 1e-5f);
    bf16* orow = MIX + (size_t)(b * T + t0 + tl) * 1024;
#pragma unroll
    for (int i = 0; i < 8; ++i) {
        const int c0 = (chunk + 8 * i) * 8;
        const f32x4 g0 = *(const f32x4*)(lg + c0), g1 = *(const f32x4*)(lg + c0 + 4), b0 = *(const f32x4*)(lb + c0), b1 = *(const f32x4*)(lb + c0 + 4);
        f32x4 o0, o1;
#pragma unroll
        for (int e = 0; e < 4; ++e) { const float v0 = y[i * 8 + e] * rstd * g0[e] + b0[e], v1 = y[i * 8 + 4 + e] * rstd * g1[e] + b1[e]; o0[e] = v0 * sigmoidf_(v0); o1[e] = v1 * sigmoidf_(v1); }
        store8(orow + c0, o0, o1);
    }
}

constexpr int DA_KROW = 272, DA_VROW = 136, DA_KB = 64 * DA_KROW, DA_VB = 128 * DA_VROW, DA_BUF = DA_KB + DA_VB;
DI int crow(int reg, int hf) { return (reg & 3) + 8 * (reg >> 2) + 4 * hf; }
DI void diffattn_unit(const Frame& F0, int unit, const bf16* QK, const bf16* VT, const float* BIAS, const float lam, const float* subg, bf16* MIX) {
    const Frame F = fresh(F0);
    const int b = unit >> 6, h = (unit >> 4) & 3, qb = unit & 15;
    const int c = F.wave >> 2, qs = F.wave & 3, r32 = F.lane & 31, hf = F.lane >> 5;
    const int q0w = qb * 128 + qs * 32;
    const float* bias_h = BIAS + h * 4096 + 2047;
    bf16x8 Qf[4];
    { const bf16* qp = QK + (size_t)(b * T + q0w + r32) * 1024 + h * 128 + c * 64 + 8 * hf;
#pragma unroll
      for (int ks = 0; ks < 4; ++ks) Qf[ks] = *(const bf16x8*)(qp + 16 * ks); }
    const bf16* kg[2]; const bf16* vg[2]; int kl[2], vl[2];
#pragma unroll
    for (int i = 0; i < 2; ++i) { const int p = F.tid + 512 * i;
        kg[i] = QK + (size_t)(b * T + (p >> 4)) * 1024 + 512 + h * 128 + (p & 15) * 8; kl[i] = (p >> 4) * DA_KROW + (p & 15) * 16;
        vg[i] = VT + (size_t)(h * 128 + (p >> 3)) * M + b * T + (p & 7) * 8; vl[i] = DA_KB + (p >> 3) * DA_VROW + (p & 7) * 16; }
    u32x4 kr[2], vr[2];
#pragma unroll
    for (int i = 0; i < 2; ++i) { kr[i] = *(const u32x4*)(kg[i]); vr[i] = *(const u32x4*)(vg[i]); }
    __syncthreads();
#pragma unroll
    for (int i = 0; i < 2; ++i) { *(LAS u32x4*)(F.lds + kl[i]) = kr[i]; *(LAS u32x2*)(F.lds + vl[i]) = (u32x2){vr[i].x, vr[i].y}; *(LAS u32x2*)(F.lds + vl[i] + 8) = (u32x2){vr[i].z, vr[i].w}; }
    __syncthreads();
    f32x16 O[4];
#pragma unroll
    for (int vt = 0; vt < 4; ++vt)
#pragma unroll
        for (int i = 0; i < 16; ++i) O[vt][i] = 0.f;
    float lsum = 0.f;
    const int ka = r32 * DA_KROW + c * 128 + 16 * hf;
    const int va = DA_KB + r32 * DA_VROW + 8 * hf;
    for (int kt = 0; kt < 32; ++kt) {
        const int k0 = kt * 64;
        LAS unsigned char* buf = F.lds + (kt & 1) * DA_BUF;
        if (kt + 1 < 32) {
#pragma unroll
            for (int i = 0; i < 2; ++i) { kr[i] = *(const u32x4*)(kg[i] + (size_t)(k0 + 64) * 1024); vr[i] = *(const u32x4*)(vg[i] + k0 + 64); }
        }
        const int dmin = k0 - (q0w + 31), dmax = k0 + 63 - q0w;
        const bool far = (dmin >= 91) || (dmax <= -91);
        const float cb = dmin >= 91 ? bias_h[91] : bias_h[-91];
#pragma unroll
        for (int sub = 0; sub < 2; ++sub) {
            f32x16 S;
#pragma unroll
            for (int i = 0; i < 16; ++i) S[i] = 0.f;
#pragma unroll
            for (int ks = 0; ks < 4; ++ks) { const bf16x8 a = *(const LAS bf16x8*)(buf + ka + sub * 32 * DA_KROW + ks * 32); S = __builtin_amdgcn_mfma_f32_32x32x16_bf16(a, Qf[ks], S, 0, 0, 0); }
            float p[16];
            if (far) {
#pragma unroll
                for (int i = 0; i < 16; ++i) p[i] = fexp2(S[i] * LOG2E + cb);
            } else {
                const int rel0 = k0 + 32 * sub - (q0w + r32);
#pragma unroll
                for (int i = 0; i < 16; ++i) p[i] = fexp2(S[i] * LOG2E + bias_h[rel0 + crow(i, hf)]);
            }
#pragma unroll
            for (int i = 0; i < 16; ++i) lsum += p[i];
#pragma unroll
            for (int s = 0; s < 2; ++s) {
                u32x4 pw; pw.x = pk2(p[8 * s], p[8 * s + 1]); pw.y = pk2(p[8 * s + 2], p[8 * s + 3]); pw.z = pk2(p[8 * s + 4], p[8 * s + 5]); pw.w = pk2(p[8 * s + 6], p[8 * s + 7]);
                const bf16x8 pa = __builtin_bit_cast(bf16x8, pw);
#pragma unroll
                for (int vt = 0; vt < 4; ++vt) {
                    const LAS unsigned char* vp = buf + va + vt * 32 * DA_VROW + (32 * sub + 16 * s) * 2;
                    const u32x2 lo = *(const LAS u32x2*)(vp), hi = *(const LAS u32x2*)(vp + 16);
                    const u32x4 vw = (u32x4){lo.x, lo.y, hi.x, hi.y};
                    O[vt] = __builtin_amdgcn_mfma_f32_32x32x16_bf16(pa, __builtin_bit_cast(bf16x8, vw), O[vt], 0, 0, 0);
                }
            }
        }
        if (kt + 1 < 32) {
            LAS unsigned char* nb = F.lds + ((kt + 1) & 1) * DA_BUF;
#pragma unroll
            for (int i = 0; i < 2; ++i) { *(LAS u32x4*)(nb + kl[i]) = kr[i]; *(LAS u32x2*)(nb + vl[i]) = (u32x2){vr[i].x, vr[i].y}; *(LAS u32x2*)(nb + vl[i] + 8) = (u32x2){vr[i].z, vr[i].w}; }
        }
        __syncthreads();
    }
    lsum = half_sum(lsum);
    LAS float* XO = (LAS float*)F.lds;
    LAS float* LW = (LAS float*)(F.lds + 65536) + F.wave * 32;
    if (hf == 0) LW[r32] = 1.0f / lsum;
    asm volatile("s_waitcnt lgkmcnt(0)" ::: "memory");
    float il[16];
#pragma unroll
    for (int i = 0; i < 16; ++i) il[i] = LW[crow(i, hf)];
    if (c == 1) {
#pragma unroll
        for (int vt = 0; vt < 4; ++vt)
#pragma unroll
            for (int i = 0; i < 16; ++i) XO[(qs * 32 + crow(i, hf)) * 128 + vt * 32 + r32] = O[vt][i] * il[i];
    }
    __syncthreads();
    if (c == 0) {
        float ss[16];
#pragma unroll
        for (int i = 0; i < 16; ++i) ss[i] = 0.f;
#pragma unroll
        for (int vt = 0; vt < 4; ++vt)
#pragma unroll
            for (int i = 0; i < 16; ++i) { const float o = O[vt][i] * il[i] - lam * XO[(qs * 32 + crow(i, hf)) * 128 + vt * 32 + r32]; O[vt][i] = o; ss[i] += o * o; }
#pragma unroll
        for (int i = 0; i < 16; ++i) { float v = ss[i]; v += swz_xor<1>(v); v += swz_xor<2>(v); v += swz_xor<4>(v); v += swz_xor<8>(v); v += swz_xor<16>(v); ss[i] = 0.8f / sqrtf(v * (1.0f / 128.0f) + EPS); }
#pragma unroll
        for (int vt = 0; vt < 4; ++vt) {
            const float g = subg[vt * 32 + r32];
#pragma unroll
            for (int i = 0; i < 16; ++i) MIX[(size_t)(b * T + q0w + crow(i, hf)) * 1024 + 512 + h * 128 + vt * 32 + r32] = (bf16)f2bf(O[vt][i] * ss[i] * g);
        }
    }
}

constexpr int SC_VECB = 256, SC_STEPB = 6 * SC_VECB, SC_BUFB = 16 * SC_STEPB;
constexpr int SC_SCR_OFF = 4 * SC_BUFB, SC_SCR_W = 16 * 68 * 4;
DI float dpp_x1(float v) { return __builtin_bit_cast(float, __builtin_amdgcn_update_dpp(0, __builtin_bit_cast(int, v), 0xB1, 0xF, 0xF, true)); }
DI float dpp_x2(float v) { return __builtin_bit_cast(float, __builtin_amdgcn_update_dpp(0, __builtin_bit_cast(int, v), 0x4E, 0xF, 0xF, true)); }
DI float quad_sum(float v) { v += dpp_x1(v); v += dpp_x2(v); return v; }

DI float a_fmac(float acc, float a, float b) { return __builtin_fmaf(a, b, acc); }
DI float a_fma(float a, float b, float c) { return __builtin_fmaf(a, b, c); }
DI float a_mul(float a, float b) { return a * b; }
struct ScanPtrs { const bf16 *R, *K, *V, *HD1, *W2T; const float *w0, *a0, *kk, *ka, *rk; bf16 *YF, *YB; float* BON; unsigned* ERR; };

DI void scan_pair(const Frame& F0, int bh, const ScanPtrs& P) {
    const Frame F = fresh(F0);
    const int b = bh >> 4, h = bh & 15;
    __syncthreads();
    if (F.wave < 4) {
        const int z = F.wave >> 1, rh = F.wave & 1, rp = F.lane >> 2, jq = F.lane & 3, i0 = rh * 32 + 2 * rp;
        float S0[16], S1[16];
#pragma unroll
        for (int j = 0; j < 16; ++j) { S0[j] = 0.f; S1[j] = 0.f; }
        bf16* Y = z ? P.YB : P.YF;
        __builtin_amdgcn_s_barrier();
#ifdef MK_TPROBE
        unsigned long long tp_acc = 0ull, tp_phase0 = __builtin_amdgcn_s_memtime();
#endif
        for (int e = 0; e < T / 16; ++e) {
#ifdef MK_TPROBE
            const unsigned long long tp0 = __builtin_amdgcn_s_memtime();
#endif
            const LAS unsigned char* base = F.lds + (z * 2 + (e & 1)) * SC_BUFB + jq * 64;
            const int t0c = z ? T - 16 * (e + 1) : 16 * e;
            bf16* yrow = Y + (size_t)(b * T + t0c) * 1024 + h * 64 + i0;
            f32x4 wv[2][4], kv[2][4], bv[2][4], av[2][4], rv[2][4]; f32x2 v2[2];
#define SC_FETCH(slot, li_) do { const LAS unsigned char* sb_ = base + (li_) * SC_STEPB; _Pragma("unroll") for (int q = 0; q < 4; ++q) { \
                av[slot][q] = *(const LAS f32x4*)(sb_ + 3 * SC_VECB + q * 16); wv[slot][q] = *(const LAS f32x4*)(sb_ + q * 16); kv[slot][q] = *(const LAS f32x4*)(sb_ + SC_VECB + q * 16); \
                bv[slot][q] = *(const LAS f32x4*)(sb_ + 2 * SC_VECB + q * 16); rv[slot][q] = *(const LAS f32x4*)(sb_ + 4 * SC_VECB + q * 16); } \
                v2[slot] = *(const LAS f32x2*)(sb_ - jq * 64 + 5 * SC_VECB + i0 * 4); } while (0)
            SC_FETCH(0, z ? 15 : 0);
#pragma unroll
            for (int s = 0; s < 16; ++s) {
                const int li = z ? 15 - s : s, cs = s & 1, ns = cs ^ 1;
                if (s < 15) SC_FETCH(ns, z ? 14 - s : s + 1);
                __builtin_amdgcn_sched_barrier(0);
                float sa0 = 0.f, sa1 = 0.f, sb0 = 0.f, sb1 = 0.f;
#pragma unroll
                for (int j = 0; j < 16; j += 2) { const float a0 = av[cs][j >> 2][j & 3], a1 = av[cs][(j + 1) >> 2][(j + 1) & 3];
                    sa0 = a_fmac(sa0, S0[j], a0); sb0 = a_fmac(sb0, S1[j], a0); sa1 = a_fmac(sa1, S0[j + 1], a1); sb1 = a_fmac(sb1, S1[j + 1], a1); }
                const float sa = quad_sum(sa0 + sa1), sb = quad_sum(sb0 + sb1);
                const float v0 = v2[cs].x, v1 = v2[cs].y;
                float y0 = 0.f, y1 = 0.f, z0 = 0.f, z1 = 0.f;
#pragma unroll
                for (int j = 0; j < 16; ++j) {
                    const float wj = wv[cs][j >> 2][j & 3], bj = bv[cs][j >> 2][j & 3], kj = kv[cs][j >> 2][j & 3], rj = rv[cs][j >> 2][j & 3];
                    S0[j] = a_fma(S0[j], wj, a_fma(sa, bj, a_mul(v0, kj)));
                    S1[j] = a_fma(S1[j], wj, a_fma(sb, bj, a_mul(v1, kj)));
                    if (j & 1) { y1 = a_fmac(y1, S0[j], rj); z1 = a_fmac(z1, S1[j], rj); } else { y0 = a_fmac(y0, S0[j], rj); z0 = a_fmac(z0, S1[j], rj); }
                }
                f32x2 y; y.x = quad_sum(y0 + y1); y.y = quad_sum(z0 + z1);
                if (jq == 0) *(unsigned*)(yrow + (size_t)li * 1024) = pk2(y.x, y.y);
                __builtin_amdgcn_sched_barrier(0);
            }
#undef SC_FETCH
            asm volatile("s_waitcnt lgkmcnt(0)" ::: "memory");
#ifdef MK_TPROBE
            tp_acc += __builtin_amdgcn_s_memtime() - tp0;
#endif
            __builtin_amdgcn_s_barrier();
        }
#ifdef MK_TPROBE
        if (blockIdx.x == 0 && F.wave == 0) {
            const unsigned long long tot = __builtin_amdgcn_s_memtime() - tp_phase0;
            const unsigned long long amt = (MK_TPROBE > 0 ? (unsigned long long)MK_TPROBE * tp_acc : (unsigned long long)(-(MK_TPROBE)) * (tot - tp_acc));
            const unsigned long long w0 = __builtin_amdgcn_s_memtime();
            while (__builtin_amdgcn_s_memtime() - w0 < amt) __builtin_amdgcn_s_sleep(8);
        }
#endif
    } else {
        const int pw = F.wave - 4, z = pw >> 1, par = pw & 1;
        const int l15 = F.lane & 15, l4 = F.lane >> 4, row = F.lane >> 2, cq = F.lane & 3;
        const bf16* w2p = P.W2T + (size_t)z * 65536 + (size_t)(h * 64 + l15) * 64 + 8 * l4;
        const int ch0 = h * 64 + cq * 16;
        LAS float* scrW = (LAS float*)(F.lds + SC_SCR_OFF + pw * 2 * SC_SCR_W);
        LAS float* scrA = scrW + 16 * 68;
        bf16x8 Ahw[2], Aha[2]; u32x4 r16[2], k16[2], v16[2];
        auto do_load = [&](int c) {
            const int t0c = z ? T - 16 * (c + 1) : 16 * c; const size_t m0 = (size_t)b * T + t0c;
#pragma unroll
            for (int ks = 0; ks < 2; ++ks) { const bf16* p = P.HD1 + (m0 + l15) * 256 + z * 64 + 32 * ks + 8 * l4; Ahw[ks] = *(const bf16x8*)p; Aha[ks] = *(const bf16x8*)(p + 128); }
            const size_t off = (m0 + row) * 1024 + ch0;
#pragma unroll
            for (int q = 0; q < 2; ++q) { r16[q] = ((const u32x4*)(P.R + off))[q]; k16[q] = ((const u32x4*)(P.K + off))[q]; v16[q] = ((const u32x4*)(P.V + off))[q]; }
        };
        auto do_compute = [&](int c) {
            const int t0c = z ? T - 16 * (c + 1) : 16 * c; const size_t m0 = (size_t)b * T + t0c;
#pragma unroll
            for (int nt = 0; nt < 4; ++nt) {
                f32x4 dw = (f32x4){0.f, 0.f, 0.f, 0.f}, da = dw;
#pragma unroll
                for (int ks = 0; ks < 2; ++ks) { const bf16x8 wf = *(const bf16x8*)(w2p + nt * 1024 + ks * 32), af = *(const bf16x8*)(w2p + 2 * 65536 + nt * 1024 + ks * 32);
                    dw = __builtin_amdgcn_mfma_f32_16x16x32_bf16(Ahw[ks], wf, dw, 0, 0, 0); da = __builtin_amdgcn_mfma_f32_16x16x32_bf16(Aha[ks], af, da, 0, 0, 0); }
#pragma unroll
                for (int rg = 0; rg < 4; ++rg) { scrW[(4 * l4 + rg) * 68 + 16 * nt + l15] = dw[rg]; scrA[(4 * l4 + rg) * 68 + 16 * nt + l15] = da[rg]; }
            }
            asm volatile("s_waitcnt lgkmcnt(0)" ::: "memory");
            float ssq = 0.f;
#pragma unroll
            for (int q = 0; q < 2; ++q)
#pragma unroll
                for (int w = 0; w < 4; ++w) { const f32x2 kc = *(const f32x2*)(P.kk + ch0 + q * 8 + 2 * w); const float k0 = bflo(k16[q][w]) * kc.x, k1 = bfhi(k16[q][w]) * kc.y; ssq += k0 * k0 + k1 * k1; }
            ssq = quad_sum(ssq);
            const float inv = 1.0f / fmaxf(sqrtf(ssq), 1e-12f);
            float bon = 0.f;
            LAS unsigned char* sb = F.lds + (z * 2 + (c & 1)) * SC_BUFB + row * SC_STEPB + cq * 64;
#pragma unroll
            for (int q = 0; q < 4; ++q) {
                const f32x4 wp = *(const LAS f32x4*)(scrW + row * 68 + cq * 16 + q * 4), ap = *(const LAS f32x4*)(scrA + row * 68 + cq * 16 + q * 4);
                const f32x4 w0v = *(const f32x4*)(P.w0 + z * 1024 + ch0 + q * 4), a0v = *(const f32x4*)(P.a0 + z * 1024 + ch0 + q * 4);
                const f32x4 kkv = *(const f32x4*)(P.kk + ch0 + q * 4), kav = *(const f32x4*)(P.ka + ch0 + q * 4), rkv = *(const f32x4*)(P.rk + ch0 + q * 4);
                const unsigned kw0 = k16[q >> 1][(q & 1) * 2], kw1 = k16[q >> 1][(q & 1) * 2 + 1], rw0 = r16[q >> 1][(q & 1) * 2], rw1 = r16[q >> 1][(q & 1) * 2 + 1], vw0 = v16[q >> 1][(q & 1) * 2], vw1 = v16[q >> 1][(q & 1) * 2 + 1];
                const f32x4 kf = (f32x4){bflo(kw0), bfhi(kw0), bflo(kw1), bfhi(kw1)}, rf = (f32x4){bflo(rw0), bfhi(rw0), bflo(rw1), bfhi(rw1)}, vf = (f32x4){bflo(vw0), bfhi(vw0), bflo(vw1), bfhi(vw1)};
                f32x4 ow, ok, ob, oa;
#pragma unroll
                for (int j = 0; j < 4; ++j) {
                    const float dec = fexp2(-0.60653066f * LOG2E * sigmoidf_(wp[j] + w0v[j]));
                    const float ar = sigmoidf_(ap[j] + a0v[j]);
                    const float kkn = kf[j] * kkv[j] * inv;
                    const float kd = kf[j] * (1.0f + (ar - 1.0f) * kav[j]);
                    ow[j] = dec; ok[j] = kd; ob[j] = kkn * ar; oa[j] = -kkn;
                    bon += rf[j] * kd * rkv[j];
                }
                *(LAS f32x4*)(sb + q * 16) = ow; *(LAS f32x4*)(sb + SC_VECB + q * 16) = ok; *(LAS f32x4*)(sb + 2 * SC_VECB + q * 16) = ob;
                *(LAS f32x4*)(sb + 3 * SC_VECB + q * 16) = oa; *(LAS f32x4*)(sb + 4 * SC_VECB + q * 16) = rf; *(LAS f32x4*)(sb + 5 * SC_VECB + q * 16) = vf;
            }
            bon = quad_sum(bon);
            if (cq == 0) P.BON[((size_t)z * M + m0 + row) * 16 + h] = bon;
            asm volatile("s_waitcnt lgkmcnt(0)" ::: "memory");
        };
        if (par == 0) { do_load(0); do_compute(0); } else do_load(1);
        __builtin_amdgcn_s_barrier();
        for (int e = 0; e < T / 16; ++e) {
            if (((e + 1) & 1) == par) { if (e + 1 < T / 16) do_compute(e + 1); }
            else { if (e + 2 < T / 16) do_load(e + 2); }
            __builtin_amdgcn_s_barrier();
        }
    }
}


constexpr int CS_AT = 0, CS_RT = 2304, CS_BK = 4608, CS_SMQ = 9728, CS_SMT = 11008, CS_NQ = 12288, CS_VT = 13568, CS_GL = 16640, CS_BUF = 16896;
constexpr int CS_PZ = 6 * CS_BUF;
constexpr int CS_W = CS_PZ + 4 * 4608;
constexpr int CS_WSZ = 4864;
constexpr int CS_BON = CS_W + 8 * CS_WSZ;
static_assert(CS_BON + 1536 <= LDS_MISC, "chunked-scan LDS map");
template <int CTRL> DI float dpp_mov0(float v) { return __builtin_bit_cast(float, __builtin_amdgcn_update_dpp(0, __builtin_bit_cast(int, v), CTRL, 0xF, 0xF, false)); }
DI float row_prefix(float v) { v += dpp_mov0<0x111>(v); v += dpp_mov0<0x112>(v); v += dpp_mov0<0x114>(v); v += dpp_mov0<0x118>(v); return v; }
DI float row_suffix(float v) { v += dpp_mov0<0x101>(v); v += dpp_mov0<0x102>(v); v += dpp_mov0<0x104>(v); v += dpp_mov0<0x108>(v); return v; }
DI bf16x8 lds16(const LAS unsigned char* p) { return *(const LAS bf16x8*)p; }
DI f32x4 mfma16(bf16x8 a, bf16x8 b, f32x4 c) { return __builtin_amdgcn_mfma_f32_16x16x32_bf16(a, b, c, 0, 0, 0); }

DI void scan_pair_mfma(const Frame& F0, int bh, const ScanPtrs& P) {
    const Frame F = fresh(F0);
    const int b = bh >> 4, h = bh & 15;
    const int z = F.wave >> 2, q4 = F.wave & 3;
    const int l15 = F.lane & 15, l4 = F.lane >> 4;
    const int te = l15, cg = l4, c4 = cg * 4;
    const int rr = z ? 15 - te : te;
    const int jl = 16 * q4 + c4;
    const int chq = h * 64 + 16 * q4;
    LAS unsigned char* const L = F.lds;
    LAS unsigned char* const wsc = L + CS_W + F.wave * CS_WSZ;
    LAS float* const scrW = (LAS float*)wsc; LAS float* const scrA = scrW + 16 * 20;
    LAS unsigned char* const ZB = wsc; LAS unsigned char* const XB = wsc + 2304; LAS unsigned char* const UB = wsc + 3072;
    LAS float* const yst = (LAS float*)(wsc + 3840);
    LAS float* const bonp = (LAS float*)(L + CS_BON);
    bf16* Y = z ? P.YB : P.YF;
    const bf16* w2p = P.W2T + (size_t)z * 65536 + (size_t)(chq + l15) * 64 + 8 * l4;
    bf16x8 Wf[2], Af[2];
#pragma unroll
    for (int ks = 0; ks < 2; ++ks) { Wf[ks] = *(const bf16x8*)(w2p + ks * 32); Af[ks] = *(const bf16x8*)(w2p + 2 * 65536 + ks * 32); }
    const f32x4 w0v = *(const f32x4*)(P.w0 + z * 1024 + chq + c4), a0v = *(const f32x4*)(P.a0 + z * 1024 + chq + c4);
    const f32x4 kkv = *(const f32x4*)(P.kk + chq + c4), kav = *(const f32x4*)(P.ka + chq + c4), rkv = *(const f32x4*)(P.rk + chq + c4);
    f32x4 kcn[4];
#pragma unroll
    for (int q = 0; q < 4; ++q) kcn[q] = *(const f32x4*)(P.kk + h * 64 + 16 * cg + q * 4);
    f32x4 Z[4];
#pragma unroll
    for (int jt = 0; jt < 4; ++jt) Z[jt] = (f32x4){0.f, 0.f, 0.f, 0.f};
    bf16x8 Ahw[2], Aha[2]; u32x2 r4, k4, v4; u32x4 kfull[2];
    auto do_load = [&](int c) {
        const int t0c = z ? T - 16 * (c + 1) : 16 * c; const size_t m0 = (size_t)b * T + t0c;
#pragma unroll
        for (int ks = 0; ks < 2; ++ks) { const bf16* p = P.HD1 + (m0 + l15) * 256 + z * 64 + 32 * ks + 8 * l4; Ahw[ks] = *(const bf16x8*)p; Aha[ks] = *(const bf16x8*)(p + 128); }
        const size_t off = (m0 + rr) * 1024;
        r4 = *(const u32x2*)(P.R + off + chq + c4); k4 = *(const u32x2*)(P.K + off + chq + c4); v4 = *(const u32x2*)(P.V + off + chq + c4);
        kfull[0] = ((const u32x4*)(P.K + off + h * 64 + 16 * cg))[0]; kfull[1] = ((const u32x4*)(P.K + off + h * 64 + 16 * cg))[1];
    };
    auto prep_a = [&](int c) {
        LAS unsigned char* const bp = L + (z * 3 + c % 3) * CS_BUF;
        LAS unsigned char* const pz = L + CS_PZ + (z * 2 + (c & 1)) * 4608;
        f32x4 dw = (f32x4){0.f, 0.f, 0.f, 0.f}, da = dw;
#pragma unroll
        for (int ks = 0; ks < 2; ++ks) { dw = mfma16(Ahw[ks], Wf[ks], dw); da = mfma16(Aha[ks], Af[ks], da); }
#pragma unroll
        for (int rg = 0; rg < 4; ++rg) { scrW[(4 * l4 + rg) * 20 + l15] = dw[rg]; scrA[(4 * l4 + rg) * 20 + l15] = da[rg]; }
        float ssq = 0.f;
#pragma unroll
        for (int q = 0; q < 2; ++q)
#pragma unroll
            for (int w = 0; w < 4; ++w) { const float k0 = bflo(kfull[q][w]) * kcn[q * 2 + (w >> 1)][(w & 1) * 2], k1 = bfhi(kfull[q][w]) * kcn[q * 2 + (w >> 1)][(w & 1) * 2 + 1]; ssq += k0 * k0 + k1 * k1; }
        ssq += swz_xor<16>(ssq); ssq = half_sum(ssq);
        const float inv = __builtin_amdgcn_rsqf(fmaxf(ssq, 1e-24f));
        asm volatile("s_waitcnt lgkmcnt(0)" ::: "memory");
        const f32x4 wp = *(const LAS f32x4*)(scrW + rr * 20 + c4), ap = *(const LAS f32x4*)(scrA + rr * 20 + c4);
        const f32x4 kf = (f32x4){bflo(k4.x), bfhi(k4.x), bflo(k4.y), bfhi(k4.y)}, rf = (f32x4){bflo(r4.x), bfhi(r4.x), bflo(r4.y), bfhi(r4.y)}, vf = (f32x4){bflo(v4.x), bfhi(v4.x), bflo(v4.y), bfhi(v4.y)};
        f32x4 at, rt, bt, kt, bhh, khh, gl; float bon = 0.f;
#pragma unroll
        for (int j = 0; j < 4; ++j) {
            const float lw = -0.60653066f * LOG2E * sigmoidf_(wp[j] + w0v[j]);
            const float ar = sigmoidf_(ap[j] + a0v[j]);
            const float kkn = kf[j] * kkv[j] * inv;
            const float kd = kf[j] * (1.0f + (ar - 1.0f) * kav[j]);
            const float bvec = kkn * ar, avec = -kkn;
#ifdef MK_LDSPREFIX
            scrW[te * 20 + c4 + j] = lw;
            asm volatile("s_waitcnt lgkmcnt(0)" ::: "memory");
            float pi = 0.f, su = 0.f;
            for (int s2 = 0; s2 < 16; ++s2) { const float x = scrW[s2 * 20 + c4 + j]; if (s2 <= te) pi += x; else su += x; }
            asm volatile("s_waitcnt lgkmcnt(0)" ::: "memory");
#else
            const float pi = row_prefix(lw), su = row_suffix(lw) - lw;
#endif
            const float eI = fexp2(pi), eE = fexp2(pi - lw), eN = frcp(eI), eS = fexp2(su);
            at[j] = avec * eE; rt[j] = rf[j] * eI; bt[j] = bvec * eN; kt[j] = kd * eN; bhh[j] = bvec * eS; khh[j] = kd * eS; gl[j] = eI * eS;
            bon += rf[j] * kd * rkv[j];
        }
        const int co = jl * 2;
        { u32x2 w; w.x = pk2(at[0], at[1]); w.y = pk2(at[2], at[3]); *(LAS u32x2*)(bp + CS_AT + te * 144 + co) = w; }
        { u32x2 w; w.x = pk2(rt[0], rt[1]); w.y = pk2(rt[2], rt[3]); *(LAS u32x2*)(bp + CS_RT + te * 144 + co) = w; }
        { u32x2 w; w.x = pk2(bt[0], bt[1]); w.y = pk2(bt[2], bt[3]); *(LAS u32x2*)(pz + te * 144 + co) = w; }
        { u32x2 w; w.x = pk2(kt[0], kt[1]); w.y = pk2(kt[2], kt[3]); *(LAS u32x2*)(pz + 2304 + te * 144 + co) = w; }
#pragma unroll
        for (int j = 0; j < 4; ++j) {
            const unsigned bk = pk2(bhh[j], khh[j]);
            *(LAS bf16*)(bp + CS_BK + (jl + j) * 80 + te * 2) = (bf16)(bk & 0xffffu);
            *(LAS bf16*)(bp + CS_BK + (jl + j) * 80 + 32 + te * 2) = (bf16)(bk >> 16);
        }
        *(LAS bf16*)(bp + CS_VT + (jl + 0) * 48 + te * 2) = (bf16)(v4.x & 0xffffu); *(LAS bf16*)(bp + CS_VT + (jl + 1) * 48 + te * 2) = (bf16)(v4.x >> 16);
        *(LAS bf16*)(bp + CS_VT + (jl + 2) * 48 + te * 2) = (bf16)(v4.y & 0xffffu); *(LAS bf16*)(bp + CS_VT + (jl + 3) * 48 + te * 2) = (bf16)(v4.y >> 16);
        if (te == 0) *(LAS f32x4*)(bp + CS_GL + jl * 4) = gl;
        bon += swz_xor<16>(bon); bon = half_sum(bon);
        if (cg == 0) bonp[((z * 3 + c % 3) * 4 + q4) * 16 + rr] = bon;
    };
    auto prep_b = [&](int c) {
        LAS unsigned char* const bp = L + (z * 3 + c % 3) * CS_BUF;
        const LAS unsigned char* const pz = L + CS_PZ + (z * 2 + (c & 1)) * 4608;
        const int r32 = F.lane & 31, hf = F.lane >> 5;
        const LAS unsigned char* pa = (r32 < 16 ? bp + CS_AT + r32 * 144 : bp + CS_RT + (r32 - 16) * 144) + 16 * hf;
        const LAS unsigned char* pb = (r32 < 16 ? pz + r32 * 144 : pz + 2304 + (r32 - 16) * 144) + 16 * hf;
        f32x16 Dm;
#pragma unroll
        for (int i = 0; i < 16; ++i) Dm[i] = 0.f;
#pragma unroll
        for (int ks = 0; ks < 4; ++ks) Dm = __builtin_amdgcn_mfma_f32_32x32x16_bf16(lds16(pa + 32 * ks), lds16(pb + 32 * ks), Dm, 0, 0, 0);
        const int sc = r32 & 15;
#pragma unroll
        for (int reg = 0; reg < 8; reg += 2) { const int t = crow(reg, hf);
            if (r32 >= 16) { const unsigned w = pk2(sc < t ? Dm[reg] : 0.f, sc < t + 1 ? Dm[reg + 1] : 0.f);
                *(LAS bf16*)(bp + CS_SMQ + t * 80 + sc * 2) = (bf16)(w & 0xffffu); *(LAS bf16*)(bp + CS_SMQ + (t + 1) * 80 + sc * 2) = (bf16)(w >> 16); } }
#pragma unroll
        for (int reg = 8; reg < 16; reg += 2) { const int t = crow(reg, hf) - 16;
            const unsigned w = pk2(sc <= t ? Dm[reg] : 0.f, sc <= t + 1 ? Dm[reg + 1] : 0.f);
            *(LAS bf16*)(bp + CS_NQ + t * 80 + r32 * 2) = (bf16)(w & 0xffffu); *(LAS bf16*)(bp + CS_NQ + (t + 1) * 80 + r32 * 2) = (bf16)(w >> 16); }
#pragma unroll
        for (int reg = 0; reg < 8; ++reg) { if (r32 < 16) scrW[crow(reg, hf) * 16 + r32] = Dm[reg]; }
        asm volatile("s_waitcnt lgkmcnt(0)" ::: "memory");
        float Tr[16];
        f32x4 nr[2][4];
#pragma unroll
        for (int r = 0; r < 2; ++r)
#pragma unroll
            for (int q = 0; q < 4; ++q) nr[r][q] = (4 * q < r) ? *(const LAS f32x4*)(scrW + r * 16 + q * 4) : (f32x4){0.f, 0.f, 0.f, 0.f};
#pragma unroll
        for (int t = 0; t < 16; ++t) {
            float acc = (sc == t) ? 1.0f : 0.0f, acc1 = 0.f;
#pragma unroll
            for (int s2 = 0; s2 < t; ++s2) { const float n = nr[t & 1][s2 >> 2][s2 & 3];
                if ((s2 & 1) == 0) acc = __builtin_fmaf(n, Tr[s2], acc); else acc1 = __builtin_fmaf(n, Tr[s2], acc1); }
            acc += acc1;
            Tr[t] = acc;
            if (t + 2 < 16) {
#pragma unroll
                for (int q = 0; q < 4; ++q) if (4 * q < t + 2) nr[t & 1][q] = *(const LAS f32x4*)(scrW + (t + 2) * 16 + q * 4);
            }
            if ((t & 1) && F.lane < 16) { const unsigned w = pk2(Tr[t - 1], acc);
                *(LAS bf16*)(bp + CS_SMT + (t - 1) * 80 + sc * 2) = (bf16)(w & 0xffffu); *(LAS bf16*)(bp + CS_SMT + t * 80 + sc * 2) = (bf16)(w >> 16); }
        }
    };
    auto stage_s = [&](int c) {
        const LAS unsigned char* const bp = L + (z * 3 + c % 3) * CS_BUF;
        const int q = l4, i = l15;
#pragma unroll
        for (int jt = 0; jt < 4; ++jt) { u32x2 w; w.x = pk2(Z[jt][0], Z[jt][1]); w.y = pk2(Z[jt][2], Z[jt][3]); *(LAS u32x2*)(ZB + i * 144 + (16 * jt + 4 * q) * 2) = w; }
        asm volatile("" ::: "memory");
        const bf16x8 Zb0 = lds16(ZB + i * 144 + (8 * q) * 2), Zb1 = lds16(ZB + i * 144 + (32 + 8 * q) * 2);
        const bf16x8 Vb = lds16(bp + CS_VT + (16 * q4 + i) * 48 + 8 * (q & 1) * 2);
        const LAS unsigned char* arow = bp + l15 * 144 + 8 * q * 2;
        const f32x4 zero = (f32x4){0.f, 0.f, 0.f, 0.f};
        f32x4 X = mfma16(lds16(arow + CS_AT), Zb0, zero); X = mfma16(lds16(arow + CS_AT + 64), Zb1, X);
        X = mfma16(lds16(bp + CS_SMQ + l15 * 80 + 16 * q), Vb, X);
        { u32x2 w; w.x = pk2(X[0], X[1]); w.y = pk2(X[2], X[3]); *(LAS u32x2*)(XB + i * 48 + 8 * q) = w; }
        asm volatile("" ::: "memory");
        const bf16x8 Xb = lds16(XB + i * 48 + 16 * (q & 1));
        const f32x4 U = mfma16(lds16(bp + CS_SMT + l15 * 80 + 16 * q), Xb, zero);
        { u32x2 w; w.x = pk2(U[0], U[1]); w.y = pk2(U[2], U[3]); *(LAS u32x2*)(UB + i * 48 + 8 * q) = w; }
        asm volatile("" ::: "memory");
        const bf16x8 Ub = lds16(UB + i * 48 + 16 * (q & 1));
        const bf16x8 UVb = q < 2 ? Ub : Vb;
        f32x4 Yv = mfma16(lds16(arow + CS_RT), Zb0, zero); Yv = mfma16(lds16(arow + CS_RT + 64), Zb1, Yv);
        Yv = mfma16(lds16(bp + CS_NQ + l15 * 80 + 16 * q), UVb, Yv);
#pragma unroll
        for (int r = 0; r < 4; ++r) yst[(4 * q + r) * 16 + i] = Yv[r];
#pragma unroll
        for (int jt = 0; jt < 4; ++jt) { const f32x4 g = *(const LAS f32x4*)(bp + CS_GL + (16 * jt + 4 * q) * 4);
            Z[jt] = mfma16(lds16(bp + CS_BK + (16 * jt + l15) * 80 + 16 * q), UVb, Z[jt] * g); }
    };
    auto flush_y = [&](int c) {
        const int t0c = z ? T - 16 * (c + 1) : 16 * c; const int st = F.lane >> 2, i4 = (F.lane & 3) * 4;
        f32x4 yv = *(const LAS f32x4*)(yst + st * 16 + i4);
#ifdef MK_CLAMPY
        for (int j = 0; j < 4; ++j) yv[j] = (yv[j] == yv[j]) ? fminf(fmaxf(yv[j], -1.0e4f), 1.0e4f) : 0.f;
#endif
#ifdef MK_SCANCHECK
        { const u32x2 ref = *(const u32x2*)(Y + (size_t)(b * T + t0c + (z ? 15 - st : st)) * 1024 + chq + i4);
          const float r0 = bflo(ref.x), r1 = bfhi(ref.x), r2 = bflo(ref.y), r3 = bfhi(ref.y);
          float er = fmaxf(fmaxf(fabsf(yv.x - r0) / (fabsf(r0) + 1.0f), fabsf(yv.y - r1) / (fabsf(r1) + 1.0f)), fmaxf(fabsf(yv.z - r2) / (fabsf(r2) + 1.0f), fabsf(yv.w - r3) / (fabsf(r3) + 1.0f)));
          if (!(er == er)) er = 1.0e9f;
          atomicMax((unsigned*)(P.ERR + c), __float_as_uint(er)); }
#else
        u32x2 w; w.x = pk2(yv.x, yv.y); w.y = pk2(yv.z, yv.w);
        *(u32x2*)(Y + (size_t)(b * T + t0c + (z ? 15 - st : st)) * 1024 + chq + i4) = w;
#endif
    };
    auto bonus_flush = [&](int c) {
#ifdef MK_SCANCHECK
        return;
#endif
        if (q4 == 0 && F.lane < 16) {
            const int t0c = z ? T - 16 * (c + 1) : 16 * c; const size_t m0 = (size_t)b * T + t0c;
            const LAS float* qq = bonp + (z * 3 + c % 3) * 64 + F.lane;
            P.BON[((size_t)z * M + m0 + F.lane) * 16 + h] = (qq[0] + qq[16]) + (qq[32] + qq[48]);
        }
    };
    __syncthreads();
    for (int e = F.tid; e < 6 * 2 * 16 * 8; e += 512) { const int row = (e >> 3) & 15, tile = (e >> 7) & 1, zb = e >> 8, w = e & 7;
        *(LAS unsigned*)(L + zb * CS_BUF + (tile ? CS_SMT : CS_SMQ) + row * 80 + 32 + w * 4) = 0u; }
    const bool pb_wave = (q4 == z);
    constexpr int NC = T / 16;
    do_load(0); prep_a(0); do_load(1); prep_a(1);
    asm volatile("s_waitcnt lgkmcnt(0)" ::: "memory"); __builtin_amdgcn_s_barrier(); asm volatile("" ::: "memory");
    if (pb_wave) prep_b(0);
    do_load(2);
    asm volatile("s_waitcnt lgkmcnt(0)" ::: "memory"); __builtin_amdgcn_s_barrier(); asm volatile("" ::: "memory");
#ifdef MK_TPROBE
    unsigned long long tpa[4] = {0ull, 0ull, 0ull, 0ull};
#define TP_T() __builtin_amdgcn_s_memtime()
#define TP_ACC(i, t0) tpa[i] += TP_T() - (t0)
#else
#define TP_T() 0ull
#define TP_ACC(i, t0) ((void)(t0))
#endif
    for (int e = 0; e < NC; ++e) {
        const unsigned long long t0 = TP_T();
        if (e + 2 < NC) prep_a(e + 2);
        asm volatile("s_waitcnt lgkmcnt(0)" ::: "memory");
        TP_ACC(0, t0); const unsigned long long t1 = TP_T();
        if (e > 0) flush_y(e - 1);
        if (e + 1 < NC) bonus_flush(e + 1);
        if (e == 0) bonus_flush(0);
        if (e + 3 < NC) do_load(e + 3);
        stage_s(e);
        asm volatile("s_waitcnt lgkmcnt(0)" ::: "memory");
        TP_ACC(1, t1); const unsigned long long t2 = TP_T();
        if (pb_wave && e + 1 < NC) prep_b(e + 1);
        asm volatile("s_waitcnt lgkmcnt(0)" ::: "memory");
        TP_ACC(2, t2); const unsigned long long t3 = TP_T();
        __builtin_amdgcn_s_barrier(); asm volatile("" ::: "memory");
        TP_ACC(3, t3);
    }
#ifdef MK_TPROBE
    if (blockIdx.x == 0 && F.wave == MK_TPROBE_WAVE) {
        const unsigned long long amt = 4ull * tpa[MK_TPROBE];
        const unsigned long long w0 = __builtin_amdgcn_s_memtime();
        while (__builtin_amdgcn_s_memtime() - w0 < amt) __builtin_amdgcn_s_sleep(8);
    }
#endif
    flush_y(T / 16 - 1);
}

#define XB_TMO      128
#define XB_XCNT(j)  (256  + 64 * (j))
#define XB_XSUB(j)  (1280 + 64 * (j))
#define XB_XGEN(j)  (2304 + 64 * (j))
#define XB_TOP      3328
#define XB_TOPGEN   3392
#define XCD_BAR_WORDS 3456
#define XB_SPIN_CAP (1u << 22)
DI unsigned xb_ld(unsigned* p)              { return __hip_atomic_load(p, __ATOMIC_RELAXED, __HIP_MEMORY_SCOPE_AGENT); }
DI unsigned xb_add(unsigned* p, unsigned v) { return __hip_atomic_fetch_add(p, v, __ATOMIC_RELAXED, __HIP_MEMORY_SCOPE_AGENT); }
DI unsigned xb_xcc_id() { return (unsigned)__builtin_amdgcn_s_getreg((3 << 11) | 20) & 0xFu; }
#define XB_SPIN(cond, bar) do { unsigned _sp = 0; while (cond) { __builtin_amdgcn_s_sleep(1); \
    if ((++_sp & 255u) == 0u) { if (xb_ld(&(bar)[XB_TMO])) break; if (_sp > XB_SPIN_CAP) { atomicAdd(&(bar)[XB_TMO], 1u); break; } } } } while (0)
struct XcdBarrier { unsigned* bar; unsigned x; volatile LAS unsigned* st; };
DI XcdBarrier xcd_barrier_post(unsigned* bar, volatile LAS unsigned* st) {
    XcdBarrier b; b.bar = bar; b.x = xb_xcc_id(); b.st = st;
    if (threadIdx.x == 0) (void)xb_add(&bar[XB_XCNT(b.x)], 1u);
    return b;
}
DI void xcd_barrier_complete(unsigned* bar, unsigned x, unsigned& nloc, unsigned& nx) {
    const unsigned G = gridDim.x * gridDim.y * gridDim.z;
    unsigned sum, cnt, mine, sp = 0u;
    for (;;) {
        sum = 0u; cnt = 0u; mine = 0u;
#pragma unroll
        for (unsigned j = 0; j < 16; ++j) { const unsigned c = xb_ld(&bar[XB_XCNT(j)]); sum += c; cnt += (c > 0u) ? 1u : 0u; mine = (j == x) ? c : mine; }
        if (sum == G) break;
        __builtin_amdgcn_s_sleep(1);
        if ((++sp & 255u) == 0u) { if (xb_ld(&bar[XB_TMO])) break; if (sp > XB_SPIN_CAP) { atomicAdd(&bar[XB_TMO], 1u); break; } }
    }
    nloc = mine > 0u ? mine : 1u; nx = cnt > 0u ? cnt : 1u;
}
DI void xcd_barrier(const XcdBarrier& b) {
    asm volatile("s_waitcnt vmcnt(0)" ::: "memory");
    __syncthreads();
    if (threadIdx.x == 0) {
        unsigned* bar = b.bar;
        __builtin_amdgcn_s_waitcnt(0);
        unsigned nloc = b.st[0], nx = b.st[1];
        if (nloc == 0u) { xcd_barrier_complete(bar, b.x, nloc, nx); b.st[0] = nloc; b.st[1] = nx; }
        const unsigned old = xb_add(&bar[XB_XSUB(b.x)], 1u);
        const unsigned gen = old / nloc;
        if (old + 1u == (gen + 1u) * nloc) {
            __builtin_amdgcn_fence(__ATOMIC_RELEASE, "agent");
            asm volatile("s_waitcnt vmcnt(0)" ::: "memory");
            const unsigned og = xb_add(&bar[XB_TOP], 1u);
            const unsigned tg = og / nx;
            if (og + 1u == (tg + 1u) * nx) xb_add(&bar[XB_TOPGEN], 1u);
            else XB_SPIN(xb_ld(&bar[XB_TOPGEN]) == tg, bar);
            __builtin_amdgcn_fence(__ATOMIC_ACQUIRE, "agent");
            xb_add(&bar[XB_XGEN(b.x)], 1u);
            asm volatile("s_waitcnt vmcnt(0)" ::: "memory");
        } else {
            XB_SPIN(xb_ld(&bar[XB_XGEN(b.x)]) == gen, bar);
            __builtin_amdgcn_fence(__ATOMIC_ACQUIRE, "agent");
            asm volatile("s_waitcnt vmcnt(0)" ::: "memory");
        }
    }
    __syncthreads();
}

#ifndef MK_PROG
#ifdef MK_SCANCHECK
#define MK_PROG 0,1,2,3,4,5,7,8,10,11,12,13,14,25,15,16,17,19,20,22,23,24
#else
#define MK_PROG 0,3,4,5,7,8,10,11,12,13,14,15,16,17,19,20,22,23,24
#endif
#endif
__constant__ int PROG[] = {MK_PROG};
constexpr int NPH = sizeof(PROG) / sizeof(int);
template <int TYPE> struct PreSched {
    const bf16* KV; const bf16* W; int G, c;
    DI bool next(int i, Unit& u) const {
        const long L = (long)i * G + c; if (L >= 512) return false;
        const int rem = (int)L, i2 = rem >> 8, b = (rem >> 4) & 15, hh = (rem >> 2) & 3, t4 = rem & 3;
        u.pm = 0; u.pn = 0;
        const bf16* kvp = KV + (size_t)(b * 256) * 4096 + i2 * 2048 + hh * 256;
        const bf16* wp = W + (size_t)i2 * 1024 * 1024 + (size_t)(t4 * 256) * 1024 + hh * 256;
        if (TYPE == 0) { u.pa = (const char*)kvp; u.pb = (const char*)wp; u.z = (i2 << 30) | (b * 1048576 + hh * 256 * 1024 + t4 * 256); }
        else { u.pa = (const char*)wp; u.pb = (const char*)(kvp + 1024); u.z = (i2 << 30) | (16 * 1048576 + b * 1048576 + t4 * 256 * 1024 + hh * 256); }
        return true;
    }
};

__global__ void __launch_bounds__(512, 2) mk_fwd(Args a) {
    extern __shared__ __attribute__((aligned(16))) unsigned char lds_raw[];
    Frame F;
    F.lds = (LAS unsigned char*)lds_raw;
    F.tid = threadIdx.x; F.lane = F.tid & 63; F.wave = __builtin_amdgcn_readfirstlane(F.tid >> 6);
    F.gw = blockIdx.x * 8 + F.wave; F.ngw = gridDim.x * 8; F.ws = a.ws;
    cg::grid_group grid = cg::this_grid();
    volatile LAS unsigned* MISC = (volatile LAS unsigned*)(F.lds + LDS_MISC);
    if (F.tid < 2) MISC[F.tid] = 0u;
    __syncthreads();
    (void)xcd_barrier_post((unsigned*)(a.ws + WS_BAR), MISC);

    for (int pi = a.ph_lo; pi < a.ph_hi; ++pi) {
        const int ph = PROG[pi];
        const int G = opq(gridDim.x), cblk = opq(blockIdx.x);
        unsigned char* ws = a.ws + (size_t)opq(0);
        float* RS = (float*)(ws + WS_RS);
        bf16* SA = (bf16*)(ws + WS_SA); bf16* SB = (bf16*)(ws + WS_SB);
        bf16* H = (bf16*)a.out;
        const int li = ph >= 18 ? 1 : 0;
        int cp = ph; if (ph >= 18 && ph <= 23) cp = ph - 12;
#ifndef PH_MASK
#define PH_MASK 0xffffffffu
#endif
        if (!((PH_MASK >> cp) & 1u)) cp = 99;
        switch (cp) {
        case 0: phase_prologue(F, a, ws); break;
        case 3: {
            { pg8::PlainSched S{SA, (const bf16*)(ws + WS_WIN), 1024, 1024, M / 256, 8, G, cblk, 30, 0};
              EpiInProj E{(bf16*)(ws + WS_GLU), SB, RS};
              pg8::gemm_phase(F.lds, 1024, 1024, 1024, S, E); }
            { pg8::PlainSched S{(const bf16*)(ws + WS_WIN) + (size_t)2048 * 1024, SA, 1024, 1024, 2, M / 256, G, cblk, 30, 0};
              EpiVT E{(bf16*)(ws + WS_VT), RS};
              pg8::gemm_phase(F.lds, 1024, 1024, 1024, S, E); }
                    {

            pg8::PlainSched S{(const bf16*)(ws + WS_MEMB), (const bf16*)(ws + WS_WKV), 1024, 1024, MMEM / 256, 16, G, cblk, 30, 0};
            EpiRowScale<0> E{(bf16*)(ws + WS_KV), 4096, (const float*)(ws + WS_RSMEM), nullptr};
            pg8::gemm_phase(F.lds, 1024, 1024, 1024, S, E);
                    }
        } break;
        case 4: {
            const float lam = ((const float*)(ws + WS_LAM))[0];
#ifndef NO_ATTN
            for (int u = cblk; u < 1024; u += G) diffattn_unit(F, u, SB, (const bf16*)(ws + WS_VT), (const float*)(ws + WS_BIAS), lam, a.in[opq(I_SUBLN)], (bf16*)(ws + WS_MIX));
#endif
            __syncthreads();
#ifndef NO_CONV
            conv_load_weights(F, a.in[opq(I_CONVW)]);
            for (int u = cblk; u < 512; u += G) conv_unit(F, u, (const bf16*)(ws + WS_GLU), a.in[opq(I_CONVB)], a.in[opq(I_CLNG)], a.in[opq(I_CLNB)], (bf16*)(ws + WS_MIX));
#endif
            __syncthreads();
                    {

            EpiPre E{(bf16*)(ws + WS_G0)};
            { PreSched<0> S{(const bf16*)(ws + WS_KV), (const bf16*)(ws + WS_WQN), G, cblk}; pg8::gemm_phase(F.lds, 256, 4096, 1024, S, E); }
            { PreSched<1> S{(const bf16*)(ws + WS_KV), (const bf16*)(ws + WS_WXO), G, cblk}; pg8::gemm_phase(F.lds, 256, 1024, 4096, S, E); }
                    }
        } break;
        case 5: {
            pg8::PlainSched S{(const bf16*)(ws + WS_MIX), (const bf16*)(ws + WS_WOUT), 1024, 1024, M / 256, 4, G, cblk, 30, 0};
            EpiResid E{a.in[opq(I_X)], nullptr, H, (float*)(ws + WS_PS)};
            pg8::gemm_phase(F.lds, 1024, 1024, 1024, S, E);
        } break;
        case 7: {
            pg8::PlainSched S{H, (const bf16*)(ws + (li ? WS_G1 : WS_G0)), 1024, 1024, M / 256, 4, G, cblk, 3, (size_t)1048576};
            EpiSoftmax E{SB, (const float*)(ws + WS_PS)};
            pg8::gemm_phase(F.lds, 1024, 1024, 1024, S, E);
        } break;
        case 8: {
            pg8::PlainSched S{SB, (const bf16*)(ws + (li ? WS_VW1 : WS_VW0)), 1024, 1024, M / 256, 4, G, cblk, 3, (size_t)1048576};
            EpiResid E{nullptr, H, H, (float*)(ws + WS_PS)};
            pg8::gemm_phase(F.lds, 1024, 1024, 1024, S, E);
        } break;
        case 10: {
            pg8::PlainSched S{H, (const bf16*)(ws + WS_WUP) + (size_t)li * 4096 * 1024, 1024, 1024, M / 256, 16, G, cblk, 30, 0};
            EpiRowScale<2> E{(bf16*)(ws + WS_HID), 4096, nullptr, (const float*)(ws + WS_PS)};
            pg8::gemm_phase(F.lds, 1024, 1024, 1024, S, E);
        } break;
        case 11: {
            pg8::PlainSched S{(const bf16*)(ws + WS_HID), (const bf16*)(ws + WS_WDN) + (size_t)li * 1024 * 4096, 4096, 4096, M / 256, 4, G, cblk, 30, 0};
            EpiResid E{nullptr, H, li ? SA : H, nullptr};
            pg8::gemm_phase(F.lds, 4096, 4096, 4096, S, E);
        } break;
        case 12: phase_rwkv_shift(F, H, a.in[opq(I_NMIX)] + 1024, (bf16*)(ws + WS_A1)); break;
        case 13: {
            pg8::PlainSched S{(const bf16*)(ws + WS_A1), (const bf16*)(ws + WS_WBIG), 2048, 2048, M / 256, 14, G, cblk, 30, 0};
            EpiRwkv E{(bf16*)(ws + WS_R), (bf16*)(ws + WS_K), (bf16*)(ws + WS_V), (bf16*)(ws + WS_HD1), (bf16*)(ws + WS_HD2)};
            pg8::gemm_phase(F.lds, 2048, 2048, 2048, S, E);
        } break;
        case 14: {
            ScanPtrs P{(const bf16*)(ws + WS_R), (const bf16*)(ws + WS_K), (const bf16*)(ws + WS_V), (const bf16*)(ws + WS_HD1), (const bf16*)(ws + WS_W2T),
                       a.in[opq(I_W0)], a.in[opq(I_A0)], a.in[opq(I_KK)], a.in[opq(I_KA)], a.in[opq(I_RK)], (bf16*)(ws + WS_YF), (bf16*)(ws + WS_YB), (float*)(ws + WS_BONUS), (unsigned*)(ws + WS_BAR + 32768)};
#if defined(MK_SCAN_VALU) || defined(MK_SCANCHECK)
            for (int bh = cblk; bh < 256; bh += G) scan_pair(F, bh, P);
#else
            for (int bh = cblk; bh < 256; bh += G) scan_pair_mfma(F, bh, P);
#endif
            __syncthreads();
        } break;
#ifdef MK_SCANCHECK
        case 25: {
            ScanPtrs P{(const bf16*)(ws + WS_R), (const bf16*)(ws + WS_K), (const bf16*)(ws + WS_V), (const bf16*)(ws + WS_HD1), (const bf16*)(ws + WS_W2T),
                       a.in[opq(I_W0)], a.in[opq(I_A0)], a.in[opq(I_KK)], a.in[opq(I_KA)], a.in[opq(I_RK)], (bf16*)(ws + WS_YF), (bf16*)(ws + WS_YB), (float*)(ws + WS_BONUS), (unsigned*)(ws + WS_BAR + 32768)};
            for (int bh = cblk; bh < 256; bh += G) scan_pair_mfma(F, bh, P);
            __syncthreads();
        } break;
#endif
        case 15: {

            pg8::PlainSched S{(const bf16*)(ws + WS_HD2), (const bf16*)(ws + WS_G2T), 256, 256, M / 256, 4, G, cblk, 30, 0};
            EpiRowScale<0> E{(bf16*)(ws + WS_GATE), 1024, nullptr, nullptr};
            pg8::gemm_phase(F.lds, 256, 256, 256, S, E);
                } break;
        case 16: phase_rwkv_comb(F, (const bf16*)(ws + WS_YF), (const bf16*)(ws + WS_YB), (const bf16*)(ws + WS_V), (const bf16*)(ws + WS_GATE), (const float*)(ws + WS_BONUS),
                                 a.in[opq(I_LNG)], a.in[opq(I_LNB)], (bf16*)(ws + WS_COMB)); break;
        case 17: {
            pg8::PlainSched S{(const bf16*)(ws + WS_COMB), (const bf16*)(ws + WS_WRO), 1024, 1024, M / 256, 4, G, cblk, 30, 0};
            EpiResid E{nullptr, H, H, (float*)(ws + WS_PS)};
            pg8::gemm_phase(F.lds, 1024, 1024, 1024, S, E);
        } break;
        case 24: {
            float osc = 1.0f;
#ifdef MK_SCANCHECK
            { const unsigned* ER = (const unsigned*)(ws + WS_BAR + 32768); int bad = -1;
              for (int c = 127; c >= 0; --c) if (__uint_as_float(__builtin_amdgcn_readfirstlane(__hip_atomic_load(ER + c, __ATOMIC_RELAXED, __HIP_MEMORY_SCOPE_AGENT))) > MK_SCANCHECK_TOL) bad = c;
              if (bad >= 0) osc = 1.0f + 0.03f * (float)(bad + 1); }
#endif
            phase_final_norm(F, SA, a.out, a.in[opq(I_NFINAL)], osc);
        } break;
        default: break;
        }
        if (pi + 1 < a.ph_hi) {
#ifdef MK_ALL_CG
            grid.sync();
#else
            if (pi == a.ph_lo) grid.sync(); else { XcdBarrier xb; xb.bar = (unsigned*)(ws + WS_BAR); xb.x = xb_xcc_id(); xb.st = (volatile LAS unsigned*)(F.lds + LDS_MISC); xcd_barrier(xb); }
#endif
        }
    }
}

extern "C" void kernel_launch(void* const* d_in, const int* in_sizes, int n_in, void* d_out, int out_size, void* d_ws, size_t ws_size, hipStream_t stream) {
    static int grid = 0;
    if (grid == 0) {
        if (n_in != N_IN || in_sizes[0] != M * D || out_size != M * D || ws_size < WS_NEED) {
            fprintf(stderr, "kernel_launch: unexpected problem (n_in %d, in0 %d, out %d, ws %zu); nothing launched\n", n_in, n_in > 0 ? in_sizes[0] : -1, out_size, ws_size); grid = -1; return; }
        int dev = 0, cus = 0, per_cu = 0;
        if (hipGetDevice(&dev) != hipSuccess || hipDeviceGetAttribute(&cus, hipDeviceAttributeMultiprocessorCount, dev) != hipSuccess) { grid = -1; return; }
        if (hipFuncSetAttribute((const void*)mk_fwd, hipFuncAttributeMaxDynamicSharedMemorySize, LDS_BYTES) != hipSuccess) { fprintf(stderr, "kernel_launch: hipFuncSetAttribute failed\n"); grid = -1; return; }
        if (hipOccupancyMaxActiveBlocksPerMultiprocessor(&per_cu, (const void*)mk_fwd, 512, LDS_BYTES) != hipSuccess || per_cu < 1) { fprintf(stderr, "kernel_launch: occupancy query says %d\n", per_cu); (void)hipGetLastError(); grid = -1; return; }
        grid = cus;
    }
    if (grid < 0) return;
    if (hipMemsetAsync((char*)d_ws + WS_BAR, 0, 65536, stream) != hipSuccess) { fprintf(stderr, "kernel_launch: memset failed\n"); return; }
    Args a{};
    for (int i = 0; i < N_IN; ++i) a.in[i] = (const float*)d_in[i];
    a.out = (float*)d_out; a.ws = (unsigned char*)d_ws;
#if MK_SINGLE
    a.ph_lo = 0; a.ph_hi = NPH;
    void* params[] = {&a};
    hipError_t e = hipLaunchCooperativeKernel((const void*)mk_fwd, dim3(grid), dim3(512), params, LDS_BYTES, stream);
    if (e != hipSuccess) fprintf(stderr, "kernel_launch: cooperative launch failed: %s\n", hipGetErrorString(e));
#else
    for (int ph = 0; ph < NPH; ++ph) { a.ph_lo = ph; a.ph_hi = ph + 1; hipLaunchKernelGGL(mk_fwd, dim3(grid), dim3(512), LDS_BYTES, stream, a); }
#endif
}
```

```cpp
#include <hip/hip_runtime.h>
#include <hip/hip_cooperative_groups.h>
#include <cstdio>
#include <cstdint>
namespace cg = cooperative_groups;

#ifndef MK_SINGLE
#define MK_SINGLE 1
#endif

#define LAS __attribute__((address_space(3)))
#define DI __device__ __forceinline__
typedef unsigned short bf16;
typedef short bf16x8 __attribute__((ext_vector_type(8)));
typedef short s16x4 __attribute__((ext_vector_type(4)));
typedef float f32x2 __attribute__((ext_vector_type(2)));
typedef float f32x4 __attribute__((ext_vector_type(4)));
typedef float f32x16 __attribute__((ext_vector_type(16)));
typedef unsigned u32x2 __attribute__((ext_vector_type(2)));
typedef unsigned u32x4 __attribute__((ext_vector_type(4)));

constexpr int D = 1024, NB = 16, T = 2048, M = NB * T, NMEM = 256, MMEM = NB * NMEM;
constexpr int FF = 4096;
constexpr float EPS = 1e-6f;
constexpr float LOG2E = 1.4426950408889634f;

constexpr size_t MiB = 1u << 20;
constexpr size_t WS_BAR = 0;
constexpr size_t WS_RS = 64 * 1024;
constexpr size_t WS_RSMEM = WS_RS + M * 4;
constexpr size_t WS_BIAS = WS_RSMEM + MMEM * 4;
constexpr size_t WS_LAM = WS_BIAS + 4 * 4096 * 4;
constexpr size_t WS_WIN = 1 * MiB;
constexpr size_t WS_WOUT = WS_WIN + 5 * MiB;
constexpr size_t WS_WQN = WS_WOUT + 2 * MiB;
constexpr size_t WS_WKV = WS_WQN + 4 * MiB;
constexpr size_t WS_WXO = WS_WKV + 8 * MiB;
constexpr size_t WS_WUP = WS_WXO + 4 * MiB;
constexpr size_t WS_WDN = WS_WUP + 16 * MiB;
constexpr size_t WS_WBIG = WS_WDN + 16 * MiB;
constexpr size_t WS_W2T = WS_WBIG + 14 * MiB;
constexpr size_t WS_G2T = WS_W2T + 512 * 1024;
constexpr size_t WS_WRO = WS_G2T + 512 * 1024;
constexpr size_t WS_WEND = WS_WRO + 2 * MiB;
static_assert(WS_WEND == 73 * MiB, "weight map");
constexpr size_t WS_SA = 73 * MiB;
constexpr size_t WS_SB = 137 * MiB;
constexpr size_t WS_GLU = 201 * MiB;
constexpr size_t WS_VT = 233 * MiB;
constexpr size_t WS_MIX = 265 * MiB;
constexpr size_t WS_G0 = 329 * MiB;
constexpr size_t WS_VW0 = 361 * MiB;
constexpr size_t WS_MEMB = 393 * MiB;
constexpr size_t WS_KV = 401 * MiB;
constexpr size_t WS_G1 = 433 * MiB;
constexpr size_t WS_VW1 = 465 * MiB;
static_assert(WS_G1 - WS_G0 == 104 * MiB && WS_VW0 - WS_G0 == 32 * MiB && WS_VW1 - WS_G1 == 32 * MiB, "G / VW spacing used by EpiPre");
constexpr size_t WS_BONUS = 497 * MiB;
constexpr size_t WS_PS = 502 * MiB;
constexpr size_t WS_HID = 137 * MiB;
constexpr size_t WS_A1 = 73 * MiB;
constexpr size_t WS_R = 201 * MiB, WS_K = 265 * MiB, WS_V = 329 * MiB;
static_assert(WS_K - WS_R == 64 * MiB && WS_V - WS_K == 64 * MiB, "r, k, v spacing used by EpiRwkv");
constexpr size_t WS_HD1 = 393 * MiB;
constexpr size_t WS_HD2 = 409 * MiB;
constexpr size_t WS_YF = 73 * MiB, WS_YB = 137 * MiB;
constexpr size_t WS_GATE = 265 * MiB;
constexpr size_t WS_COMB = 201 * MiB;
constexpr size_t WS_NEED = 512 * MiB;

constexpr int LDS_X = 131072;
constexpr int LDS_MISC = 163840 - 256;
constexpr int LDS_BYTES = 163840;

DI unsigned f2bf(float f) { unsigned u = __builtin_bit_cast(unsigned, f); return (u + 0x7fffu + ((u >> 16) & 1u)) >> 16; }
typedef __bf16 bf16x2v __attribute__((ext_vector_type(2)));
DI unsigned pk2(float lo, float hi) { const f32x2 v = {lo, hi}; return __builtin_bit_cast(unsigned, __builtin_convertvector(v, bf16x2v)); }
DI float bf2f(unsigned short b) { return __builtin_bit_cast(float, ((unsigned)b) << 16); }
DI float bflo(unsigned w) { return __builtin_bit_cast(float, w << 16); }
DI float bfhi(unsigned w) { return __builtin_bit_cast(float, w & 0xffff0000u); }
template <int MASK> DI float swz_xor(float v) { return __builtin_bit_cast(float, __builtin_amdgcn_ds_swizzle(__builtin_bit_cast(int, v), (MASK << 10) | 0x1f)); }
DI float half_sum(float v) { const int x = __builtin_bit_cast(int, v); const auto r = __builtin_amdgcn_permlane32_swap(x, x, false, false); return __builtin_bit_cast(float, (int)r[0]) + __builtin_bit_cast(float, (int)r[1]); }
DI float half_max(float v) { const int x = __builtin_bit_cast(int, v); const auto r = __builtin_amdgcn_permlane32_swap(x, x, false, false); return fmaxf(__builtin_bit_cast(float, (int)r[0]), __builtin_bit_cast(float, (int)r[1])); }
DI float wave_sum(float v) {
    v += swz_xor<1>(v); v += swz_xor<2>(v); v += swz_xor<4>(v); v += swz_xor<8>(v); v += swz_xor<16>(v); v = half_sum(v);
    return v;
}
DI int opaque(int x) { asm volatile("" : "+v"(x)); return x; }
template <class Tp> DI Tp* opq_ptr(Tp* p) { asm volatile("" : "+s"(p)); return p; }
DI int opq(int x) { asm volatile("" : "+s"(x)); return x; }
DI float fexp2(float x) { return __builtin_amdgcn_exp2f(x); }
DI float frcp(float x) { return __builtin_amdgcn_rcpf(x); }
DI float sigmoidf_(float x) { return frcp(1.0f + fexp2(-x * LOG2E)); }
DI float tanhf_(float x) { float e = fexp2(-2.0f * LOG2E * fabsf(x)); float t = (1.0f - e) * frcp(1.0f + e); return x < 0.f ? -t : t; }

namespace pg8 {
constexpr int BM = 256, BK = 64, HALF = 128, HTB = HALF * BK * 2, STAGE_BYTES = 8 * HTB, NXCD = 8, WGM = 8;
DI int lds_byte(int r, int c) { const int st = (r >> 4) * 2 + (c >> 5), rr = r & 15, cc = c & 31, ob = rr * 64 + cc * 2; return st * 1024 + (ob ^ (((ob >> 9) & 1) << 5)); }
DI void stage_rc(int b, int& R, int& C) { const int st = b / 1024, sb = b % 1024, swz = sb ^ (((sb >> 9) & 1) << 5); R = (st >> 1) * 16 + swz / 64; C = (st & 1) * 32 + (swz % 64) / 2; }
DI int perm32(int rho) { const int n = rho >> 4, i = rho & 15; return 8 * (i >> 2) + 4 * n + (i & 3); }

struct Unit { int pm, pn, z; const char* pa; const char* pb; };

DI bool tile_order(long L, int nM, int nN, int& pm, int& pn) {
    const int nwg = nM * nN; if (L >= nwg) return false;
    int wgid = (int)L; { const int q = nwg / NXCD, r = nwg % NXCD, xcd = wgid % NXCD, off = wgid / NXCD; wgid = (xcd < r ? xcd * (q + 1) : r * (q + 1) + (xcd - r) * q) + off; }
    const int nig = WGM * nN, gid = wgid / nig, fm = gid * WGM, gsz = (nM - fm) < WGM ? (nM - fm) : WGM;
    pm = fm + ((wgid % nig) % gsz); pn = (wgid % nig) / gsz; return true;
}
struct PlainSched {
    const bf16* A; const bf16* Bt; int lda, ldb, nM, nN, G, c, bshift; size_t bstride;
    DI bool next(int i, Unit& u) const {
        if (!tile_order((long)i * G + c, nM, nN, u.pm, u.pn)) return false;
        u.z = u.pm >> bshift;
        u.pa = (const char*)(A + (size_t)u.pm * 256 * lda);
        u.pb = (const char*)(Bt + (size_t)u.z * bstride + (size_t)u.pn * 256 * ldb);
        return true;
    }
};

DI unsigned cvt_pk_bf16(float lo, float hi) { return pk2(lo, hi); }

template <class Epi, class Sched>
DI void gemm_phase(LAS unsigned char* lds, const int K, const int lda, const int ldb, const Sched& S, const Epi& E) {
    const int tid = opaque(threadIdx.x), wid = __builtin_amdgcn_readfirstlane(tid >> 6), lane = tid & 63, wr = wid >> 2, wc = wid & 3, fr = lane & 15, fq = lane >> 4;
    const int nt = K / BK;
    unsigned voffA[2], voffB[2];
#pragma unroll
    for (int i = 0; i < 2; ++i) { int R, C; stage_rc(tid * 16 + i * 8192, R, C); const int Rb = Epi::PERM ? ((R & ~31) + perm32(R & 31)) : R;
        voffA[i] = (unsigned)(R * lda + C) * 2u; voffB[i] = (unsigned)(Rb * ldb + C) * 2u; }
    const size_t kstep = (size_t)(BK * 2);
    const size_t hstepA = (size_t)HALF * lda * 2, hstepB = (size_t)HALF * ldb * 2;
    const unsigned ldsw = (unsigned)wid * 1024u;
    const int aoff = lds_byte(wr * 64 + fr, fq * 8), boff = lds_byte(wc * 32 + fr, fq * 8);
#define PG8_SA(b, h) (((b) * 2 + (h)) * HTB)
#define PG8_SB(b, h) ((4 + (b) * 2 + (h)) * HTB)
#define PG8_STAGE(bufoff, gbase, voff) do { _Pragma("unroll") for (int _i = 0; _i < 2; ++_i) \
        __builtin_amdgcn_global_load_lds((const unsigned*)((const char*)(gbase) + (voff)[_i]), (LAS unsigned*)(lds + (bufoff) + ldsw + _i * 8192), 16, 0, 0); } while (0)
#define PG8_LDA(dst, b, h) do { _Pragma("unroll") for (int m = 0; m < 4; ++m) _Pragma("unroll") for (int k = 0; k < 2; ++k) dst[m][k] = *(const LAS bf16x8*)(lds + PG8_SA(b, h) + aoff + m * 2048 + k * 1024); } while (0)
#define PG8_LDB(dst, b, h) do { _Pragma("unroll") for (int n = 0; n < 2; ++n) _Pragma("unroll") for (int k = 0; k < 2; ++k) dst[n][k] = *(const LAS bf16x8*)(lds + PG8_SB(b, h) + boff + n * 2048 + k * 1024); } while (0)
#define PG8_MMA(ai, bj, At, Bt) do { __builtin_amdgcn_s_setprio(1); _Pragma("unroll") for (int m = 0; m < 4; ++m) _Pragma("unroll") for (int n = 0; n < 2; ++n) _Pragma("unroll") for (int k = 0; k < 2; ++k) \
        acc[ai][bj][m][n] = __builtin_amdgcn_mfma_f32_16x16x32_bf16(Bt[n][k], At[m][k], acc[ai][bj][m][n], 0, 0, 0); __builtin_amdgcn_s_setprio(0); } while (0)
#define PG8_WAIT_V(n) asm volatile("s_waitcnt vmcnt(" #n ")" ::: "memory")
#define PG8_WAIT_L(n) asm volatile("s_waitcnt lgkmcnt(" #n ")" ::: "memory")
#define PG8_BAR __builtin_amdgcn_s_barrier()
#define PG8_SCHED __builtin_amdgcn_sched_barrier(0)
    Unit cur, nxt; int ui = 0;
    if (!S.next(0, cur)) return;
    f32x4 acc[2][2][4][2];
#pragma unroll
    for (int a = 0; a < 2; ++a)
#pragma unroll
        for (int b = 0; b < 2; ++b)
#pragma unroll
            for (int m = 0; m < 4; ++m)
#pragma unroll
                for (int n = 0; n < 2; ++n) acc[a][b][m][n] = (f32x4){0.f, 0.f, 0.f, 0.f};
    bf16x8 At[4][2], B0[2][2], B1[2][2];
    const char* cA = cur.pa; const char* cB = cur.pb;
    PG8_STAGE(PG8_SB(0, 0), cB, voffB); PG8_STAGE(PG8_SB(0, 1), cB + hstepB, voffB); PG8_STAGE(PG8_SA(0, 0), cA, voffA); PG8_STAGE(PG8_SA(0, 1), cA + hstepA, voffA);
    if (wr == 1) PG8_BAR;
    PG8_WAIT_V(2); PG8_BAR;
    PG8_STAGE(PG8_SB(1, 0), cB + kstep, voffB); PG8_STAGE(PG8_SA(1, 0), cA + kstep, voffA); PG8_STAGE(PG8_SB(1, 1), cB + hstepB + kstep, voffB);
    PG8_WAIT_V(6); PG8_BAR;
    for (;;) {
        const bool has_next = S.next(ui + 1, nxt);
        const char* nA = has_next ? nxt.pa : cA; const char* nB = has_next ? nxt.pb : cB;
#pragma unroll 1
        for (int t = 0; t < nt; t += 2) {
            const bool last = (t == nt - 2);
            const char* a1 = cA + (size_t)(t + 1) * kstep;
            const char* a2 = last ? nA : cA + (size_t)(t + 2) * kstep; const char* b2 = last ? nB : cB + (size_t)(t + 2) * kstep;
            const char* a3 = a2 + kstep; const char* b3 = b2 + kstep;
            PG8_LDB(B0, 0, 0); PG8_LDB(B1, 0, 1); PG8_SCHED; PG8_LDA(At, 0, 0); PG8_STAGE(PG8_SA(1, 1), a1 + hstepA, voffA);
            PG8_WAIT_V(8); PG8_WAIT_L(0); PG8_BAR; PG8_MMA(0, 0, At, B0); PG8_MMA(0, 1, At, B1); PG8_BAR; PG8_SCHED;
            PG8_LDA(At, 0, 1); PG8_STAGE(PG8_SB(0, 0), b2, voffB); PG8_STAGE(PG8_SB(0, 1), b2 + hstepB, voffB); PG8_STAGE(PG8_SA(0, 0), a2, voffA);
            PG8_WAIT_V(8); PG8_WAIT_L(0); PG8_BAR; PG8_MMA(1, 0, At, B0); PG8_MMA(1, 1, At, B1); PG8_BAR; PG8_SCHED;
            PG8_LDB(B0, 1, 0); PG8_LDB(B1, 1, 1); PG8_SCHED; PG8_LDA(At, 1, 0); PG8_STAGE(PG8_SA(0, 1), a2 + hstepA, voffA);
            PG8_WAIT_V(8); PG8_WAIT_L(0); PG8_BAR; PG8_MMA(0, 0, At, B0); PG8_MMA(0, 1, At, B1); PG8_BAR; PG8_SCHED;
            PG8_LDA(At, 1, 1); PG8_STAGE(PG8_SB(1, 0), b3, voffB); PG8_STAGE(PG8_SB(1, 1), b3 + hstepB, voffB); PG8_STAGE(PG8_SA(1, 0), a3, voffA);
            PG8_WAIT_V(8); PG8_WAIT_L(0); PG8_BAR; PG8_MMA(1, 0, At, B0); PG8_MMA(1, 1, At, B1); PG8_BAR; PG8_SCHED;
        }
        if (wr == 0) PG8_BAR;
        E(acc, cur, wr, wc, fr, fq, lds);
        if (!has_next) break;
#pragma unroll
        for (int a = 0; a < 2; ++a)
#pragma unroll
            for (int b = 0; b < 2; ++b)
#pragma unroll
                for (int m = 0; m < 4; ++m)
#pragma unroll
                    for (int n = 0; n < 2; ++n) acc[a][b][m][n] = (f32x4){0.f, 0.f, 0.f, 0.f};
        cur = nxt; cA = nA; cB = nB; ++ui;
        if (wr == 1) PG8_BAR;
    }
    PG8_WAIT_V(0);
    PG8_BAR;
#undef PG8_SA
#undef PG8_SB
#undef PG8_STAGE
#undef PG8_LDA
#undef PG8_LDB
#undef PG8_MMA
#undef PG8_WAIT_V
#undef PG8_WAIT_L
#undef PG8_BAR
#undef PG8_SCHED
}
}
using pg8::Unit;

DI void store8(bf16* p, const f32x4 v0, const f32x4 v1) {
    u32x4 w; w.x = pk2(v0[0], v0[1]); w.y = pk2(v0[2], v0[3]); w.z = pk2(v1[0], v1[1]); w.w = pk2(v1[2], v1[3]);
    *(u32x4*)p = w;
}
#define EPI_ARGS f32x4 (&acc)[2][2][4][2], const Unit& u, int wr, int wc, int fr, int fq, LAS unsigned char* lds

DI float rs_ps(const float* ps, int row) {
    const f32x4* p = (const f32x4*)(ps + (size_t)row * 16); const f32x4 a = p[0], b = p[1], c = p[2], d = p[3];
    const float s = ((a.x + a.y) + (a.z + a.w)) + ((b.x + b.y) + (b.z + b.w)) + (((c.x + c.y) + (c.z + c.w)) + ((d.x + d.y) + (d.z + d.w)));
    return 1.0f / sqrtf(s * (1.0f / D) + EPS);
}
template <int ACT> struct EpiRowScale {
    static constexpr bool PERM = true;
    bf16* O; int ldc; const float* rs; const float* ps;
    DI void operator()(EPI_ARGS) const {
        const int row0 = u.pm * 256 + wr * 64 + fr, col0 = u.pn * 256 + wc * 32 + 8 * fq;
#pragma unroll
        for (int ai = 0; ai < 2; ++ai)
#pragma unroll
            for (int m = 0; m < 4; ++m) {
                const int row = row0 + ai * 128 + m * 16; const float s = ps ? rs_ps(ps, row) : (rs ? rs[row] : 1.0f);
                bf16* rowp = O + (size_t)row * ldc + col0;
#pragma unroll
                for (int bj = 0; bj < 2; ++bj) { f32x4 v0 = acc[ai][bj][m][0] * s, v1 = acc[ai][bj][m][1] * s;
                    if (ACT == 2) {
#pragma unroll
                        for (int j = 0; j < 4; ++j) { float a = fmaxf(v0[j], 0.f), b = fmaxf(v1[j], 0.f); v0[j] = a * a; v1[j] = b * b; } }
                    store8(rowp + bj * 128, v0, v1); }
            }
    }
};
struct EpiInProj {
    static constexpr bool PERM = true;
    bf16* GLU; bf16* QK; const float* rs;
    DI void operator()(EPI_ARGS) const {
        const int row0 = u.pm * 256 + wr * 64 + fr;
        if (u.pn < 4) {
            const int col0 = u.pn * 128 + wc * 32 + 8 * fq;
#pragma unroll
            for (int ai = 0; ai < 2; ++ai)
#pragma unroll
                for (int m = 0; m < 4; ++m) {
                    const int row = row0 + ai * 128 + m * 16; const float s = rs[row];
                    f32x4 o0, o1;
#pragma unroll
                    for (int j = 0; j < 4; ++j) { o0[j] = acc[ai][0][m][0][j] * s * sigmoidf_(acc[ai][1][m][0][j] * s); o1[j] = acc[ai][0][m][1][j] * s * sigmoidf_(acc[ai][1][m][1][j] * s); }
                    store8(GLU + (size_t)row * 512 + col0, o0, o1);
                }
        } else {
            const int col0 = (u.pn - 4) * 256 + wc * 32 + 8 * fq;
#pragma unroll
            for (int ai = 0; ai < 2; ++ai)
#pragma unroll
                for (int m = 0; m < 4; ++m) {
                    const int row = row0 + ai * 128 + m * 16; const float s = rs[row];
#pragma unroll
                    for (int bj = 0; bj < 2; ++bj) store8(QK + (size_t)row * 1024 + col0 + bj * 128, acc[ai][bj][m][0] * s, acc[ai][bj][m][1] * s);
                }
        }
    }
};
struct EpiVT {
    static constexpr bool PERM = true;
    bf16* O; const float* cs;
    DI void operator()(EPI_ARGS) const {
        const int row0 = u.pm * 256 + wr * 64 + fr, col0 = u.pn * 256 + wc * 32 + 8 * fq;
        f32x4 c[2][2];
#pragma unroll
        for (int bj = 0; bj < 2; ++bj) { c[bj][0] = *(const f32x4*)(cs + col0 + bj * 128); c[bj][1] = *(const f32x4*)(cs + col0 + bj * 128 + 4); }
#pragma unroll
        for (int ai = 0; ai < 2; ++ai)
#pragma unroll
            for (int m = 0; m < 4; ++m) {
                const int row = row0 + ai * 128 + m * 16;
#pragma unroll
                for (int bj = 0; bj < 2; ++bj) store8(O + (size_t)row * M + col0 + bj * 128, acc[ai][bj][m][0] * c[bj][0], acc[ai][bj][m][1] * c[bj][1]);
            }
    }
};
struct EpiPre {
    static constexpr bool PERM = true;
    bf16* base0;
    DI void operator()(EPI_ARGS) const {
        bf16* O = base0 + (size_t)((u.z >> 30) & 1) * (52u << 20) + (size_t)(u.z & 0x3fffffff);
        const int row0 = wr * 64 + fr, col0 = wc * 32 + 8 * fq;
#pragma unroll
        for (int ai = 0; ai < 2; ++ai)
#pragma unroll
            for (int m = 0; m < 4; ++m) {
                const int row = row0 + ai * 128 + m * 16;
#pragma unroll
                for (int bj = 0; bj < 2; ++bj) store8(O + (size_t)row * 1024 + col0 + bj * 128, acc[ai][bj][m][0], acc[ai][bj][m][1]);
            }
    }
};
struct EpiResid {
    static constexpr bool PERM = true;
    const float* xres; const bf16* hres; bf16* out; float* ps;
    DI void operator()(EPI_ARGS) const {
        const int row0 = u.pm * 256 + wr * 64 + fr, col0 = u.pn * 256 + wc * 32 + 8 * fq;
#pragma unroll
        for (int ai = 0; ai < 2; ++ai)
#pragma unroll
            for (int m = 0; m < 4; ++m) {
                const int row = row0 + ai * 128 + m * 16; const size_t off = (size_t)row * D + col0; float ss = 0.f;
#pragma unroll
                for (int bj = 0; bj < 2; ++bj) {
                    f32x4 r0, r1;
                    if (xres) { r0 = *(const f32x4*)(xres + off + bj * 128); r1 = *(const f32x4*)(xres + off + bj * 128 + 4); }
                    else { const u32x4 hw = *(const u32x4*)(hres + off + bj * 128); r0 = (f32x4){bflo(hw.x), bfhi(hw.x), bflo(hw.y), bfhi(hw.y)}; r1 = (f32x4){bflo(hw.z), bfhi(hw.z), bflo(hw.w), bfhi(hw.w)}; }
                    r0 = r0 + acc[ai][bj][m][0]; r1 = r1 + acc[ai][bj][m][1];
                    u32x4 w; w.x = pk2(r0[0], r0[1]); w.y = pk2(r0[2], r0[3]); w.z = pk2(r1[0], r1[1]); w.w = pk2(r1[2], r1[3]);
                    *(u32x4*)(out + off + bj * 128) = w;
                    if (ps) {
#pragma unroll
                        for (int q = 0; q < 4; ++q) { const float a = bflo(w[q]), b = bfhi(w[q]); ss += a * a + b * b; }
                    }
                }
                if (ps) { ss += swz_xor<16>(ss); ss = half_sum(ss); if (fq == 0) ps[(size_t)row * 16 + u.pn * 4 + wc] = ss; }
            }
    }
};
struct EpiGateComb {
    static constexpr bool PERM = true;
    const bf16 *YF, *YB, *V; const float *BON, *lng, *lnb; bf16* O;
    DI void operator()(EPI_ARGS) const {
        const int head = u.pn * 4 + wc, ch0 = u.pn * 256 + 64 * wc + 8 * fq, row0 = u.pm * 256 + wr * 64 + fr;
        f32x4 lg[2][2], lb[2][2];
#pragma unroll
        for (int bj = 0; bj < 2; ++bj)
#pragma unroll
            for (int n = 0; n < 2; ++n) { lg[bj][n] = *(const f32x4*)(lng + ch0 + 32 * bj + 4 * n); lb[bj][n] = *(const f32x4*)(lnb + ch0 + 32 * bj + 4 * n); }
#pragma unroll
        for (int ai = 0; ai < 2; ++ai)
#pragma unroll
            for (int m = 0; m < 4; ++m) {
                const int row = row0 + ai * 128 + m * 16; const size_t off = (size_t)row * D + ch0;
                u32x4 a[2], b[2], vv[2];
#pragma unroll
                for (int bj = 0; bj < 2; ++bj) { a[bj] = *(const u32x4*)(YF + off + 32 * bj); b[bj] = *(const u32x4*)(YB + off + 32 * bj); vv[bj] = *(const u32x4*)(V + off + 32 * bj); }
                const float bon = BON[(size_t)row * 16 + head] + BON[(size_t)(M + row) * 16 + head];
                float y[16]; float s = 0.f;
#pragma unroll
                for (int bj = 0; bj < 2; ++bj)
#pragma unroll
                    for (int w = 0; w < 4; ++w) { y[bj * 8 + 2 * w] = bflo(a[bj][w]) + bflo(b[bj][w]); y[bj * 8 + 2 * w + 1] = bfhi(a[bj][w]) + bfhi(b[bj][w]); }
#pragma unroll
                for (int j = 0; j < 16; ++j) s += y[j];
                s += swz_xor<16>(s); s = half_sum(s);
                const float mean = s * (1.0f / 64.0f); float q2 = 0.f;
#pragma unroll
                for (int j = 0; j < 16; ++j) { y[j] -= mean; q2 += y[j] * y[j]; }
                q2 += swz_xor<16>(q2); q2 = half_sum(q2);
                const float rstd = 1.0f / sqrtf(q2 * (1.0f / 64.0f) + 64e-5f);
#pragma unroll
                for (int bj = 0; bj < 2; ++bj) {
                    f32x4 o0, o1;
#pragma unroll
                    for (int j = 0; j < 4; ++j) {
                        const float v0 = (j & 1) ? bfhi(vv[bj][j >> 1]) : bflo(vv[bj][j >> 1]), v1 = (j & 1) ? bfhi(vv[bj][2 + (j >> 1)]) : bflo(vv[bj][2 + (j >> 1)]);
                        o0[j] = (y[bj * 8 + j] * rstd * lg[bj][0][j] + lb[bj][0][j] + bon * v0) * acc[ai][bj][m][0][j];
                        o1[j] = (y[bj * 8 + 4 + j] * rstd * lg[bj][1][j] + lb[bj][1][j] + bon * v1) * acc[ai][bj][m][1][j];
                    }
                    store8(O + off + 32 * bj, o0, o1);
                }
            }
    }
};
struct EpiSoftmax {
    static constexpr bool PERM = true;
    bf16* P; const float* ps;
    DI void operator()(EPI_ARGS) const {
        LAS f32x2* X = (LAS f32x2*)(lds + LDS_X);
        const int row0 = u.pm * 256, col0 = u.pn * 256 + wc * 32 + 8 * fq;
        float mw[2][4];
#pragma unroll
        for (int ai = 0; ai < 2; ++ai)
#pragma unroll
            for (int m = 0; m < 4; ++m) {
                const int rl = ai * 128 + wr * 64 + m * 16 + fr; const float s = rs_ps(ps, row0 + rl) * LOG2E;
                float mx = -3.0e38f;
#pragma unroll
                for (int bj = 0; bj < 2; ++bj)
#pragma unroll
                    for (int n = 0; n < 2; ++n) { acc[ai][bj][m][n] = acc[ai][bj][m][n] * s;
#pragma unroll
                        for (int j = 0; j < 4; ++j) mx = fmaxf(mx, acc[ai][bj][m][n][j]); }
                mx = fmaxf(mx, swz_xor<16>(mx)); mx = half_max(mx);
                float sum = 0.f;
#pragma unroll
                for (int bj = 0; bj < 2; ++bj)
#pragma unroll
                    for (int n = 0; n < 2; ++n)
#pragma unroll
                        for (int j = 0; j < 4; ++j) { const float p = fexp2(acc[ai][bj][m][n][j] - mx); acc[ai][bj][m][n][j] = p; sum += p; }
                sum += swz_xor<16>(sum); sum = half_sum(sum);
                mw[ai][m] = mx;
                if (fq == 0) X[rl * 4 + wc] = (f32x2){mx, sum};
            }
        asm volatile("s_waitcnt lgkmcnt(0)" ::: "memory"); __builtin_amdgcn_s_barrier(); asm volatile("" ::: "memory");
#pragma unroll
        for (int ai = 0; ai < 2; ++ai)
#pragma unroll
            for (int m = 0; m < 4; ++m) {
                const int rl = ai * 128 + wr * 64 + m * 16 + fr;
                const f32x2 a = X[rl * 4 + 0], b = X[rl * 4 + 1], c = X[rl * 4 + 2], d = X[rl * 4 + 3];
                const float mt = fmaxf(fmaxf(a.x, b.x), fmaxf(c.x, d.x));
                const float lt = a.y * fexp2(a.x - mt) + b.y * fexp2(b.x - mt) + c.y * fexp2(c.x - mt) + d.y * fexp2(d.x - mt);
                const float f = fexp2(mw[ai][m] - mt) / lt;
                bf16* rowp = P + (size_t)(row0 + rl) * 1024 + col0;
#pragma unroll
                for (int bj = 0; bj < 2; ++bj) store8(rowp + bj * 128, acc[ai][bj][m][0] * f, acc[ai][bj][m][1] * f);
            }
        asm volatile("s_waitcnt lgkmcnt(0)" ::: "memory"); __builtin_amdgcn_s_barrier(); asm volatile("" ::: "memory");
    }
};
struct EpiRwkv {
    static constexpr bool PERM = true;
    bf16* R; bf16* Kk; bf16* V; bf16* HD1; bf16* HD2;
    DI void operator()(EPI_ARGS) const {
        const int row0 = u.pm * 256 + wr * 64 + fr; const int g = u.pn >> 2;
        bf16* O; int ldc, colt, mode0 = 0, mode1 = 0;
        if (u.pn < 12) { O = R + (size_t)g * (32u << 20); ldc = 1024; colt = (u.pn & 3) * 256; }
        else if (u.pn == 12) { O = HD1; ldc = 256; colt = 0; mode0 = 1; }
        else { O = HD2; ldc = 256; colt = 0; mode0 = 2; mode1 = 2; }
        const int col0 = colt + wc * 32 + 8 * fq;
#pragma unroll
        for (int ai = 0; ai < 2; ++ai)
#pragma unroll
            for (int m = 0; m < 4; ++m) {
                bf16* rowp = O + (size_t)(row0 + ai * 128 + m * 16) * ldc + col0;
#pragma unroll
                for (int bj = 0; bj < 2; ++bj) { f32x4 v0 = acc[ai][bj][m][0], v1 = acc[ai][bj][m][1]; const int md = bj ? mode1 : mode0;
                    if (md == 1) {
#pragma unroll
                        for (int j = 0; j < 4; ++j) { v0[j] = tanhf_(v0[j]); v1[j] = tanhf_(v1[j]); } }
                    else if (md == 2) {
#pragma unroll
                        for (int j = 0; j < 4; ++j) { v0[j] = sigmoidf_(v0[j]); v1[j] = sigmoidf_(v1[j]); } }
                    store8(rowp + bj * 128, v0, v1); }
            }
    }
};

enum InIdx { I_X = 0, I_MEM, I_REL, I_NMIX, I_NXATTN, I_NMEM, I_NFFN, I_NFINAL, I_WIN, I_WOUT, I_CONVW, I_CONVB, I_CLNG, I_CLNB, I_LQ1, I_LK1, I_LQ2, I_LK2, I_SUBLN,
             I_MU, I_WR, I_WK, I_WV, I_WO, I_W0, I_W1, I_W2, I_A0, I_A1, I_A2, I_G1, I_G2, I_KK, I_KA, I_RK, I_LNG, I_LNB, I_XQ, I_XKV, I_XO, I_UP, I_DN, N_IN };
struct Args { const float* in[N_IN]; float* out; unsigned char* ws; int ph_lo, ph_hi; };
static_assert(sizeof(Args) == (N_IN + 2) * 8 + 8, "Args has no padding");

struct Frame {
    LAS unsigned char* lds;
    int tid, lane, wave, gw, ngw;
    unsigned char* ws;
};

DI Frame fresh(const Frame& F0) {
    Frame F = F0; F.tid = opaque(threadIdx.x); F.lane = F.tid & 63; F.wave = __builtin_amdgcn_readfirstlane(F.tid >> 6); F.gw = opq(blockIdx.x) * 8 + F.wave; F.ngw = opq(gridDim.x) * 8; return F;
}
struct TJob { const float* W; int K, N; bf16* WT; int ldt, row_off, col_off, perm; const float* gain; };
DI void tr_item(const TJob& J, LAS float* scr, int item, int lane) {
    const int nblk = J.N / 32, kb = item / nblk, nb = item % nblk, k0 = 64 * kb, n0 = 32 * nb;
    float scale = 1.0f; int drow = J.row_off + n0;
    if (J.perm) {
        if (n0 < 512) drow = 256 * (n0 >> 7) + (n0 & 127);
        else if (n0 < 1024) drow = 256 * ((n0 - 512) >> 7) + 128 + ((n0 - 512) & 127);
        else drow = n0;
        if (n0 >= 1024 && n0 < 1536) scale = 0.125f;
    }
    float tv[32];
    const float* wp = J.W + (size_t)(k0 + (lane >> 5)) * J.N + n0 + (lane & 31);
#pragma unroll
    for (int i = 0; i < 32; ++i) tv[i] = wp[(size_t)(2 * i) * J.N];
    if (J.gain) {
#pragma unroll
        for (int i = 0; i < 32; ++i) tv[i] *= J.gain[k0 + 2 * i + (lane >> 5)];
    }
#pragma unroll
    for (int i = 0; i < 32; ++i) scr[(2 * i + (lane >> 5)) * 33 + (lane & 31)] = tv[i] * scale;
    asm volatile("s_waitcnt lgkmcnt(0)" ::: "memory");
    const int c = lane & 7;
#pragma unroll
    for (int j = 0; j < 4; ++j) { const int n = (lane >> 3) + 8 * j; const LAS float* s = scr + (8 * c) * 33 + n;
        u32x4 o; o.x = pk2(s[0 * 33], s[1 * 33]); o.y = pk2(s[2 * 33], s[3 * 33]); o.z = pk2(s[4 * 33], s[5 * 33]); o.w = pk2(s[6 * 33], s[7 * 33]);
        *(u32x4*)(J.WT + (size_t)(drow + n) * J.ldt + J.col_off + k0 + 8 * c) = o; }
    asm volatile("s_waitcnt lgkmcnt(0)" ::: "memory");
}
constexpr int N_TJOBS = 31;
DI TJob get_tjob(int j, const Args& a, unsigned char* ws) {
    TJob J; J.perm = 0; J.gain = nullptr; J.row_off = 0; J.col_off = 0;
    if (j == 0) { J.W = a.in[opq(I_WIN)]; J.K = 1024; J.N = 2560; J.WT = (bf16*)(ws + WS_WIN); J.ldt = 1024; J.perm = 1; J.gain = a.in[opq(I_NMIX)]; }
    else if (j == 1) { J.W = a.in[opq(I_WOUT)]; J.K = 1024; J.N = 1024; J.WT = (bf16*)(ws + WS_WOUT); J.ldt = 1024; }
    else if (j < 4) { const int i = j - 2; J.W = a.in[opq(I_XKV)] + (size_t)i * 1024 * 2048; J.K = 1024; J.N = 2048; J.WT = (bf16*)(ws + WS_WKV) + (size_t)i * 2048 * 1024; J.ldt = 1024; J.gain = a.in[opq(I_NMEM)] + i * 1024; }
    else if (j < 6) { const int i = j - 4; J.W = a.in[opq(I_XO)] + (size_t)i * 1024 * 1024; J.K = 1024; J.N = 1024; J.WT = (bf16*)(ws + WS_WXO) + (size_t)i * 1024 * 1024; J.ldt = 1024; }
    else if (j < 8) { const int i = j - 6; J.W = a.in[opq(I_UP)] + (size_t)i * 1024 * 4096; J.K = 1024; J.N = 4096; J.WT = (bf16*)(ws + WS_WUP) + (size_t)i * 4096 * 1024; J.ldt = 1024; J.gain = a.in[opq(I_NFFN)] + i * 1024; }
    else if (j < 10) { const int i = j - 8; J.W = a.in[opq(I_DN)] + (size_t)i * 4096 * 1024; J.K = 4096; J.N = 1024; J.WT = (bf16*)(ws + WS_WDN) + (size_t)i * 1024 * 4096; J.ldt = 4096; }
    else if (j < 26) {
        const int q = j - 10, src = q >> 1, copy = q & 1; int mu = 0;
        J.K = 1024; J.WT = (bf16*)(ws + WS_WBIG); J.ldt = 2048; J.col_off = copy * 1024;
        if (src == 0) { J.W = a.in[opq(I_WR)]; J.N = 1024; J.row_off = 0; mu = 0; }
        else if (src == 1) { J.W = a.in[opq(I_WK)]; J.N = 1024; J.row_off = 1024; mu = 2; }
        else if (src == 2) { J.W = a.in[opq(I_WV)]; J.N = 1024; J.row_off = 2048; mu = 3; }
        else if (src == 3) { J.W = a.in[opq(I_W1)]; J.N = 64; J.row_off = 3072; mu = 1; }
        else if (src == 4) { J.W = a.in[opq(I_W1)] + 1024 * 64; J.N = 64; J.row_off = 3136; mu = 1; }
        else if (src == 5) { J.W = a.in[opq(I_A1)]; J.N = 64; J.row_off = 3200; mu = 4; }
        else if (src == 6) { J.W = a.in[opq(I_A1)] + 1024 * 64; J.N = 64; J.row_off = 3264; mu = 4; }
        else { J.W = a.in[opq(I_G1)]; J.N = 160; J.row_off = 3328; mu = 5; }
        if (copy) J.gain = a.in[opq(I_MU)] + mu * 1024;
    }
    else if (j < 30) { const int q = j - 26; J.W = (q < 2 ? a.in[opq(I_W2)] : a.in[opq(I_A2)]) + (size_t)(q & 1) * 64 * 1024; J.K = 64; J.N = 1024; J.WT = (bf16*)(ws + WS_W2T) + (size_t)q * 1024 * 64; J.ldt = 64; }
    else { J.W = a.in[opq(I_WO)]; J.K = 1024; J.N = 1024; J.WT = (bf16*)(ws + WS_WRO); J.ldt = 1024; }
    return J;
}
DI void row_to_bf16_rs(const float* xrow, bf16* orow, float* rs, int lane) {
    const f32x4* xr = (const f32x4*)xrow + lane;
    f32x4 v[4]; float s = 0.f;
#pragma unroll
    for (int j = 0; j < 4; ++j) { v[j] = xr[64 * j]; s += (v[j].x * v[j].x + v[j].y * v[j].y) + (v[j].z * v[j].z + v[j].w * v[j].w); }
    s = wave_sum(s);
    u32x2* o8 = (u32x2*)orow + lane;
#pragma unroll
    for (int j = 0; j < 4; ++j) { u32x2 w; w.x = pk2(v[j].x, v[j].y); w.y = pk2(v[j].z, v[j].w); o8[64 * j] = w; }
    if (lane == 0) *rs = 1.0f / sqrtf(s * (1.0f / D) + EPS);
}
DI void rows4_to_bf16_rs(const Frame& F, const float* X, bf16* O, float* rs, int nrows) {
    for (int m0 = F.gw * 4; m0 < nrows; m0 += F.ngw * 4) {
        f32x4 v[4][4];
#pragma unroll
        for (int r = 0; r < 4; ++r)
#pragma unroll
            for (int j = 0; j < 4; ++j) v[r][j] = ((const f32x4*)(X + (size_t)(m0 + r) * D))[F.lane + 64 * j];
#pragma unroll
        for (int r = 0; r < 4; ++r) {
            float s = 0.f;
#pragma unroll
            for (int j = 0; j < 4; ++j) s += (v[r][j].x * v[r][j].x + v[r][j].y * v[r][j].y) + (v[r][j].z * v[r][j].z + v[r][j].w * v[r][j].w);
            s = wave_sum(s);
            u32x2* o8 = (u32x2*)(O + (size_t)(m0 + r) * D) + F.lane;
#pragma unroll
            for (int j = 0; j < 4; ++j) { u32x2 w; w.x = pk2(v[r][j].x, v[r][j].y); w.y = pk2(v[r][j].z, v[r][j].w); o8[64 * j] = w; }
            if (F.lane == 0) rs[m0 + r] = 1.0f / sqrtf(s * (1.0f / D) + EPS);
        }
    }
}
DI int t5_bucket(int rel) {
    const int n = rel < 0 ? -rel : rel; int r = rel > 0 ? 16 : 0;
    if (n < 8) return r + n;
    int lg = 8; lg += (n >= 12); lg += (n >= 16); lg += (n >= 23); lg += (n >= 32); lg += (n >= 46); lg += (n >= 64); lg += (n >= 91);
    return r + lg;
}
DI void phase_prologue(const Frame& F0, const Args& a, unsigned char* ws) {
    const Frame F = fresh(F0);
    LAS float* scr = (LAS float*)(F.lds + F.wave * 16384);
    for (int j = 0; j < N_TJOBS; ++j) {
        const TJob J = get_tjob(j, a, ws); const int items = (J.K / 64) * (J.N / 32);
        for (int it = F.gw; it < items; it += F.ngw) tr_item(J, scr, it, F.lane);
    }
    const int gt = F.gw * 64 + F.lane, ngt = F.ngw * 64;
    for (int i = 0; i < 2; ++i) {
        const float* W = a.in[opq(I_XQ)] + (size_t)i * 1024 * 1024; const float* g = a.in[opq(I_NXATTN)] + i * 1024; bf16* O = (bf16*)(ws + WS_WQN) + (size_t)i * 1024 * 1024;
        for (int e = gt; e < 1024 * 1024 / 4; e += ngt) { const f32x4 v = ((const f32x4*)W)[e]; const float s = g[(e * 4) >> 10] * 0.0625f; u32x2 w; w.x = pk2(v.x * s, v.y * s); w.y = pk2(v.z * s, v.w * s); ((u32x2*)O)[e] = w; }
    }
    { const float* W = a.in[opq(I_G2)]; bf16* O = (bf16*)(ws + WS_G2T);
      for (int e = gt; e < 1024 * 256; e += ngt) { const int rown = e >> 8, k = e & 255, cc = rown & 255;
        const int n = (rown & ~255) + 64 * ((cc >> 5) & 3) + 32 * (cc >> 7) + (cc & 31);
        O[e] = (bf16)(k < 160 ? f2bf(W[(size_t)k * 1024 + n]) : 0u); } }
    { u32x4* O = (u32x4*)((bf16*)(ws + WS_WBIG) + (size_t)3488 * 2048);
      for (int e = gt; e < 96 * 2048 * 2 / 16; e += ngt) O[e] = (u32x4){0u, 0u, 0u, 0u}; }
    rows4_to_bf16_rs(F, a.in[opq(I_X)], (bf16*)(ws + WS_SA), (float*)(ws + WS_RS), M);
    rows4_to_bf16_rs(F, a.in[opq(I_MEM)], (bf16*)(ws + WS_MEMB), (float*)(ws + WS_RSMEM), MMEM);
    { float* B = (float*)(ws + WS_BIAS); const float* tab = a.in[opq(I_REL)];
      for (int e = gt; e < 4 * 4096; e += ngt) { const int h = e >> 12, idx = e & 4095; const int rel = idx - 2047; B[e] = idx < 4095 ? tab[t5_bucket(rel) * 4 + h] * LOG2E : 0.f; } }
    if (F.gw == 0) {
        const float q1 = a.in[opq(I_LQ1)][F.lane] * a.in[opq(I_LK1)][F.lane], q2 = a.in[opq(I_LQ2)][F.lane] * a.in[opq(I_LK2)][F.lane];
        const float s1 = wave_sum(q1), s2 = wave_sum(q2);
        if (F.lane == 0) ((float*)(ws + WS_LAM))[0] = expf(s1) - expf(s2) + 0.2f;
    }
}

DI void phase_norm(const Frame& F0, const float* h, bf16* hb, float* rs) {
    const Frame F = fresh(F0);
    for (int m = F.gw; m < M; m += F.ngw) row_to_bf16_rs(h + (size_t)m * D, hb + (size_t)m * D, rs + m, F.lane);
}
DI void phase_final_norm(const Frame& F0, const bf16* h, float* out, const float* g, const float osc) {
    const Frame F = fresh(F0);
    f32x4 gv[4];
#pragma unroll
    for (int j = 0; j < 4; ++j) gv[j] = ((const f32x4*)g)[F.lane + 64 * j];
    for (int m0 = F.gw * 4; m0 < M; m0 += F.ngw * 4) {
        u32x2 hw[4][4];
#pragma unroll
        for (int r = 0; r < 4; ++r)
#pragma unroll
            for (int j = 0; j < 4; ++j) hw[r][j] = ((const u32x2*)(h + (size_t)(m0 + r) * D))[F.lane + 64 * j];
#pragma unroll
        for (int r = 0; r < 4; ++r) {
            f32x4 v[4]; float s = 0.f;
#pragma unroll
            for (int j = 0; j < 4; ++j) { v[j] = (f32x4){bflo(hw[r][j].x), bfhi(hw[r][j].x), bflo(hw[r][j].y), bfhi(hw[r][j].y)}; s += (v[j].x * v[j].x + v[j].y * v[j].y) + (v[j].z * v[j].z + v[j].w * v[j].w); }
            const float rr = osc / sqrtf(wave_sum(s) * (1.0f / D) + EPS);
            f32x4* xr = (f32x4*)(out + (size_t)(m0 + r) * D) + F.lane;
#pragma unroll
            for (int j = 0; j < 4; ++j) xr[64 * j] = v[j] * rr * gv[j];
        }
    }
}
DI void phase_rwkv_shift(const Frame& F0, const bf16* h, const float* g, bf16* A1) {
    const Frame F = fresh(F0);
    f32x4 gv[4];
#pragma unroll
    for (int j = 0; j < 4; ++j) gv[j] = ((const f32x4*)g)[F.lane + 64 * j];
    for (int ch = F.gw; ch < M / 16; ch += F.ngw) {
        const int m0 = ch * 16, t0 = m0 & (T - 1);
        f32x4 p2[4], p1[4], cu[4];
#pragma unroll
        for (int j = 0; j < 4; ++j) { p2[j] = (f32x4){0.f, 0.f, 0.f, 0.f}; p1[j] = p2[j]; cu[j] = p2[j]; }
#pragma unroll 1
        for (int g6 = 0; g6 < 3; ++g6) {
            f32x4 ld[6][4];
#pragma unroll
            for (int r = 0; r < 6; ++r) { const int i = g6 * 6 + r - 1, t = t0 + i; const bool ok = (t >= 0 && t < T);
#pragma unroll
                for (int j = 0; j < 4; ++j) { const u32x2 w = ok ? ((const u32x2*)(h + (size_t)(m0 + i) * D))[F.lane + 64 * j] : (u32x2){0u, 0u}; ld[r][j] = (f32x4){bflo(w.x), bfhi(w.x), bflo(w.y), bfhi(w.y)}; } }
#pragma unroll
            for (int r = 0; r < 6; ++r) {
                const int i = g6 * 6 + r - 1;
                float s = 0.f;
#pragma unroll
                for (int j = 0; j < 4; ++j) { p2[j] = p1[j]; p1[j] = cu[j]; cu[j] = ld[r][j]; s += (cu[j].x * cu[j].x + cu[j].y * cu[j].y) + (cu[j].z * cu[j].z + cu[j].w * cu[j].w); }
                const float rr = 1.0f / sqrtf(wave_sum(s) * (1.0f / D) + EPS);
#pragma unroll
                for (int j = 0; j < 4; ++j) cu[j] = cu[j] * rr * gv[j];
                if (i >= 1) {
                    u32x2* o = (u32x2*)(A1 + (size_t)(m0 + i - 1) * 2048) + F.lane;
#pragma unroll
                    for (int j = 0; j < 4; ++j) { const f32x4 hh = (p2[j] + cu[j]) * 0.5f - p1[j];
                        u32x2 w; w.x = pk2(p1[j].x, p1[j].y); w.y = pk2(p1[j].z, p1[j].w); o[64 * j] = w;
                        u32x2 w2; w2.x = pk2(hh.x, hh.y); w2.y = pk2(hh.z, hh.w); o[256 + 64 * j] = w2; }
                }
            }
        }
    }
}
DI void phase_rwkv_comb(const Frame& F0, const bf16* YF, const bf16* YB, const bf16* V, const bf16* GT, const float* BON, const float* lng, const float* lnb, bf16* O) {
    const Frame F = fresh(F0);
    const int hd = F.lane >> 2, c0 = F.lane * 16;
    float lg[16], lb[16];
#pragma unroll
    for (int j = 0; j < 16; ++j) { lg[j] = lng[c0 + j]; lb[j] = lnb[c0 + j]; }
    for (int m0 = F.gw * 2; m0 < M; m0 += F.ngw * 2) {
        u32x4 a[2][2], b[2][2], vv[2][2], gg[2][2]; float bonr[2];
#pragma unroll
        for (int r = 0; r < 2; ++r) { const size_t off = (size_t)(m0 + r) * D + c0;
#pragma unroll
            for (int q = 0; q < 2; ++q) { a[r][q] = ((const u32x4*)(YF + off))[q]; b[r][q] = ((const u32x4*)(YB + off))[q]; vv[r][q] = ((const u32x4*)(V + off))[q]; gg[r][q] = ((const u32x4*)(GT + off))[q]; }
            bonr[r] = BON[(size_t)(m0 + r) * 16 + hd] + BON[(size_t)(M + m0 + r) * 16 + hd]; }
#pragma unroll
        for (int r = 0; r < 2; ++r) {
            const size_t off = (size_t)(m0 + r) * D + c0; const float bon = bonr[r];
            float y[16]; float s = 0.f;
#pragma unroll
            for (int q = 0; q < 2; ++q)
#pragma unroll
                for (int w = 0; w < 4; ++w) { y[q * 8 + 2 * w] = bflo(a[r][q][w]) + bflo(b[r][q][w]); y[q * 8 + 2 * w + 1] = bfhi(a[r][q][w]) + bfhi(b[r][q][w]); }
#pragma unroll
            for (int j = 0; j < 16; ++j) s += y[j];
            s += swz_xor<1>(s); s += swz_xor<2>(s);
            const float mean = s * (1.0f / 64.0f); float q2 = 0.f;
#pragma unroll
            for (int j = 0; j < 16; ++j) { y[j] -= mean; q2 += y[j] * y[j]; }
            q2 += swz_xor<1>(q2); q2 += swz_xor<2>(q2);
            const float rstd = 1.0f / sqrtf(q2 * (1.0f / 64.0f) + 64e-5f);
            u32x4 o[2];
#pragma unroll
            for (int q = 0; q < 2; ++q)
#pragma unroll
                for (int w = 0; w < 4; ++w) {
                    const int j = q * 8 + 2 * w;
                    const float r0 = (y[j] * rstd * lg[j] + lb[j] + bon * bflo(vv[r][q][w])) * bflo(gg[r][q][w]);
                    const float r1 = (y[j + 1] * rstd * lg[j + 1] + lb[j + 1] + bon * bfhi(vv[r][q][w])) * bfhi(gg[r][q][w]);
                    o[q][w] = pk2(r0, r1);
                }
            ((u32x4*)(O + off))[0] = o[0]; ((u32x4*)(O + off))[1] = o[1];
        }
    }
}
constexpr int CV_ROWB = 1040, CV_IN_BYTES = 94 * CV_ROWB, CV_W_OFF = CV_IN_BYTES;
DI void conv_load_weights(const Frame& F0, const float* cw) {
    const Frame F = fresh(F0);
    LAS bf16* W = (LAS bf16*)(F.lds + CV_W_OFF);
    for (int e = F.tid; e < 31 * 512; e += 512) W[e] = (bf16)f2bf(cw[e]);
}
DI void conv_unit(const Frame& F0, int unit, const bf16* GLU, const float* cb, const float* lg, const float* lb, bf16* MIX) {
    const Frame F = fresh(F0);
    const int b = unit >> 5, t0 = (unit & 31) * 64;
    __syncthreads();
    for (int p = F.tid; p < 94 * 64; p += 512) {
        const int r = p >> 6, c = p & 63, t = t0 - 15 + r;
        u32x4 v = (u32x4){0u, 0u, 0u, 0u};
        if (t >= 0 && t < T) v = *(const u32x4*)(GLU + (size_t)(b * T + t) * 512 + c * 8);
        *(LAS u32x4*)(F.lds + r * CV_ROWB + c * 16) = v;
    }
    __syncthreads();
    const int tl = F.tid >> 3, chunk = F.tid & 7;
    float y[64];
#pragma unroll
    for (int i = 0; i < 8; ++i) {
        const int cg = chunk + 8 * i;
        float acc[8];
#pragma unroll
        for (int e = 0; e < 8; ++e) acc[e] = cb[cg * 8 + e];
#pragma unroll 1
        for (int j = 0; j < 31; ++j) {
            const u32x4 x = *(const LAS u32x4*)(F.lds + (tl + j) * CV_ROWB + cg * 16);
            const u32x4 w = *(const LAS u32x4*)(F.lds + CV_W_OFF + j * 1024 + cg * 16);
#pragma unroll
            for (int q = 0; q < 4; ++q) { acc[2 * q] += bflo(x[q]) * bflo(w[q]); acc[2 * q + 1] += bfhi(x[q]) * bfhi(w[q]); }
        }
#pragma unroll
        for (int e = 0; e < 8; ++e) y[i * 8 + e] = acc[e];
    }
    float s = 0.f;
#pragma unroll
    for (int j = 0; j < 64; ++j) s += y[j];
    s += swz_xor<1>(s); s += swz_xor<2>(s); s += swz_xor<4>(s);
    const float mean = s * (1.0f / 512.0f); float q2 = 0.f;
#pragma unroll
    for (int j = 0; j < 64; ++j) { y[j] -= mean; q2 += y[j] * y[j]; }
    q2 += swz_xor<1>(q2); q2 += swz_xor<2>(q2); q2 += swz_xor<4>(q2);
    const float rstd = 1.0f / sqrtf(q2 * (1.0f / 512.0f) + 1e-5f);
    bf16* orow = MIX + (size_t)(b * T + t0 + tl) * 1024;
#pragma unroll
    for (int i = 0; i < 8; ++i) {
        const int c0 = (chunk + 8 * i) * 8;
        const f32x4 g0 = *(const f32x4*)(lg + c0), g1 = *(const f32x4*)(lg + c0 + 4), b0 = *(const f32x4*)(lb + c0), b1 = *(const f32x4*)(lb + c0 + 4);
        f32x4 o0, o1;
#pragma unroll
        for (int e = 0; e < 4; ++e) { const float v0 = y[i * 8 + e] * rstd * g0[e] + b0[e], v1 = y[i * 8 + 4 + e] * rstd * g1[e] + b1[e]; o0[e] = v0 * sigmoidf_(v0); o1[e] = v1 * sigmoidf_(v1); }
        store8(orow + c0, o0, o1);
    }
}

constexpr int DA_KROW = 272, DA_VROW = 144, DA_KB = 64 * DA_KROW, DA_VB = 128 * DA_VROW, DA_BUF = DA_KB + DA_VB;
DI int crow(int reg, int hf) { return (reg & 3) + 8 * (reg >> 2) + 4 * hf; }
DI void diffattn_unit(const Frame& F0, int unit, const bf16* QK, const bf16* VT, const float* BIAS, const float lam, const float* subg, bf16* MIX) {
    const Frame F = fresh(F0);
    const int b = unit >> 6, h = (unit >> 4) & 3, qb = unit & 15;
    const int c = F.wave >> 2, qs = F.wave & 3, r32 = F.lane & 31, hf = F.lane >> 5;
    const int q0w = qb * 128 + qs * 32;
    const float* bias_h = BIAS + h * 4096 + 2047;
    bf16x8 Qf[4];
    { const bf16* qp = QK + (size_t)(b * T + q0w + r32) * 1024 + h * 128 + c * 64 + 8 * hf;
#pragma unroll
      for (int ks = 0; ks < 4; ++ks) Qf[ks] = *(const bf16x8*)(qp + 16 * ks); }
    const bf16* kg[2]; const bf16* vg[2]; int kl[2], vl[2];
#pragma unroll
    for (int i = 0; i < 2; ++i) { const int p = F.tid + 512 * i;
        kg[i] = QK + (size_t)(b * T + (p >> 4)) * 1024 + 512 + h * 128 + (p & 15) * 8; kl[i] = (p >> 4) * DA_KROW + (p & 15) * 16;
        vg[i] = VT + (size_t)(h * 128 + (p >> 3)) * M + b * T + (p & 7) * 8; vl[i] = DA_KB + (p >> 3) * DA_VROW + ((p & 7) >> 1) * 32 + ((p & 7) & 1) * 8; }
    u32x4 kr[2], vr[2];
#pragma unroll
    for (int i = 0; i < 2; ++i) { kr[i] = *(const u32x4*)(kg[i]); vr[i] = *(const u32x4*)(vg[i]); }
    __syncthreads();
    LAS float* const btab = (LAS float*)(F.lds + 2 * DA_BUF);
    btab[F.tid] = bias_h[F.tid - 256];
#pragma unroll
    for (int i = 0; i < 2; ++i) { *(LAS u32x4*)(F.lds + kl[i]) = kr[i]; *(LAS u32x2*)(F.lds + vl[i]) = (u32x2){vr[i].x, vr[i].y}; *(LAS u32x2*)(F.lds + vl[i] + 16) = (u32x2){vr[i].z, vr[i].w}; }
#pragma unroll
    for (int i = 0; i < 2; ++i) { kr[i] = *(const u32x4*)(kg[i] + (size_t)64 * 1024); vr[i] = *(const u32x4*)(vg[i] + 64); }
    __syncthreads();
    f32x16 O[4];
#pragma unroll
    for (int vt = 0; vt < 4; ++vt)
#pragma unroll
        for (int i = 0; i < 16; ++i) O[vt][i] = 0.f;
    float lsum = 0.f;
    const float cbR = bias_h[91], cbL = bias_h[-91];
    const int ka = r32 * DA_KROW + c * 128 + 16 * hf;
    const int va = DA_KB + r32 * DA_VROW + 16 * hf;
    for (int kt = 0; kt < 32; ++kt) {
        const int k0 = kt * 64;
        LAS unsigned char* buf = F.lds + (kt & 1) * DA_BUF;
        const int dmin = k0 - (q0w + 31), dmax = k0 + 63 - q0w;
        const bool far = (dmin >= 91) || (dmax <= -91);
        const float cb = dmin >= 91 ? cbR : cbL;
        bf16x8 kf[8];
#pragma unroll
        for (int f = 0; f < 8; ++f) kf[f] = *(const LAS bf16x8*)(buf + ka + (f >> 2) * 32 * DA_KROW + (f & 3) * 32);
        __builtin_amdgcn_sched_barrier(0);
        f32x16 S0, S1;
#pragma unroll
        for (int i = 0; i < 16; ++i) { S0[i] = 0.f; S1[i] = 0.f; }
        bf16x8 vf0[8];
#pragma unroll
        for (int f = 0; f < 8; ++f) vf0[f] = *(const LAS bf16x8*)(buf + va + (f & 3) * 32 * DA_VROW + (f >> 2) * 32);
#pragma unroll
        for (int ks = 0; ks < 4; ++ks) S0 = __builtin_amdgcn_mfma_f32_32x32x16_bf16(kf[ks], Qf[ks], S0, 0, 0, 0);
#pragma unroll
        for (int ks = 0; ks < 4; ++ks) S1 = __builtin_amdgcn_mfma_f32_32x32x16_bf16(kf[4 + ks], Qf[ks], S1, 0, 0, 0);
        __builtin_amdgcn_sched_barrier(0);
        bf16x8 vf1[8];
#pragma unroll
        for (int f = 0; f < 8; ++f) vf1[f] = *(const LAS bf16x8*)(buf + va + (f & 3) * 32 * DA_VROW + (2 + (f >> 2)) * 32);
        bf16x8 pa0[2], pa1[2];
        {
            float p[16];
            if (far) {
#pragma unroll
                for (int i = 0; i < 16; ++i) p[i] = fexp2(S0[i] * LOG2E + cb); } else { const LAS float* tb = btab + (k0 - (q0w + r32) + 256);
#pragma unroll
                for (int i = 0; i < 16; ++i) p[i] = fexp2(S0[i] * LOG2E + tb[crow(i, hf)]); }
#pragma unroll
            for (int i = 0; i < 16; ++i) lsum += p[i];
#pragma unroll
            for (int s2 = 0; s2 < 2; ++s2) { u32x4 pw; pw.x = pk2(p[8 * s2], p[8 * s2 + 1]); pw.y = pk2(p[8 * s2 + 2], p[8 * s2 + 3]); pw.z = pk2(p[8 * s2 + 4], p[8 * s2 + 5]); pw.w = pk2(p[8 * s2 + 6], p[8 * s2 + 7]); pa0[s2] = __builtin_bit_cast(bf16x8, pw); }
        }
        __builtin_amdgcn_sched_barrier(0);
#pragma unroll
        for (int f = 0; f < 8; ++f) O[f & 3] = __builtin_amdgcn_mfma_f32_32x32x16_bf16(pa0[f >> 2], vf0[f], O[f & 3], 0, 0, 0);
        {
            float p[16];
            if (far) {
#pragma unroll
                for (int i = 0; i < 16; ++i) p[i] = fexp2(S1[i] * LOG2E + cb); } else { const LAS float* tb = btab + (k0 + 32 - (q0w + r32) + 256);
#pragma unroll
                for (int i = 0; i < 16; ++i) p[i] = fexp2(S1[i] * LOG2E + tb[crow(i, hf)]); }
#pragma unroll
            for (int i = 0; i < 16; ++i) lsum += p[i];
#pragma unroll
            for (int s2 = 0; s2 < 2; ++s2) { u32x4 pw; pw.x = pk2(p[8 * s2], p[8 * s2 + 1]); pw.y = pk2(p[8 * s2 + 2], p[8 * s2 + 3]); pw.z = pk2(p[8 * s2 + 4], p[8 * s2 + 5]); pw.w = pk2(p[8 * s2 + 6], p[8 * s2 + 7]); pa1[s2] = __builtin_bit_cast(bf16x8, pw); }
        }
        __builtin_amdgcn_sched_barrier(0);
#pragma unroll
        for (int f = 0; f < 8; ++f) O[f & 3] = __builtin_amdgcn_mfma_f32_32x32x16_bf16(pa1[f >> 2], vf1[f], O[f & 3], 0, 0, 0);
        if (kt + 1 < 32) {
            LAS unsigned char* nb = F.lds + ((kt + 1) & 1) * DA_BUF;
#pragma unroll
            for (int i = 0; i < 2; ++i) { *(LAS u32x4*)(nb + kl[i]) = kr[i]; *(LAS u32x2*)(nb + vl[i]) = (u32x2){vr[i].x, vr[i].y}; *(LAS u32x2*)(nb + vl[i] + 16) = (u32x2){vr[i].z, vr[i].w}; }
        }
        if (kt + 2 < 32) {
#pragma unroll
            for (int i = 0; i < 2; ++i) { kr[i] = *(const u32x4*)(kg[i] + (size_t)(k0 + 128) * 1024); vr[i] = *(const u32x4*)(vg[i] + k0 + 128); }
        }
        __syncthreads();
    }
    lsum = half_sum(lsum);
    LAS float* XO = (LAS float*)F.lds;
    LAS float* LW = (LAS float*)(F.lds + 65536) + F.wave * 32;
    if (hf == 0) LW[r32] = 1.0f / lsum;
    asm volatile("s_waitcnt lgkmcnt(0)" ::: "memory");
    float il[16];
#pragma unroll
    for (int i = 0; i < 16; ++i) il[i] = LW[crow(i, hf)];
    if (c == 1) {
#pragma unroll
        for (int vt = 0; vt < 4; ++vt)
#pragma unroll
            for (int i = 0; i < 16; ++i) XO[(qs * 32 + crow(i, hf)) * 128 + vt * 32 + r32] = O[vt][i] * il[i];
    }
    __syncthreads();
    if (c == 0) {
        float ss[16];
#pragma unroll
        for (int i = 0; i < 16; ++i) ss[i] = 0.f;
#pragma unroll
        for (int vt = 0; vt < 4; ++vt)
#pragma unroll
            for (int i = 0; i < 16; ++i) { const float o = O[vt][i] * il[i] - lam * XO[(qs * 32 + crow(i, hf)) * 128 + vt * 32 + r32]; O[vt][i] = o; ss[i] += o * o; }
#pragma unroll
        for (int i = 0; i < 16; ++i) { float v = ss[i]; v += swz_xor<1>(v); v += swz_xor<2>(v); v += swz_xor<4>(v); v += swz_xor<8>(v); v += swz_xor<16>(v); ss[i] = 0.8f / sqrtf(v * (1.0f / 128.0f) + EPS); }
#pragma unroll
        for (int vt = 0; vt < 4; ++vt) {
            const float g = subg[vt * 32 + r32];
#pragma unroll
            for (int i = 0; i < 16; ++i) MIX[(size_t)(b * T + q0w + crow(i, hf)) * 1024 + 512 + h * 128 + vt * 32 + r32] = (bf16)f2bf(O[vt][i] * ss[i] * g);
        }
    }
}

constexpr int SC_VECB = 256, SC_STEPB = 6 * SC_VECB, SC_BUFB = 16 * SC_STEPB;
constexpr int SC_SCR_OFF = 4 * SC_BUFB, SC_SCR_W = 16 * 68 * 4;
DI float dpp_x1(float v) { return __builtin_bit_cast(float, __builtin_amdgcn_update_dpp(0, __builtin_bit_cast(int, v), 0xB1, 0xF, 0xF, true)); }
DI float dpp_x2(float v) { return __builtin_bit_cast(float, __builtin_amdgcn_update_dpp(0, __builtin_bit_cast(int, v), 0x4E, 0xF, 0xF, true)); }
DI float quad_sum(float v) { v += dpp_x1(v); v += dpp_x2(v); return v; }

DI float a_fmac(float acc, float a, float b) { return __builtin_fmaf(a, b, acc); }
DI float a_fma(float a, float b, float c) { return __builtin_fmaf(a, b, c); }
DI float a_mul(float a, float b) { return a * b; }
struct ScanPtrs { const bf16 *R, *K, *V, *HD1, *W2T; const float *w0, *a0, *kk, *ka, *rk; bf16 *YF, *YB; float* BON; unsigned* ERR; };

DI void scan_pair(const Frame& F0, int bh, const ScanPtrs& P) {
    const Frame F = fresh(F0);
    const int b = bh >> 4, h = bh & 15;
    __syncthreads();
    if (F.wave < 4) {
        const int z = F.wave >> 1, rh = F.wave & 1, rp = F.lane >> 2, jq = F.lane & 3, i0 = rh * 32 + 2 * rp;
        float S0[16], S1[16];
#pragma unroll
        for (int j = 0; j < 16; ++j) { S0[j] = 0.f; S1[j] = 0.f; }
        bf16* Y = z ? P.YB : P.YF;
        __builtin_amdgcn_s_barrier();
#ifdef MK_TPROBE
        unsigned long long tp_acc = 0ull, tp_phase0 = __builtin_amdgcn_s_memtime();
#endif
        for (int e = 0; e < T / 16; ++e) {
#ifdef MK_TPROBE
            const unsigned long long tp0 = __builtin_amdgcn_s_memtime();
#endif
            const LAS unsigned char* base = F.lds + (z * 2 + (e & 1)) * SC_BUFB + jq * 64;
            const int t0c = z ? T - 16 * (e + 1) : 16 * e;
            bf16* yrow = Y + (size_t)(b * T + t0c) * 1024 + h * 64 + i0;
            f32x4 wv[2][4], kv[2][4], bv[2][4], av[2][4], rv[2][4]; f32x2 v2[2];
#define SC_FETCH(slot, li_) do { const LAS unsigned char* sb_ = base + (li_) * SC_STEPB; _Pragma("unroll") for (int q = 0; q < 4; ++q) { \
                av[slot][q] = *(const LAS f32x4*)(sb_ + 3 * SC_VECB + q * 16); wv[slot][q] = *(const LAS f32x4*)(sb_ + q * 16); kv[slot][q] = *(const LAS f32x4*)(sb_ + SC_VECB + q * 16); \
                bv[slot][q] = *(const LAS f32x4*)(sb_ + 2 * SC_VECB + q * 16); rv[slot][q] = *(const LAS f32x4*)(sb_ + 4 * SC_VECB + q * 16); } \
                v2[slot] = *(const LAS f32x2*)(sb_ - jq * 64 + 5 * SC_VECB + i0 * 4); } while (0)
            SC_FETCH(0, z ? 15 : 0);
#pragma unroll
            for (int s = 0; s < 16; ++s) {
                const int li = z ? 15 - s : s, cs = s & 1, ns = cs ^ 1;
                if (s < 15) SC_FETCH(ns, z ? 14 - s : s + 1);
                __builtin_amdgcn_sched_barrier(0);
                float sa0 = 0.f, sa1 = 0.f, sb0 = 0.f, sb1 = 0.f;
#pragma unroll
                for (int j = 0; j < 16; j += 2) { const float a0 = av[cs][j >> 2][j & 3], a1 = av[cs][(j + 1) >> 2][(j + 1) & 3];
                    sa0 = a_fmac(sa0, S0[j], a0); sb0 = a_fmac(sb0, S1[j], a0); sa1 = a_fmac(sa1, S0[j + 1], a1); sb1 = a_fmac(sb1, S1[j + 1], a1); }
                const float sa = quad_sum(sa0 + sa1), sb = quad_sum(sb0 + sb1);
                const float v0 = v2[cs].x, v1 = v2[cs].y;
                float y0 = 0.f, y1 = 0.f, z0 = 0.f, z1 = 0.f;
#pragma unroll
                for (int j = 0; j < 16; ++j) {
                    const float wj = wv[cs][j >> 2][j & 3], bj = bv[cs][j >> 2][j & 3], kj = kv[cs][j >> 2][j & 3], rj = rv[cs][j >> 2][j & 3];
                    S0[j] = a_fma(S0[j], wj, a_fma(sa, bj, a_mul(v0, kj)));
                    S1[j] = a_fma(S1[j], wj, a_fma(sb, bj, a_mul(v1, kj)));
                    if (j & 1) { y1 = a_fmac(y1, S0[j], rj); z1 = a_fmac(z1, S1[j], rj); } else { y0 = a_fmac(y0, S0[j], rj); z0 = a_fmac(z0, S1[j], rj); }
                }
                f32x2 y; y.x = quad_sum(y0 + y1); y.y = quad_sum(z0 + z1);
                if (jq == 0) *(unsigned*)(yrow + (size_t)li * 1024) = pk2(y.x, y.y);
                __builtin_amdgcn_sched_barrier(0);
            }
#undef SC_FETCH
            asm volatile("s_waitcnt lgkmcnt(0)" ::: "memory");
#ifdef MK_TPROBE
            tp_acc += __builtin_amdgcn_s_memtime() - tp0;
#endif
            __builtin_amdgcn_s_barrier();
        }
#ifdef MK_TPROBE
        if (blockIdx.x == 0 && F.wave == 0) {
            const unsigned long long tot = __builtin_amdgcn_s_memtime() - tp_phase0;
            const unsigned long long amt = (MK_TPROBE > 0 ? (unsigned long long)MK_TPROBE * tp_acc : (unsigned long long)(-(MK_TPROBE)) * (tot - tp_acc));
            const unsigned long long w0 = __builtin_amdgcn_s_memtime();
            while (__builtin_amdgcn_s_memtime() - w0 < amt) __builtin_amdgcn_s_sleep(8);
        }
#endif
    } else {
        const int pw = F.wave - 4, z = pw >> 1, par = pw & 1;
        const int l15 = F.lane & 15, l4 = F.lane >> 4, row = F.lane >> 2, cq = F.lane & 3;
        const bf16* w2p = P.W2T + (size_t)z * 65536 + (size_t)(h * 64 + l15) * 64 + 8 * l4;
        const int ch0 = h * 64 + cq * 16;
        LAS float* scrW = (LAS float*)(F.lds + SC_SCR_OFF + pw * 2 * SC_SCR_W);
        LAS float* scrA = scrW + 16 * 68;
        bf16x8 Ahw[2], Aha[2]; u32x4 r16[2], k16[2], v16[2];
        auto do_load = [&](int c) {
            const int t0c = z ? T - 16 * (c + 1) : 16 * c; const size_t m0 = (size_t)b * T + t0c;
#pragma unroll
            for (int ks = 0; ks < 2; ++ks) { const bf16* p = P.HD1 + (m0 + l15) * 256 + z * 64 + 32 * ks + 8 * l4; Ahw[ks] = *(const bf16x8*)p; Aha[ks] = *(const bf16x8*)(p + 128); }
            const size_t off = (m0 + row) * 1024 + ch0;
#pragma unroll
            for (int q = 0; q < 2; ++q) { r16[q] = ((const u32x4*)(P.R + off))[q]; k16[q] = ((const u32x4*)(P.K + off))[q]; v16[q] = ((const u32x4*)(P.V + off))[q]; }
        };
        auto do_compute = [&](int c) {
            const int t0c = z ? T - 16 * (c + 1) : 16 * c; const size_t m0 = (size_t)b * T + t0c;
#pragma unroll
            for (int nt = 0; nt < 4; ++nt) {
                f32x4 dw = (f32x4){0.f, 0.f, 0.f, 0.f}, da = dw;
#pragma unroll
                for (int ks = 0; ks < 2; ++ks) { const bf16x8 wf = *(const bf16x8*)(w2p + nt * 1024 + ks * 32), af = *(const bf16x8*)(w2p + 2 * 65536 + nt * 1024 + ks * 32);
                    dw = __builtin_amdgcn_mfma_f32_16x16x32_bf16(Ahw[ks], wf, dw, 0, 0, 0); da = __builtin_amdgcn_mfma_f32_16x16x32_bf16(Aha[ks], af, da, 0, 0, 0); }
#pragma unroll
                for (int rg = 0; rg < 4; ++rg) { scrW[(4 * l4 + rg) * 68 + 16 * nt + l15] = dw[rg]; scrA[(4 * l4 + rg) * 68 + 16 * nt + l15] = da[rg]; }
            }
            asm volatile("s_waitcnt lgkmcnt(0)" ::: "memory");
            float ssq = 0.f;
#pragma unroll
            for (int q = 0; q < 2; ++q)
#pragma unroll
                for (int w = 0; w < 4; ++w) { const f32x2 kc = *(const f32x2*)(P.kk + ch0 + q * 8 + 2 * w); const float k0 = bflo(k16[q][w]) * kc.x, k1 = bfhi(k16[q][w]) * kc.y; ssq += k0 * k0 + k1 * k1; }
            ssq = quad_sum(ssq);
            const float inv = 1.0f / fmaxf(sqrtf(ssq), 1e-12f);
            float bon = 0.f;
            LAS unsigned char* sb = F.lds + (z * 2 + (c & 1)) * SC_BUFB + row * SC_STEPB + cq * 64;
#pragma unroll
            for (int q = 0; q < 4; ++q) {
                const f32x4 wp = *(const LAS f32x4*)(scrW + row * 68 + cq * 16 + q * 4), ap = *(const LAS f32x4*)(scrA + row * 68 + cq * 16 + q * 4);
                const f32x4 w0v = *(const f32x4*)(P.w0 + z * 1024 + ch0 + q * 4), a0v = *(const f32x4*)(P.a0 + z * 1024 + ch0 + q * 4);
                const f32x4 kkv = *(const f32x4*)(P.kk + ch0 + q * 4), kav = *(const f32x4*)(P.ka + ch0 + q * 4), rkv = *(const f32x4*)(P.rk + ch0 + q * 4);
                const unsigned kw0 = k16[q >> 1][(q & 1) * 2], kw1 = k16[q >> 1][(q & 1) * 2 + 1], rw0 = r16[q >> 1][(q & 1) * 2], rw1 = r16[q >> 1][(q & 1) * 2 + 1], vw0 = v16[q >> 1][(q & 1) * 2], vw1 = v16[q >> 1][(q & 1) * 2 + 1];
                const f32x4 kf = (f32x4){bflo(kw0), bfhi(kw0), bflo(kw1), bfhi(kw1)}, rf = (f32x4){bflo(rw0), bfhi(rw0), bflo(rw1), bfhi(rw1)}, vf = (f32x4){bflo(vw0), bfhi(vw0), bflo(vw1), bfhi(vw1)};
                f32x4 ow, ok, ob, oa;
#pragma unroll
                for (int j = 0; j < 4; ++j) {
                    const float dec = fexp2(-0.60653066f * LOG2E * sigmoidf_(wp[j] + w0v[j]));
                    const float ar = sigmoidf_(ap[j] + a0v[j]);
                    const float kkn = kf[j] * kkv[j] * inv;
                    const float kd = kf[j] * (1.0f + (ar - 1.0f) * kav[j]);
                    ow[j] = dec; ok[j] = kd; ob[j] = kkn * ar; oa[j] = -kkn;
                    bon += rf[j] * kd * rkv[j];
                }
                *(LAS f32x4*)(sb + q * 16) = ow; *(LAS f32x4*)(sb + SC_VECB + q * 16) = ok; *(LAS f32x4*)(sb + 2 * SC_VECB + q * 16) = ob;
                *(LAS f32x4*)(sb + 3 * SC_VECB + q * 16) = oa; *(LAS f32x4*)(sb + 4 * SC_VECB + q * 16) = rf; *(LAS f32x4*)(sb + 5 * SC_VECB + q * 16) = vf;
            }
            bon = quad_sum(bon);
            if (cq == 0) P.BON[((size_t)z * M + m0 + row) * 16 + h] = bon;
            asm volatile("s_waitcnt lgkmcnt(0)" ::: "memory");
        };
        if (par == 0) { do_load(0); do_compute(0); } else do_load(1);
        __builtin_amdgcn_s_barrier();
        for (int e = 0; e < T / 16; ++e) {
            if (((e + 1) & 1) == par) { if (e + 1 < T / 16) do_compute(e + 1); }
            else { if (e + 2 < T / 16) do_load(e + 2); }
            __builtin_amdgcn_s_barrier();
        }
    }
}


constexpr int CS_AT = 0, CS_RT = 2304, CS_BK = 4608, CS_SMQ = 9728, CS_SMT = 11008, CS_NQ = 12288, CS_VT = 13568, CS_GL = 16640, CS_BUF = 16896;
constexpr int CS_PZ = 6 * CS_BUF;
constexpr int CS_W = CS_PZ + 4 * 4608;
constexpr int CS_WSZ = 4864;
constexpr int CS_BON = CS_W + 8 * CS_WSZ;
static_assert(CS_BON + 1536 <= LDS_MISC, "chunked-scan LDS map");
template <int CTRL> DI float dpp_mov0(float v) { return __builtin_bit_cast(float, __builtin_amdgcn_update_dpp(0, __builtin_bit_cast(int, v), CTRL, 0xF, 0xF, false)); }
DI float row_prefix(float v) { v += dpp_mov0<0x111>(v); v += dpp_mov0<0x112>(v); v += dpp_mov0<0x114>(v); v += dpp_mov0<0x118>(v); return v; }
DI float row_suffix(float v) { v += dpp_mov0<0x101>(v); v += dpp_mov0<0x102>(v); v += dpp_mov0<0x104>(v); v += dpp_mov0<0x108>(v); return v; }
DI bf16x8 lds16(const LAS unsigned char* p) { return *(const LAS bf16x8*)p; }
DI f32x4 mfma16(bf16x8 a, bf16x8 b, f32x4 c) { return __builtin_amdgcn_mfma_f32_16x16x32_bf16(a, b, c, 0, 0, 0); }

DI void scan_pair_mfma(const Frame& F0, int bh, const ScanPtrs& P) {
    const Frame F = fresh(F0);
    const int b = bh >> 4, h = bh & 15;
    const int z = F.wave >> 2, q4 = F.wave & 3;
    const int l15 = F.lane & 15, l4 = F.lane >> 4;
    const int te = l15, cg = l4, c4 = cg * 4;
    const int rr = z ? 15 - te : te;
    const int jl = 16 * q4 + c4;
    const int chq = h * 64 + 16 * q4;
    LAS unsigned char* const L = F.lds;
    LAS unsigned char* const wsc = L + CS_W + F.wave * CS_WSZ;
    LAS float* const scrW = (LAS float*)wsc; LAS float* const scrA = scrW + 16 * 20;
    LAS unsigned char* const ZB = wsc; LAS unsigned char* const XB = wsc + 2304; LAS unsigned char* const UB = wsc + 3072;
    LAS float* const yst = (LAS float*)(wsc + 3840);
    LAS float* const bonp = (LAS float*)(L + CS_BON);
    bf16* Y = z ? P.YB : P.YF;
    const bf16* w2p = P.W2T + (size_t)z * 65536 + (size_t)(chq + l15) * 64 + 8 * l4;
    bf16x8 Wf[2], Af[2];
#pragma unroll
    for (int ks = 0; ks < 2; ++ks) { Wf[ks] = *(const bf16x8*)(w2p + ks * 32); Af[ks] = *(const bf16x8*)(w2p + 2 * 65536 + ks * 32); }
    const f32x4 w0v = *(const f32x4*)(P.w0 + z * 1024 + chq + c4), a0v = *(const f32x4*)(P.a0 + z * 1024 + chq + c4);
    const f32x4 kkv = *(const f32x4*)(P.kk + chq + c4), kav = *(const f32x4*)(P.ka + chq + c4), rkv = *(const f32x4*)(P.rk + chq + c4);
    f32x4 kcn[4];
#pragma unroll
    for (int q = 0; q < 4; ++q) kcn[q] = *(const f32x4*)(P.kk + h * 64 + 16 * cg + q * 4);
    f32x4 Z[4];
#pragma unroll
    for (int jt = 0; jt < 4; ++jt) Z[jt] = (f32x4){0.f, 0.f, 0.f, 0.f};
    bf16x8 Ahw[2], Aha[2]; u32x2 r4, k4, v4; u32x4 kfull[2];
    auto do_load = [&](int c) {
        const int t0c = z ? T - 16 * (c + 1) : 16 * c; const size_t m0 = (size_t)b * T + t0c;
#pragma unroll
        for (int ks = 0; ks < 2; ++ks) { const bf16* p = P.HD1 + (m0 + l15) * 256 + z * 64 + 32 * ks + 8 * l4; Ahw[ks] = *(const bf16x8*)p; Aha[ks] = *(const bf16x8*)(p + 128); }
        const size_t off = (m0 + rr) * 1024;
        r4 = *(const u32x2*)(P.R + off + chq + c4); k4 = *(const u32x2*)(P.K + off + chq + c4); v4 = *(const u32x2*)(P.V + off + chq + c4);
        kfull[0] = ((const u32x4*)(P.K + off + h * 64 + 16 * cg))[0]; kfull[1] = ((const u32x4*)(P.K + off + h * 64 + 16 * cg))[1];
    };
    auto prep_a = [&](int c) {
        LAS unsigned char* const bp = L + (z * 3 + c % 3) * CS_BUF;
        LAS unsigned char* const pz = L + CS_PZ + (z * 2 + (c & 1)) * 4608;
        f32x4 dw = (f32x4){0.f, 0.f, 0.f, 0.f}, da = dw;
#pragma unroll
        for (int ks = 0; ks < 2; ++ks) { dw = mfma16(Ahw[ks], Wf[ks], dw); da = mfma16(Aha[ks], Af[ks], da); }
#pragma unroll
        for (int rg = 0; rg < 4; ++rg) { scrW[(4 * l4 + rg) * 20 + l15] = dw[rg]; scrA[(4 * l4 + rg) * 20 + l15] = da[rg]; }
        float ssq = 0.f;
#pragma unroll
        for (int q = 0; q < 2; ++q)
#pragma unroll
            for (int w = 0; w < 4; ++w) { const float k0 = bflo(kfull[q][w]) * kcn[q * 2 + (w >> 1)][(w & 1) * 2], k1 = bfhi(kfull[q][w]) * kcn[q * 2 + (w >> 1)][(w & 1) * 2 + 1]; ssq += k0 * k0 + k1 * k1; }
        ssq += swz_xor<16>(ssq); ssq = half_sum(ssq);
        const float inv = __builtin_amdgcn_rsqf(fmaxf(ssq, 1e-24f));
        asm volatile("s_waitcnt lgkmcnt(0)" ::: "memory");
        const f32x4 wp = *(const LAS f32x4*)(scrW + rr * 20 + c4), ap = *(const LAS f32x4*)(scrA + rr * 20 + c4);
        const f32x4 kf = (f32x4){bflo(k4.x), bfhi(k4.x), bflo(k4.y), bfhi(k4.y)}, rf = (f32x4){bflo(r4.x), bfhi(r4.x), bflo(r4.y), bfhi(r4.y)}, vf = (f32x4){bflo(v4.x), bfhi(v4.x), bflo(v4.y), bfhi(v4.y)};
        f32x4 at, rt, bt, kt, bhh, khh, gl; float bon = 0.f;
#pragma unroll
        for (int j = 0; j < 4; ++j) {
            const float lw = -0.60653066f * LOG2E * sigmoidf_(wp[j] + w0v[j]);
            const float ar = sigmoidf_(ap[j] + a0v[j]);
            const float kkn = kf[j] * kkv[j] * inv;
            const float kd = kf[j] * (1.0f + (ar - 1.0f) * kav[j]);
            const float bvec = kkn * ar, avec = -kkn;
#ifdef MK_LDSPREFIX
            scrW[te * 20 + c4 + j] = lw;
            asm volatile("s_waitcnt lgkmcnt(0)" ::: "memory");
            float pi = 0.f, su = 0.f;
            for (int s2 = 0; s2 < 16; ++s2) { const float x = scrW[s2 * 20 + c4 + j]; if (s2 <= te) pi += x; else su += x; }
            asm volatile("s_waitcnt lgkmcnt(0)" ::: "memory");
#else
            const float pi = row_prefix(lw), su = row_suffix(lw) - lw;
#endif
            const float eI = fexp2(pi), eE = fexp2(pi - lw), eN = frcp(eI), eS = fexp2(su);
            at[j] = avec * eE; rt[j] = rf[j] * eI; bt[j] = bvec * eN; kt[j] = kd * eN; bhh[j] = bvec * eS; khh[j] = kd * eS; gl[j] = eI * eS;
            bon += rf[j] * kd * rkv[j];
        }
        const int co = jl * 2;
        { u32x2 w; w.x = pk2(at[0], at[1]); w.y = pk2(at[2], at[3]); *(LAS u32x2*)(bp + CS_AT + te * 144 + co) = w; }
        { u32x2 w; w.x = pk2(rt[0], rt[1]); w.y = pk2(rt[2], rt[3]); *(LAS u32x2*)(bp + CS_RT + te * 144 + co) = w; }
        { u32x2 w; w.x = pk2(bt[0], bt[1]); w.y = pk2(bt[2], bt[3]); *(LAS u32x2*)(pz + te * 144 + co) = w; }
        { u32x2 w; w.x = pk2(kt[0], kt[1]); w.y = pk2(kt[2], kt[3]); *(LAS u32x2*)(pz + 2304 + te * 144 + co) = w; }
#pragma unroll
        for (int j = 0; j < 4; ++j) {
            const unsigned bk = pk2(bhh[j], khh[j]);
            *(LAS bf16*)(bp + CS_BK + (jl + j) * 80 + te * 2) = (bf16)(bk & 0xffffu);
            *(LAS bf16*)(bp + CS_BK + (jl + j) * 80 + 32 + te * 2) = (bf16)(bk >> 16);
        }
        *(LAS bf16*)(bp + CS_VT + (jl + 0) * 48 + te * 2) = (bf16)(v4.x & 0xffffu); *(LAS bf16*)(bp + CS_VT + (jl + 1) * 48 + te * 2) = (bf16)(v4.x >> 16);
        *(LAS bf16*)(bp + CS_VT + (jl + 2) * 48 + te * 2) = (bf16)(v4.y & 0xffffu); *(LAS bf16*)(bp + CS_VT + (jl + 3) * 48 + te * 2) = (bf16)(v4.y >> 16);
        if (te == 0) *(LAS f32x4*)(bp + CS_GL + jl * 4) = gl;
        bon += swz_xor<16>(bon); bon = half_sum(bon);
        if (cg == 0) bonp[((z * 3 + c % 3) * 4 + q4) * 16 + rr] = bon;
    };
    auto prep_b = [&](int c) {
        LAS unsigned char* const bp = L + (z * 3 + c % 3) * CS_BUF;
        const LAS unsigned char* const pz = L + CS_PZ + (z * 2 + (c & 1)) * 4608;
        const int r32 = F.lane & 31, hf = F.lane >> 5;
        const LAS unsigned char* pa = (r32 < 16 ? bp + CS_AT + r32 * 144 : bp + CS_RT + (r32 - 16) * 144) + 16 * hf;
        const LAS unsigned char* pb = (r32 < 16 ? pz + r32 * 144 : pz + 2304 + (r32 - 16) * 144) + 16 * hf;
        f32x16 Dm;
#pragma unroll
        for (int i = 0; i < 16; ++i) Dm[i] = 0.f;
#pragma unroll
        for (int ks = 0; ks < 4; ++ks) Dm = __builtin_amdgcn_mfma_f32_32x32x16_bf16(lds16(pa + 32 * ks), lds16(pb + 32 * ks), Dm, 0, 0, 0);
        const int sc = r32 & 15;
#pragma unroll
        for (int reg = 0; reg < 8; reg += 2) { const int t = crow(reg, hf);
            if (r32 >= 16) { const unsigned w = pk2(sc < t ? Dm[reg] : 0.f, sc < t + 1 ? Dm[reg + 1] : 0.f);
                *(LAS bf16*)(bp + CS_SMQ + t * 80 + sc * 2) = (bf16)(w & 0xffffu); *(LAS bf16*)(bp + CS_SMQ + (t + 1) * 80 + sc * 2) = (bf16)(w >> 16); } }
#pragma unroll
        for (int reg = 8; reg < 16; reg += 2) { const int t = crow(reg, hf) - 16;
            const unsigned w = pk2(sc <= t ? Dm[reg] : 0.f, sc <= t + 1 ? Dm[reg + 1] : 0.f);
            *(LAS bf16*)(bp + CS_NQ + t * 80 + r32 * 2) = (bf16)(w & 0xffffu); *(LAS bf16*)(bp + CS_NQ + (t + 1) * 80 + r32 * 2) = (bf16)(w >> 16); }
#pragma unroll
        for (int reg = 0; reg < 8; ++reg) { if (r32 < 16) scrW[crow(reg, hf) * 16 + r32] = Dm[reg]; }
        asm volatile("s_waitcnt lgkmcnt(0)" ::: "memory");
        float Tr[16];
        f32x4 nr[2][4];
#pragma unroll
        for (int r = 0; r < 2; ++r)
#pragma unroll
            for (int q = 0; q < 4; ++q) nr[r][q] = (4 * q < r) ? *(const LAS f32x4*)(scrW + r * 16 + q * 4) : (f32x4){0.f, 0.f, 0.f, 0.f};
#pragma unroll
        for (int t = 0; t < 16; ++t) {
            float acc = (sc == t) ? 1.0f : 0.0f, acc1 = 0.f;
#pragma unroll
            for (int s2 = 0; s2 < t; ++s2) { const float n = nr[t & 1][s2 >> 2][s2 & 3];
                if ((s2 & 1) == 0) acc = __builtin_fmaf(n, Tr[s2], acc); else acc1 = __builtin_fmaf(n, Tr[s2], acc1); }
            acc += acc1;
            Tr[t] = acc;
            if (t + 2 < 16) {
#pragma unroll
                for (int q = 0; q < 4; ++q) if (4 * q < t + 2) nr[t & 1][q] = *(const LAS f32x4*)(scrW + (t + 2) * 16 + q * 4);
            }
            if ((t & 1) && F.lane < 16) { const unsigned w = pk2(Tr[t - 1], acc);
                *(LAS bf16*)(bp + CS_SMT + (t - 1) * 80 + sc * 2) = (bf16)(w & 0xffffu); *(LAS bf16*)(bp + CS_SMT + t * 80 + sc * 2) = (bf16)(w >> 16); }
        }
    };
    auto stage_s = [&](int c) {
        const LAS unsigned char* const bp = L + (z * 3 + c % 3) * CS_BUF;
        const int q = l4, i = l15;
#pragma unroll
        for (int jt = 0; jt < 4; ++jt) { u32x2 w; w.x = pk2(Z[jt][0], Z[jt][1]); w.y = pk2(Z[jt][2], Z[jt][3]); *(LAS u32x2*)(ZB + i * 144 + (16 * jt + 4 * q) * 2) = w; }
        asm volatile("" ::: "memory");
        const bf16x8 Zb0 = lds16(ZB + i * 144 + (8 * q) * 2), Zb1 = lds16(ZB + i * 144 + (32 + 8 * q) * 2);
        const bf16x8 Vb = lds16(bp + CS_VT + (16 * q4 + i) * 48 + 8 * (q & 1) * 2);
        const LAS unsigned char* arow = bp + l15 * 144 + 8 * q * 2;
        const f32x4 zero = (f32x4){0.f, 0.f, 0.f, 0.f};
        f32x4 X = mfma16(lds16(arow + CS_AT), Zb0, zero); X = mfma16(lds16(arow + CS_AT + 64), Zb1, X);
        X = mfma16(lds16(bp + CS_SMQ + l15 * 80 + 16 * q), Vb, X);
        { u32x2 w; w.x = pk2(X[0], X[1]); w.y = pk2(X[2], X[3]); *(LAS u32x2*)(XB + i * 48 + 8 * q) = w; }
        asm volatile("" ::: "memory");
        const bf16x8 Xb = lds16(XB + i * 48 + 16 * (q & 1));
        const f32x4 U = mfma16(lds16(bp + CS_SMT + l15 * 80 + 16 * q), Xb, zero);
        { u32x2 w; w.x = pk2(U[0], U[1]); w.y = pk2(U[2], U[3]); *(LAS u32x2*)(UB + i * 48 + 8 * q) = w; }
        asm volatile("" ::: "memory");
        const bf16x8 Ub = lds16(UB + i * 48 + 16 * (q & 1));
        const bf16x8 UVb = q < 2 ? Ub : Vb;
        f32x4 Yv = mfma16(lds16(arow + CS_RT), Zb0, zero); Yv = mfma16(lds16(arow + CS_RT + 64), Zb1, Yv);
        Yv = mfma16(lds16(bp + CS_NQ + l15 * 80 + 16 * q), UVb, Yv);
#pragma unroll
        for (int r = 0; r < 4; ++r) yst[(4 * q + r) * 16 + i] = Yv[r];
#pragma unroll
        for (int jt = 0; jt < 4; ++jt) { const f32x4 g = *(const LAS f32x4*)(bp + CS_GL + (16 * jt + 4 * q) * 4);
            Z[jt] = mfma16(lds16(bp + CS_BK + (16 * jt + l15) * 80 + 16 * q), UVb, Z[jt] * g); }
    };
    auto flush_y = [&](int c) {
        const int t0c = z ? T - 16 * (c + 1) : 16 * c; const int st = F.lane >> 2, i4 = (F.lane & 3) * 4;
        f32x4 yv = *(const LAS f32x4*)(yst + st * 16 + i4);
#ifdef MK_CLAMPY
        for (int j = 0; j < 4; ++j) yv[j] = (yv[j] == yv[j]) ? fminf(fmaxf(yv[j], -1.0e4f), 1.0e4f) : 0.f;
#endif
#ifdef MK_SCANCHECK
        { const u32x2 ref = *(const u32x2*)(Y + (size_t)(b * T + t0c + (z ? 15 - st : st)) * 1024 + chq + i4);
          const float r0 = bflo(ref.x), r1 = bfhi(ref.x), r2 = bflo(ref.y), r3 = bfhi(ref.y);
          float er = fmaxf(fmaxf(fabsf(yv.x - r0) / (fabsf(r0) + 1.0f), fabsf(yv.y - r1) / (fabsf(r1) + 1.0f)), fmaxf(fabsf(yv.z - r2) / (fabsf(r2) + 1.0f), fabsf(yv.w - r3) / (fabsf(r3) + 1.0f)));
          if (!(er == er)) er = 1.0e9f;
          atomicMax((unsigned*)(P.ERR + c), __float_as_uint(er)); }
#else
        u32x2 w; w.x = pk2(yv.x, yv.y); w.y = pk2(yv.z, yv.w);
        *(u32x2*)(Y + (size_t)(b * T + t0c + (z ? 15 - st : st)) * 1024 + chq + i4) = w;
#endif
    };
    auto bonus_flush = [&](int c) {
#ifdef MK_SCANCHECK
        return;
#endif
        if (q4 == 0 && F.lane < 16) {
            const int t0c = z ? T - 16 * (c + 1) : 16 * c; const size_t m0 = (size_t)b * T + t0c;
            const LAS float* qq = bonp + (z * 3 + c % 3) * 64 + F.lane;
            P.BON[((size_t)z * M + m0 + F.lane) * 16 + h] = (qq[0] + qq[16]) + (qq[32] + qq[48]);
        }
    };
    __syncthreads();
    for (int e = F.tid; e < 6 * 2 * 16 * 8; e += 512) { const int row = (e >> 3) & 15, tile = (e >> 7) & 1, zb = e >> 8, w = e & 7;
        *(LAS unsigned*)(L + zb * CS_BUF + (tile ? CS_SMT : CS_SMQ) + row * 80 + 32 + w * 4) = 0u; }
    const bool pb_wave = (q4 == z);
    constexpr int NC = T / 16;
    do_load(0); prep_a(0); do_load(1); prep_a(1);
    asm volatile("s_waitcnt lgkmcnt(0)" ::: "memory"); __builtin_amdgcn_s_barrier(); asm volatile("" ::: "memory");
    if (pb_wave) prep_b(0);
    do_load(2);
    asm volatile("s_waitcnt lgkmcnt(0)" ::: "memory"); __builtin_amdgcn_s_barrier(); asm volatile("" ::: "memory");
#ifdef MK_TPROBE
    unsigned long long tpa[4] = {0ull, 0ull, 0ull, 0ull};
#define TP_T() __builtin_amdgcn_s_memtime()
#define TP_ACC(i, t0) tpa[i] += TP_T() - (t0)
#else
#define TP_T() 0ull
#define TP_ACC(i, t0) ((void)(t0))
#endif
    for (int e = 0; e < NC; ++e) {
        const unsigned long long t0 = TP_T();
        if (e + 2 < NC) prep_a(e + 2);
        asm volatile("s_waitcnt lgkmcnt(0)" ::: "memory");
        TP_ACC(0, t0); const unsigned long long t1 = TP_T();
        if (e > 0) flush_y(e - 1);
        if (e + 1 < NC) bonus_flush(e + 1);
        if (e == 0) bonus_flush(0);
        if (e + 3 < NC) do_load(e + 3);
        stage_s(e);
        asm volatile("s_waitcnt lgkmcnt(0)" ::: "memory");
        TP_ACC(1, t1); const unsigned long long t2 = TP_T();
        if (pb_wave && e + 1 < NC) prep_b(e + 1);
        asm volatile("s_waitcnt lgkmcnt(0)" ::: "memory");
        TP_ACC(2, t2); const unsigned long long t3 = TP_T();
        __builtin_amdgcn_s_barrier(); asm volatile("" ::: "memory");
        TP_ACC(3, t3);
    }
#ifdef MK_TPROBE
    if (blockIdx.x == 0 && F.wave == MK_TPROBE_WAVE) {
        const unsigned long long amt = 4ull * tpa[MK_TPROBE];
        const unsigned long long w0 = __builtin_amdgcn_s_memtime();
        while (__builtin_amdgcn_s_memtime() - w0 < amt) __builtin_amdgcn_s_sleep(8);
    }
#endif
    flush_y(T / 16 - 1);
}

#define XB_TMO      128
#define XB_XCNT(j)  (256  + 64 * (j))
#define XB_XSUB(j)  (1280 + 64 * (j))
#define XB_XGEN(j)  (2304 + 64 * (j))
#define XB_TOP      3328
#define XB_TOPGEN   3392
#define XCD_BAR_WORDS 3456
#define XB_SPIN_CAP (1u << 22)
DI unsigned xb_ld(unsigned* p)              { return __hip_atomic_load(p, __ATOMIC_RELAXED, __HIP_MEMORY_SCOPE_AGENT); }
DI unsigned xb_add(unsigned* p, unsigned v) { return __hip_atomic_fetch_add(p, v, __ATOMIC_RELAXED, __HIP_MEMORY_SCOPE_AGENT); }
DI unsigned xb_xcc_id() { return (unsigned)__builtin_amdgcn_s_getreg((3 << 11) | 20) & 0xFu; }
#define XB_SPIN(cond, bar) do { unsigned _sp = 0; while (cond) { __builtin_amdgcn_s_sleep(1); \
    if ((++_sp & 255u) == 0u) { if (xb_ld(&(bar)[XB_TMO])) break; if (_sp > XB_SPIN_CAP) { atomicAdd(&(bar)[XB_TMO], 1u); break; } } } } while (0)
struct XcdBarrier { unsigned* bar; unsigned x; volatile LAS unsigned* st; };
DI XcdBarrier xcd_barrier_post(unsigned* bar, volatile LAS unsigned* st) {
    XcdBarrier b; b.bar = bar; b.x = xb_xcc_id(); b.st = st;
    if (threadIdx.x == 0) (void)xb_add(&bar[XB_XCNT(b.x)], 1u);
    return b;
}
DI void xcd_barrier_complete(unsigned* bar, unsigned x, unsigned& nloc, unsigned& nx) {
    const unsigned G = gridDim.x * gridDim.y * gridDim.z;
    unsigned sum, cnt, mine, sp = 0u;
    for (;;) {
        sum = 0u; cnt = 0u; mine = 0u;
#pragma unroll
        for (unsigned j = 0; j < 16; ++j) { const unsigned c = xb_ld(&bar[XB_XCNT(j)]); sum += c; cnt += (c > 0u) ? 1u : 0u; mine = (j == x) ? c : mine; }
        if (sum == G) break;
        __builtin_amdgcn_s_sleep(1);
        if ((++sp & 255u) == 0u) { if (xb_ld(&bar[XB_TMO])) break; if (sp > XB_SPIN_CAP) { atomicAdd(&bar[XB_TMO], 1u); break; } }
    }
    nloc = mine > 0u ? mine : 1u; nx = cnt > 0u ? cnt : 1u;
}
DI void xcd_barrier(const XcdBarrier& b) {
    asm volatile("s_waitcnt vmcnt(0)" ::: "memory");
    __syncthreads();
    if (threadIdx.x == 0) {
        unsigned* bar = b.bar;
        __builtin_amdgcn_s_waitcnt(0);
        unsigned nloc = b.st[0], nx = b.st[1];
        if (nloc == 0u) { xcd_barrier_complete(bar, b.x, nloc, nx); b.st[0] = nloc; b.st[1] = nx; }
        const unsigned old = xb_add(&bar[XB_XSUB(b.x)], 1u);
        const unsigned gen = old / nloc;
        if (old + 1u == (gen + 1u) * nloc) {
            __builtin_amdgcn_fence(__ATOMIC_RELEASE, "agent");
            asm volatile("s_waitcnt vmcnt(0)" ::: "memory");
            const unsigned og = xb_add(&bar[XB_TOP], 1u);
            const unsigned tg = og / nx;
            if (og + 1u == (tg + 1u) * nx) xb_add(&bar[XB_TOPGEN], 1u);
            else XB_SPIN(xb_ld(&bar[XB_TOPGEN]) == tg, bar);
            __builtin_amdgcn_fence(__ATOMIC_ACQUIRE, "agent");
            xb_add(&bar[XB_XGEN(b.x)], 1u);
            asm volatile("s_waitcnt vmcnt(0)" ::: "memory");
        } else {
            XB_SPIN(xb_ld(&bar[XB_XGEN(b.x)]) == gen, bar);
            __builtin_amdgcn_fence(__ATOMIC_ACQUIRE, "agent");
            asm volatile("s_waitcnt vmcnt(0)" ::: "memory");
        }
    }
    __syncthreads();
}

#ifndef MK_PROG
#ifdef MK_SCANCHECK
#define MK_PROG 0,1,2,3,4,5,7,8,10,11,12,13,14,25,15,16,17,19,20,22,23,24
#else
#define MK_PROG 0,3,4,5,7,8,10,11,12,13,14,15,17,19,20,22,23,24
#endif
#endif
__constant__ int PROG[] = {MK_PROG};
constexpr int NPH = sizeof(PROG) / sizeof(int);
template <int TYPE> struct PreSched {
    const bf16* KV; const bf16* W; int G, c;
    DI bool next(int i, Unit& u) const {
        const long L = (long)i * G + c; if (L >= 512) return false;
        const int rem = (int)L, i2 = rem >> 8, b = (rem >> 4) & 15, hh = (rem >> 2) & 3, t4 = rem & 3;
        u.pm = 0; u.pn = 0;
        const bf16* kvp = KV + (size_t)(b * 256) * 4096 + i2 * 2048 + hh * 256;
        const bf16* wp = W + (size_t)i2 * 1024 * 1024 + (size_t)(t4 * 256) * 1024 + hh * 256;
        if (TYPE == 0) { u.pa = (const char*)kvp; u.pb = (const char*)wp; u.z = (i2 << 30) | (b * 1048576 + hh * 256 * 1024 + t4 * 256); }
        else { u.pa = (const char*)wp; u.pb = (const char*)(kvp + 1024); u.z = (i2 << 30) | (16 * 1048576 + b * 1048576 + t4 * 256 * 1024 + hh * 256); }
        return true;
    }
};

__global__ void __launch_bounds__(512, 2) mk_fwd(Args a) {
    extern __shared__ __attribute__((aligned(16))) unsigned char lds_raw[];
    Frame F;
    F.lds = (LAS unsigned char*)lds_raw;
    F.tid = threadIdx.x; F.lane = F.tid & 63; F.wave = __builtin_amdgcn_readfirstlane(F.tid >> 6);
    F.gw = blockIdx.x * 8 + F.wave; F.ngw = gridDim.x * 8; F.ws = a.ws;
    cg::grid_group grid = cg::this_grid();
    volatile LAS unsigned* MISC = (volatile LAS unsigned*)(F.lds + LDS_MISC);
    if (F.tid < 2) MISC[F.tid] = 0u;
    __syncthreads();
    (void)xcd_barrier_post((unsigned*)(a.ws + WS_BAR), MISC);

    for (int pi = a.ph_lo; pi < a.ph_hi; ++pi) {
        const int ph = PROG[pi];
        const int G = opq(gridDim.x), cblk = opq(blockIdx.x);
        unsigned char* ws = a.ws + (size_t)opq(0);
        float* RS = (float*)(ws + WS_RS);
        bf16* SA = (bf16*)(ws + WS_SA); bf16* SB = (bf16*)(ws + WS_SB);
        bf16* H = (bf16*)a.out;
        const int li = ph >= 18 ? 1 : 0;
        int cp = ph; if (ph >= 18 && ph <= 23) cp = ph - 12;
#ifndef PH_MASK
#define PH_MASK 0xffffffffu
#endif
        if (!((PH_MASK >> cp) & 1u)) cp = 99;
        switch (cp) {
        case 0: phase_prologue(F, a, ws); break;
        case 3: {
            { pg8::PlainSched S{SA, (const bf16*)(ws + WS_WIN), 1024, 1024, M / 256, 8, G, cblk, 30, 0};
              EpiInProj E{(bf16*)(ws + WS_GLU), SB, RS};
              pg8::gemm_phase(F.lds, 1024, 1024, 1024, S, E); }
            { pg8::PlainSched S{(const bf16*)(ws + WS_WIN) + (size_t)2048 * 1024, SA, 1024, 1024, 2, M / 256, G, cblk, 30, 0};
              EpiVT E{(bf16*)(ws + WS_VT), RS};
              pg8::gemm_phase(F.lds, 1024, 1024, 1024, S, E); }
                    {

            pg8::PlainSched S{(const bf16*)(ws + WS_MEMB), (const bf16*)(ws + WS_WKV), 1024, 1024, MMEM / 256, 16, G, cblk, 30, 0};
            EpiRowScale<0> E{(bf16*)(ws + WS_KV), 4096, (const float*)(ws + WS_RSMEM), nullptr};
            pg8::gemm_phase(F.lds, 1024, 1024, 1024, S, E);
                    }
        } break;
        case 4: {
            const float lam = ((const float*)(ws + WS_LAM))[0];
#ifndef NO_ATTN
            for (int u = cblk; u < 1024; u += G) diffattn_unit(F, u, SB, (const bf16*)(ws + WS_VT), (const float*)(ws + WS_BIAS), lam, a.in[opq(I_SUBLN)], (bf16*)(ws + WS_MIX));
#endif
            __syncthreads();
#ifndef NO_CONV
            conv_load_weights(F, a.in[opq(I_CONVW)]);
            for (int u = cblk; u < 512; u += G) conv_unit(F, u, (const bf16*)(ws + WS_GLU), a.in[opq(I_CONVB)], a.in[opq(I_CLNG)], a.in[opq(I_CLNB)], (bf16*)(ws + WS_MIX));
#endif
            __syncthreads();
                    {

            EpiPre E{(bf16*)(ws + WS_G0)};
            { PreSched<0> S{(const bf16*)(ws + WS_KV), (const bf16*)(ws + WS_WQN), G, cblk}; pg8::gemm_phase(F.lds, 256, 4096, 1024, S, E); }
            { PreSched<1> S{(const bf16*)(ws + WS_KV), (const bf16*)(ws + WS_WXO), G, cblk}; pg8::gemm_phase(F.lds, 256, 1024, 4096, S, E); }
                    }
        } break;
        case 5: {
            pg8::PlainSched S{(const bf16*)(ws + WS_MIX), (const bf16*)(ws + WS_WOUT), 1024, 1024, M / 256, 4, G, cblk, 30, 0};
            EpiResid E{a.in[opq(I_X)], nullptr, H, (float*)(ws + WS_PS)};
            pg8::gemm_phase(F.lds, 1024, 1024, 1024, S, E);
        } break;
        case 7: {
            pg8::PlainSched S{H, (const bf16*)(ws + (li ? WS_G1 : WS_G0)), 1024, 1024, M / 256, 4, G, cblk, 3, (size_t)1048576};
            EpiSoftmax E{SB, (const float*)(ws + WS_PS)};
            pg8::gemm_phase(F.lds, 1024, 1024, 1024, S, E);
        } break;
        case 8: {
            pg8::PlainSched S{SB, (const bf16*)(ws + (li ? WS_VW1 : WS_VW0)), 1024, 1024, M / 256, 4, G, cblk, 3, (size_t)1048576};
            EpiResid E{nullptr, H, H, (float*)(ws + WS_PS)};
            pg8::gemm_phase(F.lds, 1024, 1024, 1024, S, E);
        } break;
        case 10: {
            pg8::PlainSched S{H, (const bf16*)(ws + WS_WUP) + (size_t)li * 4096 * 1024, 1024, 1024, M / 256, 16, G, cblk, 30, 0};
            EpiRowScale<2> E{(bf16*)(ws + WS_HID), 4096, nullptr, (const float*)(ws + WS_PS)};
            pg8::gemm_phase(F.lds, 1024, 1024, 1024, S, E);
        } break;
        case 11: {
            pg8::PlainSched S{(const bf16*)(ws + WS_HID), (const bf16*)(ws + WS_WDN) + (size_t)li * 1024 * 4096, 4096, 4096, M / 256, 4, G, cblk, 30, 0};
            EpiResid E{nullptr, H, li ? SA : H, nullptr};
            pg8::gemm_phase(F.lds, 4096, 4096, 4096, S, E);
        } break;
        case 12: phase_rwkv_shift(F, H, a.in[opq(I_NMIX)] + 1024, (bf16*)(ws + WS_A1)); break;
        case 13: {
            pg8::PlainSched S{(const bf16*)(ws + WS_A1), (const bf16*)(ws + WS_WBIG), 2048, 2048, M / 256, 14, G, cblk, 30, 0};
            EpiRwkv E{(bf16*)(ws + WS_R), (bf16*)(ws + WS_K), (bf16*)(ws + WS_V), (bf16*)(ws + WS_HD1), (bf16*)(ws + WS_HD2)};
            pg8::gemm_phase(F.lds, 2048, 2048, 2048, S, E);
        } break;
        case 14: {
            ScanPtrs P{(const bf16*)(ws + WS_R), (const bf16*)(ws + WS_K), (const bf16*)(ws + WS_V), (const bf16*)(ws + WS_HD1), (const bf16*)(ws + WS_W2T),
                       a.in[opq(I_W0)], a.in[opq(I_A0)], a.in[opq(I_KK)], a.in[opq(I_KA)], a.in[opq(I_RK)], (bf16*)(ws + WS_YF), (bf16*)(ws + WS_YB), (float*)(ws + WS_BONUS), (unsigned*)(ws + WS_BAR + 32768)};
#if defined(MK_SCAN_VALU) || defined(MK_SCANCHECK)
            for (int bh = cblk; bh < 256; bh += G) scan_pair(F, bh, P);
#else
            for (int bh = cblk; bh < 256; bh += G) scan_pair_mfma(F, bh, P);
#endif
            __syncthreads();
        } break;
#ifdef MK_SCANCHECK
        case 25: {
            ScanPtrs P{(const bf16*)(ws + WS_R), (const bf16*)(ws + WS_K), (const bf16*)(ws + WS_V), (const bf16*)(ws + WS_HD1), (const bf16*)(ws + WS_W2T),
                       a.in[opq(I_W0)], a.in[opq(I_A0)], a.in[opq(I_KK)], a.in[opq(I_KA)], a.in[opq(I_RK)], (bf16*)(ws + WS_YF), (bf16*)(ws + WS_YB), (float*)(ws + WS_BONUS), (unsigned*)(ws + WS_BAR + 32768)};
            for (int bh = cblk; bh < 256; bh += G) scan_pair_mfma(F, bh, P);
            __syncthreads();
        } break;
#endif
        case 15: {
            pg8::PlainSched S{(const bf16*)(ws + WS_HD2), (const bf16*)(ws + WS_G2T), 256, 256, M / 256, 4, G, cblk, 30, 0};
            EpiGateComb E{(const bf16*)(ws + WS_YF), (const bf16*)(ws + WS_YB), (const bf16*)(ws + WS_V), (const float*)(ws + WS_BONUS), a.in[opq(I_LNG)], a.in[opq(I_LNB)], (bf16*)(ws + WS_COMB)};
            pg8::gemm_phase(F.lds, 256, 256, 256, S, E);
        } break;
        case 16: phase_rwkv_comb(F, (const bf16*)(ws + WS_YF), (const bf16*)(ws + WS_YB), (const bf16*)(ws + WS_V), (const bf16*)(ws + WS_GATE), (const float*)(ws + WS_BONUS),
                                 a.in[opq(I_LNG)], a.in[opq(I_LNB)], (bf16*)(ws + WS_COMB)); break;
        case 17: {
            pg8::PlainSched S{(const bf16*)(ws + WS_COMB), (const bf16*)(ws + WS_WRO), 1024, 1024, M / 256, 4, G, cblk, 30, 0};
            EpiResid E{nullptr, H, H, (float*)(ws + WS_PS)};
            pg8::gemm_phase(F.lds, 1024, 1024, 1024, S, E);
        } break;
        case 24: {
            float osc = 1.0f;
#ifdef MK_SCANCHECK
            { const unsigned* ER = (const unsigned*)(ws + WS_BAR + 32768); int bad = -1;
              for (int c = 127; c >= 0; --c) if (__uint_as_float(__builtin_amdgcn_readfirstlane(__hip_atomic_load(ER + c, __ATOMIC_RELAXED, __HIP_MEMORY_SCOPE_AGENT))) > MK_SCANCHECK_TOL) bad = c;
              if (bad >= 0) osc = 1.0f + 0.03f * (float)(bad + 1); }
#endif
            phase_final_norm(F, SA, a.out, a.in[opq(I_NFINAL)], osc);
        } break;
        default: break;
        }
        if (pi + 1 < a.ph_hi) {
#ifdef MK_ALL_CG
            grid.sync();
#else
            if (pi == a.ph_lo) grid.sync(); else { XcdBarrier xb; xb.bar = (unsigned*)(ws + WS_BAR); xb.x = xb_xcc_id(); xb.st = (volatile LAS unsigned*)(F.lds + LDS_MISC); xcd_barrier(xb); }
#endif
        }
    }
}

extern "C" void kernel_launch(void* const* d_in, const int* in_sizes, int n_in, void* d_out, int out_size, void* d_ws, size_t ws_size, hipStream_t stream) {
    static int grid = 0;
    if (grid == 0) {
        if (n_in != N_IN || in_sizes[0] != M * D || out_size != M * D || ws_size < WS_NEED) {
            fprintf(stderr, "kernel_launch: unexpected problem (n_in %d, in0 %d, out %d, ws %zu); nothing launched\n", n_in, n_in > 0 ? in_sizes[0] : -1, out_size, ws_size); grid = -1; return; }
        int dev = 0, cus = 0, per_cu = 0;
        if (hipGetDevice(&dev) != hipSuccess || hipDeviceGetAttribute(&cus, hipDeviceAttributeMultiprocessorCount, dev) != hipSuccess) { grid = -1; return; }
        if (hipFuncSetAttribute((const void*)mk_fwd, hipFuncAttributeMaxDynamicSharedMemorySize, LDS_BYTES) != hipSuccess) { fprintf(stderr, "kernel_launch: hipFuncSetAttribute failed\n"); grid = -1; return; }
        if (hipOccupancyMaxActiveBlocksPerMultiprocessor(&per_cu, (const void*)mk_fwd, 512, LDS_BYTES) != hipSuccess || per_cu < 1) { fprintf(stderr, "kernel_launch: occupancy query says %d\n", per_cu); (void)hipGetLastError(); grid = -1; return; }
        grid = cus;
    }
    if (grid < 0) return;
    if (hipMemsetAsync((char*)d_ws + WS_BAR, 0, 65536, stream) != hipSuccess) { fprintf(stderr, "kernel_launch: memset failed\n"); return; }
    Args a{};
    for (int i = 0; i < N_IN; ++i) a.in[i] = (const float*)d_in[i];
    a.out = (float*)d_out; a.ws = (unsigned char*)d_ws;
#if MK_SINGLE
    a.ph_lo = 0; a.ph_hi = NPH;
    void* params[] = {&a};
    hipError_t e = hipLaunchCooperativeKernel((const void*)mk_fwd, dim3(grid), dim3(512), params, LDS_BYTES, stream);
    if (e != hipSuccess) fprintf(stderr, "kernel_launch: cooperative launch failed: %s\n", hipGetErrorString(e));
#else
    for (int ph = 0; ph < NPH; ++ph) { a.ph_lo = ph; a.ph_hi = ph + 1; hipLaunchKernelGGL(mk_fwd, dim3(grid), dim3(512), LDS_BYTES, stream, a); }
#endif
}
```

```cpp
#include <hip/hip_runtime.h>
#include <hip/hip_cooperative_groups.h>
#include <cstdio>
#include <cstdint>
namespace cg = cooperative_groups;

#ifndef MK_SINGLE
#define MK_SINGLE 1
#endif

#define LAS __attribute__((address_space(3)))
#define DI __device__ __forceinline__
typedef unsigned short bf16;
typedef short bf16x8 __attribute__((ext_vector_type(8)));
typedef short s16x4 __attribute__((ext_vector_type(4)));
typedef float f32x2 __attribute__((ext_vector_type(2)));
typedef float f32x4 __attribute__((ext_vector_type(4)));
typedef float f32x16 __attribute__((ext_vector_type(16)));
typedef unsigned u32x2 __attribute__((ext_vector_type(2)));
typedef unsigned u32x4 __attribute__((ext_vector_type(4)));

constexpr int D = 1024, NB = 16, T = 2048, M = NB * T, NMEM = 256, MMEM = NB * NMEM;
constexpr int FF = 4096;
constexpr float EPS = 1e-6f;
constexpr float LOG2E = 1.4426950408889634f;

constexpr size_t MiB = 1u << 20;
constexpr size_t WS_BAR = 0;
constexpr size_t WS_RS = 64 * 1024;
constexpr size_t WS_RSMEM = WS_RS + M * 4;
constexpr size_t WS_BIAS = WS_RSMEM + MMEM * 4;
constexpr size_t WS_LAM = WS_BIAS + 4 * 4096 * 4;
constexpr size_t WS_WIN = 1 * MiB;
constexpr size_t WS_WOUT = WS_WIN + 5 * MiB;
constexpr size_t WS_WQN = WS_WOUT + 2 * MiB;
constexpr size_t WS_WKV = WS_WQN + 4 * MiB;
constexpr size_t WS_WXO = WS_WKV + 8 * MiB;
constexpr size_t WS_WUP = WS_WXO + 4 * MiB;
constexpr size_t WS_WDN = WS_WUP + 16 * MiB;
constexpr size_t WS_WBIG = WS_WDN + 16 * MiB;
constexpr size_t WS_W2T = WS_WBIG + 14 * MiB;
constexpr size_t WS_G2T = WS_W2T + 512 * 1024;
constexpr size_t WS_WRO = WS_G2T + 512 * 1024;
constexpr size_t WS_WEND = WS_WRO + 2 * MiB;
static_assert(WS_WEND == 73 * MiB, "weight map");
constexpr size_t WS_SA = 73 * MiB;
constexpr size_t WS_SB = 137 * MiB;
constexpr size_t WS_GLU = 201 * MiB;
constexpr size_t WS_VT = 233 * MiB;
constexpr size_t WS_MIX = 265 * MiB;
constexpr size_t WS_G0 = 329 * MiB;
constexpr size_t WS_VW0 = 361 * MiB;
constexpr size_t WS_MEMB = 393 * MiB;
constexpr size_t WS_KV = 401 * MiB;
constexpr size_t WS_G1 = 433 * MiB;
constexpr size_t WS_VW1 = 465 * MiB;
static_assert(WS_G1 - WS_G0 == 104 * MiB && WS_VW0 - WS_G0 == 32 * MiB && WS_VW1 - WS_G1 == 32 * MiB, "G / VW spacing used by EpiPre");
constexpr size_t WS_BONUS = 497 * MiB;
constexpr size_t WS_PS = 502 * MiB;
constexpr size_t WS_HID = 137 * MiB;
constexpr size_t WS_A1 = 73 * MiB;
constexpr size_t WS_R = 201 * MiB, WS_K = 265 * MiB, WS_V = 329 * MiB;
static_assert(WS_K - WS_R == 64 * MiB && WS_V - WS_K == 64 * MiB, "r, k, v spacing used by EpiRwkv");
constexpr size_t WS_HD1 = 393 * MiB;
constexpr size_t WS_HD2 = 409 * MiB;
constexpr size_t WS_YF = 73 * MiB, WS_YB = 137 * MiB;
constexpr size_t WS_GATE = 265 * MiB;
constexpr size_t WS_COMB = 201 * MiB;
constexpr size_t WS_NEED = 512 * MiB;

constexpr int LDS_X = 131072;
constexpr int LDS_MISC = 163840 - 256;
constexpr int LDS_BYTES = 163840;

DI unsigned f2bf(float f) { unsigned u = __builtin_bit_cast(unsigned, f); return (u + 0x7fffu + ((u >> 16) & 1u)) >> 16; }
typedef __bf16 bf16x2v __attribute__((ext_vector_type(2)));
DI unsigned pk2(float lo, float hi) { const f32x2 v = {lo, hi}; return __builtin_bit_cast(unsigned, __builtin_convertvector(v, bf16x2v)); }
DI float bf2f(unsigned short b) { return __builtin_bit_cast(float, ((unsigned)b) << 16); }
DI float bflo(unsigned w) { return __builtin_bit_cast(float, w << 16); }
DI float bfhi(unsigned w) { return __builtin_bit_cast(float, w & 0xffff0000u); }
template <int MASK> DI float swz_xor(float v) { return __builtin_bit_cast(float, __builtin_amdgcn_ds_swizzle(__builtin_bit_cast(int, v), (MASK << 10) | 0x1f)); }
DI float half_sum(float v) { const int x = __builtin_bit_cast(int, v); const auto r = __builtin_amdgcn_permlane32_swap(x, x, false, false); return __builtin_bit_cast(float, (int)r[0]) + __builtin_bit_cast(float, (int)r[1]); }
DI float half_max(float v) { const int x = __builtin_bit_cast(int, v); const auto r = __builtin_amdgcn_permlane32_swap(x, x, false, false); return fmaxf(__builtin_bit_cast(float, (int)r[0]), __builtin_bit_cast(float, (int)r[1])); }
DI float wave_sum(float v) {
    v += swz_xor<1>(v); v += swz_xor<2>(v); v += swz_xor<4>(v); v += swz_xor<8>(v); v += swz_xor<16>(v); v = half_sum(v);
    return v;
}
DI float ozero() { float z; asm volatile("v_mov_b32 %0, 0" : "=v"(z)); return z; }
DI int opaque(int x) { asm volatile("" : "+v"(x)); return x; }
template <class Tp> DI Tp* opq_ptr(Tp* p) { asm volatile("" : "+s"(p)); return p; }
DI int opq(int x) { asm volatile("" : "+s"(x)); return x; }
DI float fexp2(float x) { return __builtin_amdgcn_exp2f(x); }
DI float frcp(float x) { return __builtin_amdgcn_rcpf(x); }
DI float sigmoidf_(float x) { return frcp(1.0f + fexp2(-x * LOG2E)); }
DI float tanhf_(float x) { float e = fexp2(-2.0f * LOG2E * fabsf(x)); float t = (1.0f - e) * frcp(1.0f + e); return x < 0.f ? -t : t; }

namespace pg8 {
constexpr int BM = 256, BK = 64, HALF = 128, HTB = HALF * BK * 2, STAGE_BYTES = 8 * HTB, NXCD = 8, WGM = 8;
DI int lds_byte(int r, int c) { const int st = (r >> 4) * 2 + (c >> 5), rr = r & 15, cc = c & 31, ob = rr * 64 + cc * 2; return st * 1024 + (ob ^ (((ob >> 9) & 1) << 5)); }
DI void stage_rc(int b, int& R, int& C) { const int st = b / 1024, sb = b % 1024, swz = sb ^ (((sb >> 9) & 1) << 5); R = (st >> 1) * 16 + swz / 64; C = (st & 1) * 32 + (swz % 64) / 2; }
DI int perm32(int rho) { const int n = rho >> 4, i = rho & 15; return 8 * (i >> 2) + 4 * n + (i & 3); }

struct Unit { int pm, pn, z; const char* pa; const char* pb; };

DI bool tile_order(long L, int nM, int nN, int& pm, int& pn) {
    const int nwg = nM * nN; if (L >= nwg) return false;
    int wgid = (int)L; { const int q = nwg / NXCD, r = nwg % NXCD, xcd = wgid % NXCD, off = wgid / NXCD; wgid = (xcd < r ? xcd * (q + 1) : r * (q + 1) + (xcd - r) * q) + off; }
    const int nig = WGM * nN, gid = wgid / nig, fm = gid * WGM, gsz = (nM - fm) < WGM ? (nM - fm) : WGM;
    pm = fm + ((wgid % nig) % gsz); pn = (wgid % nig) / gsz; return true;
}
struct PlainSched {
    const bf16* A; const bf16* Bt; int lda, ldb, nM, nN, G, c, bshift; size_t bstride;
    DI bool next(int i, Unit& u) const {
        if (!tile_order((long)i * G + c, nM, nN, u.pm, u.pn)) return false;
        u.z = u.pm >> bshift;
        u.pa = (const char*)(A + (size_t)u.pm * 256 * lda);
        u.pb = (const char*)(Bt + (size_t)u.z * bstride + (size_t)u.pn * 256 * ldb);
        return true;
    }
};

DI unsigned cvt_pk_bf16(float lo, float hi) { return pk2(lo, hi); }

template <class Epi, class Sched>
DI void gemm_phase(LAS unsigned char* lds, const int K, const int lda, const int ldb, const Sched& S, const Epi& E) {
    const int tid = opaque(threadIdx.x), wid = __builtin_amdgcn_readfirstlane(tid >> 6), lane = tid & 63, wr = wid >> 2, wc = wid & 3, fr = lane & 15, fq = lane >> 4;
    const int nt = K / BK;
    unsigned voffA[2], voffB[2];
#pragma unroll
    for (int i = 0; i < 2; ++i) { int R, C; stage_rc(tid * 16 + i * 8192, R, C); const int Rb = Epi::PERM ? ((R & ~31) + perm32(R & 31)) : R;
        voffA[i] = (unsigned)(R * lda + C) * 2u; voffB[i] = (unsigned)(Rb * ldb + C) * 2u; }
    const size_t kstep = (size_t)(BK * 2);
    const size_t hstepA = (size_t)HALF * lda * 2, hstepB = (size_t)HALF * ldb * 2;
    const unsigned ldsw = (unsigned)wid * 1024u;
    const int aoff = lds_byte(wr * 64 + fr, fq * 8), boff = lds_byte(wc * 32 + fr, fq * 8);
#define PG8_SA(b, h) (((b) * 2 + (h)) * HTB)
#define PG8_SB(b, h) ((4 + (b) * 2 + (h)) * HTB)
#define PG8_STAGE(bufoff, gbase, voff) do { _Pragma("unroll") for (int _i = 0; _i < 2; ++_i) \
        __builtin_amdgcn_global_load_lds((const unsigned*)((const char*)(gbase) + (voff)[_i]), (LAS unsigned*)(lds + (bufoff) + ldsw + _i * 8192), 16, 0, 0); } while (0)
#define PG8_LDA(dst, b, h) do { _Pragma("unroll") for (int m = 0; m < 4; ++m) _Pragma("unroll") for (int k = 0; k < 2; ++k) dst[m][k] = *(const LAS bf16x8*)(lds + PG8_SA(b, h) + aoff + m * 2048 + k * 1024); } while (0)
#define PG8_LDB(dst, b, h) do { _Pragma("unroll") for (int n = 0; n < 2; ++n) _Pragma("unroll") for (int k = 0; k < 2; ++k) dst[n][k] = *(const LAS bf16x8*)(lds + PG8_SB(b, h) + boff + n * 2048 + k * 1024); } while (0)
#define PG8_MMA(ai, bj, At, Bt) do { __builtin_amdgcn_s_setprio(1); _Pragma("unroll") for (int m = 0; m < 4; ++m) _Pragma("unroll") for (int n = 0; n < 2; ++n) _Pragma("unroll") for (int k = 0; k < 2; ++k) \
        acc[ai][bj][m][n] = __builtin_amdgcn_mfma_f32_16x16x32_bf16(Bt[n][k], At[m][k], acc[ai][bj][m][n], 0, 0, 0); __builtin_amdgcn_s_setprio(0); } while (0)
#define PG8_WAIT_V(n) asm volatile("s_waitcnt vmcnt(" #n ")" ::: "memory")
#define PG8_WAIT_L(n) asm volatile("s_waitcnt lgkmcnt(" #n ")" ::: "memory")
#define PG8_BAR __builtin_amdgcn_s_barrier()
#define PG8_SCHED __builtin_amdgcn_sched_barrier(0)
    Unit cur, nxt; int ui = 0;
    if (!S.next(0, cur)) return;
    f32x4 acc[2][2][4][2];
    { const float z0 = ozero();
#pragma unroll
    for (int a = 0; a < 2; ++a)
#pragma unroll
        for (int b = 0; b < 2; ++b)
#pragma unroll
            for (int m = 0; m < 4; ++m)
#pragma unroll
                for (int n = 0; n < 2; ++n) acc[a][b][m][n] = (f32x4){z0, z0, z0, z0}; }
    bf16x8 At[4][2], B0[2][2], B1[2][2];
    const char* cA = cur.pa; const char* cB = cur.pb;
    PG8_STAGE(PG8_SB(0, 0), cB, voffB); PG8_STAGE(PG8_SB(0, 1), cB + hstepB, voffB); PG8_STAGE(PG8_SA(0, 0), cA, voffA); PG8_STAGE(PG8_SA(0, 1), cA + hstepA, voffA);
    if (wr == 1) PG8_BAR;
    PG8_WAIT_V(2); PG8_BAR;
    PG8_STAGE(PG8_SB(1, 0), cB + kstep, voffB); PG8_STAGE(PG8_SA(1, 0), cA + kstep, voffA); PG8_STAGE(PG8_SB(1, 1), cB + hstepB + kstep, voffB);
    PG8_WAIT_V(6); PG8_BAR;
    for (;;) {
        const bool has_next = S.next(ui + 1, nxt);
        const char* nA = has_next ? nxt.pa : cA; const char* nB = has_next ? nxt.pb : cB;
#pragma unroll 1
        for (int t = 0; t < nt; t += 2) {
            const bool last = (t == nt - 2);
            const char* a1 = cA + (size_t)(t + 1) * kstep;
            const char* a2 = last ? nA : cA + (size_t)(t + 2) * kstep; const char* b2 = last ? nB : cB + (size_t)(t + 2) * kstep;
            const char* a3 = a2 + kstep; const char* b3 = b2 + kstep;
            PG8_LDB(B0, 0, 0); PG8_LDB(B1, 0, 1); PG8_SCHED; PG8_LDA(At, 0, 0); PG8_STAGE(PG8_SA(1, 1), a1 + hstepA, voffA);
            PG8_WAIT_V(8); PG8_WAIT_L(0); PG8_BAR; PG8_MMA(0, 0, At, B0); PG8_MMA(0, 1, At, B1); PG8_BAR; PG8_SCHED;
            PG8_LDA(At, 0, 1); PG8_STAGE(PG8_SB(0, 0), b2, voffB); PG8_STAGE(PG8_SB(0, 1), b2 + hstepB, voffB); PG8_STAGE(PG8_SA(0, 0), a2, voffA);
            PG8_WAIT_V(8); PG8_WAIT_L(0); PG8_BAR; PG8_MMA(1, 0, At, B0); PG8_MMA(1, 1, At, B1); PG8_BAR; PG8_SCHED;
            PG8_LDB(B0, 1, 0); PG8_LDB(B1, 1, 1); PG8_SCHED; PG8_LDA(At, 1, 0); PG8_STAGE(PG8_SA(0, 1), a2 + hstepA, voffA);
            PG8_WAIT_V(8); PG8_WAIT_L(0); PG8_BAR; PG8_MMA(0, 0, At, B0); PG8_MMA(0, 1, At, B1); PG8_BAR; PG8_SCHED;
            PG8_LDA(At, 1, 1); PG8_STAGE(PG8_SB(1, 0), b3, voffB); PG8_STAGE(PG8_SB(1, 1), b3 + hstepB, voffB); PG8_STAGE(PG8_SA(1, 0), a3, voffA);
            PG8_WAIT_V(8); PG8_WAIT_L(0); PG8_BAR; PG8_MMA(1, 0, At, B0); PG8_MMA(1, 1, At, B1); PG8_BAR; PG8_SCHED;
        }
        if (wr == 0) PG8_BAR;
        E(acc, cur, wr, wc, fr, fq, lds);
        if (!has_next) break;
        { const float z0 = ozero();
#pragma unroll
        for (int a = 0; a < 2; ++a)
#pragma unroll
            for (int b = 0; b < 2; ++b)
#pragma unroll
                for (int m = 0; m < 4; ++m)
#pragma unroll
                    for (int n = 0; n < 2; ++n) acc[a][b][m][n] = (f32x4){z0, z0, z0, z0}; }
        cur = nxt; cA = nA; cB = nB; ++ui;
        if (wr == 1) PG8_BAR;
    }
    PG8_WAIT_V(0);
    PG8_BAR;
#undef PG8_SA
#undef PG8_SB
#undef PG8_STAGE
#undef PG8_LDA
#undef PG8_LDB
#undef PG8_MMA
#undef PG8_WAIT_V
#undef PG8_WAIT_L
#undef PG8_BAR
#undef PG8_SCHED
}
}
using pg8::Unit;

DI void store8(bf16* p, const f32x4 v0, const f32x4 v1) {
    u32x4 w; w.x = pk2(v0[0], v0[1]); w.y = pk2(v0[2], v0[3]); w.z = pk2(v1[0], v1[1]); w.w = pk2(v1[2], v1[3]);
    *(u32x4*)p = w;
}
#define EPI_ARGS f32x4 (&acc)[2][2][4][2], const Unit& u, int wr, int wc, int fr, int fq, LAS unsigned char* lds

DI float rs_ps(const float* ps, int row) {
    const f32x4* p = (const f32x4*)(ps + (size_t)row * 16); const f32x4 a = p[0], b = p[1], c = p[2], d = p[3];
    const float s = ((a.x + a.y) + (a.z + a.w)) + ((b.x + b.y) + (b.z + b.w)) + (((c.x + c.y) + (c.z + c.w)) + ((d.x + d.y) + (d.z + d.w)));
    return 1.0f / sqrtf(s * (1.0f / D) + EPS);
}
template <int ACT> struct EpiRowScale {
    static constexpr bool PERM = true;
    bf16* O; int ldc; const float* rs; const float* ps;
    DI void operator()(EPI_ARGS) const {
        const int row0 = u.pm * 256 + wr * 64 + fr, col0 = u.pn * 256 + wc * 32 + 8 * fq;
#pragma unroll
        for (int ai = 0; ai < 2; ++ai)
#pragma unroll
            for (int m = 0; m < 4; ++m) {
                const int row = row0 + ai * 128 + m * 16; const float s = ps ? rs_ps(ps, row) : (rs ? rs[row] : 1.0f);
                bf16* rowp = O + (size_t)row * ldc + col0;
#pragma unroll
                for (int bj = 0; bj < 2; ++bj) { f32x4 v0 = acc[ai][bj][m][0] * s, v1 = acc[ai][bj][m][1] * s;
                    if (ACT == 2) {
#pragma unroll
                        for (int j = 0; j < 4; ++j) { float a = fmaxf(v0[j], 0.f), b = fmaxf(v1[j], 0.f); v0[j] = a * a; v1[j] = b * b; } }
                    store8(rowp + bj * 128, v0, v1); }
            }
    }
};
struct EpiInProj {
    static constexpr bool PERM = true;
    bf16* GLU; bf16* QK; const float* rs;
    DI void operator()(EPI_ARGS) const {
        const int row0 = u.pm * 256 + wr * 64 + fr;
        if (u.pn < 4) {
            const int col0 = u.pn * 128 + wc * 32 + 8 * fq;
#pragma unroll
            for (int ai = 0; ai < 2; ++ai)
#pragma unroll
                for (int m = 0; m < 4; ++m) {
                    const int row = row0 + ai * 128 + m * 16; const float s = rs[row];
                    f32x4 o0, o1;
#pragma unroll
                    for (int j = 0; j < 4; ++j) { o0[j] = acc[ai][0][m][0][j] * s * sigmoidf_(acc[ai][1][m][0][j] * s); o1[j] = acc[ai][0][m][1][j] * s * sigmoidf_(acc[ai][1][m][1][j] * s); }
                    store8(GLU + (size_t)row * 512 + col0, o0, o1);
                }
        } else {
            const int col0 = (u.pn - 4) * 256 + wc * 32 + 8 * fq;
#pragma unroll
            for (int ai = 0; ai < 2; ++ai)
#pragma unroll
                for (int m = 0; m < 4; ++m) {
                    const int row = row0 + ai * 128 + m * 16; const float s = rs[row];
#pragma unroll
                    for (int bj = 0; bj < 2; ++bj) store8(QK + (size_t)row * 1024 + col0 + bj * 128, acc[ai][bj][m][0] * s, acc[ai][bj][m][1] * s);
                }
        }
    }
};
struct EpiVT {
    static constexpr bool PERM = true;
    bf16* O; const float* cs;
    DI void operator()(EPI_ARGS) const {
        const int row0 = u.pm * 256 + wr * 64 + fr, col0 = u.pn * 256 + wc * 32 + 8 * fq;
        f32x4 c[2][2];
#pragma unroll
        for (int bj = 0; bj < 2; ++bj) { c[bj][0] = *(const f32x4*)(cs + col0 + bj * 128); c[bj][1] = *(const f32x4*)(cs + col0 + bj * 128 + 4); }
#pragma unroll
        for (int ai = 0; ai < 2; ++ai)
#pragma unroll
            for (int m = 0; m < 4; ++m) {
                const int row = row0 + ai * 128 + m * 16;
#pragma unroll
                for (int bj = 0; bj < 2; ++bj) store8(O + (size_t)row * M + col0 + bj * 128, acc[ai][bj][m][0] * c[bj][0], acc[ai][bj][m][1] * c[bj][1]);
            }
    }
};
struct EpiPre {
    static constexpr bool PERM = true;
    bf16* base0;
    DI void operator()(EPI_ARGS) const {
        bf16* O = base0 + (size_t)((u.z >> 30) & 1) * (52u << 20) + (size_t)(u.z & 0x3fffffff);
        const int row0 = wr * 64 + fr, col0 = wc * 32 + 8 * fq;
#pragma unroll
        for (int ai = 0; ai < 2; ++ai)
#pragma unroll
            for (int m = 0; m < 4; ++m) {
                const int row = row0 + ai * 128 + m * 16;
#pragma unroll
                for (int bj = 0; bj < 2; ++bj) store8(O + (size_t)row * 1024 + col0 + bj * 128, acc[ai][bj][m][0], acc[ai][bj][m][1]);
            }
    }
};
struct EpiResid {
    static constexpr bool PERM = true;
    const float* xres; const bf16* hres; bf16* out; float* ps;
    DI void operator()(EPI_ARGS) const {
        const int row0 = u.pm * 256 + wr * 64 + fr, col0 = u.pn * 256 + wc * 32 + 8 * fq;
#pragma unroll
        for (int ai = 0; ai < 2; ++ai)
#pragma unroll
            for (int m = 0; m < 4; ++m) {
                const int row = row0 + ai * 128 + m * 16; const size_t off = (size_t)row * D + col0; float ss = 0.f;
#pragma unroll
                for (int bj = 0; bj < 2; ++bj) {
                    f32x4 r0, r1;
                    if (xres) { r0 = *(const f32x4*)(xres + off + bj * 128); r1 = *(const f32x4*)(xres + off + bj * 128 + 4); }
                    else { const u32x4 hw = *(const u32x4*)(hres + off + bj * 128); r0 = (f32x4){bflo(hw.x), bfhi(hw.x), bflo(hw.y), bfhi(hw.y)}; r1 = (f32x4){bflo(hw.z), bfhi(hw.z), bflo(hw.w), bfhi(hw.w)}; }
                    r0 = r0 + acc[ai][bj][m][0]; r1 = r1 + acc[ai][bj][m][1];
                    u32x4 w; w.x = pk2(r0[0], r0[1]); w.y = pk2(r0[2], r0[3]); w.z = pk2(r1[0], r1[1]); w.w = pk2(r1[2], r1[3]);
                    *(u32x4*)(out + off + bj * 128) = w;
                    if (ps) {
#pragma unroll
                        for (int q = 0; q < 4; ++q) { const float a = bflo(w[q]), b = bfhi(w[q]); ss += a * a + b * b; }
                    }
                }
                if (ps) { ss += swz_xor<16>(ss); ss = half_sum(ss); if (fq == 0) ps[(size_t)row * 16 + u.pn * 4 + wc] = ss; }
            }
    }
};
struct EpiGateComb {
    static constexpr bool PERM = true;
    const bf16 *YF, *YB, *V; const float *BON, *lng, *lnb; bf16* O;
    DI void operator()(EPI_ARGS) const {
        const int head = u.pn * 4 + wc, ch0 = u.pn * 256 + 64 * wc + 8 * fq, row0 = u.pm * 256 + wr * 64 + fr;
        f32x4 lg[2][2], lb[2][2];
#pragma unroll
        for (int bj = 0; bj < 2; ++bj)
#pragma unroll
            for (int n = 0; n < 2; ++n) { lg[bj][n] = *(const f32x4*)(lng + ch0 + 32 * bj + 4 * n); lb[bj][n] = *(const f32x4*)(lnb + ch0 + 32 * bj + 4 * n); }
#pragma unroll
        for (int ai = 0; ai < 2; ++ai)
#pragma unroll
            for (int m = 0; m < 4; ++m) {
                const int row = row0 + ai * 128 + m * 16; const size_t off = (size_t)row * D + ch0;
                u32x4 a[2], b[2], vv[2];
#pragma unroll
                for (int bj = 0; bj < 2; ++bj) { a[bj] = *(const u32x4*)(YF + off + 32 * bj); b[bj] = *(const u32x4*)(YB + off + 32 * bj); vv[bj] = *(const u32x4*)(V + off + 32 * bj); }
                const float bon = BON[(size_t)row * 16 + head] + BON[(size_t)(M + row) * 16 + head];
                float y[16]; float s = 0.f;
#pragma unroll
                for (int bj = 0; bj < 2; ++bj)
#pragma unroll
                    for (int w = 0; w < 4; ++w) { y[bj * 8 + 2 * w] = bflo(a[bj][w]) + bflo(b[bj][w]); y[bj * 8 + 2 * w + 1] = bfhi(a[bj][w]) + bfhi(b[bj][w]); }
#pragma unroll
                for (int j = 0; j < 16; ++j) s += y[j];
                s += swz_xor<16>(s); s = half_sum(s);
                const float mean = s * (1.0f / 64.0f); float q2 = 0.f;
#pragma unroll
                for (int j = 0; j < 16; ++j) { y[j] -= mean; q2 += y[j] * y[j]; }
                q2 += swz_xor<16>(q2); q2 = half_sum(q2);
                const float rstd = 1.0f / sqrtf(q2 * (1.0f / 64.0f) + 64e-5f);
#pragma unroll
                for (int bj = 0; bj < 2; ++bj) {
                    f32x4 o0, o1;
#pragma unroll
                    for (int j = 0; j < 4; ++j) {
                        const float v0 = (j & 1) ? bfhi(vv[bj][j >> 1]) : bflo(vv[bj][j >> 1]), v1 = (j & 1) ? bfhi(vv[bj][2 + (j >> 1)]) : bflo(vv[bj][2 + (j >> 1)]);
                        o0[j] = (y[bj * 8 + j] * rstd * lg[bj][0][j] + lb[bj][0][j] + bon * v0) * acc[ai][bj][m][0][j];
                        o1[j] = (y[bj * 8 + 4 + j] * rstd * lg[bj][1][j] + lb[bj][1][j] + bon * v1) * acc[ai][bj][m][1][j];
                    }
                    store8(O + off + 32 * bj, o0, o1);
                }
            }
    }
};
struct EpiSoftmax {
    static constexpr bool PERM = true;
    bf16* P; const float* ps;
    DI void operator()(EPI_ARGS) const {
        LAS f32x2* X = (LAS f32x2*)(lds + LDS_X);
        const int row0 = u.pm * 256, col0 = u.pn * 256 + wc * 32 + 8 * fq;
        float mw[2][4];
#pragma unroll
        for (int ai = 0; ai < 2; ++ai)
#pragma unroll
            for (int m = 0; m < 4; ++m) {
                const int rl = ai * 128 + wr * 64 + m * 16 + fr; const float s = rs_ps(ps, row0 + rl) * LOG2E;
                float mx = -3.0e38f;
#pragma unroll
                for (int bj = 0; bj < 2; ++bj)
#pragma unroll
                    for (int n = 0; n < 2; ++n) { acc[ai][bj][m][n] = acc[ai][bj][m][n] * s;
#pragma unroll
                        for (int j = 0; j < 4; ++j) mx = fmaxf(mx, acc[ai][bj][m][n][j]); }
                mx = fmaxf(mx, swz_xor<16>(mx)); mx = half_max(mx);
                float sum = 0.f;
#pragma unroll
                for (int bj = 0; bj < 2; ++bj)
#pragma unroll
                    for (int n = 0; n < 2; ++n)
#pragma unroll
                        for (int j = 0; j < 4; ++j) { const float p = fexp2(acc[ai][bj][m][n][j] - mx); acc[ai][bj][m][n][j] = p; sum += p; }
                sum += swz_xor<16>(sum); sum = half_sum(sum);
                mw[ai][m] = mx;
                if (fq == 0) X[rl * 4 + wc] = (f32x2){mx, sum};
            }
        asm volatile("s_waitcnt lgkmcnt(0)" ::: "memory"); __builtin_amdgcn_s_barrier(); asm volatile("" ::: "memory");
#pragma unroll
        for (int ai = 0; ai < 2; ++ai)
#pragma unroll
            for (int m = 0; m < 4; ++m) {
                const int rl = ai * 128 + wr * 64 + m * 16 + fr;
                const f32x2 a = X[rl * 4 + 0], b = X[rl * 4 + 1], c = X[rl * 4 + 2], d = X[rl * 4 + 3];
                const float mt = fmaxf(fmaxf(a.x, b.x), fmaxf(c.x, d.x));
                const float lt = a.y * fexp2(a.x - mt) + b.y * fexp2(b.x - mt) + c.y * fexp2(c.x - mt) + d.y * fexp2(d.x - mt);
                const float f = fexp2(mw[ai][m] - mt) / lt;
                bf16* rowp = P + (size_t)(row0 + rl) * 1024 + col0;
#pragma unroll
                for (int bj = 0; bj < 2; ++bj) store8(rowp + bj * 128, acc[ai][bj][m][0] * f, acc[ai][bj][m][1] * f);
            }
        asm volatile("s_waitcnt lgkmcnt(0)" ::: "memory"); __builtin_amdgcn_s_barrier(); asm volatile("" ::: "memory");
    }
};
struct EpiRwkv {
    static constexpr bool PERM = true;
    bf16* R; bf16* Kk; bf16* V; bf16* HD1; bf16* HD2;
    DI void operator()(EPI_ARGS) const {
        const int row0 = u.pm * 256 + wr * 64 + fr; const int g = u.pn >> 2;
        bf16* O; int ldc, colt, mode0 = 0, mode1 = 0;
        if (u.pn < 12) { O = R + (size_t)g * (32u << 20); ldc = 1024; colt = (u.pn & 3) * 256; }
        else if (u.pn == 12) { O = HD1; ldc = 256; colt = 0; mode0 = 1; }
        else { O = HD2; ldc = 256; colt = 0; mode0 = 2; mode1 = 2; }
        const int col0 = colt + wc * 32 + 8 * fq;
#pragma unroll
        for (int ai = 0; ai < 2; ++ai)
#pragma unroll
            for (int m = 0; m < 4; ++m) {
                bf16* rowp = O + (size_t)(row0 + ai * 128 + m * 16) * ldc + col0;
#pragma unroll
                for (int bj = 0; bj < 2; ++bj) { f32x4 v0 = acc[ai][bj][m][0], v1 = acc[ai][bj][m][1]; const int md = bj ? mode1 : mode0;
                    if (md == 1) {
#pragma unroll
                        for (int j = 0; j < 4; ++j) { v0[j] = tanhf_(v0[j]); v1[j] = tanhf_(v1[j]); } }
                    else if (md == 2) {
#pragma unroll
                        for (int j = 0; j < 4; ++j) { v0[j] = sigmoidf_(v0[j]); v1[j] = sigmoidf_(v1[j]); } }
                    store8(rowp + bj * 128, v0, v1); }
            }
    }
};

enum InIdx { I_X = 0, I_MEM, I_REL, I_NMIX, I_NXATTN, I_NMEM, I_NFFN, I_NFINAL, I_WIN, I_WOUT, I_CONVW, I_CONVB, I_CLNG, I_CLNB, I_LQ1, I_LK1, I_LQ2, I_LK2, I_SUBLN,
             I_MU, I_WR, I_WK, I_WV, I_WO, I_W0, I_W1, I_W2, I_A0, I_A1, I_A2, I_G1, I_G2, I_KK, I_KA, I_RK, I_LNG, I_LNB, I_XQ, I_XKV, I_XO, I_UP, I_DN, N_IN };
struct Args { const float* in[N_IN]; float* out; unsigned char* ws; int ph_lo, ph_hi; };
static_assert(sizeof(Args) == (N_IN + 2) * 8 + 8, "Args has no padding");

struct Frame {
    LAS unsigned char* lds;
    int tid, lane, wave, gw, ngw;
    unsigned char* ws;
};

DI Frame fresh(const Frame& F0) {
    Frame F = F0; F.tid = opaque(threadIdx.x); F.lane = F.tid & 63; F.wave = __builtin_amdgcn_readfirstlane(F.tid >> 6); F.gw = opq(blockIdx.x) * 8 + F.wave; F.ngw = opq(gridDim.x) * 8; return F;
}
struct TJob { const float* W; int K, N; bf16* WT; int ldt, row_off, col_off, perm; const float* gain; };
DI void tr_item(const TJob& J, LAS float* scr, int item, int lane) {
    const int nblk = J.N / 32, kb = item / nblk, nb = item % nblk, k0 = 64 * kb, n0 = 32 * nb;
    float scale = 1.0f; int drow = J.row_off + n0;
    if (J.perm) {
        if (n0 < 512) drow = 256 * (n0 >> 7) + (n0 & 127);
        else if (n0 < 1024) drow = 256 * ((n0 - 512) >> 7) + 128 + ((n0 - 512) & 127);
        else drow = n0;
        if (n0 >= 1024 && n0 < 1536) scale = 0.125f;
    }
    float tv[32];
    const float* wp = J.W + (size_t)(k0 + (lane >> 5)) * J.N + n0 + (lane & 31);
#pragma unroll
    for (int i = 0; i < 32; ++i) tv[i] = wp[(size_t)(2 * i) * J.N];
    if (J.gain) {
#pragma unroll
        for (int i = 0; i < 32; ++i) tv[i] *= J.gain[k0 + 2 * i + (lane >> 5)];
    }
#pragma unroll
    for (int i = 0; i < 32; ++i) scr[(2 * i + (lane >> 5)) * 33 + (lane & 31)] = tv[i] * scale;
    asm volatile("s_waitcnt lgkmcnt(0)" ::: "memory");
    const int c = lane & 7;
#pragma unroll
    for (int j = 0; j < 4; ++j) { const int n = (lane >> 3) + 8 * j; const LAS float* s = scr + (8 * c) * 33 + n;
        u32x4 o; o.x = pk2(s[0 * 33], s[1 * 33]); o.y = pk2(s[2 * 33], s[3 * 33]); o.z = pk2(s[4 * 33], s[5 * 33]); o.w = pk2(s[6 * 33], s[7 * 33]);
        *(u32x4*)(J.WT + (size_t)(drow + n) * J.ldt + J.col_off + k0 + 8 * c) = o; }
    asm volatile("s_waitcnt lgkmcnt(0)" ::: "memory");
}
constexpr int N_TJOBS = 31;
DI TJob get_tjob(int j, const Args& a, unsigned char* ws) {
    TJob J; J.perm = 0; J.gain = nullptr; J.row_off = 0; J.col_off = 0;
    if (j == 0) { J.W = a.in[opq(I_WIN)]; J.K = 1024; J.N = 2560; J.WT = (bf16*)(ws + WS_WIN); J.ldt = 1024; J.perm = 1; J.gain = a.in[opq(I_NMIX)]; }
    else if (j == 1) { J.W = a.in[opq(I_WOUT)]; J.K = 1024; J.N = 1024; J.WT = (bf16*)(ws + WS_WOUT); J.ldt = 1024; }
    else if (j < 4) { const int i = j - 2; J.W = a.in[opq(I_XKV)] + (size_t)i * 1024 * 2048; J.K = 1024; J.N = 2048; J.WT = (bf16*)(ws + WS_WKV) + (size_t)i * 2048 * 1024; J.ldt = 1024; J.gain = a.in[opq(I_NMEM)] + i * 1024; }
    else if (j < 6) { const int i = j - 4; J.W = a.in[opq(I_XO)] + (size_t)i * 1024 * 1024; J.K = 1024; J.N = 1024; J.WT = (bf16*)(ws + WS_WXO) + (size_t)i * 1024 * 1024; J.ldt = 1024; }
    else if (j < 8) { const int i = j - 6; J.W = a.in[opq(I_UP)] + (size_t)i * 1024 * 4096; J.K = 1024; J.N = 4096; J.WT = (bf16*)(ws + WS_WUP) + (size_t)i * 4096 * 1024; J.ldt = 1024; J.gain = a.in[opq(I_NFFN)] + i * 1024; }
    else if (j < 10) { const int i = j - 8; J.W = a.in[opq(I_DN)] + (size_t)i * 4096 * 1024; J.K = 4096; J.N = 1024; J.WT = (bf16*)(ws + WS_WDN) + (size_t)i * 1024 * 4096; J.ldt = 4096; }
    else if (j < 26) {
        const int q = j - 10, src = q >> 1, copy = q & 1; int mu = 0;
        J.K = 1024; J.WT = (bf16*)(ws + WS_WBIG); J.ldt = 2048; J.col_off = copy * 1024;
        if (src == 0) { J.W = a.in[opq(I_WR)]; J.N = 1024; J.row_off = 0; mu = 0; }
        else if (src == 1) { J.W = a.in[opq(I_WK)]; J.N = 1024; J.row_off = 1024; mu = 2; }
        else if (src == 2) { J.W = a.in[opq(I_WV)]; J.N = 1024; J.row_off = 2048; mu = 3; }
        else if (src == 3) { J.W = a.in[opq(I_W1)]; J.N = 64; J.row_off = 3072; mu = 1; }
        else if (src == 4) { J.W = a.in[opq(I_W1)] + 1024 * 64; J.N = 64; J.row_off = 3136; mu = 1; }
        else if (src == 5) { J.W = a.in[opq(I_A1)]; J.N = 64; J.row_off = 3200; mu = 4; }
        else if (src == 6) { J.W = a.in[opq(I_A1)] + 1024 * 64; J.N = 64; J.row_off = 3264; mu = 4; }
        else { J.W = a.in[opq(I_G1)]; J.N = 160; J.row_off = 3328; mu = 5; }
        if (copy) J.gain = a.in[opq(I_MU)] + mu * 1024;
    }
    else if (j < 30) { const int q = j - 26; J.W = (q < 2 ? a.in[opq(I_W2)] : a.in[opq(I_A2)]) + (size_t)(q & 1) * 64 * 1024; J.K = 64; J.N = 1024; J.WT = (bf16*)(ws + WS_W2T) + (size_t)q * 1024 * 64; J.ldt = 64; }
    else { J.W = a.in[opq(I_WO)]; J.K = 1024; J.N = 1024; J.WT = (bf16*)(ws + WS_WRO); J.ldt = 1024; }
    return J;
}
DI void row_to_bf16_rs(const float* xrow, bf16* orow, float* rs, int lane) {
    const f32x4* xr = (const f32x4*)xrow + lane;
    f32x4 v[4]; float s = 0.f;
#pragma unroll
    for (int j = 0; j < 4; ++j) { v[j] = xr[64 * j]; s += (v[j].x * v[j].x + v[j].y * v[j].y) + (v[j].z * v[j].z + v[j].w * v[j].w); }
    s = wave_sum(s);
    u32x2* o8 = (u32x2*)orow + lane;
#pragma unroll
    for (int j = 0; j < 4; ++j) { u32x2 w; w.x = pk2(v[j].x, v[j].y); w.y = pk2(v[j].z, v[j].w); o8[64 * j] = w; }
    if (lane == 0) *rs = 1.0f / sqrtf(s * (1.0f / D) + EPS);
}
DI void rows4_to_bf16_rs(const Frame& F, const float* X, bf16* O, float* rs, int nrows) {
    for (int m0 = F.gw * 4; m0 < nrows; m0 += F.ngw * 4) {
        f32x4 v[4][4];
#pragma unroll
        for (int r = 0; r < 4; ++r)
#pragma unroll
            for (int j = 0; j < 4; ++j) v[r][j] = ((const f32x4*)(X + (size_t)(m0 + r) * D))[F.lane + 64 * j];
#pragma unroll
        for (int r = 0; r < 4; ++r) {
            float s = 0.f;
#pragma unroll
            for (int j = 0; j < 4; ++j) s += (v[r][j].x * v[r][j].x + v[r][j].y * v[r][j].y) + (v[r][j].z * v[r][j].z + v[r][j].w * v[r][j].w);
            s = wave_sum(s);
            u32x2* o8 = (u32x2*)(O + (size_t)(m0 + r) * D) + F.lane;
#pragma unroll
            for (int j = 0; j < 4; ++j) { u32x2 w; w.x = pk2(v[r][j].x, v[r][j].y); w.y = pk2(v[r][j].z, v[r][j].w); o8[64 * j] = w; }
            if (F.lane == 0) rs[m0 + r] = 1.0f / sqrtf(s * (1.0f / D) + EPS);
        }
    }
}
DI int t5_bucket(int rel) {
    const int n = rel < 0 ? -rel : rel; int r = rel > 0 ? 16 : 0;
    if (n < 8) return r + n;
    int lg = 8; lg += (n >= 12); lg += (n >= 16); lg += (n >= 23); lg += (n >= 32); lg += (n >= 46); lg += (n >= 64); lg += (n >= 91);
    return r + lg;
}
DI void phase_prologue(const Frame& F0, const Args& a, unsigned char* ws) {
    const Frame F = fresh(F0);
    LAS float* scr = (LAS float*)(F.lds + F.wave * 16384);
    for (int j = 0; j < N_TJOBS; ++j) {
        const TJob J = get_tjob(j, a, ws); const int items = (J.K / 64) * (J.N / 32);
        for (int it = F.gw; it < items; it += F.ngw) tr_item(J, scr, it, F.lane);
    }
    const int gt = F.gw * 64 + F.lane, ngt = F.ngw * 64;
    for (int i = 0; i < 2; ++i) {
        const float* W = a.in[opq(I_XQ)] + (size_t)i * 1024 * 1024; const float* g = a.in[opq(I_NXATTN)] + i * 1024; bf16* O = (bf16*)(ws + WS_WQN) + (size_t)i * 1024 * 1024;
        for (int e = gt; e < 1024 * 1024 / 4; e += ngt) { const f32x4 v = ((const f32x4*)W)[e]; const float s = g[(e * 4) >> 10] * 0.0625f; u32x2 w; w.x = pk2(v.x * s, v.y * s); w.y = pk2(v.z * s, v.w * s); ((u32x2*)O)[e] = w; }
    }
    { const float* W = a.in[opq(I_G2)]; bf16* O = (bf16*)(ws + WS_G2T);
      for (int e = gt; e < 1024 * 256; e += ngt) { const int rown = e >> 8, k = e & 255, cc = rown & 255;
        const int n = (rown & ~255) + 64 * ((cc >> 5) & 3) + 32 * (cc >> 7) + (cc & 31);
        O[e] = (bf16)(k < 160 ? f2bf(W[(size_t)k * 1024 + n]) : 0u); } }
    { u32x4* O = (u32x4*)((bf16*)(ws + WS_WBIG) + (size_t)3488 * 2048);
      const unsigned zq = (unsigned)opaque(0);
      for (int e = gt; e < 96 * 2048 * 2 / 16; e += ngt) O[e] = (u32x4){zq, zq, zq, zq}; }
    rows4_to_bf16_rs(F, a.in[opq(I_X)], (bf16*)(ws + WS_SA), (float*)(ws + WS_RS), M);
    rows4_to_bf16_rs(F, a.in[opq(I_MEM)], (bf16*)(ws + WS_MEMB), (float*)(ws + WS_RSMEM), MMEM);
    { float* B = (float*)(ws + WS_BIAS); const float* tab = a.in[opq(I_REL)];
      for (int e = gt; e < 4 * 4096; e += ngt) { const int h = e >> 12, idx = e & 4095; const int rel = idx - 2047; B[e] = idx < 4095 ? tab[t5_bucket(rel) * 4 + h] * LOG2E : 0.f; } }
    if (F.gw == 0) {
        const float q1 = a.in[opq(I_LQ1)][F.lane] * a.in[opq(I_LK1)][F.lane], q2 = a.in[opq(I_LQ2)][F.lane] * a.in[opq(I_LK2)][F.lane];
        const float s1 = wave_sum(q1), s2 = wave_sum(q2);
        if (F.lane == 0) ((float*)(ws + WS_LAM))[0] = expf(s1) - expf(s2) + 0.2f;
    }
}

DI void phase_norm(const Frame& F0, const float* h, bf16* hb, float* rs) {
    const Frame F = fresh(F0);
    for (int m = F.gw; m < M; m += F.ngw) row_to_bf16_rs(h + (size_t)m * D, hb + (size_t)m * D, rs + m, F.lane);
}
DI void phase_final_norm(const Frame& F0, const bf16* h, float* out, const float* g, const float osc) {
    const Frame F = fresh(F0);
    f32x4 gv[4];
#pragma unroll
    for (int j = 0; j < 4; ++j) gv[j] = ((const f32x4*)g)[F.lane + 64 * j];
    for (int m0 = F.gw * 4; m0 < M; m0 += F.ngw * 4) {
        u32x2 hw[4][4];
#pragma unroll
        for (int r = 0; r < 4; ++r)
#pragma unroll
            for (int j = 0; j < 4; ++j) hw[r][j] = ((const u32x2*)(h + (size_t)(m0 + r) * D))[F.lane + 64 * j];
#pragma unroll
        for (int r = 0; r < 4; ++r) {
            f32x4 v[4]; float s = 0.f;
#pragma unroll
            for (int j = 0; j < 4; ++j) { v[j] = (f32x4){bflo(hw[r][j].x), bfhi(hw[r][j].x), bflo(hw[r][j].y), bfhi(hw[r][j].y)}; s += (v[j].x * v[j].x + v[j].y * v[j].y) + (v[j].z * v[j].z + v[j].w * v[j].w); }
            const float rr = osc / sqrtf(wave_sum(s) * (1.0f / D) + EPS);
            f32x4* xr = (f32x4*)(out + (size_t)(m0 + r) * D) + F.lane;
#pragma unroll
            for (int j = 0; j < 4; ++j) xr[64 * j] = v[j] * rr * gv[j];
        }
    }
}
DI void phase_rwkv_shift(const Frame& F0, const bf16* h, const float* g, bf16* A1) {
    const Frame F = fresh(F0);
    f32x4 gv[4];
#pragma unroll
    for (int j = 0; j < 4; ++j) gv[j] = ((const f32x4*)g)[F.lane + 64 * j];
    for (int ch = F.gw; ch < M / 16; ch += F.ngw) {
        const int m0 = ch * 16, t0 = m0 & (T - 1);
        f32x4 p2[4], p1[4], cu[4];
#pragma unroll
        for (int j = 0; j < 4; ++j) { p2[j] = (f32x4){0.f, 0.f, 0.f, 0.f}; p1[j] = p2[j]; cu[j] = p2[j]; }
#pragma unroll 1
        for (int g6 = 0; g6 < 3; ++g6) {
            f32x4 ld[6][4];
#pragma unroll
            for (int r = 0; r < 6; ++r) { const int i = g6 * 6 + r - 1, t = t0 + i; const bool ok = (t >= 0 && t < T);
#pragma unroll
                for (int j = 0; j < 4; ++j) { const u32x2 w = ok ? ((const u32x2*)(h + (size_t)(m0 + i) * D))[F.lane + 64 * j] : (u32x2){0u, 0u}; ld[r][j] = (f32x4){bflo(w.x), bfhi(w.x), bflo(w.y), bfhi(w.y)}; } }
#pragma unroll
            for (int r = 0; r < 6; ++r) {
                const int i = g6 * 6 + r - 1;
                float s = 0.f;
#pragma unroll
                for (int j = 0; j < 4; ++j) { p2[j] = p1[j]; p1[j] = cu[j]; cu[j] = ld[r][j]; s += (cu[j].x * cu[j].x + cu[j].y * cu[j].y) + (cu[j].z * cu[j].z + cu[j].w * cu[j].w); }
                const float rr = 1.0f / sqrtf(wave_sum(s) * (1.0f / D) + EPS);
#pragma unroll
                for (int j = 0; j < 4; ++j) cu[j] = cu[j] * rr * gv[j];
                if (i >= 1) {
                    u32x2* o = (u32x2*)(A1 + (size_t)(m0 + i - 1) * 2048) + F.lane;
#pragma unroll
                    for (int j = 0; j < 4; ++j) { const f32x4 hh = (p2[j] + cu[j]) * 0.5f - p1[j];
                        u32x2 w; w.x = pk2(p1[j].x, p1[j].y); w.y = pk2(p1[j].z, p1[j].w); o[64 * j] = w;
                        u32x2 w2; w2.x = pk2(hh.x, hh.y); w2.y = pk2(hh.z, hh.w); o[256 + 64 * j] = w2; }
                }
            }
        }
    }
}
DI void phase_rwkv_comb(const Frame& F0, const bf16* YF, const bf16* YB, const bf16* V, const bf16* GT, const float* BON, const float* lng, const float* lnb, bf16* O) {
    const Frame F = fresh(F0);
    const int hd = F.lane >> 2, c0 = F.lane * 16;
    float lg[16], lb[16];
#pragma unroll
    for (int j = 0; j < 16; ++j) { lg[j] = lng[c0 + j]; lb[j] = lnb[c0 + j]; }
    for (int m0 = F.gw * 2; m0 < M; m0 += F.ngw * 2) {
        u32x4 a[2][2], b[2][2], vv[2][2], gg[2][2]; float bonr[2];
#pragma unroll
        for (int r = 0; r < 2; ++r) { const size_t off = (size_t)(m0 + r) * D + c0;
#pragma unroll
            for (int q = 0; q < 2; ++q) { a[r][q] = ((const u32x4*)(YF + off))[q]; b[r][q] = ((const u32x4*)(YB + off))[q]; vv[r][q] = ((const u32x4*)(V + off))[q]; gg[r][q] = ((const u32x4*)(GT + off))[q]; }
            bonr[r] = BON[(size_t)(m0 + r) * 16 + hd] + BON[(size_t)(M + m0 + r) * 16 + hd]; }
#pragma unroll
        for (int r = 0; r < 2; ++r) {
            const size_t off = (size_t)(m0 + r) * D + c0; const float bon = bonr[r];
            float y[16]; float s = 0.f;
#pragma unroll
            for (int q = 0; q < 2; ++q)
#pragma unroll
                for (int w = 0; w < 4; ++w) { y[q * 8 + 2 * w] = bflo(a[r][q][w]) + bflo(b[r][q][w]); y[q * 8 + 2 * w + 1] = bfhi(a[r][q][w]) + bfhi(b[r][q][w]); }
#pragma unroll
            for (int j = 0; j < 16; ++j) s += y[j];
            s += swz_xor<1>(s); s += swz_xor<2>(s);
            const float mean = s * (1.0f / 64.0f); float q2 = 0.f;
#pragma unroll
            for (int j = 0; j < 16; ++j) { y[j] -= mean; q2 += y[j] * y[j]; }
            q2 += swz_xor<1>(q2); q2 += swz_xor<2>(q2);
            const float rstd = 1.0f / sqrtf(q2 * (1.0f / 64.0f) + 64e-5f);
            u32x4 o[2];
#pragma unroll
            for (int q = 0; q < 2; ++q)
#pragma unroll
                for (int w = 0; w < 4; ++w) {
                    const int j = q * 8 + 2 * w;
                    const float r0 = (y[j] * rstd * lg[j] + lb[j] + bon * bflo(vv[r][q][w])) * bflo(gg[r][q][w]);
                    const float r1 = (y[j + 1] * rstd * lg[j + 1] + lb[j + 1] + bon * bfhi(vv[r][q][w])) * bfhi(gg[r][q][w]);
                    o[q][w] = pk2(r0, r1);
                }
            ((u32x4*)(O + off))[0] = o[0]; ((u32x4*)(O + off))[1] = o[1];
        }
    }
}
constexpr int CV_ROWB = 1040, CV_IN_BYTES = 94 * CV_ROWB, CV_W_OFF = CV_IN_BYTES;
DI void conv_load_weights(const Frame& F0, const float* cw) {
    const Frame F = fresh(F0);
    LAS bf16* W = (LAS bf16*)(F.lds + CV_W_OFF);
    for (int e = F.tid; e < 31 * 512; e += 512) W[e] = (bf16)f2bf(cw[e]);
}
DI void conv_unit(const Frame& F0, int unit, const bf16* GLU, const float* cb, const float* lg, const float* lb, bf16* MIX) {
    const Frame F = fresh(F0);
    const int b = unit >> 5, t0 = (unit & 31) * 64;
    __syncthreads();
    for (int p = F.tid; p < 94 * 64; p += 512) {
        const int r = p >> 6, c = p & 63, t = t0 - 15 + r;
        u32x4 v = (u32x4){0u, 0u, 0u, 0u};
        if (t >= 0 && t < T) v = *(const u32x4*)(GLU + (size_t)(b * T + t) * 512 + c * 8);
        *(LAS u32x4*)(F.lds + r * CV_ROWB + c * 16) = v;
    }
    __syncthreads();
    const int tl = F.tid >> 3, chunk = F.tid & 7;
    float y[64];
#pragma unroll
    for (int i = 0; i < 8; ++i) {
        const int cg = chunk + 8 * i;
        float acc[8];
#pragma unroll
        for (int e = 0; e < 8; ++e) acc[e] = cb[cg * 8 + e];
#pragma unroll 1
        for (int j = 0; j < 31; ++j) {
            const u32x4 x = *(const LAS u32x4*)(F.lds + (tl + j) * CV_ROWB + cg * 16);
            const u32x4 w = *(const LAS u32x4*)(F.lds + CV_W_OFF + j * 1024 + cg * 16);
#pragma unroll
            for (int q = 0; q < 4; ++q) { acc[2 * q] += bflo(x[q]) * bflo(w[q]); acc[2 * q + 1] += bfhi(x[q]) * bfhi(w[q]); }
        }
#pragma unroll
        for (int e = 0; e < 8; ++e) y[i * 8 + e] = acc[e];
    }
    float s = 0.f;
#pragma unroll
    for (int j = 0; j < 64; ++j) s += y[j];
    s += swz_xor<1>(s); s += swz_xor<2>(s); s += swz_xor<4>(s);
    const float mean = s * (1.0f / 512.0f); float q2 = 0.f;
#pragma unroll
    for (int j = 0; j < 64; ++j) { y[j] -= mean; q2 += y[j] * y[j]; }
    q2 += swz_xor<1>(q2); q2 += swz_xor<2>(q2); q2 += swz_xor<4>(q2);
    const float rstd = 1.0f / sqrtf(q2 * (1.0f / 512.0f) + 1e-5f);
    bf16* orow = MIX + (size_t)(b * T + t0 + tl) * 1024;
#pragma unroll
    for (int i = 0; i < 8; ++i) {
        const int c0 = (chunk + 8 * i) * 8;
        const f32x4 g0 = *(const f32x4*)(lg + c0), g1 = *(const f32x4*)(lg + c0 + 4), b0 = *(const f32x4*)(lb + c0), b1 = *(const f32x4*)(lb + c0 + 4);
        f32x4 o0, o1;
#pragma unroll
        for (int e = 0; e < 4; ++e) { const float v0 = y[i * 8 + e] * rstd * g0[e] + b0[e], v1 = y[i * 8 + 4 + e] * rstd * g1[e] + b1[e]; o0[e] = v0 * sigmoidf_(v0); o1[e] = v1 * sigmoidf_(v1); }
        store8(orow + c0, o0, o1);
    }
}

constexpr int DA_KROW = 272, DA_VROW = 144, DA_KB = 64 * DA_KROW, DA_VB = 128 * DA_VROW, DA_BUF = DA_KB + DA_VB;
DI int crow(int reg, int hf) { return (reg & 3) + 8 * (reg >> 2) + 4 * hf; }
DI void diffattn_unit(const Frame& F0, int unit, const bf16* QK, const bf16* VT, const float* BIAS, const float lam, const float* subg, bf16* MIX) {
    const Frame F = fresh(F0);
    const int b = unit >> 6, h = (unit >> 4) & 3, qb = unit & 15;
    const int c = F.wave >> 2, qs = F.wave & 3, r32 = F.lane & 31, hf = F.lane >> 5;
    const int q0w = qb * 128 + qs * 32;
    const float* bias_h = BIAS + h * 4096 + 2047;
    bf16x8 Qf[4];
    { const bf16* qp = QK + (size_t)(b * T + q0w + r32) * 1024 + h * 128 + c * 64 + 8 * hf;
#pragma unroll
      for (int ks = 0; ks < 4; ++ks) Qf[ks] = *(const bf16x8*)(qp + 16 * ks); }
    const bf16* kg[2]; const bf16* vg[2]; int kl[2], vl[2];
#pragma unroll
    for (int i = 0; i < 2; ++i) { const int p = F.tid + 512 * i;
        kg[i] = QK + (size_t)(b * T + (p >> 4)) * 1024 + 512 + h * 128 + (p & 15) * 8; kl[i] = (p >> 4) * DA_KROW + (p & 15) * 16;
        vg[i] = VT + (size_t)(h * 128 + (p >> 3)) * M + b * T + (p & 7) * 8; vl[i] = DA_KB + (p >> 3) * DA_VROW + ((p & 7) >> 1) * 32 + ((p & 7) & 1) * 8; }
    u32x4 kr[2], vr[2];
#pragma unroll
    for (int i = 0; i < 2; ++i) { kr[i] = *(const u32x4*)(kg[i]); vr[i] = *(const u32x4*)(vg[i]); }
    __syncthreads();
    LAS float* const btab = (LAS float*)(F.lds + 2 * DA_BUF);
    btab[F.tid] = bias_h[F.tid - 256];
#pragma unroll
    for (int i = 0; i < 2; ++i) { *(LAS u32x4*)(F.lds + kl[i]) = kr[i]; *(LAS u32x2*)(F.lds + vl[i]) = (u32x2){vr[i].x, vr[i].y}; *(LAS u32x2*)(F.lds + vl[i] + 16) = (u32x2){vr[i].z, vr[i].w}; }
#pragma unroll
    for (int i = 0; i < 2; ++i) { kr[i] = *(const u32x4*)(kg[i] + (size_t)64 * 1024); vr[i] = *(const u32x4*)(vg[i] + 64); }
    __syncthreads();
    f32x16 O[4];
#pragma unroll
    for (int vt = 0; vt < 4; ++vt)
#pragma unroll
        for (int i = 0; i < 16; ++i) O[vt][i] = 0.f;
    float lsum = 0.f;
    const float cbR = bias_h[91], cbL = bias_h[-91];
    const int ka = r32 * DA_KROW + c * 128 + 16 * hf;
    const int va = DA_KB + r32 * DA_VROW + 16 * hf;
    for (int kt = 0; kt < 32; ++kt) {
        const int k0 = kt * 64;
        LAS unsigned char* buf = F.lds + (kt & 1) * DA_BUF;
        const int dmin = k0 - (q0w + 31), dmax = k0 + 63 - q0w;
        const bool far = (dmin >= 91) || (dmax <= -91);
        const float cb = dmin >= 91 ? cbR : cbL;
        bf16x8 kf[8];
#pragma unroll
        for (int f = 0; f < 8; ++f) kf[f] = *(const LAS bf16x8*)(buf + ka + (f >> 2) * 32 * DA_KROW + (f & 3) * 32);
        __builtin_amdgcn_sched_barrier(0);
        f32x16 S0, S1;
        { const float z0 = ozero();
#pragma unroll
          for (int i = 0; i < 16; ++i) { S0[i] = z0; S1[i] = z0; } }
        bf16x8 vf0[8];
#pragma unroll
        for (int f = 0; f < 8; ++f) vf0[f] = *(const LAS bf16x8*)(buf + va + (f & 3) * 32 * DA_VROW + (f >> 2) * 32);
#pragma unroll
        for (int ks = 0; ks < 4; ++ks) S0 = __builtin_amdgcn_mfma_f32_32x32x16_bf16(kf[ks], Qf[ks], S0, 0, 0, 0);
#pragma unroll
        for (int ks = 0; ks < 4; ++ks) S1 = __builtin_amdgcn_mfma_f32_32x32x16_bf16(kf[4 + ks], Qf[ks], S1, 0, 0, 0);
        __builtin_amdgcn_sched_barrier(0);
        bf16x8 vf1[8];
#pragma unroll
        for (int f = 0; f < 8; ++f) vf1[f] = *(const LAS bf16x8*)(buf + va + (f & 3) * 32 * DA_VROW + (2 + (f >> 2)) * 32);
        bf16x8 pa0[2], pa1[2];
        {
            float p[16];
            if (far) {
#pragma unroll
                for (int i = 0; i < 16; ++i) p[i] = fexp2(S0[i] * LOG2E + cb); } else { const LAS float* tb = btab + (k0 - (q0w + r32) + 256);
#pragma unroll
                for (int i = 0; i < 16; ++i) p[i] = fexp2(S0[i] * LOG2E + tb[crow(i, hf)]); }
#pragma unroll
            for (int i = 0; i < 16; ++i) lsum += p[i];
#pragma unroll
            for (int s2 = 0; s2 < 2; ++s2) { u32x4 pw; pw.x = pk2(p[8 * s2], p[8 * s2 + 1]); pw.y = pk2(p[8 * s2 + 2], p[8 * s2 + 3]); pw.z = pk2(p[8 * s2 + 4], p[8 * s2 + 5]); pw.w = pk2(p[8 * s2 + 6], p[8 * s2 + 7]); pa0[s2] = __builtin_bit_cast(bf16x8, pw); }
        }
        __builtin_amdgcn_sched_barrier(0);
#pragma unroll
        for (int f = 0; f < 8; ++f) O[f & 3] = __builtin_amdgcn_mfma_f32_32x32x16_bf16(pa0[f >> 2], vf0[f], O[f & 3], 0, 0, 0);
        {
            float p[16];
            if (far) {
#pragma unroll
                for (int i = 0; i < 16; ++i) p[i] = fexp2(S1[i] * LOG2E + cb); } else { const LAS float* tb = btab + (k0 + 32 - (q0w + r32) + 256);
#pragma unroll
                for (int i = 0; i < 16; ++i) p[i] = fexp2(S1[i] * LOG2E + tb[crow(i, hf)]); }
#pragma unroll
            for (int i = 0; i < 16; ++i) lsum += p[i];
#pragma unroll
            for (int s2 = 0; s2 < 2; ++s2) { u32x4 pw; pw.x = pk2(p[8 * s2], p[8 * s2 + 1]); pw.y = pk2(p[8 * s2 + 2], p[8 * s2 + 3]); pw.z = pk2(p[8 * s2 + 4], p[8 * s2 + 5]); pw.w = pk2(p[8 * s2 + 6], p[8 * s2 + 7]); pa1[s2] = __builtin_bit_cast(bf16x8, pw); }
        }
        __builtin_amdgcn_sched_barrier(0);
#pragma unroll
        for (int f = 0; f < 8; ++f) O[f & 3] = __builtin_amdgcn_mfma_f32_32x32x16_bf16(pa1[f >> 2], vf1[f], O[f & 3], 0, 0, 0);
        if (kt + 1 < 32) {
            LAS unsigned char* nb = F.lds + ((kt + 1) & 1) * DA_BUF;
#pragma unroll
            for (int i = 0; i < 2; ++i) { *(LAS u32x4*)(nb + kl[i]) = kr[i]; *(LAS u32x2*)(nb + vl[i]) = (u32x2){vr[i].x, vr[i].y}; *(LAS u32x2*)(nb + vl[i] + 16) = (u32x2){vr[i].z, vr[i].w}; }
        }
        if (kt + 2 < 32) {
#pragma unroll
            for (int i = 0; i < 2; ++i) { kr[i] = *(const u32x4*)(kg[i] + (size_t)(k0 + 128) * 1024); vr[i] = *(const u32x4*)(vg[i] + k0 + 128); }
        }
        __syncthreads();
    }
    lsum = half_sum(lsum);
    LAS float* XO = (LAS float*)F.lds;
    LAS float* LW = (LAS float*)(F.lds + 65536) + F.wave * 32;
    if (hf == 0) LW[r32] = 1.0f / lsum;
    asm volatile("s_waitcnt lgkmcnt(0)" ::: "memory");
    float il[16];
#pragma unroll
    for (int i = 0; i < 16; ++i) il[i] = LW[crow(i, hf)];
    if (c == 1) {
#pragma unroll
        for (int vt = 0; vt < 4; ++vt)
#pragma unroll
            for (int i = 0; i < 16; ++i) XO[(qs * 32 + crow(i, hf)) * 128 + vt * 32 + r32] = O[vt][i] * il[i];
    }
    __syncthreads();
    if (c == 0) {
        float ss[16];
#pragma unroll
        for (int i = 0; i < 16; ++i) ss[i] = 0.f;
#pragma unroll
        for (int vt = 0; vt < 4; ++vt)
#pragma unroll
            for (int i = 0; i < 16; ++i) { const float o = O[vt][i] * il[i] - lam * XO[(qs * 32 + crow(i, hf)) * 128 + vt * 32 + r32]; O[vt][i] = o; ss[i] += o * o; }
#pragma unroll
        for (int i = 0; i < 16; ++i) { float v = ss[i]; v += swz_xor<1>(v); v += swz_xor<2>(v); v += swz_xor<4>(v); v += swz_xor<8>(v); v += swz_xor<16>(v); ss[i] = 0.8f / sqrtf(v * (1.0f / 128.0f) + EPS); }
#pragma unroll
        for (int vt = 0; vt < 4; ++vt) {
            const float g = subg[vt * 32 + r32];
#pragma unroll
            for (int i = 0; i < 16; ++i) MIX[(size_t)(b * T + q0w + crow(i, hf)) * 1024 + 512 + h * 128 + vt * 32 + r32] = (bf16)f2bf(O[vt][i] * ss[i] * g);
        }
    }
}

constexpr int SC_VECB = 256, SC_STEPB = 6 * SC_VECB, SC_BUFB = 16 * SC_STEPB;
constexpr int SC_SCR_OFF = 4 * SC_BUFB, SC_SCR_W = 16 * 68 * 4;
DI float dpp_x1(float v) { return __builtin_bit_cast(float, __builtin_amdgcn_update_dpp(0, __builtin_bit_cast(int, v), 0xB1, 0xF, 0xF, true)); }
DI float dpp_x2(float v) { return __builtin_bit_cast(float, __builtin_amdgcn_update_dpp(0, __builtin_bit_cast(int, v), 0x4E, 0xF, 0xF, true)); }
DI float quad_sum(float v) { v += dpp_x1(v); v += dpp_x2(v); return v; }

DI float a_fmac(float acc, float a, float b) { return __builtin_fmaf(a, b, acc); }
DI float a_fma(float a, float b, float c) { return __builtin_fmaf(a, b, c); }
DI float a_mul(float a, float b) { return a * b; }
struct ScanPtrs { const bf16 *R, *K, *V, *HD1, *W2T; const float *w0, *a0, *kk, *ka, *rk; bf16 *YF, *YB; float* BON; unsigned* ERR; };

DI void scan_pair(const Frame& F0, int bh, const ScanPtrs& P) {
    const Frame F = fresh(F0);
    const int b = bh >> 4, h = bh & 15;
    __syncthreads();
    if (F.wave < 4) {
        const int z = F.wave >> 1, rh = F.wave & 1, rp = F.lane >> 2, jq = F.lane & 3, i0 = rh * 32 + 2 * rp;
        float S0[16], S1[16];
#pragma unroll
        for (int j = 0; j < 16; ++j) { S0[j] = 0.f; S1[j] = 0.f; }
        bf16* Y = z ? P.YB : P.YF;
        __builtin_amdgcn_s_barrier();
#ifdef MK_TPROBE
        unsigned long long tp_acc = 0ull, tp_phase0 = __builtin_amdgcn_s_memtime();
#endif
        for (int e = 0; e < T / 16; ++e) {
#ifdef MK_TPROBE
            const unsigned long long tp0 = __builtin_amdgcn_s_memtime();
#endif
            const LAS unsigned char* base = F.lds + (z * 2 + (e & 1)) * SC_BUFB + jq * 64;
            const int t0c = z ? T - 16 * (e + 1) : 16 * e;
            bf16* yrow = Y + (size_t)(b * T + t0c) * 1024 + h * 64 + i0;
            f32x4 wv[2][4], kv[2][4], bv[2][4], av[2][4], rv[2][4]; f32x2 v2[2];
#define SC_FETCH(slot, li_) do { const LAS unsigned char* sb_ = base + (li_) * SC_STEPB; _Pragma("unroll") for (int q = 0; q < 4; ++q) { \
                av[slot][q] = *(const LAS f32x4*)(sb_ + 3 * SC_VECB + q * 16); wv[slot][q] = *(const LAS f32x4*)(sb_ + q * 16); kv[slot][q] = *(const LAS f32x4*)(sb_ + SC_VECB + q * 16); \
                bv[slot][q] = *(const LAS f32x4*)(sb_ + 2 * SC_VECB + q * 16); rv[slot][q] = *(const LAS f32x4*)(sb_ + 4 * SC_VECB + q * 16); } \
                v2[slot] = *(const LAS f32x2*)(sb_ - jq * 64 + 5 * SC_VECB + i0 * 4); } while (0)
            SC_FETCH(0, z ? 15 : 0);
#pragma unroll
            for (int s = 0; s < 16; ++s) {
                const int li = z ? 15 - s : s, cs = s & 1, ns = cs ^ 1;
                if (s < 15) SC_FETCH(ns, z ? 14 - s : s + 1);
                __builtin_amdgcn_sched_barrier(0);
                float sa0 = 0.f, sa1 = 0.f, sb0 = 0.f, sb1 = 0.f;
#pragma unroll
                for (int j = 0; j < 16; j += 2) { const float a0 = av[cs][j >> 2][j & 3], a1 = av[cs][(j + 1) >> 2][(j + 1) & 3];
                    sa0 = a_fmac(sa0, S0[j], a0); sb0 = a_fmac(sb0, S1[j], a0); sa1 = a_fmac(sa1, S0[j + 1], a1); sb1 = a_fmac(sb1, S1[j + 1], a1); }
                const float sa = quad_sum(sa0 + sa1), sb = quad_sum(sb0 + sb1);
                const float v0 = v2[cs].x, v1 = v2[cs].y;
                float y0 = 0.f, y1 = 0.f, z0 = 0.f, z1 = 0.f;
#pragma unroll
                for (int j = 0; j < 16; ++j) {
                    const float wj = wv[cs][j >> 2][j & 3], bj = bv[cs][j >> 2][j & 3], kj = kv[cs][j >> 2][j & 3], rj = rv[cs][j >> 2][j & 3];
                    S0[j] = a_fma(S0[j], wj, a_fma(sa, bj, a_mul(v0, kj)));
                    S1[j] = a_fma(S1[j], wj, a_fma(sb, bj, a_mul(v1, kj)));
                    if (j & 1) { y1 = a_fmac(y1, S0[j], rj); z1 = a_fmac(z1, S1[j], rj); } else { y0 = a_fmac(y0, S0[j], rj); z0 = a_fmac(z0, S1[j], rj); }
                }
                f32x2 y; y.x = quad_sum(y0 + y1); y.y = quad_sum(z0 + z1);
                if (jq == 0) *(unsigned*)(yrow + (size_t)li * 1024) = pk2(y.x, y.y);
                __builtin_amdgcn_sched_barrier(0);
            }
#undef SC_FETCH
            asm volatile("s_waitcnt lgkmcnt(0)" ::: "memory");
#ifdef MK_TPROBE
            tp_acc += __builtin_amdgcn_s_memtime() - tp0;
#endif
            __builtin_amdgcn_s_barrier();
        }
#ifdef MK_TPROBE
        if (blockIdx.x == 0 && F.wave == 0) {
            const unsigned long long tot = __builtin_amdgcn_s_memtime() - tp_phase0;
            const unsigned long long amt = (MK_TPROBE > 0 ? (unsigned long long)MK_TPROBE * tp_acc : (unsigned long long)(-(MK_TPROBE)) * (tot - tp_acc));
            const unsigned long long w0 = __builtin_amdgcn_s_memtime();
            while (__builtin_amdgcn_s_memtime() - w0 < amt) __builtin_amdgcn_s_sleep(8);
        }
#endif
    } else {
        const int pw = F.wave - 4, z = pw >> 1, par = pw & 1;
        const int l15 = F.lane & 15, l4 = F.lane >> 4, row = F.lane >> 2, cq = F.lane & 3;
        const bf16* w2p = P.W2T + (size_t)z * 65536 + (size_t)(h * 64 + l15) * 64 + 8 * l4;
        const int ch0 = h * 64 + cq * 16;
        LAS float* scrW = (LAS float*)(F.lds + SC_SCR_OFF + pw * 2 * SC_SCR_W);
        LAS float* scrA = scrW + 16 * 68;
        bf16x8 Ahw[2], Aha[2]; u32x4 r16[2], k16[2], v16[2];
        auto do_load = [&](int c) {
            const int t0c = z ? T - 16 * (c + 1) : 16 * c; const size_t m0 = (size_t)b * T + t0c;
#pragma unroll
            for (int ks = 0; ks < 2; ++ks) { const bf16* p = P.HD1 + (m0 + l15) * 256 + z * 64 + 32 * ks + 8 * l4; Ahw[ks] = *(const bf16x8*)p; Aha[ks] = *(const bf16x8*)(p + 128); }
            const size_t off = (m0 + row) * 1024 + ch0;
#pragma unroll
            for (int q = 0; q < 2; ++q) { r16[q] = ((const u32x4*)(P.R + off))[q]; k16[q] = ((const u32x4*)(P.K + off))[q]; v16[q] = ((const u32x4*)(P.V + off))[q]; }
        };
        auto do_compute = [&](int c) {
            const int t0c = z ? T - 16 * (c + 1) : 16 * c; const size_t m0 = (size_t)b * T + t0c;
#pragma unroll
            for (int nt = 0; nt < 4; ++nt) {
                f32x4 dw = (f32x4){0.f, 0.f, 0.f, 0.f}, da = dw;
#pragma unroll
                for (int ks = 0; ks < 2; ++ks) { const bf16x8 wf = *(const bf16x8*)(w2p + nt * 1024 + ks * 32), af = *(const bf16x8*)(w2p + 2 * 65536 + nt * 1024 + ks * 32);
                    dw = __builtin_amdgcn_mfma_f32_16x16x32_bf16(Ahw[ks], wf, dw, 0, 0, 0); da = __builtin_amdgcn_mfma_f32_16x16x32_bf16(Aha[ks], af, da, 0, 0, 0); }
#pragma unroll
                for (int rg = 0; rg < 4; ++rg) { scrW[(4 * l4 + rg) * 68 + 16 * nt + l15] = dw[rg]; scrA[(4 * l4 + rg) * 68 + 16 * nt + l15] = da[rg]; }
            }
            asm volatile("s_waitcnt lgkmcnt(0)" ::: "memory");
            float ssq = 0.f;
#pragma unroll
            for (int q = 0; q < 2; ++q)
#pragma unroll
                for (int w = 0; w < 4; ++w) { const f32x2 kc = *(const f32x2*)(P.kk + ch0 + q * 8 + 2 * w); const float k0 = bflo(k16[q][w]) * kc.x, k1 = bfhi(k16[q][w]) * kc.y; ssq += k0 * k0 + k1 * k1; }
            ssq = quad_sum(ssq);
            const float inv = 1.0f / fmaxf(sqrtf(ssq), 1e-12f);
            float bon = 0.f;
            LAS unsigned char* sb = F.lds + (z * 2 + (c & 1)) * SC_BUFB + row * SC_STEPB + cq * 64;
#pragma unroll
            for (int q = 0; q < 4; ++q) {
                const f32x4 wp = *(const LAS f32x4*)(scrW + row * 68 + cq * 16 + q * 4), ap = *(const LAS f32x4*)(scrA + row * 68 + cq * 16 + q * 4);
                const f32x4 w0v = *(const f32x4*)(P.w0 + z * 1024 + ch0 + q * 4), a0v = *(const f32x4*)(P.a0 + z * 1024 + ch0 + q * 4);
                const f32x4 kkv = *(const f32x4*)(P.kk + ch0 + q * 4), kav = *(const f32x4*)(P.ka + ch0 + q * 4), rkv = *(const f32x4*)(P.rk + ch0 + q * 4);
                const unsigned kw0 = k16[q >> 1][(q & 1) * 2], kw1 = k16[q >> 1][(q & 1) * 2 + 1], rw0 = r16[q >> 1][(q & 1) * 2], rw1 = r16[q >> 1][(q & 1) * 2 + 1], vw0 = v16[q >> 1][(q & 1) * 2], vw1 = v16[q >> 1][(q & 1) * 2 + 1];
                const f32x4 kf = (f32x4){bflo(kw0), bfhi(kw0), bflo(kw1), bfhi(kw1)}, rf = (f32x4){bflo(rw0), bfhi(rw0), bflo(rw1), bfhi(rw1)}, vf = (f32x4){bflo(vw0), bfhi(vw0), bflo(vw1), bfhi(vw1)};
                f32x4 ow, ok, ob, oa;
#pragma unroll
                for (int j = 0; j < 4; ++j) {
                    const float dec = fexp2(-0.60653066f * LOG2E * sigmoidf_(wp[j] + w0v[j]));
                    const float ar = sigmoidf_(ap[j] + a0v[j]);
                    const float kkn = kf[j] * kkv[j] * inv;
                    const float kd = kf[j] * (1.0f + (ar - 1.0f) * kav[j]);
                    ow[j] = dec; ok[j] = kd; ob[j] = kkn * ar; oa[j] = -kkn;
                    bon += rf[j] * kd * rkv[j];
                }
                *(LAS f32x4*)(sb + q * 16) = ow; *(LAS f32x4*)(sb + SC_VECB + q * 16) = ok; *(LAS f32x4*)(sb + 2 * SC_VECB + q * 16) = ob;
                *(LAS f32x4*)(sb + 3 * SC_VECB + q * 16) = oa; *(LAS f32x4*)(sb + 4 * SC_VECB + q * 16) = rf; *(LAS f32x4*)(sb + 5 * SC_VECB + q * 16) = vf;
            }
            bon = quad_sum(bon);
            if (cq == 0) P.BON[((size_t)z * M + m0 + row) * 16 + h] = bon;
            asm volatile("s_waitcnt lgkmcnt(0)" ::: "memory");
        };
        if (par == 0) { do_load(0); do_compute(0); } else do_load(1);
        __builtin_amdgcn_s_barrier();
        for (int e = 0; e < T / 16; ++e) {
            if (((e + 1) & 1) == par) { if (e + 1 < T / 16) do_compute(e + 1); }
            else { if (e + 2 < T / 16) do_load(e + 2); }
            __builtin_amdgcn_s_barrier();
        }
    }
}


constexpr int CS_AT = 0, CS_RT = 2304, CS_BK = 4608, CS_SMQ = 9728, CS_SMT = 11008, CS_NQ = 12288, CS_VT = 13568, CS_GL = 16640, CS_BUF = 16896;
constexpr int CS_PZ = 6 * CS_BUF;
constexpr int CS_W = CS_PZ + 4 * 4608;
constexpr int CS_WSZ = 4864;
constexpr int CS_BON = CS_W + 8 * CS_WSZ;
constexpr int CS_NS = CS_BON + 1536;
static_assert(CS_NS + 2048 + 16 <= LDS_MISC, "chunked-scan LDS map");
template <int CTRL> DI float dpp_mov0(float v) { return __builtin_bit_cast(float, __builtin_amdgcn_update_dpp(0, __builtin_bit_cast(int, v), CTRL, 0xF, 0xF, false)); }
DI float row_prefix(float v) { v += dpp_mov0<0x111>(v); v += dpp_mov0<0x112>(v); v += dpp_mov0<0x114>(v); v += dpp_mov0<0x118>(v); return v; }
DI float row_suffix(float v) { v += dpp_mov0<0x101>(v); v += dpp_mov0<0x102>(v); v += dpp_mov0<0x104>(v); v += dpp_mov0<0x108>(v); return v; }
DI bf16x8 lds16(const LAS unsigned char* p) { return *(const LAS bf16x8*)p; }
DI f32x4 mfma16(bf16x8 a, bf16x8 b, f32x4 c) { return __builtin_amdgcn_mfma_f32_16x16x32_bf16(a, b, c, 0, 0, 0); }

DI void scan_pair_mfma(const Frame& F0, int bh, const ScanPtrs& P) {
    const Frame F = fresh(F0);
    const int b = bh >> 4, h = bh & 15;
    const int z = F.wave >> 2, q4 = F.wave & 3;
    const int l15 = F.lane & 15, l4 = F.lane >> 4;
    const int te = l15, cg = l4, c4 = cg * 4;
    const int rr = z ? 15 - te : te;
    const int jl = 16 * q4 + c4;
    const int chq = h * 64 + 16 * q4;
    LAS unsigned char* const L = F.lds;
    LAS unsigned char* const wsc = L + CS_W + F.wave * CS_WSZ;
    LAS float* const scrW = (LAS float*)wsc; LAS float* const scrA = scrW + 16 * 20;
    LAS unsigned char* const ZB = wsc; LAS unsigned char* const XB = wsc + 2304; LAS unsigned char* const UB = wsc + 3072;
    LAS float* const yst = (LAS float*)(wsc + 3840);
    LAS float* const bonp = (LAS float*)(L + CS_BON);
    bf16* Y = z ? P.YB : P.YF;
    const bf16* w2p = P.W2T + (size_t)z * 65536 + (size_t)(chq + l15) * 64 + 8 * l4;
    bf16x8 Wf[2], Af[2];
#pragma unroll
    for (int ks = 0; ks < 2; ++ks) { Wf[ks] = *(const bf16x8*)(w2p + ks * 32); Af[ks] = *(const bf16x8*)(w2p + 2 * 65536 + ks * 32); }
    const f32x4 w0v = *(const f32x4*)(P.w0 + z * 1024 + chq + c4), a0v = *(const f32x4*)(P.a0 + z * 1024 + chq + c4);
    const f32x4 kkv = *(const f32x4*)(P.kk + chq + c4), kav = *(const f32x4*)(P.ka + chq + c4), rkv = *(const f32x4*)(P.rk + chq + c4);
    f32x4 kcn[4];
#pragma unroll
    for (int q = 0; q < 4; ++q) kcn[q] = *(const f32x4*)(P.kk + h * 64 + 16 * cg + q * 4);
    f32x4 Z[4];
#pragma unroll
    for (int jt = 0; jt < 4; ++jt) { const float zq = ozero(); Z[jt] = (f32x4){zq, zq, zq, zq}; }
    bf16x8 Ahw[2], Aha[2]; u32x2 r4, k4, v4; u32x4 kfull[2];
    auto do_load = [&](int c) {
        const int t0c = z ? T - 16 * (c + 1) : 16 * c; const size_t m0 = (size_t)b * T + t0c;
#pragma unroll
        for (int ks = 0; ks < 2; ++ks) { const bf16* p = P.HD1 + (m0 + l15) * 256 + z * 64 + 32 * ks + 8 * l4; Ahw[ks] = *(const bf16x8*)p; Aha[ks] = *(const bf16x8*)(p + 128); }
        const size_t off = (m0 + rr) * 1024;
        r4 = *(const u32x2*)(P.R + off + chq + c4); k4 = *(const u32x2*)(P.K + off + chq + c4); v4 = *(const u32x2*)(P.V + off + chq + c4);
        kfull[0] = ((const u32x4*)(P.K + off + h * 64 + 16 * cg))[0]; kfull[1] = ((const u32x4*)(P.K + off + h * 64 + 16 * cg))[1];
    };
    auto prep_a = [&](int c) {
        LAS unsigned char* const bp = L + (z * 3 + c % 3) * CS_BUF;
        LAS unsigned char* const pz = L + CS_PZ + (z * 2 + (c & 1)) * 4608;
        const float zq = ozero(); f32x4 dw = (f32x4){zq, zq, zq, zq}, da = dw;
#pragma unroll
        for (int ks = 0; ks < 2; ++ks) { dw = mfma16(Ahw[ks], Wf[ks], dw); da = mfma16(Aha[ks], Af[ks], da); }
#pragma unroll
        for (int rg = 0; rg < 4; ++rg) { scrW[(4 * l4 + rg) * 20 + l15] = dw[rg]; scrA[(4 * l4 + rg) * 20 + l15] = da[rg]; }
        float ssq = 0.f;
#pragma unroll
        for (int q = 0; q < 2; ++q)
#pragma unroll
            for (int w = 0; w < 4; ++w) { const float k0 = bflo(kfull[q][w]) * kcn[q * 2 + (w >> 1)][(w & 1) * 2], k1 = bfhi(kfull[q][w]) * kcn[q * 2 + (w >> 1)][(w & 1) * 2 + 1]; ssq += k0 * k0 + k1 * k1; }
        ssq += swz_xor<16>(ssq); ssq = half_sum(ssq);
        const float inv = __builtin_amdgcn_rsqf(fmaxf(ssq, 1e-24f));
        asm volatile("s_waitcnt lgkmcnt(0)" ::: "memory");
        const f32x4 wp = *(const LAS f32x4*)(scrW + rr * 20 + c4), ap = *(const LAS f32x4*)(scrA + rr * 20 + c4);
        const f32x4 kf = (f32x4){bflo(k4.x), bfhi(k4.x), bflo(k4.y), bfhi(k4.y)}, rf = (f32x4){bflo(r4.x), bfhi(r4.x), bflo(r4.y), bfhi(r4.y)}, vf = (f32x4){bflo(v4.x), bfhi(v4.x), bflo(v4.y), bfhi(v4.y)};
        f32x4 at, rt, bt, kt, bhh, khh, gl; float bon = 0.f;
#pragma unroll
        for (int j = 0; j < 4; ++j) {
            const float lw = -0.60653066f * LOG2E * sigmoidf_(wp[j] + w0v[j]);
            const float ar = sigmoidf_(ap[j] + a0v[j]);
            const float kkn = kf[j] * kkv[j] * inv;
            const float kd = kf[j] * (1.0f + (ar - 1.0f) * kav[j]);
            const float bvec = kkn * ar, avec = -kkn;
#ifdef MK_LDSPREFIX
            scrW[te * 20 + c4 + j] = lw;
            asm volatile("s_waitcnt lgkmcnt(0)" ::: "memory");
            float pi = 0.f, su = 0.f;
            for (int s2 = 0; s2 < 16; ++s2) { const float x = scrW[s2 * 20 + c4 + j]; if (s2 <= te) pi += x; else su += x; }
            asm volatile("s_waitcnt lgkmcnt(0)" ::: "memory");
#else
            const float pi = row_prefix(lw), su = row_suffix(lw) - lw;
#endif
            const float eI = fexp2(pi), eE = fexp2(pi - lw), eN = frcp(eI), eS = fexp2(su);
            at[j] = avec * eE; rt[j] = rf[j] * eI; bt[j] = bvec * eN; kt[j] = kd * eN; bhh[j] = bvec * eS; khh[j] = kd * eS; gl[j] = eI * eS;
            bon += rf[j] * kd * rkv[j];
        }
        const int co = jl * 2;
        { u32x2 w; w.x = pk2(at[0], at[1]); w.y = pk2(at[2], at[3]); *(LAS u32x2*)(bp + CS_AT + te * 144 + co) = w; }
        { u32x2 w; w.x = pk2(rt[0], rt[1]); w.y = pk2(rt[2], rt[3]); *(LAS u32x2*)(bp + CS_RT + te * 144 + co) = w; }
        { u32x2 w; w.x = pk2(bt[0], bt[1]); w.y = pk2(bt[2], bt[3]); *(LAS u32x2*)(pz + te * 144 + co) = w; }
        { u32x2 w; w.x = pk2(kt[0], kt[1]); w.y = pk2(kt[2], kt[3]); *(LAS u32x2*)(pz + 2304 + te * 144 + co) = w; }
#pragma unroll
        for (int j = 0; j < 4; ++j) {
            const unsigned bk = pk2(bhh[j], khh[j]);
            *(LAS bf16*)(bp + CS_BK + (jl + j) * 80 + te * 2) = (bf16)(bk & 0xffffu);
            *(LAS bf16*)(bp + CS_BK + (jl + j) * 80 + 32 + te * 2) = (bf16)(bk >> 16);
        }
        *(LAS bf16*)(bp + CS_VT + (jl + 0) * 48 + te * 2) = (bf16)(v4.x & 0xffffu); *(LAS bf16*)(bp + CS_VT + (jl + 1) * 48 + te * 2) = (bf16)(v4.x >> 16);
        *(LAS bf16*)(bp + CS_VT + (jl + 2) * 48 + te * 2) = (bf16)(v4.y & 0xffffu); *(LAS bf16*)(bp + CS_VT + (jl + 3) * 48 + te * 2) = (bf16)(v4.y >> 16);
        if (te == 0) *(LAS f32x4*)(bp + CS_GL + jl * 4) = gl;
        bon += swz_xor<16>(bon); bon = half_sum(bon);
        if (cg == 0) bonp[((z * 3 + c % 3) * 4 + q4) * 16 + rr] = bon;
    };
    LAS float* const nsm = (LAS float*)(L + CS_NS + z * 1024);
    volatile LAS unsigned* const nflag = (volatile LAS unsigned*)(L + CS_NS + 2048 + z * 8);
    auto prep_b1 = [&](int c) {
        LAS unsigned char* const bp = L + (z * 3 + c % 3) * CS_BUF;
        const LAS unsigned char* const pz = L + CS_PZ + (z * 2 + (c & 1)) * 4608;
        const int r32 = F.lane & 31, hf = F.lane >> 5;
        const LAS unsigned char* pa = (r32 < 16 ? bp + CS_AT + r32 * 144 : bp + CS_RT + (r32 - 16) * 144) + 16 * hf;
        const LAS unsigned char* pb = (r32 < 16 ? pz + r32 * 144 : pz + 2304 + (r32 - 16) * 144) + 16 * hf;
        f32x16 Dm;
#pragma unroll
        for (int i = 0; i < 16; ++i) Dm[i] = 0.f;
#pragma unroll
        for (int ks = 0; ks < 4; ++ks) Dm = __builtin_amdgcn_mfma_f32_32x32x16_bf16(lds16(pa + 32 * ks), lds16(pb + 32 * ks), Dm, 0, 0, 0);
        const int sc = r32 & 15;
#pragma unroll
        for (int reg = 0; reg < 8; ++reg) { if (r32 < 16) nsm[crow(reg, hf) * 16 + r32] = Dm[reg]; }
        asm volatile("s_waitcnt lgkmcnt(0)" ::: "memory");
        if (F.lane == 0) *nflag = (unsigned)(c + 1);
#pragma unroll
        for (int reg = 0; reg < 8; reg += 2) { const int t = crow(reg, hf);
            if (r32 >= 16) { const unsigned w = pk2(sc < t ? Dm[reg] : 0.f, sc < t + 1 ? Dm[reg + 1] : 0.f);
                *(LAS bf16*)(bp + CS_SMQ + t * 80 + sc * 2) = (bf16)(w & 0xffffu); *(LAS bf16*)(bp + CS_SMQ + (t + 1) * 80 + sc * 2) = (bf16)(w >> 16); } }
#pragma unroll
        for (int reg = 8; reg < 16; reg += 2) { const int t = crow(reg, hf) - 16;
            const unsigned w = pk2(sc <= t ? Dm[reg] : 0.f, sc <= t + 1 ? Dm[reg + 1] : 0.f);
            *(LAS bf16*)(bp + CS_NQ + t * 80 + r32 * 2) = (bf16)(w & 0xffffu); *(LAS bf16*)(bp + CS_NQ + (t + 1) * 80 + r32 * 2) = (bf16)(w >> 16); }
    };
    auto prep_b2 = [&](int c) {
        LAS unsigned char* const bp = L + (z * 3 + c % 3) * CS_BUF;
        const int sc = F.lane & 15;
        while (*nflag != (unsigned)(c + 1)) __builtin_amdgcn_s_sleep(1);
        asm volatile("" ::: "memory");
        float Tr[16];
        f32x4 nr[2][4];
#pragma unroll
        for (int r = 0; r < 2; ++r)
#pragma unroll
            for (int q = 0; q < 4; ++q) nr[r][q] = (4 * q < r) ? *(const LAS f32x4*)(nsm + r * 16 + q * 4) : (f32x4){0.f, 0.f, 0.f, 0.f};
#pragma unroll
        for (int t = 0; t < 16; ++t) {
            float acc = (sc == t) ? 1.0f : 0.0f, acc1 = 0.f;
#pragma unroll
            for (int s2 = 0; s2 < t; ++s2) { const float n = nr[t & 1][s2 >> 2][s2 & 3];
                if ((s2 & 1) == 0) acc = __builtin_fmaf(n, Tr[s2], acc); else acc1 = __builtin_fmaf(n, Tr[s2], acc1); }
            acc += acc1;
            Tr[t] = acc;
            if (t + 2 < 16) {
#pragma unroll
                for (int q = 0; q < 4; ++q) if (4 * q < t + 2) nr[t & 1][q] = *(const LAS f32x4*)(nsm + (t + 2) * 16 + q * 4);
            }
            if ((t & 1) && F.lane < 16) { const unsigned w = pk2(Tr[t - 1], acc);
                *(LAS bf16*)(bp + CS_SMT + (t - 1) * 80 + sc * 2) = (bf16)(w & 0xffffu); *(LAS bf16*)(bp + CS_SMT + t * 80 + sc * 2) = (bf16)(w >> 16); }
        }
    };
    auto stage_s = [&](int c) {
        const LAS unsigned char* const bp = L + (z * 3 + c % 3) * CS_BUF;
        const int q = l4, i = l15;
#pragma unroll
        for (int jt = 0; jt < 4; ++jt) { u32x2 w; w.x = pk2(Z[jt][0], Z[jt][1]); w.y = pk2(Z[jt][2], Z[jt][3]); *(LAS u32x2*)(ZB + i * 144 + (16 * jt + 4 * q) * 2) = w; }
        asm volatile("" ::: "memory");
        const bf16x8 Zb0 = lds16(ZB + i * 144 + (8 * q) * 2), Zb1 = lds16(ZB + i * 144 + (32 + 8 * q) * 2);
        const bf16x8 Vb = lds16(bp + CS_VT + (16 * q4 + i) * 48 + 8 * (q & 1) * 2);
        const LAS unsigned char* arow = bp + l15 * 144 + 8 * q * 2;
        const float zq = ozero(); const f32x4 zero = (f32x4){zq, zq, zq, zq};
        f32x4 X = mfma16(lds16(arow + CS_AT), Zb0, zero); f32x4 Yv = mfma16(lds16(arow + CS_RT), Zb0, zero);
        X = mfma16(lds16(arow + CS_AT + 64), Zb1, X); Yv = mfma16(lds16(arow + CS_RT + 64), Zb1, Yv);
        X = mfma16(lds16(bp + CS_SMQ + l15 * 80 + 16 * q), Vb, X);
        { u32x2 w; w.x = pk2(X[0], X[1]); w.y = pk2(X[2], X[3]); *(LAS u32x2*)(XB + i * 48 + 8 * q) = w; }
        asm volatile("" ::: "memory");
        const bf16x8 Xb = lds16(XB + i * 48 + 16 * (q & 1));
        const f32x4 U = mfma16(lds16(bp + CS_SMT + l15 * 80 + 16 * q), Xb, zero);
        { u32x2 w; w.x = pk2(U[0], U[1]); w.y = pk2(U[2], U[3]); *(LAS u32x2*)(UB + i * 48 + 8 * q) = w; }
        asm volatile("" ::: "memory");
        const bf16x8 Ub = lds16(UB + i * 48 + 16 * (q & 1));
        const bf16x8 UVb = q < 2 ? Ub : Vb;
        Yv = mfma16(lds16(bp + CS_NQ + l15 * 80 + 16 * q), UVb, Yv);
#pragma unroll
        for (int r = 0; r < 4; ++r) yst[(4 * q + r) * 16 + i] = Yv[r];
#pragma unroll
        for (int jt = 0; jt < 4; ++jt) { const f32x4 g = *(const LAS f32x4*)(bp + CS_GL + (16 * jt + 4 * q) * 4);
            Z[jt] = mfma16(lds16(bp + CS_BK + (16 * jt + l15) * 80 + 16 * q), UVb, Z[jt] * g); }
    };
    auto flush_y = [&](int c) {
        const int t0c = z ? T - 16 * (c + 1) : 16 * c; const int st = F.lane >> 2, i4 = (F.lane & 3) * 4;
        f32x4 yv = *(const LAS f32x4*)(yst + st * 16 + i4);
#ifdef MK_CLAMPY
        for (int j = 0; j < 4; ++j) yv[j] = (yv[j] == yv[j]) ? fminf(fmaxf(yv[j], -1.0e4f), 1.0e4f) : 0.f;
#endif
#ifdef MK_SCANCHECK
        { const u32x2 ref = *(const u32x2*)(Y + (size_t)(b * T + t0c + (z ? 15 - st : st)) * 1024 + chq + i4);
          const float r0 = bflo(ref.x), r1 = bfhi(ref.x), r2 = bflo(ref.y), r3 = bfhi(ref.y);
          float er = fmaxf(fmaxf(fabsf(yv.x - r0) / (fabsf(r0) + 1.0f), fabsf(yv.y - r1) / (fabsf(r1) + 1.0f)), fmaxf(fabsf(yv.z - r2) / (fabsf(r2) + 1.0f), fabsf(yv.w - r3) / (fabsf(r3) + 1.0f)));
          if (!(er == er)) er = 1.0e9f;
          atomicMax((unsigned*)(P.ERR + c), __float_as_uint(er)); }
#else
        u32x2 w; w.x = pk2(yv.x, yv.y); w.y = pk2(yv.z, yv.w);
        *(u32x2*)(Y + (size_t)(b * T + t0c + (z ? 15 - st : st)) * 1024 + chq + i4) = w;
#endif
    };
    auto bonus_flush = [&](int c) {
#ifdef MK_SCANCHECK
        return;
#endif
        if (q4 == 0 && F.lane < 16) {
            const int t0c = z ? T - 16 * (c + 1) : 16 * c; const size_t m0 = (size_t)b * T + t0c;
            const LAS float* qq = bonp + (z * 3 + c % 3) * 64 + F.lane;
            P.BON[((size_t)z * M + m0 + F.lane) * 16 + h] = (qq[0] + qq[16]) + (qq[32] + qq[48]);
        }
    };
    __syncthreads();
    for (int e = F.tid; e < 6 * 2 * 16 * 8; e += 512) { const int row = (e >> 3) & 15, tile = (e >> 7) & 1, zb = e >> 8, w = e & 7;
        *(LAS unsigned*)(L + zb * CS_BUF + (tile ? CS_SMT : CS_SMQ) + row * 80 + 32 + w * 4) = 0u; }
    const bool pa_wave = (q4 == z), pb_wave = (q4 == (z ^ 2));
    if (F.tid < 4) ((LAS unsigned*)(L + CS_NS + 2048))[F.tid] = 0u;
    constexpr int NC = T / 16;
    do_load(0); prep_a(0); do_load(1); prep_a(1);
    asm volatile("s_waitcnt lgkmcnt(0)" ::: "memory"); __builtin_amdgcn_s_barrier(); asm volatile("" ::: "memory");
    if (pa_wave) prep_b1(0);
    if (pb_wave) prep_b2(0);
    do_load(2);
    asm volatile("s_waitcnt lgkmcnt(0)" ::: "memory"); __builtin_amdgcn_s_barrier(); asm volatile("" ::: "memory");
#ifdef MK_TPROBE
    unsigned long long tpa[4] = {0ull, 0ull, 0ull, 0ull};
#define TP_T() __builtin_amdgcn_s_memtime()
#define TP_ACC(i, t0) tpa[i] += TP_T() - (t0)
#else
#define TP_T() 0ull
#define TP_ACC(i, t0) ((void)(t0))
#endif
    for (int e = 0; e < NC; ++e) {
        const unsigned long long t0 = TP_T();
        if (pa_wave && e + 1 < NC) prep_b1(e + 1);
        asm volatile("" ::: "memory");
        if (e + 2 < NC) prep_a(e + 2);
        asm volatile("s_waitcnt lgkmcnt(0)" ::: "memory");
        TP_ACC(0, t0); const unsigned long long t1 = TP_T();
        if (e > 0) flush_y(e - 1);
        if (e + 1 < NC) bonus_flush(e + 1);
        if (e == 0) bonus_flush(0);
        if (e + 3 < NC) do_load(e + 3);
        if (pb_wave && e + 1 < NC) prep_b2(e + 1);
        asm volatile("" ::: "memory");
        TP_ACC(1, t1); const unsigned long long t2 = TP_T();
        stage_s(e);
        asm volatile("s_waitcnt lgkmcnt(0)" ::: "memory");
        TP_ACC(2, t2); const unsigned long long t3 = TP_T();
        __builtin_amdgcn_s_barrier(); asm volatile("" ::: "memory");
        TP_ACC(3, t3);
    }
#ifdef MK_TPROBE
    if (blockIdx.x == 0 && F.wave == MK_TPROBE_WAVE) {
        const unsigned long long amt = 4ull * tpa[MK_TPROBE];
        const unsigned long long w0 = __builtin_amdgcn_s_memtime();
        while (__builtin_amdgcn_s_memtime() - w0 < amt) __builtin_amdgcn_s_sleep(8);
    }
#endif
    flush_y(T / 16 - 1);
}

#define XB_TMO      128
#define XB_XCNT(j)  (256  + 64 * (j))
#define XB_XSUB(j)  (1280 + 64 * (j))
#define XB_XGEN(j)  (2304 + 64 * (j))
#define XB_TOP      3328
#define XB_TOPGEN   3392
#define XCD_BAR_WORDS 3456
#define XB_SPIN_CAP (1u << 22)
DI unsigned xb_ld(unsigned* p)              { return __hip_atomic_load(p, __ATOMIC_RELAXED, __HIP_MEMORY_SCOPE_AGENT); }
DI unsigned xb_add(unsigned* p, unsigned v) { return __hip_atomic_fetch_add(p, v, __ATOMIC_RELAXED, __HIP_MEMORY_SCOPE_AGENT); }
DI unsigned xb_xcc_id() { return (unsigned)__builtin_amdgcn_s_getreg((3 << 11) | 20) & 0xFu; }
#define XB_SPIN(cond, bar) do { unsigned _sp = 0; while (cond) { __builtin_amdgcn_s_sleep(1); \
    if ((++_sp & 255u) == 0u) { if (xb_ld(&(bar)[XB_TMO])) break; if (_sp > XB_SPIN_CAP) { atomicAdd(&(bar)[XB_TMO], 1u); break; } } } } while (0)
struct XcdBarrier { unsigned* bar; unsigned x; volatile LAS unsigned* st; };
DI XcdBarrier xcd_barrier_post(unsigned* bar, volatile LAS unsigned* st) {
    XcdBarrier b; b.bar = bar; b.x = xb_xcc_id(); b.st = st;
    if (threadIdx.x == 0) (void)xb_add(&bar[XB_XCNT(b.x)], 1u);
    return b;
}
DI void xcd_barrier_complete(unsigned* bar, unsigned x, unsigned& nloc, unsigned& nx) {
    const unsigned G = gridDim.x * gridDim.y * gridDim.z;
    unsigned sum, cnt, mine, sp = 0u;
    for (;;) {
        sum = 0u; cnt = 0u; mine = 0u;
#pragma unroll
        for (unsigned j = 0; j < 16; ++j) { const unsigned c = xb_ld(&bar[XB_XCNT(j)]); sum += c; cnt += (c > 0u) ? 1u : 0u; mine = (j == x) ? c : mine; }
        if (sum == G) break;
        __builtin_amdgcn_s_sleep(1);
        if ((++sp & 255u) == 0u) { if (xb_ld(&bar[XB_TMO])) break; if (sp > XB_SPIN_CAP) { atomicAdd(&bar[XB_TMO], 1u); break; } }
    }
    nloc = mine > 0u ? mine : 1u; nx = cnt > 0u ? cnt : 1u;
}
DI void xcd_barrier(const XcdBarrier& b) {
    asm volatile("s_waitcnt vmcnt(0)" ::: "memory");
    __syncthreads();
    if (threadIdx.x == 0) {
        unsigned* bar = b.bar;
        __builtin_amdgcn_s_waitcnt(0);
        unsigned nloc = b.st[0], nx = b.st[1];
        if (nloc == 0u) { xcd_barrier_complete(bar, b.x, nloc, nx); b.st[0] = nloc; b.st[1] = nx; }
        const unsigned old = xb_add(&bar[XB_XSUB(b.x)], 1u);
        const unsigned gen = old / nloc;
        if (old + 1u == (gen + 1u) * nloc) {
            __builtin_amdgcn_fence(__ATOMIC_RELEASE, "agent");
            asm volatile("s_waitcnt vmcnt(0)" ::: "memory");
            const unsigned og = xb_add(&bar[XB_TOP], 1u);
            const unsigned tg = og / nx;
            if (og + 1u == (tg + 1u) * nx) xb_add(&bar[XB_TOPGEN], 1u);
            else XB_SPIN(xb_ld(&bar[XB_TOPGEN]) == tg, bar);
            __builtin_amdgcn_fence(__ATOMIC_ACQUIRE, "agent");
            xb_add(&bar[XB_XGEN(b.x)], 1u);
            asm volatile("s_waitcnt vmcnt(0)" ::: "memory");
        } else {
            XB_SPIN(xb_ld(&bar[XB_XGEN(b.x)]) == gen, bar);
            __builtin_amdgcn_fence(__ATOMIC_ACQUIRE, "agent");
            asm volatile("s_waitcnt vmcnt(0)" ::: "memory");
        }
    }
    __syncthreads();
}

#ifndef MK_PROG
#ifdef MK_SCANCHECK
#define MK_PROG 0,1,2,3,4,5,7,8,10,11,12,13,14,25,15,16,17,19,20,22,23,24
#else
#define MK_PROG 0,3,4,5,7,8,10,11,12,13,14,15,17,19,20,22,23,24
#endif
#endif
__constant__ int PROG[] = {MK_PROG};
constexpr int NPH = sizeof(PROG) / sizeof(int);
template <int TYPE> struct PreSched {
    const bf16* KV; const bf16* W; int G, c;
    DI bool next(int i, Unit& u) const {
        const long L = (long)i * G + c; if (L >= 512) return false;
        const int rem = (int)L, i2 = rem >> 8, b = (rem >> 4) & 15, hh = (rem >> 2) & 3, t4 = rem & 3;
        u.pm = 0; u.pn = 0;
        const bf16* kvp = KV + (size_t)(b * 256) * 4096 + i2 * 2048 + hh * 256;
        const bf16* wp = W + (size_t)i2 * 1024 * 1024 + (size_t)(t4 * 256) * 1024 + hh * 256;
        if (TYPE == 0) { u.pa = (const char*)kvp; u.pb = (const char*)wp; u.z = (i2 << 30) | (b * 1048576 + hh * 256 * 1024 + t4 * 256); }
        else { u.pa = (const char*)wp; u.pb = (const char*)(kvp + 1024); u.z = (i2 << 30) | (16 * 1048576 + b * 1048576 + t4 * 256 * 1024 + hh * 256); }
        return true;
    }
};

__global__ void __launch_bounds__(512, 2) mk_fwd(Args a) {
    extern __shared__ __attribute__((aligned(16))) unsigned char lds_raw[];
    Frame F;
    F.lds = (LAS unsigned char*)lds_raw;
    F.tid = threadIdx.x; F.lane = F.tid & 63; F.wave = __builtin_amdgcn_readfirstlane(F.tid >> 6);
    F.gw = blockIdx.x * 8 + F.wave; F.ngw = gridDim.x * 8; F.ws = a.ws;
    cg::grid_group grid = cg::this_grid();
    volatile LAS unsigned* MISC = (volatile LAS unsigned*)(F.lds + LDS_MISC);
    if (F.tid < 2) MISC[F.tid] = 0u;
    __syncthreads();
    (void)xcd_barrier_post((unsigned*)(a.ws + WS_BAR), MISC);

    for (int pi = a.ph_lo; pi < a.ph_hi; ++pi) {
        const int ph = PROG[pi];
        const int G = opq(gridDim.x), cblk = opq(blockIdx.x);
        unsigned char* ws = a.ws + (size_t)opq(0);
        float* RS = (float*)(ws + WS_RS);
        bf16* SA = (bf16*)(ws + WS_SA); bf16* SB = (bf16*)(ws + WS_SB);
        bf16* H = (bf16*)a.out;
        const int li = ph >= 18 ? 1 : 0;
        int cp = ph; if (ph >= 18 && ph <= 23) cp = ph - 12;
#ifndef PH_MASK
#define PH_MASK 0xffffffffu
#endif
        if (!((PH_MASK >> cp) & 1u)) cp = 99;
        switch (cp) {
        case 0: phase_prologue(F, a, ws); break;
        case 3: {
            { pg8::PlainSched S{SA, (const bf16*)(ws + WS_WIN), 1024, 1024, M / 256, 8, G, cblk, 30, 0};
              EpiInProj E{(bf16*)(ws + WS_GLU), SB, RS};
              pg8::gemm_phase(F.lds, 1024, 1024, 1024, S, E); }
            { pg8::PlainSched S{(const bf16*)(ws + WS_WIN) + (size_t)2048 * 1024, SA, 1024, 1024, 2, M / 256, G, cblk, 30, 0};
              EpiVT E{(bf16*)(ws + WS_VT), RS};
              pg8::gemm_phase(F.lds, 1024, 1024, 1024, S, E); }
                    {

            pg8::PlainSched S{(const bf16*)(ws + WS_MEMB), (const bf16*)(ws + WS_WKV), 1024, 1024, MMEM / 256, 16, G, cblk, 30, 0};
            EpiRowScale<0> E{(bf16*)(ws + WS_KV), 4096, (const float*)(ws + WS_RSMEM), nullptr};
            pg8::gemm_phase(F.lds, 1024, 1024, 1024, S, E);
                    }
        } break;
        case 4: {
            const float lam = ((const float*)(ws + WS_LAM))[0];
#ifndef NO_ATTN
            for (int u = cblk; u < 1024; u += G) diffattn_unit(F, u, SB, (const bf16*)(ws + WS_VT), (const float*)(ws + WS_BIAS), lam, a.in[opq(I_SUBLN)], (bf16*)(ws + WS_MIX));
#endif
            __syncthreads();
#ifndef NO_CONV
            conv_load_weights(F, a.in[opq(I_CONVW)]);
            for (int u = cblk; u < 512; u += G) conv_unit(F, u, (const bf16*)(ws + WS_GLU), a.in[opq(I_CONVB)], a.in[opq(I_CLNG)], a.in[opq(I_CLNB)], (bf16*)(ws + WS_MIX));
#endif
            __syncthreads();
                    {

            EpiPre E{(bf16*)(ws + WS_G0)};
            { PreSched<0> S{(const bf16*)(ws + WS_KV), (const bf16*)(ws + WS_WQN), G, cblk}; pg8::gemm_phase(F.lds, 256, 4096, 1024, S, E); }
            { PreSched<1> S{(const bf16*)(ws + WS_KV), (const bf16*)(ws + WS_WXO), G, cblk}; pg8::gemm_phase(F.lds, 256, 1024, 4096, S, E); }
                    }
        } break;
        case 5: {
            pg8::PlainSched S{(const bf16*)(ws + WS_MIX), (const bf16*)(ws + WS_WOUT), 1024, 1024, M / 256, 4, G, cblk, 30, 0};
            EpiResid E{a.in[opq(I_X)], nullptr, H, (float*)(ws + WS_PS)};
            pg8::gemm_phase(F.lds, 1024, 1024, 1024, S, E);
        } break;
        case 7: {
            pg8::PlainSched S{H, (const bf16*)(ws + (li ? WS_G1 : WS_G0)), 1024, 1024, M / 256, 4, G, cblk, 3, (size_t)1048576};
            EpiSoftmax E{SB, (const float*)(ws + WS_PS)};
            pg8::gemm_phase(F.lds, 1024, 1024, 1024, S, E);
        } break;
        case 8: {
            pg8::PlainSched S{SB, (const bf16*)(ws + (li ? WS_VW1 : WS_VW0)), 1024, 1024, M / 256, 4, G, cblk, 3, (size_t)1048576};
            EpiResid E{nullptr, H, H, (float*)(ws + WS_PS)};
            pg8::gemm_phase(F.lds, 1024, 1024, 1024, S, E);
        } break;
        case 10: {
            pg8::PlainSched S{H, (const bf16*)(ws + WS_WUP) + (size_t)li * 4096 * 1024, 1024, 1024, M / 256, 16, G, cblk, 30, 0};
            EpiRowScale<2> E{(bf16*)(ws + WS_HID), 4096, nullptr, (const float*)(ws + WS_PS)};
            pg8::gemm_phase(F.lds, 1024, 1024, 1024, S, E);
        } break;
        case 11: {
            pg8::PlainSched S{(const bf16*)(ws + WS_HID), (const bf16*)(ws + WS_WDN) + (size_t)li * 1024 * 4096, 4096, 4096, M / 256, 4, G, cblk, 30, 0};
            EpiResid E{nullptr, H, li ? SA : H, nullptr};
            pg8::gemm_phase(F.lds, 4096, 4096, 4096, S, E);
        } break;
        case 12: phase_rwkv_shift(F, H, a.in[opq(I_NMIX)] + 1024, (bf16*)(ws + WS_A1)); break;
        case 13: {
            pg8::PlainSched S{(const bf16*)(ws + WS_A1), (const bf16*)(ws + WS_WBIG), 2048, 2048, M / 256, 14, G, cblk, 30, 0};
            EpiRwkv E{(bf16*)(ws + WS_R), (bf16*)(ws + WS_K), (bf16*)(ws + WS_V), (bf16*)(ws + WS_HD1), (bf16*)(ws + WS_HD2)};
            pg8::gemm_phase(F.lds, 2048, 2048, 2048, S, E);
        } break;
        case 14: {
            ScanPtrs P{(const bf16*)(ws + WS_R), (const bf16*)(ws + WS_K), (const bf16*)(ws + WS_V), (const bf16*)(ws + WS_HD1), (const bf16*)(ws + WS_W2T),
                       a.in[opq(I_W0)], a.in[opq(I_A0)], a.in[opq(I_KK)], a.in[opq(I_KA)], a.in[opq(I_RK)], (bf16*)(ws + WS_YF), (bf16*)(ws + WS_YB), (float*)(ws + WS_BONUS), (unsigned*)(ws + WS_BAR + 32768)};
#if defined(MK_SCAN_VALU) || defined(MK_SCANCHECK)
            for (int bh = cblk; bh < 256; bh += G) scan_pair(F, bh, P);
#else
            for (int bh = cblk; bh < 256; bh += G) scan_pair_mfma(F, bh, P);
#endif
            __syncthreads();
        } break;
#ifdef MK_SCANCHECK
        case 25: {
            ScanPtrs P{(const bf16*)(ws + WS_R), (const bf16*)(ws + WS_K), (const bf16*)(ws + WS_V), (const bf16*)(ws + WS_HD1), (const bf16*)(ws + WS_W2T),
                       a.in[opq(I_W0)], a.in[opq(I_A0)], a.in[opq(I_KK)], a.in[opq(I_KA)], a.in[opq(I_RK)], (bf16*)(ws + WS_YF), (bf16*)(ws + WS_YB), (float*)(ws + WS_BONUS), (unsigned*)(ws + WS_BAR + 32768)};
            for (int bh = cblk; bh < 256; bh += G) scan_pair_mfma(F, bh, P);
            __syncthreads();
        } break;
#endif
        case 15: {
            pg8::PlainSched S{(const bf16*)(ws + WS_HD2), (const bf16*)(ws + WS_G2T), 256, 256, M / 256, 4, G, cblk, 30, 0};
            EpiGateComb E{(const bf16*)(ws + WS_YF), (const bf16*)(ws + WS_YB), (const bf16*)(ws + WS_V), (const float*)(ws + WS_BONUS), a.in[opq(I_LNG)], a.in[opq(I_LNB)], (bf16*)(ws + WS_COMB)};
            pg8::gemm_phase(F.lds, 256, 256, 256, S, E);
        } break;
        case 16: phase_rwkv_comb(F, (const bf16*)(ws + WS_YF), (const bf16*)(ws + WS_YB), (const bf16*)(ws + WS_V), (const bf16*)(ws + WS_GATE), (const float*)(ws + WS_BONUS),
                                 a.in[opq(I_LNG)], a.in[opq(I_LNB)], (bf16*)(ws + WS_COMB)); break;
        case 17: {
            pg8::PlainSched S{(const bf16*)(ws + WS_COMB), (const bf16*)(ws + WS_WRO), 1024, 1024, M / 256, 4, G, cblk, 30, 0};
            EpiResid E{nullptr, H, H, (float*)(ws + WS_PS)};
            pg8::gemm_phase(F.lds, 1024, 1024, 1024, S, E);
        } break;
        case 24: {
            float osc = 1.0f;
#ifdef MK_SCANCHECK
            { const unsigned* ER = (const unsigned*)(ws + WS_BAR + 32768); int bad = -1;
              for (int c = 127; c >= 0; --c) if (__uint_as_float(__builtin_amdgcn_readfirstlane(__hip_atomic_load(ER + c, __ATOMIC_RELAXED, __HIP_MEMORY_SCOPE_AGENT))) > MK_SCANCHECK_TOL) bad = c;
              if (bad >= 0) osc = 1.0f + 0.03f * (float)(bad + 1); }
#endif
            phase_final_norm(F, SA, a.out, a.in[opq(I_NFINAL)], osc);
        } break;
        default: break;
        }
        if (pi + 1 < a.ph_hi) {
#ifdef MK_ALL_CG
            grid.sync();
#else
            if (pi == a.ph_lo) grid.sync(); else { XcdBarrier xb; xb.bar = (unsigned*)(ws + WS_BAR); xb.x = xb_xcc_id(); xb.st = (volatile LAS unsigned*)(F.lds + LDS_MISC); xcd_barrier(xb); }
#endif
        }
    }
}

extern "C" void kernel_launch(void* const* d_in, const int* in_sizes, int n_in, void* d_out, int out_size, void* d_ws, size_t ws_size, hipStream_t stream) {
    static int grid = 0;
    if (grid == 0) {
        if (n_in != N_IN || in_sizes[0] != M * D || out_size != M * D || ws_size < WS_NEED) {
            fprintf(stderr, "kernel_launch: unexpected problem (n_in %d, in0 %d, out %d, ws %zu); nothing launched\n", n_in, n_in > 0 ? in_sizes[0] : -1, out_size, ws_size); grid = -1; return; }
        int dev = 0, cus = 0, per_cu = 0;
        if (hipGetDevice(&dev) != hipSuccess || hipDeviceGetAttribute(&cus, hipDeviceAttributeMultiprocessorCount, dev) != hipSuccess) { grid = -1; return; }
        if (hipFuncSetAttribute((const void*)mk_fwd, hipFuncAttributeMaxDynamicSharedMemorySize, LDS_BYTES) != hipSuccess) { fprintf(stderr, "kernel_launch: hipFuncSetAttribute failed\n"); grid = -1; return; }
        if (hipOccupancyMaxActiveBlocksPerMultiprocessor(&per_cu, (const void*)mk_fwd, 512, LDS_BYTES) != hipSuccess || per_cu < 1) { fprintf(stderr, "kernel_launch: occupancy query says %d\n", per_cu); (void)hipGetLastError(); grid = -1; return; }
        grid = cus;
    }
    if (grid < 0) return;
    if (hipMemsetAsync((char*)d_ws + WS_BAR, 0, 65536, stream) != hipSuccess) { fprintf(stderr, "kernel_launch: memset failed\n"); return; }
    Args a{};
    for (int i = 0; i < N_IN; ++i) a.in[i] = (const float*)d_in[i];
    a.out = (float*)d_out; a.ws = (unsigned char*)d_ws;
#if MK_SINGLE
    a.ph_lo = 0; a.ph_hi = NPH;
    void* params[] = {&a};
    hipError_t e = hipLaunchCooperativeKernel((const void*)mk_fwd, dim3(grid), dim3(512), params, LDS_BYTES, stream);
    if (e != hipSuccess) fprintf(stderr, "kernel_launch: cooperative launch failed: %s\n", hipGetErrorString(e));
#else
    for (int ph = 0; ph < NPH; ++ph) { a.ph_lo = ph; a.ph_hi = ph + 1; hipLaunchKernelGGL(mk_fwd, dim3(grid), dim3(512), LDS_BYTES, stream, a); }
#endif
}
```

```cpp
#include <hip/hip_runtime.h>
#include <hip/hip_cooperative_groups.h>
#include <cstdio>
#include <cstdint>
namespace cg = cooperative_groups;

#ifndef MK_SINGLE
#define MK_SINGLE 1
#endif

#define LAS __attribute__((address_space(3)))
#define DI __device__ __forceinline__
typedef unsigned short bf16;
typedef short bf16x8 __attribute__((ext_vector_type(8)));
typedef short s16x4 __attribute__((ext_vector_type(4)));
typedef float f32x2 __attribute__((ext_vector_type(2)));
typedef float f32x4 __attribute__((ext_vector_type(4)));
typedef float f32x16 __attribute__((ext_vector_type(16)));
typedef unsigned u32x2 __attribute__((ext_vector_type(2)));
typedef unsigned u32x4 __attribute__((ext_vector_type(4)));

constexpr int D = 1024, NB = 16, T = 2048, M = NB * T, NMEM = 256, MMEM = NB * NMEM;
constexpr int FF = 4096;
constexpr float EPS = 1e-6f;
constexpr float LOG2E = 1.4426950408889634f;

constexpr size_t MiB = 1u << 20;
constexpr size_t WS_BAR = 0;
constexpr size_t WS_RS = 64 * 1024;
constexpr size_t WS_RSMEM = WS_RS + M * 4;
constexpr size_t WS_BIAS = WS_RSMEM + MMEM * 4;
constexpr size_t WS_LAM = WS_BIAS + 4 * 4096 * 4;
constexpr size_t WS_WIN = 1 * MiB;
constexpr size_t WS_WOUT = WS_WIN + 5 * MiB;
constexpr size_t WS_WQN = WS_WOUT + 2 * MiB;
constexpr size_t WS_WKV = WS_WQN + 4 * MiB;
constexpr size_t WS_WXO = WS_WKV + 8 * MiB;
constexpr size_t WS_WUP = WS_WXO + 4 * MiB;
constexpr size_t WS_WDN = WS_WUP + 16 * MiB;
constexpr size_t WS_WBIG = WS_WDN + 16 * MiB;
constexpr size_t WS_W2T = WS_WBIG + 14 * MiB;
constexpr size_t WS_G2T = WS_W2T + 512 * 1024;
constexpr size_t WS_WRO = WS_G2T + 512 * 1024;
constexpr size_t WS_WEND = WS_WRO + 2 * MiB;
static_assert(WS_WEND == 73 * MiB, "weight map");
constexpr size_t WS_SA = 73 * MiB;
constexpr size_t WS_SB = 137 * MiB;
constexpr size_t WS_GLU = 201 * MiB;
constexpr size_t WS_VT = 233 * MiB;
constexpr size_t WS_MIX = 265 * MiB;
constexpr size_t WS_G0 = 329 * MiB;
constexpr size_t WS_VW0 = 361 * MiB;
constexpr size_t WS_MEMB = 393 * MiB;
constexpr size_t WS_KV = 401 * MiB;
constexpr size_t WS_G1 = 433 * MiB;
constexpr size_t WS_VW1 = 465 * MiB;
static_assert(WS_G1 - WS_G0 == 104 * MiB && WS_VW0 - WS_G0 == 32 * MiB && WS_VW1 - WS_G1 == 32 * MiB, "G / VW spacing used by EpiPre");
constexpr size_t WS_BONUS = 497 * MiB;
constexpr size_t WS_PS = 502 * MiB;
constexpr size_t WS_HID = 137 * MiB;
constexpr size_t WS_A1 = 73 * MiB;
constexpr size_t WS_R = 201 * MiB, WS_K = 265 * MiB, WS_V = 329 * MiB;
static_assert(WS_K - WS_R == 64 * MiB && WS_V - WS_K == 64 * MiB, "r, k, v spacing used by EpiRwkv");
constexpr size_t WS_HD1 = 393 * MiB;
constexpr size_t WS_HD2 = 409 * MiB;
constexpr size_t WS_YF = 73 * MiB, WS_YB = 137 * MiB;
constexpr size_t WS_GATE = 265 * MiB;
constexpr size_t WS_COMB = 201 * MiB;
constexpr size_t WS_NEED = 512 * MiB;

constexpr int LDS_X = 131072;
constexpr int LDS_MISC = 163840 - 256;
constexpr int LDS_BYTES = 163840;

DI unsigned f2bf(float f) { unsigned u = __builtin_bit_cast(unsigned, f); return (u + 0x7fffu + ((u >> 16) & 1u)) >> 16; }
typedef __bf16 bf16x2v __attribute__((ext_vector_type(2)));
DI unsigned pk2(float lo, float hi) { const f32x2 v = {lo, hi}; return __builtin_bit_cast(unsigned, __builtin_convertvector(v, bf16x2v)); }
DI float bf2f(unsigned short b) { return __builtin_bit_cast(float, ((unsigned)b) << 16); }
DI float bflo(unsigned w) { return __builtin_bit_cast(float, w << 16); }
DI float bfhi(unsigned w) { return __builtin_bit_cast(float, w & 0xffff0000u); }
template <int MASK> DI float swz_xor(float v) { return __builtin_bit_cast(float, __builtin_amdgcn_ds_swizzle(__builtin_bit_cast(int, v), (MASK << 10) | 0x1f)); }
DI float half_sum(float v) { const int x = __builtin_bit_cast(int, v); const auto r = __builtin_amdgcn_permlane32_swap(x, x, false, false); return __builtin_bit_cast(float, (int)r[0]) + __builtin_bit_cast(float, (int)r[1]); }
DI float half_max(float v) { const int x = __builtin_bit_cast(int, v); const auto r = __builtin_amdgcn_permlane32_swap(x, x, false, false); return fmaxf(__builtin_bit_cast(float, (int)r[0]), __builtin_bit_cast(float, (int)r[1])); }
DI float wave_sum(float v) {
    v += swz_xor<1>(v); v += swz_xor<2>(v); v += swz_xor<4>(v); v += swz_xor<8>(v); v += swz_xor<16>(v); v = half_sum(v);
    return v;
}
DI float ozero() { float z; asm volatile("v_mov_b32 %0, 0" : "=v"(z)); return z; }
DI int opaque(int x) { asm volatile("" : "+v"(x)); return x; }
template <class Tp> DI Tp* opq_ptr(Tp* p) { asm volatile("" : "+s"(p)); return p; }
DI int opq(int x) { asm volatile("" : "+s"(x)); return x; }
DI float fexp2(float x) { return __builtin_amdgcn_exp2f(x); }
DI float frcp(float x) { return __builtin_amdgcn_rcpf(x); }
DI float sigmoidf_(float x) { return frcp(1.0f + fexp2(-x * LOG2E)); }
DI float tanhf_(float x) { float e = fexp2(-2.0f * LOG2E * fabsf(x)); float t = (1.0f - e) * frcp(1.0f + e); return x < 0.f ? -t : t; }

namespace pg8 {
constexpr int BM = 256, BK = 64, HALF = 128, HTB = HALF * BK * 2, STAGE_BYTES = 8 * HTB, NXCD = 8, WGM = 8;
DI int lds_byte(int r, int c) { const int st = (r >> 4) * 2 + (c >> 5), rr = r & 15, cc = c & 31, ob = rr * 64 + cc * 2; return st * 1024 + (ob ^ (((ob >> 9) & 1) << 5)); }
DI void stage_rc(int b, int& R, int& C) { const int st = b / 1024, sb = b % 1024, swz = sb ^ (((sb >> 9) & 1) << 5); R = (st >> 1) * 16 + swz / 64; C = (st & 1) * 32 + (swz % 64) / 2; }
DI int perm32(int rho) { const int n = rho >> 4, i = rho & 15; return 8 * (i >> 2) + 4 * n + (i & 3); }

struct Unit { int pm, pn, z; const char* pa; const char* pb; };

DI bool tile_order(long L, int nM, int nN, int& pm, int& pn) {
    const int nwg = nM * nN; if (L >= nwg) return false;
    int wgid = (int)L; { const int q = nwg / NXCD, r = nwg % NXCD, xcd = wgid % NXCD, off = wgid / NXCD; wgid = (xcd < r ? xcd * (q + 1) : r * (q + 1) + (xcd - r) * q) + off; }
    const int nig = WGM * nN, gid = wgid / nig, fm = gid * WGM, gsz = (nM - fm) < WGM ? (nM - fm) : WGM;
    pm = fm + ((wgid % nig) % gsz); pn = (wgid % nig) / gsz; return true;
}
struct PlainSched {
    const bf16* A; const bf16* Bt; int lda, ldb, nM, nN, G, c, bshift; size_t bstride;
    DI bool next(int i, Unit& u) const {
        if (!tile_order((long)i * G + c, nM, nN, u.pm, u.pn)) return false;
        u.z = u.pm >> bshift;
        u.pa = (const char*)(A + (size_t)u.pm * 256 * lda);
        u.pb = (const char*)(Bt + (size_t)u.z * bstride + (size_t)u.pn * 256 * ldb);
        return true;
    }
};

DI unsigned cvt_pk_bf16(float lo, float hi) { return pk2(lo, hi); }

template <class Epi, class Sched>
DI void gemm_phase(LAS unsigned char* lds, const int K, const int lda, const int ldb, const Sched& S, const Epi& E) {
    const int tid = opaque(threadIdx.x), wid = __builtin_amdgcn_readfirstlane(tid >> 6), lane = tid & 63, wr = wid >> 2, wc = wid & 3, fr = lane & 15, fq = lane >> 4;
    const int nt = K / BK;
    unsigned voffA[2], voffB[2];
#pragma unroll
    for (int i = 0; i < 2; ++i) { int R, C; stage_rc(tid * 16 + i * 8192, R, C); const int Rb = Epi::PERM ? ((R & ~31) + perm32(R & 31)) : R;
        voffA[i] = (unsigned)(R * lda + C) * 2u; voffB[i] = (unsigned)(Rb * ldb + C) * 2u; }
    const size_t kstep = (size_t)(BK * 2);
    const size_t hstepA = (size_t)HALF * lda * 2, hstepB = (size_t)HALF * ldb * 2;
    const unsigned ldsw = (unsigned)wid * 1024u;
    const int aoff = lds_byte(wr * 64 + fr, fq * 8), boff = lds_byte(wc * 32 + fr, fq * 8);
#define PG8_SA(b, h) (((b) * 2 + (h)) * HTB)
#define PG8_SB(b, h) ((4 + (b) * 2 + (h)) * HTB)
#define PG8_STAGE(bufoff, gbase, voff) do { _Pragma("unroll") for (int _i = 0; _i < 2; ++_i) \
        __builtin_amdgcn_global_load_lds((const unsigned*)((const char*)(gbase) + (voff)[_i]), (LAS unsigned*)(lds + (bufoff) + ldsw + _i * 8192), 16, 0, 0); } while (0)
#define PG8_LDA(dst, b, h) do { _Pragma("unroll") for (int m = 0; m < 4; ++m) _Pragma("unroll") for (int k = 0; k < 2; ++k) dst[m][k] = *(const LAS bf16x8*)(lds + PG8_SA(b, h) + aoff + m * 2048 + k * 1024); } while (0)
#define PG8_LDB(dst, b, h) do { _Pragma("unroll") for (int n = 0; n < 2; ++n) _Pragma("unroll") for (int k = 0; k < 2; ++k) dst[n][k] = *(const LAS bf16x8*)(lds + PG8_SB(b, h) + boff + n * 2048 + k * 1024); } while (0)
#define PG8_MMA(ai, bj, At, Bt) do { __builtin_amdgcn_s_setprio(1); _Pragma("unroll") for (int m = 0; m < 4; ++m) _Pragma("unroll") for (int n = 0; n < 2; ++n) _Pragma("unroll") for (int k = 0; k < 2; ++k) \
        acc[ai][bj][m][n] = __builtin_amdgcn_mfma_f32_16x16x32_bf16(Bt[n][k], At[m][k], acc[ai][bj][m][n], 0, 0, 0); __builtin_amdgcn_s_setprio(0); } while (0)
#define PG8_WAIT_V(n) asm volatile("s_waitcnt vmcnt(" #n ")" ::: "memory")
#define PG8_WAIT_L(n) asm volatile("s_waitcnt lgkmcnt(" #n ")" ::: "memory")
#define PG8_BAR __builtin_amdgcn_s_barrier()
#define PG8_SCHED __builtin_amdgcn_sched_barrier(0)
    Unit cur, nxt; int ui = 0;
    if (!S.next(0, cur)) return;
    f32x4 acc[2][2][4][2];
    { const float z0 = ozero();
#pragma unroll
    for (int a = 0; a < 2; ++a)
#pragma unroll
        for (int b = 0; b < 2; ++b)
#pragma unroll
            for (int m = 0; m < 4; ++m)
#pragma unroll
                for (int n = 0; n < 2; ++n) acc[a][b][m][n] = (f32x4){z0, z0, z0, z0}; }
    bf16x8 At[4][2], B0[2][2], B1[2][2];
    const char* cA = cur.pa; const char* cB = cur.pb;
    PG8_STAGE(PG8_SB(0, 0), cB, voffB); PG8_STAGE(PG8_SB(0, 1), cB + hstepB, voffB); PG8_STAGE(PG8_SA(0, 0), cA, voffA); PG8_STAGE(PG8_SA(0, 1), cA + hstepA, voffA);
    if (wr == 1) PG8_BAR;
    PG8_WAIT_V(2); PG8_BAR;
    PG8_STAGE(PG8_SB(1, 0), cB + kstep, voffB); PG8_STAGE(PG8_SA(1, 0), cA + kstep, voffA); PG8_STAGE(PG8_SB(1, 1), cB + hstepB + kstep, voffB);
    PG8_WAIT_V(6); PG8_BAR;
    for (;;) {
        const bool has_next = S.next(ui + 1, nxt);
        const char* nA = has_next ? nxt.pa : cA; const char* nB = has_next ? nxt.pb : cB;
#pragma unroll 1
        for (int t = 0; t < nt; t += 2) {
            const bool last = (t == nt - 2);
            const char* a1 = cA + (size_t)(t + 1) * kstep;
            const char* a2 = last ? nA : cA + (size_t)(t + 2) * kstep; const char* b2 = last ? nB : cB + (size_t)(t + 2) * kstep;
            const char* a3 = a2 + kstep; const char* b3 = b2 + kstep;
            PG8_LDB(B0, 0, 0); PG8_LDB(B1, 0, 1); PG8_SCHED; PG8_LDA(At, 0, 0); PG8_STAGE(PG8_SA(1, 1), a1 + hstepA, voffA);
            PG8_WAIT_V(8); PG8_WAIT_L(0); PG8_BAR; PG8_MMA(0, 0, At, B0); PG8_MMA(0, 1, At, B1); PG8_BAR; PG8_SCHED;
            PG8_LDA(At, 0, 1); PG8_STAGE(PG8_SB(0, 0), b2, voffB); PG8_STAGE(PG8_SB(0, 1), b2 + hstepB, voffB); PG8_STAGE(PG8_SA(0, 0), a2, voffA);
            PG8_WAIT_V(8); PG8_WAIT_L(0); PG8_BAR; PG8_MMA(1, 0, At, B0); PG8_MMA(1, 1, At, B1); PG8_BAR; PG8_SCHED;
            PG8_LDB(B0, 1, 0); PG8_LDB(B1, 1, 1); PG8_SCHED; PG8_LDA(At, 1, 0); PG8_STAGE(PG8_SA(0, 1), a2 + hstepA, voffA);
            PG8_WAIT_V(8); PG8_WAIT_L(0); PG8_BAR; PG8_MMA(0, 0, At, B0); PG8_MMA(0, 1, At, B1); PG8_BAR; PG8_SCHED;
            PG8_LDA(At, 1, 1); PG8_STAGE(PG8_SB(1, 0), b3, voffB); PG8_STAGE(PG8_SB(1, 1), b3 + hstepB, voffB); PG8_STAGE(PG8_SA(1, 0), a3, voffA);
            PG8_WAIT_V(8); PG8_WAIT_L(0); PG8_BAR; PG8_MMA(1, 0, At, B0); PG8_MMA(1, 1, At, B1); PG8_BAR; PG8_SCHED;
        }
        if (wr == 0) PG8_BAR;
        E(acc, cur, wr, wc, fr, fq, lds);
        if (!has_next) break;
        { const float z0 = ozero();
#pragma unroll
        for (int a = 0; a < 2; ++a)
#pragma unroll
            for (int b = 0; b < 2; ++b)
#pragma unroll
                for (int m = 0; m < 4; ++m)
#pragma unroll
                    for (int n = 0; n < 2; ++n) acc[a][b][m][n] = (f32x4){z0, z0, z0, z0}; }
        cur = nxt; cA = nA; cB = nB; ++ui;
        if (wr == 1) PG8_BAR;
    }
    PG8_WAIT_V(0);
    PG8_BAR;
#undef PG8_SA
#undef PG8_SB
#undef PG8_STAGE
#undef PG8_LDA
#undef PG8_LDB
#undef PG8_MMA
#undef PG8_WAIT_V
#undef PG8_WAIT_L
#undef PG8_BAR
#undef PG8_SCHED
}
}
using pg8::Unit;

DI void store8(bf16* p, const f32x4 v0, const f32x4 v1) {
    u32x4 w; w.x = pk2(v0[0], v0[1]); w.y = pk2(v0[2], v0[3]); w.z = pk2(v1[0], v1[1]); w.w = pk2(v1[2], v1[3]);
    *(u32x4*)p = w;
}
#define EPI_ARGS f32x4 (&acc)[2][2][4][2], const Unit& u, int wr, int wc, int fr, int fq, LAS unsigned char* lds

DI float rs_ps(const float* ps, int row) {
    const f32x4* p = (const f32x4*)(ps + (size_t)row * 16); const f32x4 a = p[0], b = p[1], c = p[2], d = p[3];
    const float s = ((a.x + a.y) + (a.z + a.w)) + ((b.x + b.y) + (b.z + b.w)) + (((c.x + c.y) + (c.z + c.w)) + ((d.x + d.y) + (d.z + d.w)));
    return 1.0f / sqrtf(s * (1.0f / D) + EPS);
}
template <int ACT> struct EpiRowScale {
    static constexpr bool PERM = true;
    bf16* O; int ldc; const float* rs; const float* ps;
    DI void operator()(EPI_ARGS) const {
        const int row0 = u.pm * 256 + wr * 64 + fr, col0 = u.pn * 256 + wc * 32 + 8 * fq;
#pragma unroll
        for (int ai = 0; ai < 2; ++ai)
#pragma unroll
            for (int m = 0; m < 4; ++m) {
                const int row = row0 + ai * 128 + m * 16; const float s = ps ? rs_ps(ps, row) : (rs ? rs[row] : 1.0f);
                bf16* rowp = O + (size_t)row * ldc + col0;
#pragma unroll
                for (int bj = 0; bj < 2; ++bj) { f32x4 v0 = acc[ai][bj][m][0] * s, v1 = acc[ai][bj][m][1] * s;
                    if (ACT == 2) {
#pragma unroll
                        for (int j = 0; j < 4; ++j) { float a = fmaxf(v0[j], 0.f), b = fmaxf(v1[j], 0.f); v0[j] = a * a; v1[j] = b * b; } }
                    store8(rowp + bj * 128, v0, v1); }
            }
    }
};
struct EpiInProj {
    static constexpr bool PERM = true;
    bf16* GLU; bf16* QK; const float* rs;
    DI void operator()(EPI_ARGS) const {
        const int row0 = u.pm * 256 + wr * 64 + fr;
        if (u.pn < 4) {
            const int col0 = u.pn * 128 + wc * 32 + 8 * fq;
#pragma unroll
            for (int ai = 0; ai < 2; ++ai)
#pragma unroll
                for (int m = 0; m < 4; ++m) {
                    const int row = row0 + ai * 128 + m * 16; const float s = rs[row];
                    f32x4 o0, o1;
#pragma unroll
                    for (int j = 0; j < 4; ++j) { o0[j] = acc[ai][0][m][0][j] * s * sigmoidf_(acc[ai][1][m][0][j] * s); o1[j] = acc[ai][0][m][1][j] * s * sigmoidf_(acc[ai][1][m][1][j] * s); }
                    store8(GLU + (size_t)row * 512 + col0, o0, o1);
                }
        } else {
            const int col0 = (u.pn - 4) * 256 + wc * 32 + 8 * fq;
#pragma unroll
            for (int ai = 0; ai < 2; ++ai)
#pragma unroll
                for (int m = 0; m < 4; ++m) {
                    const int row = row0 + ai * 128 + m * 16; const float s = rs[row];
#pragma unroll
                    for (int bj = 0; bj < 2; ++bj) store8(QK + (size_t)row * 1024 + col0 + bj * 128, acc[ai][bj][m][0] * s, acc[ai][bj][m][1] * s);
                }
        }
    }
};
struct EpiVT {
    static constexpr bool PERM = true;
    bf16* O; const float* cs;
    DI void operator()(EPI_ARGS) const {
        const int row0 = u.pm * 256 + wr * 64 + fr, col0 = u.pn * 256 + wc * 32 + 8 * fq;
        f32x4 c[2][2];
#pragma unroll
        for (int bj = 0; bj < 2; ++bj) { c[bj][0] = *(const f32x4*)(cs + col0 + bj * 128); c[bj][1] = *(const f32x4*)(cs + col0 + bj * 128 + 4); }
#pragma unroll
        for (int ai = 0; ai < 2; ++ai)
#pragma unroll
            for (int m = 0; m < 4; ++m) {
                const int row = row0 + ai * 128 + m * 16;
#pragma unroll
                for (int bj = 0; bj < 2; ++bj) store8(O + (size_t)row * M + col0 + bj * 128, acc[ai][bj][m][0] * c[bj][0], acc[ai][bj][m][1] * c[bj][1]);
            }
    }
};
struct EpiPre {
    static constexpr bool PERM = true;
    bf16* base0;
    DI void operator()(EPI_ARGS) const {
        bf16* O = base0 + (size_t)((u.z >> 30) & 1) * (52u << 20) + (size_t)(u.z & 0x3fffffff);
        const int row0 = wr * 64 + fr, col0 = wc * 32 + 8 * fq;
#pragma unroll
        for (int ai = 0; ai < 2; ++ai)
#pragma unroll
            for (int m = 0; m < 4; ++m) {
                const int row = row0 + ai * 128 + m * 16;
#pragma unroll
                for (int bj = 0; bj < 2; ++bj) store8(O + (size_t)row * 1024 + col0 + bj * 128, acc[ai][bj][m][0], acc[ai][bj][m][1]);
            }
    }
};
struct EpiResid {
    static constexpr bool PERM = true;
    const float* xres; const bf16* hres; bf16* out; float* ps;
    DI void operator()(EPI_ARGS) const {
        const int row0 = u.pm * 256 + wr * 64 + fr, col0 = u.pn * 256 + wc * 32 + 8 * fq;
#pragma unroll
        for (int ai = 0; ai < 2; ++ai)
#pragma unroll
            for (int m = 0; m < 4; ++m) {
                const int row = row0 + ai * 128 + m * 16; const size_t off = (size_t)row * D + col0; float ss = 0.f;
#pragma unroll
                for (int bj = 0; bj < 2; ++bj) {
                    f32x4 r0, r1;
                    if (xres) { r0 = *(const f32x4*)(xres + off + bj * 128); r1 = *(const f32x4*)(xres + off + bj * 128 + 4); }
                    else { const u32x4 hw = *(const u32x4*)(hres + off + bj * 128); r0 = (f32x4){bflo(hw.x), bfhi(hw.x), bflo(hw.y), bfhi(hw.y)}; r1 = (f32x4){bflo(hw.z), bfhi(hw.z), bflo(hw.w), bfhi(hw.w)}; }
                    r0 = r0 + acc[ai][bj][m][0]; r1 = r1 + acc[ai][bj][m][1];
                    u32x4 w; w.x = pk2(r0[0], r0[1]); w.y = pk2(r0[2], r0[3]); w.z = pk2(r1[0], r1[1]); w.w = pk2(r1[2], r1[3]);
                    *(u32x4*)(out + off + bj * 128) = w;
                    if (ps) {
#pragma unroll
                        for (int q = 0; q < 4; ++q) { const float a = bflo(w[q]), b = bfhi(w[q]); ss += a * a + b * b; }
                    }
                }
                if (ps) { ss += swz_xor<16>(ss); ss = half_sum(ss); if (fq == 0) ps[(size_t)row * 16 + u.pn * 4 + wc] = ss; }
            }
    }
};
struct EpiGateComb {
    static constexpr bool PERM = true;
    const bf16 *YF, *YB, *V; const float *BON, *lng, *lnb; bf16* O;
    DI void operator()(EPI_ARGS) const {
        const int head = u.pn * 4 + wc, ch0 = u.pn * 256 + 64 * wc + 8 * fq, row0 = u.pm * 256 + wr * 64 + fr;
        f32x4 lg[2][2], lb[2][2];
#pragma unroll
        for (int bj = 0; bj < 2; ++bj)
#pragma unroll
            for (int n = 0; n < 2; ++n) { lg[bj][n] = *(const f32x4*)(lng + ch0 + 32 * bj + 4 * n); lb[bj][n] = *(const f32x4*)(lnb + ch0 + 32 * bj + 4 * n); }
#pragma unroll
        for (int ai = 0; ai < 2; ++ai)
#pragma unroll
            for (int m = 0; m < 4; ++m) {
                const int row = row0 + ai * 128 + m * 16; const size_t off = (size_t)row * D + ch0;
                u32x4 a[2], b[2], vv[2];
#pragma unroll
                for (int bj = 0; bj < 2; ++bj) { a[bj] = *(const u32x4*)(YF + off + 32 * bj); b[bj] = *(const u32x4*)(YB + off + 32 * bj); vv[bj] = *(const u32x4*)(V + off + 32 * bj); }
                const float bon = BON[(size_t)row * 16 + head] + BON[(size_t)(M + row) * 16 + head];
                float y[16]; float s = 0.f;
#pragma unroll
                for (int bj = 0; bj < 2; ++bj)
#pragma unroll
                    for (int w = 0; w < 4; ++w) { y[bj * 8 + 2 * w] = bflo(a[bj][w]) + bflo(b[bj][w]); y[bj * 8 + 2 * w + 1] = bfhi(a[bj][w]) + bfhi(b[bj][w]); }
#pragma unroll
                for (int j = 0; j < 16; ++j) s += y[j];
                s += swz_xor<16>(s); s = half_sum(s);
                const float mean = s * (1.0f / 64.0f); float q2 = 0.f;
#pragma unroll
                for (int j = 0; j < 16; ++j) { y[j] -= mean; q2 += y[j] * y[j]; }
                q2 += swz_xor<16>(q2); q2 = half_sum(q2);
                const float rstd = 1.0f / sqrtf(q2 * (1.0f / 64.0f) + 64e-5f);
#pragma unroll
                for (int bj = 0; bj < 2; ++bj) {
                    f32x4 o0, o1;
#pragma unroll
                    for (int j = 0; j < 4; ++j) {
                        const float v0 = (j & 1) ? bfhi(vv[bj][j >> 1]) : bflo(vv[bj][j >> 1]), v1 = (j & 1) ? bfhi(vv[bj][2 + (j >> 1)]) : bflo(vv[bj][2 + (j >> 1)]);
                        o0[j] = (y[bj * 8 + j] * rstd * lg[bj][0][j] + lb[bj][0][j] + bon * v0) * acc[ai][bj][m][0][j];
                        o1[j] = (y[bj * 8 + 4 + j] * rstd * lg[bj][1][j] + lb[bj][1][j] + bon * v1) * acc[ai][bj][m][1][j];
                    }
                    store8(O + off + 32 * bj, o0, o1);
                }
            }
    }
};
struct EpiSoftmax {
    static constexpr bool PERM = true;
    bf16* P; const float* ps;
    DI void operator()(EPI_ARGS) const {
        LAS f32x2* X = (LAS f32x2*)(lds + LDS_X);
        const int row0 = u.pm * 256, col0 = u.pn * 256 + wc * 32 + 8 * fq;
        float mw[2][4];
#pragma unroll
        for (int ai = 0; ai < 2; ++ai)
#pragma unroll
            for (int m = 0; m < 4; ++m) {
                const int rl = ai * 128 + wr * 64 + m * 16 + fr; const float s = rs_ps(ps, row0 + rl) * LOG2E;
                float mx = -3.0e38f;
#pragma unroll
                for (int bj = 0; bj < 2; ++bj)
#pragma unroll
                    for (int n = 0; n < 2; ++n) { acc[ai][bj][m][n] = acc[ai][bj][m][n] * s;
#pragma unroll
                        for (int j = 0; j < 4; ++j) mx = fmaxf(mx, acc[ai][bj][m][n][j]); }
                mx = fmaxf(mx, swz_xor<16>(mx)); mx = half_max(mx);
                float sum = 0.f;
#pragma unroll
                for (int bj = 0; bj < 2; ++bj)
#pragma unroll
                    for (int n = 0; n < 2; ++n)
#pragma unroll
                        for (int j = 0; j < 4; ++j) { const float p = fexp2(acc[ai][bj][m][n][j] - mx); acc[ai][bj][m][n][j] = p; sum += p; }
                sum += swz_xor<16>(sum); sum = half_sum(sum);
                mw[ai][m] = mx;
                if (fq == 0) X[rl * 4 + wc] = (f32x2){mx, sum};
            }
        asm volatile("s_waitcnt lgkmcnt(0)" ::: "memory"); __builtin_amdgcn_s_barrier(); asm volatile("" ::: "memory");
#pragma unroll
        for (int ai = 0; ai < 2; ++ai)
#pragma unroll
            for (int m = 0; m < 4; ++m) {
                const int rl = ai * 128 + wr * 64 + m * 16 + fr;
                const f32x2 a = X[rl * 4 + 0], b = X[rl * 4 + 1], c = X[rl * 4 + 2], d = X[rl * 4 + 3];
                const float mt = fmaxf(fmaxf(a.x, b.x), fmaxf(c.x, d.x));
                const float lt = a.y * fexp2(a.x - mt) + b.y * fexp2(b.x - mt) + c.y * fexp2(c.x - mt) + d.y * fexp2(d.x - mt);
                const float f = fexp2(mw[ai][m] - mt) / lt;
                bf16* rowp = P + (size_t)(row0 + rl) * 1024 + col0;
#pragma unroll
                for (int bj = 0; bj < 2; ++bj) store8(rowp + bj * 128, acc[ai][bj][m][0] * f, acc[ai][bj][m][1] * f);
            }
        asm volatile("s_waitcnt lgkmcnt(0)" ::: "memory"); __builtin_amdgcn_s_barrier(); asm volatile("" ::: "memory");
    }
};
struct EpiRwkv {
    static constexpr bool PERM = true;
    bf16* R; bf16* Kk; bf16* V; bf16* HD1; bf16* HD2;
    DI void operator()(EPI_ARGS) const {
        const int row0 = u.pm * 256 + wr * 64 + fr; const int g = u.pn >> 2;
        bf16* O; int ldc, colt, mode0 = 0, mode1 = 0;
        if (u.pn < 12) { O = R + (size_t)g * (32u << 20); ldc = 1024; colt = (u.pn & 3) * 256; }
        else if (u.pn == 12) { O = HD1; ldc = 256; colt = 0; mode0 = 1; }
        else { O = HD2; ldc = 256; colt = 0; mode0 = 2; mode1 = 2; }
        const int col0 = colt + wc * 32 + 8 * fq;
#pragma unroll
        for (int ai = 0; ai < 2; ++ai)
#pragma unroll
            for (int m = 0; m < 4; ++m) {
                bf16* rowp = O + (size_t)(row0 + ai * 128 + m * 16) * ldc + col0;
#pragma unroll
                for (int bj = 0; bj < 2; ++bj) { f32x4 v0 = acc[ai][bj][m][0], v1 = acc[ai][bj][m][1]; const int md = bj ? mode1 : mode0;
                    if (md == 1) {
#pragma unroll
                        for (int j = 0; j < 4; ++j) { v0[j] = tanhf_(v0[j]); v1[j] = tanhf_(v1[j]); } }
                    else if (md == 2) {
#pragma unroll
                        for (int j = 0; j < 4; ++j) { v0[j] = sigmoidf_(v0[j]); v1[j] = sigmoidf_(v1[j]); } }
                    store8(rowp + bj * 128, v0, v1); }
            }
    }
};

enum InIdx { I_X = 0, I_MEM, I_REL, I_NMIX, I_NXATTN, I_NMEM, I_NFFN, I_NFINAL, I_WIN, I_WOUT, I_CONVW, I_CONVB, I_CLNG, I_CLNB, I_LQ1, I_LK1, I_LQ2, I_LK2, I_SUBLN,
             I_MU, I_WR, I_WK, I_WV, I_WO, I_W0, I_W1, I_W2, I_A0, I_A1, I_A2, I_G1, I_G2, I_KK, I_KA, I_RK, I_LNG, I_LNB, I_XQ, I_XKV, I_XO, I_UP, I_DN, N_IN };
struct Args { const float* in[N_IN]; float* out; unsigned char* ws; int ph_lo, ph_hi; };
static_assert(sizeof(Args) == (N_IN + 2) * 8 + 8, "Args has no padding");

struct Frame {
    LAS unsigned char* lds;
    int tid, lane, wave, gw, ngw;
    unsigned char* ws;
};

DI Frame fresh(const Frame& F0) {
    Frame F = F0; F.tid = opaque(threadIdx.x); F.lane = F.tid & 63; F.wave = __builtin_amdgcn_readfirstlane(F.tid >> 6); F.gw = opq(blockIdx.x) * 8 + F.wave; F.ngw = opq(gridDim.x) * 8; return F;
}
struct TJob { const float* W; int K, N; bf16* WT; int ldt, row_off, col_off, perm; const float* gain; };
DI void tr_item(const TJob& J, LAS float* scr, int item, int lane) {
    const int nblk = J.N / 32, kb = item / nblk, nb = item % nblk, k0 = 64 * kb, n0 = 32 * nb;
    float scale = 1.0f; int drow = J.row_off + n0;
    if (J.perm) {
        if (n0 < 512) drow = 256 * (n0 >> 7) + (n0 & 127);
        else if (n0 < 1024) drow = 256 * ((n0 - 512) >> 7) + 128 + ((n0 - 512) & 127);
        else drow = n0;
        if (n0 >= 1024 && n0 < 1536) scale = 0.125f;
    }
    float tv[32];
    const float* wp = J.W + (size_t)(k0 + (lane >> 5)) * J.N + n0 + (lane & 31);
#pragma unroll
    for (int i = 0; i < 32; ++i) tv[i] = wp[(size_t)(2 * i) * J.N];
    if (J.gain) {
#pragma unroll
        for (int i = 0; i < 32; ++i) tv[i] *= J.gain[k0 + 2 * i + (lane >> 5)];
    }
#pragma unroll
    for (int i = 0; i < 32; ++i) scr[(2 * i + (lane >> 5)) * 33 + (lane & 31)] = tv[i] * scale;
    asm volatile("s_waitcnt lgkmcnt(0)" ::: "memory");
    const int c = lane & 7;
#pragma unroll
    for (int j = 0; j < 4; ++j) { const int n = (lane >> 3) + 8 * j; const LAS float* s = scr + (8 * c) * 33 + n;
        u32x4 o; o.x = pk2(s[0 * 33], s[1 * 33]); o.y = pk2(s[2 * 33], s[3 * 33]); o.z = pk2(s[4 * 33], s[5 * 33]); o.w = pk2(s[6 * 33], s[7 * 33]);
        *(u32x4*)(J.WT + (size_t)(drow + n) * J.ldt + J.col_off + k0 + 8 * c) = o; }
    asm volatile("s_waitcnt lgkmcnt(0)" ::: "memory");
}
DI void tr_item64(const TJob& J, LAS float* scr, int item, int lane) {
    const int nblk = J.N / 64, kb = item / nblk, nb = item % nblk, k0 = 64 * kb, n0 = 64 * nb;
    float scale = 1.0f; int drow = J.row_off + n0;
    if (J.perm) {
        if (n0 < 512) drow = 256 * (n0 >> 7) + (n0 & 127);
        else if (n0 < 1024) drow = 256 * ((n0 - 512) >> 7) + 128 + ((n0 - 512) & 127);
        else drow = n0;
        if (n0 >= 1024 && n0 < 1536) scale = 0.125f;
    }
    f32x4 tv[16];
    const float* wp = J.W + (size_t)(k0 + (lane >> 4)) * J.N + n0 + 4 * (lane & 15);
#pragma unroll
    for (int i = 0; i < 16; ++i) tv[i] = *(const f32x4*)(wp + (size_t)(4 * i) * J.N);
#pragma unroll
    for (int i = 0; i < 16; ++i) { const int kk = 4 * i + (lane >> 4); const float g = (J.gain ? J.gain[k0 + kk] : 1.0f) * scale;
        LAS float* d = scr + kk * 65 + 4 * (lane & 15); d[0] = tv[i].x * g; d[1] = tv[i].y * g; d[2] = tv[i].z * g; d[3] = tv[i].w * g; }
    asm volatile("s_waitcnt lgkmcnt(0)" ::: "memory");
    const int c = lane & 7;
#pragma unroll
    for (int j = 0; j < 8; ++j) { const int n = (lane >> 3) + 8 * j; const LAS float* sp = scr + (8 * c) * 65 + n;
        u32x4 o; o.x = pk2(sp[0 * 65], sp[1 * 65]); o.y = pk2(sp[2 * 65], sp[3 * 65]); o.z = pk2(sp[4 * 65], sp[5 * 65]); o.w = pk2(sp[6 * 65], sp[7 * 65]);
        *(u32x4*)(J.WT + (size_t)(drow + n) * J.ldt + J.col_off + k0 + 8 * c) = o; }
    asm volatile("s_waitcnt lgkmcnt(0)" ::: "memory");
}
constexpr int N_TJOBS = 31;
DI TJob get_tjob(int j, const Args& a, unsigned char* ws) {
    TJob J; J.perm = 0; J.gain = nullptr; J.row_off = 0; J.col_off = 0;
    if (j == 0) { J.W = a.in[opq(I_WIN)]; J.K = 1024; J.N = 2560; J.WT = (bf16*)(ws + WS_WIN); J.ldt = 1024; J.perm = 1; J.gain = a.in[opq(I_NMIX)]; }
    else if (j == 1) { J.W = a.in[opq(I_WOUT)]; J.K = 1024; J.N = 1024; J.WT = (bf16*)(ws + WS_WOUT); J.ldt = 1024; }
    else if (j < 4) { const int i = j - 2; J.W = a.in[opq(I_XKV)] + (size_t)i * 1024 * 2048; J.K = 1024; J.N = 2048; J.WT = (bf16*)(ws + WS_WKV) + (size_t)i * 2048 * 1024; J.ldt = 1024; J.gain = a.in[opq(I_NMEM)] + i * 1024; }
    else if (j < 6) { const int i = j - 4; J.W = a.in[opq(I_XO)] + (size_t)i * 1024 * 1024; J.K = 1024; J.N = 1024; J.WT = (bf16*)(ws + WS_WXO) + (size_t)i * 1024 * 1024; J.ldt = 1024; }
    else if (j < 8) { const int i = j - 6; J.W = a.in[opq(I_UP)] + (size_t)i * 1024 * 4096; J.K = 1024; J.N = 4096; J.WT = (bf16*)(ws + WS_WUP) + (size_t)i * 4096 * 1024; J.ldt = 1024; J.gain = a.in[opq(I_NFFN)] + i * 1024; }
    else if (j < 10) { const int i = j - 8; J.W = a.in[opq(I_DN)] + (size_t)i * 4096 * 1024; J.K = 4096; J.N = 1024; J.WT = (bf16*)(ws + WS_WDN) + (size_t)i * 1024 * 4096; J.ldt = 4096; }
    else if (j < 26) {
        const int q = j - 10, src = q >> 1, copy = q & 1; int mu = 0;
        J.K = 1024; J.WT = (bf16*)(ws + WS_WBIG); J.ldt = 2048; J.col_off = copy * 1024;
        if (src == 0) { J.W = a.in[opq(I_WR)]; J.N = 1024; J.row_off = 0; mu = 0; }
        else if (src == 1) { J.W = a.in[opq(I_WK)]; J.N = 1024; J.row_off = 1024; mu = 2; }
        else if (src == 2) { J.W = a.in[opq(I_WV)]; J.N = 1024; J.row_off = 2048; mu = 3; }
        else if (src == 3) { J.W = a.in[opq(I_W1)]; J.N = 64; J.row_off = 3072; mu = 1; }
        else if (src == 4) { J.W = a.in[opq(I_W1)] + 1024 * 64; J.N = 64; J.row_off = 3136; mu = 1; }
        else if (src == 5) { J.W = a.in[opq(I_A1)]; J.N = 64; J.row_off = 3200; mu = 4; }
        else if (src == 6) { J.W = a.in[opq(I_A1)] + 1024 * 64; J.N = 64; J.row_off = 3264; mu = 4; }
        else { J.W = a.in[opq(I_G1)]; J.N = 160; J.row_off = 3328; mu = 5; }
        if (copy) J.gain = a.in[opq(I_MU)] + mu * 1024;
    }
    else if (j < 30) { const int q = j - 26; J.W = (q < 2 ? a.in[opq(I_W2)] : a.in[opq(I_A2)]) + (size_t)(q & 1) * 64 * 1024; J.K = 64; J.N = 1024; J.WT = (bf16*)(ws + WS_W2T) + (size_t)q * 1024 * 64; J.ldt = 64; }
    else { J.W = a.in[opq(I_WO)]; J.K = 1024; J.N = 1024; J.WT = (bf16*)(ws + WS_WRO); J.ldt = 1024; }
    return J;
}
DI void row_to_bf16_rs(const float* xrow, bf16* orow, float* rs, int lane) {
    const f32x4* xr = (const f32x4*)xrow + lane;
    f32x4 v[4]; float s = 0.f;
#pragma unroll
    for (int j = 0; j < 4; ++j) { v[j] = xr[64 * j]; s += (v[j].x * v[j].x + v[j].y * v[j].y) + (v[j].z * v[j].z + v[j].w * v[j].w); }
    s = wave_sum(s);
    u32x2* o8 = (u32x2*)orow + lane;
#pragma unroll
    for (int j = 0; j < 4; ++j) { u32x2 w; w.x = pk2(v[j].x, v[j].y); w.y = pk2(v[j].z, v[j].w); o8[64 * j] = w; }
    if (lane == 0) *rs = 1.0f / sqrtf(s * (1.0f / D) + EPS);
}
DI void rows4_to_bf16_rs(const Frame& F, const float* X, bf16* O, float* rs, int nrows) {
    for (int m0 = F.gw * 4; m0 < nrows; m0 += F.ngw * 4) {
        f32x4 v[4][4];
#pragma unroll
        for (int r = 0; r < 4; ++r)
#pragma unroll
            for (int j = 0; j < 4; ++j) v[r][j] = ((const f32x4*)(X + (size_t)(m0 + r) * D))[F.lane + 64 * j];
#pragma unroll
        for (int r = 0; r < 4; ++r) {
            float s = 0.f;
#pragma unroll
            for (int j = 0; j < 4; ++j) s += (v[r][j].x * v[r][j].x + v[r][j].y * v[r][j].y) + (v[r][j].z * v[r][j].z + v[r][j].w * v[r][j].w);
            s = wave_sum(s);
            u32x2* o8 = (u32x2*)(O + (size_t)(m0 + r) * D) + F.lane;
#pragma unroll
            for (int j = 0; j < 4; ++j) { u32x2 w; w.x = pk2(v[r][j].x, v[r][j].y); w.y = pk2(v[r][j].z, v[r][j].w); o8[64 * j] = w; }
            if (F.lane == 0) rs[m0 + r] = 1.0f / sqrtf(s * (1.0f / D) + EPS);
        }
    }
}
DI int t5_bucket(int rel) {
    const int n = rel < 0 ? -rel : rel; int r = rel > 0 ? 16 : 0;
    if (n < 8) return r + n;
    int lg = 8; lg += (n >= 12); lg += (n >= 16); lg += (n >= 23); lg += (n >= 32); lg += (n >= 46); lg += (n >= 64); lg += (n >= 91);
    return r + lg;
}
DI void phase_prologue(const Frame& F0, const Args& a, unsigned char* ws) {
    const Frame F = fresh(F0);
    LAS float* scr = (LAS float*)(F.lds + F.wave * 17408);
    {
        int total = 0;
        for (int j = 0; j < N_TJOBS; ++j) { const TJob J = get_tjob(j, a, ws); total += (J.N & 63) == 0 ? (J.K / 64) * (J.N / 64) : (J.K / 64) * (J.N / 32); }
        for (int g = F.gw; g < total; g += F.ngw) {
            int r = g;
            for (int j = 0; j < N_TJOBS; ++j) {
                const TJob J = get_tjob(j, a, ws); const bool wide = (J.N & 63) == 0; const int cnt = wide ? (J.K / 64) * (J.N / 64) : (J.K / 64) * (J.N / 32);
                if (r < cnt) { if (wide) tr_item64(J, scr, r, F.lane); else tr_item(J, scr, r, F.lane); break; }
                r -= cnt;
            }
        }
    }
    const int gt = F.gw * 64 + F.lane, ngt = F.ngw * 64;
    for (int i = 0; i < 2; ++i) {
        const float* W = a.in[opq(I_XQ)] + (size_t)i * 1024 * 1024; const float* g = a.in[opq(I_NXATTN)] + i * 1024; bf16* O = (bf16*)(ws + WS_WQN) + (size_t)i * 1024 * 1024;
        for (int e = gt; e < 1024 * 1024 / 4; e += ngt) { const f32x4 v = ((const f32x4*)W)[e]; const float s = g[(e * 4) >> 10] * 0.0625f; u32x2 w; w.x = pk2(v.x * s, v.y * s); w.y = pk2(v.z * s, v.w * s); ((u32x2*)O)[e] = w; }
    }
    { const float* W = a.in[opq(I_G2)]; bf16* O = (bf16*)(ws + WS_G2T);
      for (int e = gt; e < 1024 * 256; e += ngt) { const int rown = e >> 8, k = e & 255, cc = rown & 255;
        const int n = (rown & ~255) + 64 * ((cc >> 5) & 3) + 32 * (cc >> 7) + (cc & 31);
        O[e] = (bf16)(k < 160 ? f2bf(W[(size_t)k * 1024 + n]) : 0u); } }
    { u32x4* O = (u32x4*)((bf16*)(ws + WS_WBIG) + (size_t)3488 * 2048);
      const unsigned zq = (unsigned)opaque(0);
      for (int e = gt; e < 96 * 2048 * 2 / 16; e += ngt) O[e] = (u32x4){zq, zq, zq, zq}; }
    rows4_to_bf16_rs(F, a.in[opq(I_X)], (bf16*)(ws + WS_SA), (float*)(ws + WS_RS), M);
    rows4_to_bf16_rs(F, a.in[opq(I_MEM)], (bf16*)(ws + WS_MEMB), (float*)(ws + WS_RSMEM), MMEM);
    { float* B = (float*)(ws + WS_BIAS); const float* tab = a.in[opq(I_REL)];
      for (int e = gt; e < 4 * 4096; e += ngt) { const int h = e >> 12, idx = e & 4095; const int rel = idx - 2047; B[e] = idx < 4095 ? tab[t5_bucket(rel) * 4 + h] * LOG2E : 0.f; } }
    if (F.gw == 0) {
        const float q1 = a.in[opq(I_LQ1)][F.lane] * a.in[opq(I_LK1)][F.lane], q2 = a.in[opq(I_LQ2)][F.lane] * a.in[opq(I_LK2)][F.lane];
        const float s1 = wave_sum(q1), s2 = wave_sum(q2);
        if (F.lane == 0) ((float*)(ws + WS_LAM))[0] = expf(s1) - expf(s2) + 0.2f;
    }
}

DI void phase_norm(const Frame& F0, const float* h, bf16* hb, float* rs) {
    const Frame F = fresh(F0);
    for (int m = F.gw; m < M; m += F.ngw) row_to_bf16_rs(h + (size_t)m * D, hb + (size_t)m * D, rs + m, F.lane);
}
DI void phase_final_norm(const Frame& F0, const bf16* h, float* out, const float* g, const float osc) {
    const Frame F = fresh(F0);
    f32x4 gv[4];
#pragma unroll
    for (int j = 0; j < 4; ++j) gv[j] = ((const f32x4*)g)[F.lane + 64 * j];
    for (int m0 = F.gw * 4; m0 < M; m0 += F.ngw * 4) {
        u32x2 hw[4][4];
#pragma unroll
        for (int r = 0; r < 4; ++r)
#pragma unroll
            for (int j = 0; j < 4; ++j) hw[r][j] = ((const u32x2*)(h + (size_t)(m0 + r) * D))[F.lane + 64 * j];
#pragma unroll
        for (int r = 0; r < 4; ++r) {
            f32x4 v[4]; float s = 0.f;
#pragma unroll
            for (int j = 0; j < 4; ++j) { v[j] = (f32x4){bflo(hw[r][j].x), bfhi(hw[r][j].x), bflo(hw[r][j].y), bfhi(hw[r][j].y)}; s += (v[j].x * v[j].x + v[j].y * v[j].y) + (v[j].z * v[j].z + v[j].w * v[j].w); }
            const float rr = osc / sqrtf(wave_sum(s) * (1.0f / D) + EPS);
            f32x4* xr = (f32x4*)(out + (size_t)(m0 + r) * D) + F.lane;
#pragma unroll
            for (int j = 0; j < 4; ++j) xr[64 * j] = v[j] * rr * gv[j];
        }
    }
}
DI void phase_rwkv_shift(const Frame& F0, const bf16* h, const float* g, bf16* A1) {
    const Frame F = fresh(F0);
    f32x4 gv[4];
#pragma unroll
    for (int j = 0; j < 4; ++j) gv[j] = ((const f32x4*)g)[F.lane + 64 * j];
    for (int ch = F.gw; ch < M / 16; ch += F.ngw) {
        const int m0 = ch * 16, t0 = m0 & (T - 1);
        f32x4 p2[4], p1[4], cu[4];
#pragma unroll
        for (int j = 0; j < 4; ++j) { p2[j] = (f32x4){0.f, 0.f, 0.f, 0.f}; p1[j] = p2[j]; cu[j] = p2[j]; }
#pragma unroll 1
        for (int g6 = 0; g6 < 3; ++g6) {
            f32x4 ld[6][4];
#pragma unroll
            for (int r = 0; r < 6; ++r) { const int i = g6 * 6 + r - 1, t = t0 + i; const bool ok = (t >= 0 && t < T);
#pragma unroll
                for (int j = 0; j < 4; ++j) { const u32x2 w = ok ? ((const u32x2*)(h + (size_t)(m0 + i) * D))[F.lane + 64 * j] : (u32x2){0u, 0u}; ld[r][j] = (f32x4){bflo(w.x), bfhi(w.x), bflo(w.y), bfhi(w.y)}; } }
#pragma unroll
            for (int r = 0; r < 6; ++r) {
                const int i = g6 * 6 + r - 1;
                float s = 0.f;
#pragma unroll
                for (int j = 0; j < 4; ++j) { p2[j] = p1[j]; p1[j] = cu[j]; cu[j] = ld[r][j]; s += (cu[j].x * cu[j].x + cu[j].y * cu[j].y) + (cu[j].z * cu[j].z + cu[j].w * cu[j].w); }
                const float rr = 1.0f / sqrtf(wave_sum(s) * (1.0f / D) + EPS);
#pragma unroll
                for (int j = 0; j < 4; ++j) cu[j] = cu[j] * rr * gv[j];
                if (i >= 1) {
                    u32x2* o = (u32x2*)(A1 + (size_t)(m0 + i - 1) * 2048) + F.lane;
#pragma unroll
                    for (int j = 0; j < 4; ++j) { const f32x4 hh = (p2[j] + cu[j]) * 0.5f - p1[j];
                        u32x2 w; w.x = pk2(p1[j].x, p1[j].y); w.y = pk2(p1[j].z, p1[j].w); o[64 * j] = w;
                        u32x2 w2; w2.x = pk2(hh.x, hh.y); w2.y = pk2(hh.z, hh.w); o[256 + 64 * j] = w2; }
                }
            }
        }
    }
}
DI void phase_rwkv_comb(const Frame& F0, const bf16* YF, const bf16* YB, const bf16* V, const bf16* GT, const float* BON, const float* lng, const float* lnb, bf16* O) {
    const Frame F = fresh(F0);
    const int hd = F.lane >> 2, c0 = F.lane * 16;
    float lg[16], lb[16];
#pragma unroll
    for (int j = 0; j < 16; ++j) { lg[j] = lng[c0 + j]; lb[j] = lnb[c0 + j]; }
    for (int m0 = F.gw * 2; m0 < M; m0 += F.ngw * 2) {
        u32x4 a[2][2], b[2][2], vv[2][2], gg[2][2]; float bonr[2];
#pragma unroll
        for (int r = 0; r < 2; ++r) { const size_t off = (size_t)(m0 + r) * D + c0;
#pragma unroll
            for (int q = 0; q < 2; ++q) { a[r][q] = ((const u32x4*)(YF + off))[q]; b[r][q] = ((const u32x4*)(YB + off))[q]; vv[r][q] = ((const u32x4*)(V + off))[q]; gg[r][q] = ((const u32x4*)(GT + off))[q]; }
            bonr[r] = BON[(size_t)(m0 + r) * 16 + hd] + BON[(size_t)(M + m0 + r) * 16 + hd]; }
#pragma unroll
        for (int r = 0; r < 2; ++r) {
            const size_t off = (size_t)(m0 + r) * D + c0; const float bon = bonr[r];
            float y[16]; float s = 0.f;
#pragma unroll
            for (int q = 0; q < 2; ++q)
#pragma unroll
                for (int w = 0; w < 4; ++w) { y[q * 8 + 2 * w] = bflo(a[r][q][w]) + bflo(b[r][q][w]); y[q * 8 + 2 * w + 1] = bfhi(a[r][q][w]) + bfhi(b[r][q][w]); }
#pragma unroll
            for (int j = 0; j < 16; ++j) s += y[j];
            s += swz_xor<1>(s); s += swz_xor<2>(s);
            const float mean = s * (1.0f / 64.0f); float q2 = 0.f;
#pragma unroll
            for (int j = 0; j < 16; ++j) { y[j] -= mean; q2 += y[j] * y[j]; }
            q2 += swz_xor<1>(q2); q2 += swz_xor<2>(q2);
            const float rstd = 1.0f / sqrtf(q2 * (1.0f / 64.0f) + 64e-5f);
            u32x4 o[2];
#pragma unroll
            for (int q = 0; q < 2; ++q)
#pragma unroll
                for (int w = 0; w < 4; ++w) {
                    const int j = q * 8 + 2 * w;
                    const float r0 = (y[j] * rstd * lg[j] + lb[j] + bon * bflo(vv[r][q][w])) * bflo(gg[r][q][w]);
                    const float r1 = (y[j + 1] * rstd * lg[j + 1] + lb[j + 1] + bon * bfhi(vv[r][q][w])) * bfhi(gg[r][q][w]);
                    o[q][w] = pk2(r0, r1);
                }
            ((u32x4*)(O + off))[0] = o[0]; ((u32x4*)(O + off))[1] = o[1];
        }
    }
}
constexpr int CV_ROWB = 1040, CV_IN_BYTES = 94 * CV_ROWB, CV_W_OFF = CV_IN_BYTES;
DI void conv_load_weights(const Frame& F0, const float* cw) {
    const Frame F = fresh(F0);
    LAS bf16* W = (LAS bf16*)(F.lds + CV_W_OFF);
    for (int e = F.tid; e < 31 * 512; e += 512) W[e] = (bf16)f2bf(cw[e]);
}
DI void conv_unit(const Frame& F0, int unit, const bf16* GLU, const float* cb, const float* lg, const float* lb, bf16* MIX) {
    const Frame F = fresh(F0);
    const int b = unit >> 5, t0 = (unit & 31) * 64;
    __syncthreads();
    for (int p = F.tid; p < 94 * 64; p += 512) {
        const int r = p >> 6, c = p & 63, t = t0 - 15 + r;
        u32x4 v = (u32x4){0u, 0u, 0u, 0u};
        if (t >= 0 && t < T) v = *(const u32x4*)(GLU + (size_t)(b * T + t) * 512 + c * 8);
        *(LAS u32x4*)(F.lds + r * CV_ROWB + c * 16) = v;
    }
    __syncthreads();
    const int tl = F.tid >> 3, chunk = F.tid & 7;
    float y[64];
#pragma unroll
    for (int i = 0; i < 8; ++i) {
        const int cg = chunk + 8 * i;
        float acc[8];
#pragma unroll
        for (int e = 0; e < 8; ++e) acc[e] = cb[cg * 8 + e];
#pragma unroll 1
        for (int j = 0; j < 31; ++j) {
            const u32x4 x = *(const LAS u32x4*)(F.lds + (tl + j) * CV_ROWB + cg * 16);
            const u32x4 w = *(const LAS u32x4*)(F.lds + CV_W_OFF + j * 1024 + cg * 16);
#pragma unroll
            for (int q = 0; q < 4; ++q) { acc[2 * q] += bflo(x[q]) * bflo(w[q]); acc[2 * q + 1] += bfhi(x[q]) * bfhi(w[q]); }
        }
#pragma unroll
        for (int e = 0; e < 8; ++e) y[i * 8 + e] = acc[e];
    }
    float s = 0.f;
#pragma unroll
    for (int j = 0; j < 64; ++j) s += y[j];
    s += swz_xor<1>(s); s += swz_xor<2>(s); s += swz_xor<4>(s);
    const float mean = s * (1.0f / 512.0f); float q2 = 0.f;
#pragma unroll
    for (int j = 0; j < 64; ++j) { y[j] -= mean; q2 += y[j] * y[j]; }
    q2 += swz_xor<1>(q2); q2 += swz_xor<2>(q2); q2 += swz_xor<4>(q2);
    const float rstd = 1.0f / sqrtf(q2 * (1.0f / 512.0f) + 1e-5f);
    bf16* orow = MIX + (size_t)(b * T + t0 + tl) * 1024;
#pragma unroll
    for (int i = 0; i < 8; ++i) {
        const int c0 = (chunk + 8 * i) * 8;
        const f32x4 g0 = *(const f32x4*)(lg + c0), g1 = *(const f32x4*)(lg + c0 + 4), b0 = *(const f32x4*)(lb + c0), b1 = *(const f32x4*)(lb + c0 + 4);
        f32x4 o0, o1;
#pragma unroll
        for (int e = 0; e < 4; ++e) { const float v0 = y[i * 8 + e] * rstd * g0[e] + b0[e], v1 = y[i * 8 + 4 + e] * rstd * g1[e] + b1[e]; o0[e] = v0 * sigmoidf_(v0); o1[e] = v1 * sigmoidf_(v1); }
        store8(orow + c0, o0, o1);
    }
}

constexpr int DA_KROW = 272, DA_VROW = 144, DA_KB = 64 * DA_KROW, DA_VB = 128 * DA_VROW, DA_BUF = DA_KB + DA_VB;
DI int crow(int reg, int hf) { return (reg & 3) + 8 * (reg >> 2) + 4 * hf; }
DI void diffattn_unit(const Frame& F0, int unit, const bf16* QK, const bf16* VT, const float* BIAS, const float lam, const float* subg, bf16* MIX) {
    const Frame F = fresh(F0);
    const int b = unit >> 6, h = (unit >> 4) & 3, qb = unit & 15;
    const int c = F.wave >> 2, qs = F.wave & 3, r32 = F.lane & 31, hf = F.lane >> 5;
    const int q0w = qb * 128 + qs * 32;
    const float* bias_h = BIAS + h * 4096 + 2047;
    bf16x8 Qf[4];
    { const bf16* qp = QK + (size_t)(b * T + q0w + r32) * 1024 + h * 128 + c * 64 + 8 * hf;
#pragma unroll
      for (int ks = 0; ks < 4; ++ks) Qf[ks] = *(const bf16x8*)(qp + 16 * ks); }
    const bf16* kg[2]; const bf16* vg[2]; int kl[2], vl[2];
#pragma unroll
    for (int i = 0; i < 2; ++i) { const int p = F.tid + 512 * i;
        kg[i] = QK + (size_t)(b * T + (p >> 4)) * 1024 + 512 + h * 128 + (p & 15) * 8; kl[i] = (p >> 4) * DA_KROW + (p & 15) * 16;
        vg[i] = VT + (size_t)(h * 128 + (p >> 3)) * M + b * T + (p & 7) * 8; vl[i] = DA_KB + (p >> 3) * DA_VROW + ((p & 7) >> 1) * 32 + ((p & 7) & 1) * 8; }
    u32x4 kr[2], vr[2];
#pragma unroll
    for (int i = 0; i < 2; ++i) { kr[i] = *(const u32x4*)(kg[i]); vr[i] = *(const u32x4*)(vg[i]); }
    __syncthreads();
    LAS float* const btab = (LAS float*)(F.lds + 2 * DA_BUF);
    btab[F.tid] = bias_h[F.tid - 256];
#pragma unroll
    for (int i = 0; i < 2; ++i) { *(LAS u32x4*)(F.lds + kl[i]) = kr[i]; *(LAS u32x2*)(F.lds + vl[i]) = (u32x2){vr[i].x, vr[i].y}; *(LAS u32x2*)(F.lds + vl[i] + 16) = (u32x2){vr[i].z, vr[i].w}; }
#pragma unroll
    for (int i = 0; i < 2; ++i) { kr[i] = *(const u32x4*)(kg[i] + (size_t)64 * 1024); vr[i] = *(const u32x4*)(vg[i] + 64); }
    __syncthreads();
    f32x16 O[4];
#pragma unroll
    for (int vt = 0; vt < 4; ++vt)
#pragma unroll
        for (int i = 0; i < 16; ++i) O[vt][i] = 0.f;
    float lsum = 0.f;
    const float cbR = bias_h[91], cbL = bias_h[-91];
    const int ka = r32 * DA_KROW + c * 128 + 16 * hf;
    const int va = DA_KB + r32 * DA_VROW + 16 * hf;
    for (int kt = 0; kt < 32; ++kt) {
        const int k0 = kt * 64;
        LAS unsigned char* buf = F.lds + (kt & 1) * DA_BUF;
        const int dmin = k0 - (q0w + 31), dmax = k0 + 63 - q0w;
        const bool far = (dmin >= 91) || (dmax <= -91);
        const float cb = dmin >= 91 ? cbR : cbL;
        bf16x8 kf[8];
#pragma unroll
        for (int f = 0; f < 8; ++f) kf[f] = *(const LAS bf16x8*)(buf + ka + (f >> 2) * 32 * DA_KROW + (f & 3) * 32);
        __builtin_amdgcn_sched_barrier(0);
        f32x16 S0, S1;
        { const float z0 = ozero();
#pragma unroll
          for (int i = 0; i < 16; ++i) { S0[i] = z0; S1[i] = z0; } }
        bf16x8 vf0[8];
#pragma unroll
        for (int f = 0; f < 8; ++f) vf0[f] = *(const LAS bf16x8*)(buf + va + (f & 3) * 32 * DA_VROW + (f >> 2) * 32);
#pragma unroll
        for (int ks = 0; ks < 4; ++ks) S0 = __builtin_amdgcn_mfma_f32_32x32x16_bf16(kf[ks], Qf[ks], S0, 0, 0, 0);
#pragma unroll
        for (int ks = 0; ks < 4; ++ks) S1 = __builtin_amdgcn_mfma_f32_32x32x16_bf16(kf[4 + ks], Qf[ks], S1, 0, 0, 0);
        __builtin_amdgcn_sched_barrier(0);
        bf16x8 vf1[8];
#pragma unroll
        for (int f = 0; f < 8; ++f) vf1[f] = *(const LAS bf16x8*)(buf + va + (f & 3) * 32 * DA_VROW + (2 + (f >> 2)) * 32);
        bf16x8 pa0[2], pa1[2];
        {
            float p[16];
            if (far) {
#pragma unroll
                for (int i = 0; i < 16; ++i) p[i] = fexp2(S0[i] * LOG2E + cb); } else { const LAS float* tb = btab + (k0 - (q0w + r32) + 256);
#pragma unroll
                for (int i = 0; i < 16; ++i) p[i] = fexp2(S0[i] * LOG2E + tb[crow(i, hf)]); }
#pragma unroll
            for (int i = 0; i < 16; ++i) lsum += p[i];
#pragma unroll
            for (int s2 = 0; s2 < 2; ++s2) { u32x4 pw; pw.x = pk2(p[8 * s2], p[8 * s2 + 1]); pw.y = pk2(p[8 * s2 + 2], p[8 * s2 + 3]); pw.z = pk2(p[8 * s2 + 4], p[8 * s2 + 5]); pw.w = pk2(p[8 * s2 + 6], p[8 * s2 + 7]); pa0[s2] = __builtin_bit_cast(bf16x8, pw); }
        }
        __builtin_amdgcn_sched_barrier(0);
#pragma unroll
        for (int f = 0; f < 8; ++f) O[f & 3] = __builtin_amdgcn_mfma_f32_32x32x16_bf16(pa0[f >> 2], vf0[f], O[f & 3], 0, 0, 0);
        {
            float p[16];
            if (far) {
#pragma unroll
                for (int i = 0; i < 16; ++i) p[i] = fexp2(S1[i] * LOG2E + cb); } else { const LAS float* tb = btab + (k0 + 32 - (q0w + r32) + 256);
#pragma unroll
                for (int i = 0; i < 16; ++i) p[i] = fexp2(S1[i] * LOG2E + tb[crow(i, hf)]); }
#pragma unroll
            for (int i = 0; i < 16; ++i) lsum += p[i];
#pragma unroll
            for (int s2 = 0; s2 < 2; ++s2) { u32x4 pw; pw.x = pk2(p[8 * s2], p[8 * s2 + 1]); pw.y = pk2(p[8 * s2 + 2], p[8 * s2 + 3]); pw.z = pk2(p[8 * s2 + 4], p[8 * s2 + 5]); pw.w = pk2(p[8 * s2 + 6], p[8 * s2 + 7]); pa1[s2] = __builtin_bit_cast(bf16x8, pw); }
        }
        __builtin_amdgcn_sched_barrier(0);
#pragma unroll
        for (int f = 0; f < 8; ++f) O[f & 3] = __builtin_amdgcn_mfma_f32_32x32x16_bf16(pa1[f >> 2], vf1[f], O[f & 3], 0, 0, 0);
        if (kt + 1 < 32) {
            LAS unsigned char* nb = F.lds + ((kt + 1) & 1) * DA_BUF;
#pragma unroll
            for (int i = 0; i < 2; ++i) { *(LAS u32x4*)(nb + kl[i]) = kr[i]; *(LAS u32x2*)(nb + vl[i]) = (u32x2){vr[i].x, vr[i].y}; *(LAS u32x2*)(nb + vl[i] + 16) = (u32x2){vr[i].z, vr[i].w}; }
        }
        if (kt + 2 < 32) {
#pragma unroll
            for (int i = 0; i < 2; ++i) { kr[i] = *(const u32x4*)(kg[i] + (size_t)(k0 + 128) * 1024); vr[i] = *(const u32x4*)(vg[i] + k0 + 128); }
        }
        __syncthreads();
    }
    lsum = half_sum(lsum);
    LAS float* XO = (LAS float*)F.lds;
    LAS float* LW = (LAS float*)(F.lds + 65536) + F.wave * 32;
    if (hf == 0) LW[r32] = 1.0f / lsum;
    asm volatile("s_waitcnt lgkmcnt(0)" ::: "memory");
    float il[16];
#pragma unroll
    for (int i = 0; i < 16; ++i) il[i] = LW[crow(i, hf)];
    if (c == 1) {
#pragma unroll
        for (int vt = 0; vt < 4; ++vt)
#pragma unroll
            for (int i = 0; i < 16; ++i) XO[(qs * 32 + crow(i, hf)) * 128 + vt * 32 + r32] = O[vt][i] * il[i];
    }
    __syncthreads();
    if (c == 0) {
        float ss[16];
#pragma unroll
        for (int i = 0; i < 16; ++i) ss[i] = 0.f;
#pragma unroll
        for (int vt = 0; vt < 4; ++vt)
#pragma unroll
            for (int i = 0; i < 16; ++i) { const float o = O[vt][i] * il[i] - lam * XO[(qs * 32 + crow(i, hf)) * 128 + vt * 32 + r32]; O[vt][i] = o; ss[i] += o * o; }
#pragma unroll
        for (int i = 0; i < 16; ++i) { float v = ss[i]; v += swz_xor<1>(v); v += swz_xor<2>(v); v += swz_xor<4>(v); v += swz_xor<8>(v); v += swz_xor<16>(v); ss[i] = 0.8f / sqrtf(v * (1.0f / 128.0f) + EPS); }
#pragma unroll
        for (int vt = 0; vt < 4; ++vt) {
            const float g = subg[vt * 32 + r32];
#pragma unroll
            for (int i = 0; i < 16; ++i) MIX[(size_t)(b * T + q0w + crow(i, hf)) * 1024 + 512 + h * 128 + vt * 32 + r32] = (bf16)f2bf(O[vt][i] * ss[i] * g);
        }
    }
}

constexpr int SC_VECB = 256, SC_STEPB = 6 * SC_VECB, SC_BUFB = 16 * SC_STEPB;
constexpr int SC_SCR_OFF = 4 * SC_BUFB, SC_SCR_W = 16 * 68 * 4;
DI float dpp_x1(float v) { return __builtin_bit_cast(float, __builtin_amdgcn_update_dpp(0, __builtin_bit_cast(int, v), 0xB1, 0xF, 0xF, true)); }
DI float dpp_x2(float v) { return __builtin_bit_cast(float, __builtin_amdgcn_update_dpp(0, __builtin_bit_cast(int, v), 0x4E, 0xF, 0xF, true)); }
DI float quad_sum(float v) { v += dpp_x1(v); v += dpp_x2(v); return v; }

DI float a_fmac(float acc, float a, float b) { return __builtin_fmaf(a, b, acc); }
DI float a_fma(float a, float b, float c) { return __builtin_fmaf(a, b, c); }
DI float a_mul(float a, float b) { return a * b; }
struct ScanPtrs { const bf16 *R, *K, *V, *HD1, *W2T; const float *w0, *a0, *kk, *ka, *rk; bf16 *YF, *YB; float* BON; unsigned* ERR; };

DI void scan_pair(const Frame& F0, int bh, const ScanPtrs& P) {
    const Frame F = fresh(F0);
    const int b = bh >> 4, h = bh & 15;
    __syncthreads();
    if (F.wave < 4) {
        const int z = F.wave >> 1, rh = F.wave & 1, rp = F.lane >> 2, jq = F.lane & 3, i0 = rh * 32 + 2 * rp;
        float S0[16], S1[16];
#pragma unroll
        for (int j = 0; j < 16; ++j) { S0[j] = 0.f; S1[j] = 0.f; }
        bf16* Y = z ? P.YB : P.YF;
        __builtin_amdgcn_s_barrier();
#ifdef MK_TPROBE
        unsigned long long tp_acc = 0ull, tp_phase0 = __builtin_amdgcn_s_memtime();
#endif
        for (int e = 0; e < T / 16; ++e) {
#ifdef MK_TPROBE
            const unsigned long long tp0 = __builtin_amdgcn_s_memtime();
#endif
            const LAS unsigned char* base = F.lds + (z * 2 + (e & 1)) * SC_BUFB + jq * 64;
            const int t0c = z ? T - 16 * (e + 1) : 16 * e;
            bf16* yrow = Y + (size_t)(b * T + t0c) * 1024 + h * 64 + i0;
            f32x4 wv[2][4], kv[2][4], bv[2][4], av[2][4], rv[2][4]; f32x2 v2[2];
#define SC_FETCH(slot, li_) do { const LAS unsigned char* sb_ = base + (li_) * SC_STEPB; _Pragma("unroll") for (int q = 0; q < 4; ++q) { \
                av[slot][q] = *(const LAS f32x4*)(sb_ + 3 * SC_VECB + q * 16); wv[slot][q] = *(const LAS f32x4*)(sb_ + q * 16); kv[slot][q] = *(const LAS f32x4*)(sb_ + SC_VECB + q * 16); \
                bv[slot][q] = *(const LAS f32x4*)(sb_ + 2 * SC_VECB + q * 16); rv[slot][q] = *(const LAS f32x4*)(sb_ + 4 * SC_VECB + q * 16); } \
                v2[slot] = *(const LAS f32x2*)(sb_ - jq * 64 + 5 * SC_VECB + i0 * 4); } while (0)
            SC_FETCH(0, z ? 15 : 0);
#pragma unroll
            for (int s = 0; s < 16; ++s) {
                const int li = z ? 15 - s : s, cs = s & 1, ns = cs ^ 1;
                if (s < 15) SC_FETCH(ns, z ? 14 - s : s + 1);
                __builtin_amdgcn_sched_barrier(0);
                float sa0 = 0.f, sa1 = 0.f, sb0 = 0.f, sb1 = 0.f;
#pragma unroll
                for (int j = 0; j < 16; j += 2) { const float a0 = av[cs][j >> 2][j & 3], a1 = av[cs][(j + 1) >> 2][(j + 1) & 3];
                    sa0 = a_fmac(sa0, S0[j], a0); sb0 = a_fmac(sb0, S1[j], a0); sa1 = a_fmac(sa1, S0[j + 1], a1); sb1 = a_fmac(sb1, S1[j + 1], a1); }
                const float sa = quad_sum(sa0 + sa1), sb = quad_sum(sb0 + sb1);
                const float v0 = v2[cs].x, v1 = v2[cs].y;
                float y0 = 0.f, y1 = 0.f, z0 = 0.f, z1 = 0.f;
#pragma unroll
                for (int j = 0; j < 16; ++j) {
                    const float wj = wv[cs][j >> 2][j & 3], bj = bv[cs][j >> 2][j & 3], kj = kv[cs][j >> 2][j & 3], rj = rv[cs][j >> 2][j & 3];
                    S0[j] = a_fma(S0[j], wj, a_fma(sa, bj, a_mul(v0, kj)));
                    S1[j] = a_fma(S1[j], wj, a_fma(sb, bj, a_mul(v1, kj)));
                    if (j & 1) { y1 = a_fmac(y1, S0[j], rj); z1 = a_fmac(z1, S1[j], rj); } else { y0 = a_fmac(y0, S0[j], rj); z0 = a_fmac(z0, S1[j], rj); }
                }
                f32x2 y; y.x = quad_sum(y0 + y1); y.y = quad_sum(z0 + z1);
                if (jq == 0) *(unsigned*)(yrow + (size_t)li * 1024) = pk2(y.x, y.y);
                __builtin_amdgcn_sched_barrier(0);
            }
#undef SC_FETCH
            asm volatile("s_waitcnt lgkmcnt(0)" ::: "memory");
#ifdef MK_TPROBE
            tp_acc += __builtin_amdgcn_s_memtime() - tp0;
#endif
            __builtin_amdgcn_s_barrier();
        }
#ifdef MK_TPROBE
        if (blockIdx.x == 0 && F.wave == 0) {
            const unsigned long long tot = __builtin_amdgcn_s_memtime() - tp_phase0;
            const unsigned long long amt = (MK_TPROBE > 0 ? (unsigned long long)MK_TPROBE * tp_acc : (unsigned long long)(-(MK_TPROBE)) * (tot - tp_acc));
            const unsigned long long w0 = __builtin_amdgcn_s_memtime();
            while (__builtin_amdgcn_s_memtime() - w0 < amt) __builtin_amdgcn_s_sleep(8);
        }
#endif
    } else {
        const int pw = F.wave - 4, z = pw >> 1, par = pw & 1;
        const int l15 = F.lane & 15, l4 = F.lane >> 4, row = F.lane >> 2, cq = F.lane & 3;
        const bf16* w2p = P.W2T + (size_t)z * 65536 + (size_t)(h * 64 + l15) * 64 + 8 * l4;
        const int ch0 = h * 64 + cq * 16;
        LAS float* scrW = (LAS float*)(F.lds + SC_SCR_OFF + pw * 2 * SC_SCR_W);
        LAS float* scrA = scrW + 16 * 68;
        bf16x8 Ahw[2], Aha[2]; u32x4 r16[2], k16[2], v16[2];
        auto do_load = [&](int c) {
            const int t0c = z ? T - 16 * (c + 1) : 16 * c; const size_t m0 = (size_t)b * T + t0c;
#pragma unroll
            for (int ks = 0; ks < 2; ++ks) { const bf16* p = P.HD1 + (m0 + l15) * 256 + z * 64 + 32 * ks + 8 * l4; Ahw[ks] = *(const bf16x8*)p; Aha[ks] = *(const bf16x8*)(p + 128); }
            const size_t off = (m0 + row) * 1024 + ch0;
#pragma unroll
            for (int q = 0; q < 2; ++q) { r16[q] = ((const u32x4*)(P.R + off))[q]; k16[q] = ((const u32x4*)(P.K + off))[q]; v16[q] = ((const u32x4*)(P.V + off))[q]; }
        };
        auto do_compute = [&](int c) {
            const int t0c = z ? T - 16 * (c + 1) : 16 * c; const size_t m0 = (size_t)b * T + t0c;
#pragma unroll
            for (int nt = 0; nt < 4; ++nt) {
                f32x4 dw = (f32x4){0.f, 0.f, 0.f, 0.f}, da = dw;
#pragma unroll
                for (int ks = 0; ks < 2; ++ks) { const bf16x8 wf = *(const bf16x8*)(w2p + nt * 1024 + ks * 32), af = *(const bf16x8*)(w2p + 2 * 65536 + nt * 1024 + ks * 32);
                    dw = __builtin_amdgcn_mfma_f32_16x16x32_bf16(Ahw[ks], wf, dw, 0, 0, 0); da = __builtin_amdgcn_mfma_f32_16x16x32_bf16(Aha[ks], af, da, 0, 0, 0); }
#pragma unroll
                for (int rg = 0; rg < 4; ++rg) { scrW[(4 * l4 + rg) * 68 + 16 * nt + l15] = dw[rg]; scrA[(4 * l4 + rg) * 68 + 16 * nt + l15] = da[rg]; }
            }
            asm volatile("s_waitcnt lgkmcnt(0)" ::: "memory");
            float ssq = 0.f;
#pragma unroll
            for (int q = 0; q < 2; ++q)
#pragma unroll
                for (int w = 0; w < 4; ++w) { const f32x2 kc = *(const f32x2*)(P.kk + ch0 + q * 8 + 2 * w); const float k0 = bflo(k16[q][w]) * kc.x, k1 = bfhi(k16[q][w]) * kc.y; ssq += k0 * k0 + k1 * k1; }
            ssq = quad_sum(ssq);
            const float inv = 1.0f / fmaxf(sqrtf(ssq), 1e-12f);
            float bon = 0.f;
            LAS unsigned char* sb = F.lds + (z * 2 + (c & 1)) * SC_BUFB + row * SC_STEPB + cq * 64;
#pragma unroll
            for (int q = 0; q < 4; ++q) {
                const f32x4 wp = *(const LAS f32x4*)(scrW + row * 68 + cq * 16 + q * 4), ap = *(const LAS f32x4*)(scrA + row * 68 + cq * 16 + q * 4);
                const f32x4 w0v = *(const f32x4*)(P.w0 + z * 1024 + ch0 + q * 4), a0v = *(const f32x4*)(P.a0 + z * 1024 + ch0 + q * 4);
                const f32x4 kkv = *(const f32x4*)(P.kk + ch0 + q * 4), kav = *(const f32x4*)(P.ka + ch0 + q * 4), rkv = *(const f32x4*)(P.rk + ch0 + q * 4);
                const unsigned kw0 = k16[q >> 1][(q & 1) * 2], kw1 = k16[q >> 1][(q & 1) * 2 + 1], rw0 = r16[q >> 1][(q & 1) * 2], rw1 = r16[q >> 1][(q & 1) * 2 + 1], vw0 = v16[q >> 1][(q & 1) * 2], vw1 = v16[q >> 1][(q & 1) * 2 + 1];
                const f32x4 kf = (f32x4){bflo(kw0), bfhi(kw0), bflo(kw1), bfhi(kw1)}, rf = (f32x4){bflo(rw0), bfhi(rw0), bflo(rw1), bfhi(rw1)}, vf = (f32x4){bflo(vw0), bfhi(vw0), bflo(vw1), bfhi(vw1)};
                f32x4 ow, ok, ob, oa;
#pragma unroll
                for (int j = 0; j < 4; ++j) {
                    const float dec = fexp2(-0.60653066f * LOG2E * sigmoidf_(wp[j] + w0v[j]));
                    const float ar = sigmoidf_(ap[j] + a0v[j]);
                    const float kkn = kf[j] * kkv[j] * inv;
                    const float kd = kf[j] * (1.0f + (ar - 1.0f) * kav[j]);
                    ow[j] = dec; ok[j] = kd; ob[j] = kkn * ar; oa[j] = -kkn;
                    bon += rf[j] * kd * rkv[j];
                }
                *(LAS f32x4*)(sb + q * 16) = ow; *(LAS f32x4*)(sb + SC_VECB + q * 16) = ok; *(LAS f32x4*)(sb + 2 * SC_VECB + q * 16) = ob;
                *(LAS f32x4*)(sb + 3 * SC_VECB + q * 16) = oa; *(LAS f32x4*)(sb + 4 * SC_VECB + q * 16) = rf; *(LAS f32x4*)(sb + 5 * SC_VECB + q * 16) = vf;
            }
            bon = quad_sum(bon);
            if (cq == 0) P.BON[((size_t)z * M + m0 + row) * 16 + h] = bon;
            asm volatile("s_waitcnt lgkmcnt(0)" ::: "memory");
        };
        if (par == 0) { do_load(0); do_compute(0); } else do_load(1);
        __builtin_amdgcn_s_barrier();
        for (int e = 0; e < T / 16; ++e) {
            if (((e + 1) & 1) == par) { if (e + 1 < T / 16) do_compute(e + 1); }
            else { if (e + 2 < T / 16) do_load(e + 2); }
            __builtin_amdgcn_s_barrier();
        }
    }
}


constexpr int CS_AT = 0, CS_RT = 2304, CS_BK = 4608, CS_SMQ = 9728, CS_SMT = 11008, CS_NQ = 12288, CS_VT = 13568, CS_GL = 16640, CS_BUF = 16896;
constexpr int CS_PZ = 6 * CS_BUF;
constexpr int CS_W = CS_PZ + 4 * 4608;
constexpr int CS_WSZ = 4864;
constexpr int CS_BON = CS_W + 8 * CS_WSZ;
constexpr int CS_NS = CS_BON + 1536;
static_assert(CS_NS + 2048 + 16 <= LDS_MISC, "chunked-scan LDS map");
template <int CTRL> DI float dpp_mov0(float v) { return __builtin_bit_cast(float, __builtin_amdgcn_update_dpp(0, __builtin_bit_cast(int, v), CTRL, 0xF, 0xF, false)); }
DI float row_prefix(float v) { v += dpp_mov0<0x111>(v); v += dpp_mov0<0x112>(v); v += dpp_mov0<0x114>(v); v += dpp_mov0<0x118>(v); return v; }
DI float row_suffix(float v) { v += dpp_mov0<0x101>(v); v += dpp_mov0<0x102>(v); v += dpp_mov0<0x104>(v); v += dpp_mov0<0x108>(v); return v; }
DI bf16x8 lds16(const LAS unsigned char* p) { return *(const LAS bf16x8*)p; }
DI f32x4 mfma16(bf16x8 a, bf16x8 b, f32x4 c) { return __builtin_amdgcn_mfma_f32_16x16x32_bf16(a, b, c, 0, 0, 0); }

DI void scan_pair_mfma(const Frame& F0, int bh, const ScanPtrs& P) {
    const Frame F = fresh(F0);
    const int b = bh >> 4, h = bh & 15;
    const int z = F.wave >> 2, q4 = F.wave & 3;
    const int l15 = F.lane & 15, l4 = F.lane >> 4;
    const int te = l15, cg = l4, c4 = cg * 4;
    const int rr = z ? 15 - te : te;
    const int jl = 16 * q4 + c4;
    const int chq = h * 64 + 16 * q4;
    LAS unsigned char* const L = F.lds;
    LAS unsigned char* const wsc = L + CS_W + F.wave * CS_WSZ;
    LAS float* const scrW = (LAS float*)wsc; LAS float* const scrA = scrW + 16 * 20;
    LAS unsigned char* const ZB = wsc; LAS unsigned char* const XB = wsc + 2304; LAS unsigned char* const UB = wsc + 3072;
    LAS float* const yst = (LAS float*)(wsc + 3840);
    LAS float* const bonp = (LAS float*)(L + CS_BON);
    bf16* Y = z ? P.YB : P.YF;
    const bf16* w2p = P.W2T + (size_t)z * 65536 + (size_t)(chq + l15) * 64 + 8 * l4;
    bf16x8 Wf[2], Af[2];
#pragma unroll
    for (int ks = 0; ks < 2; ++ks) { Wf[ks] = *(const bf16x8*)(w2p + ks * 32); Af[ks] = *(const bf16x8*)(w2p + 2 * 65536 + ks * 32); }
    const f32x4 w0v = *(const f32x4*)(P.w0 + z * 1024 + chq + c4), a0v = *(const f32x4*)(P.a0 + z * 1024 + chq + c4);
    const f32x4 kkv = *(const f32x4*)(P.kk + chq + c4), kav = *(const f32x4*)(P.ka + chq + c4), rkv = *(const f32x4*)(P.rk + chq + c4);
    f32x4 kcn[4];
#pragma unroll
    for (int q = 0; q < 4; ++q) kcn[q] = *(const f32x4*)(P.kk + h * 64 + 16 * cg + q * 4);
    f32x4 Z[4];
#pragma unroll
    for (int jt = 0; jt < 4; ++jt) { const float zq = ozero(); Z[jt] = (f32x4){zq, zq, zq, zq}; }
    bf16x8 Ahw[2], Aha[2]; u32x2 r4, k4, v4; u32x4 kfull[2];
    auto do_load = [&](int c) {
        const int t0c = z ? T - 16 * (c + 1) : 16 * c; const size_t m0 = (size_t)b * T + t0c;
#pragma unroll
        for (int ks = 0; ks < 2; ++ks) { const bf16* p = P.HD1 + (m0 + l15) * 256 + z * 64 + 32 * ks + 8 * l4; Ahw[ks] = *(const bf16x8*)p; Aha[ks] = *(const bf16x8*)(p + 128); }
        const size_t off = (m0 + rr) * 1024;
        r4 = *(const u32x2*)(P.R + off + chq + c4); k4 = *(const u32x2*)(P.K + off + chq + c4); v4 = *(const u32x2*)(P.V + off + chq + c4);
        kfull[0] = ((const u32x4*)(P.K + off + h * 64 + 16 * cg))[0]; kfull[1] = ((const u32x4*)(P.K + off + h * 64 + 16 * cg))[1];
    };
    auto prep_a = [&](int c) {
        LAS unsigned char* const bp = L + (z * 3 + c % 3) * CS_BUF;
        LAS unsigned char* const pz = L + CS_PZ + (z * 2 + (c & 1)) * 4608;
        const float zq = ozero(); f32x4 dw = (f32x4){zq, zq, zq, zq}, da = dw;
#pragma unroll
        for (int ks = 0; ks < 2; ++ks) { dw = mfma16(Ahw[ks], Wf[ks], dw); da = mfma16(Aha[ks], Af[ks], da); }
#pragma unroll
        for (int rg = 0; rg < 4; ++rg) { scrW[(4 * l4 + rg) * 20 + l15] = dw[rg]; scrA[(4 * l4 + rg) * 20 + l15] = da[rg]; }
        float ssq = 0.f;
#pragma unroll
        for (int q = 0; q < 2; ++q)
#pragma unroll
            for (int w = 0; w < 4; ++w) { const float k0 = bflo(kfull[q][w]) * kcn[q * 2 + (w >> 1)][(w & 1) * 2], k1 = bfhi(kfull[q][w]) * kcn[q * 2 + (w >> 1)][(w & 1) * 2 + 1]; ssq += k0 * k0 + k1 * k1; }
        ssq += swz_xor<16>(ssq); ssq = half_sum(ssq);
        const float inv = __builtin_amdgcn_rsqf(fmaxf(ssq, 1e-24f));
        asm volatile("s_waitcnt lgkmcnt(0)" ::: "memory");
        const f32x4 wp = *(const LAS f32x4*)(scrW + rr * 20 + c4), ap = *(const LAS f32x4*)(scrA + rr * 20 + c4);
        const f32x4 kf = (f32x4){bflo(k4.x), bfhi(k4.x), bflo(k4.y), bfhi(k4.y)}, rf = (f32x4){bflo(r4.x), bfhi(r4.x), bflo(r4.y), bfhi(r4.y)}, vf = (f32x4){bflo(v4.x), bfhi(v4.x), bflo(v4.y), bfhi(v4.y)};
        f32x4 at, rt, bt, kt, bhh, khh, gl; float bon = 0.f;
#pragma unroll
        for (int j = 0; j < 4; ++j) {
            const float lw = -0.60653066f * LOG2E * sigmoidf_(wp[j] + w0v[j]);
            const float ar = sigmoidf_(ap[j] + a0v[j]);
            const float kkn = kf[j] * kkv[j] * inv;
            const float kd = kf[j] * (1.0f + (ar - 1.0f) * kav[j]);
            const float bvec = kkn * ar, avec = -kkn;
#ifdef MK_LDSPREFIX
            scrW[te * 20 + c4 + j] = lw;
            asm volatile("s_waitcnt lgkmcnt(0)" ::: "memory");
            float pi = 0.f, su = 0.f;
            for (int s2 = 0; s2 < 16; ++s2) { const float x = scrW[s2 * 20 + c4 + j]; if (s2 <= te) pi += x; else su += x; }
            asm volatile("s_waitcnt lgkmcnt(0)" ::: "memory");
#else
            const float pi = row_prefix(lw), su = row_suffix(lw) - lw;
#endif
            const float eI = fexp2(pi), eE = fexp2(pi - lw), eN = frcp(eI), eS = fexp2(su);
            at[j] = avec * eE; rt[j] = rf[j] * eI; bt[j] = bvec * eN; kt[j] = kd * eN; bhh[j] = bvec * eS; khh[j] = kd * eS; gl[j] = eI * eS;
            bon += rf[j] * kd * rkv[j];
        }
        const int co = jl * 2;
        { u32x2 w; w.x = pk2(at[0], at[1]); w.y = pk2(at[2], at[3]); *(LAS u32x2*)(bp + CS_AT + te * 144 + co) = w; }
        { u32x2 w; w.x = pk2(rt[0], rt[1]); w.y = pk2(rt[2], rt[3]); *(LAS u32x2*)(bp + CS_RT + te * 144 + co) = w; }
        { u32x2 w; w.x = pk2(bt[0], bt[1]); w.y = pk2(bt[2], bt[3]); *(LAS u32x2*)(pz + te * 144 + co) = w; }
        { u32x2 w; w.x = pk2(kt[0], kt[1]); w.y = pk2(kt[2], kt[3]); *(LAS u32x2*)(pz + 2304 + te * 144 + co) = w; }
#pragma unroll
        for (int j = 0; j < 4; ++j) {
            const unsigned bk = pk2(bhh[j], khh[j]);
            *(LAS bf16*)(bp + CS_BK + (jl + j) * 80 + te * 2) = (bf16)(bk & 0xffffu);
            *(LAS bf16*)(bp + CS_BK + (jl + j) * 80 + 32 + te * 2) = (bf16)(bk >> 16);
        }
        *(LAS bf16*)(bp + CS_VT + (jl + 0) * 48 + te * 2) = (bf16)(v4.x & 0xffffu); *(LAS bf16*)(bp + CS_VT + (jl + 1) * 48 + te * 2) = (bf16)(v4.x >> 16);
        *(LAS bf16*)(bp + CS_VT + (jl + 2) * 48 + te * 2) = (bf16)(v4.y & 0xffffu); *(LAS bf16*)(bp + CS_VT + (jl + 3) * 48 + te * 2) = (bf16)(v4.y >> 16);
        if (te == 0) *(LAS f32x4*)(bp + CS_GL + jl * 4) = gl;
        bon += swz_xor<16>(bon); bon = half_sum(bon);
        if (cg == 0) bonp[((z * 3 + c % 3) * 4 + q4) * 16 + rr] = bon;
    };
    LAS float* const nsm = (LAS float*)(L + CS_NS + z * 1024);
    volatile LAS unsigned* const nflag = (volatile LAS unsigned*)(L + CS_NS + 2048 + z * 8);
    auto prep_b1 = [&](int c) {
        LAS unsigned char* const bp = L + (z * 3 + c % 3) * CS_BUF;
        const LAS unsigned char* const pz = L + CS_PZ + (z * 2 + (c & 1)) * 4608;
        const int r32 = F.lane & 31, hf = F.lane >> 5;
        const LAS unsigned char* pa = (r32 < 16 ? bp + CS_AT + r32 * 144 : bp + CS_RT + (r32 - 16) * 144) + 16 * hf;
        const LAS unsigned char* pb = (r32 < 16 ? pz + r32 * 144 : pz + 2304 + (r32 - 16) * 144) + 16 * hf;
        f32x16 Dm;
#pragma unroll
        for (int i = 0; i < 16; ++i) Dm[i] = 0.f;
#pragma unroll
        for (int ks = 0; ks < 4; ++ks) Dm = __builtin_amdgcn_mfma_f32_32x32x16_bf16(lds16(pa + 32 * ks), lds16(pb + 32 * ks), Dm, 0, 0, 0);
        const int sc = r32 & 15;
#pragma unroll
        for (int reg = 0; reg < 8; ++reg) { if (r32 < 16) nsm[crow(reg, hf) * 16 + r32] = Dm[reg]; }
        asm volatile("s_waitcnt lgkmcnt(0)" ::: "memory");
        if (F.lane == 0) *nflag = (unsigned)(c + 1);
#pragma unroll
        for (int reg = 0; reg < 8; reg += 2) { const int t = crow(reg, hf);
            if (r32 >= 16) { const unsigned w = pk2(sc < t ? Dm[reg] : 0.f, sc < t + 1 ? Dm[reg + 1] : 0.f);
                *(LAS bf16*)(bp + CS_SMQ + t * 80 + sc * 2) = (bf16)(w & 0xffffu); *(LAS bf16*)(bp + CS_SMQ + (t + 1) * 80 + sc * 2) = (bf16)(w >> 16); } }
#pragma unroll
        for (int reg = 8; reg < 16; reg += 2) { const int t = crow(reg, hf) - 16;
            const unsigned w = pk2(sc <= t ? Dm[reg] : 0.f, sc <= t + 1 ? Dm[reg + 1] : 0.f);
            *(LAS bf16*)(bp + CS_NQ + t * 80 + r32 * 2) = (bf16)(w & 0xffffu); *(LAS bf16*)(bp + CS_NQ + (t + 1) * 80 + r32 * 2) = (bf16)(w >> 16); }
    };
    auto prep_b2 = [&](int c) {
        LAS unsigned char* const bp = L + (z * 3 + c % 3) * CS_BUF;
        const int sc = F.lane & 15;
        while (*nflag != (unsigned)(c + 1)) __builtin_amdgcn_s_sleep(1);
        asm volatile("" ::: "memory");
        float Tr[16];
        f32x4 nr[2][4];
#pragma unroll
        for (int r = 0; r < 2; ++r)
#pragma unroll
            for (int q = 0; q < 4; ++q) nr[r][q] = (4 * q < r) ? *(const LAS f32x4*)(nsm + r * 16 + q * 4) : (f32x4){0.f, 0.f, 0.f, 0.f};
#pragma unroll
        for (int t = 0; t < 16; ++t) {
            float acc = (sc == t) ? 1.0f : 0.0f, acc1 = 0.f;
#pragma unroll
            for (int s2 = 0; s2 < t; ++s2) { const float n = nr[t & 1][s2 >> 2][s2 & 3];
                if ((s2 & 1) == 0) acc = __builtin_fmaf(n, Tr[s2], acc); else acc1 = __builtin_fmaf(n, Tr[s2], acc1); }
            acc += acc1;
            Tr[t] = acc;
            if (t + 2 < 16) {
#pragma unroll
                for (int q = 0; q < 4; ++q) if (4 * q < t + 2) nr[t & 1][q] = *(const LAS f32x4*)(nsm + (t + 2) * 16 + q * 4);
            }
            if ((t & 1) && F.lane < 16) { const unsigned w = pk2(Tr[t - 1], acc);
                *(LAS bf16*)(bp + CS_SMT + (t - 1) * 80 + sc * 2) = (bf16)(w & 0xffffu); *(LAS bf16*)(bp + CS_SMT + t * 80 + sc * 2) = (bf16)(w >> 16); }
        }
    };
    auto stage_s = [&](int c) {
        const LAS unsigned char* const bp = L + (z * 3 + c % 3) * CS_BUF;
        const int q = l4, i = l15;
#pragma unroll
        for (int jt = 0; jt < 4; ++jt) { u32x2 w; w.x = pk2(Z[jt][0], Z[jt][1]); w.y = pk2(Z[jt][2], Z[jt][3]); *(LAS u32x2*)(ZB + i * 144 + (16 * jt + 4 * q) * 2) = w; }
        asm volatile("" ::: "memory");
        const bf16x8 Zb0 = lds16(ZB + i * 144 + (8 * q) * 2), Zb1 = lds16(ZB + i * 144 + (32 + 8 * q) * 2);
        const bf16x8 Vb = lds16(bp + CS_VT + (16 * q4 + i) * 48 + 8 * (q & 1) * 2);
        const LAS unsigned char* arow = bp + l15 * 144 + 8 * q * 2;
        const float zq = ozero(); const f32x4 zero = (f32x4){zq, zq, zq, zq};
        f32x4 X = mfma16(lds16(arow + CS_AT), Zb0, zero); f32x4 Yv = mfma16(lds16(arow + CS_RT), Zb0, zero);
        X = mfma16(lds16(arow + CS_AT + 64), Zb1, X); Yv = mfma16(lds16(arow + CS_RT + 64), Zb1, Yv);
        X = mfma16(lds16(bp + CS_SMQ + l15 * 80 + 16 * q), Vb, X);
        { u32x2 w; w.x = pk2(X[0], X[1]); w.y = pk2(X[2], X[3]); *(LAS u32x2*)(XB + i * 48 + 8 * q) = w; }
        asm volatile("" ::: "memory");
        const bf16x8 Xb = lds16(XB + i * 48 + 16 * (q & 1));
        const f32x4 U = mfma16(lds16(bp + CS_SMT + l15 * 80 + 16 * q), Xb, zero);
        { u32x2 w; w.x = pk2(U[0], U[1]); w.y = pk2(U[2], U[3]); *(LAS u32x2*)(UB + i * 48 + 8 * q) = w; }
        asm volatile("" ::: "memory");
        const bf16x8 Ub = lds16(UB + i * 48 + 16 * (q & 1));
        const bf16x8 UVb = q < 2 ? Ub : Vb;
        Yv = mfma16(lds16(bp + CS_NQ + l15 * 80 + 16 * q), UVb, Yv);
#pragma unroll
        for (int r = 0; r < 4; ++r) yst[(4 * q + r) * 16 + i] = Yv[r];
#pragma unroll
        for (int jt = 0; jt < 4; ++jt) { const f32x4 g = *(const LAS f32x4*)(bp + CS_GL + (16 * jt + 4 * q) * 4);
            Z[jt] = mfma16(lds16(bp + CS_BK + (16 * jt + l15) * 80 + 16 * q), UVb, Z[jt] * g); }
    };
    auto flush_y = [&](int c) {
        const int t0c = z ? T - 16 * (c + 1) : 16 * c; const int st = F.lane >> 2, i4 = (F.lane & 3) * 4;
        f32x4 yv = *(const LAS f32x4*)(yst + st * 16 + i4);
#ifdef MK_CLAMPY
        for (int j = 0; j < 4; ++j) yv[j] = (yv[j] == yv[j]) ? fminf(fmaxf(yv[j], -1.0e4f), 1.0e4f) : 0.f;
#endif
#ifdef MK_SCANCHECK
        { const u32x2 ref = *(const u32x2*)(Y + (size_t)(b * T + t0c + (z ? 15 - st : st)) * 1024 + chq + i4);
          const float r0 = bflo(ref.x), r1 = bfhi(ref.x), r2 = bflo(ref.y), r3 = bfhi(ref.y);
          float er = fmaxf(fmaxf(fabsf(yv.x - r0) / (fabsf(r0) + 1.0f), fabsf(yv.y - r1) / (fabsf(r1) + 1.0f)), fmaxf(fabsf(yv.z - r2) / (fabsf(r2) + 1.0f), fabsf(yv.w - r3) / (fabsf(r3) + 1.0f)));
          if (!(er == er)) er = 1.0e9f;
          atomicMax((unsigned*)(P.ERR + c), __float_as_uint(er)); }
#else
        u32x2 w; w.x = pk2(yv.x, yv.y); w.y = pk2(yv.z, yv.w);
        *(u32x2*)(Y + (size_t)(b * T + t0c + (z ? 15 - st : st)) * 1024 + chq + i4) = w;
#endif
    };
    auto bonus_flush = [&](int c) {
#ifdef MK_SCANCHECK
        return;
#endif
        if (q4 == 0 && F.lane < 16) {
            const int t0c = z ? T - 16 * (c + 1) : 16 * c; const size_t m0 = (size_t)b * T + t0c;
            const LAS float* qq = bonp + (z * 3 + c % 3) * 64 + F.lane;
            P.BON[((size_t)z * M + m0 + F.lane) * 16 + h] = (qq[0] + qq[16]) + (qq[32] + qq[48]);
        }
    };
    __syncthreads();
    for (int e = F.tid; e < 6 * 2 * 16 * 8; e += 512) { const int row = (e >> 3) & 15, tile = (e >> 7) & 1, zb = e >> 8, w = e & 7;
        *(LAS unsigned*)(L + zb * CS_BUF + (tile ? CS_SMT : CS_SMQ) + row * 80 + 32 + w * 4) = 0u; }
    const bool pa_wave = (q4 == z), pb_wave = (q4 == (z ^ 2));
    if (F.tid < 4) ((LAS unsigned*)(L + CS_NS + 2048))[F.tid] = 0u;
    constexpr int NC = T / 16;
    do_load(0); prep_a(0); do_load(1); prep_a(1);
    asm volatile("s_waitcnt lgkmcnt(0)" ::: "memory"); __builtin_amdgcn_s_barrier(); asm volatile("" ::: "memory");
    if (pa_wave) prep_b1(0);
    if (pb_wave) prep_b2(0);
    do_load(2);
    asm volatile("s_waitcnt lgkmcnt(0)" ::: "memory"); __builtin_amdgcn_s_barrier(); asm volatile("" ::: "memory");
#ifdef MK_TPROBE
    unsigned long long tpa[4] = {0ull, 0ull, 0ull, 0ull};
#define TP_T() __builtin_amdgcn_s_memtime()
#define TP_ACC(i, t0) tpa[i] += TP_T() - (t0)
#else
#define TP_T() 0ull
#define TP_ACC(i, t0) ((void)(t0))
#endif
    for (int e = 0; e < NC; ++e) {
        if (pa_wave && e + 1 < NC) prep_b1(e + 1);
        asm volatile("" ::: "memory");
        if (e > 0) flush_y(e - 1);
        if (e + 1 < NC) bonus_flush(e + 1);
        if (e == 0) bonus_flush(0);
#pragma unroll 1
        for (int st = 0; st < 2; ++st) {
            if ((st ^ z) == 0) {
                if (e + 2 < NC) prep_a(e + 2);
                asm volatile("" ::: "memory");
                if (e + 3 < NC) do_load(e + 3);
            } else {
                if (pb_wave && e + 1 < NC) prep_b2(e + 1);
                asm volatile("" ::: "memory");
                stage_s(e);
            }
            asm volatile("" ::: "memory");
        }
        asm volatile("s_waitcnt lgkmcnt(0)" ::: "memory");
        __builtin_amdgcn_s_barrier(); asm volatile("" ::: "memory");
    }
    flush_y(T / 16 - 1);
}

#define XB_TMO      128
#define XB_XCNT(j)  (256  + 64 * (j))
#define XB_XSUB(j)  (1280 + 64 * (j))
#define XB_XGEN(j)  (2304 + 64 * (j))
#define XB_TOP      3328
#define XB_TOPGEN   3392
#define XCD_BAR_WORDS 3456
#define XB_SPIN_CAP (1u << 22)
DI unsigned xb_ld(unsigned* p)              { return __hip_atomic_load(p, __ATOMIC_RELAXED, __HIP_MEMORY_SCOPE_AGENT); }
DI unsigned xb_add(unsigned* p, unsigned v) { return __hip_atomic_fetch_add(p, v, __ATOMIC_RELAXED, __HIP_MEMORY_SCOPE_AGENT); }
DI unsigned xb_xcc_id() { return (unsigned)__builtin_amdgcn_s_getreg((3 << 11) | 20) & 0xFu; }
#define XB_SPIN(cond, bar) do { unsigned _sp = 0; while (cond) { __builtin_amdgcn_s_sleep(1); \
    if ((++_sp & 255u) == 0u) { if (xb_ld(&(bar)[XB_TMO])) break; if (_sp > XB_SPIN_CAP) { atomicAdd(&(bar)[XB_TMO], 1u); break; } } } } while (0)
struct XcdBarrier { unsigned* bar; unsigned x; volatile LAS unsigned* st; };
DI XcdBarrier xcd_barrier_post(unsigned* bar, volatile LAS unsigned* st) {
    XcdBarrier b; b.bar = bar; b.x = xb_xcc_id(); b.st = st;
    if (threadIdx.x == 0) (void)xb_add(&bar[XB_XCNT(b.x)], 1u);
    return b;
}
DI void xcd_barrier_complete(unsigned* bar, unsigned x, unsigned& nloc, unsigned& nx) {
    const unsigned G = gridDim.x * gridDim.y * gridDim.z;
    unsigned sum, cnt, mine, sp = 0u;
    for (;;) {
        sum = 0u; cnt = 0u; mine = 0u;
#pragma unroll
        for (unsigned j = 0; j < 16; ++j) { const unsigned c = xb_ld(&bar[XB_XCNT(j)]); sum += c; cnt += (c > 0u) ? 1u : 0u; mine = (j == x) ? c : mine; }
        if (sum == G) break;
        __builtin_amdgcn_s_sleep(1);
        if ((++sp & 255u) == 0u) { if (xb_ld(&bar[XB_TMO])) break; if (sp > XB_SPIN_CAP) { atomicAdd(&bar[XB_TMO], 1u); break; } }
    }
    nloc = mine > 0u ? mine : 1u; nx = cnt > 0u ? cnt : 1u;
}
DI void xcd_barrier(const XcdBarrier& b) {
    asm volatile("s_waitcnt vmcnt(0)" ::: "memory");
    __syncthreads();
    if (threadIdx.x == 0) {
        unsigned* bar = b.bar;
        __builtin_amdgcn_s_waitcnt(0);
        unsigned nloc = b.st[0], nx = b.st[1];
        if (nloc == 0u) { xcd_barrier_complete(bar, b.x, nloc, nx); b.st[0] = nloc; b.st[1] = nx; }
        const unsigned old = xb_add(&bar[XB_XSUB(b.x)], 1u);
        const unsigned gen = old / nloc;
        if (old + 1u == (gen + 1u) * nloc) {
            __builtin_amdgcn_fence(__ATOMIC_RELEASE, "agent");
            asm volatile("s_waitcnt vmcnt(0)" ::: "memory");
            const unsigned og = xb_add(&bar[XB_TOP], 1u);
            const unsigned tg = og / nx;
            if (og + 1u == (tg + 1u) * nx) xb_add(&bar[XB_TOPGEN], 1u);
            else XB_SPIN(xb_ld(&bar[XB_TOPGEN]) == tg, bar);
            __builtin_amdgcn_fence(__ATOMIC_ACQUIRE, "agent");
            xb_add(&bar[XB_XGEN(b.x)], 1u);
            asm volatile("s_waitcnt vmcnt(0)" ::: "memory");
        } else {
            XB_SPIN(xb_ld(&bar[XB_XGEN(b.x)]) == gen, bar);
            __builtin_amdgcn_fence(__ATOMIC_ACQUIRE, "agent");
            asm volatile("s_waitcnt vmcnt(0)" ::: "memory");
        }
    }
    __syncthreads();
}

#ifndef MK_PROG
#ifdef MK_SCANCHECK
#define MK_PROG 0,1,2,3,4,5,7,8,10,11,12,13,14,25,15,16,17,19,20,22,23,24
#else
#define MK_PROG 0,3,4,5,7,8,10,11,12,13,14,15,17,19,20,22,23,24
#endif
#endif
__constant__ int PROG[] = {MK_PROG};
constexpr int NPH = sizeof(PROG) / sizeof(int);
template <int TYPE> struct PreSched {
    const bf16* KV; const bf16* W; int G, c;
    DI bool next(int i, Unit& u) const {
        const long L = (long)i * G + c; if (L >= 512) return false;
        const int rem = (int)L, i2 = rem >> 8, b = (rem >> 4) & 15, hh = (rem >> 2) & 3, t4 = rem & 3;
        u.pm = 0; u.pn = 0;
        const bf16* kvp = KV + (size_t)(b * 256) * 4096 + i2 * 2048 + hh * 256;
        const bf16* wp = W + (size_t)i2 * 1024 * 1024 + (size_t)(t4 * 256) * 1024 + hh * 256;
        if (TYPE == 0) { u.pa = (const char*)kvp; u.pb = (const char*)wp; u.z = (i2 << 30) | (b * 1048576 + hh * 256 * 1024 + t4 * 256); }
        else { u.pa = (const char*)wp; u.pb = (const char*)(kvp + 1024); u.z = (i2 << 30) | (16 * 1048576 + b * 1048576 + t4 * 256 * 1024 + hh * 256); }
        return true;
    }
};

__global__ void __launch_bounds__(512, 2) mk_fwd(Args a) {
    extern __shared__ __attribute__((aligned(16))) unsigned char lds_raw[];
    Frame F;
    F.lds = (LAS unsigned char*)lds_raw;
    F.tid = threadIdx.x; F.lane = F.tid & 63; F.wave = __builtin_amdgcn_readfirstlane(F.tid >> 6);
    F.gw = blockIdx.x * 8 + F.wave; F.ngw = gridDim.x * 8; F.ws = a.ws;
    cg::grid_group grid = cg::this_grid();
    volatile LAS unsigned* MISC = (volatile LAS unsigned*)(F.lds + LDS_MISC);
    if (F.tid < 2) MISC[F.tid] = 0u;
    __syncthreads();
    (void)xcd_barrier_post((unsigned*)(a.ws + WS_BAR), MISC);

    for (int pi = a.ph_lo; pi < a.ph_hi; ++pi) {
        const int ph = PROG[pi];
        const int G = opq(gridDim.x), cblk = opq(blockIdx.x);
        unsigned char* ws = a.ws + (size_t)opq(0);
        float* RS = (float*)(ws + WS_RS);
        bf16* SA = (bf16*)(ws + WS_SA); bf16* SB = (bf16*)(ws + WS_SB);
        bf16* H = (bf16*)a.out;
        const int li = ph >= 18 ? 1 : 0;
        int cp = ph; if (ph >= 18 && ph <= 23) cp = ph - 12;
#ifndef PH_MASK
#define PH_MASK 0xffffffffu
#endif
        if (!((PH_MASK >> cp) & 1u)) cp = 99;
        switch (cp) {
        case 0: phase_prologue(F, a, ws); break;
        case 3: {
            { pg8::PlainSched S{SA, (const bf16*)(ws + WS_WIN), 1024, 1024, M / 256, 8, G, cblk, 30, 0};
              EpiInProj E{(bf16*)(ws + WS_GLU), SB, RS};
              pg8::gemm_phase(F.lds, 1024, 1024, 1024, S, E); }
            { pg8::PlainSched S{(const bf16*)(ws + WS_WIN) + (size_t)2048 * 1024, SA, 1024, 1024, 2, M / 256, G, cblk, 30, 0};
              EpiVT E{(bf16*)(ws + WS_VT), RS};
              pg8::gemm_phase(F.lds, 1024, 1024, 1024, S, E); }
                    {

            pg8::PlainSched S{(const bf16*)(ws + WS_MEMB), (const bf16*)(ws + WS_WKV), 1024, 1024, MMEM / 256, 16, G, cblk, 30, 0};
            EpiRowScale<0> E{(bf16*)(ws + WS_KV), 4096, (const float*)(ws + WS_RSMEM), nullptr};
            pg8::gemm_phase(F.lds, 1024, 1024, 1024, S, E);
                    }
        } break;
        case 4: {
            const float lam = ((const float*)(ws + WS_LAM))[0];
#ifndef NO_ATTN
            for (int u = cblk; u < 1024; u += G) diffattn_unit(F, u, SB, (const bf16*)(ws + WS_VT), (const float*)(ws + WS_BIAS), lam, a.in[opq(I_SUBLN)], (bf16*)(ws + WS_MIX));
#endif
            __syncthreads();
#ifndef NO_CONV
            conv_load_weights(F, a.in[opq(I_CONVW)]);
            for (int u = cblk; u < 512; u += G) conv_unit(F, u, (const bf16*)(ws + WS_GLU), a.in[opq(I_CONVB)], a.in[opq(I_CLNG)], a.in[opq(I_CLNB)], (bf16*)(ws + WS_MIX));
#endif
            __syncthreads();
                    {

            EpiPre E{(bf16*)(ws + WS_G0)};
            { PreSched<0> S{(const bf16*)(ws + WS_KV), (const bf16*)(ws + WS_WQN), G, cblk}; pg8::gemm_phase(F.lds, 256, 4096, 1024, S, E); }
            { PreSched<1> S{(const bf16*)(ws + WS_KV), (const bf16*)(ws + WS_WXO), G, cblk}; pg8::gemm_phase(F.lds, 256, 1024, 4096, S, E); }
                    }
        } break;
        case 5: {
            pg8::PlainSched S{(const bf16*)(ws + WS_MIX), (const bf16*)(ws + WS_WOUT), 1024, 1024, M / 256, 4, G, cblk, 30, 0};
            EpiResid E{a.in[opq(I_X)], nullptr, H, (float*)(ws + WS_PS)};
            pg8::gemm_phase(F.lds, 1024, 1024, 1024, S, E);
        } break;
        case 7: {
            pg8::PlainSched S{H, (const bf16*)(ws + (li ? WS_G1 : WS_G0)), 1024, 1024, M / 256, 4, G, cblk, 3, (size_t)1048576};
            EpiSoftmax E{SB, (const float*)(ws + WS_PS)};
            pg8::gemm_phase(F.lds, 1024, 1024, 1024, S, E);
        } break;
        case 8: {
            pg8::PlainSched S{SB, (const bf16*)(ws + (li ? WS_VW1 : WS_VW0)), 1024, 1024, M / 256, 4, G, cblk, 3, (size_t)1048576};
            EpiResid E{nullptr, H, H, (float*)(ws + WS_PS)};
            pg8::gemm_phase(F.lds, 1024, 1024, 1024, S, E);
        } break;
        case 10: {
            pg8::PlainSched S{H, (const bf16*)(ws + WS_WUP) + (size_t)li * 4096 * 1024, 1024, 1024, M / 256, 16, G, cblk, 30, 0};
            EpiRowScale<2> E{(bf16*)(ws + WS_HID), 4096, nullptr, (const float*)(ws + WS_PS)};
            pg8::gemm_phase(F.lds, 1024, 1024, 1024, S, E);
        } break;
        case 11: {
            pg8::PlainSched S{(const bf16*)(ws + WS_HID), (const bf16*)(ws + WS_WDN) + (size_t)li * 1024 * 4096, 4096, 4096, M / 256, 4, G, cblk, 30, 0};
            EpiResid E{nullptr, H, li ? SA : H, nullptr};
            pg8::gemm_phase(F.lds, 4096, 4096, 4096, S, E);
        } break;
        case 12: phase_rwkv_shift(F, H, a.in[opq(I_NMIX)] + 1024, (bf16*)(ws + WS_A1)); break;
        case 13: {
            pg8::PlainSched S{(const bf16*)(ws + WS_A1), (const bf16*)(ws + WS_WBIG), 2048, 2048, M / 256, 14, G, cblk, 30, 0};
            EpiRwkv E{(bf16*)(ws + WS_R), (bf16*)(ws + WS_K), (bf16*)(ws + WS_V), (bf16*)(ws + WS_HD1), (bf16*)(ws + WS_HD2)};
            pg8::gemm_phase(F.lds, 2048, 2048, 2048, S, E);
        } break;
        case 14: {
            ScanPtrs P{(const bf16*)(ws + WS_R), (const bf16*)(ws + WS_K), (const bf16*)(ws + WS_V), (const bf16*)(ws + WS_HD1), (const bf16*)(ws + WS_W2T),
                       a.in[opq(I_W0)], a.in[opq(I_A0)], a.in[opq(I_KK)], a.in[opq(I_KA)], a.in[opq(I_RK)], (bf16*)(ws + WS_YF), (bf16*)(ws + WS_YB), (float*)(ws + WS_BONUS), (unsigned*)(ws + WS_BAR + 32768)};
#if defined(MK_SCAN_VALU) || defined(MK_SCANCHECK)
            for (int bh = cblk; bh < 256; bh += G) scan_pair(F, bh, P);
#else
            for (int bh = cblk; bh < 256; bh += G) scan_pair_mfma(F, bh, P);
#endif
            __syncthreads();
        } break;
#ifdef MK_SCANCHECK
        case 25: {
            ScanPtrs P{(const bf16*)(ws + WS_R), (const bf16*)(ws + WS_K), (const bf16*)(ws + WS_V), (const bf16*)(ws + WS_HD1), (const bf16*)(ws + WS_W2T),
                       a.in[opq(I_W0)], a.in[opq(I_A0)], a.in[opq(I_KK)], a.in[opq(I_KA)], a.in[opq(I_RK)], (bf16*)(ws + WS_YF), (bf16*)(ws + WS_YB), (float*)(ws + WS_BONUS), (unsigned*)(ws + WS_BAR + 32768)};
            for (int bh = cblk; bh < 256; bh += G) scan_pair_mfma(F, bh, P);
            __syncthreads();
        } break;
#endif
        case 15: {
            pg8::PlainSched S{(const bf16*)(ws + WS_HD2), (const bf16*)(ws + WS_G2T), 256, 256, M / 256, 4, G, cblk, 30, 0};
            EpiGateComb E{(const bf16*)(ws + WS_YF), (const bf16*)(ws + WS_YB), (const bf16*)(ws + WS_V), (const float*)(ws + WS_BONUS), a.in[opq(I_LNG)], a.in[opq(I_LNB)], (bf16*)(ws + WS_COMB)};
            pg8::gemm_phase(F.lds, 256, 256, 256, S, E);
        } break;
        case 16: phase_rwkv_comb(F, (const bf16*)(ws + WS_YF), (const bf16*)(ws + WS_YB), (const bf16*)(ws + WS_V), (const bf16*)(ws + WS_GATE), (const float*)(ws + WS_BONUS),
                                 a.in[opq(I_LNG)], a.in[opq(I_LNB)], (bf16*)(ws + WS_COMB)); break;
        case 17: {
            pg8::PlainSched S{(const bf16*)(ws + WS_COMB), (const bf16*)(ws + WS_WRO), 1024, 1024, M / 256, 4, G, cblk, 30, 0};
            EpiResid E{nullptr, H, H, (float*)(ws + WS_PS)};
            pg8::gemm_phase(F.lds, 1024, 1024, 1024, S, E);
        } break;
        case 24: {
            float osc = 1.0f;
#ifdef MK_SCANCHECK
            { const unsigned* ER = (const unsigned*)(ws + WS_BAR + 32768); int bad = -1;
              for (int c = 127; c >= 0; --c) if (__uint_as_float(__builtin_amdgcn_readfirstlane(__hip_atomic_load(ER + c, __ATOMIC_RELAXED, __HIP_MEMORY_SCOPE_AGENT))) > MK_SCANCHECK_TOL) bad = c;
              if (bad >= 0) osc = 1.0f + 0.03f * (float)(bad + 1); }
#endif
            phase_final_norm(F, SA, a.out, a.in[opq(I_NFINAL)], osc);
        } break;
        default: break;
        }
        if (pi + 1 < a.ph_hi) {
#ifdef MK_ALL_CG
            grid.sync();
#else
            if (a.ph_lo < 0) grid.sync();
            { XcdBarrier xb; xb.bar = (unsigned*)(ws + WS_BAR); xb.x = xb_xcc_id(); xb.st = (volatile LAS unsigned*)(F.lds + LDS_MISC); xcd_barrier(xb); }
#endif
        }
    }
}

extern "C" void kernel_launch(void* const* d_in, const int* in_sizes, int n_in, void* d_out, int out_size, void* d_ws, size_t ws_size, hipStream_t stream) {
    static int grid = 0;
    if (grid == 0) {
        if (n_in != N_IN || in_sizes[0] != M * D || out_size != M * D || ws_size < WS_NEED) {
            fprintf(stderr, "kernel_launch: unexpected problem (n_in %d, in0 %d, out %d, ws %zu); nothing launched\n", n_in, n_in > 0 ? in_sizes[0] : -1, out_size, ws_size); grid = -1; return; }
        int dev = 0, cus = 0, per_cu = 0;
        if (hipGetDevice(&dev) != hipSuccess || hipDeviceGetAttribute(&cus, hipDeviceAttributeMultiprocessorCount, dev) != hipSuccess) { grid = -1; return; }
        if (hipFuncSetAttribute((const void*)mk_fwd, hipFuncAttributeMaxDynamicSharedMemorySize, LDS_BYTES) != hipSuccess) { fprintf(stderr, "kernel_launch: hipFuncSetAttribute failed\n"); grid = -1; return; }
        if (hipOccupancyMaxActiveBlocksPerMultiprocessor(&per_cu, (const void*)mk_fwd, 512, LDS_BYTES) != hipSuccess || per_cu < 1) { fprintf(stderr, "kernel_launch: occupancy query says %d\n", per_cu); (void)hipGetLastError(); grid = -1; return; }
        grid = cus;
    }
    if (grid < 0) return;
    if (hipMemsetAsync((char*)d_ws + WS_BAR, 0, 65536, stream) != hipSuccess) { fprintf(stderr, "kernel_launch: memset failed\n"); return; }
    Args a{};
    for (int i = 0; i < N_IN; ++i) a.in[i] = (const float*)d_in[i];
    a.out = (float*)d_out; a.ws = (unsigned char*)d_ws;
#if MK_SINGLE
    a.ph_lo = 0; a.ph_hi = NPH;
    void* params[] = {&a};
    hipError_t e = hipLaunchCooperativeKernel((const void*)mk_fwd, dim3(grid), dim3(512), params, LDS_BYTES, stream);
    if (e != hipSuccess) fprintf(stderr, "kernel_launch: cooperative launch failed: %s\n", hipGetErrorString(e));
#else
    for (int ph = 0; ph < NPH; ++ph) { a.ph_lo = ph; a.ph_hi = ph + 1; hipLaunchKernelGGL(mk_fwd, dim3(grid), dim3(512), LDS_BYTES, stream, a); }
#endif
}
```

```cpp
#include <hip/hip_runtime.h>
#include <hip/hip_cooperative_groups.h>
#include <cstdio>
#include <cstdint>
namespace cg = cooperative_groups;

#ifndef MK_SINGLE
#define MK_SINGLE 1
#endif

#define LAS __attribute__((address_space(3)))
#define DI __device__ __forceinline__
typedef unsigned short bf16;
typedef short bf16x8 __attribute__((ext_vector_type(8)));
typedef short s16x4 __attribute__((ext_vector_type(4)));
typedef float f32x2 __attribute__((ext_vector_type(2)));
typedef float f32x4 __attribute__((ext_vector_type(4)));
typedef float f32x16 __attribute__((ext_vector_type(16)));
typedef unsigned u32x2 __attribute__((ext_vector_type(2)));
typedef unsigned u32x4 __attribute__((ext_vector_type(4)));

constexpr int D = 1024, NB = 16, T = 2048, M = NB * T, NMEM = 256, MMEM = NB * NMEM;
constexpr int FF = 4096;
constexpr float EPS = 1e-6f;
constexpr float LOG2E = 1.4426950408889634f;

constexpr size_t MiB = 1u << 20;
constexpr size_t WS_BAR = 0;
constexpr size_t WS_RS = 64 * 1024;
constexpr size_t WS_RSMEM = WS_RS + M * 4;
constexpr size_t WS_BIAS = WS_RSMEM + MMEM * 4;
constexpr size_t WS_LAM = WS_BIAS + 4 * 4096 * 4;
constexpr size_t WS_WIN = 1 * MiB;
constexpr size_t WS_WOUT = WS_WIN + 5 * MiB;
constexpr size_t WS_WQN = WS_WOUT + 2 * MiB;
constexpr size_t WS_WKV = WS_WQN + 4 * MiB;
constexpr size_t WS_WXO = WS_WKV + 8 * MiB;
constexpr size_t WS_WUP = WS_WXO + 4 * MiB;
constexpr size_t WS_WDN = WS_WUP + 16 * MiB;
constexpr size_t WS_WBIG = WS_WDN + 16 * MiB;
constexpr size_t WS_WLORA = WS_WBIG + 6 * MiB;
constexpr size_t WS_W2T = WS_WBIG + 14 * MiB;
constexpr size_t WS_G2T = WS_W2T + 512 * 1024;
constexpr size_t WS_WRO = WS_G2T + 512 * 1024;
constexpr size_t WS_WEND = WS_WRO + 2 * MiB;
static_assert(WS_WEND == 73 * MiB, "weight map");
constexpr size_t WS_SA = 73 * MiB;
constexpr size_t WS_SB = 137 * MiB;
constexpr size_t WS_GLU = 201 * MiB;
constexpr size_t WS_VT = 233 * MiB;
constexpr size_t WS_MIX = 265 * MiB;
constexpr size_t WS_G0 = 329 * MiB;
constexpr size_t WS_VW0 = 361 * MiB;
constexpr size_t WS_MEMB = 393 * MiB;
constexpr size_t WS_KV = 401 * MiB;
constexpr size_t WS_G1 = 433 * MiB;
constexpr size_t WS_VW1 = 465 * MiB;
static_assert(WS_G1 - WS_G0 == 104 * MiB && WS_VW0 - WS_G0 == 32 * MiB && WS_VW1 - WS_G1 == 32 * MiB, "G / VW spacing used by EpiPre");
constexpr size_t WS_BONUS = 497 * MiB;
constexpr size_t WS_PS = 502 * MiB;
constexpr size_t WS_HID = 137 * MiB;
constexpr size_t WS_XR = 73 * MiB, WS_HH = 137 * MiB, WS_XV = 201 * MiB;
constexpr size_t WS_R = 201 * MiB, WS_K = 265 * MiB, WS_V = 329 * MiB;
static_assert(WS_K - WS_R == 64 * MiB && WS_V - WS_K == 64 * MiB, "r, k, v spacing used by EpiRwkv");
constexpr size_t WS_HD1 = 393 * MiB;
constexpr size_t WS_HD2 = 409 * MiB;
constexpr size_t WS_YF = 73 * MiB, WS_YB = 137 * MiB;
constexpr size_t WS_GATE = 265 * MiB;
constexpr size_t WS_COMB = 201 * MiB;
constexpr size_t WS_NEED = 512 * MiB;

constexpr int LDS_X = 131072;
constexpr int LDS_MISC = 163840 - 256;
constexpr int LDS_BYTES = 163840;

DI unsigned f2bf(float f) { unsigned u = __builtin_bit_cast(unsigned, f); return (u + 0x7fffu + ((u >> 16) & 1u)) >> 16; }
typedef __bf16 bf16x2v __attribute__((ext_vector_type(2)));
DI unsigned pk2(float lo, float hi) { const f32x2 v = {lo, hi}; return __builtin_bit_cast(unsigned, __builtin_convertvector(v, bf16x2v)); }
DI float bf2f(unsigned short b) { return __builtin_bit_cast(float, ((unsigned)b) << 16); }
DI float bflo(unsigned w) { return __builtin_bit_cast(float, w << 16); }
DI float bfhi(unsigned w) { return __builtin_bit_cast(float, w & 0xffff0000u); }
template <int MASK> DI float swz_xor(float v) { return __builtin_bit_cast(float, __builtin_amdgcn_ds_swizzle(__builtin_bit_cast(int, v), (MASK << 10) | 0x1f)); }
DI float half_sum(float v) { const int x = __builtin_bit_cast(int, v); const auto r = __builtin_amdgcn_permlane32_swap(x, x, false, false); return __builtin_bit_cast(float, (int)r[0]) + __builtin_bit_cast(float, (int)r[1]); }
DI float half_max(float v) { const int x = __builtin_bit_cast(int, v); const auto r = __builtin_amdgcn_permlane32_swap(x, x, false, false); return fmaxf(__builtin_bit_cast(float, (int)r[0]), __builtin_bit_cast(float, (int)r[1])); }
DI float wave_sum(float v) {
    v += swz_xor<1>(v); v += swz_xor<2>(v); v += swz_xor<4>(v); v += swz_xor<8>(v); v += swz_xor<16>(v); v = half_sum(v);
    return v;
}
DI float ozero() { float z; asm volatile("v_mov_b32 %0, 0" : "=v"(z)); return z; }
DI int opaque(int x) { asm volatile("" : "+v"(x)); return x; }
template <class Tp> DI Tp* opq_ptr(Tp* p) { asm volatile("" : "+s"(p)); return p; }
DI int opq(int x) { asm volatile("" : "+s"(x)); return x; }
DI float fexp2(float x) { return __builtin_amdgcn_exp2f(x); }
DI float frcp(float x) { return __builtin_amdgcn_rcpf(x); }
DI float sigmoidf_(float x) { return frcp(1.0f + fexp2(-x * LOG2E)); }
DI float tanhf_(float x) { float e = fexp2(-2.0f * LOG2E * fabsf(x)); float t = (1.0f - e) * frcp(1.0f + e); return x < 0.f ? -t : t; }

namespace pg8 {
constexpr int BM = 256, BK = 64, HALF = 128, HTB = HALF * BK * 2, STAGE_BYTES = 8 * HTB, NXCD = 8, WGM = 8;
DI int lds_byte(int r, int c) { const int st = (r >> 4) * 2 + (c >> 5), rr = r & 15, cc = c & 31, ob = rr * 64 + cc * 2; return st * 1024 + (ob ^ (((ob >> 9) & 1) << 5)); }
DI void stage_rc(int b, int& R, int& C) { const int st = b / 1024, sb = b % 1024, swz = sb ^ (((sb >> 9) & 1) << 5); R = (st >> 1) * 16 + swz / 64; C = (st & 1) * 32 + (swz % 64) / 2; }
DI int perm32(int rho) { const int n = rho >> 4, i = rho & 15; return 8 * (i >> 2) + 4 * n + (i & 3); }

struct Unit { int pm, pn, z; const char* pa; const char* pb; };

DI bool tile_order(long L, int nM, int nN, int& pm, int& pn) {
    const int nwg = nM * nN; if (L >= nwg) return false;
    int wgid = (int)L; { const int q = nwg / NXCD, r = nwg % NXCD, xcd = wgid % NXCD, off = wgid / NXCD; wgid = (xcd < r ? xcd * (q + 1) : r * (q + 1) + (xcd - r) * q) + off; }
    const int nig = WGM * nN, gid = wgid / nig, fm = gid * WGM, gsz = (nM - fm) < WGM ? (nM - fm) : WGM;
    pm = fm + ((wgid % nig) % gsz); pn = (wgid % nig) / gsz; return true;
}
struct PlainSched {
    static constexpr int AJT = 1 << 30; static constexpr size_t ajump = 0;
    const bf16* A; const bf16* Bt; int lda, ldb, nM, nN, G, c, bshift; size_t bstride;
    DI bool next(int i, Unit& u) const {
        if (!tile_order((long)i * G + c, nM, nN, u.pm, u.pn)) return false;
        u.z = u.pm >> bshift;
        u.pa = (const char*)(A + (size_t)u.pm * 256 * lda);
        u.pb = (const char*)(Bt + (size_t)u.z * bstride + (size_t)u.pn * 256 * ldb);
        return true;
    }
};

template <int PN0, int AJT_> struct SelSched {
    static constexpr int AJT = AJT_;
    const bf16* A0; const bf16* A1; const bf16* Bt; int lda, ldb, nM, nN, split, G, c; size_t ajump;
    DI bool next(int i, Unit& u) const {
        int pn; if (!tile_order((long)i * G + c, nM, nN, u.pm, pn)) return false;
        u.z = 0; u.pn = pn + PN0;
        u.pa = (const char*)((pn < split ? A0 : A1) + (size_t)u.pm * 256 * lda);
        u.pb = (const char*)(Bt + (size_t)pn * 256 * ldb);
        return true;
    }
};
DI unsigned cvt_pk_bf16(float lo, float hi) { return pk2(lo, hi); }

template <class Epi, class Sched>
DI void gemm_phase(LAS unsigned char* lds, const int K, const int lda, const int ldb, const Sched& S, const Epi& E) {
    const int tid = opaque(threadIdx.x), wid = __builtin_amdgcn_readfirstlane(tid >> 6), lane = tid & 63, wr = wid >> 2, wc = wid & 3, fr = lane & 15, fq = lane >> 4;
    const int nt = K / BK;
    unsigned voffA[2], voffB[2];
#pragma unroll
    for (int i = 0; i < 2; ++i) { int R, C; stage_rc(tid * 16 + i * 8192, R, C); const int Rb = Epi::PERM ? ((R & ~31) + perm32(R & 31)) : R;
        voffA[i] = (unsigned)(R * lda + C) * 2u; voffB[i] = (unsigned)(Rb * ldb + C) * 2u; }
    const size_t kstep = (size_t)(BK * 2);
    const size_t hstepA = (size_t)HALF * lda * 2, hstepB = (size_t)HALF * ldb * 2;
    const unsigned ldsw = (unsigned)wid * 1024u;
    const int aoff = lds_byte(wr * 64 + fr, fq * 8), boff = lds_byte(wc * 32 + fr, fq * 8);
#define PG8_SA(b, h) (((b) * 2 + (h)) * HTB)
#define PG8_SB(b, h) ((4 + (b) * 2 + (h)) * HTB)
#define PG8_STAGE(bufoff, gbase, voff) do { _Pragma("unroll") for (int _i = 0; _i < 2; ++_i) \
        __builtin_amdgcn_global_load_lds((const unsigned*)((const char*)(gbase) + (voff)[_i]), (LAS unsigned*)(lds + (bufoff) + ldsw + _i * 8192), 16, 0, 0); } while (0)
#define PG8_LDA(dst, b, h) do { _Pragma("unroll") for (int m = 0; m < 4; ++m) _Pragma("unroll") for (int k = 0; k < 2; ++k) dst[m][k] = *(const LAS bf16x8*)(lds + PG8_SA(b, h) + aoff + m * 2048 + k * 1024); } while (0)
#define PG8_LDB(dst, b, h) do { _Pragma("unroll") for (int n = 0; n < 2; ++n) _Pragma("unroll") for (int k = 0; k < 2; ++k) dst[n][k] = *(const LAS bf16x8*)(lds + PG8_SB(b, h) + boff + n * 2048 + k * 1024); } while (0)
#define PG8_MMA(ai, bj, At, Bt) do { __builtin_amdgcn_s_setprio(1); _Pragma("unroll") for (int m = 0; m < 4; ++m) _Pragma("unroll") for (int n = 0; n < 2; ++n) _Pragma("unroll") for (int k = 0; k < 2; ++k) \
        acc[ai][bj][m][n] = __builtin_amdgcn_mfma_f32_16x16x32_bf16(Bt[n][k], At[m][k], acc[ai][bj][m][n], 0, 0, 0); __builtin_amdgcn_s_setprio(0); } while (0)
#define PG8_WAIT_V(n) asm volatile("s_waitcnt vmcnt(" #n ")" ::: "memory")
#define PG8_WAIT_L(n) asm volatile("s_waitcnt lgkmcnt(" #n ")" ::: "memory")
#define PG8_BAR __builtin_amdgcn_s_barrier()
#define PG8_SCHED __builtin_amdgcn_sched_barrier(0)
    Unit cur, nxt; int ui = 0;
    if (!S.next(0, cur)) return;
    f32x4 acc[2][2][4][2];
    { const float z0 = ozero();
#pragma unroll
    for (int a = 0; a < 2; ++a)
#pragma unroll
        for (int b = 0; b < 2; ++b)
#pragma unroll
            for (int m = 0; m < 4; ++m)
#pragma unroll
                for (int n = 0; n < 2; ++n) acc[a][b][m][n] = (f32x4){z0, z0, z0, z0}; }
    bf16x8 At[4][2], B0[2][2], B1[2][2];
    const char* cA = cur.pa; const char* cB = cur.pb;
    PG8_STAGE(PG8_SB(0, 0), cB, voffB); PG8_STAGE(PG8_SB(0, 1), cB + hstepB, voffB); PG8_STAGE(PG8_SA(0, 0), cA, voffA); PG8_STAGE(PG8_SA(0, 1), cA + hstepA, voffA);
    if (wr == 1) PG8_BAR;
    PG8_WAIT_V(2); PG8_BAR;
    PG8_STAGE(PG8_SB(1, 0), cB + kstep, voffB); PG8_STAGE(PG8_SA(1, 0), cA + kstep, voffA); PG8_STAGE(PG8_SB(1, 1), cB + hstepB + kstep, voffB);
    PG8_WAIT_V(6); PG8_BAR;
    for (;;) {
        const bool has_next = S.next(ui + 1, nxt);
        const char* nA = has_next ? nxt.pa : cA; const char* nB = has_next ? nxt.pb : cB;
#pragma unroll 1
        for (int t = 0; t < nt; t += 2) {
            const bool last = (t == nt - 2);
            const char* a1 = cA + (size_t)(t + 1) * kstep + (t + 1 >= Sched::AJT ? S.ajump : (size_t)0);
            const char* a2 = last ? nA : cA + (size_t)(t + 2) * kstep + (t + 2 >= Sched::AJT ? S.ajump : (size_t)0); const char* b2 = last ? nB : cB + (size_t)(t + 2) * kstep;
            const char* a3 = a2 + kstep; const char* b3 = b2 + kstep;
            PG8_LDB(B0, 0, 0); PG8_LDB(B1, 0, 1); PG8_SCHED; PG8_LDA(At, 0, 0); PG8_STAGE(PG8_SA(1, 1), a1 + hstepA, voffA);
            PG8_WAIT_V(8); PG8_WAIT_L(0); PG8_BAR; PG8_MMA(0, 0, At, B0); PG8_MMA(0, 1, At, B1); PG8_BAR; PG8_SCHED;
            PG8_LDA(At, 0, 1); PG8_STAGE(PG8_SB(0, 0), b2, voffB); PG8_STAGE(PG8_SB(0, 1), b2 + hstepB, voffB); PG8_STAGE(PG8_SA(0, 0), a2, voffA);
            PG8_WAIT_V(8); PG8_WAIT_L(0); PG8_BAR; PG8_MMA(1, 0, At, B0); PG8_MMA(1, 1, At, B1); PG8_BAR; PG8_SCHED;
            PG8_LDB(B0, 1, 0); PG8_LDB(B1, 1, 1); PG8_SCHED; PG8_LDA(At, 1, 0); PG8_STAGE(PG8_SA(0, 1), a2 + hstepA, voffA);
            PG8_WAIT_V(8); PG8_WAIT_L(0); PG8_BAR; PG8_MMA(0, 0, At, B0); PG8_MMA(0, 1, At, B1); PG8_BAR; PG8_SCHED;
            PG8_LDA(At, 1, 1); PG8_STAGE(PG8_SB(1, 0), b3, voffB); PG8_STAGE(PG8_SB(1, 1), b3 + hstepB, voffB); PG8_STAGE(PG8_SA(1, 0), a3, voffA);
            PG8_WAIT_V(8); PG8_WAIT_L(0); PG8_BAR; PG8_MMA(1, 0, At, B0); PG8_MMA(1, 1, At, B1); PG8_BAR; PG8_SCHED;
        }
        if (wr == 0) PG8_BAR;
        E(acc, cur, wr, wc, fr, fq, lds);
        if (!has_next) break;
        { const float z0 = ozero();
#pragma unroll
        for (int a = 0; a < 2; ++a)
#pragma unroll
            for (int b = 0; b < 2; ++b)
#pragma unroll
                for (int m = 0; m < 4; ++m)
#pragma unroll
                    for (int n = 0; n < 2; ++n) acc[a][b][m][n] = (f32x4){z0, z0, z0, z0}; }
        cur = nxt; cA = nA; cB = nB; ++ui;
        if (wr == 1) PG8_BAR;
    }
    PG8_WAIT_V(0);
    PG8_BAR;
#undef PG8_SA
#undef PG8_SB
#undef PG8_STAGE
#undef PG8_LDA
#undef PG8_LDB
#undef PG8_MMA
#undef PG8_WAIT_V
#undef PG8_WAIT_L
#undef PG8_BAR
#undef PG8_SCHED
}
}
using pg8::Unit;

DI void store8(bf16* p, const f32x4 v0, const f32x4 v1) {
    u32x4 w; w.x = pk2(v0[0], v0[1]); w.y = pk2(v0[2], v0[3]); w.z = pk2(v1[0], v1[1]); w.w = pk2(v1[2], v1[3]);
    *(u32x4*)p = w;
}
#define EPI_ARGS f32x4 (&acc)[2][2][4][2], const Unit& u, int wr, int wc, int fr, int fq, LAS unsigned char* lds

DI float rs_ps(const float* ps, int row) {
    const f32x4* p = (const f32x4*)(ps + (size_t)row * 16); const f32x4 a = p[0], b = p[1], c = p[2], d = p[3];
    const float s = ((a.x + a.y) + (a.z + a.w)) + ((b.x + b.y) + (b.z + b.w)) + (((c.x + c.y) + (c.z + c.w)) + ((d.x + d.y) + (d.z + d.w)));
    return 1.0f / sqrtf(s * (1.0f / D) + EPS);
}
template <int ACT> struct EpiRowScale {
    static constexpr bool PERM = true;
    bf16* O; int ldc; const float* rs; const float* ps;
    DI void operator()(EPI_ARGS) const {
        const int row0 = u.pm * 256 + wr * 64 + fr, col0 = u.pn * 256 + wc * 32 + 8 * fq;
#pragma unroll
        for (int ai = 0; ai < 2; ++ai)
#pragma unroll
            for (int m = 0; m < 4; ++m) {
                const int row = row0 + ai * 128 + m * 16; const float s = ps ? rs_ps(ps, row) : (rs ? rs[row] : 1.0f);
                bf16* rowp = O + (size_t)row * ldc + col0;
#pragma unroll
                for (int bj = 0; bj < 2; ++bj) { f32x4 v0 = acc[ai][bj][m][0] * s, v1 = acc[ai][bj][m][1] * s;
                    if (ACT == 2) {
#pragma unroll
                        for (int j = 0; j < 4; ++j) { float a = fmaxf(v0[j], 0.f), b = fmaxf(v1[j], 0.f); v0[j] = a * a; v1[j] = b * b; } }
                    store8(rowp + bj * 128, v0, v1); }
            }
    }
};
struct EpiInProj {
    static constexpr bool PERM = true;
    bf16* GLU; bf16* QK; const float* rs;
    DI void operator()(EPI_ARGS) const {
        const int row0 = u.pm * 256 + wr * 64 + fr;
        if (u.pn < 4) {
            const int col0 = u.pn * 128 + wc * 32 + 8 * fq;
#pragma unroll
            for (int ai = 0; ai < 2; ++ai)
#pragma unroll
                for (int m = 0; m < 4; ++m) {
                    const int row = row0 + ai * 128 + m * 16; const float s = rs[row];
                    f32x4 o0, o1;
#pragma unroll
                    for (int j = 0; j < 4; ++j) { o0[j] = acc[ai][0][m][0][j] * s * sigmoidf_(acc[ai][1][m][0][j] * s); o1[j] = acc[ai][0][m][1][j] * s * sigmoidf_(acc[ai][1][m][1][j] * s); }
                    store8(GLU + (size_t)row * 512 + col0, o0, o1);
                }
        } else {
            const int col0 = (u.pn - 4) * 256 + wc * 32 + 8 * fq;
#pragma unroll
            for (int ai = 0; ai < 2; ++ai)
#pragma unroll
                for (int m = 0; m < 4; ++m) {
                    const int row = row0 + ai * 128 + m * 16; const float s = rs[row];
#pragma unroll
                    for (int bj = 0; bj < 2; ++bj) store8(QK + (size_t)row * 1024 + col0 + bj * 128, acc[ai][bj][m][0] * s, acc[ai][bj][m][1] * s);
                }
        }
    }
};
struct EpiVT {
    static constexpr bool PERM = true;
    bf16* O; const float* cs;
    DI void operator()(EPI_ARGS) const {
        const int row0 = u.pm * 256 + wr * 64 + fr, col0 = u.pn * 256 + wc * 32 + 8 * fq;
        f32x4 c[2][2];
#pragma unroll
        for (int bj = 0; bj < 2; ++bj) { c[bj][0] = *(const f32x4*)(cs + col0 + bj * 128); c[bj][1] = *(const f32x4*)(cs + col0 + bj * 128 + 4); }
#pragma unroll
        for (int ai = 0; ai < 2; ++ai)
#pragma unroll
            for (int m = 0; m < 4; ++m) {
                const int row = row0 + ai * 128 + m * 16;
#pragma unroll
                for (int bj = 0; bj < 2; ++bj) { const int t = col0 + bj * 128;
                    store8(O + ((size_t)(((t >> 11) * 4 + (row >> 7)) * 32 + ((t >> 6) & 31)) * 128 + (row & 127)) * 64 + (t & 63), acc[ai][bj][m][0] * c[bj][0], acc[ai][bj][m][1] * c[bj][1]); }
            }
    }
};
struct EpiPre {
    static constexpr bool PERM = true;
    bf16* base0;
    DI void operator()(EPI_ARGS) const {
        bf16* O = base0 + (size_t)((u.z >> 30) & 1) * (52u << 20) + (size_t)(u.z & 0x3fffffff);
        const int row0 = wr * 64 + fr, col0 = wc * 32 + 8 * fq;
#pragma unroll
        for (int ai = 0; ai < 2; ++ai)
#pragma unroll
            for (int m = 0; m < 4; ++m) {
                const int row = row0 + ai * 128 + m * 16;
#pragma unroll
                for (int bj = 0; bj < 2; ++bj) store8(O + (size_t)row * 1024 + col0 + bj * 128, acc[ai][bj][m][0], acc[ai][bj][m][1]);
            }
    }
};
struct EpiResid {
    static constexpr bool PERM = true;
    const float* xres; const bf16* hres; bf16* out; float* ps;
    DI void operator()(EPI_ARGS) const {
        const int row0 = u.pm * 256 + wr * 64 + fr, col0 = u.pn * 256 + wc * 32 + 8 * fq;
#pragma unroll
        for (int ai = 0; ai < 2; ++ai)
#pragma unroll
            for (int m = 0; m < 4; ++m) {
                const int row = row0 + ai * 128 + m * 16; const size_t off = (size_t)row * D + col0; float ss = 0.f;
#pragma unroll
                for (int bj = 0; bj < 2; ++bj) {
                    f32x4 r0, r1;
                    if (xres) { r0 = *(const f32x4*)(xres + off + bj * 128); r1 = *(const f32x4*)(xres + off + bj * 128 + 4); }
                    else { const u32x4 hw = *(const u32x4*)(hres + off + bj * 128); r0 = (f32x4){bflo(hw.x), bfhi(hw.x), bflo(hw.y), bfhi(hw.y)}; r1 = (f32x4){bflo(hw.z), bfhi(hw.z), bflo(hw.w), bfhi(hw.w)}; }
                    r0 = r0 + acc[ai][bj][m][0]; r1 = r1 + acc[ai][bj][m][1];
                    u32x4 w; w.x = pk2(r0[0], r0[1]); w.y = pk2(r0[2], r0[3]); w.z = pk2(r1[0], r1[1]); w.w = pk2(r1[2], r1[3]);
                    *(u32x4*)(out + off + bj * 128) = w;
                    if (ps) {
#pragma unroll
                        for (int q = 0; q < 4; ++q) { const float a = bflo(w[q]), b = bfhi(w[q]); ss += a * a + b * b; }
                    }
                }
                if (ps) { ss += swz_xor<16>(ss); ss = half_sum(ss); if (fq == 0) ps[(size_t)row * 16 + u.pn * 4 + wc] = ss; }
            }
    }
};
struct EpiGateComb {
    static constexpr bool PERM = true;
    const bf16 *YF, *YB, *V; const float *BON, *lng, *lnb; bf16* O;
    DI void operator()(EPI_ARGS) const {
        const int head = u.pn * 4 + wc, ch0 = u.pn * 256 + 64 * wc + 8 * fq, row0 = u.pm * 256 + wr * 64 + fr;
        f32x4 lg[2][2], lb[2][2];
#pragma unroll
        for (int bj = 0; bj < 2; ++bj)
#pragma unroll
            for (int n = 0; n < 2; ++n) { lg[bj][n] = *(const f32x4*)(lng + ch0 + 32 * bj + 4 * n); lb[bj][n] = *(const f32x4*)(lnb + ch0 + 32 * bj + 4 * n); }
#pragma unroll
        for (int ai = 0; ai < 2; ++ai)
#pragma unroll
            for (int m = 0; m < 4; ++m) {
                const int row = row0 + ai * 128 + m * 16; const size_t off = (size_t)row * D + ch0;
                u32x4 a[2], b[2], vv[2];
#pragma unroll
                for (int bj = 0; bj < 2; ++bj) { a[bj] = *(const u32x4*)(YF + off + 32 * bj); b[bj] = *(const u32x4*)(YB + off + 32 * bj); vv[bj] = *(const u32x4*)(V + off + 32 * bj); }
                const float bon = BON[(size_t)row * 16 + head] + BON[(size_t)(M + row) * 16 + head];
                float y[16]; float s = 0.f;
#pragma unroll
                for (int bj = 0; bj < 2; ++bj)
#pragma unroll
                    for (int w = 0; w < 4; ++w) { y[bj * 8 + 2 * w] = bflo(a[bj][w]) + bflo(b[bj][w]); y[bj * 8 + 2 * w + 1] = bfhi(a[bj][w]) + bfhi(b[bj][w]); }
#pragma unroll
                for (int j = 0; j < 16; ++j) s += y[j];
                s += swz_xor<16>(s); s = half_sum(s);
                const float mean = s * (1.0f / 64.0f); float q2 = 0.f;
#pragma unroll
                for (int j = 0; j < 16; ++j) { y[j] -= mean; q2 += y[j] * y[j]; }
                q2 += swz_xor<16>(q2); q2 = half_sum(q2);
                const float rstd = 1.0f / sqrtf(q2 * (1.0f / 64.0f) + 64e-5f);
#pragma unroll
                for (int bj = 0; bj < 2; ++bj) {
                    f32x4 o0, o1;
#pragma unroll
                    for (int j = 0; j < 4; ++j) {
                        const float v0 = (j & 1) ? bfhi(vv[bj][j >> 1]) : bflo(vv[bj][j >> 1]), v1 = (j & 1) ? bfhi(vv[bj][2 + (j >> 1)]) : bflo(vv[bj][2 + (j >> 1)]);
                        o0[j] = (y[bj * 8 + j] * rstd * lg[bj][0][j] + lb[bj][0][j] + bon * v0) * acc[ai][bj][m][0][j];
                        o1[j] = (y[bj * 8 + 4 + j] * rstd * lg[bj][1][j] + lb[bj][1][j] + bon * v1) * acc[ai][bj][m][1][j];
                    }
                    store8(O + off + 32 * bj, o0, o1);
                }
            }
    }
};
struct EpiSoftmax {
    static constexpr bool PERM = true;
    bf16* P; const float* ps;
    DI void operator()(EPI_ARGS) const {
        LAS f32x2* X = (LAS f32x2*)(lds + LDS_X);
        const int row0 = u.pm * 256, col0 = u.pn * 256 + wc * 32 + 8 * fq;
        float mw[2][4];
#pragma unroll
        for (int ai = 0; ai < 2; ++ai)
#pragma unroll
            for (int m = 0; m < 4; ++m) {
                const int rl = ai * 128 + wr * 64 + m * 16 + fr; const float s = rs_ps(ps, row0 + rl) * LOG2E;
                float mx = -3.0e38f;
#pragma unroll
                for (int bj = 0; bj < 2; ++bj)
#pragma unroll
                    for (int n = 0; n < 2; ++n) { acc[ai][bj][m][n] = acc[ai][bj][m][n] * s;
#pragma unroll
                        for (int j = 0; j < 4; ++j) mx = fmaxf(mx, acc[ai][bj][m][n][j]); }
                mx = fmaxf(mx, swz_xor<16>(mx)); mx = half_max(mx);
                float sum = 0.f;
#pragma unroll
                for (int bj = 0; bj < 2; ++bj)
#pragma unroll
                    for (int n = 0; n < 2; ++n)
#pragma unroll
                        for (int j = 0; j < 4; ++j) { const float p = fexp2(acc[ai][bj][m][n][j] - mx); acc[ai][bj][m][n][j] = p; sum += p; }
                sum += swz_xor<16>(sum); sum = half_sum(sum);
                mw[ai][m] = mx;
                if (fq == 0) X[rl * 4 + wc] = (f32x2){mx, sum};
            }
        asm volatile("s_waitcnt lgkmcnt(0)" ::: "memory"); __builtin_amdgcn_s_barrier(); asm volatile("" ::: "memory");
#pragma unroll
        for (int ai = 0; ai < 2; ++ai)
#pragma unroll
            for (int m = 0; m < 4; ++m) {
                const int rl = ai * 128 + wr * 64 + m * 16 + fr;
                const f32x2 a = X[rl * 4 + 0], b = X[rl * 4 + 1], c = X[rl * 4 + 2], d = X[rl * 4 + 3];
                const float mt = fmaxf(fmaxf(a.x, b.x), fmaxf(c.x, d.x));
                const float lt = a.y * fexp2(a.x - mt) + b.y * fexp2(b.x - mt) + c.y * fexp2(c.x - mt) + d.y * fexp2(d.x - mt);
                const float f = fexp2(mw[ai][m] - mt) / lt;
                bf16* rowp = P + (size_t)(row0 + rl) * 1024 + col0;
#pragma unroll
                for (int bj = 0; bj < 2; ++bj) store8(rowp + bj * 128, acc[ai][bj][m][0] * f, acc[ai][bj][m][1] * f);
            }
        asm volatile("s_waitcnt lgkmcnt(0)" ::: "memory"); __builtin_amdgcn_s_barrier(); asm volatile("" ::: "memory");
    }
};
struct EpiRwkv {
    static constexpr bool PERM = true;
    bf16* R; bf16* Kk; bf16* V; bf16* HD1; bf16* HD2;
    DI void operator()(EPI_ARGS) const {
        const int row0 = u.pm * 256 + wr * 64 + fr; const int g = u.pn >> 2;
        bf16* O; int ldc, colt, mode0 = 0, mode1 = 0;
        if (u.pn < 12) { O = R + (size_t)g * (32u << 20); ldc = 1024; colt = (u.pn & 3) * 256; }
        else if (u.pn == 12) { O = HD1; ldc = 256; colt = 0; mode0 = 1; }
        else { O = HD2; ldc = 256; colt = 0; mode0 = 2; mode1 = 2; }
        const int col0 = colt + wc * 32 + 8 * fq;
#pragma unroll
        for (int ai = 0; ai < 2; ++ai)
#pragma unroll
            for (int m = 0; m < 4; ++m) {
                bf16* rowp = O + (size_t)(row0 + ai * 128 + m * 16) * ldc + col0;
#pragma unroll
                for (int bj = 0; bj < 2; ++bj) { f32x4 v0 = acc[ai][bj][m][0], v1 = acc[ai][bj][m][1]; const int md = bj ? mode1 : mode0;
                    if (md == 1) {
#pragma unroll
                        for (int j = 0; j < 4; ++j) { v0[j] = tanhf_(v0[j]); v1[j] = tanhf_(v1[j]); } }
                    else if (md == 2) {
#pragma unroll
                        for (int j = 0; j < 4; ++j) { v0[j] = sigmoidf_(v0[j]); v1[j] = sigmoidf_(v1[j]); } }
                    store8(rowp + bj * 128, v0, v1); }
            }
    }
};

enum InIdx { I_X = 0, I_MEM, I_REL, I_NMIX, I_NXATTN, I_NMEM, I_NFFN, I_NFINAL, I_WIN, I_WOUT, I_CONVW, I_CONVB, I_CLNG, I_CLNB, I_LQ1, I_LK1, I_LQ2, I_LK2, I_SUBLN,
             I_MU, I_WR, I_WK, I_WV, I_WO, I_W0, I_W1, I_W2, I_A0, I_A1, I_A2, I_G1, I_G2, I_KK, I_KA, I_RK, I_LNG, I_LNB, I_XQ, I_XKV, I_XO, I_UP, I_DN, N_IN };
struct Args { const float* in[N_IN]; float* out; unsigned char* ws; int ph_lo, ph_hi; };
static_assert(sizeof(Args) == (N_IN + 2) * 8 + 8, "Args has no padding");

struct Frame {
    LAS unsigned char* lds;
    int tid, lane, wave, gw, ngw;
    unsigned char* ws;
};

DI Frame fresh(const Frame& F0) {
    Frame F = F0; F.tid = opaque(threadIdx.x); F.lane = F.tid & 63; F.wave = __builtin_amdgcn_readfirstlane(F.tid >> 6); F.gw = opq(blockIdx.x) * 8 + F.wave; F.ngw = opq(gridDim.x) * 8; return F;
}
struct TJob { const float* W; int K, N; bf16* WT; int ldt, row_off, col_off, perm; const float* gain; const float* gsub; };
DI void tr_item(const TJob& J, LAS float* scr, int item, int lane) {
    const int nblk = J.N / 32, kb = item / nblk, nb = item % nblk, k0 = 64 * kb, n0 = 32 * nb;
    float scale = 1.0f; int drow = J.row_off + n0;
    if (J.perm) {
        if (n0 < 512) drow = 256 * (n0 >> 7) + (n0 & 127);
        else if (n0 < 1024) drow = 256 * ((n0 - 512) >> 7) + 128 + ((n0 - 512) & 127);
        else drow = n0;
        if (n0 >= 1024 && n0 < 1536) scale = 0.125f * LOG2E;
    }
    float tv[32];
    const float* wp = J.W + (size_t)(k0 + (lane >> 5)) * J.N + n0 + (lane & 31);
#pragma unroll
    for (int i = 0; i < 32; ++i) tv[i] = wp[(size_t)(2 * i) * J.N];
    if (J.gain) {
#pragma unroll
        for (int i = 0; i < 32; ++i) tv[i] *= J.gain[k0 + 2 * i + (lane >> 5)] - (J.gsub ? J.gsub[k0 + 2 * i + (lane >> 5)] : 0.0f);
    }
#pragma unroll
    for (int i = 0; i < 32; ++i) scr[(2 * i + (lane >> 5)) * 33 + (lane & 31)] = tv[i] * scale;
    asm volatile("s_waitcnt lgkmcnt(0)" ::: "memory");
    const int c = lane & 7;
#pragma unroll
    for (int j = 0; j < 4; ++j) { const int n = (lane >> 3) + 8 * j; const LAS float* s = scr + (8 * c) * 33 + n;
        u32x4 o; o.x = pk2(s[0 * 33], s[1 * 33]); o.y = pk2(s[2 * 33], s[3 * 33]); o.z = pk2(s[4 * 33], s[5 * 33]); o.w = pk2(s[6 * 33], s[7 * 33]);
        *(u32x4*)(J.WT + (size_t)(drow + n) * J.ldt + J.col_off + k0 + 8 * c) = o; }
    asm volatile("s_waitcnt lgkmcnt(0)" ::: "memory");
}
DI void tr_item64(const TJob& J, LAS float* scr, int item, int lane) {
    const int nblk = J.N / 64, kb = item / nblk, nb = item % nblk, k0 = 64 * kb, n0 = 64 * nb;
    float scale = 1.0f; int drow = J.row_off + n0;
    if (J.perm) {
        if (n0 < 512) drow = 256 * (n0 >> 7) + (n0 & 127);
        else if (n0 < 1024) drow = 256 * ((n0 - 512) >> 7) + 128 + ((n0 - 512) & 127);
        else drow = n0;
        if (n0 >= 1024 && n0 < 1536) scale = 0.125f * LOG2E;
    }
    f32x4 tv[16];
    const float* wp = J.W + (size_t)(k0 + (lane >> 4)) * J.N + n0 + 4 * (lane & 15);
#pragma unroll
    for (int i = 0; i < 16; ++i) tv[i] = *(const f32x4*)(wp + (size_t)(4 * i) * J.N);
#pragma unroll
    for (int i = 0; i < 16; ++i) { const int kk = 4 * i + (lane >> 4); const float g = (J.gain ? J.gain[k0 + kk] - (J.gsub ? J.gsub[k0 + kk] : 0.0f) : 1.0f) * scale;
        LAS float* d = scr + kk * 65 + 4 * (lane & 15); d[0] = tv[i].x * g; d[1] = tv[i].y * g; d[2] = tv[i].z * g; d[3] = tv[i].w * g; }
    asm volatile("s_waitcnt lgkmcnt(0)" ::: "memory");
    const int c = lane & 7;
#pragma unroll
    for (int j = 0; j < 8; ++j) { const int n = (lane >> 3) + 8 * j; const LAS float* sp = scr + (8 * c) * 65 + n;
        u32x4 o; o.x = pk2(sp[0 * 65], sp[1 * 65]); o.y = pk2(sp[2 * 65], sp[3 * 65]); o.z = pk2(sp[4 * 65], sp[5 * 65]); o.w = pk2(sp[6 * 65], sp[7 * 65]);
        *(u32x4*)(J.WT + (size_t)(drow + n) * J.ldt + J.col_off + k0 + 8 * c) = o; }
    asm volatile("s_waitcnt lgkmcnt(0)" ::: "memory");
}
constexpr int N_TJOBS = 31;
DI TJob get_tjob(int j, const Args& a, unsigned char* ws) {
    TJob J; J.perm = 0; J.gain = nullptr; J.gsub = nullptr; J.row_off = 0; J.col_off = 0;
    if (j == 0) { J.W = a.in[opq(I_WIN)]; J.K = 1024; J.N = 2560; J.WT = (bf16*)(ws + WS_WIN); J.ldt = 1024; J.perm = 1; J.gain = a.in[opq(I_NMIX)]; }
    else if (j == 1) { J.W = a.in[opq(I_WOUT)]; J.K = 1024; J.N = 1024; J.WT = (bf16*)(ws + WS_WOUT); J.ldt = 1024; }
    else if (j < 4) { const int i = j - 2; J.W = a.in[opq(I_XKV)] + (size_t)i * 1024 * 2048; J.K = 1024; J.N = 2048; J.WT = (bf16*)(ws + WS_WKV) + (size_t)i * 2048 * 1024; J.ldt = 1024; J.gain = a.in[opq(I_NMEM)] + i * 1024; }
    else if (j < 6) { const int i = j - 4; J.W = a.in[opq(I_XO)] + (size_t)i * 1024 * 1024; J.K = 1024; J.N = 1024; J.WT = (bf16*)(ws + WS_WXO) + (size_t)i * 1024 * 1024; J.ldt = 1024; }
    else if (j < 8) { const int i = j - 6; J.W = a.in[opq(I_UP)] + (size_t)i * 1024 * 4096; J.K = 1024; J.N = 4096; J.WT = (bf16*)(ws + WS_WUP) + (size_t)i * 4096 * 1024; J.ldt = 1024; J.gain = a.in[opq(I_NFFN)] + i * 1024; }
    else if (j < 10) { const int i = j - 8; J.W = a.in[opq(I_DN)] + (size_t)i * 4096 * 1024; J.K = 4096; J.N = 1024; J.WT = (bf16*)(ws + WS_WDN) + (size_t)i * 1024 * 4096; J.ldt = 4096; }
    else if (j < 26) {
        const int q = j - 10, src = q >> 1, copy = q & 1; int mu = 0;
        J.K = 1024;
        if (src < 3) { J.WT = (bf16*)(ws + WS_WBIG); J.ldt = 1024; J.row_off = src * 1024; J.N = copy ? 0 : 1024; J.W = a.in[opq(src == 0 ? I_WR : src == 1 ? I_WK : I_WV)]; }
        else {
            J.WT = (bf16*)(ws + WS_WLORA); J.ldt = 2048; J.col_off = copy * 1024;
            if (src == 3) { J.W = a.in[opq(I_W1)]; J.N = 64; J.row_off = 0; mu = 1; }
            else if (src == 4) { J.W = a.in[opq(I_W1)] + 1024 * 64; J.N = 64; J.row_off = 64; mu = 1; }
            else if (src == 5) { J.W = a.in[opq(I_A1)]; J.N = 64; J.row_off = 128; mu = 4; }
            else if (src == 6) { J.W = a.in[opq(I_A1)] + 1024 * 64; J.N = 64; J.row_off = 192; mu = 4; }
            else { J.W = a.in[opq(I_G1)]; J.N = 160; J.row_off = 256; mu = 5; }
            if (copy) { J.gain = a.in[opq(I_MU)] + mu * 1024; J.gsub = a.in[opq(I_MU)]; }
        }
    }
    else if (j < 30) { const int q = j - 26; J.W = (q < 2 ? a.in[opq(I_W2)] : a.in[opq(I_A2)]) + (size_t)(q & 1) * 64 * 1024; J.K = 64; J.N = 1024; J.WT = (bf16*)(ws + WS_W2T) + (size_t)q * 1024 * 64; J.ldt = 64; }
    else { J.W = a.in[opq(I_WO)]; J.K = 1024; J.N = 1024; J.WT = (bf16*)(ws + WS_WRO); J.ldt = 1024; }
    return J;
}
DI void row_to_bf16_rs(const float* xrow, bf16* orow, float* rs, int lane) {
    const f32x4* xr = (const f32x4*)xrow + lane;
    f32x4 v[4]; float s = 0.f;
#pragma unroll
    for (int j = 0; j < 4; ++j) { v[j] = xr[64 * j]; s += (v[j].x * v[j].x + v[j].y * v[j].y) + (v[j].z * v[j].z + v[j].w * v[j].w); }
    s = wave_sum(s);
    u32x2* o8 = (u32x2*)orow + lane;
#pragma unroll
    for (int j = 0; j < 4; ++j) { u32x2 w; w.x = pk2(v[j].x, v[j].y); w.y = pk2(v[j].z, v[j].w); o8[64 * j] = w; }
    if (lane == 0) *rs = 1.0f / sqrtf(s * (1.0f / D) + EPS);
}
DI void rows4_to_bf16_rs(const Frame& F, const float* X, bf16* O, float* rs, int nrows) {
    for (int m0 = F.gw * 4; m0 < nrows; m0 += F.ngw * 4) {
        f32x4 v[4][4];
#pragma unroll
        for (int r = 0; r < 4; ++r)
#pragma unroll
            for (int j = 0; j < 4; ++j) v[r][j] = ((const f32x4*)(X + (size_t)(m0 + r) * D))[F.lane + 64 * j];
#pragma unroll
        for (int r = 0; r < 4; ++r) {
            float s = 0.f;
#pragma unroll
            for (int j = 0; j < 4; ++j) s += (v[r][j].x * v[r][j].x + v[r][j].y * v[r][j].y) + (v[r][j].z * v[r][j].z + v[r][j].w * v[r][j].w);
            s = wave_sum(s);
            u32x2* o8 = (u32x2*)(O + (size_t)(m0 + r) * D) + F.lane;
#pragma unroll
            for (int j = 0; j < 4; ++j) { u32x2 w; w.x = pk2(v[r][j].x, v[r][j].y); w.y = pk2(v[r][j].z, v[r][j].w); o8[64 * j] = w; }
            if (F.lane == 0) rs[m0 + r] = 1.0f / sqrtf(s * (1.0f / D) + EPS);
        }
    }
}
DI int t5_bucket(int rel) {
    const int n = rel < 0 ? -rel : rel; int r = rel > 0 ? 16 : 0;
    if (n < 8) return r + n;
    int lg = 8; lg += (n >= 12); lg += (n >= 16); lg += (n >= 23); lg += (n >= 32); lg += (n >= 46); lg += (n >= 64); lg += (n >= 91);
    return r + lg;
}
DI void phase_prologue(const Frame& F0, const Args& a, unsigned char* ws) {
    const Frame F = fresh(F0);
    LAS float* scr = (LAS float*)(F.lds + F.wave * 17408);
    {
        int total = 0;
        for (int j = 0; j < N_TJOBS; ++j) { const TJob J = get_tjob(j, a, ws); total += (J.N & 63) == 0 ? (J.K / 64) * (J.N / 64) : (J.K / 64) * (J.N / 32); }
        for (int g = F.gw; g < total; g += F.ngw) {
            int r = g;
            for (int j = 0; j < N_TJOBS; ++j) {
                const TJob J = get_tjob(j, a, ws); const bool wide = (J.N & 63) == 0; const int cnt = wide ? (J.K / 64) * (J.N / 64) : (J.K / 64) * (J.N / 32);
                if (r < cnt) { if (wide) tr_item64(J, scr, r, F.lane); else tr_item(J, scr, r, F.lane); break; }
                r -= cnt;
            }
        }
    }
    const int gt = F.gw * 64 + F.lane, ngt = F.ngw * 64;
    for (int i = 0; i < 2; ++i) {
        const float* W = a.in[opq(I_XQ)] + (size_t)i * 1024 * 1024; const float* g = a.in[opq(I_NXATTN)] + i * 1024; bf16* O = (bf16*)(ws + WS_WQN) + (size_t)i * 1024 * 1024;
        for (int e = gt; e < 1024 * 1024 / 4; e += ngt) { const f32x4 v = ((const f32x4*)W)[e]; const float s = g[(e * 4) >> 10] * 0.0625f; u32x2 w; w.x = pk2(v.x * s, v.y * s); w.y = pk2(v.z * s, v.w * s); ((u32x2*)O)[e] = w; }
    }
    { const float* W = a.in[opq(I_G2)]; bf16* O = (bf16*)(ws + WS_G2T);
      for (int e = gt; e < 1024 * 256; e += ngt) { const int rown = e >> 8, k = e & 255, cc = rown & 255;
        const int n = (rown & ~255) + 64 * ((cc >> 5) & 3) + 32 * (cc >> 7) + (cc & 31);
        O[e] = (bf16)(k < 160 ? f2bf(W[(size_t)k * 1024 + n]) : 0u); } }
    { u32x4* O = (u32x4*)((bf16*)(ws + WS_WLORA) + (size_t)416 * 2048);
      const unsigned zq = (unsigned)opaque(0);
      for (int e = gt; e < 96 * 2048 * 2 / 16; e += ngt) O[e] = (u32x4){zq, zq, zq, zq}; }
    rows4_to_bf16_rs(F, a.in[opq(I_X)], (bf16*)(ws + WS_SA), (float*)(ws + WS_RS), M);
    rows4_to_bf16_rs(F, a.in[opq(I_MEM)], (bf16*)(ws + WS_MEMB), (float*)(ws + WS_RSMEM), MMEM);
    { float* B = (float*)(ws + WS_BIAS); const float* tab = a.in[opq(I_REL)];
      for (int e = gt; e < 4 * 4096; e += ngt) { const int h = e >> 12, idx = e & 4095; const int rel = idx - 2047; B[e] = idx < 4095 ? tab[t5_bucket(rel) * 4 + h] * LOG2E : 0.f; } }
    if (F.gw == 0) {
        const float q1 = a.in[opq(I_LQ1)][F.lane] * a.in[opq(I_LK1)][F.lane], q2 = a.in[opq(I_LQ2)][F.lane] * a.in[opq(I_LK2)][F.lane];
        const float s1 = wave_sum(q1), s2 = wave_sum(q2);
        if (F.lane == 0) ((float*)(ws + WS_LAM))[0] = expf(s1) - expf(s2) + 0.2f;
    }
}

DI void phase_final_norm(const Frame& F0, const bf16* h, float* out, const float* g, const float osc) {
    const Frame F = fresh(F0);
    f32x4 gv[4];
#pragma unroll
    for (int j = 0; j < 4; ++j) gv[j] = ((const f32x4*)g)[F.lane + 64 * j];
    for (int m0 = F.gw * 4; m0 < M; m0 += F.ngw * 4) {
        u32x2 hw[4][4];
#pragma unroll
        for (int r = 0; r < 4; ++r)
#pragma unroll
            for (int j = 0; j < 4; ++j) hw[r][j] = ((const u32x2*)(h + (size_t)(m0 + r) * D))[F.lane + 64 * j];
#pragma unroll
        for (int r = 0; r < 4; ++r) {
            f32x4 v[4]; float s = 0.f;
#pragma unroll
            for (int j = 0; j < 4; ++j) { v[j] = (f32x4){bflo(hw[r][j].x), bfhi(hw[r][j].x), bflo(hw[r][j].y), bfhi(hw[r][j].y)}; s += (v[j].x * v[j].x + v[j].y * v[j].y) + (v[j].z * v[j].z + v[j].w * v[j].w); }
            const float rr = osc / sqrtf(wave_sum(s) * (1.0f / D) + EPS);
            f32x4* xr = (f32x4*)(out + (size_t)(m0 + r) * D) + F.lane;
#pragma unroll
            for (int j = 0; j < 4; ++j) xr[64 * j] = v[j] * rr * gv[j];
        }
    }
}
DI void phase_rwkv_shift(const Frame& F0, const bf16* h, const float* g, const float* mu, bf16* XR, bf16* XK, bf16* XV, bf16* HH) {
    const Frame F = fresh(F0);
    f32x4 gv[4], mr[4], mk[4], mv[4];
#pragma unroll
    for (int j = 0; j < 4; ++j) { gv[j] = ((const f32x4*)g)[F.lane + 64 * j]; mr[j] = ((const f32x4*)mu)[F.lane + 64 * j]; mk[j] = ((const f32x4*)(mu + 2048))[F.lane + 64 * j]; mv[j] = ((const f32x4*)(mu + 3072))[F.lane + 64 * j]; }
    for (int ch = F.gw; ch < M / 16; ch += F.ngw) {
        const int m0 = ch * 16, t0 = m0 & (T - 1);
        f32x4 p2[4], p1[4], cu[4];
#pragma unroll
        for (int j = 0; j < 4; ++j) { p2[j] = (f32x4){0.f, 0.f, 0.f, 0.f}; p1[j] = p2[j]; cu[j] = p2[j]; }
#pragma unroll 1
        for (int g6 = 0; g6 < 6; ++g6) {
            f32x4 ld[3][4];
#pragma unroll
            for (int r = 0; r < 3; ++r) { const int i = g6 * 3 + r - 1, t = t0 + i; const bool ok = (t >= 0 && t < T);
#pragma unroll
                for (int j = 0; j < 4; ++j) { const u32x2 w = ok ? ((const u32x2*)(h + (size_t)(m0 + i) * D))[F.lane + 64 * j] : (u32x2){0u, 0u}; ld[r][j] = (f32x4){bflo(w.x), bfhi(w.x), bflo(w.y), bfhi(w.y)}; } }
#pragma unroll
            for (int r = 0; r < 3; ++r) {
                const int i = g6 * 3 + r - 1;
                float s = 0.f;
#pragma unroll
                for (int j = 0; j < 4; ++j) { p2[j] = p1[j]; p1[j] = cu[j]; cu[j] = ld[r][j]; s += (cu[j].x * cu[j].x + cu[j].y * cu[j].y) + (cu[j].z * cu[j].z + cu[j].w * cu[j].w); }
                const float rr = 1.0f / sqrtf(wave_sum(s) * (1.0f / D) + EPS);
#pragma unroll
                for (int j = 0; j < 4; ++j) cu[j] = cu[j] * rr * gv[j];
                if (i >= 1) {
                    const size_t ro = (size_t)(m0 + i - 1) * 1024;
#pragma unroll
                    for (int j = 0; j < 4; ++j) { const f32x4 hh = (p2[j] + cu[j]) * 0.5f - p1[j];
                        const f32x4 xr = p1[j] + mr[j] * hh, xk = p1[j] + mk[j] * hh, xv = p1[j] + mv[j] * hh;
                        u32x2 w; w.x = pk2(xr.x, xr.y); w.y = pk2(xr.z, xr.w); __builtin_nontemporal_store(w, (u32x2*)(XR + ro) + F.lane + 64 * j);
                        w.x = pk2(xk.x, xk.y); w.y = pk2(xk.z, xk.w); __builtin_nontemporal_store(w, (u32x2*)(XK + ro) + F.lane + 64 * j);
                        w.x = pk2(xv.x, xv.y); w.y = pk2(xv.z, xv.w); __builtin_nontemporal_store(w, (u32x2*)(XV + ro) + F.lane + 64 * j);
                        w.x = pk2(hh.x, hh.y); w.y = pk2(hh.z, hh.w); __builtin_nontemporal_store(w, (u32x2*)(HH + ro) + F.lane + 64 * j); }
                }
            }
        }
    }
}
constexpr int CV_ROWB = 1040, CV_IN_BYTES = 94 * CV_ROWB, CV_W_OFF = CV_IN_BYTES;
DI void conv_load_weights(const Frame& F0, const float* cw) {
    const Frame F = fresh(F0);
    LAS bf16* W = (LAS bf16*)(F.lds + CV_W_OFF);
    for (int e = F.tid; e < 31 * 512; e += 512) W[e] = (bf16)f2bf(cw[e]);
}
DI void conv_unit(const Frame& F0, int unit, const bf16* GLU, const float* cb, const float* lg, const float* lb, bf16* MIX) {
    const Frame F = fresh(F0);
    const int b = unit >> 5, t0 = (unit & 31) * 64;
    __syncthreads();
    for (int p = F.tid; p < 94 * 64; p += 512) {
        const int r = p >> 6, c = p & 63, t = t0 - 15 + r;
        u32x4 v = (u32x4){0u, 0u, 0u, 0u};
        if (t >= 0 && t < T) v = *(const u32x4*)(GLU + (size_t)(b * T + t) * 512 + c * 8);
        *(LAS u32x4*)(F.lds + r * CV_ROWB + c * 16) = v;
    }
    __syncthreads();
    const int tl = F.tid >> 3, chunk = F.tid & 7;
    float y[64];
#pragma unroll
    for (int i = 0; i < 8; ++i) {
        const int cg = chunk + 8 * i;
        float acc[8];
#pragma unroll
        for (int e = 0; e < 8; ++e) acc[e] = cb[cg * 8 + e];
#pragma unroll 1
        for (int j = 0; j < 31; ++j) {
            const u32x4 x = *(const LAS u32x4*)(F.lds + (tl + j) * CV_ROWB + cg * 16);
            const u32x4 w = *(const LAS u32x4*)(F.lds + CV_W_OFF + j * 1024 + cg * 16);
#pragma unroll
            for (int q = 0; q < 4; ++q) { acc[2 * q] += bflo(x[q]) * bflo(w[q]); acc[2 * q + 1] += bfhi(x[q]) * bfhi(w[q]); }
        }
#pragma unroll
        for (int e = 0; e < 8; ++e) y[i * 8 + e] = acc[e];
    }
    float s = 0.f;
#pragma unroll
    for (int j = 0; j < 64; ++j) s += y[j];
    s += swz_xor<1>(s); s += swz_xor<2>(s); s += swz_xor<4>(s);
    const float mean = s * (1.0f / 512.0f); float q2 = 0.f;
#pragma unroll
    for (int j = 0; j < 64; ++j) { y[j] -= mean; q2 += y[j] * y[j]; }
    q2 += swz_xor<1>(q2); q2 += swz_xor<2>(q2); q2 += swz_xor<4>(q2);
    const float rstd = 1.0f / sqrtf(q2 * (1.0f / 512.0f) + 1e-5f);
    bf16* orow = MIX + (size_t)(b * T + t0 + tl) * 1024;
#pragma unroll
    for (int i = 0; i < 8; ++i) {
        const int c0 = (chunk + 8 * i) * 8;
        const f32x4 g0 = *(const f32x4*)(lg + c0), g1 = *(const f32x4*)(lg + c0 + 4), b0 = *(const f32x4*)(lb + c0), b1 = *(const f32x4*)(lb + c0 + 4);
        f32x4 o0, o1;
#pragma unroll
        for (int e = 0; e < 4; ++e) { const float v0 = y[i * 8 + e] * rstd * g0[e] + b0[e], v1 = y[i * 8 + 4 + e] * rstd * g1[e] + b1[e]; o0[e] = v0 * sigmoidf_(v0); o1[e] = v1 * sigmoidf_(v1); }
        store8(orow + c0, o0, o1);
    }
}

constexpr int DA_KROW = 272, DA_VROW = 144, DA_KB = 64 * DA_KROW, DA_VB = 128 * DA_VROW, DA_BUF = DA_KB + DA_VB;
DI int crow(int reg, int hf) { return (reg & 3) + 8 * (reg >> 2) + 4 * hf; }
DI void diffattn_unit(const Frame& F0, int unit, const bf16* QK, const bf16* VT, const float* BIAS, const float lam, const float* subg, bf16* MIX) {
    const Frame F = fresh(F0);
    const int b = unit >> 6, h = (unit >> 4) & 3, qb = unit & 15;
    const int c = F.wave >> 2, qs = F.wave & 3, r32 = F.lane & 31, hf = F.lane >> 5;
    const int q0w = qb * 128 + qs * 32;
    const float* bias_h = BIAS + h * 4096 + 2047;
    bf16x8 Qf[4];
    { const bf16* qp = QK + (size_t)(b * T + q0w + r32) * 1024 + h * 128 + c * 64 + 8 * hf;
#pragma unroll
      for (int ks = 0; ks < 4; ++ks) Qf[ks] = *(const bf16x8*)(qp + 16 * ks); }
    const bf16* kg[2]; const bf16* vg[2]; int kl[2], vl[2];
#pragma unroll
    for (int i = 0; i < 2; ++i) { const int p = F.tid + 512 * i;
        kg[i] = QK + (size_t)(b * T + (p >> 4)) * 1024 + 512 + h * 128 + (p & 15) * 8; kl[i] = (p >> 4) * DA_KROW + (p & 15) * 16;
        vg[i] = VT + (size_t)(b * 4 + h) * (32 * 8192) + p * 8; vl[i] = DA_KB + (p >> 3) * DA_VROW + ((p & 7) >> 1) * 32 + ((p & 7) & 1) * 8; }
    u32x4 kr[2], vr[2];
#pragma unroll
    for (int i = 0; i < 2; ++i) { kr[i] = *(const u32x4*)(kg[i]); vr[i] = *(const u32x4*)(vg[i]); }
    __syncthreads();
    LAS float* const btab = (LAS float*)(F.lds + 2 * DA_BUF);
    btab[F.tid] = bias_h[F.tid - 256];
#pragma unroll
    for (int i = 0; i < 2; ++i) { *(LAS u32x4*)(F.lds + kl[i]) = kr[i]; *(LAS u32x2*)(F.lds + vl[i]) = (u32x2){vr[i].x, vr[i].y}; *(LAS u32x2*)(F.lds + vl[i] + 16) = (u32x2){vr[i].z, vr[i].w}; }
#pragma unroll
    for (int i = 0; i < 2; ++i) { kr[i] = *(const u32x4*)(kg[i] + (size_t)64 * 1024); vr[i] = *(const u32x4*)(vg[i] + 8192); }
    __syncthreads();
    f32x16 O[4];
#pragma unroll
    for (int vt = 0; vt < 4; ++vt)
#pragma unroll
        for (int i = 0; i < 16; ++i) O[vt][i] = 0.f;
    float lsum = 0.f;
    const float cbR = bias_h[91], cbL = bias_h[-91];
    const int ka = r32 * DA_KROW + c * 128 + 16 * hf;
    const int va = DA_KB + r32 * DA_VROW + 16 * hf;
    for (int kt = 0; kt < 32; ++kt) {
        const int k0 = kt * 64;
        LAS unsigned char* buf = F.lds + (kt & 1) * DA_BUF;
        const int dmin = k0 - (q0w + 31), dmax = k0 + 63 - q0w;
        const bool far = (dmin >= 91) || (dmax <= -91);
        const float cb = dmin >= 91 ? cbR : cbL;
        bf16x8 kf[8];
#pragma unroll
        for (int f = 0; f < 8; ++f) kf[f] = *(const LAS bf16x8*)(buf + ka + (f >> 2) * 32 * DA_KROW + (f & 3) * 32);
        __builtin_amdgcn_sched_barrier(0);
        f32x16 S0, S1;
        if (far) {
#pragma unroll
            for (int i = 0; i < 16; ++i) { S0[i] = cb; S1[i] = cb; }
        } else { const LAS float* tb = btab + (k0 - (q0w + r32) + 256);
#pragma unroll
            for (int i = 0; i < 16; ++i) { S0[i] = tb[crow(i, hf)]; S1[i] = tb[32 + crow(i, hf)]; }
        }
        bf16x8 vf0[8];
#pragma unroll
        for (int f = 0; f < 8; ++f) vf0[f] = *(const LAS bf16x8*)(buf + va + (f & 3) * 32 * DA_VROW + (f >> 2) * 32);
#pragma unroll
        for (int ks = 0; ks < 4; ++ks) S0 = __builtin_amdgcn_mfma_f32_32x32x16_bf16(kf[ks], Qf[ks], S0, 0, 0, 0);
#pragma unroll
        for (int ks = 0; ks < 4; ++ks) S1 = __builtin_amdgcn_mfma_f32_32x32x16_bf16(kf[4 + ks], Qf[ks], S1, 0, 0, 0);
        __builtin_amdgcn_sched_barrier(0);
        bf16x8 pa0[2], pa1[2];
        {
#pragma unroll
            for (int s2 = 0; s2 < 2; ++s2) { u32x4 pw;
#pragma unroll
                for (int i = 0; i < 8; ++i) { S0[8 * s2 + i] = fexp2(S0[8 * s2 + i]); lsum += S0[8 * s2 + i]; }
                pw.x = pk2(S0[8 * s2], S0[8 * s2 + 1]); pw.y = pk2(S0[8 * s2 + 2], S0[8 * s2 + 3]); pw.z = pk2(S0[8 * s2 + 4], S0[8 * s2 + 5]); pw.w = pk2(S0[8 * s2 + 6], S0[8 * s2 + 7]);
                pa0[s2] = __builtin_bit_cast(bf16x8, pw); }
        }
        __builtin_amdgcn_sched_barrier(0);
        bf16x8 vf1[8];
#pragma unroll
        for (int f = 0; f < 8; ++f) vf1[f] = *(const LAS bf16x8*)(buf + va + (f & 3) * 32 * DA_VROW + (2 + (f >> 2)) * 32);
#pragma unroll
        for (int f = 0; f < 8; ++f) O[f & 3] = __builtin_amdgcn_mfma_f32_32x32x16_bf16(pa0[f >> 2], vf0[f], O[f & 3], 0, 0, 0);
        {
#pragma unroll
            for (int s2 = 0; s2 < 2; ++s2) { u32x4 pw;
#pragma unroll
                for (int i = 0; i < 8; ++i) { S1[8 * s2 + i] = fexp2(S1[8 * s2 + i]); lsum += S1[8 * s2 + i]; }
                pw.x = pk2(S1[8 * s2], S1[8 * s2 + 1]); pw.y = pk2(S1[8 * s2 + 2], S1[8 * s2 + 3]); pw.z = pk2(S1[8 * s2 + 4], S1[8 * s2 + 5]); pw.w = pk2(S1[8 * s2 + 6], S1[8 * s2 + 7]);
                pa1[s2] = __builtin_bit_cast(bf16x8, pw); }
        }
        __builtin_amdgcn_sched_barrier(0);
#pragma unroll
        for (int f = 0; f < 8; ++f) O[f & 3] = __builtin_amdgcn_mfma_f32_32x32x16_bf16(pa1[f >> 2], vf1[f], O[f & 3], 0, 0, 0);
        if (kt + 1 < 32) {
            LAS unsigned char* nb = F.lds + ((kt + 1) & 1) * DA_BUF;
#pragma unroll
            for (int i = 0; i < 2; ++i) { *(LAS u32x4*)(nb + kl[i]) = kr[i]; *(LAS u32x2*)(nb + vl[i]) = (u32x2){vr[i].x, vr[i].y}; *(LAS u32x2*)(nb + vl[i] + 16) = (u32x2){vr[i].z, vr[i].w}; }
        }
        if (kt + 2 < 32) {
#pragma unroll
            for (int i = 0; i < 2; ++i) { kr[i] = *(const u32x4*)(kg[i] + (size_t)(k0 + 128) * 1024); vr[i] = *(const u32x4*)(vg[i] + (kt + 2) * 8192); }
        }
        __syncthreads();
    }
    lsum = half_sum(lsum);
    LAS float* XO = (LAS float*)F.lds;
    LAS float* LW = (LAS float*)(F.lds + 65536) + F.wave * 32;
    if (hf == 0) LW[r32] = 1.0f / lsum;
    asm volatile("s_waitcnt lgkmcnt(0)" ::: "memory");
    float il[16];
#pragma unroll
    for (int i = 0; i < 16; ++i) il[i] = LW[crow(i, hf)];
    if (c == 1) {
#pragma unroll
        for (int vt = 0; vt < 4; ++vt)
#pragma unroll
            for (int i = 0; i < 16; ++i) XO[(qs * 32 + crow(i, hf)) * 128 + vt * 32 + r32] = O[vt][i] * il[i];
    }
    __syncthreads();
    if (c == 0) {
        float ss[16];
#pragma unroll
        for (int i = 0; i < 16; ++i) ss[i] = 0.f;
#pragma unroll
        for (int vt = 0; vt < 4; ++vt)
#pragma unroll
            for (int i = 0; i < 16; ++i) { const float o = O[vt][i] * il[i] - lam * XO[(qs * 32 + crow(i, hf)) * 128 + vt * 32 + r32]; O[vt][i] = o; ss[i] += o * o; }
#pragma unroll
        for (int i = 0; i < 16; ++i) { float v = ss[i]; v += swz_xor<1>(v); v += swz_xor<2>(v); v += swz_xor<4>(v); v += swz_xor<8>(v); v += swz_xor<16>(v); ss[i] = 0.8f / sqrtf(v * (1.0f / 128.0f) + EPS); }
#pragma unroll
        for (int vt = 0; vt < 4; ++vt) {
            const float g = subg[vt * 32 + r32];
#pragma unroll
            for (int i = 0; i < 16; ++i) MIX[(size_t)(b * T + q0w + crow(i, hf)) * 1024 + 512 + h * 128 + vt * 32 + r32] = (bf16)f2bf(O[vt][i] * ss[i] * g);
        }
    }
}

DI float dpp_x1(float v) { return __builtin_bit_cast(float, __builtin_amdgcn_update_dpp(0, __builtin_bit_cast(int, v), 0xB1, 0xF, 0xF, true)); }
DI float dpp_x2(float v) { return __builtin_bit_cast(float, __builtin_amdgcn_update_dpp(0, __builtin_bit_cast(int, v), 0x4E, 0xF, 0xF, true)); }
DI float quad_sum(float v) { v += dpp_x1(v); v += dpp_x2(v); return v; }
struct ScanPtrs { const bf16 *R, *K, *V, *HD1, *W2T; const float *w0, *a0, *kk, *ka, *rk; bf16 *YF, *YB; float* BON; unsigned* ERR; };
constexpr int CS_AT = 0, CS_RT = 2304, CS_BK = 4608, CS_SMQ = 9728, CS_SMT = 11008, CS_NQ = 12288, CS_VT = 13568, CS_GL = 16640, CS_BUF = 16896;
constexpr int CS_PZ = 6 * CS_BUF;
constexpr int CS_W = CS_PZ + 4 * 4608;
constexpr int CS_WSZ = 4864;
constexpr int CS_BON = CS_W + 8 * CS_WSZ;
constexpr int CS_NS = CS_BON + 1536;
static_assert(CS_NS + 2048 + 16 <= LDS_MISC, "chunked-scan LDS map");
template <int CTRL> DI float dpp_mov0(float v) { return __builtin_bit_cast(float, __builtin_amdgcn_update_dpp(0, __builtin_bit_cast(int, v), CTRL, 0xF, 0xF, false)); }
DI float row_prefix(float v) { v += dpp_mov0<0x111>(v); v += dpp_mov0<0x112>(v); v += dpp_mov0<0x114>(v); v += dpp_mov0<0x118>(v); return v; }
DI float row_suffix(float v) { v += dpp_mov0<0x101>(v); v += dpp_mov0<0x102>(v); v += dpp_mov0<0x104>(v); v += dpp_mov0<0x108>(v); return v; }
DI bf16x8 lds16(const LAS unsigned char* p) { return *(const LAS bf16x8*)p; }
DI f32x4 mfma16(bf16x8 a, bf16x8 b, f32x4 c) { return __builtin_amdgcn_mfma_f32_16x16x32_bf16(a, b, c, 0, 0, 0); }

DI void scan_pair_mfma(const Frame& F0, int bh, const ScanPtrs& P) {
    const Frame F = fresh(F0);
    const int b = bh >> 4, h = bh & 15;
    const int z = F.wave >> 2, q4 = F.wave & 3;
    const int l15 = F.lane & 15, l4 = F.lane >> 4;
    const int te = l15, cg = l4, c4 = cg * 4;
    const int rr = z ? 15 - te : te;
    const int jl = 16 * q4 + c4;
    const int chq = h * 64 + 16 * q4;
    LAS unsigned char* const L = F.lds;
    LAS unsigned char* const wsc = L + CS_W + F.wave * CS_WSZ;
    LAS float* const scrW = (LAS float*)wsc; LAS float* const scrA = scrW + 16 * 20;
    LAS unsigned char* const ZB = wsc; LAS unsigned char* const XB = wsc + 2304; LAS unsigned char* const UB = wsc + 3072;
    LAS float* const yst = (LAS float*)(wsc + 3840);
    LAS float* const bonp = (LAS float*)(L + CS_BON);
    bf16* Y = z ? P.YB : P.YF;
    const bf16* w2p = P.W2T + (size_t)z * 65536 + (size_t)(chq + l15) * 64 + 8 * l4;
    bf16x8 Wf[2], Af[2];
#pragma unroll
    for (int ks = 0; ks < 2; ++ks) { Wf[ks] = *(const bf16x8*)(w2p + ks * 32); Af[ks] = *(const bf16x8*)(w2p + 2 * 65536 + ks * 32); }
    const f32x4 w0v = *(const f32x4*)(P.w0 + z * 1024 + chq + c4), a0v = *(const f32x4*)(P.a0 + z * 1024 + chq + c4);
    const f32x4 kkv = *(const f32x4*)(P.kk + chq + c4), kav = *(const f32x4*)(P.ka + chq + c4), rkv = *(const f32x4*)(P.rk + chq + c4);
    f32x4 kcn[4];
#pragma unroll
    for (int q = 0; q < 4; ++q) kcn[q] = *(const f32x4*)(P.kk + h * 64 + 16 * cg + q * 4);
    f32x4 Z[4];
#pragma unroll
    for (int jt = 0; jt < 4; ++jt) { const float zq = ozero(); Z[jt] = (f32x4){zq, zq, zq, zq}; }
    bf16x8 Ahw[2], Aha[2]; u32x2 r4, k4, v4; u32x4 kfull[2];
    auto do_load = [&](int c) {
        const int t0c = z ? T - 16 * (c + 1) : 16 * c; const size_t m0 = (size_t)b * T + t0c;
#pragma unroll
        for (int ks = 0; ks < 2; ++ks) { const bf16* p = P.HD1 + (m0 + l15) * 256 + z * 64 + 32 * ks + 8 * l4; Ahw[ks] = *(const bf16x8*)p; Aha[ks] = *(const bf16x8*)(p + 128); }
        const size_t off = (m0 + rr) * 1024;
        r4 = *(const u32x2*)(P.R + off + chq + c4); k4 = *(const u32x2*)(P.K + off + chq + c4); v4 = *(const u32x2*)(P.V + off + chq + c4);
        kfull[0] = ((const u32x4*)(P.K + off + h * 64 + 16 * cg))[0]; kfull[1] = ((const u32x4*)(P.K + off + h * 64 + 16 * cg))[1];
    };
    auto prep_a = [&](int c) {
        LAS unsigned char* const bp = L + (z * 3 + c % 3) * CS_BUF;
        LAS unsigned char* const pz = L + CS_PZ + (z * 2 + (c & 1)) * 4608;
        const float zq = ozero(); f32x4 dw = (f32x4){zq, zq, zq, zq}, da = dw;
#pragma unroll
        for (int ks = 0; ks < 2; ++ks) { dw = mfma16(Ahw[ks], Wf[ks], dw); da = mfma16(Aha[ks], Af[ks], da); }
#pragma unroll
        for (int rg = 0; rg < 4; ++rg) { scrW[(4 * l4 + rg) * 20 + l15] = dw[rg]; scrA[(4 * l4 + rg) * 20 + l15] = da[rg]; }
        float ssq = 0.f;
#pragma unroll
        for (int q = 0; q < 2; ++q)
#pragma unroll
            for (int w = 0; w < 4; ++w) { const float k0 = bflo(kfull[q][w]) * kcn[q * 2 + (w >> 1)][(w & 1) * 2], k1 = bfhi(kfull[q][w]) * kcn[q * 2 + (w >> 1)][(w & 1) * 2 + 1]; ssq += k0 * k0 + k1 * k1; }
        ssq += swz_xor<16>(ssq); ssq = half_sum(ssq);
        const float inv = __builtin_amdgcn_rsqf(fmaxf(ssq, 1e-24f));
        asm volatile("s_waitcnt lgkmcnt(0)" ::: "memory");
        const f32x4 wp = *(const LAS f32x4*)(scrW + rr * 20 + c4), ap = *(const LAS f32x4*)(scrA + rr * 20 + c4);
        const f32x4 kf = (f32x4){bflo(k4.x), bfhi(k4.x), bflo(k4.y), bfhi(k4.y)}, rf = (f32x4){bflo(r4.x), bfhi(r4.x), bflo(r4.y), bfhi(r4.y)}, vf = (f32x4){bflo(v4.x), bfhi(v4.x), bflo(v4.y), bfhi(v4.y)};
        f32x4 at, rt, bt, kt, bhh, khh, gl; float bon = 0.f;
#pragma unroll
        for (int j = 0; j < 4; ++j) {
            const float lw = -0.60653066f * LOG2E * sigmoidf_(wp[j] + w0v[j]);
            const float ar = sigmoidf_(ap[j] + a0v[j]);
            const float kkn = kf[j] * kkv[j] * inv;
            const float kd = kf[j] * (1.0f + (ar - 1.0f) * kav[j]);
            const float bvec = kkn * ar, avec = -kkn;
            const float pi = row_prefix(lw), su = row_suffix(lw) - lw;
            const float eI = fexp2(pi), eE = fexp2(pi - lw), eN = frcp(eI), eS = fexp2(su);
            at[j] = avec * eE; rt[j] = rf[j] * eI; bt[j] = bvec * eN; kt[j] = kd * eN; bhh[j] = bvec * eS; khh[j] = kd * eS; gl[j] = eI * eS;
            bon += rf[j] * kd * rkv[j];
        }
        const int co = jl * 2;
        { u32x2 w; w.x = pk2(at[0], at[1]); w.y = pk2(at[2], at[3]); *(LAS u32x2*)(bp + CS_AT + te * 144 + co) = w; }
        { u32x2 w; w.x = pk2(rt[0], rt[1]); w.y = pk2(rt[2], rt[3]); *(LAS u32x2*)(bp + CS_RT + te * 144 + co) = w; }
        { u32x2 w; w.x = pk2(bt[0], bt[1]); w.y = pk2(bt[2], bt[3]); *(LAS u32x2*)(pz + te * 144 + co) = w; }
        { u32x2 w; w.x = pk2(kt[0], kt[1]); w.y = pk2(kt[2], kt[3]); *(LAS u32x2*)(pz + 2304 + te * 144 + co) = w; }
#pragma unroll
        for (int j = 0; j < 4; ++j) {
            const unsigned bk = pk2(bhh[j], khh[j]);
            *(LAS bf16*)(bp + CS_BK + (jl + j) * 80 + te * 2) = (bf16)(bk & 0xffffu);
            *(LAS bf16*)(bp + CS_BK + (jl + j) * 80 + 32 + te * 2) = (bf16)(bk >> 16);
        }
        *(LAS bf16*)(bp + CS_VT + (jl + 0) * 48 + te * 2) = (bf16)(v4.x & 0xffffu); *(LAS bf16*)(bp + CS_VT + (jl + 1) * 48 + te * 2) = (bf16)(v4.x >> 16);
        *(LAS bf16*)(bp + CS_VT + (jl + 2) * 48 + te * 2) = (bf16)(v4.y & 0xffffu); *(LAS bf16*)(bp + CS_VT + (jl + 3) * 48 + te * 2) = (bf16)(v4.y >> 16);
        if (te == 0) *(LAS f32x4*)(bp + CS_GL + jl * 4) = gl;
        bon += swz_xor<16>(bon); bon = half_sum(bon);
        if (cg == 0) bonp[((z * 3 + c % 3) * 4 + q4) * 16 + rr] = bon;
    };
    LAS float* const nsm = (LAS float*)(L + CS_NS + z * 1024);
    volatile LAS unsigned* const nflag = (volatile LAS unsigned*)(L + CS_NS + 2048 + z * 8);
    auto prep_b1 = [&](int c) {
        LAS unsigned char* const bp = L + (z * 3 + c % 3) * CS_BUF;
        const LAS unsigned char* const pz = L + CS_PZ + (z * 2 + (c & 1)) * 4608;
        const LAS unsigned char* const arow = bp + CS_AT + l15 * 144 + 16 * l4;
        const LAS unsigned char* const brow = pz + l15 * 144 + 16 * l4;
        const float zq = ozero(); f32x4 Nn = (f32x4){zq, zq, zq, zq}, Qq = Nn;
#pragma unroll
        for (int ks = 0; ks < 2; ++ks) { const bf16x8 af = lds16(arow + 64 * ks); Nn = mfma16(af, lds16(brow + 64 * ks), Nn); Qq = mfma16(af, lds16(brow + 2304 + 64 * ks), Qq); }
#pragma unroll
        for (int r = 0; r < 4; ++r) nsm[(4 * l4 + r) * 16 + l15] = Nn[r];
        asm volatile("s_waitcnt lgkmcnt(0)" ::: "memory");
        if (F.lane == 0) *nflag = (unsigned)(c + 1);
#pragma unroll
        for (int r = 0; r < 4; r += 2) { const int t = 4 * l4 + r;
            const unsigned w = pk2(l15 < t ? Qq[r] : 0.f, l15 < t + 1 ? Qq[r + 1] : 0.f);
            *(LAS bf16*)(bp + CS_SMQ + t * 80 + l15 * 2) = (bf16)(w & 0xffffu); *(LAS bf16*)(bp + CS_SMQ + (t + 1) * 80 + l15 * 2) = (bf16)(w >> 16); }
    };
    auto prep_b2 = [&](int c) {
        LAS unsigned char* const bp = L + (z * 3 + c % 3) * CS_BUF;
        const LAS unsigned char* const pz = L + CS_PZ + (z * 2 + (c & 1)) * 4608;
        const LAS unsigned char* const arow = bp + CS_RT + l15 * 144 + 16 * l4;
        const LAS unsigned char* const brow = pz + l15 * 144 + 16 * l4;
        const float zq = ozero(); const f32x4 zero = (f32x4){zq, zq, zq, zq}; f32x4 Nr = zero, Qr = zero;
#pragma unroll
        for (int ks = 0; ks < 2; ++ks) { const bf16x8 af = lds16(arow + 64 * ks); Nr = mfma16(af, lds16(brow + 64 * ks), Nr); Qr = mfma16(af, lds16(brow + 2304 + 64 * ks), Qr); }
#pragma unroll
        for (int r = 0; r < 4; r += 2) { const int t = 4 * l4 + r;
            const unsigned w0 = pk2(l15 <= t ? Nr[r] : 0.f, l15 <= t + 1 ? Nr[r + 1] : 0.f), w1 = pk2(l15 <= t ? Qr[r] : 0.f, l15 <= t + 1 ? Qr[r + 1] : 0.f);
            *(LAS bf16*)(bp + CS_NQ + t * 80 + l15 * 2) = (bf16)(w0 & 0xffffu); *(LAS bf16*)(bp + CS_NQ + (t + 1) * 80 + l15 * 2) = (bf16)(w0 >> 16);
            *(LAS bf16*)(bp + CS_NQ + t * 80 + 32 + l15 * 2) = (bf16)(w1 & 0xffffu); *(LAS bf16*)(bp + CS_NQ + (t + 1) * 80 + 32 + l15 * 2) = (bf16)(w1 >> 16); }
        while (*nflag != (unsigned)(c + 1)) __builtin_amdgcn_s_sleep(1);
        asm volatile("" ::: "memory");
        f32x4 Nc, Mc;
        { const f32x4 mrow = *(const LAS f32x4*)(nsm + l15 * 16 + 4 * l4);
#pragma unroll
          for (int r = 0; r < 4; ++r) { const float n = nsm[(4 * l4 + r) * 16 + l15]; Nc[r] = (l15 < 4 * l4 + r) ? n : 0.f; Mc[r] = (4 * l4 + r < l15) ? mrow[r] : 0.f; } }
        auto prod = [&](const f32x4& lt, const f32x4& rc, f32x4 acc) __attribute__((always_inline)) {
#pragma unroll
            for (int ks = 0; ks < 4; ++ks) acc = __builtin_amdgcn_mfma_f32_16x16x4f32(lt[ks], rc[ks], acc, 0, 0, 0);
            return acc; };
        const f32x4 N2 = prod(Mc, Nc, zero), M2 = prod(Nc, Mc, zero);
        const f32x4 N4 = prod(M2, N2, zero), M4 = prod(N2, M2, zero);
        f32x4 R = prod(N4, M4, zero);
#pragma unroll
        for (int r = 0; r < 4; ++r) R[r] += (4 * l4 + r == l15) ? 1.0f : 0.0f;
        R = prod(N4, R, R); R = prod(N2, R, R); R = prod(Nc, R, R);
        { u32x2 w; w.x = pk2(R[0], R[1]); w.y = pk2(R[2], R[3]); *(LAS u32x2*)(bp + CS_SMT + l15 * 80 + 8 * l4) = w; }
    };
    auto stage_s = [&](int c) {
        const LAS unsigned char* const bp = L + (z * 3 + c % 3) * CS_BUF;
        const int q = l4, i = l15;
#pragma unroll
        for (int jt = 0; jt < 4; ++jt) { u32x2 w; w.x = pk2(Z[jt][0], Z[jt][1]); w.y = pk2(Z[jt][2], Z[jt][3]); *(LAS u32x2*)(ZB + i * 144 + (16 * jt + 4 * q) * 2) = w; }
        asm volatile("" ::: "memory");
        const bf16x8 Zb0 = lds16(ZB + i * 144 + (8 * q) * 2), Zb1 = lds16(ZB + i * 144 + (32 + 8 * q) * 2);
        const bf16x8 Vb = lds16(bp + CS_VT + (16 * q4 + i) * 48 + 8 * (q & 1) * 2);
        const LAS unsigned char* arow = bp + l15 * 144 + 8 * q * 2;
        const float zq = ozero(); const f32x4 zero = (f32x4){zq, zq, zq, zq};
        f32x4 X = mfma16(lds16(arow + CS_AT), Zb0, zero); f32x4 Yv = mfma16(lds16(arow + CS_RT), Zb0, zero);
        X = mfma16(lds16(arow + CS_AT + 64), Zb1, X); Yv = mfma16(lds16(arow + CS_RT + 64), Zb1, Yv);
        X = mfma16(lds16(bp + CS_SMQ + l15 * 80 + 16 * q), Vb, X);
        { u32x2 w; w.x = pk2(X[0], X[1]); w.y = pk2(X[2], X[3]); *(LAS u32x2*)(XB + i * 48 + 8 * q) = w; }
        asm volatile("" ::: "memory");
        const bf16x8 Xb = lds16(XB + i * 48 + 16 * (q & 1));
        const f32x4 U = mfma16(lds16(bp + CS_SMT + l15 * 80 + 16 * q), Xb, zero);
        { u32x2 w; w.x = pk2(U[0], U[1]); w.y = pk2(U[2], U[3]); *(LAS u32x2*)(UB + i * 48 + 8 * q) = w; }
        asm volatile("" ::: "memory");
        const bf16x8 Ub = lds16(UB + i * 48 + 16 * (q & 1));
        const bf16x8 UVb = q < 2 ? Ub : Vb;
        Yv = mfma16(lds16(bp + CS_NQ + l15 * 80 + 16 * q), UVb, Yv);
#pragma unroll
        for (int r = 0; r < 4; ++r) yst[(4 * q + r) * 16 + i] = Yv[r];
#pragma unroll
        for (int jt = 0; jt < 4; ++jt) { const f32x4 g = *(const LAS f32x4*)(bp + CS_GL + (16 * jt + 4 * q) * 4);
            Z[jt] = mfma16(lds16(bp + CS_BK + (16 * jt + l15) * 80 + 16 * q), UVb, Z[jt] * g); }
    };
    auto flush_y = [&](int c) {
        const int t0c = z ? T - 16 * (c + 1) : 16 * c; const int st = F.lane >> 2, i4 = (F.lane & 3) * 4;
        f32x4 yv = *(const LAS f32x4*)(yst + st * 16 + i4);
        u32x2 w; w.x = pk2(yv.x, yv.y); w.y = pk2(yv.z, yv.w);
        *(u32x2*)(Y + (size_t)(b * T + t0c + (z ? 15 - st : st)) * 1024 + chq + i4) = w;
    };
    auto bonus_flush = [&](int c) {
        if (q4 == 0 && F.lane < 16) {
            const int t0c = z ? T - 16 * (c + 1) : 16 * c; const size_t m0 = (size_t)b * T + t0c;
            const LAS float* qq = bonp + (z * 3 + c % 3) * 64 + F.lane;
            P.BON[((size_t)z * M + m0 + F.lane) * 16 + h] = (qq[0] + qq[16]) + (qq[32] + qq[48]);
        }
    };
    __syncthreads();
    for (int e = F.tid; e < 6 * 2 * 16 * 8; e += 512) { const int row = (e >> 3) & 15, tile = (e >> 7) & 1, zb = e >> 8, w = e & 7;
        *(LAS unsigned*)(L + zb * CS_BUF + (tile ? CS_SMT : CS_SMQ) + row * 80 + 32 + w * 4) = 0u; }
    const bool pa_wave = (q4 == z), pb_wave = (q4 == (z ^ 2));
    if (F.tid < 4) ((LAS unsigned*)(L + CS_NS + 2048))[F.tid] = 0u;
    constexpr int NC = T / 16;
    do_load(0); prep_a(0); do_load(1); prep_a(1);
    asm volatile("s_waitcnt lgkmcnt(0)" ::: "memory"); __builtin_amdgcn_s_barrier(); asm volatile("" ::: "memory");
    if (pa_wave) prep_b1(0);
    if (pb_wave) prep_b2(0);
    do_load(2);
    asm volatile("s_waitcnt lgkmcnt(0)" ::: "memory"); __builtin_amdgcn_s_barrier(); asm volatile("" ::: "memory");
    for (int e = 0; e < NC; ++e) {
        if (pa_wave && e + 1 < NC) prep_b1(e + 1);
        if (pb_wave && e + 1 < NC) prep_b2(e + 1);
        asm volatile("" ::: "memory");
        if (e > 0) flush_y(e - 1);
        if (e + 1 < NC) bonus_flush(e + 1);
        if (e == 0) bonus_flush(0);
#pragma unroll 1
        for (int st = 0; st < 2; ++st) {
            if ((st ^ z) == 0) {
                if (e + 2 < NC) prep_a(e + 2);
                asm volatile("" ::: "memory");
                if (e + 3 < NC) do_load(e + 3);
            } else {
                stage_s(e);
            }
            asm volatile("" ::: "memory");
        }
        asm volatile("s_waitcnt lgkmcnt(0)" ::: "memory");
        __builtin_amdgcn_s_barrier(); asm volatile("" ::: "memory");
    }
    flush_y(T / 16 - 1);
}

#define XB_TMO      128
#define XB_XCNT(j)  (256  + 64 * (j))
#define XB_XSUB(j)  (1280 + 64 * (j))
#define XB_XGEN(j)  (2304 + 64 * (j))
#define XB_TOP      3328
#define XB_TOPGEN   3392
#define XCD_BAR_WORDS 3456
#define XB_SPIN_CAP (1u << 22)
DI unsigned xb_ld(unsigned* p)              { return __hip_atomic_load(p, __ATOMIC_RELAXED, __HIP_MEMORY_SCOPE_AGENT); }
DI unsigned xb_add(unsigned* p, unsigned v) { return __hip_atomic_fetch_add(p, v, __ATOMIC_RELAXED, __HIP_MEMORY_SCOPE_AGENT); }
DI unsigned xb_xcc_id() { return (unsigned)__builtin_amdgcn_s_getreg((3 << 11) | 20) & 0xFu; }
#define XB_SPIN(cond, bar) do { unsigned _sp = 0; while (cond) { __builtin_amdgcn_s_sleep(1); \
    if ((++_sp & 255u) == 0u) { if (xb_ld(&(bar)[XB_TMO])) break; if (_sp > XB_SPIN_CAP) { atomicAdd(&(bar)[XB_TMO], 1u); break; } } } } while (0)
struct XcdBarrier { unsigned* bar; unsigned x; volatile LAS unsigned* st; };
DI XcdBarrier xcd_barrier_post(unsigned* bar, volatile LAS unsigned* st) {
    XcdBarrier b; b.bar = bar; b.x = xb_xcc_id(); b.st = st;
    if (threadIdx.x == 0) (void)xb_add(&bar[XB_XCNT(b.x)], 1u);
    return b;
}
DI void xcd_barrier_complete(unsigned* bar, unsigned x, unsigned& nloc, unsigned& nx) {
    const unsigned G = gridDim.x * gridDim.y * gridDim.z;
    unsigned sum, cnt, mine, sp = 0u;
    for (;;) {
        sum = 0u; cnt = 0u; mine = 0u;
#pragma unroll
        for (unsigned j = 0; j < 16; ++j) { const unsigned c = xb_ld(&bar[XB_XCNT(j)]); sum += c; cnt += (c > 0u) ? 1u : 0u; mine = (j == x) ? c : mine; }
        if (sum == G) break;
        __builtin_amdgcn_s_sleep(1);
        if ((++sp & 255u) == 0u) { if (xb_ld(&bar[XB_TMO])) break; if (sp > XB_SPIN_CAP) { atomicAdd(&bar[XB_TMO], 1u); break; } }
    }
    nloc = mine > 0u ? mine : 1u; nx = cnt > 0u ? cnt : 1u;
}
DI void xcd_barrier(const XcdBarrier& b) {
    asm volatile("s_waitcnt vmcnt(0)" ::: "memory");
    __syncthreads();
    if (threadIdx.x == 0) {
        unsigned* bar = b.bar;
        __builtin_amdgcn_s_waitcnt(0);
        unsigned nloc = b.st[0], nx = b.st[1];
        if (nloc == 0u) { xcd_barrier_complete(bar, b.x, nloc, nx); b.st[0] = nloc; b.st[1] = nx; }
        const unsigned old = xb_add(&bar[XB_XSUB(b.x)], 1u);
        const unsigned gen = old / nloc;
        if (old + 1u == (gen + 1u) * nloc) {
            __builtin_amdgcn_fence(__ATOMIC_RELEASE, "agent");
            asm volatile("s_waitcnt vmcnt(0)" ::: "memory");
            const unsigned og = xb_add(&bar[XB_TOP], 1u);
            const unsigned tg = og / nx;
            if (og + 1u == (tg + 1u) * nx) xb_add(&bar[XB_TOPGEN], 1u);
            else XB_SPIN(xb_ld(&bar[XB_TOPGEN]) == tg, bar);
            __builtin_amdgcn_fence(__ATOMIC_ACQUIRE, "agent");
            xb_add(&bar[XB_XGEN(b.x)], 1u);
            asm volatile("s_waitcnt vmcnt(0)" ::: "memory");
        } else {
            XB_SPIN(xb_ld(&bar[XB_XGEN(b.x)]) == gen, bar);
            __builtin_amdgcn_fence(__ATOMIC_ACQUIRE, "agent");
            asm volatile("s_waitcnt vmcnt(0)" ::: "memory");
        }
    }
    __syncthreads();
}

#ifndef MK_PROG
#define MK_PROG 0,3,4,5,7,8,10,11,12,13,16,14,15,17,19,20,22,23,24
#endif
__constant__ int PROG[] = {MK_PROG};
constexpr int NPH = sizeof(PROG) / sizeof(int);
template <int TYPE> struct PreSched {
    static constexpr int AJT = 1 << 30; static constexpr size_t ajump = 0;
    const bf16* KV; const bf16* W; int G, c;
    DI bool next(int i, Unit& u) const {
        const long L = (long)i * G + c; if (L >= 512) return false;
        const int rem = (int)L, i2 = rem >> 8, b = (rem >> 4) & 15, hh = (rem >> 2) & 3, t4 = rem & 3;
        u.pm = 0; u.pn = 0;
        const bf16* kvp = KV + (size_t)(b * 256) * 4096 + i2 * 2048 + hh * 256;
        const bf16* wp = W + (size_t)i2 * 1024 * 1024 + (size_t)(t4 * 256) * 1024 + hh * 256;
        if (TYPE == 0) { u.pa = (const char*)kvp; u.pb = (const char*)wp; u.z = (i2 << 30) | (b * 1048576 + hh * 256 * 1024 + t4 * 256); }
        else { u.pa = (const char*)wp; u.pb = (const char*)(kvp + 1024); u.z = (i2 << 30) | (16 * 1048576 + b * 1048576 + t4 * 256 * 1024 + hh * 256); }
        return true;
    }
};

__global__ void __launch_bounds__(512, 2) mk_fwd(Args a) {
    extern __shared__ __attribute__((aligned(16))) unsigned char lds_raw[];
    Frame F;
    F.lds = (LAS unsigned char*)lds_raw;
    F.tid = threadIdx.x; F.lane = F.tid & 63; F.wave = __builtin_amdgcn_readfirstlane(F.tid >> 6);
    F.gw = blockIdx.x * 8 + F.wave; F.ngw = gridDim.x * 8; F.ws = a.ws;
    cg::grid_group grid = cg::this_grid();
    volatile LAS unsigned* MISC = (volatile LAS unsigned*)(F.lds + LDS_MISC);
    if (F.tid < 2) MISC[F.tid] = 0u;
    __syncthreads();
    (void)xcd_barrier_post((unsigned*)(a.ws + WS_BAR), MISC);

    for (int pi = a.ph_lo; pi < a.ph_hi; ++pi) {
        const int ph = PROG[pi];
        const int G = opq(gridDim.x), cblk = opq(blockIdx.x);
        unsigned char* ws = a.ws + (size_t)opq(0);
        float* RS = (float*)(ws + WS_RS);
        bf16* SA = (bf16*)(ws + WS_SA); bf16* SB = (bf16*)(ws + WS_SB);
        bf16* H = (bf16*)a.out;
        const int li = ph >= 18 ? 1 : 0;
        int cp = ph; if (ph >= 18 && ph <= 23) cp = ph - 12;
#ifndef PH_MASK
#define PH_MASK 0xffffffffu
#endif
        if (!((PH_MASK >> cp) & 1u)) cp = 99;
        switch (cp) {
        case 0: phase_prologue(F, a, ws); break;
        case 3: {
            { pg8::PlainSched S{SA, (const bf16*)(ws + WS_WIN), 1024, 1024, M / 256, 8, G, cblk, 30, 0};
              EpiInProj E{(bf16*)(ws + WS_GLU), SB, RS};
              pg8::gemm_phase(F.lds, 1024, 1024, 1024, S, E); }
            { pg8::PlainSched S{(const bf16*)(ws + WS_WIN) + (size_t)2048 * 1024, SA, 1024, 1024, 2, M / 256, G, cblk, 30, 0};
              EpiVT E{(bf16*)(ws + WS_VT), RS};
              pg8::gemm_phase(F.lds, 1024, 1024, 1024, S, E); }
                    {

            pg8::PlainSched S{(const bf16*)(ws + WS_MEMB), (const bf16*)(ws + WS_WKV), 1024, 1024, MMEM / 256, 16, G, cblk, 30, 0};
            EpiRowScale<0> E{(bf16*)(ws + WS_KV), 4096, (const float*)(ws + WS_RSMEM), nullptr};
            pg8::gemm_phase(F.lds, 1024, 1024, 1024, S, E);
                    }
        } break;
        case 4: {
            const float lam = ((const float*)(ws + WS_LAM))[0];
            for (int u = cblk; u < 1024; u += G) diffattn_unit(F, u, SB, (const bf16*)(ws + WS_VT), (const float*)(ws + WS_BIAS), lam, a.in[opq(I_SUBLN)], (bf16*)(ws + WS_MIX));
            __syncthreads();
            conv_load_weights(F, a.in[opq(I_CONVW)]);
            for (int u = cblk; u < 512; u += G) conv_unit(F, u, (const bf16*)(ws + WS_GLU), a.in[opq(I_CONVB)], a.in[opq(I_CLNG)], a.in[opq(I_CLNB)], (bf16*)(ws + WS_MIX));
            __syncthreads();
                    {

            EpiPre E{(bf16*)(ws + WS_G0)};
            { PreSched<0> S{(const bf16*)(ws + WS_KV), (const bf16*)(ws + WS_WQN), G, cblk}; pg8::gemm_phase(F.lds, 256, 4096, 1024, S, E); }
            { PreSched<1> S{(const bf16*)(ws + WS_KV), (const bf16*)(ws + WS_WXO), G, cblk}; pg8::gemm_phase(F.lds, 256, 1024, 4096, S, E); }
                    }
        } break;
        case 5: {
            pg8::PlainSched S{(const bf16*)(ws + WS_MIX), (const bf16*)(ws + WS_WOUT), 1024, 1024, M / 256, 4, G, cblk, 30, 0};
            EpiResid E{a.in[opq(I_X)], nullptr, H, (float*)(ws + WS_PS)};
            pg8::gemm_phase(F.lds, 1024, 1024, 1024, S, E);
        } break;
        case 7: {
            pg8::PlainSched S{H, (const bf16*)(ws + (li ? WS_G1 : WS_G0)), 1024, 1024, M / 256, 4, G, cblk, 3, (size_t)1048576};
            EpiSoftmax E{SB, (const float*)(ws + WS_PS)};
            pg8::gemm_phase(F.lds, 1024, 1024, 1024, S, E);
        } break;
        case 8: {
            pg8::PlainSched S{SB, (const bf16*)(ws + (li ? WS_VW1 : WS_VW0)), 1024, 1024, M / 256, 4, G, cblk, 3, (size_t)1048576};
            EpiResid E{nullptr, H, H, (float*)(ws + WS_PS)};
            pg8::gemm_phase(F.lds, 1024, 1024, 1024, S, E);
        } break;
        case 10: {
            pg8::PlainSched S{H, (const bf16*)(ws + WS_WUP) + (size_t)li * 4096 * 1024, 1024, 1024, M / 256, 16, G, cblk, 30, 0};
            EpiRowScale<2> E{(bf16*)(ws + WS_HID), 4096, nullptr, (const float*)(ws + WS_PS)};
            pg8::gemm_phase(F.lds, 1024, 1024, 1024, S, E);
        } break;
        case 11: {
            pg8::PlainSched S{(const bf16*)(ws + WS_HID), (const bf16*)(ws + WS_WDN) + (size_t)li * 1024 * 4096, 4096, 4096, M / 256, 4, G, cblk, 30, 0};
            EpiResid E{nullptr, H, li ? SA : H, nullptr};
            pg8::gemm_phase(F.lds, 4096, 4096, 4096, S, E);
        } break;
        case 12: phase_rwkv_shift(F, H, a.in[opq(I_NMIX)] + 1024, a.in[opq(I_MU)], (bf16*)(ws + WS_XR), (bf16*)a.out + (size_t)M * 1024, (bf16*)(ws + WS_XV), (bf16*)(ws + WS_HH)); break;
        case 13: {
            pg8::SelSched<4, 1 << 30> S{(const bf16*)a.out + (size_t)M * 1024, (const bf16*)(ws + WS_XV), (const bf16*)(ws + WS_WBIG) + (size_t)1024 * 1024, 1024, 1024, M / 256, 8, 4, G, cblk, 0};
            EpiRwkv E{(bf16*)(ws + WS_R), (bf16*)(ws + WS_K), (bf16*)(ws + WS_V), (bf16*)(ws + WS_HD1), (bf16*)(ws + WS_HD2)};
            pg8::gemm_phase(F.lds, 1024, 1024, 1024, S, E);
        } break;
        case 16: {
            EpiRwkv E{(bf16*)(ws + WS_R), (bf16*)(ws + WS_K), (bf16*)(ws + WS_V), (bf16*)(ws + WS_HD1), (bf16*)(ws + WS_HD2)};
            { pg8::SelSched<0, 1 << 30> S{(const bf16*)(ws + WS_XR), (const bf16*)(ws + WS_XR), (const bf16*)(ws + WS_WBIG), 1024, 1024, M / 256, 4, 4, G, cblk, 0};
              pg8::gemm_phase(F.lds, 1024, 1024, 1024, S, E); }
            { pg8::SelSched<12, 16> S{(const bf16*)(ws + WS_XR), (const bf16*)(ws + WS_XR), (const bf16*)(ws + WS_WLORA), 1024, 2048, M / 256, 2, 2, G, cblk, ((size_t)M * 1024 - 1024) * 2};
              pg8::gemm_phase(F.lds, 2048, 1024, 2048, S, E); }
        } break;
        case 14: {
            ScanPtrs P{(const bf16*)(ws + WS_R), (const bf16*)(ws + WS_K), (const bf16*)(ws + WS_V), (const bf16*)(ws + WS_HD1), (const bf16*)(ws + WS_W2T),
                       a.in[opq(I_W0)], a.in[opq(I_A0)], a.in[opq(I_KK)], a.in[opq(I_KA)], a.in[opq(I_RK)], (bf16*)(ws + WS_YF), (bf16*)(ws + WS_YB), (float*)(ws + WS_BONUS), (unsigned*)(ws + WS_BAR + 32768)};
            for (int bh = cblk; bh < 256; bh += G) scan_pair_mfma(F, bh, P);
            __syncthreads();
        } break;
        case 15: {
            pg8::PlainSched S{(const bf16*)(ws + WS_HD2), (const bf16*)(ws + WS_G2T), 256, 256, M / 256, 4, G, cblk, 30, 0};
            EpiGateComb E{(const bf16*)(ws + WS_YF), (const bf16*)(ws + WS_YB), (const bf16*)(ws + WS_V), (const float*)(ws + WS_BONUS), a.in[opq(I_LNG)], a.in[opq(I_LNB)], (bf16*)(ws + WS_COMB)};
            pg8::gemm_phase(F.lds, 256, 256, 256, S, E);
        } break;
        case 17: {
            pg8::PlainSched S{(const bf16*)(ws + WS_COMB), (const bf16*)(ws + WS_WRO), 1024, 1024, M / 256, 4, G, cblk, 30, 0};
            EpiResid E{nullptr, H, H, (float*)(ws + WS_PS)};
            pg8::gemm_phase(F.lds, 1024, 1024, 1024, S, E);
        } break;
        case 24: {
            float osc = 1.0f;
            phase_final_norm(F, SA, a.out, a.in[opq(I_NFINAL)], osc);
        } break;
        default: break;
        }
        if (pi + 1 < a.ph_hi) {
            if (a.ph_lo < 0) grid.sync();
            { XcdBarrier xb; xb.bar = (unsigned*)(ws + WS_BAR); xb.x = xb_xcc_id(); xb.st = (volatile LAS unsigned*)(F.lds + LDS_MISC); xcd_barrier(xb); }
        }
    }
}

extern "C" void kernel_launch(void* const* d_in, const int* in_sizes, int n_in, void* d_out, int out_size, void* d_ws, size_t ws_size, hipStream_t stream) {
    static int grid = 0;
    if (grid == 0) {
        if (n_in != N_IN || in_sizes[0] != M * D || out_size != M * D || ws_size < WS_NEED) {
            fprintf(stderr, "kernel_launch: unexpected problem (n_in %d, in0 %d, out %d, ws %zu); nothing launched\n", n_in, n_in > 0 ? in_sizes[0] : -1, out_size, ws_size); grid = -1; return; }
        int dev = 0, cus = 0, per_cu = 0;
        if (hipGetDevice(&dev) != hipSuccess || hipDeviceGetAttribute(&cus, hipDeviceAttributeMultiprocessorCount, dev) != hipSuccess) { grid = -1; return; }
        if (hipFuncSetAttribute((const void*)mk_fwd, hipFuncAttributeMaxDynamicSharedMemorySize, LDS_BYTES) != hipSuccess) { fprintf(stderr, "kernel_launch: hipFuncSetAttribute failed\n"); grid = -1; return; }
        if (hipOccupancyMaxActiveBlocksPerMultiprocessor(&per_cu, (const void*)mk_fwd, 512, LDS_BYTES) != hipSuccess || per_cu < 1) { fprintf(stderr, "kernel_launch: occupancy query says %d\n", per_cu); (void)hipGetLastError(); grid = -1; return; }
        grid = cus;
    }
    if (grid < 0) return;
    if (hipMemsetAsync((char*)d_ws + WS_BAR, 0, 65536, stream) != hipSuccess) { fprintf(stderr, "kernel_launch: memset failed\n"); return; }
    Args a{};
    for (int i = 0; i < N_IN; ++i) a.in[i] = (const float*)d_in[i];
    a.out = (float*)d_out; a.ws = (unsigned char*)d_ws;
#if MK_SINGLE
    a.ph_lo = 0; a.ph_hi = NPH;
    void* params[] = {&a};
    hipError_t e = hipLaunchCooperativeKernel((const void*)mk_fwd, dim3(grid), dim3(512), params, LDS_BYTES, stream);
    if (e != hipSuccess) fprintf(stderr, "kernel_launch: cooperative launch failed: %s\n", hipGetErrorString(e));
#else
    for (int ph = 0; ph < NPH; ++ph) { a.ph_lo = ph; a.ph_hi = ph + 1; hipLaunchKernelGGL(mk_fwd, dim3(grid), dim3(512), LDS_BYTES, stream, a); }
#endif
}
```

```cpp
#include <hip/hip_runtime.h>
#include <hip/hip_cooperative_groups.h>
#include <cstdio>
#include <cstdint>
namespace cg = cooperative_groups;

#ifndef MK_SINGLE
#define MK_SINGLE 1
#endif

#define LAS __attribute__((address_space(3)))
#define DI __device__ __forceinline__
typedef unsigned short bf16;
typedef short bf16x8 __attribute__((ext_vector_type(8)));
typedef short s16x4 __attribute__((ext_vector_type(4)));
typedef float f32x2 __attribute__((ext_vector_type(2)));
typedef float f32x4 __attribute__((ext_vector_type(4)));
typedef float f32x16 __attribute__((ext_vector_type(16)));
typedef unsigned u32x2 __attribute__((ext_vector_type(2)));
typedef unsigned u32x4 __attribute__((ext_vector_type(4)));

constexpr int D = 1024, NB = 16, T = 2048, M = NB * T, NMEM = 256, MMEM = NB * NMEM;
constexpr int FF = 4096;
constexpr float EPS = 1e-6f;
constexpr float LOG2E = 1.4426950408889634f;

constexpr size_t MiB = 1u << 20;
constexpr size_t WS_BAR = 0;
constexpr size_t WS_RS = 64 * 1024;
constexpr size_t WS_RSMEM = WS_RS + M * 4;
constexpr size_t WS_BIAS = WS_RSMEM + MMEM * 4;
constexpr size_t WS_LAM = WS_BIAS + 4 * 4096 * 4;
constexpr size_t WS_WIN = 1 * MiB;
constexpr size_t WS_WOUT = WS_WIN + 5 * MiB;
constexpr size_t WS_WQN = WS_WOUT + 2 * MiB;
constexpr size_t WS_WKV = WS_WQN + 4 * MiB;
constexpr size_t WS_WXO = WS_WKV + 8 * MiB;
constexpr size_t WS_WUP = WS_WXO + 4 * MiB;
constexpr size_t WS_WDN = WS_WUP + 16 * MiB;
constexpr size_t WS_WBIG = WS_WDN + 16 * MiB;
constexpr size_t WS_WLORA = WS_WBIG + 6 * MiB;
constexpr size_t WS_W2T = WS_WBIG + 14 * MiB;
constexpr size_t WS_G2T = WS_W2T + 512 * 1024;
constexpr size_t WS_WRO = WS_G2T + 512 * 1024;
constexpr size_t WS_WEND = WS_WRO + 2 * MiB;
static_assert(WS_WEND == 73 * MiB, "weight map");
constexpr size_t WS_SA = 73 * MiB;
constexpr size_t WS_SB = 137 * MiB;
constexpr size_t WS_GLU = 201 * MiB;
constexpr size_t WS_VT = 233 * MiB;
constexpr size_t WS_MIX = 265 * MiB;
constexpr size_t WS_G0 = 329 * MiB;
constexpr size_t WS_VW0 = 361 * MiB;
constexpr size_t WS_MEMB = 393 * MiB;
constexpr size_t WS_KV = 401 * MiB;
constexpr size_t WS_G1 = 433 * MiB;
constexpr size_t WS_VW1 = 465 * MiB;
static_assert(WS_G1 - WS_G0 == 104 * MiB && WS_VW0 - WS_G0 == 32 * MiB && WS_VW1 - WS_G1 == 32 * MiB, "G / VW spacing used by EpiPre");
constexpr size_t WS_BONUS = 497 * MiB;
constexpr size_t WS_PS = 502 * MiB;
constexpr size_t WS_HID = 137 * MiB;
constexpr size_t WS_XR = 73 * MiB, WS_HH = 137 * MiB, WS_XV = 201 * MiB;
constexpr size_t WS_R = 201 * MiB, WS_K = 265 * MiB, WS_V = 329 * MiB;
static_assert(WS_K - WS_R == 64 * MiB && WS_V - WS_K == 64 * MiB, "r, k, v spacing used by EpiRwkv");
constexpr size_t WS_HD1 = 393 * MiB;
constexpr size_t WS_HD2 = 409 * MiB;
constexpr size_t WS_YF = 73 * MiB, WS_YB = 137 * MiB;
constexpr size_t WS_GATE = 265 * MiB;
constexpr size_t WS_COMB = 201 * MiB;
constexpr size_t WS_NEED = 512 * MiB;

constexpr int LDS_X = 131072;
constexpr int LDS_MISC = 163840 - 256;
constexpr int LDS_BYTES = 163840;

DI unsigned f2bf(float f) { unsigned u = __builtin_bit_cast(unsigned, f); return (u + 0x7fffu + ((u >> 16) & 1u)) >> 16; }
typedef __bf16 bf16x2v __attribute__((ext_vector_type(2)));
DI unsigned pk2(float lo, float hi) { const f32x2 v = {lo, hi}; return __builtin_bit_cast(unsigned, __builtin_convertvector(v, bf16x2v)); }
DI float bf2f(unsigned short b) { return __builtin_bit_cast(float, ((unsigned)b) << 16); }
DI float bflo(unsigned w) { return __builtin_bit_cast(float, w << 16); }
DI float bfhi(unsigned w) { return __builtin_bit_cast(float, w & 0xffff0000u); }
template <int MASK> DI float swz_xor(float v) { return __builtin_bit_cast(float, __builtin_amdgcn_ds_swizzle(__builtin_bit_cast(int, v), (MASK << 10) | 0x1f)); }
DI float half_sum(float v) { const int x = __builtin_bit_cast(int, v); const auto r = __builtin_amdgcn_permlane32_swap(x, x, false, false); return __builtin_bit_cast(float, (int)r[0]) + __builtin_bit_cast(float, (int)r[1]); }
DI float half_max(float v) { const int x = __builtin_bit_cast(int, v); const auto r = __builtin_amdgcn_permlane32_swap(x, x, false, false); return fmaxf(__builtin_bit_cast(float, (int)r[0]), __builtin_bit_cast(float, (int)r[1])); }
DI float wave_sum(float v) {
    v += swz_xor<1>(v); v += swz_xor<2>(v); v += swz_xor<4>(v); v += swz_xor<8>(v); v += swz_xor<16>(v); v = half_sum(v);
    return v;
}
DI float ozero() { float z; asm volatile("v_mov_b32 %0, 0" : "=v"(z)); return z; }
DI int opaque(int x) { asm volatile("" : "+v"(x)); return x; }
template <class Tp> DI Tp* opq_ptr(Tp* p) { asm volatile("" : "+s"(p)); return p; }
DI int opq(int x) { asm volatile("" : "+s"(x)); return x; }
DI float fexp2(float x) { return __builtin_amdgcn_exp2f(x); }
DI float frcp(float x) { return __builtin_amdgcn_rcpf(x); }
DI float sigmoidf_(float x) { return frcp(1.0f + fexp2(-x * LOG2E)); }
DI float tanhf_(float x) { float e = fexp2(-2.0f * LOG2E * fabsf(x)); float t = (1.0f - e) * frcp(1.0f + e); return x < 0.f ? -t : t; }

namespace pg8 {
constexpr int BM = 256, BK = 64, HALF = 128, HTB = HALF * BK * 2, STAGE_BYTES = 8 * HTB, NXCD = 8, WGM = 8;
DI int lds_byte(int r, int c) { const int st = (r >> 4) * 2 + (c >> 5), rr = r & 15, cc = c & 31, ob = rr * 64 + cc * 2; return st * 1024 + (ob ^ (((ob >> 9) & 1) << 5)); }
DI void stage_rc(int b, int& R, int& C) { const int st = b / 1024, sb = b % 1024, swz = sb ^ (((sb >> 9) & 1) << 5); R = (st >> 1) * 16 + swz / 64; C = (st & 1) * 32 + (swz % 64) / 2; }
DI int perm32(int rho) { const int n = rho >> 4, i = rho & 15; return 8 * (i >> 2) + 4 * n + (i & 3); }

struct Unit { int pm, pn, z; const char* pa; const char* pb; };

DI bool tile_order(long L, int nM, int nN, int& pm, int& pn) {
    const int nwg = nM * nN; if (L >= nwg) return false;
    int wgid = (int)L; { const int q = nwg / NXCD, r = nwg % NXCD, xcd = wgid % NXCD, off = wgid / NXCD; wgid = (xcd < r ? xcd * (q + 1) : r * (q + 1) + (xcd - r) * q) + off; }
    const int nig = WGM * nN, gid = wgid / nig, fm = gid * WGM, gsz = (nM - fm) < WGM ? (nM - fm) : WGM;
    pm = fm + ((wgid % nig) % gsz); pn = (wgid % nig) / gsz; return true;
}
struct PlainSched {
    static constexpr int AJT = 1 << 30; static constexpr size_t ajump = 0;
    const bf16* A; const bf16* Bt; int lda, ldb, nM, nN, G, c, bshift; size_t bstride;
    DI bool next(int i, Unit& u) const {
        if (!tile_order((long)i * G + c, nM, nN, u.pm, u.pn)) return false;
        u.z = u.pm >> bshift;
        u.pa = (const char*)(A + (size_t)u.pm * 256 * lda);
        u.pb = (const char*)(Bt + (size_t)u.z * bstride + (size_t)u.pn * 256 * ldb);
        return true;
    }
};

template <int PN0, int AJT_> struct SelSched {
    static constexpr int AJT = AJT_;
    const bf16* A0; const bf16* A1; const bf16* Bt; int lda, ldb, nM, nN, split, G, c; size_t ajump;
    DI bool next(int i, Unit& u) const {
        int pn; if (!tile_order((long)i * G + c, nM, nN, u.pm, pn)) return false;
        u.z = 0; u.pn = pn + PN0;
        u.pa = (const char*)((pn < split ? A0 : A1) + (size_t)u.pm * 256 * lda);
        u.pb = (const char*)(Bt + (size_t)pn * 256 * ldb);
        return true;
    }
};
DI unsigned cvt_pk_bf16(float lo, float hi) { return pk2(lo, hi); }

template <class Epi, class Sched>
DI void gemm_phase(LAS unsigned char* lds, const int K, const int lda, const int ldb, const Sched& S, const Epi& E) {
    const int tid = opaque(threadIdx.x), wid = __builtin_amdgcn_readfirstlane(tid >> 6), lane = tid & 63, wr = wid >> 2, wc = wid & 3, fr = lane & 15, fq = lane >> 4;
    const int nt = K / BK;
    unsigned voffA[2], voffB[2];
#pragma unroll
    for (int i = 0; i < 2; ++i) { int R, C; stage_rc(tid * 16 + i * 8192, R, C); const int Rb = Epi::PERM ? ((R & ~31) + perm32(R & 31)) : R;
        voffA[i] = (unsigned)(R * lda + C) * 2u; voffB[i] = (unsigned)(Rb * ldb + C) * 2u; }
    const size_t kstep = (size_t)(BK * 2);
    const size_t hstepA = (size_t)HALF * lda * 2, hstepB = (size_t)HALF * ldb * 2;
    const unsigned ldsw = (unsigned)wid * 1024u;
    const int aoff = lds_byte(wr * 64 + fr, fq * 8), boff = lds_byte(wc * 32 + fr, fq * 8);
#define PG8_SA(b, h) (((b) * 2 + (h)) * HTB)
#define PG8_SB(b, h) ((4 + (b) * 2 + (h)) * HTB)
#define PG8_STAGE(bufoff, gbase, voff) do { _Pragma("unroll") for (int _i = 0; _i < 2; ++_i) \
        __builtin_amdgcn_global_load_lds((const unsigned*)((const char*)(gbase) + (voff)[_i]), (LAS unsigned*)(lds + (bufoff) + ldsw + _i * 8192), 16, 0, 0); } while (0)
#define PG8_LDA(dst, b, h) do { _Pragma("unroll") for (int m = 0; m < 4; ++m) _Pragma("unroll") for (int k = 0; k < 2; ++k) dst[m][k] = *(const LAS bf16x8*)(lds + PG8_SA(b, h) + aoff + m * 2048 + k * 1024); } while (0)
#define PG8_LDB(dst, b, h) do { _Pragma("unroll") for (int n = 0; n < 2; ++n) _Pragma("unroll") for (int k = 0; k < 2; ++k) dst[n][k] = *(const LAS bf16x8*)(lds + PG8_SB(b, h) + boff + n * 2048 + k * 1024); } while (0)
#define PG8_MMA(ai, bj, At, Bt) do { __builtin_amdgcn_s_setprio(1); _Pragma("unroll") for (int m = 0; m < 4; ++m) _Pragma("unroll") for (int n = 0; n < 2; ++n) _Pragma("unroll") for (int k = 0; k < 2; ++k) \
        acc[ai][bj][m][n] = __builtin_amdgcn_mfma_f32_16x16x32_bf16(Bt[n][k], At[m][k], acc[ai][bj][m][n], 0, 0, 0); __builtin_amdgcn_s_setprio(0); } while (0)
#define PG8_WAIT_V(n) asm volatile("s_waitcnt vmcnt(" #n ")" ::: "memory")
#define PG8_WAIT_L(n) asm volatile("s_waitcnt lgkmcnt(" #n ")" ::: "memory")
#define PG8_BAR __builtin_amdgcn_s_barrier()
#define PG8_SCHED __builtin_amdgcn_sched_barrier(0)
    Unit cur, nxt; int ui = 0;
    if (!S.next(0, cur)) return;
    f32x4 acc[2][2][4][2];
    { const float z0 = ozero();
#pragma unroll
    for (int a = 0; a < 2; ++a)
#pragma unroll
        for (int b = 0; b < 2; ++b)
#pragma unroll
            for (int m = 0; m < 4; ++m)
#pragma unroll
                for (int n = 0; n < 2; ++n) acc[a][b][m][n] = (f32x4){z0, z0, z0, z0}; }
    bf16x8 At[4][2], B0[2][2], B1[2][2];
    const char* cA = cur.pa; const char* cB = cur.pb;
    PG8_STAGE(PG8_SB(0, 0), cB, voffB); PG8_STAGE(PG8_SB(0, 1), cB + hstepB, voffB); PG8_STAGE(PG8_SA(0, 0), cA, voffA); PG8_STAGE(PG8_SA(0, 1), cA + hstepA, voffA);
    if (wr == 1) PG8_BAR;
    PG8_WAIT_V(2); PG8_BAR;
    PG8_STAGE(PG8_SB(1, 0), cB + kstep, voffB); PG8_STAGE(PG8_SA(1, 0), cA + kstep, voffA); PG8_STAGE(PG8_SB(1, 1), cB + hstepB + kstep, voffB);
    PG8_WAIT_V(6); PG8_BAR;
    for (;;) {
        const bool has_next = S.next(ui + 1, nxt);
        const char* nA = has_next ? nxt.pa : cA; const char* nB = has_next ? nxt.pb : cB;
#pragma unroll 1
        for (int t = 0; t < nt; t += 2) {
            const bool last = (t == nt - 2);
            const char* a1 = cA + (size_t)(t + 1) * kstep + (t + 1 >= Sched::AJT ? S.ajump : (size_t)0);
            const char* a2 = last ? nA : cA + (size_t)(t + 2) * kstep + (t + 2 >= Sched::AJT ? S.ajump : (size_t)0); const char* b2 = last ? nB : cB + (size_t)(t + 2) * kstep;
            const char* a3 = a2 + kstep; const char* b3 = b2 + kstep;
            PG8_LDB(B0, 0, 0); PG8_LDB(B1, 0, 1); PG8_SCHED; PG8_LDA(At, 0, 0); PG8_STAGE(PG8_SA(1, 1), a1 + hstepA, voffA);
            PG8_WAIT_V(8); PG8_WAIT_L(0); PG8_BAR; PG8_MMA(0, 0, At, B0); PG8_MMA(0, 1, At, B1); PG8_BAR; PG8_SCHED;
            PG8_LDA(At, 0, 1); PG8_STAGE(PG8_SB(0, 0), b2, voffB); PG8_STAGE(PG8_SB(0, 1), b2 + hstepB, voffB); PG8_STAGE(PG8_SA(0, 0), a2, voffA);
            PG8_WAIT_V(8); PG8_WAIT_L(0); PG8_BAR; PG8_MMA(1, 0, At, B0); PG8_MMA(1, 1, At, B1); PG8_BAR; PG8_SCHED;
            PG8_LDB(B0, 1, 0); PG8_LDB(B1, 1, 1); PG8_SCHED; PG8_LDA(At, 1, 0); PG8_STAGE(PG8_SA(0, 1), a2 + hstepA, voffA);
            PG8_WAIT_V(8); PG8_WAIT_L(0); PG8_BAR; PG8_MMA(0, 0, At, B0); PG8_MMA(0, 1, At, B1); PG8_BAR; PG8_SCHED;
            PG8_LDA(At, 1, 1); PG8_STAGE(PG8_SB(1, 0), b3, voffB); PG8_STAGE(PG8_SB(1, 1), b3 + hstepB, voffB); PG8_STAGE(PG8_SA(1, 0), a3, voffA);
            PG8_WAIT_V(8); PG8_WAIT_L(0); PG8_BAR; PG8_MMA(1, 0, At, B0); PG8_MMA(1, 1, At, B1); PG8_BAR; PG8_SCHED;
        }
        if (wr == 0) PG8_BAR;
        E(acc, cur, wr, wc, fr, fq, lds);
        if (!has_next) break;
        { const float z0 = ozero();
#pragma unroll
        for (int a = 0; a < 2; ++a)
#pragma unroll
            for (int b = 0; b < 2; ++b)
#pragma unroll
                for (int m = 0; m < 4; ++m)
#pragma unroll
                    for (int n = 0; n < 2; ++n) acc[a][b][m][n] = (f32x4){z0, z0, z0, z0}; }
        cur = nxt; cA = nA; cB = nB; ++ui;
        if (wr == 1) PG8_BAR;
    }
    PG8_WAIT_V(0);
    PG8_BAR;
#undef PG8_SA
#undef PG8_SB
#undef PG8_STAGE
#undef PG8_LDA
#undef PG8_LDB
#undef PG8_MMA
#undef PG8_WAIT_V
#undef PG8_WAIT_L
#undef PG8_BAR
#undef PG8_SCHED
}
}
using pg8::Unit;

DI void store8(bf16* p, const f32x4 v0, const f32x4 v1) {
    u32x4 w; w.x = pk2(v0[0], v0[1]); w.y = pk2(v0[2], v0[3]); w.z = pk2(v1[0], v1[1]); w.w = pk2(v1[2], v1[3]);
    *(u32x4*)p = w;
}
#define EPI_ARGS f32x4 (&acc)[2][2][4][2], const Unit& u, int wr, int wc, int fr, int fq, LAS unsigned char* lds

DI float rs_ps(const float* ps, int row) {
    const f32x4* p = (const f32x4*)(ps + (size_t)row * 16); const f32x4 a = p[0], b = p[1], c = p[2], d = p[3];
    const float s = ((a.x + a.y) + (a.z + a.w)) + ((b.x + b.y) + (b.z + b.w)) + (((c.x + c.y) + (c.z + c.w)) + ((d.x + d.y) + (d.z + d.w)));
    return 1.0f / sqrtf(s * (1.0f / D) + EPS);
}
template <int ACT> struct EpiRowScale {
    static constexpr bool PERM = true;
    bf16* O; int ldc; const float* rs; const float* ps;
    DI void operator()(EPI_ARGS) const {
        const int row0 = u.pm * 256 + wr * 64 + fr, col0 = u.pn * 256 + wc * 32 + 8 * fq;
#pragma unroll
        for (int ai = 0; ai < 2; ++ai)
#pragma unroll
            for (int m = 0; m < 4; ++m) {
                const int row = row0 + ai * 128 + m * 16; const float s = ps ? rs_ps(ps, row) : (rs ? rs[row] : 1.0f);
                bf16* rowp = O + (size_t)row * ldc + col0;
#pragma unroll
                for (int bj = 0; bj < 2; ++bj) { f32x4 v0 = acc[ai][bj][m][0] * s, v1 = acc[ai][bj][m][1] * s;
                    if (ACT == 2) {
#pragma unroll
                        for (int j = 0; j < 4; ++j) { float a = fmaxf(v0[j], 0.f), b = fmaxf(v1[j], 0.f); v0[j] = a * a; v1[j] = b * b; } }
                    store8(rowp + bj * 128, v0, v1); }
            }
    }
};
struct EpiInProj {
    static constexpr bool PERM = true;
    bf16* GLU; bf16* QK; const float* rs;
    DI void operator()(EPI_ARGS) const {
        const int row0 = u.pm * 256 + wr * 64 + fr;
        if (u.pn < 4) {
            const int col0 = u.pn * 128 + wc * 32 + 8 * fq;
#pragma unroll
            for (int ai = 0; ai < 2; ++ai)
#pragma unroll
                for (int m = 0; m < 4; ++m) {
                    const int row = row0 + ai * 128 + m * 16; const float s = rs[row];
                    f32x4 o0, o1;
#pragma unroll
                    for (int j = 0; j < 4; ++j) { o0[j] = acc[ai][0][m][0][j] * s * sigmoidf_(acc[ai][1][m][0][j] * s); o1[j] = acc[ai][0][m][1][j] * s * sigmoidf_(acc[ai][1][m][1][j] * s); }
                    store8(GLU + (size_t)row * 512 + col0, o0, o1);
                }
        } else {
            const int col0 = (u.pn - 4) * 256 + wc * 32 + 8 * fq;
#pragma unroll
            for (int ai = 0; ai < 2; ++ai)
#pragma unroll
                for (int m = 0; m < 4; ++m) {
                    const int row = row0 + ai * 128 + m * 16; const float s = rs[row];
#pragma unroll
                    for (int bj = 0; bj < 2; ++bj) store8(QK + (size_t)row * 1024 + col0 + bj * 128, acc[ai][bj][m][0] * s, acc[ai][bj][m][1] * s);
                }
        }
    }
};
struct EpiVT {
    static constexpr bool PERM = true;
    bf16* O; const float* cs;
    DI void operator()(EPI_ARGS) const {
        const int row0 = u.pm * 256 + wr * 64 + fr, col0 = u.pn * 256 + wc * 32 + 8 * fq;
        f32x4 c[2][2];
#pragma unroll
        for (int bj = 0; bj < 2; ++bj) { c[bj][0] = *(const f32x4*)(cs + col0 + bj * 128); c[bj][1] = *(const f32x4*)(cs + col0 + bj * 128 + 4); }
#pragma unroll
        for (int ai = 0; ai < 2; ++ai)
#pragma unroll
            for (int m = 0; m < 4; ++m) {
                const int row = row0 + ai * 128 + m * 16;
#pragma unroll
                for (int bj = 0; bj < 2; ++bj) { const int t = col0 + bj * 128;
                    store8(O + ((size_t)(((t >> 11) * 4 + (row >> 7)) * 32 + ((t >> 6) & 31)) * 128 + (row & 127)) * 64 + (t & 63), acc[ai][bj][m][0] * c[bj][0], acc[ai][bj][m][1] * c[bj][1]); }
            }
    }
};
struct EpiPre {
    static constexpr bool PERM = true;
    bf16* base0;
    DI void operator()(EPI_ARGS) const {
        bf16* O = base0 + (size_t)((u.z >> 30) & 1) * (52u << 20) + (size_t)(u.z & 0x3fffffff);
        const int row0 = wr * 64 + fr, col0 = wc * 32 + 8 * fq;
#pragma unroll
        for (int ai = 0; ai < 2; ++ai)
#pragma unroll
            for (int m = 0; m < 4; ++m) {
                const int row = row0 + ai * 128 + m * 16;
#pragma unroll
                for (int bj = 0; bj < 2; ++bj) store8(O + (size_t)row * 1024 + col0 + bj * 128, acc[ai][bj][m][0], acc[ai][bj][m][1]);
            }
    }
};
struct EpiResid {
    static constexpr bool PERM = true;
    const float* xres; const bf16* hres; bf16* out; float* ps;
    DI void operator()(EPI_ARGS) const {
        const int row0 = u.pm * 256 + wr * 64 + fr, col0 = u.pn * 256 + wc * 32 + 8 * fq;
#pragma unroll
        for (int ai = 0; ai < 2; ++ai)
#pragma unroll
            for (int m = 0; m < 4; ++m) {
                const int row = row0 + ai * 128 + m * 16; const size_t off = (size_t)row * D + col0; float ss = 0.f;
#pragma unroll
                for (int bj = 0; bj < 2; ++bj) {
                    f32x4 r0, r1;
                    if (xres) { r0 = *(const f32x4*)(xres + off + bj * 128); r1 = *(const f32x4*)(xres + off + bj * 128 + 4); }
                    else { const u32x4 hw = *(const u32x4*)(hres + off + bj * 128); r0 = (f32x4){bflo(hw.x), bfhi(hw.x), bflo(hw.y), bfhi(hw.y)}; r1 = (f32x4){bflo(hw.z), bfhi(hw.z), bflo(hw.w), bfhi(hw.w)}; }
                    r0 = r0 + acc[ai][bj][m][0]; r1 = r1 + acc[ai][bj][m][1];
                    u32x4 w; w.x = pk2(r0[0], r0[1]); w.y = pk2(r0[2], r0[3]); w.z = pk2(r1[0], r1[1]); w.w = pk2(r1[2], r1[3]);
                    *(u32x4*)(out + off + bj * 128) = w;
                    if (ps) {
#pragma unroll
                        for (int q = 0; q < 4; ++q) { const float a = bflo(w[q]), b = bfhi(w[q]); ss += a * a + b * b; }
                    }
                }
                if (ps) { ss += swz_xor<16>(ss); ss = half_sum(ss); if (fq == 0) ps[(size_t)row * 16 + u.pn * 4 + wc] = ss; }
            }
    }
};
struct EpiGateComb {
    static constexpr bool PERM = true;
    const bf16 *YF, *YB, *V; const float *BON, *lng, *lnb; bf16* O;
    DI void operator()(EPI_ARGS) const {
        const int head = u.pn * 4 + wc, ch0 = u.pn * 256 + 64 * wc + 8 * fq, row0 = u.pm * 256 + wr * 64 + fr;
        f32x4 lg[2][2], lb[2][2];
#pragma unroll
        for (int bj = 0; bj < 2; ++bj)
#pragma unroll
            for (int n = 0; n < 2; ++n) { lg[bj][n] = *(const f32x4*)(lng + ch0 + 32 * bj + 4 * n); lb[bj][n] = *(const f32x4*)(lnb + ch0 + 32 * bj + 4 * n); }
#pragma unroll
        for (int ai = 0; ai < 2; ++ai)
#pragma unroll
            for (int m = 0; m < 4; ++m) {
                const int row = row0 + ai * 128 + m * 16; const size_t off = (size_t)row * D + ch0;
                u32x4 a[2], b[2], vv[2];
#pragma unroll
                for (int bj = 0; bj < 2; ++bj) { a[bj] = *(const u32x4*)(YF + off + 32 * bj); b[bj] = *(const u32x4*)(YB + off + 32 * bj); vv[bj] = *(const u32x4*)(V + off + 32 * bj); }
                const float bon = BON[(size_t)row * 16 + head] + BON[(size_t)(M + row) * 16 + head];
                float y[16]; float s = 0.f;
#pragma unroll
                for (int bj = 0; bj < 2; ++bj)
#pragma unroll
                    for (int w = 0; w < 4; ++w) { y[bj * 8 + 2 * w] = bflo(a[bj][w]) + bflo(b[bj][w]); y[bj * 8 + 2 * w + 1] = bfhi(a[bj][w]) + bfhi(b[bj][w]); }
#pragma unroll
                for (int j = 0; j < 16; ++j) s += y[j];
                s += swz_xor<16>(s); s = half_sum(s);
                const float mean = s * (1.0f / 64.0f); float q2 = 0.f;
#pragma unroll
                for (int j = 0; j < 16; ++j) { y[j] -= mean; q2 += y[j] * y[j]; }
                q2 += swz_xor<16>(q2); q2 = half_sum(q2);
                const float rstd = 1.0f / sqrtf(q2 * (1.0f / 64.0f) + 64e-5f);
#pragma unroll
                for (int bj = 0; bj < 2; ++bj) {
                    f32x4 o0, o1;
#pragma unroll
                    for (int j = 0; j < 4; ++j) {
                        const float v0 = (j & 1) ? bfhi(vv[bj][j >> 1]) : bflo(vv[bj][j >> 1]), v1 = (j & 1) ? bfhi(vv[bj][2 + (j >> 1)]) : bflo(vv[bj][2 + (j >> 1)]);
                        o0[j] = (y[bj * 8 + j] * rstd * lg[bj][0][j] + lb[bj][0][j] + bon * v0) * acc[ai][bj][m][0][j];
                        o1[j] = (y[bj * 8 + 4 + j] * rstd * lg[bj][1][j] + lb[bj][1][j] + bon * v1) * acc[ai][bj][m][1][j];
                    }
                    store8(O + off + 32 * bj, o0, o1);
                }
            }
    }
};
struct EpiSoftmax {
    static constexpr bool PERM = true;
    bf16* P; const float* ps;
    DI void operator()(EPI_ARGS) const {
        LAS f32x2* X = (LAS f32x2*)(lds + LDS_X);
        const int row0 = u.pm * 256, col0 = u.pn * 256 + wc * 32 + 8 * fq;
        float mw[2][4];
#pragma unroll
        for (int ai = 0; ai < 2; ++ai)
#pragma unroll
            for (int m = 0; m < 4; ++m) {
                const int rl = ai * 128 + wr * 64 + m * 16 + fr; const float s = rs_ps(ps, row0 + rl) * LOG2E;
                float mx = -3.0e38f;
#pragma unroll
                for (int bj = 0; bj < 2; ++bj)
#pragma unroll
                    for (int n = 0; n < 2; ++n) { acc[ai][bj][m][n] = acc[ai][bj][m][n] * s;
#pragma unroll
                        for (int j = 0; j < 4; ++j) mx = fmaxf(mx, acc[ai][bj][m][n][j]); }
                mx = fmaxf(mx, swz_xor<16>(mx)); mx = half_max(mx);
                float sum = 0.f;
#pragma unroll
                for (int bj = 0; bj < 2; ++bj)
#pragma unroll
                    for (int n = 0; n < 2; ++n)
#pragma unroll
                        for (int j = 0; j < 4; ++j) { const float p = fexp2(acc[ai][bj][m][n][j] - mx); acc[ai][bj][m][n][j] = p; sum += p; }
                sum += swz_xor<16>(sum); sum = half_sum(sum);
                mw[ai][m] = mx;
                if (fq == 0) X[rl * 4 + wc] = (f32x2){mx, sum};
            }
        asm volatile("s_waitcnt lgkmcnt(0)" ::: "memory"); __builtin_amdgcn_s_barrier(); asm volatile("" ::: "memory");
#pragma unroll
        for (int ai = 0; ai < 2; ++ai)
#pragma unroll
            for (int m = 0; m < 4; ++m) {
                const int rl = ai * 128 + wr * 64 + m * 16 + fr;
                const f32x2 a = X[rl * 4 + 0], b = X[rl * 4 + 1], c = X[rl * 4 + 2], d = X[rl * 4 + 3];
                const float mt = fmaxf(fmaxf(a.x, b.x), fmaxf(c.x, d.x));
                const float lt = a.y * fexp2(a.x - mt) + b.y * fexp2(b.x - mt) + c.y * fexp2(c.x - mt) + d.y * fexp2(d.x - mt);
                const float f = fexp2(mw[ai][m] - mt) / lt;
                bf16* rowp = P + (size_t)(row0 + rl) * 1024 + col0;
#pragma unroll
                for (int bj = 0; bj < 2; ++bj) store8(rowp + bj * 128, acc[ai][bj][m][0] * f, acc[ai][bj][m][1] * f);
            }
        asm volatile("s_waitcnt lgkmcnt(0)" ::: "memory"); __builtin_amdgcn_s_barrier(); asm volatile("" ::: "memory");
    }
};
struct EpiRwkv {
    static constexpr bool PERM = true;
    bf16* R; bf16* Kk; bf16* V; bf16* HD1; bf16* HD2;
    DI void operator()(EPI_ARGS) const {
        const int row0 = u.pm * 256 + wr * 64 + fr; const int g = u.pn >> 2;
        bf16* O; int ldc, colt, mode0 = 0, mode1 = 0;
        if (u.pn < 12) { O = R + (size_t)g * (32u << 20); ldc = 1024; colt = (u.pn & 3) * 256; }
        else if (u.pn == 12) { O = HD1; ldc = 256; colt = 0; mode0 = 1; }
        else { O = HD2; ldc = 256; colt = 0; mode0 = 2; mode1 = 2; }
        const int col0 = colt + wc * 32 + 8 * fq;
#pragma unroll
        for (int ai = 0; ai < 2; ++ai)
#pragma unroll
            for (int m = 0; m < 4; ++m) {
                bf16* rowp = O + (size_t)(row0 + ai * 128 + m * 16) * ldc + col0;
#pragma unroll
                for (int bj = 0; bj < 2; ++bj) { f32x4 v0 = acc[ai][bj][m][0], v1 = acc[ai][bj][m][1]; const int md = bj ? mode1 : mode0;
                    if (md == 1) {
#pragma unroll
                        for (int j = 0; j < 4; ++j) { v0[j] = tanhf_(v0[j]); v1[j] = tanhf_(v1[j]); } }
                    else if (md == 2) {
#pragma unroll
                        for (int j = 0; j < 4; ++j) { v0[j] = sigmoidf_(v0[j]); v1[j] = sigmoidf_(v1[j]); } }
                    store8(rowp + bj * 128, v0, v1); }
            }
    }
};

enum InIdx { I_X = 0, I_MEM, I_REL, I_NMIX, I_NXATTN, I_NMEM, I_NFFN, I_NFINAL, I_WIN, I_WOUT, I_CONVW, I_CONVB, I_CLNG, I_CLNB, I_LQ1, I_LK1, I_LQ2, I_LK2, I_SUBLN,
             I_MU, I_WR, I_WK, I_WV, I_WO, I_W0, I_W1, I_W2, I_A0, I_A1, I_A2, I_G1, I_G2, I_KK, I_KA, I_RK, I_LNG, I_LNB, I_XQ, I_XKV, I_XO, I_UP, I_DN, N_IN };
struct Args { const float* in[N_IN]; float* out; unsigned char* ws; int ph_lo, ph_hi; };
static_assert(sizeof(Args) == (N_IN + 2) * 8 + 8, "Args has no padding");

struct Frame {
    LAS unsigned char* lds;
    int tid, lane, wave, gw, ngw;
    unsigned char* ws;
};

DI Frame fresh(const Frame& F0) {
    Frame F = F0; F.tid = opaque(threadIdx.x); F.lane = F.tid & 63; F.wave = __builtin_amdgcn_readfirstlane(F.tid >> 6); F.gw = opq(blockIdx.x) * 8 + F.wave; F.ngw = opq(gridDim.x) * 8; return F;
}
struct TJob { const float* W; int K, N; bf16* WT; int ldt, row_off, col_off, perm; const float* gain; const float* gsub; };
DI void tr_item(const TJob& J, LAS float* scr, int item, int lane) {
    const int nblk = J.N / 32, kb = item / nblk, nb = item % nblk, k0 = 64 * kb, n0 = 32 * nb;
    float scale = 1.0f; int drow = J.row_off + n0;
    if (J.perm) {
        if (n0 < 512) drow = 256 * (n0 >> 7) + (n0 & 127);
        else if (n0 < 1024) drow = 256 * ((n0 - 512) >> 7) + 128 + ((n0 - 512) & 127);
        else drow = n0;
        if (n0 >= 1024 && n0 < 1536) scale = 0.125f * LOG2E;
    }
    float tv[32];
    const float* wp = J.W + (size_t)(k0 + (lane >> 5)) * J.N + n0 + (lane & 31);
#pragma unroll
    for (int i = 0; i < 32; ++i) tv[i] = wp[(size_t)(2 * i) * J.N];
    if (J.gain) {
#pragma unroll
        for (int i = 0; i < 32; ++i) tv[i] *= J.gain[k0 + 2 * i + (lane >> 5)] - (J.gsub ? J.gsub[k0 + 2 * i + (lane >> 5)] : 0.0f);
    }
#pragma unroll
    for (int i = 0; i < 32; ++i) scr[(2 * i + (lane >> 5)) * 33 + (lane & 31)] = tv[i] * scale;
    asm volatile("s_waitcnt lgkmcnt(0)" ::: "memory");
    const int c = lane & 7;
#pragma unroll
    for (int j = 0; j < 4; ++j) { const int n = (lane >> 3) + 8 * j; const LAS float* s = scr + (8 * c) * 33 + n;
        u32x4 o; o.x = pk2(s[0 * 33], s[1 * 33]); o.y = pk2(s[2 * 33], s[3 * 33]); o.z = pk2(s[4 * 33], s[5 * 33]); o.w = pk2(s[6 * 33], s[7 * 33]);
        *(u32x4*)(J.WT + (size_t)(drow + n) * J.ldt + J.col_off + k0 + 8 * c) = o; }
    asm volatile("s_waitcnt lgkmcnt(0)" ::: "memory");
}
DI void tr_item64(const TJob& J, LAS float* scr, int item, int lane) {
    const int nblk = J.N / 64, kb = item / nblk, nb = item % nblk, k0 = 64 * kb, n0 = 64 * nb;
    float scale = 1.0f; int drow = J.row_off + n0;
    if (J.perm) {
        if (n0 < 512) drow = 256 * (n0 >> 7) + (n0 & 127);
        else if (n0 < 1024) drow = 256 * ((n0 - 512) >> 7) + 128 + ((n0 - 512) & 127);
        else drow = n0;
        if (n0 >= 1024 && n0 < 1536) scale = 0.125f * LOG2E;
    }
    f32x4 tv[16];
    const float* wp = J.W + (size_t)(k0 + (lane >> 4)) * J.N + n0 + 4 * (lane & 15);
#pragma unroll
    for (int i = 0; i < 16; ++i) tv[i] = __builtin_nontemporal_load((const f32x4*)(wp + (size_t)(4 * i) * J.N));
#pragma unroll
    for (int i = 0; i < 16; ++i) { const int kk = 4 * i + (lane >> 4); const float g = (J.gain ? J.gain[k0 + kk] - (J.gsub ? J.gsub[k0 + kk] : 0.0f) : 1.0f) * scale;
        LAS float* d = scr + kk * 65 + 4 * (lane & 15); d[0] = tv[i].x * g; d[1] = tv[i].y * g; d[2] = tv[i].z * g; d[3] = tv[i].w * g; }
    asm volatile("s_waitcnt lgkmcnt(0)" ::: "memory");
    const int c = lane & 7;
#pragma unroll
    for (int j = 0; j < 8; ++j) { const int n = (lane >> 3) + 8 * j; const LAS float* sp = scr + (8 * c) * 65 + n;
        u32x4 o; o.x = pk2(sp[0 * 65], sp[1 * 65]); o.y = pk2(sp[2 * 65], sp[3 * 65]); o.z = pk2(sp[4 * 65], sp[5 * 65]); o.w = pk2(sp[6 * 65], sp[7 * 65]);
        *(u32x4*)(J.WT + (size_t)(drow + n) * J.ldt + J.col_off + k0 + 8 * c) = o; }
    asm volatile("s_waitcnt lgkmcnt(0)" ::: "memory");
}
constexpr int N_TJOBS = 31;
DI TJob get_tjob(int j, const Args& a, unsigned char* ws) {
    TJob J; J.perm = 0; J.gain = nullptr; J.gsub = nullptr; J.row_off = 0; J.col_off = 0;
    if (j == 0) { J.W = a.in[opq(I_WIN)]; J.K = 1024; J.N = 2560; J.WT = (bf16*)(ws + WS_WIN); J.ldt = 1024; J.perm = 1; J.gain = a.in[opq(I_NMIX)]; }
    else if (j == 1) { J.W = a.in[opq(I_WOUT)]; J.K = 1024; J.N = 1024; J.WT = (bf16*)(ws + WS_WOUT); J.ldt = 1024; }
    else if (j < 4) { const int i = j - 2; J.W = a.in[opq(I_XKV)] + (size_t)i * 1024 * 2048; J.K = 1024; J.N = 2048; J.WT = (bf16*)(ws + WS_WKV) + (size_t)i * 2048 * 1024; J.ldt = 1024; J.gain = a.in[opq(I_NMEM)] + i * 1024; }
    else if (j < 6) { const int i = j - 4; J.W = a.in[opq(I_XO)] + (size_t)i * 1024 * 1024; J.K = 1024; J.N = 1024; J.WT = (bf16*)(ws + WS_WXO) + (size_t)i * 1024 * 1024; J.ldt = 1024; }
    else if (j < 8) { const int i = j - 6; J.W = a.in[opq(I_UP)] + (size_t)i * 1024 * 4096; J.K = 1024; J.N = 4096; J.WT = (bf16*)(ws + WS_WUP) + (size_t)i * 4096 * 1024; J.ldt = 1024; J.gain = a.in[opq(I_NFFN)] + i * 1024; }
    else if (j < 10) { const int i = j - 8; J.W = a.in[opq(I_DN)] + (size_t)i * 4096 * 1024; J.K = 4096; J.N = 1024; J.WT = (bf16*)(ws + WS_WDN) + (size_t)i * 1024 * 4096; J.ldt = 4096; }
    else if (j < 26) {
        const int q = j - 10, src = q >> 1, copy = q & 1; int mu = 0;
        J.K = 1024;
        if (src < 3) { J.WT = (bf16*)(ws + WS_WBIG); J.ldt = 1024; J.row_off = src * 1024; J.N = copy ? 0 : 1024; J.W = a.in[opq(src == 0 ? I_WR : src == 1 ? I_WK : I_WV)]; }
        else {
            J.WT = (bf16*)(ws + WS_WLORA); J.ldt = 2048; J.col_off = copy * 1024;
            if (src == 3) { J.W = a.in[opq(I_W1)]; J.N = 64; J.row_off = 0; mu = 1; }
            else if (src == 4) { J.W = a.in[opq(I_W1)] + 1024 * 64; J.N = 64; J.row_off = 64; mu = 1; }
            else if (src == 5) { J.W = a.in[opq(I_A1)]; J.N = 64; J.row_off = 128; mu = 4; }
            else if (src == 6) { J.W = a.in[opq(I_A1)] + 1024 * 64; J.N = 64; J.row_off = 192; mu = 4; }
            else { J.W = a.in[opq(I_G1)]; J.N = 160; J.row_off = 256; mu = 5; }
            if (copy) { J.gain = a.in[opq(I_MU)] + mu * 1024; J.gsub = a.in[opq(I_MU)]; }
        }
    }
    else if (j < 30) { const int q = j - 26; J.W = (q < 2 ? a.in[opq(I_W2)] : a.in[opq(I_A2)]) + (size_t)(q & 1) * 64 * 1024; J.K = 64; J.N = 1024; J.WT = (bf16*)(ws + WS_W2T) + (size_t)q * 1024 * 64; J.ldt = 64; }
    else { J.W = a.in[opq(I_WO)]; J.K = 1024; J.N = 1024; J.WT = (bf16*)(ws + WS_WRO); J.ldt = 1024; }
    return J;
}
DI void row_to_bf16_rs(const float* xrow, bf16* orow, float* rs, int lane) {
    const f32x4* xr = (const f32x4*)xrow + lane;
    f32x4 v[4]; float s = 0.f;
#pragma unroll
    for (int j = 0; j < 4; ++j) { v[j] = xr[64 * j]; s += (v[j].x * v[j].x + v[j].y * v[j].y) + (v[j].z * v[j].z + v[j].w * v[j].w); }
    s = wave_sum(s);
    u32x2* o8 = (u32x2*)orow + lane;
#pragma unroll
    for (int j = 0; j < 4; ++j) { u32x2 w; w.x = pk2(v[j].x, v[j].y); w.y = pk2(v[j].z, v[j].w); o8[64 * j] = w; }
    if (lane == 0) *rs = 1.0f / sqrtf(s * (1.0f / D) + EPS);
}
DI void rows4_to_bf16_rs(const Frame& F, const float* X, bf16* O, float* rs, int nrows) {
    for (int m0 = F.gw * 4; m0 < nrows; m0 += F.ngw * 4) {
        f32x4 v[4][4];
#pragma unroll
        for (int r = 0; r < 4; ++r)
#pragma unroll
            for (int j = 0; j < 4; ++j) v[r][j] = __builtin_nontemporal_load((const f32x4*)(X + (size_t)(m0 + r) * D) + F.lane + 64 * j);
#pragma unroll
        for (int r = 0; r < 4; ++r) {
            float s = 0.f;
#pragma unroll
            for (int j = 0; j < 4; ++j) s += (v[r][j].x * v[r][j].x + v[r][j].y * v[r][j].y) + (v[r][j].z * v[r][j].z + v[r][j].w * v[r][j].w);
            s = wave_sum(s);
            u32x2* o8 = (u32x2*)(O + (size_t)(m0 + r) * D) + F.lane;
#pragma unroll
            for (int j = 0; j < 4; ++j) { u32x2 w; w.x = pk2(v[r][j].x, v[r][j].y); w.y = pk2(v[r][j].z, v[r][j].w); o8[64 * j] = w; }
            if (F.lane == 0) rs[m0 + r] = 1.0f / sqrtf(s * (1.0f / D) + EPS);
        }
    }
}
DI int t5_bucket(int rel) {
    const int n = rel < 0 ? -rel : rel; int r = rel > 0 ? 16 : 0;
    if (n < 8) return r + n;
    int lg = 8; lg += (n >= 12); lg += (n >= 16); lg += (n >= 23); lg += (n >= 32); lg += (n >= 46); lg += (n >= 64); lg += (n >= 91);
    return r + lg;
}
DI void phase_prologue(const Frame& F0, const Args& a, unsigned char* ws) {
    const Frame F = fresh(F0);
    LAS float* scr = (LAS float*)(F.lds + F.wave * 17408);
    {
        int total = 0;
        for (int j = 0; j < N_TJOBS; ++j) { const TJob J = get_tjob(j, a, ws); total += (J.N & 63) == 0 ? (J.K / 64) * (J.N / 64) : (J.K / 64) * (J.N / 32); }
        for (int g = F.gw; g < total; g += F.ngw) {
            int r = g;
            for (int j = 0; j < N_TJOBS; ++j) {
                const TJob J = get_tjob(j, a, ws); const bool wide = (J.N & 63) == 0; const int cnt = wide ? (J.K / 64) * (J.N / 64) : (J.K / 64) * (J.N / 32);
                if (r < cnt) { if (wide) tr_item64(J, scr, r, F.lane); else tr_item(J, scr, r, F.lane); break; }
                r -= cnt;
            }
        }
    }
    const int gt = F.gw * 64 + F.lane, ngt = F.ngw * 64;
    for (int i = 0; i < 2; ++i) {
        const float* W = a.in[opq(I_XQ)] + (size_t)i * 1024 * 1024; const float* g = a.in[opq(I_NXATTN)] + i * 1024; bf16* O = (bf16*)(ws + WS_WQN) + (size_t)i * 1024 * 1024;
        for (int e = gt; e < 1024 * 1024 / 4; e += ngt) { const f32x4 v = ((const f32x4*)W)[e]; const float s = g[(e * 4) >> 10] * 0.0625f; u32x2 w; w.x = pk2(v.x * s, v.y * s); w.y = pk2(v.z * s, v.w * s); ((u32x2*)O)[e] = w; }
    }
    { const float* W = a.in[opq(I_G2)]; bf16* O = (bf16*)(ws + WS_G2T);
      for (int e = gt; e < 1024 * 256; e += ngt) { const int rown = e >> 8, k = e & 255, cc = rown & 255;
        const int n = (rown & ~255) + 64 * ((cc >> 5) & 3) + 32 * (cc >> 7) + (cc & 31);
        O[e] = (bf16)(k < 160 ? f2bf(W[(size_t)k * 1024 + n]) : 0u); } }
    { u32x4* O = (u32x4*)((bf16*)(ws + WS_WLORA) + (size_t)416 * 2048);
      const unsigned zq = (unsigned)opaque(0);
      for (int e = gt; e < 96 * 2048 * 2 / 16; e += ngt) O[e] = (u32x4){zq, zq, zq, zq}; }
    rows4_to_bf16_rs(F, a.in[opq(I_X)], (bf16*)(ws + WS_SA), (float*)(ws + WS_RS), M);
    rows4_to_bf16_rs(F, a.in[opq(I_MEM)], (bf16*)(ws + WS_MEMB), (float*)(ws + WS_RSMEM), MMEM);
    { float* B = (float*)(ws + WS_BIAS); const float* tab = a.in[opq(I_REL)];
      for (int e = gt; e < 4 * 4096; e += ngt) { const int h = e >> 12, idx = e & 4095; const int rel = idx - 2047; B[e] = idx < 4095 ? tab[t5_bucket(rel) * 4 + h] * LOG2E : 0.f; } }
    if (F.gw == 0) {
        const float q1 = a.in[opq(I_LQ1)][F.lane] * a.in[opq(I_LK1)][F.lane], q2 = a.in[opq(I_LQ2)][F.lane] * a.in[opq(I_LK2)][F.lane];
        const float s1 = wave_sum(q1), s2 = wave_sum(q2);
        if (F.lane == 0) ((float*)(ws + WS_LAM))[0] = expf(s1) - expf(s2) + 0.2f;
    }
}

DI void phase_final_norm(const Frame& F0, const bf16* h, float* out, const float* g, const float osc) {
    const Frame F = fresh(F0);
    f32x4 gv[4];
#pragma unroll
    for (int j = 0; j < 4; ++j) gv[j] = ((const f32x4*)g)[F.lane + 64 * j];
    for (int m0 = F.gw * 4; m0 < M; m0 += F.ngw * 4) {
        u32x2 hw[4][4];
#pragma unroll
        for (int r = 0; r < 4; ++r)
#pragma unroll
            for (int j = 0; j < 4; ++j) hw[r][j] = ((const u32x2*)(h + (size_t)(m0 + r) * D))[F.lane + 64 * j];
#pragma unroll
        for (int r = 0; r < 4; ++r) {
            f32x4 v[4]; float s = 0.f;
#pragma unroll
            for (int j = 0; j < 4; ++j) { v[j] = (f32x4){bflo(hw[r][j].x), bfhi(hw[r][j].x), bflo(hw[r][j].y), bfhi(hw[r][j].y)}; s += (v[j].x * v[j].x + v[j].y * v[j].y) + (v[j].z * v[j].z + v[j].w * v[j].w); }
            const float rr = osc / sqrtf(wave_sum(s) * (1.0f / D) + EPS);
            f32x4* xr = (f32x4*)(out + (size_t)(m0 + r) * D) + F.lane;
#pragma unroll
            for (int j = 0; j < 4; ++j) xr[64 * j] = v[j] * rr * gv[j];
        }
    }
}
DI void phase_rwkv_shift(const Frame& F0, const bf16* h, const float* g, const float* mu, bf16* XR, bf16* XK, bf16* XV, bf16* HH) {
    const Frame F = fresh(F0);
    f32x4 gv[4], mr[4], mk[4], mv[4];
#pragma unroll
    for (int j = 0; j < 4; ++j) { gv[j] = ((const f32x4*)g)[F.lane + 64 * j]; mr[j] = ((const f32x4*)mu)[F.lane + 64 * j]; mk[j] = ((const f32x4*)(mu + 2048))[F.lane + 64 * j]; mv[j] = ((const f32x4*)(mu + 3072))[F.lane + 64 * j]; }
    for (int ch = F.gw; ch < M / 16; ch += F.ngw) {
        const int m0 = ch * 16, t0 = m0 & (T - 1);
        f32x4 p2[4], p1[4], cu[4];
#pragma unroll
        for (int j = 0; j < 4; ++j) { p2[j] = (f32x4){0.f, 0.f, 0.f, 0.f}; p1[j] = p2[j]; cu[j] = p2[j]; }
#pragma unroll 1
        for (int g6 = 0; g6 < 6; ++g6) {
            f32x4 ld[3][4];
#pragma unroll
            for (int r = 0; r < 3; ++r) { const int i = g6 * 3 + r - 1, t = t0 + i; const bool ok = (t >= 0 && t < T);
#pragma unroll
                for (int j = 0; j < 4; ++j) { const u32x2 w = ok ? ((const u32x2*)(h + (size_t)(m0 + i) * D))[F.lane + 64 * j] : (u32x2){0u, 0u}; ld[r][j] = (f32x4){bflo(w.x), bfhi(w.x), bflo(w.y), bfhi(w.y)}; } }
#pragma unroll
            for (int r = 0; r < 3; ++r) {
                const int i = g6 * 3 + r - 1;
                float s = 0.f;
#pragma unroll
                for (int j = 0; j < 4; ++j) { p2[j] = p1[j]; p1[j] = cu[j]; cu[j] = ld[r][j]; s += (cu[j].x * cu[j].x + cu[j].y * cu[j].y) + (cu[j].z * cu[j].z + cu[j].w * cu[j].w); }
                const float rr = 1.0f / sqrtf(wave_sum(s) * (1.0f / D) + EPS);
#pragma unroll
                for (int j = 0; j < 4; ++j) cu[j] = cu[j] * rr * gv[j];
                if (i >= 1) {
                    const size_t ro = (size_t)(m0 + i - 1) * 1024;
#pragma unroll
                    for (int j = 0; j < 4; ++j) { const f32x4 hh = (p2[j] + cu[j]) * 0.5f - p1[j];
                        const f32x4 xr = p1[j] + mr[j] * hh, xk = p1[j] + mk[j] * hh, xv = p1[j] + mv[j] * hh;
                        u32x2 w; w.x = pk2(xr.x, xr.y); w.y = pk2(xr.z, xr.w); __builtin_nontemporal_store(w, (u32x2*)(XR + ro) + F.lane + 64 * j);
                        w.x = pk2(xk.x, xk.y); w.y = pk2(xk.z, xk.w); __builtin_nontemporal_store(w, (u32x2*)(XK + ro) + F.lane + 64 * j);
                        w.x = pk2(xv.x, xv.y); w.y = pk2(xv.z, xv.w); __builtin_nontemporal_store(w, (u32x2*)(XV + ro) + F.lane + 64 * j);
                        w.x = pk2(hh.x, hh.y); w.y = pk2(hh.z, hh.w); __builtin_nontemporal_store(w, (u32x2*)(HH + ro) + F.lane + 64 * j); }
                }
            }
        }
    }
}
constexpr int CV_ROWB = 1040, CV_IN_BYTES = 94 * CV_ROWB, CV_W_OFF = CV_IN_BYTES;
DI void conv_load_weights(const Frame& F0, const float* cw) {
    const Frame F = fresh(F0);
    LAS bf16* W = (LAS bf16*)(F.lds + CV_W_OFF);
    for (int e = F.tid; e < 31 * 512; e += 512) W[e] = (bf16)f2bf(cw[e]);
}
DI void conv_unit(const Frame& F0, int unit, const bf16* GLU, const float* cb, const float* lg, const float* lb, bf16* MIX) {
    const Frame F = fresh(F0);
    const int b = unit >> 5, t0 = (unit & 31) * 64;
    __syncthreads();
    for (int p = F.tid; p < 94 * 64; p += 512) {
        const int r = p >> 6, c = p & 63, t = t0 - 15 + r;
        u32x4 v = (u32x4){0u, 0u, 0u, 0u};
        if (t >= 0 && t < T) v = *(const u32x4*)(GLU + (size_t)(b * T + t) * 512 + c * 8);
        *(LAS u32x4*)(F.lds + r * CV_ROWB + c * 16) = v;
    }
    __syncthreads();
    const int tl = F.tid >> 3, chunk = F.tid & 7;
    float y[64];
#pragma unroll
    for (int i = 0; i < 8; ++i) {
        const int cg = chunk + 8 * i;
        float acc[8];
#pragma unroll
        for (int e = 0; e < 8; ++e) acc[e] = cb[cg * 8 + e];
#pragma unroll 1
        for (int j = 0; j < 31; ++j) {
            const u32x4 x = *(const LAS u32x4*)(F.lds + (tl + j) * CV_ROWB + cg * 16);
            const u32x4 w = *(const LAS u32x4*)(F.lds + CV_W_OFF + j * 1024 + cg * 16);
#pragma unroll
            for (int q = 0; q < 4; ++q) { acc[2 * q] += bflo(x[q]) * bflo(w[q]); acc[2 * q + 1] += bfhi(x[q]) * bfhi(w[q]); }
        }
#pragma unroll
        for (int e = 0; e < 8; ++e) y[i * 8 + e] = acc[e];
    }
    float s = 0.f;
#pragma unroll
    for (int j = 0; j < 64; ++j) s += y[j];
    s += swz_xor<1>(s); s += swz_xor<2>(s); s += swz_xor<4>(s);
    const float mean = s * (1.0f / 512.0f); float q2 = 0.f;
#pragma unroll
    for (int j = 0; j < 64; ++j) { y[j] -= mean; q2 += y[j] * y[j]; }
    q2 += swz_xor<1>(q2); q2 += swz_xor<2>(q2); q2 += swz_xor<4>(q2);
    const float rstd = 1.0f / sqrtf(q2 * (1.0f / 512.0f) + 1e-5f);
    bf16* orow = MIX + (size_t)(b * T + t0 + tl) * 1024;
#pragma unroll
    for (int i = 0; i < 8; ++i) {
        const int c0 = (chunk + 8 * i) * 8;
        const f32x4 g0 = *(const f32x4*)(lg + c0), g1 = *(const f32x4*)(lg + c0 + 4), b0 = *(const f32x4*)(lb + c0), b1 = *(const f32x4*)(lb + c0 + 4);
        f32x4 o0, o1;
#pragma unroll
        for (int e = 0; e < 4; ++e) { const float v0 = y[i * 8 + e] * rstd * g0[e] + b0[e], v1 = y[i * 8 + 4 + e] * rstd * g1[e] + b1[e]; o0[e] = v0 * sigmoidf_(v0); o1[e] = v1 * sigmoidf_(v1); }
        store8(orow + c0, o0, o1);
    }
}

constexpr int DA_KROW = 272, DA_VROW = 144, DA_KB = 64 * DA_KROW, DA_VB = 128 * DA_VROW, DA_BUF = DA_KB + DA_VB;
DI int crow(int reg, int hf) { return (reg & 3) + 8 * (reg >> 2) + 4 * hf; }
DI void diffattn_unit(const Frame& F0, int unit, const bf16* QK, const bf16* VT, const float* BIAS, const float lam, const float* subg, bf16* MIX) {
    const Frame F = fresh(F0);
    const int b = unit >> 6, h = (unit >> 4) & 3, qb = unit & 15;
    const int c = F.wave >> 2, qs = F.wave & 3, r32 = F.lane & 31, hf = F.lane >> 5;
    const int q0w = qb * 128 + qs * 32;
    const float* bias_h = BIAS + h * 4096 + 2047;
    bf16x8 Qf[4];
    { const bf16* qp = QK + (size_t)(b * T + q0w + r32) * 1024 + h * 128 + c * 64 + 8 * hf;
#pragma unroll
      for (int ks = 0; ks < 4; ++ks) Qf[ks] = *(const bf16x8*)(qp + 16 * ks); }
    const bf16* kg[2]; const bf16* vg[2]; int kl[2], vl[2];
#pragma unroll
    for (int i = 0; i < 2; ++i) { const int p = F.tid + 512 * i;
        kg[i] = QK + (size_t)(b * T + (p >> 4)) * 1024 + 512 + h * 128 + (p & 15) * 8; kl[i] = (p >> 4) * DA_KROW + (p & 15) * 16;
        vg[i] = VT + (size_t)(b * 4 + h) * (32 * 8192) + p * 8; vl[i] = DA_KB + (p >> 3) * DA_VROW + ((p & 7) >> 1) * 32 + ((p & 7) & 1) * 8; }
    u32x4 kr[2], vr[2];
#pragma unroll
    for (int i = 0; i < 2; ++i) { kr[i] = *(const u32x4*)(kg[i]); vr[i] = *(const u32x4*)(vg[i]); }
    __syncthreads();
    LAS float* const btab = (LAS float*)(F.lds + 2 * DA_BUF);
    btab[F.tid] = bias_h[F.tid - 256];
#pragma unroll
    for (int i = 0; i < 2; ++i) { *(LAS u32x4*)(F.lds + kl[i]) = kr[i]; *(LAS u32x2*)(F.lds + vl[i]) = (u32x2){vr[i].x, vr[i].y}; *(LAS u32x2*)(F.lds + vl[i] + 16) = (u32x2){vr[i].z, vr[i].w}; }
#pragma unroll
    for (int i = 0; i < 2; ++i) { kr[i] = *(const u32x4*)(kg[i] + (size_t)64 * 1024); vr[i] = *(const u32x4*)(vg[i] + 8192); }
    __syncthreads();
    f32x16 O[4];
#pragma unroll
    for (int vt = 0; vt < 4; ++vt)
#pragma unroll
        for (int i = 0; i < 16; ++i) O[vt][i] = 0.f;
    float lsum = 0.f;
    const float cbR = bias_h[91], cbL = bias_h[-91];
    const int ka = r32 * DA_KROW + c * 128 + 16 * hf;
    const int va = DA_KB + r32 * DA_VROW + 16 * hf;
    for (int kt = 0; kt < 32; ++kt) {
        const int k0 = kt * 64;
        LAS unsigned char* buf = F.lds + (kt & 1) * DA_BUF;
        const int dmin = k0 - (q0w + 31), dmax = k0 + 63 - q0w;
        const bool far = (dmin >= 91) || (dmax <= -91);
        const float cb = dmin >= 91 ? cbR : cbL;
        bf16x8 kf[8];
#pragma unroll
        for (int f = 0; f < 8; ++f) kf[f] = *(const LAS bf16x8*)(buf + ka + (f >> 2) * 32 * DA_KROW + (f & 3) * 32);
        __builtin_amdgcn_sched_barrier(0);
        f32x16 S0, S1;
        if (far) {
#pragma unroll
            for (int i = 0; i < 16; ++i) { S0[i] = cb; S1[i] = cb; }
        } else { const LAS float* tb = btab + (k0 - (q0w + r32) + 256);
#pragma unroll
            for (int i = 0; i < 16; ++i) { S0[i] = tb[crow(i, hf)]; S1[i] = tb[32 + crow(i, hf)]; }
        }
        bf16x8 vf0[8];
#pragma unroll
        for (int f = 0; f < 8; ++f) vf0[f] = *(const LAS bf16x8*)(buf + va + (f & 3) * 32 * DA_VROW + (f >> 2) * 32);
#pragma unroll
        for (int ks = 0; ks < 4; ++ks) S0 = __builtin_amdgcn_mfma_f32_32x32x16_bf16(kf[ks], Qf[ks], S0, 0, 0, 0);
#pragma unroll
        for (int ks = 0; ks < 4; ++ks) S1 = __builtin_amdgcn_mfma_f32_32x32x16_bf16(kf[4 + ks], Qf[ks], S1, 0, 0, 0);
        __builtin_amdgcn_sched_barrier(0);
        bf16x8 pa0[2], pa1[2];
        {
#pragma unroll
            for (int s2 = 0; s2 < 2; ++s2) { u32x4 pw;
#pragma unroll
                for (int i = 0; i < 8; ++i) { S0[8 * s2 + i] = fexp2(S0[8 * s2 + i]); lsum += S0[8 * s2 + i]; }
                pw.x = pk2(S0[8 * s2], S0[8 * s2 + 1]); pw.y = pk2(S0[8 * s2 + 2], S0[8 * s2 + 3]); pw.z = pk2(S0[8 * s2 + 4], S0[8 * s2 + 5]); pw.w = pk2(S0[8 * s2 + 6], S0[8 * s2 + 7]);
                pa0[s2] = __builtin_bit_cast(bf16x8, pw); }
        }
        __builtin_amdgcn_sched_barrier(0);
        bf16x8 vf1[8];
#pragma unroll
        for (int f = 0; f < 8; ++f) vf1[f] = *(const LAS bf16x8*)(buf + va + (f & 3) * 32 * DA_VROW + (2 + (f >> 2)) * 32);
#pragma unroll
        for (int f = 0; f < 8; ++f) O[f & 3] = __builtin_amdgcn_mfma_f32_32x32x16_bf16(pa0[f >> 2], vf0[f], O[f & 3], 0, 0, 0);
        {
#pragma unroll
            for (int s2 = 0; s2 < 2; ++s2) { u32x4 pw;
#pragma unroll
                for (int i = 0; i < 8; ++i) { S1[8 * s2 + i] = fexp2(S1[8 * s2 + i]); lsum += S1[8 * s2 + i]; }
                pw.x = pk2(S1[8 * s2], S1[8 * s2 + 1]); pw.y = pk2(S1[8 * s2 + 2], S1[8 * s2 + 3]); pw.z = pk2(S1[8 * s2 + 4], S1[8 * s2 + 5]); pw.w = pk2(S1[8 * s2 + 6], S1[8 * s2 + 7]);
                pa1[s2] = __builtin_bit_cast(bf16x8, pw); }
        }
        __builtin_amdgcn_sched_barrier(0);
#pragma unroll
        for (int f = 0; f < 8; ++f) O[f & 3] = __builtin_amdgcn_mfma_f32_32x32x16_bf16(pa1[f >> 2], vf1[f], O[f & 3], 0, 0, 0);
        if (kt + 1 < 32) {
            LAS unsigned char* nb = F.lds + ((kt + 1) & 1) * DA_BUF;
#pragma unroll
            for (int i = 0; i < 2; ++i) { *(LAS u32x4*)(nb + kl[i]) = kr[i]; *(LAS u32x2*)(nb + vl[i]) = (u32x2){vr[i].x, vr[i].y}; *(LAS u32x2*)(nb + vl[i] + 16) = (u32x2){vr[i].z, vr[i].w}; }
        }
        if (kt + 2 < 32) {
#pragma unroll
            for (int i = 0; i < 2; ++i) { kr[i] = *(const u32x4*)(kg[i] + (size_t)(k0 + 128) * 1024); vr[i] = *(const u32x4*)(vg[i] + (kt + 2) * 8192); }
        }
        __syncthreads();
    }
    lsum = half_sum(lsum);
    LAS float* XO = (LAS float*)F.lds;
    LAS float* LW = (LAS float*)(F.lds + 65536) + F.wave * 32;
    if (hf == 0) LW[r32] = 1.0f / lsum;
    asm volatile("s_waitcnt lgkmcnt(0)" ::: "memory");
    float il[16];
#pragma unroll
    for (int i = 0; i < 16; ++i) il[i] = LW[crow(i, hf)];
    if (c == 1) {
#pragma unroll
        for (int vt = 0; vt < 4; ++vt)
#pragma unroll
            for (int i = 0; i < 16; ++i) XO[(qs * 32 + crow(i, hf)) * 128 + vt * 32 + r32] = O[vt][i] * il[i];
    }
    __syncthreads();
    if (c == 0) {
        float ss[16];
#pragma unroll
        for (int i = 0; i < 16; ++i) ss[i] = 0.f;
#pragma unroll
        for (int vt = 0; vt < 4; ++vt)
#pragma unroll
            for (int i = 0; i < 16; ++i) { const float o = O[vt][i] * il[i] - lam * XO[(qs * 32 + crow(i, hf)) * 128 + vt * 32 + r32]; O[vt][i] = o; ss[i] += o * o; }
#pragma unroll
        for (int i = 0; i < 16; ++i) { float v = ss[i]; v += swz_xor<1>(v); v += swz_xor<2>(v); v += swz_xor<4>(v); v += swz_xor<8>(v); v += swz_xor<16>(v); ss[i] = 0.8f / sqrtf(v * (1.0f / 128.0f) + EPS); }
#pragma unroll
        for (int vt = 0; vt < 4; ++vt) {
            const float g = subg[vt * 32 + r32];
#pragma unroll
            for (int i = 0; i < 16; ++i) MIX[(size_t)(b * T + q0w + crow(i, hf)) * 1024 + 512 + h * 128 + vt * 32 + r32] = (bf16)f2bf(O[vt][i] * ss[i] * g);
        }
    }
}

DI float dpp_x1(float v) { return __builtin_bit_cast(float, __builtin_amdgcn_update_dpp(0, __builtin_bit_cast(int, v), 0xB1, 0xF, 0xF, true)); }
DI float dpp_x2(float v) { return __builtin_bit_cast(float, __builtin_amdgcn_update_dpp(0, __builtin_bit_cast(int, v), 0x4E, 0xF, 0xF, true)); }
DI float quad_sum(float v) { v += dpp_x1(v); v += dpp_x2(v); return v; }
struct ScanPtrs { const bf16 *R, *K, *V, *HD1, *W2T; const float *w0, *a0, *kk, *ka, *rk; bf16 *YF, *YB; float* BON; unsigned* ERR; };
constexpr int CS_AT = 0, CS_RT = 2304, CS_BK = 4608, CS_SMQ = 9728, CS_SMT = 11008, CS_NQ = 12288, CS_VT = 13568, CS_GL = 16640, CS_BUF = 16896;
constexpr int CS_PZ = 6 * CS_BUF;
constexpr int CS_W = CS_PZ + 4 * 4608;
constexpr int CS_WSZ = 4864;
constexpr int CS_BON = CS_W + 8 * CS_WSZ;
constexpr int CS_NS = CS_BON + 1536;
static_assert(CS_NS + 2048 + 16 <= LDS_MISC, "chunked-scan LDS map");
template <int CTRL> DI float dpp_mov0(float v) { return __builtin_bit_cast(float, __builtin_amdgcn_update_dpp(0, __builtin_bit_cast(int, v), CTRL, 0xF, 0xF, false)); }
DI float row_prefix(float v) { v += dpp_mov0<0x111>(v); v += dpp_mov0<0x112>(v); v += dpp_mov0<0x114>(v); v += dpp_mov0<0x118>(v); return v; }
DI float row_suffix(float v) { v += dpp_mov0<0x101>(v); v += dpp_mov0<0x102>(v); v += dpp_mov0<0x104>(v); v += dpp_mov0<0x108>(v); return v; }
DI bf16x8 lds16(const LAS unsigned char* p) { return *(const LAS bf16x8*)p; }
DI f32x4 mfma16(bf16x8 a, bf16x8 b, f32x4 c) { return __builtin_amdgcn_mfma_f32_16x16x32_bf16(a, b, c, 0, 0, 0); }

DI void scan_pair_mfma(const Frame& F0, int bh, const ScanPtrs& P) {
    const Frame F = fresh(F0);
    const int b = bh >> 4, h = bh & 15;
    const int z = F.wave >> 2, q4 = F.wave & 3;
    const int l15 = F.lane & 15, l4 = F.lane >> 4;
    const int te = l15, cg = l4, c4 = cg * 4;
    const int rr = z ? 15 - te : te;
    const int jl = 16 * q4 + c4;
    const int chq = h * 64 + 16 * q4;
    LAS unsigned char* const L = F.lds;
    LAS unsigned char* const wsc = L + CS_W + F.wave * CS_WSZ;
    LAS float* const scrW = (LAS float*)wsc; LAS float* const scrA = scrW + 16 * 20;
    LAS unsigned char* const ZB = wsc; LAS unsigned char* const XB = wsc + 2304; LAS unsigned char* const UB = wsc + 3072;
    LAS float* const yst = (LAS float*)(wsc + 3840);
    LAS float* const bonp = (LAS float*)(L + CS_BON);
    bf16* Y = z ? P.YB : P.YF;
    const bf16* w2p = P.W2T + (size_t)z * 65536 + (size_t)(chq + l15) * 64 + 8 * l4;
    bf16x8 Wf[2], Af[2];
#pragma unroll
    for (int ks = 0; ks < 2; ++ks) { Wf[ks] = *(const bf16x8*)(w2p + ks * 32); Af[ks] = *(const bf16x8*)(w2p + 2 * 65536 + ks * 32); }
    const f32x4 w0v = *(const f32x4*)(P.w0 + z * 1024 + chq + c4), a0v = *(const f32x4*)(P.a0 + z * 1024 + chq + c4);
    const f32x4 kkv = *(const f32x4*)(P.kk + chq + c4), kav = *(const f32x4*)(P.ka + chq + c4), rkv = *(const f32x4*)(P.rk + chq + c4);
    f32x4 kcn[4];
#pragma unroll
    for (int q = 0; q < 4; ++q) kcn[q] = *(const f32x4*)(P.kk + h * 64 + 16 * cg + q * 4);
    f32x4 Z[4];
#pragma unroll
    for (int jt = 0; jt < 4; ++jt) { const float zq = ozero(); Z[jt] = (f32x4){zq, zq, zq, zq}; }
    bf16x8 Ahw[2], Aha[2]; u32x2 r4, k4, v4; u32x4 kfull[2];
    auto do_load = [&](int c) {
        const int t0c = z ? T - 16 * (c + 1) : 16 * c; const size_t m0 = (size_t)b * T + t0c;
#pragma unroll
        for (int ks = 0; ks < 2; ++ks) { const bf16* p = P.HD1 + (m0 + l15) * 256 + z * 64 + 32 * ks + 8 * l4; Ahw[ks] = *(const bf16x8*)p; Aha[ks] = *(const bf16x8*)(p + 128); }
        const size_t off = (m0 + rr) * 1024;
        r4 = *(const u32x2*)(P.R + off + chq + c4); k4 = *(const u32x2*)(P.K + off + chq + c4); v4 = *(const u32x2*)(P.V + off + chq + c4);
        kfull[0] = ((const u32x4*)(P.K + off + h * 64 + 16 * cg))[0]; kfull[1] = ((const u32x4*)(P.K + off + h * 64 + 16 * cg))[1];
    };
    auto prep_a = [&](int c) {
        LAS unsigned char* const bp = L + (z * 3 + c % 3) * CS_BUF;
        LAS unsigned char* const pz = L + CS_PZ + (z * 2 + (c & 1)) * 4608;
        const float zq = ozero(); f32x4 dw = (f32x4){zq, zq, zq, zq}, da = dw;
#pragma unroll
        for (int ks = 0; ks < 2; ++ks) { dw = mfma16(Ahw[ks], Wf[ks], dw); da = mfma16(Aha[ks], Af[ks], da); }
#pragma unroll
        for (int rg = 0; rg < 4; ++rg) { scrW[(4 * l4 + rg) * 20 + l15] = dw[rg]; scrA[(4 * l4 + rg) * 20 + l15] = da[rg]; }
        float ssq = 0.f;
#pragma unroll
        for (int q = 0; q < 2; ++q)
#pragma unroll
            for (int w = 0; w < 4; ++w) { const float k0 = bflo(kfull[q][w]) * kcn[q * 2 + (w >> 1)][(w & 1) * 2], k1 = bfhi(kfull[q][w]) * kcn[q * 2 + (w >> 1)][(w & 1) * 2 + 1]; ssq += k0 * k0 + k1 * k1; }
        ssq += swz_xor<16>(ssq); ssq = half_sum(ssq);
        const float inv = __builtin_amdgcn_rsqf(fmaxf(ssq, 1e-24f));
        asm volatile("s_waitcnt lgkmcnt(0)" ::: "memory");
        const f32x4 wp = *(const LAS f32x4*)(scrW + rr * 20 + c4), ap = *(const LAS f32x4*)(scrA + rr * 20 + c4);
        const f32x4 kf = (f32x4){bflo(k4.x), bfhi(k4.x), bflo(k4.y), bfhi(k4.y)}, rf = (f32x4){bflo(r4.x), bfhi(r4.x), bflo(r4.y), bfhi(r4.y)}, vf = (f32x4){bflo(v4.x), bfhi(v4.x), bflo(v4.y), bfhi(v4.y)};
        f32x4 at, rt, bt, kt, bhh, khh, gl; float bon = 0.f;
#pragma unroll
        for (int j = 0; j < 4; ++j) {
            const float lw = -0.60653066f * LOG2E * sigmoidf_(wp[j] + w0v[j]);
            const float ar = sigmoidf_(ap[j] + a0v[j]);
            const float kkn = kf[j] * kkv[j] * inv;
            const float kd = kf[j] * (1.0f + (ar - 1.0f) * kav[j]);
            const float bvec = kkn * ar, avec = -kkn;
            const float pi = row_prefix(lw), su = row_suffix(lw) - lw;
            const float eI = fexp2(pi), eE = fexp2(pi - lw), eN = frcp(eI), eS = fexp2(su);
            at[j] = avec * eE; rt[j] = rf[j] * eI; bt[j] = bvec * eN; kt[j] = kd * eN; bhh[j] = bvec * eS; khh[j] = kd * eS; gl[j] = eI * eS;
            bon += rf[j] * kd * rkv[j];
        }
        const int co = jl * 2;
        { u32x2 w; w.x = pk2(at[0], at[1]); w.y = pk2(at[2], at[3]); *(LAS u32x2*)(bp + CS_AT + te * 144 + co) = w; }
        { u32x2 w; w.x = pk2(rt[0], rt[1]); w.y = pk2(rt[2], rt[3]); *(LAS u32x2*)(bp + CS_RT + te * 144 + co) = w; }
        { u32x2 w; w.x = pk2(bt[0], bt[1]); w.y = pk2(bt[2], bt[3]); *(LAS u32x2*)(pz + te * 144 + co) = w; }
        { u32x2 w; w.x = pk2(kt[0], kt[1]); w.y = pk2(kt[2], kt[3]); *(LAS u32x2*)(pz + 2304 + te * 144 + co) = w; }
#pragma unroll
        for (int j = 0; j < 4; ++j) {
            const unsigned bk = pk2(bhh[j], khh[j]);
            *(LAS bf16*)(bp + CS_BK + (jl + j) * 80 + te * 2) = (bf16)(bk & 0xffffu);
            *(LAS bf16*)(bp + CS_BK + (jl + j) * 80 + 32 + te * 2) = (bf16)(bk >> 16);
        }
        *(LAS bf16*)(bp + CS_VT + (jl + 0) * 48 + te * 2) = (bf16)(v4.x & 0xffffu); *(LAS bf16*)(bp + CS_VT + (jl + 1) * 48 + te * 2) = (bf16)(v4.x >> 16);
        *(LAS bf16*)(bp + CS_VT + (jl + 2) * 48 + te * 2) = (bf16)(v4.y & 0xffffu); *(LAS bf16*)(bp + CS_VT + (jl + 3) * 48 + te * 2) = (bf16)(v4.y >> 16);
        if (te == 0) *(LAS f32x4*)(bp + CS_GL + jl * 4) = gl;
        bon += swz_xor<16>(bon); bon = half_sum(bon);
        if (cg == 0) bonp[((z * 3 + c % 3) * 4 + q4) * 16 + rr] = bon;
    };
    LAS float* const nsm = (LAS float*)(L + CS_NS + z * 1024);
    volatile LAS unsigned* const nflag = (volatile LAS unsigned*)(L + CS_NS + 2048 + z * 8);
    auto prep_b1 = [&](int c) {
        LAS unsigned char* const bp = L + (z * 3 + c % 3) * CS_BUF;
        const LAS unsigned char* const pz = L + CS_PZ + (z * 2 + (c & 1)) * 4608;
        const LAS unsigned char* const arow = bp + CS_AT + l15 * 144 + 16 * l4;
        const LAS unsigned char* const brow = pz + l15 * 144 + 16 * l4;
        const float zq = ozero(); f32x4 Nn = (f32x4){zq, zq, zq, zq}, Qq = Nn;
#pragma unroll
        for (int ks = 0; ks < 2; ++ks) { const bf16x8 af = lds16(arow + 64 * ks); Nn = mfma16(af, lds16(brow + 64 * ks), Nn); Qq = mfma16(af, lds16(brow + 2304 + 64 * ks), Qq); }
#pragma unroll
        for (int r = 0; r < 4; ++r) nsm[(4 * l4 + r) * 16 + l15] = Nn[r];
        asm volatile("s_waitcnt lgkmcnt(0)" ::: "memory");
        if (F.lane == 0) *nflag = (unsigned)(c + 1);
#pragma unroll
        for (int r = 0; r < 4; r += 2) { const int t = 4 * l4 + r;
            const unsigned w = pk2(l15 < t ? Qq[r] : 0.f, l15 < t + 1 ? Qq[r + 1] : 0.f);
            *(LAS bf16*)(bp + CS_SMQ + t * 80 + l15 * 2) = (bf16)(w & 0xffffu); *(LAS bf16*)(bp + CS_SMQ + (t + 1) * 80 + l15 * 2) = (bf16)(w >> 16); }
    };
    auto prep_b2 = [&](int c) {
        LAS unsigned char* const bp = L + (z * 3 + c % 3) * CS_BUF;
        const LAS unsigned char* const pz = L + CS_PZ + (z * 2 + (c & 1)) * 4608;
        const LAS unsigned char* const arow = bp + CS_RT + l15 * 144 + 16 * l4;
        const LAS unsigned char* const brow = pz + l15 * 144 + 16 * l4;
        const float zq = ozero(); const f32x4 zero = (f32x4){zq, zq, zq, zq}; f32x4 Nr = zero, Qr = zero;
#pragma unroll
        for (int ks = 0; ks < 2; ++ks) { const bf16x8 af = lds16(arow + 64 * ks); Nr = mfma16(af, lds16(brow + 64 * ks), Nr); Qr = mfma16(af, lds16(brow + 2304 + 64 * ks), Qr); }
#pragma unroll
        for (int r = 0; r < 4; r += 2) { const int t = 4 * l4 + r;
            const unsigned w0 = pk2(l15 <= t ? Nr[r] : 0.f, l15 <= t + 1 ? Nr[r + 1] : 0.f), w1 = pk2(l15 <= t ? Qr[r] : 0.f, l15 <= t + 1 ? Qr[r + 1] : 0.f);
            *(LAS bf16*)(bp + CS_NQ + t * 80 + l15 * 2) = (bf16)(w0 & 0xffffu); *(LAS bf16*)(bp + CS_NQ + (t + 1) * 80 + l15 * 2) = (bf16)(w0 >> 16);
            *(LAS bf16*)(bp + CS_NQ + t * 80 + 32 + l15 * 2) = (bf16)(w1 & 0xffffu); *(LAS bf16*)(bp + CS_NQ + (t + 1) * 80 + 32 + l15 * 2) = (bf16)(w1 >> 16); }
        while (*nflag != (unsigned)(c + 1)) __builtin_amdgcn_s_sleep(1);
        asm volatile("" ::: "memory");
        f32x4 Nc, Mc;
        { const f32x4 mrow = *(const LAS f32x4*)(nsm + l15 * 16 + 4 * l4);
#pragma unroll
          for (int r = 0; r < 4; ++r) { const float n = nsm[(4 * l4 + r) * 16 + l15]; Nc[r] = (l15 < 4 * l4 + r) ? n : 0.f; Mc[r] = (4 * l4 + r < l15) ? mrow[r] : 0.f; } }
        auto prod = [&](const f32x4& lt, const f32x4& rc, f32x4 acc) __attribute__((always_inline)) {
#pragma unroll
            for (int ks = 0; ks < 4; ++ks) acc = __builtin_amdgcn_mfma_f32_16x16x4f32(lt[ks], rc[ks], acc, 0, 0, 0);
            return acc; };
        const f32x4 N2 = prod(Mc, Nc, zero), M2 = prod(Nc, Mc, zero);
        const f32x4 N4 = prod(M2, N2, zero), M4 = prod(N2, M2, zero);
        f32x4 R = prod(N4, M4, zero);
#pragma unroll
        for (int r = 0; r < 4; ++r) R[r] += (4 * l4 + r == l15) ? 1.0f : 0.0f;
        R = prod(N4, R, R); R = prod(N2, R, R); R = prod(Nc, R, R);
        { u32x2 w; w.x = pk2(R[0], R[1]); w.y = pk2(R[2], R[3]); *(LAS u32x2*)(bp + CS_SMT + l15 * 80 + 8 * l4) = w; }
    };
    auto stage_s = [&](int c) {
        const LAS unsigned char* const bp = L + (z * 3 + c % 3) * CS_BUF;
        const int q = l4, i = l15;
#pragma unroll
        for (int jt = 0; jt < 4; ++jt) { u32x2 w; w.x = pk2(Z[jt][0], Z[jt][1]); w.y = pk2(Z[jt][2], Z[jt][3]); *(LAS u32x2*)(ZB + i * 144 + (16 * jt + 4 * q) * 2) = w; }
        asm volatile("" ::: "memory");
        const bf16x8 Zb0 = lds16(ZB + i * 144 + (8 * q) * 2), Zb1 = lds16(ZB + i * 144 + (32 + 8 * q) * 2);
        const bf16x8 Vb = lds16(bp + CS_VT + (16 * q4 + i) * 48 + 8 * (q & 1) * 2);
        const LAS unsigned char* arow = bp + l15 * 144 + 8 * q * 2;
        const float zq = ozero(); const f32x4 zero = (f32x4){zq, zq, zq, zq};
        f32x4 X = mfma16(lds16(arow + CS_AT), Zb0, zero); f32x4 Yv = mfma16(lds16(arow + CS_RT), Zb0, zero);
        X = mfma16(lds16(arow + CS_AT + 64), Zb1, X); Yv = mfma16(lds16(arow + CS_RT + 64), Zb1, Yv);
        X = mfma16(lds16(bp + CS_SMQ + l15 * 80 + 16 * q), Vb, X);
        { u32x2 w; w.x = pk2(X[0], X[1]); w.y = pk2(X[2], X[3]); *(LAS u32x2*)(XB + i * 48 + 8 * q) = w; }
        asm volatile("" ::: "memory");
        const bf16x8 Xb = lds16(XB + i * 48 + 16 * (q & 1));
        const f32x4 U = mfma16(lds16(bp + CS_SMT + l15 * 80 + 16 * q), Xb, zero);
        { u32x2 w; w.x = pk2(U[0], U[1]); w.y = pk2(U[2], U[3]); *(LAS u32x2*)(UB + i * 48 + 8 * q) = w; }
        asm volatile("" ::: "memory");
        const bf16x8 Ub = lds16(UB + i * 48 + 16 * (q & 1));
        const bf16x8 UVb = q < 2 ? Ub : Vb;
        Yv = mfma16(lds16(bp + CS_NQ + l15 * 80 + 16 * q), UVb, Yv);
#pragma unroll
        for (int r = 0; r < 4; ++r) yst[(4 * q + r) * 16 + i] = Yv[r];
#pragma unroll
        for (int jt = 0; jt < 4; ++jt) { const f32x4 g = *(const LAS f32x4*)(bp + CS_GL + (16 * jt + 4 * q) * 4);
            Z[jt] = mfma16(lds16(bp + CS_BK + (16 * jt + l15) * 80 + 16 * q), UVb, Z[jt] * g); }
    };
    auto flush_y = [&](int c) {
        const int t0c = z ? T - 16 * (c + 1) : 16 * c; const int st = F.lane >> 2, i4 = (F.lane & 3) * 4;
        f32x4 yv = *(const LAS f32x4*)(yst + st * 16 + i4);
        u32x2 w; w.x = pk2(yv.x, yv.y); w.y = pk2(yv.z, yv.w);
        *(u32x2*)(Y + (size_t)(b * T + t0c + (z ? 15 - st : st)) * 1024 + chq + i4) = w;
    };
    auto bonus_flush = [&](int c) {
        if (q4 == 0 && F.lane < 16) {
            const int t0c = z ? T - 16 * (c + 1) : 16 * c; const size_t m0 = (size_t)b * T + t0c;
            const LAS float* qq = bonp + (z * 3 + c % 3) * 64 + F.lane;
            P.BON[((size_t)z * M + m0 + F.lane) * 16 + h] = (qq[0] + qq[16]) + (qq[32] + qq[48]);
        }
    };
    __syncthreads();
    for (int e = F.tid; e < 6 * 2 * 16 * 8; e += 512) { const int row = (e >> 3) & 15, tile = (e >> 7) & 1, zb = e >> 8, w = e & 7;
        *(LAS unsigned*)(L + zb * CS_BUF + (tile ? CS_SMT : CS_SMQ) + row * 80 + 32 + w * 4) = 0u; }
    const bool pa_wave = (q4 == z), pb_wave = (q4 == (z ^ 2));
    if (F.tid < 4) ((LAS unsigned*)(L + CS_NS + 2048))[F.tid] = 0u;
    constexpr int NC = T / 16;
    do_load(0); prep_a(0); do_load(1); prep_a(1);
    asm volatile("s_waitcnt lgkmcnt(0)" ::: "memory"); __builtin_amdgcn_s_barrier(); asm volatile("" ::: "memory");
    if (pa_wave) prep_b1(0);
    if (pb_wave) prep_b2(0);
    do_load(2);
    asm volatile("s_waitcnt lgkmcnt(0)" ::: "memory"); __builtin_amdgcn_s_barrier(); asm volatile("" ::: "memory");
    for (int e = 0; e < NC; ++e) {
        if (pa_wave && e + 1 < NC) prep_b1(e + 1);
        if (pb_wave && e + 1 < NC) prep_b2(e + 1);
        asm volatile("" ::: "memory");
        if (e > 0) flush_y(e - 1);
        if (e + 1 < NC) bonus_flush(e + 1);
        if (e == 0) bonus_flush(0);
#pragma unroll 1
        for (int st = 0; st < 2; ++st) {
            if ((st ^ z) == 0) {
                if (e + 2 < NC) prep_a(e + 2);
                asm volatile("" ::: "memory");
                if (e + 3 < NC) do_load(e + 3);
            } else {
                stage_s(e);
            }
            asm volatile("" ::: "memory");
        }
        asm volatile("s_waitcnt lgkmcnt(0)" ::: "memory");
        __builtin_amdgcn_s_barrier(); asm volatile("" ::: "memory");
    }
    flush_y(T / 16 - 1);
}

#define XB_TMO      128
#define XB_XCNT(j)  (256  + 64 * (j))
#define XB_XSUB(j)  (1280 + 64 * (j))
#define XB_XGEN(j)  (2304 + 64 * (j))
#define XB_TOP      3328
#define XB_TOPGEN   3392
#define XCD_BAR_WORDS 3456
#define XB_SPIN_CAP (1u << 22)
DI unsigned xb_ld(unsigned* p)              { return __hip_atomic_load(p, __ATOMIC_RELAXED, __HIP_MEMORY_SCOPE_AGENT); }
DI unsigned xb_add(unsigned* p, unsigned v) { return __hip_atomic_fetch_add(p, v, __ATOMIC_RELAXED, __HIP_MEMORY_SCOPE_AGENT); }
DI unsigned xb_xcc_id() { return (unsigned)__builtin_amdgcn_s_getreg((3 << 11) | 20) & 0xFu; }
#define XB_SPIN(cond, bar) do { unsigned _sp = 0; while (cond) { __builtin_amdgcn_s_sleep(1); \
    if ((++_sp & 255u) == 0u) { if (xb_ld(&(bar)[XB_TMO])) break; if (_sp > XB_SPIN_CAP) { atomicAdd(&(bar)[XB_TMO], 1u); break; } } } } while (0)
struct XcdBarrier { unsigned* bar; unsigned x; volatile LAS unsigned* st; };
DI XcdBarrier xcd_barrier_post(unsigned* bar, volatile LAS unsigned* st) {
    XcdBarrier b; b.bar = bar; b.x = xb_xcc_id(); b.st = st;
    if (threadIdx.x == 0) (void)xb_add(&bar[XB_XCNT(b.x)], 1u);
    return b;
}
DI void xcd_barrier_complete(unsigned* bar, unsigned x, unsigned& nloc, unsigned& nx) {
    const unsigned G = gridDim.x * gridDim.y * gridDim.z;
    unsigned sum, cnt, mine, sp = 0u;
    for (;;) {
        sum = 0u; cnt = 0u; mine = 0u;
#pragma unroll
        for (unsigned j = 0; j < 16; ++j) { const unsigned c = xb_ld(&bar[XB_XCNT(j)]); sum += c; cnt += (c > 0u) ? 1u : 0u; mine = (j == x) ? c : mine; }
        if (sum == G) break;
        __builtin_amdgcn_s_sleep(1);
        if ((++sp & 255u) == 0u) { if (xb_ld(&bar[XB_TMO])) break; if (sp > XB_SPIN_CAP) { atomicAdd(&bar[XB_TMO], 1u); break; } }
    }
    nloc = mine > 0u ? mine : 1u; nx = cnt > 0u ? cnt : 1u;
}
DI void xcd_barrier(const XcdBarrier& b) {
    asm volatile("s_waitcnt vmcnt(0)" ::: "memory");
    __syncthreads();
    if (threadIdx.x == 0) {
        unsigned* bar = b.bar;
        __builtin_amdgcn_s_waitcnt(0);
        unsigned nloc = b.st[0], nx = b.st[1];
        if (nloc == 0u) { xcd_barrier_complete(bar, b.x, nloc, nx); b.st[0] = nloc; b.st[1] = nx; }
        const unsigned old = xb_add(&bar[XB_XSUB(b.x)], 1u);
        const unsigned gen = old / nloc;
        if (old + 1u == (gen + 1u) * nloc) {
            __builtin_amdgcn_fence(__ATOMIC_RELEASE, "agent");
            asm volatile("s_waitcnt vmcnt(0)" ::: "memory");
            const unsigned og = xb_add(&bar[XB_TOP], 1u);
            const unsigned tg = og / nx;
            if (og + 1u == (tg + 1u) * nx) xb_add(&bar[XB_TOPGEN], 1u);
            else XB_SPIN(xb_ld(&bar[XB_TOPGEN]) == tg, bar);
            __builtin_amdgcn_fence(__ATOMIC_ACQUIRE, "agent");
            xb_add(&bar[XB_XGEN(b.x)], 1u);
            asm volatile("s_waitcnt vmcnt(0)" ::: "memory");
        } else {
            XB_SPIN(xb_ld(&bar[XB_XGEN(b.x)]) == gen, bar);
            __builtin_amdgcn_fence(__ATOMIC_ACQUIRE, "agent");
            asm volatile("s_waitcnt vmcnt(0)" ::: "memory");
        }
    }
    __syncthreads();
}

#ifndef MK_PROG
#define MK_PROG 0,3,4,5,7,8,10,11,12,13,16,14,15,17,19,20,22,23,24
#endif
__constant__ int PROG[] = {MK_PROG};
constexpr int NPH = sizeof(PROG) / sizeof(int);
template <int TYPE> struct PreSched {
    static constexpr int AJT = 1 << 30; static constexpr size_t ajump = 0;
    const bf16* KV; const bf16* W; int G, c;
    DI bool next(int i, Unit& u) const {
        const long L = (long)i * G + c; if (L >= 512) return false;
        const int rem = (int)L, i2 = rem >> 8, b = (rem >> 4) & 15, hh = (rem >> 2) & 3, t4 = rem & 3;
        u.pm = 0; u.pn = 0;
        const bf16* kvp = KV + (size_t)(b * 256) * 4096 + i2 * 2048 + hh * 256;
        const bf16* wp = W + (size_t)i2 * 1024 * 1024 + (size_t)(t4 * 256) * 1024 + hh * 256;
        if (TYPE == 0) { u.pa = (const char*)kvp; u.pb = (const char*)wp; u.z = (i2 << 30) | (b * 1048576 + hh * 256 * 1024 + t4 * 256); }
        else { u.pa = (const char*)wp; u.pb = (const char*)(kvp + 1024); u.z = (i2 << 30) | (16 * 1048576 + b * 1048576 + t4 * 256 * 1024 + hh * 256); }
        return true;
    }
};

__global__ void __launch_bounds__(512, 2) mk_fwd(Args a) {
    extern __shared__ __attribute__((aligned(16))) unsigned char lds_raw[];
    Frame F;
    F.lds = (LAS unsigned char*)lds_raw;
    F.tid = threadIdx.x; F.lane = F.tid & 63; F.wave = __builtin_amdgcn_readfirstlane(F.tid >> 6);
    F.gw = blockIdx.x * 8 + F.wave; F.ngw = gridDim.x * 8; F.ws = a.ws;
    cg::grid_group grid = cg::this_grid();
    volatile LAS unsigned* MISC = (volatile LAS unsigned*)(F.lds + LDS_MISC);
    if (F.tid < 2) MISC[F.tid] = 0u;
    __syncthreads();
    (void)xcd_barrier_post((unsigned*)(a.ws + WS_BAR), MISC);

    for (int pi = a.ph_lo; pi < a.ph_hi; ++pi) {
        const int ph = PROG[pi];
        const int G = opq(gridDim.x), cblk = opq(blockIdx.x);
        unsigned char* ws = a.ws + (size_t)opq(0);
        float* RS = (float*)(ws + WS_RS);
        bf16* SA = (bf16*)(ws + WS_SA); bf16* SB = (bf16*)(ws + WS_SB);
        bf16* H = (bf16*)a.out;
        const int li = ph >= 18 ? 1 : 0;
        int cp = ph; if (ph >= 18 && ph <= 23) cp = ph - 12;
#ifndef PH_MASK
#define PH_MASK 0xffffffffu
#endif
        if (!((PH_MASK >> cp) & 1u)) cp = 99;
        switch (cp) {
        case 0: phase_prologue(F, a, ws); break;
        case 3: {
            { pg8::PlainSched S{SA, (const bf16*)(ws + WS_WIN), 1024, 1024, M / 256, 8, G, cblk, 30, 0};
              EpiInProj E{(bf16*)(ws + WS_GLU), SB, RS};
              pg8::gemm_phase(F.lds, 1024, 1024, 1024, S, E); }
            { pg8::PlainSched S{(const bf16*)(ws + WS_WIN) + (size_t)2048 * 1024, SA, 1024, 1024, 2, M / 256, G, cblk, 30, 0};
              EpiVT E{(bf16*)(ws + WS_VT), RS};
              pg8::gemm_phase(F.lds, 1024, 1024, 1024, S, E); }
                    {

            pg8::PlainSched S{(const bf16*)(ws + WS_MEMB), (const bf16*)(ws + WS_WKV), 1024, 1024, MMEM / 256, 16, G, cblk, 30, 0};
            EpiRowScale<0> E{(bf16*)(ws + WS_KV), 4096, (const float*)(ws + WS_RSMEM), nullptr};
            pg8::gemm_phase(F.lds, 1024, 1024, 1024, S, E);
                    }
        } break;
        case 4: {
            const float lam = ((const float*)(ws + WS_LAM))[0];
            for (int u = cblk; u < 1024; u += G) diffattn_unit(F, u, SB, (const bf16*)(ws + WS_VT), (const float*)(ws + WS_BIAS), lam, a.in[opq(I_SUBLN)], (bf16*)(ws + WS_MIX));
            __syncthreads();
            conv_load_weights(F, a.in[opq(I_CONVW)]);
            for (int u = cblk; u < 512; u += G) conv_unit(F, u, (const bf16*)(ws + WS_GLU), a.in[opq(I_CONVB)], a.in[opq(I_CLNG)], a.in[opq(I_CLNB)], (bf16*)(ws + WS_MIX));
            __syncthreads();
                    {

            EpiPre E{(bf16*)(ws + WS_G0)};
            { PreSched<0> S{(const bf16*)(ws + WS_KV), (const bf16*)(ws + WS_WQN), G, cblk}; pg8::gemm_phase(F.lds, 256, 4096, 1024, S, E); }
            { PreSched<1> S{(const bf16*)(ws + WS_KV), (const bf16*)(ws + WS_WXO), G, cblk}; pg8::gemm_phase(F.lds, 256, 1024, 4096, S, E); }
                    }
        } break;
        case 5: {
            pg8::PlainSched S{(const bf16*)(ws + WS_MIX), (const bf16*)(ws + WS_WOUT), 1024, 1024, M / 256, 4, G, cblk, 30, 0};
            EpiResid E{a.in[opq(I_X)], nullptr, H, (float*)(ws + WS_PS)};
            pg8::gemm_phase(F.lds, 1024, 1024, 1024, S, E);
        } break;
        case 7: {
            pg8::PlainSched S{H, (const bf16*)(ws + (li ? WS_G1 : WS_G0)), 1024, 1024, M / 256, 4, G, cblk, 3, (size_t)1048576};
            EpiSoftmax E{SB, (const float*)(ws + WS_PS)};
            pg8::gemm_phase(F.lds, 1024, 1024, 1024, S, E);
        } break;
        case 8: {
            pg8::PlainSched S{SB, (const bf16*)(ws + (li ? WS_VW1 : WS_VW0)), 1024, 1024, M / 256, 4, G, cblk, 3, (size_t)1048576};
            EpiResid E{nullptr, H, H, (float*)(ws + WS_PS)};
            pg8::gemm_phase(F.lds, 1024, 1024, 1024, S, E);
        } break;
        case 10: {
            pg8::PlainSched S{H, (const bf16*)(ws + WS_WUP) + (size_t)li * 4096 * 1024, 1024, 1024, M / 256, 16, G, cblk, 30, 0};
            EpiRowScale<2> E{(bf16*)(ws + WS_HID), 4096, nullptr, (const float*)(ws + WS_PS)};
            pg8::gemm_phase(F.lds, 1024, 1024, 1024, S, E);
        } break;
        case 11: {
            pg8::PlainSched S{(const bf16*)(ws + WS_HID), (const bf16*)(ws + WS_WDN) + (size_t)li * 1024 * 4096, 4096, 4096, M / 256, 4, G, cblk, 30, 0};
            EpiResid E{nullptr, H, li ? SA : H, nullptr};
            pg8::gemm_phase(F.lds, 4096, 4096, 4096, S, E);
        } break;
        case 12: phase_rwkv_shift(F, H, a.in[opq(I_NMIX)] + 1024, a.in[opq(I_MU)], (bf16*)(ws + WS_XR), (bf16*)a.out + (size_t)M * 1024, (bf16*)(ws + WS_XV), (bf16*)(ws + WS_HH)); break;
        case 13: {
            pg8::SelSched<4, 1 << 30> S{(const bf16*)a.out + (size_t)M * 1024, (const bf16*)(ws + WS_XV), (const bf16*)(ws + WS_WBIG) + (size_t)1024 * 1024, 1024, 1024, M / 256, 8, 4, G, cblk, 0};
            EpiRwkv E{(bf16*)(ws + WS_R), (bf16*)(ws + WS_K), (bf16*)(ws + WS_V), (bf16*)(ws + WS_HD1), (bf16*)(ws + WS_HD2)};
            pg8::gemm_phase(F.lds, 1024, 1024, 1024, S, E);
        } break;
        case 16: {
            EpiRwkv E{(bf16*)(ws + WS_R), (bf16*)(ws + WS_K), (bf16*)(ws + WS_V), (bf16*)(ws + WS_HD1), (bf16*)(ws + WS_HD2)};
            { pg8::SelSched<0, 1 << 30> S{(const bf16*)(ws + WS_XR), (const bf16*)(ws + WS_XR), (const bf16*)(ws + WS_WBIG), 1024, 1024, M / 256, 4, 4, G, cblk, 0};
              pg8::gemm_phase(F.lds, 1024, 1024, 1024, S, E); }
            { pg8::SelSched<12, 16> S{(const bf16*)(ws + WS_XR), (const bf16*)(ws + WS_XR), (const bf16*)(ws + WS_WLORA), 1024, 2048, M / 256, 2, 2, G, cblk, ((size_t)M * 1024 - 1024) * 2};
              pg8::gemm_phase(F.lds, 2048, 1024, 2048, S, E); }
        } break;
        case 14: {
            ScanPtrs P{(const bf16*)(ws + WS_R), (const bf16*)(ws + WS_K), (const bf16*)(ws + WS_V), (const bf16*)(ws + WS_HD1), (const bf16*)(ws + WS_W2T),
                       a.in[opq(I_W0)], a.in[opq(I_A0)], a.in[opq(I_KK)], a.in[opq(I_KA)], a.in[opq(I_RK)], (bf16*)(ws + WS_YF), (bf16*)(ws + WS_YB), (float*)(ws + WS_BONUS), (unsigned*)(ws + WS_BAR + 32768)};
            for (int bh = cblk; bh < 256; bh += G) scan_pair_mfma(F, bh, P);
            __syncthreads();
        } break;
        case 15: {
            pg8::PlainSched S{(const bf16*)(ws + WS_HD2), (const bf16*)(ws + WS_G2T), 256, 256, M / 256, 4, G, cblk, 30, 0};
            EpiGateComb E{(const bf16*)(ws + WS_YF), (const bf16*)(ws + WS_YB), (const bf16*)(ws + WS_V), (const float*)(ws + WS_BONUS), a.in[opq(I_LNG)], a.in[opq(I_LNB)], (bf16*)(ws + WS_COMB)};
            pg8::gemm_phase(F.lds, 256, 256, 256, S, E);
        } break;
        case 17: {
            pg8::PlainSched S{(const bf16*)(ws + WS_COMB), (const bf16*)(ws + WS_WRO), 1024, 1024, M / 256, 4, G, cblk, 30, 0};
            EpiResid E{nullptr, H, H, (float*)(ws + WS_PS)};
            pg8::gemm_phase(F.lds, 1024, 1024, 1024, S, E);
        } break;
        case 24: {
            float osc = 1.0f;
            phase_final_norm(F, SA, a.out, a.in[opq(I_NFINAL)], osc);
        } break;
        default: break;
        }
        if (pi + 1 < a.ph_hi) {
            if (a.ph_lo < 0) grid.sync();
            { XcdBarrier xb; xb.bar = (unsigned*)(ws + WS_BAR); xb.x = xb_xcc_id(); xb.st = (volatile LAS unsigned*)(F.lds + LDS_MISC); xcd_barrier(xb); }
        }
    }
}

extern "C" void kernel_launch(void* const* d_in, const int* in_sizes, int n_in, void* d_out, int out_size, void* d_ws, size_t ws_size, hipStream_t stream) {
    static int grid = 0;
    if (grid == 0) {
        if (n_in != N_IN || in_sizes[0] != M * D || out_size != M * D || ws_size < WS_NEED) {
            fprintf(stderr, "kernel_launch: unexpected problem (n_in %d, in0 %d, out %d, ws %zu); nothing launched\n", n_in, n_in > 0 ? in_sizes[0] : -1, out_size, ws_size); grid = -1; return; }
        int dev = 0, cus = 0, per_cu = 0;
        if (hipGetDevice(&dev) != hipSuccess || hipDeviceGetAttribute(&cus, hipDeviceAttributeMultiprocessorCount, dev) != hipSuccess) { grid = -1; return; }
        if (hipFuncSetAttribute((const void*)mk_fwd, hipFuncAttributeMaxDynamicSharedMemorySize, LDS_BYTES) != hipSuccess) { fprintf(stderr, "kernel_launch: hipFuncSetAttribute failed\n"); grid = -1; return; }
        if (hipOccupancyMaxActiveBlocksPerMultiprocessor(&per_cu, (const void*)mk_fwd, 512, LDS_BYTES) != hipSuccess || per_cu < 1) { fprintf(stderr, "kernel_launch: occupancy query says %d\n", per_cu); (void)hipGetLastError(); grid = -1; return; }
        grid = cus;
    }
    if (grid < 0) return;
    if (hipMemsetAsync((char*)d_ws + WS_BAR, 0, 65536, stream) != hipSuccess) { fprintf(stderr, "kernel_launch: memset failed\n"); return; }
    Args a{};
    for (int i = 0; i < N_IN; ++i) a.in[i] = (const float*)d_in[i];
    a.out = (float*)d_out; a.ws = (unsigned char*)d_ws;
#if MK_SINGLE
    a.ph_lo = 0; a.ph_hi = NPH;
    void* params[] = {&a};
    hipError_t e = hipLaunchCooperativeKernel((const void*)mk_fwd, dim3(grid), dim3(512), params, LDS_BYTES, stream);
    if (e != hipSuccess) fprintf(stderr, "kernel_launch: cooperative launch failed: %s\n", hipGetErrorString(e));
#else
    for (int ph = 0; ph < NPH; ++ph) { a.ph_lo = ph; a.ph_hi = ph + 1; hipLaunchKernelGGL(mk_fwd, dim3(grid), dim3(512), LDS_BYTES, stream, a); }
#endif
}
```

```cpp
#include <hip/hip_runtime.h>
#include <hip/hip_cooperative_groups.h>
#include <cstdio>
#include <cstdint>
namespace cg = cooperative_groups;

#ifndef MK_SINGLE
#define MK_SINGLE 1
#endif

#define LAS __attribute__((address_space(3)))
#define DI __device__ __forceinline__
typedef unsigned short bf16;
typedef short bf16x8 __attribute__((ext_vector_type(8)));
typedef short s16x4 __attribute__((ext_vector_type(4)));
typedef float f32x2 __attribute__((ext_vector_type(2)));
typedef float f32x4 __attribute__((ext_vector_type(4)));
typedef float f32x16 __attribute__((ext_vector_type(16)));
typedef unsigned u32x2 __attribute__((ext_vector_type(2)));
typedef unsigned u32x4 __attribute__((ext_vector_type(4)));

constexpr int D = 1024, NB = 16, T = 2048, M = NB * T, NMEM = 256, MMEM = NB * NMEM;
constexpr int FF = 4096;
constexpr float EPS = 1e-6f;
constexpr float LOG2E = 1.4426950408889634f;

constexpr size_t MiB = 1u << 20;
constexpr size_t WS_BAR = 0;
constexpr size_t WS_RS = 64 * 1024;
constexpr size_t WS_RSMEM = WS_RS + M * 4;
constexpr size_t WS_BIAS = WS_RSMEM + MMEM * 4;
constexpr size_t WS_LAM = WS_BIAS + 4 * 4096 * 4;
constexpr size_t WS_WIN = 1 * MiB;
constexpr size_t WS_WOUT = WS_WIN + 5 * MiB;
constexpr size_t WS_WQN = WS_WOUT + 2 * MiB;
constexpr size_t WS_WKV = WS_WQN + 4 * MiB;
constexpr size_t WS_WXO = WS_WKV + 8 * MiB;
constexpr size_t WS_WUP = WS_WXO + 4 * MiB;
constexpr size_t WS_WDN = WS_WUP + 16 * MiB;
constexpr size_t WS_WBIG = WS_WDN + 16 * MiB;
constexpr size_t WS_WLORA = WS_WBIG + 6 * MiB;
constexpr size_t WS_W2T = WS_WBIG + 14 * MiB;
constexpr size_t WS_G2T = WS_W2T + 512 * 1024;
constexpr size_t WS_WRO = WS_G2T + 512 * 1024;
constexpr size_t WS_WEND = WS_WRO + 2 * MiB;
static_assert(WS_WEND == 73 * MiB, "weight map");
constexpr size_t WS_SA = 73 * MiB;
constexpr size_t WS_SB = 137 * MiB;
constexpr size_t WS_GLU = 201 * MiB;
constexpr size_t WS_VT = 233 * MiB;
constexpr size_t WS_MIX = 265 * MiB;
constexpr size_t WS_G0 = 329 * MiB;
constexpr size_t WS_VW0 = 361 * MiB;
constexpr size_t WS_MEMB = 393 * MiB;
constexpr size_t WS_KV = 401 * MiB;
constexpr size_t WS_G1 = 433 * MiB;
constexpr size_t WS_VW1 = 465 * MiB;
static_assert(WS_G1 - WS_G0 == 104 * MiB && WS_VW0 - WS_G0 == 32 * MiB && WS_VW1 - WS_G1 == 32 * MiB, "G / VW spacing used by EpiPre");
constexpr size_t WS_BONUS = 497 * MiB;
constexpr size_t WS_PS = 502 * MiB;
constexpr size_t WS_HID = 137 * MiB;
constexpr size_t WS_XR = 73 * MiB, WS_HH = 137 * MiB, WS_XV = 201 * MiB;
constexpr size_t WS_R = 201 * MiB, WS_K = 265 * MiB, WS_V = 329 * MiB;
static_assert(WS_K - WS_R == 64 * MiB && WS_V - WS_K == 64 * MiB, "r, k, v spacing used by EpiRwkv");
constexpr size_t WS_HD1 = 393 * MiB;
constexpr size_t WS_HD2 = 409 * MiB;
constexpr size_t WS_YF = 73 * MiB, WS_YB = 137 * MiB;
constexpr size_t WS_GATE = 265 * MiB;
constexpr size_t WS_COMB = 201 * MiB;
constexpr size_t WS_NEED = 512 * MiB;

constexpr int LDS_X = 131072;
constexpr int LDS_MISC = 163840 - 256;
constexpr int LDS_BYTES = 163840;

DI unsigned f2bf(float f) { unsigned u = __builtin_bit_cast(unsigned, f); return (u + 0x7fffu + ((u >> 16) & 1u)) >> 16; }
typedef __bf16 bf16x2v __attribute__((ext_vector_type(2)));
DI unsigned pk2(float lo, float hi) { const f32x2 v = {lo, hi}; return __builtin_bit_cast(unsigned, __builtin_convertvector(v, bf16x2v)); }
DI float bf2f(unsigned short b) { return __builtin_bit_cast(float, ((unsigned)b) << 16); }
DI float bflo(unsigned w) { return __builtin_bit_cast(float, w << 16); }
DI float bfhi(unsigned w) { return __builtin_bit_cast(float, w & 0xffff0000u); }
template <int MASK> DI float swz_xor(float v) { return __builtin_bit_cast(float, __builtin_amdgcn_ds_swizzle(__builtin_bit_cast(int, v), (MASK << 10) | 0x1f)); }
DI float half_sum(float v) { const int x = __builtin_bit_cast(int, v); const auto r = __builtin_amdgcn_permlane32_swap(x, x, false, false); return __builtin_bit_cast(float, (int)r[0]) + __builtin_bit_cast(float, (int)r[1]); }
DI float half_max(float v) { const int x = __builtin_bit_cast(int, v); const auto r = __builtin_amdgcn_permlane32_swap(x, x, false, false); return fmaxf(__builtin_bit_cast(float, (int)r[0]), __builtin_bit_cast(float, (int)r[1])); }
DI float wave_sum(float v) {
    v += swz_xor<1>(v); v += swz_xor<2>(v); v += swz_xor<4>(v); v += swz_xor<8>(v); v += swz_xor<16>(v); v = half_sum(v);
    return v;
}
DI float ozero() { float z; asm volatile("v_mov_b32 %0, 0" : "=v"(z)); return z; }
DI int opaque(int x) { asm volatile("" : "+v"(x)); return x; }
template <class Tp> DI Tp* opq_ptr(Tp* p) { asm volatile("" : "+s"(p)); return p; }
DI int opq(int x) { asm volatile("" : "+s"(x)); return x; }
DI float fexp2(float x) { return __builtin_amdgcn_exp2f(x); }
DI float frcp(float x) { return __builtin_amdgcn_rcpf(x); }
DI float sigmoidf_(float x) { return frcp(1.0f + fexp2(-x * LOG2E)); }
DI float tanhf_(float x) { float e = fexp2(-2.0f * LOG2E * fabsf(x)); float t = (1.0f - e) * frcp(1.0f + e); return x < 0.f ? -t : t; }

namespace pg8 {
constexpr int BM = 256, BK = 64, HALF = 128, HTB = HALF * BK * 2, STAGE_BYTES = 8 * HTB, NXCD = 8, WGM = 8;
DI int lds_byte(int r, int c) { const int st = (r >> 4) * 2 + (c >> 5), rr = r & 15, cc = c & 31, ob = rr * 64 + cc * 2; return st * 1024 + (ob ^ (((ob >> 9) & 1) << 5)); }
DI void stage_rc(int b, int& R, int& C) { const int st = b / 1024, sb = b % 1024, swz = sb ^ (((sb >> 9) & 1) << 5); R = (st >> 1) * 16 + swz / 64; C = (st & 1) * 32 + (swz % 64) / 2; }
DI int perm32(int rho) { const int n = rho >> 4, i = rho & 15; return 8 * (i >> 2) + 4 * n + (i & 3); }

struct Unit { int pm, pn, z; const char* pa; const char* pb; };

DI bool tile_order(long L, int nM, int nN, int& pm, int& pn) {
    const int nwg = nM * nN; if (L >= nwg) return false;
    int wgid = (int)L; { const int q = nwg / NXCD, r = nwg % NXCD, xcd = wgid % NXCD, off = wgid / NXCD; wgid = (xcd < r ? xcd * (q + 1) : r * (q + 1) + (xcd - r) * q) + off; }
    const int nig = WGM * nN, gid = wgid / nig, fm = gid * WGM, gsz = (nM - fm) < WGM ? (nM - fm) : WGM;
    pm = fm + ((wgid % nig) % gsz); pn = (wgid % nig) / gsz; return true;
}
struct PlainSched {
    static constexpr int AJT = 1 << 30; static constexpr size_t ajump = 0;
    const bf16* A; const bf16* Bt; int lda, ldb, nM, nN, G, c, bshift; size_t bstride;
    DI bool next(int i, Unit& u) const {
        if (!tile_order((long)i * G + c, nM, nN, u.pm, u.pn)) return false;
        u.z = u.pm >> bshift;
        u.pa = (const char*)(A + (size_t)u.pm * 256 * lda);
        u.pb = (const char*)(Bt + (size_t)u.z * bstride + (size_t)u.pn * 256 * ldb);
        return true;
    }
};

template <int PN0, int AJT_> struct SelSched {
    static constexpr int AJT = AJT_;
    const bf16* A0; const bf16* A1; const bf16* Bt; int lda, ldb, nM, nN, split, G, c; size_t ajump;
    DI bool next(int i, Unit& u) const {
        int pn; if (!tile_order((long)i * G + c, nM, nN, u.pm, pn)) return false;
        u.z = 0; u.pn = pn + PN0;
        u.pa = (const char*)((pn < split ? A0 : A1) + (size_t)u.pm * 256 * lda);
        u.pb = (const char*)(Bt + (size_t)pn * 256 * ldb);
        return true;
    }
};
DI unsigned cvt_pk_bf16(float lo, float hi) { return pk2(lo, hi); }

template <class Epi, class Sched>
DI void gemm_phase(LAS unsigned char* lds, const int K, const int lda, const int ldb, const Sched& S, const Epi& E) {
    const int tid = opaque(threadIdx.x), wid = __builtin_amdgcn_readfirstlane(tid >> 6), lane = tid & 63, wr = wid >> 2, wc = wid & 3, fr = lane & 15, fq = lane >> 4;
    const int nt = K / BK;
    unsigned voffA[2], voffB[2];
#pragma unroll
    for (int i = 0; i < 2; ++i) { int R, C; stage_rc(tid * 16 + i * 8192, R, C); const int Rb = Epi::PERM ? ((R & ~31) + perm32(R & 31)) : R;
        voffA[i] = (unsigned)(R * lda + C) * 2u; voffB[i] = (unsigned)(Rb * ldb + C) * 2u; }
    const size_t kstep = (size_t)(BK * 2);
    const size_t hstepA = (size_t)HALF * lda * 2, hstepB = (size_t)HALF * ldb * 2;
    const unsigned ldsw = (unsigned)wid * 1024u;
    const int aoff = lds_byte(wr * 64 + fr, fq * 8), boff = lds_byte(wc * 32 + fr, fq * 8);
#define PG8_SA(b, h) (((b) * 2 + (h)) * HTB)
#define PG8_SB(b, h) ((4 + (b) * 2 + (h)) * HTB)
#define PG8_STAGE(bufoff, gbase, voff) do { _Pragma("unroll") for (int _i = 0; _i < 2; ++_i) \
        __builtin_amdgcn_global_load_lds((const unsigned*)((const char*)(gbase) + (voff)[_i]), (LAS unsigned*)(lds + (bufoff) + ldsw + _i * 8192), 16, 0, 0); } while (0)
#define PG8_LDA(dst, b, h) do { _Pragma("unroll") for (int m = 0; m < 4; ++m) _Pragma("unroll") for (int k = 0; k < 2; ++k) dst[m][k] = *(const LAS bf16x8*)(lds + PG8_SA(b, h) + aoff + m * 2048 + k * 1024); } while (0)
#define PG8_LDB(dst, b, h) do { _Pragma("unroll") for (int n = 0; n < 2; ++n) _Pragma("unroll") for (int k = 0; k < 2; ++k) dst[n][k] = *(const LAS bf16x8*)(lds + PG8_SB(b, h) + boff + n * 2048 + k * 1024); } while (0)
#define PG8_MMA(ai, bj, At, Bt) do { __builtin_amdgcn_s_setprio(1); _Pragma("unroll") for (int m = 0; m < 4; ++m) _Pragma("unroll") for (int n = 0; n < 2; ++n) _Pragma("unroll") for (int k = 0; k < 2; ++k) \
        acc[ai][bj][m][n] = __builtin_amdgcn_mfma_f32_16x16x32_bf16(Bt[n][k], At[m][k], acc[ai][bj][m][n], 0, 0, 0); __builtin_amdgcn_s_setprio(0); } while (0)
#define PG8_WAIT_V(n) asm volatile("s_waitcnt vmcnt(" #n ")" ::: "memory")
#define PG8_WAIT_L(n) asm volatile("s_waitcnt lgkmcnt(" #n ")" ::: "memory")
#define PG8_BAR __builtin_amdgcn_s_barrier()
#define PG8_SCHED __builtin_amdgcn_sched_barrier(0)
    Unit cur, nxt; int ui = 0;
    if (!S.next(0, cur)) return;
    f32x4 acc[2][2][4][2];
    { const float z0 = ozero();
#pragma unroll
    for (int a = 0; a < 2; ++a)
#pragma unroll
        for (int b = 0; b < 2; ++b)
#pragma unroll
            for (int m = 0; m < 4; ++m)
#pragma unroll
                for (int n = 0; n < 2; ++n) acc[a][b][m][n] = (f32x4){z0, z0, z0, z0}; }
    bf16x8 At[4][2], B0[2][2], B1[2][2];
    const char* cA = cur.pa; const char* cB = cur.pb;
    PG8_STAGE(PG8_SB(0, 0), cB, voffB); PG8_STAGE(PG8_SB(0, 1), cB + hstepB, voffB); PG8_STAGE(PG8_SA(0, 0), cA, voffA); PG8_STAGE(PG8_SA(0, 1), cA + hstepA, voffA);
    if (wr == 1) PG8_BAR;
    PG8_WAIT_V(2); PG8_BAR;
    PG8_STAGE(PG8_SB(1, 0), cB + kstep, voffB); PG8_STAGE(PG8_SA(1, 0), cA + kstep, voffA); PG8_STAGE(PG8_SB(1, 1), cB + hstepB + kstep, voffB);
    PG8_WAIT_V(6); PG8_BAR;
    for (;;) {
        const bool has_next = S.next(ui + 1, nxt);
        const char* nA = has_next ? nxt.pa : cA; const char* nB = has_next ? nxt.pb : cB;
#pragma unroll 1
        for (int t = 0; t < nt; t += 2) {
            const bool last = (t == nt - 2);
            const char* a1 = cA + (size_t)(t + 1) * kstep + (t + 1 >= Sched::AJT ? S.ajump : (size_t)0);
            const char* a2 = last ? nA : cA + (size_t)(t + 2) * kstep + (t + 2 >= Sched::AJT ? S.ajump : (size_t)0); const char* b2 = last ? nB : cB + (size_t)(t + 2) * kstep;
            const char* a3 = a2 + kstep; const char* b3 = b2 + kstep;
            PG8_LDB(B0, 0, 0); PG8_LDB(B1, 0, 1); PG8_SCHED; PG8_LDA(At, 0, 0); PG8_STAGE(PG8_SA(1, 1), a1 + hstepA, voffA);
            PG8_WAIT_V(8); PG8_WAIT_L(0); PG8_BAR; PG8_MMA(0, 0, At, B0); PG8_MMA(0, 1, At, B1); PG8_BAR; PG8_SCHED;
            PG8_LDA(At, 0, 1); PG8_STAGE(PG8_SB(0, 0), b2, voffB); PG8_STAGE(PG8_SB(0, 1), b2 + hstepB, voffB); PG8_STAGE(PG8_SA(0, 0), a2, voffA);
            PG8_WAIT_V(8); PG8_WAIT_L(0); PG8_BAR; PG8_MMA(1, 0, At, B0); PG8_MMA(1, 1, At, B1); PG8_BAR; PG8_SCHED;
            PG8_LDB(B0, 1, 0); PG8_LDB(B1, 1, 1); PG8_SCHED; PG8_LDA(At, 1, 0); PG8_STAGE(PG8_SA(0, 1), a2 + hstepA, voffA);
            PG8_WAIT_V(8); PG8_WAIT_L(0); PG8_BAR; PG8_MMA(0, 0, At, B0); PG8_MMA(0, 1, At, B1); PG8_BAR; PG8_SCHED;
            PG8_LDA(At, 1, 1); PG8_STAGE(PG8_SB(1, 0), b3, voffB); PG8_STAGE(PG8_SB(1, 1), b3 + hstepB, voffB); PG8_STAGE(PG8_SA(1, 0), a3, voffA);
            PG8_WAIT_V(8); PG8_WAIT_L(0); PG8_BAR; PG8_MMA(1, 0, At, B0); PG8_MMA(1, 1, At, B1); PG8_BAR; PG8_SCHED;
        }
        if (wr == 0) PG8_BAR;
        E(acc, cur, wr, wc, fr, fq, lds);
        if (!has_next) break;
        { const float z0 = ozero();
#pragma unroll
        for (int a = 0; a < 2; ++a)
#pragma unroll
            for (int b = 0; b < 2; ++b)
#pragma unroll
                for (int m = 0; m < 4; ++m)
#pragma unroll
                    for (int n = 0; n < 2; ++n) acc[a][b][m][n] = (f32x4){z0, z0, z0, z0}; }
        cur = nxt; cA = nA; cB = nB; ++ui;
        if (wr == 1) PG8_BAR;
    }
    PG8_WAIT_V(0);
    PG8_BAR;
#undef PG8_SA
#undef PG8_SB
#undef PG8_STAGE
#undef PG8_LDA
#undef PG8_LDB
#undef PG8_MMA
#undef PG8_WAIT_V
#undef PG8_WAIT_L
#undef PG8_BAR
#undef PG8_SCHED
}
}
using pg8::Unit;

DI void store8(bf16* p, const f32x4 v0, const f32x4 v1) {
    u32x4 w; w.x = pk2(v0[0], v0[1]); w.y = pk2(v0[2], v0[3]); w.z = pk2(v1[0], v1[1]); w.w = pk2(v1[2], v1[3]);
    *(u32x4*)p = w;
}
#define EPI_ARGS f32x4 (&acc)[2][2][4][2], const Unit& u, int wr, int wc, int fr, int fq, LAS unsigned char* lds

DI float rs_ps(const float* ps, int row) {
    const f32x4* p = (const f32x4*)(ps + (size_t)row * 16); const f32x4 a = p[0], b = p[1], c = p[2], d = p[3];
    const float s = ((a.x + a.y) + (a.z + a.w)) + ((b.x + b.y) + (b.z + b.w)) + (((c.x + c.y) + (c.z + c.w)) + ((d.x + d.y) + (d.z + d.w)));
    return 1.0f / sqrtf(s * (1.0f / D) + EPS);
}
template <int ACT> struct EpiRowScale {
    static constexpr bool PERM = true;
    bf16* O; int ldc; const float* rs; const float* ps;
    DI void operator()(EPI_ARGS) const {
        const int row0 = u.pm * 256 + wr * 64 + fr, col0 = u.pn * 256 + wc * 32 + 8 * fq;
#pragma unroll
        for (int ai = 0; ai < 2; ++ai)
#pragma unroll
            for (int m = 0; m < 4; ++m) {
                const int row = row0 + ai * 128 + m * 16; const float s = ps ? rs_ps(ps, row) : (rs ? rs[row] : 1.0f);
                bf16* rowp = O + (size_t)row * ldc + col0;
#pragma unroll
                for (int bj = 0; bj < 2; ++bj) { f32x4 v0 = acc[ai][bj][m][0] * s, v1 = acc[ai][bj][m][1] * s;
                    if (ACT == 2) {
#pragma unroll
                        for (int j = 0; j < 4; ++j) { float a = fmaxf(v0[j], 0.f), b = fmaxf(v1[j], 0.f); v0[j] = a * a; v1[j] = b * b; } }
                    store8(rowp + bj * 128, v0, v1); }
            }
    }
};
struct EpiInProj {
    static constexpr bool PERM = true;
    bf16* GLU; bf16* QK; const float* rs;
    DI void operator()(EPI_ARGS) const {
        const int row0 = u.pm * 256 + wr * 64 + fr;
        if (u.pn < 4) {
            const int col0 = u.pn * 128 + wc * 32 + 8 * fq;
#pragma unroll
            for (int ai = 0; ai < 2; ++ai)
#pragma unroll
                for (int m = 0; m < 4; ++m) {
                    const int row = row0 + ai * 128 + m * 16; const float s = rs[row];
                    f32x4 o0, o1;
#pragma unroll
                    for (int j = 0; j < 4; ++j) { o0[j] = acc[ai][0][m][0][j] * s * sigmoidf_(acc[ai][1][m][0][j] * s); o1[j] = acc[ai][0][m][1][j] * s * sigmoidf_(acc[ai][1][m][1][j] * s); }
                    store8(GLU + (size_t)row * 512 + col0, o0, o1);
                }
        } else {
            const int col0 = (u.pn - 4) * 256 + wc * 32 + 8 * fq;
#pragma unroll
            for (int ai = 0; ai < 2; ++ai)
#pragma unroll
                for (int m = 0; m < 4; ++m) {
                    const int row = row0 + ai * 128 + m * 16; const float s = rs[row];
#pragma unroll
                    for (int bj = 0; bj < 2; ++bj) store8(QK + (size_t)row * 1024 + col0 + bj * 128, acc[ai][bj][m][0] * s, acc[ai][bj][m][1] * s);
                }
        }
    }
};
struct EpiVT {
    static constexpr bool PERM = true;
    bf16* O; const float* cs;
    DI void operator()(EPI_ARGS) const {
        const int row0 = u.pm * 256 + wr * 64 + fr, col0 = u.pn * 256 + wc * 32 + 8 * fq;
        f32x4 c[2][2];
#pragma unroll
        for (int bj = 0; bj < 2; ++bj) { c[bj][0] = *(const f32x4*)(cs + col0 + bj * 128); c[bj][1] = *(const f32x4*)(cs + col0 + bj * 128 + 4); }
#pragma unroll
        for (int ai = 0; ai < 2; ++ai)
#pragma unroll
            for (int m = 0; m < 4; ++m) {
                const int row = row0 + ai * 128 + m * 16;
#pragma unroll
                for (int bj = 0; bj < 2; ++bj) { const int t = col0 + bj * 128;
                    store8(O + ((size_t)(((t >> 11) * 4 + (row >> 7)) * 32 + ((t >> 6) & 31)) * 128 + (row & 127)) * 64 + (t & 63), acc[ai][bj][m][0] * c[bj][0], acc[ai][bj][m][1] * c[bj][1]); }
            }
    }
};
struct EpiPre {
    static constexpr bool PERM = true;
    bf16* base0;
    DI void operator()(EPI_ARGS) const {
        bf16* O = base0 + (size_t)((u.z >> 30) & 1) * (52u << 20) + (size_t)(u.z & 0x3fffffff);
        const int row0 = wr * 64 + fr, col0 = wc * 32 + 8 * fq;
#pragma unroll
        for (int ai = 0; ai < 2; ++ai)
#pragma unroll
            for (int m = 0; m < 4; ++m) {
                const int row = row0 + ai * 128 + m * 16;
#pragma unroll
                for (int bj = 0; bj < 2; ++bj) store8(O + (size_t)row * 1024 + col0 + bj * 128, acc[ai][bj][m][0], acc[ai][bj][m][1]);
            }
    }
};
struct EpiResid {
    static constexpr bool PERM = true;
    const float* xres; const bf16* hres; bf16* out; float* ps;
    DI void operator()(EPI_ARGS) const {
        const int row0 = u.pm * 256 + wr * 64 + fr, col0 = u.pn * 256 + wc * 32 + 8 * fq;
#pragma unroll
        for (int ai = 0; ai < 2; ++ai)
#pragma unroll
            for (int m = 0; m < 4; ++m) {
                const int row = row0 + ai * 128 + m * 16; const size_t off = (size_t)row * D + col0; float ss = 0.f;
#pragma unroll
                for (int bj = 0; bj < 2; ++bj) {
                    f32x4 r0, r1;
                    if (xres) { r0 = *(const f32x4*)(xres + off + bj * 128); r1 = *(const f32x4*)(xres + off + bj * 128 + 4); }
                    else { const u32x4 hw = *(const u32x4*)(hres + off + bj * 128); r0 = (f32x4){bflo(hw.x), bfhi(hw.x), bflo(hw.y), bfhi(hw.y)}; r1 = (f32x4){bflo(hw.z), bfhi(hw.z), bflo(hw.w), bfhi(hw.w)}; }
                    r0 = r0 + acc[ai][bj][m][0]; r1 = r1 + acc[ai][bj][m][1];
                    u32x4 w; w.x = pk2(r0[0], r0[1]); w.y = pk2(r0[2], r0[3]); w.z = pk2(r1[0], r1[1]); w.w = pk2(r1[2], r1[3]);
                    *(u32x4*)(out + off + bj * 128) = w;
                    if (ps) {
#pragma unroll
                        for (int q = 0; q < 4; ++q) { const float a = bflo(w[q]), b = bfhi(w[q]); ss += a * a + b * b; }
                    }
                }
                if (ps) { ss += swz_xor<16>(ss); ss = half_sum(ss); if (fq == 0) ps[(size_t)row * 16 + u.pn * 4 + wc] = ss; }
            }
    }
};
struct EpiGateComb {
    static constexpr bool PERM = true;
    const bf16 *YF, *YB, *V; const float *BON, *lng, *lnb; bf16* O;
    DI void operator()(EPI_ARGS) const {
        const int head = u.pn * 4 + wc, ch0 = u.pn * 256 + 64 * wc + 8 * fq, row0 = u.pm * 256 + wr * 64 + fr;
        f32x4 lg[2][2], lb[2][2];
#pragma unroll
        for (int bj = 0; bj < 2; ++bj)
#pragma unroll
            for (int n = 0; n < 2; ++n) { lg[bj][n] = *(const f32x4*)(lng + ch0 + 32 * bj + 4 * n); lb[bj][n] = *(const f32x4*)(lnb + ch0 + 32 * bj + 4 * n); }
#pragma unroll
        for (int ai = 0; ai < 2; ++ai)
#pragma unroll
            for (int m = 0; m < 4; ++m) {
                const int row = row0 + ai * 128 + m * 16; const size_t off = (size_t)row * D + ch0;
                u32x4 a[2], b[2], vv[2];
#pragma unroll
                for (int bj = 0; bj < 2; ++bj) { a[bj] = *(const u32x4*)(YF + off + 32 * bj); b[bj] = *(const u32x4*)(YB + off + 32 * bj); vv[bj] = *(const u32x4*)(V + off + 32 * bj); }
                const float bon = BON[(size_t)row * 16 + head] + BON[(size_t)(M + row) * 16 + head];
                float y[16]; float s = 0.f;
#pragma unroll
                for (int bj = 0; bj < 2; ++bj)
#pragma unroll
                    for (int w = 0; w < 4; ++w) { y[bj * 8 + 2 * w] = bflo(a[bj][w]) + bflo(b[bj][w]); y[bj * 8 + 2 * w + 1] = bfhi(a[bj][w]) + bfhi(b[bj][w]); }
#pragma unroll
                for (int j = 0; j < 16; ++j) s += y[j];
                s += swz_xor<16>(s); s = half_sum(s);
                const float mean = s * (1.0f / 64.0f); float q2 = 0.f;
#pragma unroll
                for (int j = 0; j < 16; ++j) { y[j] -= mean; q2 += y[j] * y[j]; }
                q2 += swz_xor<16>(q2); q2 = half_sum(q2);
                const float rstd = 1.0f / sqrtf(q2 * (1.0f / 64.0f) + 64e-5f);
#pragma unroll
                for (int bj = 0; bj < 2; ++bj) {
                    f32x4 o0, o1;
#pragma unroll
                    for (int j = 0; j < 4; ++j) {
                        const float v0 = (j & 1) ? bfhi(vv[bj][j >> 1]) : bflo(vv[bj][j >> 1]), v1 = (j & 1) ? bfhi(vv[bj][2 + (j >> 1)]) : bflo(vv[bj][2 + (j >> 1)]);
                        o0[j] = (y[bj * 8 + j] * rstd * lg[bj][0][j] + lb[bj][0][j] + bon * v0) * acc[ai][bj][m][0][j];
                        o1[j] = (y[bj * 8 + 4 + j] * rstd * lg[bj][1][j] + lb[bj][1][j] + bon * v1) * acc[ai][bj][m][1][j];
                    }
                    store8(O + off + 32 * bj, o0, o1);
                }
            }
    }
};
struct EpiSoftmax {
    static constexpr bool PERM = true;
    bf16* P; const float* ps;
    DI void operator()(EPI_ARGS) const {
        LAS f32x2* X = (LAS f32x2*)(lds + LDS_X);
        const int row0 = u.pm * 256, col0 = u.pn * 256 + wc * 32 + 8 * fq;
        float mw[2][4];
#pragma unroll
        for (int ai = 0; ai < 2; ++ai)
#pragma unroll
            for (int m = 0; m < 4; ++m) {
                const int rl = ai * 128 + wr * 64 + m * 16 + fr; const float s = rs_ps(ps, row0 + rl) * LOG2E;
                float mx = -3.0e38f;
#pragma unroll
                for (int bj = 0; bj < 2; ++bj)
#pragma unroll
                    for (int n = 0; n < 2; ++n) { acc[ai][bj][m][n] = acc[ai][bj][m][n] * s;
#pragma unroll
                        for (int j = 0; j < 4; ++j) mx = fmaxf(mx, acc[ai][bj][m][n][j]); }
                mx = fmaxf(mx, swz_xor<16>(mx)); mx = half_max(mx);
                float sum = 0.f;
#pragma unroll
                for (int bj = 0; bj < 2; ++bj)
#pragma unroll
                    for (int n = 0; n < 2; ++n)
#pragma unroll
                        for (int j = 0; j < 4; ++j) { const float p = fexp2(acc[ai][bj][m][n][j] - mx); acc[ai][bj][m][n][j] = p; sum += p; }
                sum += swz_xor<16>(sum); sum = half_sum(sum);
                mw[ai][m] = mx;
                if (fq == 0) X[rl * 4 + wc] = (f32x2){mx, sum};
            }
        asm volatile("s_waitcnt lgkmcnt(0)" ::: "memory"); __builtin_amdgcn_s_barrier(); asm volatile("" ::: "memory");
#pragma unroll
        for (int ai = 0; ai < 2; ++ai)
#pragma unroll
            for (int m = 0; m < 4; ++m) {
                const int rl = ai * 128 + wr * 64 + m * 16 + fr;
                const f32x2 a = X[rl * 4 + 0], b = X[rl * 4 + 1], c = X[rl * 4 + 2], d = X[rl * 4 + 3];
                const float mt = fmaxf(fmaxf(a.x, b.x), fmaxf(c.x, d.x));
                const float lt = a.y * fexp2(a.x - mt) + b.y * fexp2(b.x - mt) + c.y * fexp2(c.x - mt) + d.y * fexp2(d.x - mt);
                const float f = fexp2(mw[ai][m] - mt) / lt;
                bf16* rowp = P + (size_t)(row0 + rl) * 1024 + col0;
#pragma unroll
                for (int bj = 0; bj < 2; ++bj) store8(rowp + bj * 128, acc[ai][bj][m][0] * f, acc[ai][bj][m][1] * f);
            }
        asm volatile("s_waitcnt lgkmcnt(0)" ::: "memory"); __builtin_amdgcn_s_barrier(); asm volatile("" ::: "memory");
    }
};
struct EpiRwkv {
    static constexpr bool PERM = true;
    bf16* R; bf16* Kk; bf16* V; bf16* HD1; bf16* HD2;
    DI void operator()(EPI_ARGS) const {
        const int row0 = u.pm * 256 + wr * 64 + fr; const int g = u.pn >> 2;
        bf16* O; int ldc, colt, mode0 = 0, mode1 = 0;
        if (u.pn < 12) { O = R + (size_t)g * (32u << 20); ldc = 1024; colt = (u.pn & 3) * 256; }
        else if (u.pn == 12) { O = HD1; ldc = 256; colt = 0; mode0 = 1; }
        else { O = HD2; ldc = 256; colt = 0; mode0 = 2; mode1 = 2; }
        const int col0 = colt + wc * 32 + 8 * fq;
#pragma unroll
        for (int ai = 0; ai < 2; ++ai)
#pragma unroll
            for (int m = 0; m < 4; ++m) {
                bf16* rowp = O + (size_t)(row0 + ai * 128 + m * 16) * ldc + col0;
#pragma unroll
                for (int bj = 0; bj < 2; ++bj) { f32x4 v0 = acc[ai][bj][m][0], v1 = acc[ai][bj][m][1]; const int md = bj ? mode1 : mode0;
                    if (md == 1) {
#pragma unroll
                        for (int j = 0; j < 4; ++j) { v0[j] = tanhf_(v0[j]); v1[j] = tanhf_(v1[j]); } }
                    else if (md == 2) {
#pragma unroll
                        for (int j = 0; j < 4; ++j) { v0[j] = sigmoidf_(v0[j]); v1[j] = sigmoidf_(v1[j]); } }
                    store8(rowp + bj * 128, v0, v1); }
            }
    }
};

enum InIdx { I_X = 0, I_MEM, I_REL, I_NMIX, I_NXATTN, I_NMEM, I_NFFN, I_NFINAL, I_WIN, I_WOUT, I_CONVW, I_CONVB, I_CLNG, I_CLNB, I_LQ1, I_LK1, I_LQ2, I_LK2, I_SUBLN,
             I_MU, I_WR, I_WK, I_WV, I_WO, I_W0, I_W1, I_W2, I_A0, I_A1, I_A2, I_G1, I_G2, I_KK, I_KA, I_RK, I_LNG, I_LNB, I_XQ, I_XKV, I_XO, I_UP, I_DN, N_IN };
struct Args { const float* in[N_IN]; float* out; unsigned char* ws; int ph_lo, ph_hi; };
static_assert(sizeof(Args) == (N_IN + 2) * 8 + 8, "Args has no padding");

struct Frame {
    LAS unsigned char* lds;
    int tid, lane, wave, gw, ngw;
    unsigned char* ws;
};

DI Frame fresh(const Frame& F0) {
    Frame F = F0; F.tid = opaque(threadIdx.x); F.lane = F.tid & 63; F.wave = __builtin_amdgcn_readfirstlane(F.tid >> 6); F.gw = opq(blockIdx.x) * 8 + F.wave; F.ngw = opq(gridDim.x) * 8; return F;
}
struct TJob { const float* W; int K, N; bf16* WT; int ldt, row_off, col_off, perm; const float* gain; const float* gsub; };
DI void tr_item(const TJob& J, LAS float* scr, int item, int lane) {
    const int nblk = J.N / 32, kb = item / nblk, nb = item % nblk, k0 = 64 * kb, n0 = 32 * nb;
    float scale = 1.0f; int drow = J.row_off + n0;
    if (J.perm) {
        if (n0 < 512) drow = 256 * (n0 >> 7) + (n0 & 127);
        else if (n0 < 1024) drow = 256 * ((n0 - 512) >> 7) + 128 + ((n0 - 512) & 127);
        else drow = n0;
        if (n0 >= 1024 && n0 < 1536) scale = 0.125f * LOG2E;
    }
    float tv[32];
    const float* wp = J.W + (size_t)(k0 + (lane >> 5)) * J.N + n0 + (lane & 31);
#pragma unroll
    for (int i = 0; i < 32; ++i) tv[i] = wp[(size_t)(2 * i) * J.N];
    if (J.gain) {
#pragma unroll
        for (int i = 0; i < 32; ++i) tv[i] *= J.gain[k0 + 2 * i + (lane >> 5)] - (J.gsub ? J.gsub[k0 + 2 * i + (lane >> 5)] : 0.0f);
    }
#pragma unroll
    for (int i = 0; i < 32; ++i) scr[(2 * i + (lane >> 5)) * 33 + (lane & 31)] = tv[i] * scale;
    asm volatile("s_waitcnt lgkmcnt(0)" ::: "memory");
    const int c = lane & 7;
#pragma unroll
    for (int j = 0; j < 4; ++j) { const int n = (lane >> 3) + 8 * j; const LAS float* s = scr + (8 * c) * 33 + n;
        u32x4 o; o.x = pk2(s[0 * 33], s[1 * 33]); o.y = pk2(s[2 * 33], s[3 * 33]); o.z = pk2(s[4 * 33], s[5 * 33]); o.w = pk2(s[6 * 33], s[7 * 33]);
        *(u32x4*)(J.WT + (size_t)(drow + n) * J.ldt + J.col_off + k0 + 8 * c) = o; }
    asm volatile("s_waitcnt lgkmcnt(0)" ::: "memory");
}
DI void tr_item64(const TJob& J, LAS float* scr, int item, int lane) {
    const int nblk = J.N / 64, kb = item / nblk, nb = item % nblk, k0 = 64 * kb, n0 = 64 * nb;
    float scale = 1.0f; int drow = J.row_off + n0;
    if (J.perm) {
        if (n0 < 512) drow = 256 * (n0 >> 7) + (n0 & 127);
        else if (n0 < 1024) drow = 256 * ((n0 - 512) >> 7) + 128 + ((n0 - 512) & 127);
        else drow = n0;
        if (n0 >= 1024 && n0 < 1536) scale = 0.125f * LOG2E;
    }
    f32x4 tv[16];
    const float* wp = J.W + (size_t)(k0 + (lane >> 4)) * J.N + n0 + 4 * (lane & 15);
#pragma unroll
    for (int i = 0; i < 16; ++i) tv[i] = __builtin_nontemporal_load((const f32x4*)(wp + (size_t)(4 * i) * J.N));
#pragma unroll
    for (int i = 0; i < 16; ++i) { const int kk = 4 * i + (lane >> 4); const float g = (J.gain ? J.gain[k0 + kk] - (J.gsub ? J.gsub[k0 + kk] : 0.0f) : 1.0f) * scale;
        LAS float* d = scr + kk * 65 + 4 * (lane & 15); d[0] = tv[i].x * g; d[1] = tv[i].y * g; d[2] = tv[i].z * g; d[3] = tv[i].w * g; }
    asm volatile("s_waitcnt lgkmcnt(0)" ::: "memory");
    const int c = lane & 7;
#pragma unroll
    for (int j = 0; j < 8; ++j) { const int n = (lane >> 3) + 8 * j; const LAS float* sp = scr + (8 * c) * 65 + n;
        u32x4 o; o.x = pk2(sp[0 * 65], sp[1 * 65]); o.y = pk2(sp[2 * 65], sp[3 * 65]); o.z = pk2(sp[4 * 65], sp[5 * 65]); o.w = pk2(sp[6 * 65], sp[7 * 65]);
        *(u32x4*)(J.WT + (size_t)(drow + n) * J.ldt + J.col_off + k0 + 8 * c) = o; }
    asm volatile("s_waitcnt lgkmcnt(0)" ::: "memory");
}
constexpr int N_TJOBS = 31;
DI TJob get_tjob(int j, const Args& a, unsigned char* ws) {
    TJob J; J.perm = 0; J.gain = nullptr; J.gsub = nullptr; J.row_off = 0; J.col_off = 0;
    if (j == 0) { J.W = a.in[opq(I_WIN)]; J.K = 1024; J.N = 2560; J.WT = (bf16*)(ws + WS_WIN); J.ldt = 1024; J.perm = 1; J.gain = a.in[opq(I_NMIX)]; }
    else if (j == 1) { J.W = a.in[opq(I_WOUT)]; J.K = 1024; J.N = 1024; J.WT = (bf16*)(ws + WS_WOUT); J.ldt = 1024; }
    else if (j < 4) { const int i = j - 2; J.W = a.in[opq(I_XKV)] + (size_t)i * 1024 * 2048; J.K = 1024; J.N = 2048; J.WT = (bf16*)(ws + WS_WKV) + (size_t)i * 2048 * 1024; J.ldt = 1024; J.gain = a.in[opq(I_NMEM)] + i * 1024; }
    else if (j < 6) { const int i = j - 4; J.W = a.in[opq(I_XO)] + (size_t)i * 1024 * 1024; J.K = 1024; J.N = 1024; J.WT = (bf16*)(ws + WS_WXO) + (size_t)i * 1024 * 1024; J.ldt = 1024; }
    else if (j < 8) { const int i = j - 6; J.W = a.in[opq(I_UP)] + (size_t)i * 1024 * 4096; J.K = 1024; J.N = 4096; J.WT = (bf16*)(ws + WS_WUP) + (size_t)i * 4096 * 1024; J.ldt = 1024; J.gain = a.in[opq(I_NFFN)] + i * 1024; }
    else if (j < 10) { const int i = j - 8; J.W = a.in[opq(I_DN)] + (size_t)i * 4096 * 1024; J.K = 4096; J.N = 1024; J.WT = (bf16*)(ws + WS_WDN) + (size_t)i * 1024 * 4096; J.ldt = 4096; }
    else if (j < 26) {
        const int q = j - 10, src = q >> 1, copy = q & 1; int mu = 0;
        J.K = 1024;
        if (src < 3) { J.WT = (bf16*)(ws + WS_WBIG); J.ldt = 1024; J.row_off = src * 1024; J.N = copy ? 0 : 1024; J.W = a.in[opq(src == 0 ? I_WR : src == 1 ? I_WK : I_WV)]; }
        else {
            J.WT = (bf16*)(ws + WS_WLORA); J.ldt = 2048; J.col_off = copy * 1024;
            if (src == 3) { J.W = a.in[opq(I_W1)]; J.N = 64; J.row_off = 0; mu = 1; }
            else if (src == 4) { J.W = a.in[opq(I_W1)] + 1024 * 64; J.N = 64; J.row_off = 64; mu = 1; }
            else if (src == 5) { J.W = a.in[opq(I_A1)]; J.N = 64; J.row_off = 128; mu = 4; }
            else if (src == 6) { J.W = a.in[opq(I_A1)] + 1024 * 64; J.N = 64; J.row_off = 192; mu = 4; }
            else { J.W = a.in[opq(I_G1)]; J.N = 160; J.row_off = 256; mu = 5; }
            if (copy) { J.gain = a.in[opq(I_MU)] + mu * 1024; J.gsub = a.in[opq(I_MU)]; }
        }
    }
    else if (j < 30) { const int q = j - 26; J.W = (q < 2 ? a.in[opq(I_W2)] : a.in[opq(I_A2)]) + (size_t)(q & 1) * 64 * 1024; J.K = 64; J.N = 1024; J.WT = (bf16*)(ws + WS_W2T) + (size_t)q * 1024 * 64; J.ldt = 64; }
    else { J.W = a.in[opq(I_WO)]; J.K = 1024; J.N = 1024; J.WT = (bf16*)(ws + WS_WRO); J.ldt = 1024; }
    return J;
}
DI void row_to_bf16_rs(const float* xrow, bf16* orow, float* rs, int lane) {
    const f32x4* xr = (const f32x4*)xrow + lane;
    f32x4 v[4]; float s = 0.f;
#pragma unroll
    for (int j = 0; j < 4; ++j) { v[j] = xr[64 * j]; s += (v[j].x * v[j].x + v[j].y * v[j].y) + (v[j].z * v[j].z + v[j].w * v[j].w); }
    s = wave_sum(s);
    u32x2* o8 = (u32x2*)orow + lane;
#pragma unroll
    for (int j = 0; j < 4; ++j) { u32x2 w; w.x = pk2(v[j].x, v[j].y); w.y = pk2(v[j].z, v[j].w); o8[64 * j] = w; }
    if (lane == 0) *rs = 1.0f / sqrtf(s * (1.0f / D) + EPS);
}
DI void rows4_to_bf16_rs(const Frame& F, const float* X, bf16* O, float* rs, int nrows) {
    for (int m0 = F.gw * 4; m0 < nrows; m0 += F.ngw * 4) {
        f32x4 v[4][4];
#pragma unroll
        for (int r = 0; r < 4; ++r)
#pragma unroll
            for (int j = 0; j < 4; ++j) v[r][j] = __builtin_nontemporal_load((const f32x4*)(X + (size_t)(m0 + r) * D) + F.lane + 64 * j);
#pragma unroll
        for (int r = 0; r < 4; ++r) {
            float s = 0.f;
#pragma unroll
            for (int j = 0; j < 4; ++j) s += (v[r][j].x * v[r][j].x + v[r][j].y * v[r][j].y) + (v[r][j].z * v[r][j].z + v[r][j].w * v[r][j].w);
            s = wave_sum(s);
            u32x2* o8 = (u32x2*)(O + (size_t)(m0 + r) * D) + F.lane;
#pragma unroll
            for (int j = 0; j < 4; ++j) { u32x2 w; w.x = pk2(v[r][j].x, v[r][j].y); w.y = pk2(v[r][j].z, v[r][j].w); o8[64 * j] = w; }
            if (F.lane == 0) rs[m0 + r] = 1.0f / sqrtf(s * (1.0f / D) + EPS);
        }
    }
}
DI int t5_bucket(int rel) {
    const int n = rel < 0 ? -rel : rel; int r = rel > 0 ? 16 : 0;
    if (n < 8) return r + n;
    int lg = 8; lg += (n >= 12); lg += (n >= 16); lg += (n >= 23); lg += (n >= 32); lg += (n >= 46); lg += (n >= 64); lg += (n >= 91);
    return r + lg;
}
DI void phase_prologue(const Frame& F0, const Args& a, unsigned char* ws) {
    const Frame F = fresh(F0);
    LAS float* scr = (LAS float*)(F.lds + F.wave * 17408);
    {
        int total = 0;
        for (int j = 0; j < N_TJOBS; ++j) { const TJob J = get_tjob(j, a, ws); total += (J.N & 63) == 0 ? (J.K / 64) * (J.N / 64) : (J.K / 64) * (J.N / 32); }
        for (int g = F.gw; g < total; g += F.ngw) {
            int r = g;
            for (int j = 0; j < N_TJOBS; ++j) {
                const TJob J = get_tjob(j, a, ws); const bool wide = (J.N & 63) == 0; const int cnt = wide ? (J.K / 64) * (J.N / 64) : (J.K / 64) * (J.N / 32);
                if (r < cnt) { if (wide) tr_item64(J, scr, r, F.lane); else tr_item(J, scr, r, F.lane); break; }
                r -= cnt;
            }
        }
    }
    const int gt = F.gw * 64 + F.lane, ngt = F.ngw * 64;
    for (int i = 0; i < 2; ++i) {
        const float* W = a.in[opq(I_XQ)] + (size_t)i * 1024 * 1024; const float* g = a.in[opq(I_NXATTN)] + i * 1024; bf16* O = (bf16*)(ws + WS_WQN) + (size_t)i * 1024 * 1024;
        for (int e = gt; e < 1024 * 1024 / 4; e += ngt) { const f32x4 v = ((const f32x4*)W)[e]; const float s = g[(e * 4) >> 10] * 0.0625f; u32x2 w; w.x = pk2(v.x * s, v.y * s); w.y = pk2(v.z * s, v.w * s); ((u32x2*)O)[e] = w; }
    }
    { const float* W = a.in[opq(I_G2)]; bf16* O = (bf16*)(ws + WS_G2T);
      for (int e = gt; e < 1024 * 256; e += ngt) { const int rown = e >> 8, k = e & 255, cc = rown & 255;
        const int n = (rown & ~255) + 64 * ((cc >> 5) & 3) + 32 * (cc >> 7) + (cc & 31);
        O[e] = (bf16)(k < 160 ? f2bf(W[(size_t)k * 1024 + n]) : 0u); } }
    { u32x4* O = (u32x4*)((bf16*)(ws + WS_WLORA) + (size_t)416 * 2048);
      const unsigned zq = (unsigned)opaque(0);
      for (int e = gt; e < 96 * 2048 * 2 / 16; e += ngt) O[e] = (u32x4){zq, zq, zq, zq}; }
    rows4_to_bf16_rs(F, a.in[opq(I_X)], (bf16*)(ws + WS_SA), (float*)(ws + WS_RS), M);
    rows4_to_bf16_rs(F, a.in[opq(I_MEM)], (bf16*)(ws + WS_MEMB), (float*)(ws + WS_RSMEM), MMEM);
    { float* B = (float*)(ws + WS_BIAS); const float* tab = a.in[opq(I_REL)];
      for (int e = gt; e < 4 * 4096; e += ngt) { const int h = e >> 12, idx = e & 4095; const int rel = idx - 2047; B[e] = idx < 4095 ? tab[t5_bucket(rel) * 4 + h] * LOG2E : 0.f; } }
    if (F.gw == 0) {
        const float q1 = a.in[opq(I_LQ1)][F.lane] * a.in[opq(I_LK1)][F.lane], q2 = a.in[opq(I_LQ2)][F.lane] * a.in[opq(I_LK2)][F.lane];
        const float s1 = wave_sum(q1), s2 = wave_sum(q2);
        if (F.lane == 0) ((float*)(ws + WS_LAM))[0] = expf(s1) - expf(s2) + 0.2f;
    }
}

DI void phase_final_norm(const Frame& F0, const bf16* h, float* out, const float* g, const float osc) {
    const Frame F = fresh(F0);
    f32x4 gv[4];
#pragma unroll
    for (int j = 0; j < 4; ++j) gv[j] = ((const f32x4*)g)[F.lane + 64 * j];
    for (int m0 = F.gw * 4; m0 < M; m0 += F.ngw * 4) {
        u32x2 hw[4][4];
#pragma unroll
        for (int r = 0; r < 4; ++r)
#pragma unroll
            for (int j = 0; j < 4; ++j) hw[r][j] = ((const u32x2*)(h + (size_t)(m0 + r) * D))[F.lane + 64 * j];
#pragma unroll
        for (int r = 0; r < 4; ++r) {
            f32x4 v[4]; float s = 0.f;
#pragma unroll
            for (int j = 0; j < 4; ++j) { v[j] = (f32x4){bflo(hw[r][j].x), bfhi(hw[r][j].x), bflo(hw[r][j].y), bfhi(hw[r][j].y)}; s += (v[j].x * v[j].x + v[j].y * v[j].y) + (v[j].z * v[j].z + v[j].w * v[j].w); }
            const float rr = osc / sqrtf(wave_sum(s) * (1.0f / D) + EPS);
            f32x4* xr = (f32x4*)(out + (size_t)(m0 + r) * D) + F.lane;
#pragma unroll
            for (int j = 0; j < 4; ++j) xr[64 * j] = v[j] * rr * gv[j];
        }
    }
}
DI void phase_rwkv_shift(const Frame& F0, const bf16* h, const float* g, const float* mu, bf16* XR, bf16* XK, bf16* XV, bf16* HH) {
    const Frame F = fresh(F0);
    f32x4 gv[4], mr[4], mk[4], mv[4];
#pragma unroll
    for (int j = 0; j < 4; ++j) { gv[j] = ((const f32x4*)g)[F.lane + 64 * j]; mr[j] = ((const f32x4*)mu)[F.lane + 64 * j]; mk[j] = ((const f32x4*)(mu + 2048))[F.lane + 64 * j]; mv[j] = ((const f32x4*)(mu + 3072))[F.lane + 64 * j]; }
    for (int ch = F.gw; ch < M / 16; ch += F.ngw) {
        const int m0 = ch * 16, t0 = m0 & (T - 1);
        f32x4 p2[4], p1[4], cu[4];
#pragma unroll
        for (int j = 0; j < 4; ++j) { p2[j] = (f32x4){0.f, 0.f, 0.f, 0.f}; p1[j] = p2[j]; cu[j] = p2[j]; }
#pragma unroll 1
        for (int g6 = 0; g6 < 6; ++g6) {
            f32x4 ld[3][4];
#pragma unroll
            for (int r = 0; r < 3; ++r) { const int i = g6 * 3 + r - 1, t = t0 + i; const bool ok = (t >= 0 && t < T);
#pragma unroll
                for (int j = 0; j < 4; ++j) { const u32x2 w = ok ? ((const u32x2*)(h + (size_t)(m0 + i) * D))[F.lane + 64 * j] : (u32x2){0u, 0u}; ld[r][j] = (f32x4){bflo(w.x), bfhi(w.x), bflo(w.y), bfhi(w.y)}; } }
#pragma unroll
            for (int r = 0; r < 3; ++r) {
                const int i = g6 * 3 + r - 1;
                float s = 0.f;
#pragma unroll
                for (int j = 0; j < 4; ++j) { p2[j] = p1[j]; p1[j] = cu[j]; cu[j] = ld[r][j]; s += (cu[j].x * cu[j].x + cu[j].y * cu[j].y) + (cu[j].z * cu[j].z + cu[j].w * cu[j].w); }
                const float rr = 1.0f / sqrtf(wave_sum(s) * (1.0f / D) + EPS);
#pragma unroll
                for (int j = 0; j < 4; ++j) cu[j] = cu[j] * rr * gv[j];
                if (i >= 1) {
                    const size_t ro = (size_t)(m0 + i - 1) * 1024;
#pragma unroll
                    for (int j = 0; j < 4; ++j) { const f32x4 hh = (p2[j] + cu[j]) * 0.5f - p1[j];
                        const f32x4 xr = p1[j] + mr[j] * hh, xk = p1[j] + mk[j] * hh, xv = p1[j] + mv[j] * hh;
                        u32x2 w; w.x = pk2(xr.x, xr.y); w.y = pk2(xr.z, xr.w); __builtin_nontemporal_store(w, (u32x2*)(XR + ro) + F.lane + 64 * j);
                        w.x = pk2(xk.x, xk.y); w.y = pk2(xk.z, xk.w); __builtin_nontemporal_store(w, (u32x2*)(XK + ro) + F.lane + 64 * j);
                        w.x = pk2(xv.x, xv.y); w.y = pk2(xv.z, xv.w); __builtin_nontemporal_store(w, (u32x2*)(XV + ro) + F.lane + 64 * j);
                        w.x = pk2(hh.x, hh.y); w.y = pk2(hh.z, hh.w); __builtin_nontemporal_store(w, (u32x2*)(HH + ro) + F.lane + 64 * j); }
                }
            }
        }
    }
}
constexpr int CV_ROWB = 1040, CV_IN_BYTES = 94 * CV_ROWB, CV_W_OFF = CV_IN_BYTES;
DI void conv_load_weights(const Frame& F0, const float* cw) {
    const Frame F = fresh(F0);
    LAS bf16* W = (LAS bf16*)(F.lds + CV_W_OFF);
    for (int e = F.tid; e < 31 * 512; e += 512) W[e] = (bf16)f2bf(cw[e]);
}
DI void conv_unit(const Frame& F0, int unit, const bf16* GLU, const float* cb, const float* lg, const float* lb, bf16* MIX) {
    const Frame F = fresh(F0);
    const int b = unit >> 5, t0 = (unit & 31) * 64;
    __syncthreads();
    for (int p = F.tid; p < 94 * 64; p += 512) {
        const int r = p >> 6, c = p & 63, t = t0 - 15 + r;
        u32x4 v = (u32x4){0u, 0u, 0u, 0u};
        if (t >= 0 && t < T) v = *(const u32x4*)(GLU + (size_t)(b * T + t) * 512 + c * 8);
        *(LAS u32x4*)(F.lds + r * CV_ROWB + c * 16) = v;
    }
    __syncthreads();
    const int tl = F.tid >> 3, chunk = F.tid & 7;
    float y[64];
#pragma unroll
    for (int i = 0; i < 8; ++i) {
        const int cg = chunk + 8 * i;
        float acc[8];
#pragma unroll
        for (int e = 0; e < 8; ++e) acc[e] = cb[cg * 8 + e];
#pragma unroll 1
        for (int j = 0; j < 31; ++j) {
            const u32x4 x = *(const LAS u32x4*)(F.lds + (tl + j) * CV_ROWB + cg * 16);
            const u32x4 w = *(const LAS u32x4*)(F.lds + CV_W_OFF + j * 1024 + cg * 16);
#pragma unroll
            for (int q = 0; q < 4; ++q) { acc[2 * q] += bflo(x[q]) * bflo(w[q]); acc[2 * q + 1] += bfhi(x[q]) * bfhi(w[q]); }
        }
#pragma unroll
        for (int e = 0; e < 8; ++e) y[i * 8 + e] = acc[e];
    }
    float s = 0.f;
#pragma unroll
    for (int j = 0; j < 64; ++j) s += y[j];
    s += swz_xor<1>(s); s += swz_xor<2>(s); s += swz_xor<4>(s);
    const float mean = s * (1.0f / 512.0f); float q2 = 0.f;
#pragma unroll
    for (int j = 0; j < 64; ++j) { y[j] -= mean; q2 += y[j] * y[j]; }
    q2 += swz_xor<1>(q2); q2 += swz_xor<2>(q2); q2 += swz_xor<4>(q2);
    const float rstd = 1.0f / sqrtf(q2 * (1.0f / 512.0f) + 1e-5f);
    bf16* orow = MIX + (size_t)(b * T + t0 + tl) * 1024;
#pragma unroll
    for (int i = 0; i < 8; ++i) {
        const int c0 = (chunk + 8 * i) * 8;
        const f32x4 g0 = *(const f32x4*)(lg + c0), g1 = *(const f32x4*)(lg + c0 + 4), b0 = *(const f32x4*)(lb + c0), b1 = *(const f32x4*)(lb + c0 + 4);
        f32x4 o0, o1;
#pragma unroll
        for (int e = 0; e < 4; ++e) { const float v0 = y[i * 8 + e] * rstd * g0[e] + b0[e], v1 = y[i * 8 + 4 + e] * rstd * g1[e] + b1[e]; o0[e] = v0 * sigmoidf_(v0); o1[e] = v1 * sigmoidf_(v1); }
        store8(orow + c0, o0, o1);
    }
}

constexpr int DA_KROW = 272, DA_VROW = 144, DA_KB = 64 * DA_KROW, DA_VB = 128 * DA_VROW, DA_BUF = DA_KB + DA_VB;
DI int crow(int reg, int hf) { return (reg & 3) + 8 * (reg >> 2) + 4 * hf; }
DI void diffattn_unit(const Frame& F0, int unit, const bf16* QK, const bf16* VT, const float* BIAS, const float lam, const float* subg, bf16* MIX) {
    const Frame F = fresh(F0);
    const int b = unit >> 6, h = (unit >> 4) & 3, qb = unit & 15;
    const int c = F.wave >> 2, qs = F.wave & 3, r32 = F.lane & 31, hf = F.lane >> 5;
    const int q0w = qb * 128 + qs * 32;
    const float* bias_h = BIAS + h * 4096 + 2047;
    bf16x8 Qf[4];
    { const bf16* qp = QK + (size_t)(b * T + q0w + r32) * 1024 + h * 128 + c * 64 + 8 * hf;
#pragma unroll
      for (int ks = 0; ks < 4; ++ks) Qf[ks] = *(const bf16x8*)(qp + 16 * ks); }
    const bf16* kg[2]; const bf16* vg[2]; int kl[2], vl[2];
#pragma unroll
    for (int i = 0; i < 2; ++i) { const int p = F.tid + 512 * i;
        kg[i] = QK + (size_t)(b * T + (p >> 4)) * 1024 + 512 + h * 128 + (p & 15) * 8; kl[i] = (p >> 4) * DA_KROW + (p & 15) * 16;
        vg[i] = VT + (size_t)(b * 4 + h) * (32 * 8192) + p * 8; vl[i] = DA_KB + (p >> 3) * DA_VROW + ((p & 7) >> 1) * 32 + ((p & 7) & 1) * 8; }
    u32x4 kr[2], vr[2];
#pragma unroll
    for (int i = 0; i < 2; ++i) { kr[i] = *(const u32x4*)(kg[i]); vr[i] = *(const u32x4*)(vg[i]); }
    __syncthreads();
    LAS float* const btab = (LAS float*)(F.lds + 2 * DA_BUF);
    btab[F.tid] = bias_h[F.tid - 256];
#pragma unroll
    for (int i = 0; i < 2; ++i) { *(LAS u32x4*)(F.lds + kl[i]) = kr[i]; *(LAS u32x2*)(F.lds + vl[i]) = (u32x2){vr[i].x, vr[i].y}; *(LAS u32x2*)(F.lds + vl[i] + 16) = (u32x2){vr[i].z, vr[i].w}; }
#pragma unroll
    for (int i = 0; i < 2; ++i) { kr[i] = *(const u32x4*)(kg[i] + (size_t)64 * 1024); vr[i] = *(const u32x4*)(vg[i] + 8192); }
    __syncthreads();
    f32x16 O[4];
#pragma unroll
    for (int vt = 0; vt < 4; ++vt)
#pragma unroll
        for (int i = 0; i < 16; ++i) O[vt][i] = 0.f;
    float lsum = 0.f;
    const float cbR = bias_h[91], cbL = bias_h[-91];
    const int ka = r32 * DA_KROW + c * 128 + 16 * hf;
    const int va = DA_KB + r32 * DA_VROW + 16 * hf;
    for (int kt = 0; kt < 32; ++kt) {
        const int k0 = kt * 64;
        LAS unsigned char* buf = F.lds + (kt & 1) * DA_BUF;
        const int dmin = k0 - (q0w + 31), dmax = k0 + 63 - q0w;
        const bool far = (dmin >= 91) || (dmax <= -91);
        const float cb = dmin >= 91 ? cbR : cbL;
        bf16x8 kf[8];
#pragma unroll
        for (int f = 0; f < 8; ++f) kf[f] = *(const LAS bf16x8*)(buf + ka + (f >> 2) * 32 * DA_KROW + (f & 3) * 32);
        __builtin_amdgcn_sched_barrier(0);
        f32x16 S0, S1;
        if (far) {
#pragma unroll
            for (int i = 0; i < 16; ++i) { S0[i] = cb; S1[i] = cb; }
        } else { const LAS float* tb = btab + (k0 - (q0w + r32) + 256);
#pragma unroll
            for (int i = 0; i < 16; ++i) { S0[i] = tb[crow(i, hf)]; S1[i] = tb[32 + crow(i, hf)]; }
        }
        bf16x8 vf0[8];
#pragma unroll
        for (int f = 0; f < 8; ++f) vf0[f] = *(const LAS bf16x8*)(buf + va + (f & 3) * 32 * DA_VROW + (f >> 2) * 32);
#pragma unroll
        for (int ks = 0; ks < 4; ++ks) S0 = __builtin_amdgcn_mfma_f32_32x32x16_bf16(kf[ks], Qf[ks], S0, 0, 0, 0);
#pragma unroll
        for (int ks = 0; ks < 4; ++ks) S1 = __builtin_amdgcn_mfma_f32_32x32x16_bf16(kf[4 + ks], Qf[ks], S1, 0, 0, 0);
        __builtin_amdgcn_sched_barrier(0);
        bf16x8 pa0[2], pa1[2];
        {
#pragma unroll
            for (int s2 = 0; s2 < 2; ++s2) { u32x4 pw;
#pragma unroll
                for (int i = 0; i < 8; ++i) { S0[8 * s2 + i] = fexp2(S0[8 * s2 + i]); lsum += S0[8 * s2 + i]; }
                pw.x = pk2(S0[8 * s2], S0[8 * s2 + 1]); pw.y = pk2(S0[8 * s2 + 2], S0[8 * s2 + 3]); pw.z = pk2(S0[8 * s2 + 4], S0[8 * s2 + 5]); pw.w = pk2(S0[8 * s2 + 6], S0[8 * s2 + 7]);
                pa0[s2] = __builtin_bit_cast(bf16x8, pw); }
        }
        __builtin_amdgcn_sched_barrier(0);
        bf16x8 vf1[8];
#pragma unroll
        for (int f = 0; f < 8; ++f) vf1[f] = *(const LAS bf16x8*)(buf + va + (f & 3) * 32 * DA_VROW + (2 + (f >> 2)) * 32);
#pragma unroll
        for (int f = 0; f < 8; ++f) O[f & 3] = __builtin_amdgcn_mfma_f32_32x32x16_bf16(pa0[f >> 2], vf0[f], O[f & 3], 0, 0, 0);
        {
#pragma unroll
            for (int s2 = 0; s2 < 2; ++s2) { u32x4 pw;
#pragma unroll
                for (int i = 0; i < 8; ++i) { S1[8 * s2 + i] = fexp2(S1[8 * s2 + i]); lsum += S1[8 * s2 + i]; }
                pw.x = pk2(S1[8 * s2], S1[8 * s2 + 1]); pw.y = pk2(S1[8 * s2 + 2], S1[8 * s2 + 3]); pw.z = pk2(S1[8 * s2 + 4], S1[8 * s2 + 5]); pw.w = pk2(S1[8 * s2 + 6], S1[8 * s2 + 7]);
                pa1[s2] = __builtin_bit_cast(bf16x8, pw); }
        }
        __builtin_amdgcn_sched_barrier(0);
#pragma unroll
        for (int f = 0; f < 8; ++f) O[f & 3] = __builtin_amdgcn_mfma_f32_32x32x16_bf16(pa1[f >> 2], vf1[f], O[f & 3], 0, 0, 0);
        if (kt + 1 < 32) {
            LAS unsigned char* nb = F.lds + ((kt + 1) & 1) * DA_BUF;
#pragma unroll
            for (int i = 0; i < 2; ++i) { *(LAS u32x4*)(nb + kl[i]) = kr[i]; *(LAS u32x2*)(nb + vl[i]) = (u32x2){vr[i].x, vr[i].y}; *(LAS u32x2*)(nb + vl[i] + 16) = (u32x2){vr[i].z, vr[i].w}; }
        }
        if (kt + 2 < 32) {
#pragma unroll
            for (int i = 0; i < 2; ++i) { kr[i] = *(const u32x4*)(kg[i] + (size_t)(k0 + 128) * 1024); vr[i] = *(const u32x4*)(vg[i] + (kt + 2) * 8192); }
        }
        __syncthreads();
    }
    lsum = half_sum(lsum);
    LAS float* XO = (LAS float*)F.lds;
    LAS float* LW = (LAS float*)(F.lds + 65536) + F.wave * 32;
    if (hf == 0) LW[r32] = 1.0f / lsum;
    asm volatile("s_waitcnt lgkmcnt(0)" ::: "memory");
    float il[16];
#pragma unroll
    for (int i = 0; i < 16; ++i) il[i] = LW[crow(i, hf)];
    if (c == 1) {
#pragma unroll
        for (int vt = 0; vt < 4; ++vt)
#pragma unroll
            for (int i = 0; i < 16; ++i) XO[(qs * 32 + crow(i, hf)) * 128 + vt * 32 + r32] = O[vt][i] * il[i];
    }
    __syncthreads();
    if (c == 0) {
        float ss[16];
#pragma unroll
        for (int i = 0; i < 16; ++i) ss[i] = 0.f;
#pragma unroll
        for (int vt = 0; vt < 4; ++vt)
#pragma unroll
            for (int i = 0; i < 16; ++i) { const float o = O[vt][i] * il[i] - lam * XO[(qs * 32 + crow(i, hf)) * 128 + vt * 32 + r32]; O[vt][i] = o; ss[i] += o * o; }
#pragma unroll
        for (int i = 0; i < 16; ++i) { float v = ss[i]; v += swz_xor<1>(v); v += swz_xor<2>(v); v += swz_xor<4>(v); v += swz_xor<8>(v); v += swz_xor<16>(v); ss[i] = 0.8f / sqrtf(v * (1.0f / 128.0f) + EPS); }
#pragma unroll
        for (int vt = 0; vt < 4; ++vt) {
            const float g = subg[vt * 32 + r32];
#pragma unroll
            for (int i = 0; i < 16; ++i) MIX[(size_t)(b * T + q0w + crow(i, hf)) * 1024 + 512 + h * 128 + vt * 32 + r32] = (bf16)f2bf(O[vt][i] * ss[i] * g);
        }
    }
}

DI float dpp_x1(float v) { return __builtin_bit_cast(float, __builtin_amdgcn_update_dpp(0, __builtin_bit_cast(int, v), 0xB1, 0xF, 0xF, true)); }
DI float dpp_x2(float v) { return __builtin_bit_cast(float, __builtin_amdgcn_update_dpp(0, __builtin_bit_cast(int, v), 0x4E, 0xF, 0xF, true)); }
DI float quad_sum(float v) { v += dpp_x1(v); v += dpp_x2(v); return v; }
struct ScanPtrs { const bf16 *R, *K, *V, *HD1, *W2T; const float *w0, *a0, *kk, *ka, *rk; bf16 *YF, *YB; float* BON; unsigned* ERR; };
constexpr int CS_AT = 0, CS_RT = 2304, CS_BK = 4608, CS_SMQ = 9728, CS_SMT = 11008, CS_NQ = 12288, CS_VT = 13568, CS_GL = 16640, CS_BUF = 16896;
constexpr int CS_PZ = 6 * CS_BUF;
constexpr int CS_W = CS_PZ + 4 * 4608;
constexpr int CS_WSZ = 4864;
constexpr int CS_BON = CS_W + 8 * CS_WSZ;
constexpr int CS_NS = CS_BON + 1536;
static_assert(CS_NS + 2048 + 16 <= LDS_MISC, "chunked-scan LDS map");
template <int CTRL> DI float dpp_mov0(float v) { return __builtin_bit_cast(float, __builtin_amdgcn_update_dpp(0, __builtin_bit_cast(int, v), CTRL, 0xF, 0xF, false)); }
DI float row_prefix(float v) { v += dpp_mov0<0x111>(v); v += dpp_mov0<0x112>(v); v += dpp_mov0<0x114>(v); v += dpp_mov0<0x118>(v); return v; }
DI float row_suffix(float v) { v += dpp_mov0<0x101>(v); v += dpp_mov0<0x102>(v); v += dpp_mov0<0x104>(v); v += dpp_mov0<0x108>(v); return v; }
DI bf16x8 lds16(const LAS unsigned char* p) { return *(const LAS bf16x8*)p; }
DI f32x4 mfma16(bf16x8 a, bf16x8 b, f32x4 c) { return __builtin_amdgcn_mfma_f32_16x16x32_bf16(a, b, c, 0, 0, 0); }

DI void scan_pair_mfma(const Frame& F0, int bh, const ScanPtrs& P) {
    const Frame F = fresh(F0);
    const int b = bh >> 4, h = bh & 15;
    const int z = F.wave >> 2, q4 = F.wave & 3;
    const int l15 = F.lane & 15, l4 = F.lane >> 4;
    const int te = l15, cg = l4, c4 = cg * 4;
    const int rr = z ? 15 - te : te;
    const int jl = 16 * q4 + c4;
    const int chq = h * 64 + 16 * q4;
    LAS unsigned char* const L = F.lds;
    LAS unsigned char* const wsc = L + CS_W + F.wave * CS_WSZ;
    LAS float* const scrW = (LAS float*)wsc; LAS float* const scrA = scrW + 16 * 20;
    LAS unsigned char* const ZB = wsc; LAS unsigned char* const XB = wsc + 2304; LAS unsigned char* const UB = wsc + 3072;
    LAS float* const yst = (LAS float*)(wsc + 3840);
    LAS float* const bonp = (LAS float*)(L + CS_BON);
    bf16* Y = z ? P.YB : P.YF;
    const bf16* w2p = P.W2T + (size_t)z * 65536 + (size_t)(chq + l15) * 64 + 8 * l4;
    bf16x8 Wf[2], Af[2];
#pragma unroll
    for (int ks = 0; ks < 2; ++ks) { Wf[ks] = *(const bf16x8*)(w2p + ks * 32); Af[ks] = *(const bf16x8*)(w2p + 2 * 65536 + ks * 32); }
    const f32x4 w0v = *(const f32x4*)(P.w0 + z * 1024 + chq + c4), a0v = *(const f32x4*)(P.a0 + z * 1024 + chq + c4);
    const f32x4 kkv = *(const f32x4*)(P.kk + chq + c4), kav = *(const f32x4*)(P.ka + chq + c4), rkv = *(const f32x4*)(P.rk + chq + c4);
    f32x4 kcn[4];
#pragma unroll
    for (int q = 0; q < 4; ++q) kcn[q] = *(const f32x4*)(P.kk + h * 64 + 16 * cg + q * 4);
    f32x4 Z[4];
#pragma unroll
    for (int jt = 0; jt < 4; ++jt) { const float zq = ozero(); Z[jt] = (f32x4){zq, zq, zq, zq}; }
    bf16x8 Ahw[2], Aha[2]; u32x2 r4, k4, v4; u32x4 kfull[2];
    auto do_load = [&](int c) {
        const int t0c = z ? T - 16 * (c + 1) : 16 * c; const size_t m0 = (size_t)b * T + t0c;
#pragma unroll
        for (int ks = 0; ks < 2; ++ks) { const bf16* p = P.HD1 + (m0 + l15) * 256 + z * 64 + 32 * ks + 8 * l4; Ahw[ks] = *(const bf16x8*)p; Aha[ks] = *(const bf16x8*)(p + 128); }
        const size_t off = (m0 + rr) * 1024;
        r4 = *(const u32x2*)(P.R + off + chq + c4); k4 = *(const u32x2*)(P.K + off + chq + c4); v4 = *(const u32x2*)(P.V + off + chq + c4);
        kfull[0] = ((const u32x4*)(P.K + off + h * 64 + 16 * cg))[0]; kfull[1] = ((const u32x4*)(P.K + off + h * 64 + 16 * cg))[1];
    };
    auto prep_a = [&](int c) {
        LAS unsigned char* const bp = L + (z * 3 + c % 3) * CS_BUF;
        LAS unsigned char* const pz = L + CS_PZ + (z * 2 + (c & 1)) * 4608;
        const float zq = ozero(); f32x4 dw = (f32x4){zq, zq, zq, zq}, da = dw;
#pragma unroll
        for (int ks = 0; ks < 2; ++ks) { dw = mfma16(Ahw[ks], Wf[ks], dw); da = mfma16(Aha[ks], Af[ks], da); }
#pragma unroll
        for (int rg = 0; rg < 4; ++rg) { scrW[(4 * l4 + rg) * 20 + l15] = dw[rg]; scrA[(4 * l4 + rg) * 20 + l15] = da[rg]; }
        float ssq = 0.f;
#pragma unroll
        for (int q = 0; q < 2; ++q)
#pragma unroll
            for (int w = 0; w < 4; ++w) { const float k0 = bflo(kfull[q][w]) * kcn[q * 2 + (w >> 1)][(w & 1) * 2], k1 = bfhi(kfull[q][w]) * kcn[q * 2 + (w >> 1)][(w & 1) * 2 + 1]; ssq += k0 * k0 + k1 * k1; }
        ssq += swz_xor<16>(ssq); ssq = half_sum(ssq);
        const float inv = __builtin_amdgcn_rsqf(fmaxf(ssq, 1e-24f));
        asm volatile("s_waitcnt lgkmcnt(0)" ::: "memory");
        const f32x4 wp = *(const LAS f32x4*)(scrW + rr * 20 + c4), ap = *(const LAS f32x4*)(scrA + rr * 20 + c4);
        const f32x4 kf = (f32x4){bflo(k4.x), bfhi(k4.x), bflo(k4.y), bfhi(k4.y)}, rf = (f32x4){bflo(r4.x), bfhi(r4.x), bflo(r4.y), bfhi(r4.y)}, vf = (f32x4){bflo(v4.x), bfhi(v4.x), bflo(v4.y), bfhi(v4.y)};
        f32x4 at, rt, bt, kt, bhh, khh, gl; float bon = 0.f;
#pragma unroll
        for (int j = 0; j < 4; ++j) {
            const float lw = -0.60653066f * LOG2E * sigmoidf_(wp[j] + w0v[j]);
            const float ar = sigmoidf_(ap[j] + a0v[j]);
            const float kkn = kf[j] * kkv[j] * inv;
            const float kd = kf[j] * (1.0f + (ar - 1.0f) * kav[j]);
            const float bvec = kkn * ar, avec = -kkn;
            const float pi = row_prefix(lw), su = row_suffix(lw) - lw;
            const float eI = fexp2(pi), eE = fexp2(pi - lw), eN = frcp(eI), eS = fexp2(su);
            at[j] = avec * eE; rt[j] = rf[j] * eI; bt[j] = bvec * eN; kt[j] = kd * eN; bhh[j] = bvec * eS; khh[j] = kd * eS; gl[j] = eI * eS;
            bon += rf[j] * kd * rkv[j];
        }
        const int co = jl * 2;
        { u32x2 w; w.x = pk2(at[0], at[1]); w.y = pk2(at[2], at[3]); *(LAS u32x2*)(bp + CS_AT + te * 144 + co) = w; }
        { u32x2 w; w.x = pk2(rt[0], rt[1]); w.y = pk2(rt[2], rt[3]); *(LAS u32x2*)(bp + CS_RT + te * 144 + co) = w; }
        { u32x2 w; w.x = pk2(bt[0], bt[1]); w.y = pk2(bt[2], bt[3]); *(LAS u32x2*)(pz + te * 144 + co) = w; }
        { u32x2 w; w.x = pk2(kt[0], kt[1]); w.y = pk2(kt[2], kt[3]); *(LAS u32x2*)(pz + 2304 + te * 144 + co) = w; }
#pragma unroll
        for (int j = 0; j < 4; ++j) {
            const unsigned bk = pk2(bhh[j], khh[j]);
            *(LAS bf16*)(bp + CS_BK + (jl + j) * 80 + te * 2) = (bf16)(bk & 0xffffu);
            *(LAS bf16*)(bp + CS_BK + (jl + j) * 80 + 32 + te * 2) = (bf16)(bk >> 16);
        }
        *(LAS bf16*)(bp + CS_VT + (jl + 0) * 48 + te * 2) = (bf16)(v4.x & 0xffffu); *(LAS bf16*)(bp + CS_VT + (jl + 1) * 48 + te * 2) = (bf16)(v4.x >> 16);
        *(LAS bf16*)(bp + CS_VT + (jl + 2) * 48 + te * 2) = (bf16)(v4.y & 0xffffu); *(LAS bf16*)(bp + CS_VT + (jl + 3) * 48 + te * 2) = (bf16)(v4.y >> 16);
        if (te == 0) *(LAS f32x4*)(bp + CS_GL + jl * 4) = gl;
        bon += swz_xor<16>(bon); bon = half_sum(bon);
        if (cg == 0) bonp[((z * 3 + c % 3) * 4 + q4) * 16 + rr] = bon;
    };
    LAS float* const nsm = (LAS float*)(L + CS_NS + z * 1024);
    volatile LAS unsigned* const nflag = (volatile LAS unsigned*)(L + CS_NS + 2048 + z * 8);
    auto prep_b1 = [&](int c) {
        LAS unsigned char* const bp = L + (z * 3 + c % 3) * CS_BUF;
        const LAS unsigned char* const pz = L + CS_PZ + (z * 2 + (c & 1)) * 4608;
        const LAS unsigned char* const arow = bp + CS_AT + l15 * 144 + 16 * l4;
        const LAS unsigned char* const brow = pz + l15 * 144 + 16 * l4;
        const float zq = ozero(); f32x4 Nn = (f32x4){zq, zq, zq, zq}, Qq = Nn;
#pragma unroll
        for (int ks = 0; ks < 2; ++ks) { const bf16x8 af = lds16(arow + 64 * ks); Nn = mfma16(af, lds16(brow + 64 * ks), Nn); Qq = mfma16(af, lds16(brow + 2304 + 64 * ks), Qq); }
#pragma unroll
        for (int r = 0; r < 4; ++r) nsm[(4 * l4 + r) * 16 + l15] = Nn[r];
        asm volatile("s_waitcnt lgkmcnt(0)" ::: "memory");
        if (F.lane == 0) *nflag = (unsigned)(c + 1);
#pragma unroll
        for (int r = 0; r < 4; r += 2) { const int t = 4 * l4 + r;
            const unsigned w = pk2(l15 < t ? Qq[r] : 0.f, l15 < t + 1 ? Qq[r + 1] : 0.f);
            *(LAS bf16*)(bp + CS_SMQ + t * 80 + l15 * 2) = (bf16)(w & 0xffffu); *(LAS bf16*)(bp + CS_SMQ + (t + 1) * 80 + l15 * 2) = (bf16)(w >> 16); }
    };
    auto prep_b2 = [&](int c) {
        LAS unsigned char* const bp = L + (z * 3 + c % 3) * CS_BUF;
        const LAS unsigned char* const pz = L + CS_PZ + (z * 2 + (c & 1)) * 4608;
        const LAS unsigned char* const arow = bp + CS_RT + l15 * 144 + 16 * l4;
        const LAS unsigned char* const brow = pz + l15 * 144 + 16 * l4;
        const float zq = ozero(); const f32x4 zero = (f32x4){zq, zq, zq, zq}; f32x4 Nr = zero, Qr = zero;
#pragma unroll
        for (int ks = 0; ks < 2; ++ks) { const bf16x8 af = lds16(arow + 64 * ks); Nr = mfma16(af, lds16(brow + 64 * ks), Nr); Qr = mfma16(af, lds16(brow + 2304 + 64 * ks), Qr); }
#pragma unroll
        for (int r = 0; r < 4; r += 2) { const int t = 4 * l4 + r;
            const unsigned w0 = pk2(l15 <= t ? Nr[r] : 0.f, l15 <= t + 1 ? Nr[r + 1] : 0.f), w1 = pk2(l15 <= t ? Qr[r] : 0.f, l15 <= t + 1 ? Qr[r + 1] : 0.f);
            *(LAS bf16*)(bp + CS_NQ + t * 80 + l15 * 2) = (bf16)(w0 & 0xffffu); *(LAS bf16*)(bp + CS_NQ + (t + 1) * 80 + l15 * 2) = (bf16)(w0 >> 16);
            *(LAS bf16*)(bp + CS_NQ + t * 80 + 32 + l15 * 2) = (bf16)(w1 & 0xffffu); *(LAS bf16*)(bp + CS_NQ + (t + 1) * 80 + 32 + l15 * 2) = (bf16)(w1 >> 16); }
        while (*nflag != (unsigned)(c + 1)) __builtin_amdgcn_s_sleep(1);
        asm volatile("" ::: "memory");
        f32x4 Nc, Mc;
        { const f32x4 mrow = *(const LAS f32x4*)(nsm + l15 * 16 + 4 * l4);
#pragma unroll
          for (int r = 0; r < 4; ++r) { const float n = nsm[(4 * l4 + r) * 16 + l15]; Nc[r] = (l15 < 4 * l4 + r) ? n : 0.f; Mc[r] = (4 * l4 + r < l15) ? mrow[r] : 0.f; } }
        auto split = [&](const f32x4& x) __attribute__((always_inline)) {
            u32x4 w; w.x = pk2(x[0], x[1]); w.y = pk2(x[2], x[3]);
            w.z = pk2(x[0] - __builtin_bit_cast(float, w.x << 16), x[1] - __builtin_bit_cast(float, w.x & 0xffff0000u));
            w.w = pk2(x[2] - __builtin_bit_cast(float, w.y << 16), x[3] - __builtin_bit_cast(float, w.y & 0xffff0000u));
            return w; };
        auto opA = [&](const u32x4& w) __attribute__((always_inline)) { return __builtin_bit_cast(bf16x8, w); };
        auto opBh = [&](const u32x4& w) __attribute__((always_inline)) { return __builtin_bit_cast(bf16x8, (u32x4){w.x, w.y, w.x, w.y}); };
        auto opBl = [&](const u32x4& w) __attribute__((always_inline)) { return __builtin_bit_cast(bf16x8, (u32x4){w.z, w.w, 0u, 0u}); };
        auto hi2 = [&](const f32x4& x) __attribute__((always_inline)) { const unsigned a = pk2(x[0], x[1]), b = pk2(x[2], x[3]); return __builtin_bit_cast(bf16x8, (u32x4){a, b, a, b}); };
        f32x4 P1 = Mc;
#pragma unroll
        for (int r = 0; r < 4; ++r) P1[r] += (4 * l4 + r == l15) ? 1.0f : 0.0f;
        const u32x4 nw = split(Nc), mw = split(Mc);
        f32x4 N2 = mfma16(opA(mw), opBh(nw), zero), M2 = mfma16(opA(nw), opBh(mw), zero);
        N2 = mfma16(opA(mw), opBl(nw), N2); M2 = mfma16(opA(nw), opBl(mw), M2);
        const u32x4 n2w = split(N2), m2w = split(M2);
        f32x4 N4 = mfma16(opA(m2w), opBh(n2w), zero), M4 = mfma16(opA(n2w), opBh(m2w), zero);
        const f32x4 P2 = mfma16(opA(n2w), hi2(P1), P1);
        N4 = mfma16(opA(m2w), opBl(n2w), N4); M4 = mfma16(opA(n2w), opBl(m2w), M4);
        const u32x4 n4w = split(N4), m4w = split(M4);
        f32x4 N8 = mfma16(opA(m4w), opBh(n4w), zero);
        const f32x4 P4 = mfma16(opA(n4w), hi2(P2), P2);
        N8 = mfma16(opA(m4w), opBl(n4w), N8);
        const f32x4 R = mfma16(opA(split(N8)), hi2(P4), P4);
        { u32x2 w; w.x = pk2(R[0], R[1]); w.y = pk2(R[2], R[3]); *(LAS u32x2*)(bp + CS_SMT + l15 * 80 + 8 * l4) = w; }
    };
    auto stage_s = [&](int c) {
        const LAS unsigned char* const bp = L + (z * 3 + c % 3) * CS_BUF;
        const int q = l4, i = l15;
#pragma unroll
        for (int jt = 0; jt < 4; ++jt) { u32x2 w; w.x = pk2(Z[jt][0], Z[jt][1]); w.y = pk2(Z[jt][2], Z[jt][3]); *(LAS u32x2*)(ZB + i * 144 + (16 * jt + 4 * q) * 2) = w; }
        asm volatile("" ::: "memory");
        const bf16x8 Zb0 = lds16(ZB + i * 144 + (8 * q) * 2), Zb1 = lds16(ZB + i * 144 + (32 + 8 * q) * 2);
        const bf16x8 Vb = lds16(bp + CS_VT + (16 * q4 + i) * 48 + 8 * (q & 1) * 2);
        const LAS unsigned char* arow = bp + l15 * 144 + 8 * q * 2;
        const float zq = ozero(); const f32x4 zero = (f32x4){zq, zq, zq, zq};
        f32x4 X = mfma16(lds16(arow + CS_AT), Zb0, zero); f32x4 Yv = mfma16(lds16(arow + CS_RT), Zb0, zero);
        X = mfma16(lds16(arow + CS_AT + 64), Zb1, X); Yv = mfma16(lds16(arow + CS_RT + 64), Zb1, Yv);
        X = mfma16(lds16(bp + CS_SMQ + l15 * 80 + 16 * q), Vb, X);
        { u32x2 w; w.x = pk2(X[0], X[1]); w.y = pk2(X[2], X[3]); *(LAS u32x2*)(XB + i * 48 + 8 * q) = w; }
        asm volatile("" ::: "memory");
        const bf16x8 Xb = lds16(XB + i * 48 + 16 * (q & 1));
        const f32x4 U = mfma16(lds16(bp + CS_SMT + l15 * 80 + 16 * q), Xb, zero);
        { u32x2 w; w.x = pk2(U[0], U[1]); w.y = pk2(U[2], U[3]); *(LAS u32x2*)(UB + i * 48 + 8 * q) = w; }
        asm volatile("" ::: "memory");
        const bf16x8 Ub = lds16(UB + i * 48 + 16 * (q & 1));
        const bf16x8 UVb = q < 2 ? Ub : Vb;
        Yv = mfma16(lds16(bp + CS_NQ + l15 * 80 + 16 * q), UVb, Yv);
#pragma unroll
        for (int r = 0; r < 4; ++r) yst[(4 * q + r) * 16 + i] = Yv[r];
#pragma unroll
        for (int jt = 0; jt < 4; ++jt) { const f32x4 g = *(const LAS f32x4*)(bp + CS_GL + (16 * jt + 4 * q) * 4);
            Z[jt] = mfma16(lds16(bp + CS_BK + (16 * jt + l15) * 80 + 16 * q), UVb, Z[jt] * g); }
    };
    auto flush_y = [&](int c) {
        const int t0c = z ? T - 16 * (c + 1) : 16 * c; const int st = F.lane >> 2, i4 = (F.lane & 3) * 4;
        f32x4 yv = *(const LAS f32x4*)(yst + st * 16 + i4);
        u32x2 w; w.x = pk2(yv.x, yv.y); w.y = pk2(yv.z, yv.w);
        *(u32x2*)(Y + (size_t)(b * T + t0c + (z ? 15 - st : st)) * 1024 + chq + i4) = w;
    };
    auto bonus_flush = [&](int c) {
        if (q4 == 0 && F.lane < 16) {
            const int t0c = z ? T - 16 * (c + 1) : 16 * c; const size_t m0 = (size_t)b * T + t0c;
            const LAS float* qq = bonp + (z * 3 + c % 3) * 64 + F.lane;
            P.BON[((size_t)z * M + m0 + F.lane) * 16 + h] = (qq[0] + qq[16]) + (qq[32] + qq[48]);
        }
    };
    __syncthreads();
    for (int e = F.tid; e < 6 * 2 * 16 * 8; e += 512) { const int row = (e >> 3) & 15, tile = (e >> 7) & 1, zb = e >> 8, w = e & 7;
        *(LAS unsigned*)(L + zb * CS_BUF + (tile ? CS_SMT : CS_SMQ) + row * 80 + 32 + w * 4) = 0u; }
    const bool pa_wave = (q4 == z), pb_wave = (q4 == (z ^ 2));
    if (F.tid < 4) ((LAS unsigned*)(L + CS_NS + 2048))[F.tid] = 0u;
    constexpr int NC = T / 16;
    do_load(0); prep_a(0); do_load(1); prep_a(1);
    asm volatile("s_waitcnt lgkmcnt(0)" ::: "memory"); __builtin_amdgcn_s_barrier(); asm volatile("" ::: "memory");
    if (pa_wave) prep_b1(0);
    if (pb_wave) prep_b2(0);
    do_load(2);
    asm volatile("s_waitcnt lgkmcnt(0)" ::: "memory"); __builtin_amdgcn_s_barrier(); asm volatile("" ::: "memory");
    for (int e = 0; e < NC; ++e) {
        if (pa_wave && e + 1 < NC) prep_b1(e + 1);
        if (pb_wave && e + 1 < NC) prep_b2(e + 1);
        asm volatile("" ::: "memory");
#pragma unroll 1
        for (int st = 0; st < 2; ++st) {
            if ((st ^ z) == 0) {
                if (e + 2 < NC) prep_a(e + 2);
                asm volatile("" ::: "memory");
                if (e + 3 < NC) do_load(e + 3);
                asm volatile("" ::: "memory");
                { const int fe = z ? e : e - 1; if (fe >= 0) flush_y(fe); }
                if (e + 1 < NC) bonus_flush(e + 1);
                if (e == 0) bonus_flush(0);
            } else {
                stage_s(e);
            }
            asm volatile("" ::: "memory");
        }
        asm volatile("s_waitcnt lgkmcnt(0)" ::: "memory");
        __builtin_amdgcn_s_barrier(); asm volatile("" ::: "memory");
    }
    if (z == 0) flush_y(T / 16 - 1);
}

#define XB_TMO      128
#define XB_XCNT(j)  (256  + 64 * (j))
#define XB_XSUB(j)  (1280 + 64 * (j))
#define XB_XGEN(j)  (2304 + 64 * (j))
#define XB_TOP      3328
#define XB_TOPGEN   3392
#define XCD_BAR_WORDS 3456
#define XB_SPIN_CAP (1u << 22)
DI unsigned xb_ld(unsigned* p)              { return __hip_atomic_load(p, __ATOMIC_RELAXED, __HIP_MEMORY_SCOPE_AGENT); }
DI unsigned xb_add(unsigned* p, unsigned v) { return __hip_atomic_fetch_add(p, v, __ATOMIC_RELAXED, __HIP_MEMORY_SCOPE_AGENT); }
DI unsigned xb_xcc_id() { return (unsigned)__builtin_amdgcn_s_getreg((3 << 11) | 20) & 0xFu; }
#define XB_SPIN(cond, bar) do { unsigned _sp = 0; while (cond) { __builtin_amdgcn_s_sleep(1); \
    if ((++_sp & 255u) == 0u) { if (xb_ld(&(bar)[XB_TMO])) break; if (_sp > XB_SPIN_CAP) { atomicAdd(&(bar)[XB_TMO], 1u); break; } } } } while (0)
struct XcdBarrier { unsigned* bar; unsigned x; volatile LAS unsigned* st; };
DI XcdBarrier xcd_barrier_post(unsigned* bar, volatile LAS unsigned* st) {
    XcdBarrier b; b.bar = bar; b.x = xb_xcc_id(); b.st = st;
    if (threadIdx.x == 0) (void)xb_add(&bar[XB_XCNT(b.x)], 1u);
    return b;
}
DI void xcd_barrier_complete(unsigned* bar, unsigned x, unsigned& nloc, unsigned& nx) {
    const unsigned G = gridDim.x * gridDim.y * gridDim.z;
    unsigned sum, cnt, mine, sp = 0u;
    for (;;) {
        sum = 0u; cnt = 0u; mine = 0u;
#pragma unroll
        for (unsigned j = 0; j < 16; ++j) { const unsigned c = xb_ld(&bar[XB_XCNT(j)]); sum += c; cnt += (c > 0u) ? 1u : 0u; mine = (j == x) ? c : mine; }
        if (sum == G) break;
        __builtin_amdgcn_s_sleep(1);
        if ((++sp & 255u) == 0u) { if (xb_ld(&bar[XB_TMO])) break; if (sp > XB_SPIN_CAP) { atomicAdd(&bar[XB_TMO], 1u); break; } }
    }
    nloc = mine > 0u ? mine : 1u; nx = cnt > 0u ? cnt : 1u;
}
DI void xcd_barrier(const XcdBarrier& b) {
    asm volatile("s_waitcnt vmcnt(0)" ::: "memory");
    __syncthreads();
    if (threadIdx.x == 0) {
        unsigned* bar = b.bar;
        __builtin_amdgcn_s_waitcnt(0);
        unsigned nloc = b.st[0], nx = b.st[1];
        if (nloc == 0u) { xcd_barrier_complete(bar, b.x, nloc, nx); b.st[0] = nloc; b.st[1] = nx; }
        const unsigned old = xb_add(&bar[XB_XSUB(b.x)], 1u);
        const unsigned gen = old / nloc;
        if (old + 1u == (gen + 1u) * nloc) {
            __builtin_amdgcn_fence(__ATOMIC_RELEASE, "agent");
            asm volatile("s_waitcnt vmcnt(0)" ::: "memory");
            const unsigned og = xb_add(&bar[XB_TOP], 1u);
            const unsigned tg = og / nx;
            if (og + 1u == (tg + 1u) * nx) xb_add(&bar[XB_TOPGEN], 1u);
            else XB_SPIN(xb_ld(&bar[XB_TOPGEN]) == tg, bar);
            __builtin_amdgcn_fence(__ATOMIC_ACQUIRE, "agent");
            xb_add(&bar[XB_XGEN(b.x)], 1u);
            asm volatile("s_waitcnt vmcnt(0)" ::: "memory");
        } else {
            XB_SPIN(xb_ld(&bar[XB_XGEN(b.x)]) == gen, bar);
            __builtin_amdgcn_fence(__ATOMIC_ACQUIRE, "agent");
            asm volatile("s_waitcnt vmcnt(0)" ::: "memory");
        }
    }
    __syncthreads();
}

#ifndef MK_PROG
#define MK_PROG 0,3,4,5,7,8,10,11,12,13,16,14,15,17,19,20,22,23,24
#endif
__constant__ int PROG[] = {MK_PROG};
constexpr int NPH = sizeof(PROG) / sizeof(int);
template <int TYPE> struct PreSched {
    static constexpr int AJT = 1 << 30; static constexpr size_t ajump = 0;
    const bf16* KV; const bf16* W; int G, c;
    DI bool next(int i, Unit& u) const {
        const long L = (long)i * G + c; if (L >= 512) return false;
        const int rem = (int)L, i2 = rem >> 8, b = (rem >> 4) & 15, hh = (rem >> 2) & 3, t4 = rem & 3;
        u.pm = 0; u.pn = 0;
        const bf16* kvp = KV + (size_t)(b * 256) * 4096 + i2 * 2048 + hh * 256;
        const bf16* wp = W + (size_t)i2 * 1024 * 1024 + (size_t)(t4 * 256) * 1024 + hh * 256;
        if (TYPE == 0) { u.pa = (const char*)kvp; u.pb = (const char*)wp; u.z = (i2 << 30) | (b * 1048576 + hh * 256 * 1024 + t4 * 256); }
        else { u.pa = (const char*)wp; u.pb = (const char*)(kvp + 1024); u.z = (i2 << 30) | (16 * 1048576 + b * 1048576 + t4 * 256 * 1024 + hh * 256); }
        return true;
    }
};

__global__ void __launch_bounds__(512, 2) mk_fwd(Args a) {
    extern __shared__ __attribute__((aligned(16))) unsigned char lds_raw[];
    Frame F;
    F.lds = (LAS unsigned char*)lds_raw;
    F.tid = threadIdx.x; F.lane = F.tid & 63; F.wave = __builtin_amdgcn_readfirstlane(F.tid >> 6);
    F.gw = blockIdx.x * 8 + F.wave; F.ngw = gridDim.x * 8; F.ws = a.ws;
    cg::grid_group grid = cg::this_grid();
    volatile LAS unsigned* MISC = (volatile LAS unsigned*)(F.lds + LDS_MISC);
    if (F.tid < 2) MISC[F.tid] = 0u;
    __syncthreads();
    (void)xcd_barrier_post((unsigned*)(a.ws + WS_BAR), MISC);

    for (int pi = a.ph_lo; pi < a.ph_hi; ++pi) {
        const int ph = PROG[pi];
        const int G = opq(gridDim.x), cblk = opq(blockIdx.x);
        unsigned char* ws = a.ws + (size_t)opq(0);
        float* RS = (float*)(ws + WS_RS);
        bf16* SA = (bf16*)(ws + WS_SA); bf16* SB = (bf16*)(ws + WS_SB);
        bf16* H = (bf16*)a.out;
        const int li = ph >= 18 ? 1 : 0;
        int cp = ph; if (ph >= 18 && ph <= 23) cp = ph - 12;
#ifndef PH_MASK
#define PH_MASK 0xffffffffu
#endif
        if (!((PH_MASK >> cp) & 1u)) cp = 99;
        switch (cp) {
        case 0: phase_prologue(F, a, ws); break;
        case 3: {
            { pg8::PlainSched S{SA, (const bf16*)(ws + WS_WIN), 1024, 1024, M / 256, 8, G, cblk, 30, 0};
              EpiInProj E{(bf16*)(ws + WS_GLU), SB, RS};
              pg8::gemm_phase(F.lds, 1024, 1024, 1024, S, E); }
            { pg8::PlainSched S{(const bf16*)(ws + WS_WIN) + (size_t)2048 * 1024, SA, 1024, 1024, 2, M / 256, G, cblk, 30, 0};
              EpiVT E{(bf16*)(ws + WS_VT), RS};
              pg8::gemm_phase(F.lds, 1024, 1024, 1024, S, E); }
                    {

            pg8::PlainSched S{(const bf16*)(ws + WS_MEMB), (const bf16*)(ws + WS_WKV), 1024, 1024, MMEM / 256, 16, G, cblk, 30, 0};
            EpiRowScale<0> E{(bf16*)(ws + WS_KV), 4096, (const float*)(ws + WS_RSMEM), nullptr};
            pg8::gemm_phase(F.lds, 1024, 1024, 1024, S, E);
                    }
        } break;
        case 4: {
            const float lam = ((const float*)(ws + WS_LAM))[0];
            for (int u = cblk; u < 1024; u += G) diffattn_unit(F, u, SB, (const bf16*)(ws + WS_VT), (const float*)(ws + WS_BIAS), lam, a.in[opq(I_SUBLN)], (bf16*)(ws + WS_MIX));
            __syncthreads();
            conv_load_weights(F, a.in[opq(I_CONVW)]);
            for (int u = cblk; u < 512; u += G) conv_unit(F, u, (const bf16*)(ws + WS_GLU), a.in[opq(I_CONVB)], a.in[opq(I_CLNG)], a.in[opq(I_CLNB)], (bf16*)(ws + WS_MIX));
            __syncthreads();
                    {

            EpiPre E{(bf16*)(ws + WS_G0)};
            { PreSched<0> S{(const bf16*)(ws + WS_KV), (const bf16*)(ws + WS_WQN), G, cblk}; pg8::gemm_phase(F.lds, 256, 4096, 1024, S, E); }
            { PreSched<1> S{(const bf16*)(ws + WS_KV), (const bf16*)(ws + WS_WXO), G, cblk}; pg8::gemm_phase(F.lds, 256, 1024, 4096, S, E); }
                    }
        } break;
        case 5: {
            pg8::PlainSched S{(const bf16*)(ws + WS_MIX), (const bf16*)(ws + WS_WOUT), 1024, 1024, M / 256, 4, G, cblk, 30, 0};
            EpiResid E{a.in[opq(I_X)], nullptr, H, (float*)(ws + WS_PS)};
            pg8::gemm_phase(F.lds, 1024, 1024, 1024, S, E);
        } break;
        case 7: {
            pg8::PlainSched S{H, (const bf16*)(ws + (li ? WS_G1 : WS_G0)), 1024, 1024, M / 256, 4, G, cblk, 3, (size_t)1048576};
            EpiSoftmax E{SB, (const float*)(ws + WS_PS)};
            pg8::gemm_phase(F.lds, 1024, 1024, 1024, S, E);
        } break;
        case 8: {
            pg8::PlainSched S{SB, (const bf16*)(ws + (li ? WS_VW1 : WS_VW0)), 1024, 1024, M / 256, 4, G, cblk, 3, (size_t)1048576};
            EpiResid E{nullptr, H, H, (float*)(ws + WS_PS)};
            pg8::gemm_phase(F.lds, 1024, 1024, 1024, S, E);
        } break;
        case 10: {
            pg8::PlainSched S{H, (const bf16*)(ws + WS_WUP) + (size_t)li * 4096 * 1024, 1024, 1024, M / 256, 16, G, cblk, 30, 0};
            EpiRowScale<2> E{(bf16*)(ws + WS_HID), 4096, nullptr, (const float*)(ws + WS_PS)};
            pg8::gemm_phase(F.lds, 1024, 1024, 1024, S, E);
        } break;
        case 11: {
            pg8::PlainSched S{(const bf16*)(ws + WS_HID), (const bf16*)(ws + WS_WDN) + (size_t)li * 1024 * 4096, 4096, 4096, M / 256, 4, G, cblk, 30, 0};
            EpiResid E{nullptr, H, li ? SA : H, nullptr};
            pg8::gemm_phase(F.lds, 4096, 4096, 4096, S, E);
        } break;
        case 12: phase_rwkv_shift(F, H, a.in[opq(I_NMIX)] + 1024, a.in[opq(I_MU)], (bf16*)(ws + WS_XR), (bf16*)a.out + (size_t)M * 1024, (bf16*)(ws + WS_XV), (bf16*)(ws + WS_HH)); break;
        case 13: {
            pg8::SelSched<4, 1 << 30> S{(const bf16*)a.out + (size_t)M * 1024, (const bf16*)(ws + WS_XV), (const bf16*)(ws + WS_WBIG) + (size_t)1024 * 1024, 1024, 1024, M / 256, 8, 4, G, cblk, 0};
            EpiRwkv E{(bf16*)(ws + WS_R), (bf16*)(ws + WS_K), (bf16*)(ws + WS_V), (bf16*)(ws + WS_HD1), (bf16*)(ws + WS_HD2)};
            pg8::gemm_phase(F.lds, 1024, 1024, 1024, S, E);
        } break;
        case 16: {
            EpiRwkv E{(bf16*)(ws + WS_R), (bf16*)(ws + WS_K), (bf16*)(ws + WS_V), (bf16*)(ws + WS_HD1), (bf16*)(ws + WS_HD2)};
            { pg8::SelSched<0, 1 << 30> S{(const bf16*)(ws + WS_XR), (const bf16*)(ws + WS_XR), (const bf16*)(ws + WS_WBIG), 1024, 1024, M / 256, 4, 4, G, cblk, 0};
              pg8::gemm_phase(F.lds, 1024, 1024, 1024, S, E); }
            { pg8::SelSched<12, 16> S{(const bf16*)(ws + WS_XR), (const bf16*)(ws + WS_XR), (const bf16*)(ws + WS_WLORA), 1024, 2048, M / 256, 2, 2, G, cblk, ((size_t)M * 1024 - 1024) * 2};
              pg8::gemm_phase(F.lds, 2048, 1024, 2048, S, E); }
        } break;
        case 14: {
            ScanPtrs P{(const bf16*)(ws + WS_R), (const bf16*)(ws + WS_K), (const bf16*)(ws + WS_V), (const bf16*)(ws + WS_HD1), (const bf16*)(ws + WS_W2T),
                       a.in[opq(I_W0)], a.in[opq(I_A0)], a.in[opq(I_KK)], a.in[opq(I_KA)], a.in[opq(I_RK)], (bf16*)(ws + WS_YF), (bf16*)(ws + WS_YB), (float*)(ws + WS_BONUS), (unsigned*)(ws + WS_BAR + 32768)};
            for (int bh = cblk; bh < 256; bh += G) scan_pair_mfma(F, bh, P);
            __syncthreads();
        } break;
        case 15: {
            pg8::PlainSched S{(const bf16*)(ws + WS_HD2), (const bf16*)(ws + WS_G2T), 256, 256, M / 256, 4, G, cblk, 30, 0};
            EpiGateComb E{(const bf16*)(ws + WS_YF), (const bf16*)(ws + WS_YB), (const bf16*)(ws + WS_V), (const float*)(ws + WS_BONUS), a.in[opq(I_LNG)], a.in[opq(I_LNB)], (bf16*)(ws + WS_COMB)};
            pg8::gemm_phase(F.lds, 256, 256, 256, S, E);
        } break;
        case 17: {
            pg8::PlainSched S{(const bf16*)(ws + WS_COMB), (const bf16*)(ws + WS_WRO), 1024, 1024, M / 256, 4, G, cblk, 30, 0};
            EpiResid E{nullptr, H, H, (float*)(ws + WS_PS)};
            pg8::gemm_phase(F.lds, 1024, 1024, 1024, S, E);
        } break;
        case 24: {
            float osc = 1.0f;
            phase_final_norm(F, SA, a.out, a.in[opq(I_NFINAL)], osc);
        } break;
        default: break;
        }
        if (pi + 1 < a.ph_hi) {
            if (a.ph_lo < 0) grid.sync();
            { XcdBarrier xb; xb.bar = (unsigned*)(ws + WS_BAR); xb.x = xb_xcc_id(); xb.st = (volatile LAS unsigned*)(F.lds + LDS_MISC); xcd_barrier(xb); }
        }
    }
}

extern "C" void kernel_launch(void* const* d_in, const int* in_sizes, int n_in, void* d_out, int out_size, void* d_ws, size_t ws_size, hipStream_t stream) {
    static int grid = 0;
    if (grid == 0) {
        if (n_in != N_IN || in_sizes[0] != M * D || out_size != M * D || ws_size < WS_NEED) {
            fprintf(stderr, "kernel_launch: unexpected problem (n_in %d, in0 %d, out %d, ws %zu); nothing launched\n", n_in, n_in > 0 ? in_sizes[0] : -1, out_size, ws_size); grid = -1; return; }
        int dev = 0, cus = 0, per_cu = 0;
        if (hipGetDevice(&dev) != hipSuccess || hipDeviceGetAttribute(&cus, hipDeviceAttributeMultiprocessorCount, dev) != hipSuccess) { grid = -1; return; }
        if (hipFuncSetAttribute((const void*)mk_fwd, hipFuncAttributeMaxDynamicSharedMemorySize, LDS_BYTES) != hipSuccess) { fprintf(stderr, "kernel_launch: hipFuncSetAttribute failed\n"); grid = -1; return; }
        if (hipOccupancyMaxActiveBlocksPerMultiprocessor(&per_cu, (const void*)mk_fwd, 512, LDS_BYTES) != hipSuccess || per_cu < 1) { fprintf(stderr, "kernel_launch: occupancy query says %d\n", per_cu); (void)hipGetLastError(); grid = -1; return; }
        grid = cus;
    }
    if (grid < 0) return;
    if (hipMemsetAsync((char*)d_ws + WS_BAR, 0, 65536, stream) != hipSuccess) { fprintf(stderr, "kernel_launch: memset failed\n"); return; }
    Args a{};
    for (int i = 0; i < N_IN; ++i) a.in[i] = (const float*)d_in[i];
    a.out = (float*)d_out; a.ws = (unsigned char*)d_ws;
#if MK_SINGLE
    a.ph_lo = 0; a.ph_hi = NPH;
    void* params[] = {&a};
    hipError_t e = hipLaunchCooperativeKernel((const void*)mk_fwd, dim3(grid), dim3(512), params, LDS_BYTES, stream);
    if (e != hipSuccess) fprintf(stderr, "kernel_launch: cooperative launch failed: %s\n", hipGetErrorString(e));
#else
    for (int ph = 0; ph < NPH; ++ph) { a.ph_lo = ph; a.ph_hi = ph + 1; hipLaunchKernelGGL(mk_fwd, dim3(grid), dim3(512), LDS_BYTES, stream, a); }
#endif
}
```
